# Optimizing an MI355X kernel written in HIP

```python
import math
import jax
import jax.numpy as jnp
from jax import lax
import numpy as np

D_MODEL = 1024
BATCH = 4
SEQ = 8192
DEPTH = 4
DEC_BATCH = 16
DEC_SEQ = 16
PAST_LEN = 2048

CHUNK = 64
N_MIXERS = 2
N_GDN = (DEPTH + 1) // 2
N_DIFF = DEPTH // 2
RMS_EPS = 1e-6
F32 = jnp.float32

GDN_HEADS = 8
GDN_DK = 128
GDN_DV = 128
GDN_QK_WIDTH = GDN_HEADS * GDN_DK
GDN_WIDTH = GDN_HEADS * GDN_DV
CONV_WIDTH = 4
GDN_CONV_CH = 2 * GDN_QK_WIDTH + GDN_WIDTH
GDN_IN = GDN_CONV_CH + GDN_WIDTH + 2 * GDN_HEADS

DIFF_HEADS = 8
DIFF_QK_DIM = 64
DIFF_V_DIM = 2 * DIFF_QK_DIM
DIFF_QK_WIDTH = DIFF_HEADS * 2 * DIFF_QK_DIM
DIFF_WIDTH = DIFF_HEADS * DIFF_V_DIM
DIFF_IN = 2 * DIFF_QK_WIDTH + 2 * DIFF_WIDTH
Q_BLOCK = 128
ROPE_THETA = 10000.0

kernel_name = "hybrid_gdn_diffattn_stream_step"


def rmsnorm(x, w):
    xf = x.astype(F32)
    y = xf * lax.rsqrt(jnp.mean(xf * xf, axis=-1, keepdims=True) + RMS_EPS)
    return (y * w.astype(F32)).astype(x.dtype)


def l2norm(x):
    return x * lax.rsqrt(jnp.sum(x * x, axis=-1, keepdims=True) + 1e-6)


def rope(x, pos):
    half = x.shape[-1] // 2
    inv = 1.0 / (ROPE_THETA ** (jnp.arange(half, dtype=F32) / half))
    ang = pos.astype(F32)[:, None] * inv[None, :]
    cos = jnp.cos(ang)[None, :, None, :]
    sin = jnp.sin(ang)[None, :, None, :]
    xf = x.astype(F32)
    x1, x2 = xf[..., :half], xf[..., half:]
    return jnp.concatenate([x1 * cos - x2 * sin, x2 * cos + x1 * sin], axis=-1).astype(x.dtype)


def causal_conv(u, buf, w):
    T = u.shape[1]
    full = jnp.concatenate([buf, u], axis=1)
    y = full[:, 0:T] * w[0]
    for j in range(1, CONV_WIDTH):
        y = y + full[:, j:j + T] * w[j]
    return jax.nn.silu(y), full[:, -(CONV_WIDTH - 1):]


def gdn_chunked(q, k, v, g, beta, s0, chunk):
    B, T, H, _ = q.shape
    dv = v.shape[-1]
    n = T // chunk

    def blocks(a):
        return jnp.swapaxes(a.reshape((B, n, chunk, H) + a.shape[3:]), 2, 3)

    q, k, v, g, beta = blocks(q), blocks(k), blocks(v), blocks(g), blocks(beta)
    G = jnp.cumsum(g, axis=-1)
    idx = jnp.arange(chunk)
    incl = idx[:, None] >= idx[None, :]
    strict = idx[:, None] > idx[None, :]
    decay = jnp.exp(jnp.where(incl, G[..., :, None] - G[..., None, :], -jnp.inf))
    kb = k * beta[..., None]
    A = jnp.where(strict, jnp.einsum("bnhid,bnhjd->bnhij", kb, k) * decay, 0.0)
    eye = jnp.eye(chunk, dtype=q.dtype)
    rhs = jnp.concatenate([v * beta[..., None], kb * jnp.exp(G)[..., None]], axis=-1)
    sol = lax.linalg.triangular_solve(eye + A, rhs, left_side=True, lower=True, unit_diagonal=True)
    u_intra, w = sol[..., :dv], sol[..., dv:]
    qk = jnp.einsum("bnhid,bnhjd->bnhij", q, k) * decay
    qg = q * jnp.exp(G)[..., None]
    kd = k * jnp.exp(G[..., -1:] - G)[..., None]
    g_last = jnp.exp(G[..., -1])

    def step(s, xs):
        u_i, w_i, qk_i, qg_i, kd_i, gl_i = xs
        u = u_i - jnp.einsum("bhcd,bhde->bhce", w_i, s)
        o = jnp.einsum("bhcd,bhde->bhce", qg_i, s) + jnp.einsum("bhij,bhje->bhie", qk_i, u)
        s = s * gl_i[..., None, None] + jnp.einsum("bhcd,bhce->bhde", kd_i, u)
        return s, o

    xs = (jnp.moveaxis(u_intra, 1, 0), jnp.moveaxis(w, 1, 0), jnp.moveaxis(qk, 1, 0),
          jnp.moveaxis(qg, 1, 0), jnp.moveaxis(kd, 1, 0), jnp.moveaxis(g_last, 1, 0))
    s_final, o = lax.scan(step, s0, xs)
    o = jnp.swapaxes(jnp.moveaxis(o, 0, 1), 2, 3).reshape(B, T, H, dv)
    return o, s_final


def gdn_mixer(h, conv_buf, s0, w_in, conv_w, a_log, dt_bias, o_norm, w_out):
    B, T, _ = h.shape
    proj = h @ w_in
    i1 = GDN_CONV_CH
    i2 = i1 + GDN_WIDTH
    i3 = i2 + GDN_HEADS
    qkv, z, a, b = proj[..., :i1], proj[..., i1:i2], proj[..., i2:i3], proj[..., i3:]
    qkv_c, new_buf = causal_conv(qkv, conv_buf, conv_w)
    qkv_c = qkv_c.astype(F32)
    q = l2norm(qkv_c[..., :GDN_QK_WIDTH].reshape(B, T, GDN_HEADS, GDN_DK)) * (GDN_DK ** -0.5)
    k = l2norm(qkv_c[..., GDN_QK_WIDTH:2 * GDN_QK_WIDTH].reshape(B, T, GDN_HEADS, GDN_DK))
    v = qkv_c[..., 2 * GDN_QK_WIDTH:].reshape(B, T, GDN_HEADS, GDN_DV)
    g = -jnp.exp(a_log.astype(F32)) * jax.nn.softplus(a.astype(F32) + dt_bias.astype(F32))
    beta = jax.nn.sigmoid(b.astype(F32))
    o, s_new = gdn_chunked(q, k, v, g, beta, s0.astype(F32), min(CHUNK, T))
    o = rmsnorm(o, o_norm) * jax.nn.silu(z.astype(F32).reshape(B, T, GDN_HEADS, GDN_DV))
    y = o.reshape(B, T, GDN_WIDTH).astype(h.dtype) @ w_out
    return y, new_buf, s_new.astype(s0.dtype)


def diff_project(h, w_in, pos):
    B, T, _ = h.shape
    proj = h @ w_in
    i1 = DIFF_QK_WIDTH
    i2 = 2 * DIFF_QK_WIDTH
    i3 = i2 + DIFF_WIDTH
    q = rope(proj[..., :i1].reshape(B, T, 2 * DIFF_HEADS, DIFF_QK_DIM), pos)
    k = rope(proj[..., i1:i2].reshape(B, T, 2 * DIFF_HEADS, DIFF_QK_DIM), pos)
    q = q.reshape(B, T, DIFF_HEADS, 2, DIFF_QK_DIM)
    k = k.reshape(B, T, DIFF_HEADS, 2, DIFF_QK_DIM)
    v = proj[..., i2:i3].reshape(B, T, DIFF_HEADS, DIFF_V_DIM)
    z = proj[..., i3:]
    return q, k, v, z


def diff_lambda(lq1, lk1, lq2, lk2, lam_init):
    return (jnp.exp(jnp.sum(lq1.astype(F32) * lk1.astype(F32)))
            - jnp.exp(jnp.sum(lq2.astype(F32) * lk2.astype(F32))) + lam_init)


def diff_attend(q, k, v, lam, mask):
    s = jnp.einsum("bqhcd,bkhcd->bhcqk", q.astype(F32) * (DIFF_QK_DIM ** -0.5), k.astype(F32))
    if mask is not None:
        s = jnp.where(mask, s, -jnp.inf)
    p = jax.nn.softmax(s, axis=-1)
    a = p[:, :, 0] - lam * p[:, :, 1]
    return jnp.einsum("bhqk,bkhe->bqhe", a, v.astype(F32))


def diff_attend_prompt(q, k, v, lam):
    B, T = q.shape[:2]
    nb = T // Q_BLOCK
    qb = jnp.swapaxes(q.reshape(B, nb, Q_BLOCK, DIFF_HEADS, 2, DIFF_QK_DIM), 0, 1)
    key_chunk = jnp.arange(T) // CHUNK

    def block(args):
        q_blk, bi = args
        q_chunk = (bi * Q_BLOCK + jnp.arange(Q_BLOCK)) // CHUNK
        mask = key_chunk[None, :] <= q_chunk[:, None]
        return diff_attend(q_blk, k, v, lam, mask)

    o = lax.map(block, (qb, jnp.arange(nb)))
    return jnp.swapaxes(o, 0, 1).reshape(B, T, DIFF_HEADS, DIFF_V_DIM)


def diff_output(o, z, subln, lam_init, w_out, dtype):
    B, T = o.shape[:2]
    o = rmsnorm(o, subln) * (1.0 - lam_init)
    o = o.reshape(B, T, DIFF_WIDTH) * jax.nn.silu(z.astype(F32))
    return o.astype(dtype) @ w_out


def trunk(x, c, pos, conv_bufs, gdn_states, past_k, past_v, p):
    B, T, _ = x.shape
    c_act = jax.nn.silu(c.astype(F32))
    states, convs, ks, vs = [], [], [], []
    for i in range(DEPTH):
        j = i // N_MIXERS
        ada = c_act @ p["w_ada"][i].astype(F32) + p["b_ada"][i].astype(F32)
        shift, scale, gate = jnp.split(ada[:, None, :], 3, axis=-1)
        h = (rmsnorm(x, p["norm_pre"][i]).astype(F32) * (1.0 + scale) + shift).astype(x.dtype)
        if i % N_MIXERS == 0:
            out, buf, st = gdn_mixer(h, conv_bufs[j], gdn_states[j], p["w_in_gdn"][j], p["conv_gdn"][j],
                                     p["a_log_gdn"][j], p["dt_bias_gdn"][j], p["onorm_gdn"][j],
                                     p["w_out_gdn"][j])
            convs.append(buf)
            states.append(st)
        else:
            lam_init = 0.8 - 0.6 * math.exp(-0.3 * i)
            lam = diff_lambda(p["lam_q1"][j], p["lam_k1"][j], p["lam_q2"][j], p["lam_k2"][j], lam_init)
            q, k, v, z = diff_project(h, p["w_in_diff"][j], pos)
            if past_k is None:
                o = diff_attend_prompt(q, k, v, lam)
            else:
                k_all = jnp.concatenate([past_k[j].reshape(B, -1, DIFF_HEADS, 2, DIFF_QK_DIM), k], axis=1)
                v_all = jnp.concatenate([past_v[j], v], axis=1)
                o = diff_attend(q, k_all, v_all, lam, None)
            out = diff_output(o, z, p["subln_diff"][j], lam_init, p["w_out_diff"][j], x.dtype)
            ks.append(k.reshape(B, T, DIFF_HEADS, 2 * DIFF_QK_DIM))
            vs.append(v)
        x = x + (gate * rmsnorm(out, p["norm_post"][i]).astype(F32)).astype(x.dtype)
    return x, jnp.stack(states), jnp.stack(convs), jnp.stack(ks), jnp.stack(vs)


def setup_inputs(seed: int = 0) -> dict:
    key = jax.random.key(seed)
    ks = iter(jax.random.split(key, 32))

    def nrm(shape, s=1.0):
        return jax.random.normal(next(ks), shape, F32) * s

    def unif(shape, lo, hi):
        return jax.random.uniform(next(ks), shape, F32, lo, hi)

    dt = jnp.exp(unif((N_GDN, GDN_HEADS), math.log(1e-3), math.log(1e-1)))
    return {
        "x_prompt": nrm((BATCH, SEQ, D_MODEL)),
        "x_sample": nrm((DEC_BATCH, DEC_SEQ, D_MODEL)),
        "c_prompt": nrm((BATCH, D_MODEL)),
        "c_sample": nrm((DEC_BATCH, D_MODEL)),
        "state_gdn": nrm((N_GDN, DEC_BATCH, GDN_HEADS, GDN_DK, GDN_DV), 0.1),
        "cache_conv": nrm((N_GDN, DEC_BATCH, CONV_WIDTH - 1, GDN_CONV_CH)),
        "cache_k": nrm((N_DIFF, DEC_BATCH, PAST_LEN, DIFF_HEADS, 2 * DIFF_QK_DIM)),
        "cache_v": nrm((N_DIFF, DEC_BATCH, PAST_LEN, DIFF_HEADS, DIFF_V_DIM)),
        "norm_pre": 1.0 + nrm((DEPTH, D_MODEL), 0.02),
        "norm_post": 1.0 + nrm((DEPTH, D_MODEL), 0.02),
        "w_ada": nrm((DEPTH, D_MODEL, 3 * D_MODEL), 0.5 * D_MODEL ** -0.5),
        "b_ada": nrm((DEPTH, 3 * D_MODEL), 0.02),
        "w_in_gdn": nrm((N_GDN, D_MODEL, GDN_IN), D_MODEL ** -0.5),
        "conv_gdn": nrm((N_GDN, CONV_WIDTH, GDN_CONV_CH), CONV_WIDTH ** -0.5),
        "a_log_gdn": jnp.log(unif((N_GDN, GDN_HEADS), 1.0, 16.0)),
        "dt_bias_gdn": dt + jnp.log(-jnp.expm1(-dt)),
        "onorm_gdn": 1.0 + nrm((N_GDN, GDN_DV), 0.02),
        "w_out_gdn": nrm((N_GDN, GDN_WIDTH, D_MODEL), GDN_WIDTH ** -0.5),
        "w_in_diff": nrm((N_DIFF, D_MODEL, DIFF_IN), D_MODEL ** -0.5),
        "lam_q1": nrm((N_DIFF, DIFF_QK_DIM), 0.1),
        "lam_k1": nrm((N_DIFF, DIFF_QK_DIM), 0.1),
        "lam_q2": nrm((N_DIFF, DIFF_QK_DIM), 0.1),
        "lam_k2": nrm((N_DIFF, DIFF_QK_DIM), 0.1),
        "subln_diff": 1.0 + nrm((N_DIFF, DIFF_V_DIM), 0.02),
        "w_out_diff": nrm((N_DIFF, DIFF_WIDTH, D_MODEL), DIFF_WIDTH ** -0.5),
    }


def reference(x_prompt, x_sample, c_prompt, c_sample, state_gdn, cache_conv, cache_k, cache_v,
              norm_pre, norm_post, w_ada, b_ada, w_in_gdn, conv_gdn, a_log_gdn, dt_bias_gdn,
              onorm_gdn, w_out_gdn, w_in_diff, lam_q1, lam_k1, lam_q2, lam_k2, subln_diff, w_out_diff):
    p = {"norm_pre": norm_pre, "norm_post": norm_post, "w_ada": w_ada, "b_ada": b_ada,
         "w_in_gdn": w_in_gdn, "conv_gdn": conv_gdn, "a_log_gdn": a_log_gdn,
         "dt_bias_gdn": dt_bias_gdn, "onorm_gdn": onorm_gdn, "w_out_gdn": w_out_gdn,
         "w_in_diff": w_in_diff, "lam_q1": lam_q1, "lam_k1": lam_k1, "lam_q2": lam_q2,
         "lam_k2": lam_k2, "subln_diff": subln_diff, "w_out_diff": w_out_diff}
    Bp, Tp, _ = x_prompt.shape
    Ts = x_sample.shape[1]
    zero_conv = jnp.zeros((N_GDN, Bp, CONV_WIDTH - 1, GDN_CONV_CH), x_prompt.dtype)
    zero_state = jnp.zeros((N_GDN, Bp, GDN_HEADS, GDN_DK, GDN_DV), x_prompt.dtype)
    y_prompt, st_p, conv_p, k_p, v_p = trunk(x_prompt, c_prompt, jnp.arange(Tp), zero_conv, zero_state,
                                             None, None, p)
    y_sample, st_s, conv_s, k_s, v_s = trunk(x_sample, c_sample, PAST_LEN + jnp.arange(Ts), cache_conv,
                                             state_gdn, cache_k, cache_v, p)
    return (y_prompt, y_sample, st_p, conv_p, k_p, v_p, st_s, conv_s, k_s, v_s)
```

```cpp
#include <hip/hip_runtime.h>
#include <hip/hip_cooperative_groups.h>
#include <cstdio>
namespace cg = cooperative_groups;

#define DI __device__ __forceinline__
#define LAS __attribute__((address_space(3)))
typedef unsigned short bf16_t;
typedef short bf16x8 __attribute__((ext_vector_type(8)));
typedef short s16x4 __attribute__((ext_vector_type(4)));
typedef float f32x2 __attribute__((ext_vector_type(2)));
typedef float f32x4 __attribute__((ext_vector_type(4)));
typedef float f32x16 __attribute__((ext_vector_type(16)));
typedef unsigned u32x2 __attribute__((ext_vector_type(2)));
typedef unsigned u32x4 __attribute__((ext_vector_type(4)));
typedef __bf16 bf16x2_t __attribute__((ext_vector_type(2)));

constexpr int D = 1024, TP = 8192, BP = 4, BS = 16, TS = 16, PAST = 2048;
constexpr int MP = BP * TP, MS = BS * TS, M = MP + MS, NB = BP + BS;
constexpr int NPROJ = 4096;
constexpr int KSROWS = 2112;
constexpr int NITEM_P = 4096, NITEM = 4224;
constexpr size_t ITEM_BYTES = 90112;
constexpr float RMS_EPS = 1e-6f;
constexpr float QSCALE = 0.125f * 1.4426950408889634f;

constexpr size_t OFF_Y = 0;
constexpr size_t OFF_STP = (size_t)M * D;
constexpr size_t OFF_CVP = OFF_STP + 2ull * 4 * 8 * 128 * 128;
constexpr size_t OFF_KP = OFF_CVP + 2ull * 4 * 3 * 3072;
constexpr size_t OFF_VP = OFF_KP + 2ull * MP * 1024;
constexpr size_t OFF_STS = OFF_VP + 2ull * MP * 1024;
constexpr size_t OFF_CVS = OFF_STS + 2ull * 16 * 8 * 128 * 128;
constexpr size_t OFF_KSO = OFF_CVS + 2ull * 16 * 3 * 3072;
constexpr size_t OFF_VSO = OFF_KSO + 2ull * MS * 1024;

constexpr size_t WS_WING = 0;
constexpr size_t WS_WOUTG = WS_WING + 2ull * 4096 * 1024 * 2;
constexpr size_t WS_WIND = WS_WOUTG + 2ull * 1024 * 1024 * 2;
constexpr size_t WS_WOUTD = WS_WIND + 2ull * 4096 * 1024 * 2;
constexpr size_t WS_ADA = WS_WOUTD + 2ull * 1024 * 1024 * 2;
constexpr size_t WS_ROPE = WS_ADA + 4ull * NB * 3072 * 4;
constexpr size_t WS_AB = WS_ROPE + 8208ull * 64 * 4;
constexpr size_t WS_GL = WS_AB + (size_t)M * 16 * 4;
constexpr size_t WS_HBUF = WS_GL + 32768;
constexpr size_t WS_ORAW = WS_HBUF + (size_t)M * 1024 * 2;
constexpr size_t WS_PROJ = WS_ORAW + 256;
constexpr size_t WS_R1 = WS_PROJ + (size_t)M * 4096 * 2;
constexpr size_t WS_KS = WS_R1;
constexpr size_t WS_VS = WS_KS + 16ull * KSROWS * 1024 * 2;
constexpr size_t WS_END = WS_R1 + (size_t)NITEM * ITEM_BYTES;

constexpr int LDS_BYTES = 131072;

struct Params { const float* in[25]; float* out; unsigned char* ws; };

DI float bf2f(bf16_t v) { return __uint_as_float(((unsigned)v) << 16); }
DI unsigned pk2(float a, float b) { f32x2 v = {a, b}; bf16x2_t r = __builtin_convertvector(v, bf16x2_t); return __builtin_bit_cast(unsigned, r); }
DI bf16_t f2bf(float a) { return (bf16_t)(pk2(a, 0.f) & 0xffffu); }
DI float wave_sum(float v) {
#pragma unroll
    for (int o = 32; o >= 1; o >>= 1) v += __shfl_xor(v, o);
    return v;
}
DI float siluf(float x) { return x / (1.f + __expf(-x)); }
DI int ppos(int idx) { const int d5 = idx & 31; return (idx & ~31) | (((d5 >> 2) & 3) << 3) | ((d5 >> 4) << 2) | (d5 & 3); }
DI int perm64(int ls) { return (ls & 15) | (((ls >> 4) & 1) << 5) | (((ls >> 5) & 1) << 4); }
DI void unpack8(const u32x4 v, float (&o)[8]) {
#pragma unroll
    for (int i = 0; i < 4; ++i) { o[2 * i] = __uint_as_float(v[i] << 16); o[2 * i + 1] = __uint_as_float(v[i] & 0xffff0000u); }
}
#define MFMA16(a, b, c) __builtin_amdgcn_mfma_f32_16x16x32_bf16((a), (b), (c), 0, 0, 0)
#define MFMA32(a, b, c) __builtin_amdgcn_mfma_f32_32x32x16_bf16((a), (b), (c), 0, 0, 0)

namespace pg8 {
constexpr int BM = 256, BK = 64, HALF = 128, HTB = HALF * BK * 2, STAGE_BYTES = 8 * HTB, NXCD = 8, WGM = 8;
DI int lds_byte(int r, int c) { const int st = (r >> 4) * 2 + (c >> 5), rr = r & 15, cc = c & 31, ob = rr * 64 + cc * 2; return st * 1024 + (ob ^ (((ob >> 9) & 1) << 5)); }
DI void stage_rc(int b, int& R, int& C) { const int st = b / 1024, sb = b % 1024, swz = sb ^ (((sb >> 9) & 1) << 5); R = (st >> 1) * 16 + swz / 64; C = (st & 1) * 32 + (swz % 64) / 2; }
struct Unit { int pm, pn; };
struct Gemm { const bf16_t* A; const bf16_t* Bt; int M, N, K; };
struct StaticOrder {
    int nM, nN, nwg, G, c;
    DI void init(int M_, int N_, int G_, int c_) { nM = M_ / BM; nN = N_ / BM; nwg = nM * nN; G = G_; c = c_; }
    DI bool next(int i, Unit& u) const {
        const long L = (long)i * G + c; if (L >= nwg) return false;
        int wgid = (int)L; { const int q = nwg / NXCD, r = nwg % NXCD, xcd = wgid % NXCD, off = wgid / NXCD; wgid = (xcd < r ? xcd * (q + 1) : r * (q + 1) + (xcd - r) * q) + off; }
        const int nig = WGM * nN, gid = wgid / nig, fm = gid * WGM, gsz = (nM - fm) < WGM ? (nM - fm) : WGM;
        u.pm = fm + ((wgid % nig) % gsz); u.pn = (wgid % nig) / gsz; return true;
    }
};

template <class Epi>
DI void gemm_phase(LAS unsigned char* lds, const Gemm g, const StaticOrder& S, const Epi& E) {
    int tid_ = threadIdx.x; asm volatile("" : "+v"(tid_)); const int tid = tid_, wid = __builtin_amdgcn_readfirstlane(tid >> 6), lane = tid & 63, wr = wid >> 2, wc = wid & 3, fr = lane & 15, fq = lane >> 4;
    const int K = g.K, nt = K / BK;
    unsigned voffA[2];
#pragma unroll
    for (int i = 0; i < 2; ++i) { int R, C; stage_rc(tid * 16 + i * 8192, R, C); voffA[i] = (unsigned)(R * K + C) * 2u; }
    const size_t kstep = (size_t)(BK * 2);
    const size_t hstep = (size_t)HALF * K * 2;
    const size_t tstep = 2 * hstep;
    const unsigned ldsw = (unsigned)wid * 1024u;
    const int aoff = lds_byte(wr * 64 + fr, fq * 8), boff = lds_byte(wc * 32 + fr, fq * 8);
#define PG8_SA(b, h) (((b) * 2 + (h)) * HTB)
#define PG8_SB(b, h) ((4 + (b) * 2 + (h)) * HTB)
#define PG8_STAGE(bufoff, gbase) do { _Pragma("unroll") for (int _i = 0; _i < 2; ++_i) \
        __builtin_amdgcn_global_load_lds((const unsigned*)((const char*)(gbase) + voffA[_i]), (LAS unsigned*)(lds + (bufoff) + ldsw + _i * 8192), 16, 0, 0); } while (0)
#define PG8_LDA(dst, b, h) do { _Pragma("unroll") for (int m = 0; m < 4; ++m) _Pragma("unroll") for (int k = 0; k < 2; ++k) dst[m][k] = *(const LAS bf16x8*)(lds + PG8_SA(b, h) + aoff + m * 2048 + k * 1024); } while (0)
#define PG8_LDB(dst, b, h) do { _Pragma("unroll") for (int n = 0; n < 2; ++n) _Pragma("unroll") for (int k = 0; k < 2; ++k) dst[n][k] = *(const LAS bf16x8*)(lds + PG8_SB(b, h) + boff + n * 2048 + k * 1024); } while (0)
#define PG8_MMA(ai, bj, At, Bt) do { __builtin_amdgcn_s_setprio(1); _Pragma("unroll") for (int m = 0; m < 4; ++m) _Pragma("unroll") for (int n = 0; n < 2; ++n) _Pragma("unroll") for (int k = 0; k < 2; ++k) \
        acc[ai][bj][m][n] = __builtin_amdgcn_mfma_f32_16x16x32_bf16(Bt[n][k], At[m][k], acc[ai][bj][m][n], 0, 0, 0); __builtin_amdgcn_s_setprio(0); } while (0)
#define PG8_WAIT_V(n) asm volatile("s_waitcnt vmcnt(" #n ")" ::: "memory")
#define PG8_WAIT_L(n) asm volatile("s_waitcnt lgkmcnt(" #n ")" ::: "memory")
#define PG8_BAR __builtin_amdgcn_s_barrier()
#define PG8_SCHED __builtin_amdgcn_sched_barrier(0)
    Unit cur, nxt; int ui = 0;
    if (!S.next(0, cur)) return;
    f32x4 acc[2][2][4][2];
#pragma unroll
    for (int a = 0; a < 2; ++a)
#pragma unroll
        for (int b = 0; b < 2; ++b)
#pragma unroll
            for (int m = 0; m < 4; ++m)
#pragma unroll
                for (int n = 0; n < 2; ++n) acc[a][b][m][n] = (f32x4){0.f, 0.f, 0.f, 0.f};
    bf16x8 At[4][2], B0[2][2], B1[2][2];
    const char* cA = (const char*)g.A + (size_t)cur.pm * tstep; const char* cB = (const char*)g.Bt + (size_t)cur.pn * tstep;
    PG8_STAGE(PG8_SB(0, 0), cB); PG8_STAGE(PG8_SA(0, 0), cA); PG8_STAGE(PG8_SB(0, 1), cB + hstep); PG8_STAGE(PG8_SA(0, 1), cA + hstep);
    if (wr == 1) PG8_BAR;
    PG8_WAIT_V(4); PG8_BAR;
    PG8_STAGE(PG8_SB(1, 0), cB + kstep); PG8_STAGE(PG8_SA(1, 0), cA + kstep); PG8_STAGE(PG8_SB(1, 1), cB + hstep + kstep);
    PG8_WAIT_V(6); PG8_BAR;
    for (;;) {
        const bool has_next = S.next(ui + 1, nxt);
        const char* nA = has_next ? (const char*)g.A + (size_t)nxt.pm * tstep : cA; const char* nB = has_next ? (const char*)g.Bt + (size_t)nxt.pn * tstep : cB;
        for (int t = 0; t < nt; t += 2) {
            const bool last = (t == nt - 2);
            const char* a1 = cA + (size_t)(t + 1) * kstep;
            const char* a2 = last ? nA : cA + (size_t)(t + 2) * kstep; const char* b2 = last ? nB : cB + (size_t)(t + 2) * kstep;
            const char* a3 = a2 + kstep; const char* b3 = b2 + kstep;
            PG8_LDB(B0, 0, 0); PG8_SCHED; PG8_LDA(At, 0, 0); PG8_STAGE(PG8_SA(1, 1), a1 + hstep);
            PG8_WAIT_L(8); PG8_BAR; PG8_WAIT_L(0); PG8_MMA(0, 0, At, B0); PG8_BAR; PG8_SCHED;
            PG8_LDB(B1, 0, 1); PG8_STAGE(PG8_SB(0, 0), b2);
            PG8_BAR; PG8_WAIT_L(0); PG8_MMA(0, 1, At, B1); PG8_BAR;
            PG8_LDA(At, 0, 1); PG8_STAGE(PG8_SA(0, 0), a2);
            PG8_BAR; PG8_WAIT_L(0); PG8_MMA(1, 0, At, B0); PG8_BAR; PG8_SCHED;
            PG8_STAGE(PG8_SB(0, 1), b2 + hstep);
            PG8_WAIT_V(6); PG8_BAR; PG8_MMA(1, 1, At, B1); PG8_BAR;
            PG8_LDB(B0, 1, 0); PG8_SCHED; PG8_LDA(At, 1, 0); PG8_STAGE(PG8_SA(0, 1), a2 + hstep);
            PG8_WAIT_L(8); PG8_BAR; PG8_WAIT_L(0); PG8_MMA(0, 0, At, B0); PG8_BAR; PG8_SCHED;
            PG8_LDB(B1, 1, 1); PG8_STAGE(PG8_SB(1, 0), b3);
            PG8_BAR; PG8_WAIT_L(0); PG8_MMA(0, 1, At, B1); PG8_BAR;
            PG8_LDA(At, 1, 1); PG8_STAGE(PG8_SA(1, 0), a3);
            PG8_BAR; PG8_WAIT_L(0); PG8_MMA(1, 0, At, B0); PG8_BAR; PG8_SCHED;
            PG8_STAGE(PG8_SB(1, 1), b3 + hstep);
            PG8_WAIT_V(6); PG8_BAR; PG8_MMA(1, 1, At, B1); PG8_BAR;
        }
        E(acc, cur, wr, wc, fr, fq);
        if (!has_next) break;
#pragma unroll
        for (int a = 0; a < 2; ++a)
#pragma unroll
            for (int b = 0; b < 2; ++b)
#pragma unroll
                for (int m = 0; m < 4; ++m)
#pragma unroll
                    for (int n = 0; n < 2; ++n) acc[a][b][m][n] = (f32x4){0.f, 0.f, 0.f, 0.f};
        cur = nxt; cA = nA; cB = nB; ++ui;
    }
    PG8_WAIT_V(0);
    if (wr == 0) PG8_BAR;
    PG8_BAR;
#undef PG8_SA
#undef PG8_SB
#undef PG8_STAGE
#undef PG8_LDA
#undef PG8_LDB
#undef PG8_MMA
#undef PG8_WAIT_V
#undef PG8_WAIT_L
#undef PG8_BAR
#undef PG8_SCHED
}
}

struct EpiGdnIn {
    bf16_t* proj; float* conv_p; float* conv_s;
    DI void operator()(const f32x4 (&acc)[2][2][4][2], const pg8::Unit& u, int wr, int wc, int fr, int fq) const {
        const int row0 = u.pm * 256 + wr * 64 + fr, col0 = u.pn * 256 + wc * 32 + 4 * fq;
#pragma unroll
        for (int ai = 0; ai < 2; ++ai)
#pragma unroll
            for (int m = 0; m < 4; ++m) {
                const int r = row0 + ai * 128 + m * 16;
                bf16_t* rowp = proj + (size_t)r * NPROJ + col0;
                bool tail; float* cp;
                if (r < MP) { const int t = r & (TP - 1), b = r >> 13; tail = t >= TP - 3; cp = conv_p + (size_t)(b * 3 + (t - (TP - 3))) * 3072; }
                else { const int rs = r - MP, t = rs & 15, b = rs >> 4; tail = t >= TS - 3; cp = conv_s + (size_t)(b * 3 + (t - (TS - 3))) * 3072; }
#pragma unroll
                for (int bj = 0; bj < 2; ++bj)
#pragma unroll
                    for (int n = 0; n < 2; ++n) {
                        const f32x4 v = acc[ai][bj][m][n];
                        u32x2 w; w.x = pk2(v[0], v[1]); w.y = pk2(v[2], v[3]);
                        *(u32x2*)(rowp + bj * 128 + n * 16) = w;
                        const int c = col0 + bj * 128 + n * 16;
                        if (tail && c < 3072) *(f32x4*)(cp + c) = v;
                    }
            }
    }
};

struct EpiDiffIn {
    bf16_t* proj; float* k_p; float* v_p; float* k_s; float* v_s; bf16_t* ks; bf16_t* vs; const float* rope;
    DI void operator()(const f32x4 (&acc)[2][2][4][2], const pg8::Unit& u, int wr, int wc, int fr, int fq) const {
        const int part = u.pn >> 2;
        const int row0 = u.pm * 256 + wr * 64 + fr;
        const int d0 = 16 * (wc & 1) + 4 * fq;
        const int cbase = u.pn * 256 + 64 * (wc >> 1) + d0;
#pragma unroll
        for (int ai = 0; ai < 2; ++ai)
#pragma unroll
            for (int m = 0; m < 4; ++m) {
                const int r = row0 + ai * 128 + m * 16;
                const int rs = r - MP;
                const int pidx = (r < MP) ? (r & (TP - 1)) : (TP + (rs & 15));
                f32x4 cs = {1.f, 1.f, 1.f, 1.f}, sn = {0.f, 0.f, 0.f, 0.f};
                if (part < 2) { cs = *(const f32x4*)(rope + (size_t)pidx * 64 + d0); sn = *(const f32x4*)(rope + (size_t)pidx * 64 + 32 + d0); }
#pragma unroll
                for (int bj = 0; bj < 2; ++bj) {
                    const f32x4 x1 = acc[ai][bj][m][0], x2 = acc[ai][bj][m][1];
                    f32x4 y1 = x1 * cs - x2 * sn, y2 = x2 * cs + x1 * sn;
                    const int col = cbase + bj * 128;
                    bf16_t* pp = proj + (size_t)r * NPROJ + col;
                    if (part == 0) { y1 *= QSCALE; y2 *= QSCALE; }
                    u32x2 w1, w2; w1.x = pk2(y1[0], y1[1]); w1.y = pk2(y1[2], y1[3]); w2.x = pk2(y2[0], y2[1]); w2.y = pk2(y2[2], y2[3]);
                    *(u32x2*)pp = w1; *(u32x2*)(pp + 32) = w2;
                    if (part == 1 || part == 2) {
                        const int cc = col - part * 1024;
                        float* op; bf16_t* sp = nullptr;
                        if (r < MP) op = (part == 1 ? k_p : v_p) + (size_t)r * 1024 + cc;
                        else { op = (part == 1 ? k_s : v_s) + (size_t)rs * 1024 + cc;
                               sp = (part == 1 ? ks : vs) + ((size_t)(rs >> 4) * KSROWS + PAST + (rs & 15)) * 1024 + cc; }
                        *(f32x4*)op = y1; *(f32x4*)(op + 32) = y2;
                        if (sp) { *(u32x2*)sp = w1; *(u32x2*)(sp + 32) = w2; }
                    }
                }
            }
    }
};

struct EpiOut {
    float* C;
    DI void operator()(const f32x4 (&acc)[2][2][4][2], const pg8::Unit& u, int wr, int wc, int fr, int fq) const {
        const int row0 = u.pm * 256 + wr * 64 + fr, col0 = u.pn * 256 + wc * 32 + 4 * fq;
#pragma unroll
        for (int ai = 0; ai < 2; ++ai)
#pragma unroll
            for (int m = 0; m < 4; ++m) {
                float* rowp = C + (size_t)(row0 + ai * 128 + m * 16) * 1024 + col0;
#pragma unroll
                for (int bj = 0; bj < 2; ++bj)
#pragma unroll
                    for (int n = 0; n < 2; ++n) *(f32x4*)(rowp + bj * 128 + n * 16) = acc[ai][bj][m][n];
            }
    }
};

DI void transpose_tile(const float* W, int ldw, int n0, int k0, bf16_t* WT, bool perm, LAS float* tile) {
    int tid_ = threadIdx.x; asm volatile("" : "+v"(tid_)); const int tid = tid_;
    {
        const int kk = tid >> 4, c4 = (tid & 15) * 4;
#pragma unroll
        for (int p = 0; p < 2; ++p) {
            const f32x4 v = *(const f32x4*)(W + (size_t)(k0 + kk + 32 * p) * ldw + n0 + c4);
            LAS float* t = tile + (kk + 32 * p) * 65 + c4;
            t[0] = v[0]; t[1] = v[1]; t[2] = v[2]; t[3] = v[3];
        }
    }
    __syncthreads();
    {
        const int n = tid >> 3, ks = (tid & 7) * 8;
        const int src = perm ? perm64(n) : n;
        float v[8];
#pragma unroll
        for (int e = 0; e < 8; ++e) v[e] = tile[(ks + e) * 65 + src];
        u32x4 w; w.x = pk2(v[0], v[1]); w.y = pk2(v[2], v[3]); w.z = pk2(v[4], v[5]); w.w = pk2(v[6], v[7]);
        *(u32x4*)(WT + (size_t)(n0 + n) * 1024 + k0 + ks) = w;
    }
    __syncthreads();
}

DI void phase_prep(const Params& P, LAS unsigned char* lds) {
    int tid_ = threadIdx.x; asm volatile("" : "+v"(tid_)); const int tid = tid_, G = gridDim.x;
    unsigned char* ws = P.ws;
    for (int id = blockIdx.x; id < 5120; id += G) {
        const int j = id / 2560; int rem = id % 2560;
        const float* W; int ldw; bf16_t* WT; bool perm = false; int t;
        if (rem < 1024) { W = P.in[12] + (size_t)j * 1024 * 4112; ldw = 4112; WT = (bf16_t*)(ws + WS_WING) + (size_t)j * 4096 * 1024; t = rem; }
        else if (rem < 1280) { W = P.in[17] + (size_t)j * 1024 * 1024; ldw = 1024; WT = (bf16_t*)(ws + WS_WOUTG) + (size_t)j * 1024 * 1024; t = rem - 1024; }
        else if (rem < 2304) { W = P.in[18] + (size_t)j * 1024 * 4096; ldw = 4096; WT = (bf16_t*)(ws + WS_WIND) + (size_t)j * 4096 * 1024; t = rem - 1280; perm = true; }
        else { W = P.in[24] + (size_t)j * 1024 * 1024; ldw = 1024; WT = (bf16_t*)(ws + WS_WOUTD) + (size_t)j * 1024 * 1024; t = rem - 2304; }
        transpose_tile(W, ldw, (t >> 4) * 64, (t & 15) * 64, WT, perm, (LAS float*)lds);
    }
    for (int idx = blockIdx.x * 512 + tid; idx < 8208 * 32; idx += G * 512) {
        const int pi = idx >> 5, d = idx & 31;
        const int pos = pi < TP ? pi : PAST + (pi - TP);
        const float inv = 1.0f / powf(10000.0f, (float)d / 32.0f);
        const float ang = (float)pos * inv;
        const double rev = (double)ang * 0.15915494309189535;
        const double fr = rev - floor(rev);
        float* rp = (float*)(ws + WS_ROPE) + (size_t)pi * 64;
        rp[d] = __builtin_amdgcn_cosf((float)fr);
        rp[32 + d] = __builtin_amdgcn_sinf((float)fr);
    }
    {
        LAS float* cact = (LAS float*)lds;
        LAS float* red = (LAS float*)(lds + 81920);
        bool loaded = false;
        for (int id = (G - 1 - blockIdx.x); id < 192; id += G) {
            if (!loaded) {
                for (int e = tid; e < NB * 1024; e += 512) {
                    const int b = e >> 10, k = e & 1023;
                    const float c = b < BP ? P.in[2][b * 1024 + k] : P.in[3][(b - BP) * 1024 + k];
                    cact[e] = siluf(c);
                }
                loaded = true;
            }
            __syncthreads();
            const int i = id / 48, cb = id % 48;
            const int col = tid & 63, kg = tid >> 6;
            const float* Wp = P.in[10] + (size_t)i * 1024 * 3072 + cb * 64 + col;
            float acc[NB];
#pragma unroll
            for (int b = 0; b < NB; ++b) acc[b] = 0.f;
            for (int k = kg * 128; k < kg * 128 + 128; k += 4) {
                const float w0 = Wp[(size_t)k * 3072], w1 = Wp[(size_t)(k + 1) * 3072], w2 = Wp[(size_t)(k + 2) * 3072], w3 = Wp[(size_t)(k + 3) * 3072];
#pragma unroll
                for (int b = 0; b < NB; ++b) {
                    const f32x4 c4 = *(const LAS f32x4*)(cact + b * 1024 + k);
                    acc[b] += c4[0] * w0 + c4[1] * w1 + c4[2] * w2 + c4[3] * w3;
                }
            }
#pragma unroll
            for (int b = 0; b < NB; ++b) red[(kg * NB + b) * 64 + col] = acc[b];
            __syncthreads();
            for (int o = tid; o < NB * 64; o += 512) {
                const int b = o >> 6, c = o & 63;
                float s = P.in[11][i * 3072 + cb * 64 + c];
#pragma unroll
                for (int g = 0; g < 8; ++g) s += red[(g * NB + b) * 64 + c];
                ((float*)(ws + WS_ADA))[((size_t)i * NB + b) * 3072 + cb * 64 + c] = s;
            }
        }
        __syncthreads();
    }
}

DI void phase_elem(const Params& P, LAS unsigned char* lds, int layer) {
    int tid_ = threadIdx.x; asm volatile("" : "+v"(tid_)); const int tid = tid_, wid = __builtin_amdgcn_readfirstlane(tid >> 6), lane = tid & 63, G = gridDim.x;
    unsigned char* ws = P.ws;
    const int j = layer >> 1;
    const bool gdn = (layer < 4) && !(layer & 1);
    LAS float* wab = (LAS float*)lds;
    if (gdn) {
        const float* Wp = P.in[12] + (size_t)j * 1024 * 4112 + 4096;
        for (int e = tid; e < 16384; e += 512) { const int k = e >> 4, c = e & 15; wab[c * 1024 + k] = Wp[(size_t)k * 4112 + c]; }
        __syncthreads();
    }
    const float* ada = (const float*)(ws + WS_ADA);
    float* X = P.out;
    const float* OUTB = (const float*)(ws + WS_PROJ);
    bf16_t* HB = (bf16_t*)(ws + WS_HBUF);
    float* AB = (float*)(ws + WS_AB);
    for (int r = blockIdx.x * 8 + wid; r < M; r += G * 8) {
        const int b = r < MP ? (r >> 13) : BP + ((r - MP) >> 4);
        const float* xs = (layer <= 1) ? (r < MP ? P.in[0] + (size_t)r * 1024 : P.in[1] + (size_t)(r - MP) * 1024) : X + (size_t)r * 1024;
        f32x4 x[4];
#pragma unroll
        for (int q = 0; q < 4; ++q) x[q] = *(const f32x4*)(xs + 4 * (lane + 64 * q));
        if (layer >= 1) {
            f32x4 o[4]; float ss = 0.f;
#pragma unroll
            for (int q = 0; q < 4; ++q) { o[q] = *(const f32x4*)(OUTB + (size_t)r * 1024 + 4 * (lane + 64 * q)); ss += o[q][0] * o[q][0] + o[q][1] * o[q][1] + o[q][2] * o[q][2] + o[q][3] * o[q][3]; }
            ss = wave_sum(ss);
            const float rstd = rsqrtf(ss * (1.f / 1024.f) + RMS_EPS);
            const float* gp = ada + ((size_t)(layer - 1) * NB + b) * 3072 + 2048;
            const float* np = P.in[9] + (layer - 1) * 1024;
#pragma unroll
            for (int q = 0; q < 4; ++q) {
                const int d = 4 * (lane + 64 * q);
                const f32x4 gt = *(const f32x4*)(gp + d), nw = *(const f32x4*)(np + d);
                x[q] = x[q] + gt * (o[q] * rstd * nw);
                *(f32x4*)(X + (size_t)r * 1024 + d) = x[q];
            }
        }
        if (layer < 4) {
            float ss = 0.f;
#pragma unroll
            for (int q = 0; q < 4; ++q) ss += x[q][0] * x[q][0] + x[q][1] * x[q][1] + x[q][2] * x[q][2] + x[q][3] * x[q][3];
            ss = wave_sum(ss);
            const float rstd = rsqrtf(ss * (1.f / 1024.f) + RMS_EPS);
            const float* ap = ada + ((size_t)layer * NB + b) * 3072;
            const float* np = P.in[8] + layer * 1024;
            f32x4 hv[4];
#pragma unroll
            for (int q = 0; q < 4; ++q) {
                const int d = 4 * (lane + 64 * q);
                const f32x4 sh = *(const f32x4*)(ap + d), sc = *(const f32x4*)(ap + 1024 + d), nw = *(const f32x4*)(np + d);
                hv[q] = (x[q] * rstd * nw) * (1.f + sc) + sh;
                u32x2 w; w.x = pk2(hv[q][0], hv[q][1]); w.y = pk2(hv[q][2], hv[q][3]);
                *(u32x2*)(HB + (size_t)r * 1024 + d) = w;
            }
            if (gdn) {
                float mine = 0.f;
#pragma unroll
                for (int c = 0; c < 16; ++c) {
                    float a = 0.f;
#pragma unroll
                    for (int q = 0; q < 4; ++q) { const f32x4 w4 = *(const LAS f32x4*)(wab + c * 1024 + 4 * (lane + 64 * q)); a += hv[q][0] * w4[0] + hv[q][1] * w4[1] + hv[q][2] * w4[2] + hv[q][3] * w4[3]; }
                    a = wave_sum(a);
                    if (lane == c) mine = a;
                }
                if (lane < 16) AB[(size_t)r * 16 + lane] = mine;
            }
        }
    }
    if (layer < 4 && (layer & 1)) {
        const float* ck = P.in[6] + (size_t)j * 16 * PAST * 1024;
        const float* cv = P.in[7] + (size_t)j * 16 * PAST * 1024;
        bf16_t* KS = (bf16_t*)(ws + WS_KS); bf16_t* VS = (bf16_t*)(ws + WS_VS);
        const size_t nun = (size_t)16 * PAST * 128;
        for (size_t u = (size_t)blockIdx.x * 512 + tid; u < 2 * nun; u += (size_t)G * 512) {
            const bool isv = u >= nun; const size_t uu = isv ? u - nun : u;
            const size_t b = uu / ((size_t)PAST * 128), rem = uu % ((size_t)PAST * 128);
            const float* sp = (isv ? cv : ck) + uu * 8;
            const f32x4 a = *(const f32x4*)sp, c = *(const f32x4*)(sp + 4);
            u32x4 w; w.x = pk2(a[0], a[1]); w.y = pk2(a[2], a[3]); w.z = pk2(c[0], c[1]); w.w = pk2(c[2], c[3]);
            *(u32x4*)((isv ? VS : KS) + b * KSROWS * 1024 + rem * 8) = w;
        }
        const size_t npad = (size_t)16 * 48 * 128;
        for (size_t u = (size_t)blockIdx.x * 512 + tid; u < 2 * npad; u += (size_t)G * 512) {
            const bool isv = u >= npad; const size_t uu = isv ? u - npad : u;
            const size_t b = uu / (48 * 128), rem = uu % (48 * 128);
            *(u32x4*)((isv ? VS : KS) + (b * KSROWS + PAST + TS) * 1024 + rem * 8) = (u32x4){0u, 0u, 0u, 0u};
        }
    }
}

DI void phase_g1(const Params& P, LAS unsigned char* lds, int layer) {
    int tid_ = threadIdx.x; asm volatile("" : "+v"(tid_)); const int tid = tid_, wid = __builtin_amdgcn_readfirstlane(tid >> 6), lane = tid & 63, G = gridDim.x;
    const int fr = lane & 15, fq = lane >> 4;
    unsigned char* ws = P.ws;
    const int j = layer >> 1;
    const bf16_t* proj = (const bf16_t*)(ws + WS_PROJ);
    const float* AB = (const float*)(ws + WS_AB);
    float* GL = (float*)(ws + WS_GL);
    const float* convw = P.in[13] + (size_t)j * 4 * 3072;
    const float* cconv = P.in[5] + (size_t)j * 16 * 3 * 3072;
    LAS unsigned char* Qs = lds;
    LAS unsigned char* Ks = lds + 17408;
    LAS unsigned char* VBt = lds + 34816;
    LAS unsigned char* KBt = lds + 53248;
    LAS float* A32 = (LAS float*)(lds + 71680);
    LAS unsigned char* Ts = lds + 88320;
    LAS unsigned char* QKs = lds + 97536;
    LAS float* Gs = (LAS float*)(lds + 105728);

    for (int item = blockIdx.x; item < NITEM; item += G) {
        int b, h, c, row0, nvalid; bool sample;
        if (item < NITEM_P) { const int seq = item >> 7; b = seq >> 3; h = seq & 7; c = item & 127; row0 = b * TP + 64 * c; nvalid = 64; sample = false; }
        else { const int s = item - NITEM_P; b = s >> 3; h = s & 7; c = 0; row0 = MP + b * TS; nvalid = TS; sample = true; }
        unsigned char* ib = ws + WS_R1 + (size_t)item * ITEM_BYTES;
        float val[8][8];
        float rn[8];
        int tido = tid; asm volatile("" : "+v"(tido));
        const int l16 = tido & 15, grp = tido >> 4, part = grp >> 3, rb = grp & 7;
        const int lane = tido & 63, fr = lane & 15, fq = lane >> 4;
        if (tid < 384) {
            const int ch = part * 1024 + h * 128 + 8 * l16;
            float wv[4][8];
#pragma unroll
            for (int t = 0; t < 4; ++t) {
                const f32x4 a = *(const f32x4*)(convw + t * 3072 + ch), bb = *(const f32x4*)(convw + t * 3072 + ch + 4);
                wv[t][0] = a[0]; wv[t][1] = a[1]; wv[t][2] = a[2]; wv[t][3] = a[3]; wv[t][4] = bb[0]; wv[t][5] = bb[1]; wv[t][6] = bb[2]; wv[t][7] = bb[3];
            }
            float win[4][8];
#pragma unroll
            for (int t = 0; t < 4; ++t)
#pragma unroll
                for (int e = 0; e < 8; ++e) win[t][e] = 0.f;
#pragma unroll
            for (int k = 0; k < 11; ++k) {
                const int lr = 8 * rb - 3 + k;
                float in8[8];
#pragma unroll
                for (int e = 0; e < 8; ++e) in8[e] = 0.f;
                if (lr < nvalid) {
                    if (lr >= 0 || (!sample && c > 0)) {
                        const u32x4 v = *(const u32x4*)(proj + (size_t)(row0 + lr) * NPROJ + ch);
                        unpack8(v, in8);
                    } else if (sample) {
                        const float* sp = cconv + (size_t)(b * 3 + (3 + lr)) * 3072 + ch;
                        const f32x4 a = *(const f32x4*)sp, bb = *(const f32x4*)(sp + 4);
                        in8[0] = a[0]; in8[1] = a[1]; in8[2] = a[2]; in8[3] = a[3]; in8[4] = bb[0]; in8[5] = bb[1]; in8[6] = bb[2]; in8[7] = bb[3];
                    }
                }
#pragma unroll
                for (int e = 0; e < 8; ++e) { win[0][e] = win[1][e]; win[1][e] = win[2][e]; win[2][e] = win[3][e]; win[3][e] = in8[e]; }
                if (k >= 3) {
                    const bool rv = (lr < nvalid);
                    float ss = 0.f;
#pragma unroll
                    for (int e = 0; e < 8; ++e) {
                        const float y = win[0][e] * wv[0][e] + win[1][e] * wv[1][e] + win[2][e] * wv[2][e] + win[3][e] * wv[3][e];
                        const float s = rv ? siluf(y) : 0.f;
                        val[k - 3][e] = s; ss += s * s;
                    }
                    ss += __shfl_xor(ss, 1); ss += __shfl_xor(ss, 2); ss += __shfl_xor(ss, 4); ss += __shfl_xor(ss, 8);
                    rn[k - 3] = rsqrtf(ss + 1e-6f);
                }
            }
        } else if (wid == 7) {
            const int r = row0 + (lane < nvalid ? lane : 0);
            const bool valid = lane < nvalid;
            const float a = AB[(size_t)r * 16 + h], bb = AB[(size_t)r * 16 + 8 + h];
            const float xa = a + P.in[15][j * 8 + h];
            const float sp = xa > 20.f ? xa : log1pf(__expf(xa));
            float g = valid ? -__expf(P.in[14][j * 8 + h]) * sp : 0.f;
            const float beta = valid ? 1.f / (1.f + __expf(-bb)) : 0.f;
#pragma unroll
            for (int o = 1; o < 64; o <<= 1) { const float t = __shfl_up(g, o); if (lane >= o) g += t; }
            const float glast = __shfl(g, 63);
            Gs[lane] = g; Gs[64 + lane] = beta; Gs[128 + lane] = __expf(g); Gs[192 + lane] = __expf(glast - g);
            if (lane == 0) GL[item] = __expf(glast);
        }
        __syncthreads();
        if (tid < 384) {
#pragma unroll
            for (int rr = 0; rr < 8; ++rr) {
                const int row = 8 * rb + rr;
                const float beta = Gs[64 + row], eG = Gs[128 + row];
                if (part == 0) {
                    const float sc = rn[rr] * 0.08838834764831845f;
                    float q[8];
#pragma unroll
                    for (int e = 0; e < 8; ++e) q[e] = val[rr][e] * sc;
                    u32x4 w; w.x = pk2(q[0], q[1]); w.y = pk2(q[2], q[3]); w.z = pk2(q[4], q[5]); w.w = pk2(q[6], q[7]);
                    *(LAS u32x4*)(Qs + row * 272 + l16 * 16) = w;
                    bf16_t* qg = (bf16_t*)(ib + 49152) + row * 128;
                    u32x2 g0, g1; g0.x = pk2(q[0] * eG, q[1] * eG); g0.y = pk2(q[2] * eG, q[3] * eG); g1.x = pk2(q[4] * eG, q[5] * eG); g1.y = pk2(q[6] * eG, q[7] * eG);
                    *(u32x2*)(qg + ppos(8 * l16)) = g0; *(u32x2*)(qg + ppos(8 * l16 + 4)) = g1;
                    val[rr][0] = 0.f;
                } else if (part == 1) {
#pragma unroll
                    for (int e = 0; e < 8; ++e) val[rr][e] *= rn[rr];
                    u32x4 w; w.x = pk2(val[rr][0], val[rr][1]); w.y = pk2(val[rr][2], val[rr][3]); w.z = pk2(val[rr][4], val[rr][5]); w.w = pk2(val[rr][6], val[rr][7]);
                    *(LAS u32x4*)(Ks + row * 272 + l16 * 16) = w;
                }
            }
            if (part >= 1) {
                float bsc[8], ksc[8];
#pragma unroll
                for (int rr = 0; rr < 8; ++rr) { const int row = 8 * rb + rr; const float beta = Gs[64 + row]; bsc[rr] = (part == 1) ? beta * Gs[128 + row] : beta; ksc[rr] = Gs[192 + row]; }
                LAS unsigned char* Tt = (part == 1) ? KBt : VBt;
#pragma unroll
                for (int e = 0; e < 8; ++e) {
                    const int dch = 8 * l16 + e;
                    u32x4 w; w.x = pk2(val[0][e] * bsc[0], val[1][e] * bsc[1]); w.y = pk2(val[2][e] * bsc[2], val[3][e] * bsc[3]);
                    w.z = pk2(val[4][e] * bsc[4], val[5][e] * bsc[5]); w.w = pk2(val[6][e] * bsc[6], val[7][e] * bsc[7]);
                    *(LAS u32x4*)(Tt + dch * 144 + rb * 16) = w;
                    if (part == 1) {
                        bf16_t* kd = (bf16_t*)(ib + 65536) + dch * 64;
                        u32x2 k0, k1; k0.x = pk2(val[0][e] * ksc[0], val[1][e] * ksc[1]); k0.y = pk2(val[2][e] * ksc[2], val[3][e] * ksc[3]);
                        k1.x = pk2(val[4][e] * ksc[4], val[5][e] * ksc[5]); k1.y = pk2(val[6][e] * ksc[6], val[7][e] * ksc[7]);
                        *(u32x2*)(kd + ppos(8 * rb)) = k0; *(u32x2*)(kd + ppos(8 * rb + 4)) = k1;
                    }
                }
            }
        }
        __syncthreads();
        {
            const int mt = wid & 3; const bool isqk = wid >= 4;
            LAS unsigned char* As = isqk ? Qs : Ks;
            f32x4 acc[4];
#pragma unroll
            for (int nt = 0; nt < 4; ++nt) acc[nt] = (f32x4){0.f, 0.f, 0.f, 0.f};
#pragma unroll
            for (int ks = 0; ks < 4; ++ks) {
                const bf16x8 a = *(const LAS bf16x8*)(As + (16 * mt + fr) * 272 + (32 * ks + 8 * fq) * 2);
#pragma unroll
                for (int nt = 0; nt < 4; ++nt) {
                    const bf16x8 bfr = *(const LAS bf16x8*)(Ks + (16 * nt + fr) * 272 + (32 * ks + 8 * fq) * 2);
                    acc[nt] = MFMA16(a, bfr, acc[nt]);
                }
            }
#pragma unroll
            for (int nt = 0; nt < 4; ++nt) {
                const int cp = 16 * nt + fr; const float Gc2 = Gs[cp];
#pragma unroll
                for (int i = 0; i < 4; ++i) {
                    const int cr = 16 * mt + 4 * fq + i;
                    const float dec = __expf(Gs[cr] - Gc2);
                    if (!isqk) A32[cr * 65 + cp] = (cr > cp) ? Gs[64 + cr] * acc[nt][i] * dec : 0.f;
                    else *(LAS bf16_t*)(QKs + (cr * 64 + ppos(cp)) * 2) = f2bf((cr >= cp) ? acc[nt][i] * dec : 0.f);
                }
            }
        }
        __syncthreads();
        {
            float a[64];
#pragma unroll
            for (int jj = 0; jj < 64; ++jj) a[jj] = A32[lane * 65 + jj];
            float x[8];
#pragma unroll
            for (int cc = 0; cc < 8; ++cc) x[cc] = (lane == 8 * wid + cc) ? 1.f : 0.f;
#pragma unroll
            for (int jj = 0; jj < 64; ++jj) {
                if (jj >= 8 * wid) {
#pragma unroll
                    for (int cc = 0; cc < 8; ++cc) { const float xj = __shfl(x[cc], jj); x[cc] -= a[jj] * xj; }
                }
            }
            u32x4 w; w.x = pk2(x[0], x[1]); w.y = pk2(x[2], x[3]); w.z = pk2(x[4], x[5]); w.w = pk2(x[6], x[7]);
            *(LAS u32x4*)(Ts + lane * 144 + wid * 16) = w;
            *(u32x4*)(ib + 81920 + tid * 16) = *(const LAS u32x4*)(QKs + tid * 16);
        }
        __syncthreads();
        {
            const bool isw = wid >= 4; const int n0 = 32 * (wid & 3);
            LAS unsigned char* Bs = isw ? KBt : VBt;
            f32x4 acc[4][2];
#pragma unroll
            for (int mt = 0; mt < 4; ++mt) { acc[mt][0] = (f32x4){0.f, 0.f, 0.f, 0.f}; acc[mt][1] = (f32x4){0.f, 0.f, 0.f, 0.f}; }
#pragma unroll
            for (int ks = 0; ks < 2; ++ks) {
                bf16x8 bfr[2];
#pragma unroll
                for (int nn = 0; nn < 2; ++nn) bfr[nn] = *(const LAS bf16x8*)(Bs + (n0 + 16 * nn + fr) * 144 + (32 * ks + 8 * fq) * 2);
#pragma unroll
                for (int mt = 0; mt < 4; ++mt) {
                    const bf16x8 a = *(const LAS bf16x8*)(Ts + (16 * mt + fr) * 144 + (32 * ks + 8 * fq) * 2);
                    acc[mt][0] = MFMA16(a, bfr[0], acc[mt][0]); acc[mt][1] = MFMA16(a, bfr[1], acc[mt][1]);
                }
            }
            if (!isw) {
                float* U = (float*)ib;
#pragma unroll
                for (int mt = 0; mt < 4; ++mt)
#pragma unroll
                    for (int nn = 0; nn < 2; ++nn)
#pragma unroll
                        for (int i = 0; i < 4; ++i) U[(16 * mt + 4 * fq + i) * 128 + n0 + 16 * nn + fr] = acc[mt][nn][i];
            } else {
#pragma unroll
                for (int mt = 0; mt < 4; ++mt)
#pragma unroll
                    for (int nn = 0; nn < 2; ++nn)
#pragma unroll
                        for (int i = 0; i < 4; ++i) *(LAS bf16_t*)(Qs + ((16 * mt + 4 * fq + i) * 128 + ppos(n0 + 16 * nn + fr)) * 2) = f2bf(acc[mt][nn][i]);
            }
        }
        __syncthreads();
        {
            *(u32x4*)(ib + 32768 + tid * 16) = *(const LAS u32x4*)(Qs + tid * 16);
            *(u32x4*)(ib + 32768 + 8192 + tid * 16) = *(const LAS u32x4*)(Qs + 8192 + tid * 16);
        }
        __syncthreads();
    }
}

DI void phase_scan(const Params& P, LAS unsigned char* lds, int layer) {
    int tid_ = threadIdx.x; asm volatile("" : "+v"(tid_)); const int tid = tid_, wid = __builtin_amdgcn_readfirstlane(tid >> 6), lane = tid & 63, G = gridDim.x;
    const int fr = lane & 15, fq = lane >> 4;
    unsigned char* ws = P.ws;
    const int j = layer >> 1;
    const bf16_t* proj = (const bf16_t*)(ws + WS_PROJ);
    const float* GL = (const float*)(ws + WS_GL);
    bf16_t* OB = (bf16_t*)(ws + WS_HBUF);
    constexpr int BUFB = 57344;
    LAS float* red = (LAS float*)(lds + 2 * BUFB);

    for (int seq = blockIdx.x; seq < 160; seq += G) {
        int b, h, nch, item0, row0, nvalid; float* stout;
        f32x4 st[8];
        const int dvc = 16 * wid + fr;
        if (seq < 32) {
            b = seq >> 3; h = seq & 7; nch = 128; item0 = seq * 128; row0 = b * TP; nvalid = 64;
            stout = P.out + OFF_STP + ((size_t)(j * 4 + b) * 8 + h) * 16384;
#pragma unroll
            for (int mt = 0; mt < 8; ++mt) st[mt] = (f32x4){0.f, 0.f, 0.f, 0.f};
        } else {
            const int s = seq - 32; b = s >> 3; h = s & 7; nch = 1; item0 = NITEM_P + s; row0 = MP + b * TS; nvalid = TS;
            stout = P.out + OFF_STS + ((size_t)(j * 16 + b) * 8 + h) * 16384;
            const float* s0 = P.in[4] + ((size_t)(j * 16 + b) * 8 + h) * 16384;
#pragma unroll
            for (int mt = 0; mt < 8; ++mt)
#pragma unroll
                for (int i = 0; i < 4; ++i) st[mt][i] = s0[(16 * mt + 4 * fq + i) * 128 + dvc];
        }
        const float onw = P.in[16][j * 128 + dvc];
        f32x4 un[4];
#define SCAN_G2L(itm, bufi) do { const unsigned char* _ib = ws + WS_R1 + (size_t)(itm) * ITEM_BYTES + 32768; \
            _Pragma("unroll") for (int _p = 0; _p < 7; ++_p) { const int _L = (wid + 8 * _p) * 1024 + lane * 16; int _src; \
                if (_p < 4) { const int _row = _L >> 8, _ch = (_L >> 4) & 15; _src = (_L & ~255) + ((_ch ^ (_row & 15)) << 4); } \
                else { const int _a = _L - 32768, _row = _a >> 7, _ch = (_a >> 4) & 7; _src = 32768 + (_a & ~127) + ((_ch ^ ((_row >> 1) & 7)) << 4); } \
                __builtin_amdgcn_global_load_lds((const unsigned*)(_ib + _src), (LAS unsigned*)(lds + (bufi) * BUFB + (wid + 8 * _p) * 1024), 16, 0, 0); } } while (0)
#define SCAN_LOADU(itm) do { const float* _u = (const float*)(ws + WS_R1 + (size_t)(itm) * ITEM_BYTES); \
            _Pragma("unroll") for (int _m = 0; _m < 4; ++_m) _Pragma("unroll") for (int _i = 0; _i < 4; ++_i) un[_m][_i] = _u[(16 * _m + 4 * fq + _i) * 128 + dvc]; } while (0)
        __syncthreads();
        SCAN_G2L(item0, 0);
        SCAN_LOADU(item0);
        __syncthreads();
        for (int c = 0; c < nch; ++c) {
            int frq = lane; asm volatile("" : "+v"(frq));
            const int fr = frq & 15, fq = frq >> 4;
            LAS unsigned char* bb = lds + (c & 1) * BUFB;
            if (c + 1 < nch) SCAN_G2L(item0 + c + 1, (c + 1) & 1);
            f32x4 u[4];
#pragma unroll
            for (int mt = 0; mt < 4; ++mt) u[mt] = un[mt];
            const float gl = GL[item0 + c];
            float zv[4][4];
#pragma unroll
            for (int mt = 0; mt < 4; ++mt)
#pragma unroll
                for (int i = 0; i < 4; ++i) { const int lr = 16 * mt + 4 * fq + i; zv[mt][i] = (lr < nvalid) ? bf2f(proj[(size_t)(row0 + 64 * c + lr) * NPROJ + 3072 + h * 128 + dvc]) : 0.f; }
            if (c + 1 < nch) SCAN_LOADU(item0 + c + 1);
            const int x16 = fr << 4, x8 = ((fr >> 1) & 7) << 4;
            bf16x8 sf[4];
#pragma unroll
            for (int ks = 0; ks < 4; ++ks) {
                u32x4 w; w.x = pk2(-st[2 * ks][0], -st[2 * ks][1]); w.y = pk2(-st[2 * ks][2], -st[2 * ks][3]); w.z = pk2(-st[2 * ks + 1][0], -st[2 * ks + 1][1]); w.w = pk2(-st[2 * ks + 1][2], -st[2 * ks + 1][3]);
                sf[ks] = __builtin_bit_cast(bf16x8, w);
            }
#pragma unroll
            for (int mt = 0; mt < 4; ++mt) {
#pragma unroll
                for (int ks = 0; ks < 4; ++ks) {
                    const bf16x8 aw = *(const LAS bf16x8*)(bb + (16 * mt + fr) * 256 + ((((4 * ks + fq) << 4)) ^ x16));
                    u[mt] = MFMA16(aw, sf[ks], u[mt]);
                }
            }
            __builtin_amdgcn_sched_barrier(0);
#pragma unroll
            for (int ks = 0; ks < 4; ++ks) sf[ks] = sf[ks] ^ (short)0x8000;
            f32x4 o[4];
#pragma unroll
            for (int mt = 0; mt < 4; ++mt) {
                o[mt] = (f32x4){0.f, 0.f, 0.f, 0.f};
#pragma unroll
                for (int ks = 0; ks < 4; ++ks) {
                    const bf16x8 aq = *(const LAS bf16x8*)(bb + 16384 + (16 * mt + fr) * 256 + ((((4 * ks + fq) << 4)) ^ x16));
                    o[mt] = MFMA16(aq, sf[ks], o[mt]);
                }
            }
            __builtin_amdgcn_sched_barrier(0);
            bf16x8 uf[2];
#pragma unroll
            for (int k2 = 0; k2 < 2; ++k2) {
                u32x4 w; w.x = pk2(u[2 * k2][0], u[2 * k2][1]); w.y = pk2(u[2 * k2][2], u[2 * k2][3]); w.z = pk2(u[2 * k2 + 1][0], u[2 * k2 + 1][1]); w.w = pk2(u[2 * k2 + 1][2], u[2 * k2 + 1][3]);
                uf[k2] = __builtin_bit_cast(bf16x8, w);
            }
#pragma unroll
            for (int mt = 0; mt < 4; ++mt)
#pragma unroll
                for (int k2 = 0; k2 < 2; ++k2) {
                    const bf16x8 a = *(const LAS bf16x8*)(bb + 49152 + (16 * mt + fr) * 128 + (((4 * k2 + fq) << 4) ^ x8));
                    o[mt] = MFMA16(a, uf[k2], o[mt]);
                }
#pragma unroll
            for (int mt = 0; mt < 8; ++mt) {
                st[mt] = st[mt] * gl;
#pragma unroll
                for (int k2 = 0; k2 < 2; ++k2) {
                    const bf16x8 a = *(const LAS bf16x8*)(bb + 32768 + (16 * mt + fr) * 128 + (((4 * k2 + fq) << 4) ^ x8));
                    st[mt] = MFMA16(a, uf[k2], st[mt]);
                }
            }
            LAS float* rd = red + (c & 1) * 512;
#pragma unroll
            for (int mt = 0; mt < 4; ++mt)
#pragma unroll
                for (int i = 0; i < 4; ++i) {
                    float ss = o[mt][i] * o[mt][i];
                    ss += __shfl_xor(ss, 1); ss += __shfl_xor(ss, 2); ss += __shfl_xor(ss, 4); ss += __shfl_xor(ss, 8);
                    if (fr == 0) rd[(16 * mt + 4 * fq + i) * 8 + wid] = ss;
                }
            __syncthreads();
#pragma unroll
            for (int mt = 0; mt < 4; ++mt)
#pragma unroll
                for (int i = 0; i < 4; ++i) {
                    const int lr = 16 * mt + 4 * fq + i;
                    const f32x4 p0 = *(const LAS f32x4*)(rd + lr * 8), p1 = *(const LAS f32x4*)(rd + lr * 8 + 4);
                    const float ss = p0[0] + p0[1] + p0[2] + p0[3] + p1[0] + p1[1] + p1[2] + p1[3];
                    const float rstd = rsqrtf(ss * (1.f / 128.f) + RMS_EPS);
                    const float ov = o[mt][i] * rstd * onw * siluf(zv[mt][i]);
                    if (lr < nvalid) OB[(size_t)(row0 + 64 * c + lr) * 1024 + h * 128 + dvc] = f2bf(ov);
                }
        }
#pragma unroll
        for (int mt = 0; mt < 8; ++mt)
#pragma unroll
            for (int i = 0; i < 4; ++i) stout[(16 * mt + 4 * fq + i) * 128 + dvc] = st[mt][i];
#undef SCAN_G2L
#undef SCAN_LOADU
    }
}

DI void phase_attn(const Params& P, LAS unsigned char* lds, int layer) {
    int tid_ = threadIdx.x; asm volatile("" : "+v"(tid_)); const int tid = tid_, wid = __builtin_amdgcn_readfirstlane(tid >> 6), lane = tid & 63, G = gridDim.x;
    unsigned char* ws = P.ws;
    const int j = layer >> 1;
    const int comp = wid >> 2, rg = wid & 3, r32 = lane & 31, h2 = lane >> 5;
    const int q4 = (lane & 15) >> 2, p4 = lane & 3, blk = (lane >> 4) & 1;
    const bf16_t* proj = (const bf16_t*)(ws + WS_PROJ);
    bf16_t* OB = (bf16_t*)(ws + WS_HBUF);
    const float lam_init = 0.8f - 0.6f * expf(-0.3f * (float)layer);
    float lam;
    {
        float d1 = 0.f, d2 = 0.f;
        for (int i = 0; i < 64; ++i) { d1 += P.in[19][j * 64 + i] * P.in[20][j * 64 + i]; d2 += P.in[21][j * 64 + i] * P.in[22][j * 64 + i]; }
        lam = expf(d1) - expf(d2) + lam_init;
    }
    const float* subln = P.in[23] + j * 128;
    constexpr int TB = 35840;
    const int vb = (G % 8 == 0) ? (blockIdx.x % 8) * (G / 8) + blockIdx.x / 8 : blockIdx.x;
    const int nrounds = (G == 256) ? 9 : (2176 + G - 1) / G;
    for (int k = 0; k < nrounds; ++k) {
        int id;
        if (G == 256) {
            if (k < 8) { const int seq = vb >> 3, sub = vb & 7; const int qt = (k & 1) ? (16 * (k >> 1) + 15 - sub) : (16 * (k >> 1) + sub); id = seq * 64 + qt; }
            else { if (vb >= 128) break; id = 2048 + vb; }
        } else { id = vb + k * G; if (id >= 2176) break; }
        int h, qrow0, nt_all, nt_mine, last_valid, kvstride; const bf16_t* Kp; const bf16_t* Vp; bool sample;
        if (id < 2048) {
            const int seq = id >> 6, qt = id & 63, b = seq >> 3; h = seq & 7; sample = false;
            qrow0 = b * TP + 128 * qt + 32 * rg; nt_all = 2 * qt + 2; nt_mine = (rg < 2) ? 2 * qt + 1 : 2 * qt + 2; last_valid = 64; kvstride = NPROJ;
            Kp = proj + (size_t)(b * TP) * NPROJ + 1024 + h * 128; Vp = proj + (size_t)(b * TP) * NPROJ + 2048 + h * 128;
        } else {
            const int s = id - 2048, b = s >> 3; h = s & 7; sample = true;
            qrow0 = MP + b * TS; nt_all = 33; nt_mine = (rg == 0) ? 33 : 0; last_valid = 16; kvstride = 1024;
            Kp = (const bf16_t*)(ws + WS_KS) + (size_t)b * KSROWS * 1024 + h * 128; Vp = (const bf16_t*)(ws + WS_VS) + (size_t)b * KSROWS * 1024 + h * 128;
        }
        bf16x8 qf[4];
        {
            const int qr = qrow0 + (sample ? (r32 & 15) : r32);
            const bf16_t* qp = proj + (size_t)qr * NPROJ + h * 128 + comp * 64 + 8 * h2;
#pragma unroll
            for (int s = 0; s < 4; ++s) qf[s] = *(const bf16x8*)(qp + 16 * s);
        }
        f32x16 O[4];
#pragma unroll
        for (int et = 0; et < 4; ++et)
#pragma unroll
            for (int i = 0; i < 16; ++i) O[et][i] = 0.f;
        float m = -INFINITY, l = 0.f;
        u32x4 pk[2], pv[2];
#define ATT_LOAD(kt) do { _Pragma("unroll") for (int _p = 0; _p < 2; ++_p) { const int _cid = tid + 512 * _p, _row = _cid >> 4, _ch = _cid & 15; \
            pk[_p] = *(const u32x4*)(Kp + (size_t)(64 * (kt) + _row) * kvstride + _ch * 8); pv[_p] = *(const u32x4*)(Vp + (size_t)(64 * (kt) + _row) * kvstride + _ch * 8); } } while (0)
#define ATT_STORE(bufi) do { LAS unsigned char* _bb = lds + (bufi) * TB; _Pragma("unroll") for (int _p = 0; _p < 2; ++_p) { const int _cid = tid + 512 * _p, _row = _cid >> 4, _ch = _cid & 15; \
            *(LAS u32x4*)(_bb + _row * 272 + _ch * 16) = pk[_p]; *(LAS u32x4*)(_bb + 17408 + _row * 288 + _ch * 16) = pv[_p]; } } while (0)
        ATT_LOAD(0);
        ATT_STORE(0);
        __syncthreads();
        for (int kt = 0; kt < nt_all; ++kt) {
            if (kt + 1 < nt_all) ATT_LOAD(kt + 1);
            if (kt < nt_mine) {
                LAS unsigned char* Kb = lds + (kt & 1) * TB; LAS unsigned char* Vb = Kb + 17408;
                f32x16 s0, s1;
#pragma unroll
                for (int i = 0; i < 16; ++i) { s0[i] = 0.f; s1[i] = 0.f; }
#pragma unroll
                for (int s = 0; s < 4; ++s) {
                    const bf16x8 k0 = *(const LAS bf16x8*)(Kb + r32 * 272 + (comp * 64 + 16 * s + 8 * h2) * 2);
                    const bf16x8 k1 = *(const LAS bf16x8*)(Kb + (32 + r32) * 272 + (comp * 64 + 16 * s + 8 * h2) * 2);
                    s0 = MFMA32(k0, qf[s], s0); s1 = MFMA32(k1, qf[s], s1);
                }
                if (kt == nt_all - 1 && last_valid < 64) {
#pragma unroll
                    for (int i = 0; i < 16; ++i) {
                        const int key = (i & 3) + 8 * (i >> 2) + 4 * h2;
                        if (key >= last_valid) s0[i] = -INFINITY;
                        if (32 + key >= last_valid) s1[i] = -INFINITY;
                    }
                }
                float mx = s0[0];
#pragma unroll
                for (int i = 1; i < 16; ++i) mx = fmaxf(mx, s0[i]);
#pragma unroll
                for (int i = 0; i < 16; ++i) mx = fmaxf(mx, s1[i]);
                mx = fmaxf(mx, __shfl_xor(mx, 32));
                const float mn = fmaxf(m, mx);
                if (__any(mn > m)) {
                    const float alpha = __builtin_amdgcn_exp2f(m - mn);
                    l *= alpha;
#pragma unroll
                    for (int et = 0; et < 4; ++et)
#pragma unroll
                        for (int i = 0; i < 16; ++i) O[et][i] *= alpha;
                    m = mn;
                }
                float ps = 0.f;
#pragma unroll
                for (int i = 0; i < 16; ++i) { s0[i] = __builtin_amdgcn_exp2f(s0[i] - m); s1[i] = __builtin_amdgcn_exp2f(s1[i] - m); ps += s0[i] + s1[i]; }
                l += ps;
                bf16x8 pf[2][2];
                {
                    u32x4 w;
                    w.x = pk2(s0[0], s0[1]); w.y = pk2(s0[2], s0[3]); w.z = pk2(s0[4], s0[5]); w.w = pk2(s0[6], s0[7]); pf[0][0] = __builtin_bit_cast(bf16x8, w);
                    w.x = pk2(s0[8], s0[9]); w.y = pk2(s0[10], s0[11]); w.z = pk2(s0[12], s0[13]); w.w = pk2(s0[14], s0[15]); pf[0][1] = __builtin_bit_cast(bf16x8, w);
                    w.x = pk2(s1[0], s1[1]); w.y = pk2(s1[2], s1[3]); w.z = pk2(s1[4], s1[5]); w.w = pk2(s1[6], s1[7]); pf[1][0] = __builtin_bit_cast(bf16x8, w);
                    w.x = pk2(s1[8], s1[9]); w.y = pk2(s1[10], s1[11]); w.z = pk2(s1[12], s1[13]); w.w = pk2(s1[14], s1[15]); pf[1][1] = __builtin_bit_cast(bf16x8, w);
                }
#pragma unroll
                for (int kt2 = 0; kt2 < 2; ++kt2)
#pragma unroll
                    for (int s2 = 0; s2 < 2; ++s2) {
                        const int keyrow = 32 * kt2 + 16 * s2 + 4 * h2 + q4;
#pragma unroll
                        for (int et = 0; et < 4; ++et) {
                            const s16x4 lo = __builtin_amdgcn_ds_read_tr16_b64_v4i16((LAS s16x4*)(Vb + keyrow * 288 + (32 * et + 16 * blk) * 2 + 8 * p4));
                            const s16x4 hi = __builtin_amdgcn_ds_read_tr16_b64_v4i16((LAS s16x4*)(Vb + (keyrow + 8) * 288 + (32 * et + 16 * blk) * 2 + 8 * p4));
                            const bf16x8 vf = __builtin_shufflevector(lo, hi, 0, 1, 2, 3, 4, 5, 6, 7);
                            O[et] = MFMA32(vf, pf[kt2][s2], O[et]);
                        }
                    }
            }
            if (kt + 1 < nt_all) ATT_STORE((kt + 1) & 1);
            __syncthreads();
        }
#undef ATT_LOAD
#undef ATT_STORE
        const float lt = l + __shfl_xor(l, 32);
        const float inv = (nt_mine > 0) ? 1.f / lt : 0.f;
        LAS float* XO = (LAS float*)lds;
        if (comp == 1) {
            const float sc = inv * lam;
#pragma unroll
            for (int et = 0; et < 4; ++et)
#pragma unroll
                for (int i = 0; i < 16; ++i) XO[(rg * 128 + 32 * et + (i & 3) + 8 * (i >> 2) + 4 * h2) * 32 + r32] = O[et][i] * sc;
        }
        __syncthreads();
        if (comp == 0 && nt_mine > 0) {
            float ss = 0.f;
#pragma unroll
            for (int et = 0; et < 4; ++et)
#pragma unroll
                for (int i = 0; i < 16; ++i) { const float v = O[et][i] * inv - XO[(rg * 128 + 32 * et + (i & 3) + 8 * (i >> 2) + 4 * h2) * 32 + r32]; O[et][i] = v; ss += v * v; }
            ss += __shfl_xor(ss, 32);
            const float rstd = rsqrtf(ss * (1.f / 128.f) + RMS_EPS) * (1.f - lam_init);
            const bool rvalid = sample ? (r32 < TS) : true;
            const int row = qrow0 + r32;
            if (rvalid) {
#pragma unroll
                for (int et = 0; et < 4; ++et)
#pragma unroll
                    for (int g4 = 0; g4 < 4; ++g4) {
                        const int e0 = 32 * et + 8 * g4 + 4 * h2;
                        const u32x2 zz = *(const u32x2*)(proj + (size_t)row * NPROJ + 3072 + h * 128 + e0);
                        const f32x4 sl = *(const f32x4*)(subln + e0);
                        const float z0 = __uint_as_float(zz.x << 16), z1 = __uint_as_float(zz.x & 0xffff0000u), z2 = __uint_as_float(zz.y << 16), z3 = __uint_as_float(zz.y & 0xffff0000u);
                        u32x2 w;
                        w.x = pk2(O[et][4 * g4] * rstd * sl[0] * siluf(z0), O[et][4 * g4 + 1] * rstd * sl[1] * siluf(z1));
                        w.y = pk2(O[et][4 * g4 + 2] * rstd * sl[2] * siluf(z2), O[et][4 * g4 + 3] * rstd * sl[3] * siluf(z3));
                        *(u32x2*)(OB + (size_t)row * 1024 + h * 128 + e0) = w;
                    }
            }
        }
        __syncthreads();
    }
}

typedef const __attribute__((address_space(4))) Params* CParP;
#define LOADP() Params P; { CParP kp_ = KP; asm volatile("" : "+s"(kp_)); P = *kp_; } unsigned char* ws = P.ws; (void)ws
__global__ void __launch_bounds__(512, 2) fwd_megakernel(Params Pin) {
#if defined(__HIP_DEVICE_COMPILE__)
    extern __shared__ __attribute__((aligned(16))) unsigned char lds_raw[];
    LAS unsigned char* lds = (LAS unsigned char*)lds_raw;
    cg::grid_group grid = cg::this_grid();
    const CParP KP = (CParP)__builtin_amdgcn_kernarg_segment_ptr();
    { LOADP(); phase_prep(P, lds); }
    grid.sync();
    for (int layer = 0; layer < 4; ++layer) {
        const int j = layer >> 1;
        { LOADP(); phase_elem(P, lds, layer); }
        grid.sync();
        {
            LOADP();
            pg8::StaticOrder S; S.init(M, NPROJ, gridDim.x, blockIdx.x);
            pg8::Gemm g;
            g.A = (const bf16_t*)(ws + WS_HBUF); g.M = M; g.N = NPROJ; g.K = 1024;
            if (!(layer & 1)) {
                g.Bt = (const bf16_t*)(ws + WS_WING) + (size_t)j * 4096 * 1024;
                EpiGdnIn E; E.proj = (bf16_t*)(ws + WS_PROJ); E.conv_p = P.out + OFF_CVP + (size_t)j * 4 * 3 * 3072; E.conv_s = P.out + OFF_CVS + (size_t)j * 16 * 3 * 3072;
                pg8::gemm_phase(lds, g, S, E);
            } else {
                g.Bt = (const bf16_t*)(ws + WS_WIND) + (size_t)j * 4096 * 1024;
                EpiDiffIn E; E.proj = (bf16_t*)(ws + WS_PROJ);
                E.k_p = P.out + OFF_KP + (size_t)j * MP * 1024; E.v_p = P.out + OFF_VP + (size_t)j * MP * 1024;
                E.k_s = P.out + OFF_KSO + (size_t)j * MS * 1024; E.v_s = P.out + OFF_VSO + (size_t)j * MS * 1024;
                E.ks = (bf16_t*)(ws + WS_KS); E.vs = (bf16_t*)(ws + WS_VS); E.rope = (const float*)(ws + WS_ROPE);
                pg8::gemm_phase(lds, g, S, E);
            }
        }
        grid.sync();
        if (!(layer & 1)) {
            { LOADP(); phase_g1(P, lds, layer); }
            grid.sync();
            { LOADP(); phase_scan(P, lds, layer); }
        } else {
            LOADP(); phase_attn(P, lds, layer);
        }
        grid.sync();
        {
            LOADP();
            pg8::StaticOrder S; S.init(M, 1024, gridDim.x, blockIdx.x);
            pg8::Gemm g;
            g.A = (const bf16_t*)(ws + WS_HBUF); g.M = M; g.N = 1024; g.K = 1024;
            g.Bt = (const bf16_t*)(ws + ((layer & 1) ? WS_WOUTD : WS_WOUTG)) + (size_t)j * 1024 * 1024;
            EpiOut E; E.C = (float*)(ws + WS_PROJ);
            pg8::gemm_phase(lds, g, S, E);
        }
        grid.sync();
    }
    { LOADP(); phase_elem(P, lds, 4); }
#endif
}

extern "C" void kernel_launch(void* const* d_in, const int* in_sizes, int n_in, void* d_out, int out_size, void* d_ws, size_t ws_size, hipStream_t stream) {
    static int grid_blocks = 0;
    if (!grid_blocks) {
        int dev = 0, cus = 0, per_cu = 0;
        hipGetDevice(&dev);
        hipDeviceGetAttribute(&cus, hipDeviceAttributeMultiprocessorCount, dev);
        hipFuncSetAttribute((const void*)fwd_megakernel, hipFuncAttributeMaxDynamicSharedMemorySize, LDS_BYTES);
        hipOccupancyMaxActiveBlocksPerMultiprocessor(&per_cu, (const void*)fwd_megakernel, 512, LDS_BYTES);
        if (per_cu < 1) per_cu = 1;
        grid_blocks = cus * per_cu;
        if (ws_size < WS_END) fprintf(stderr, "kernel_launch: workspace too small: %zu < %zu\n", ws_size, (size_t)WS_END);
    }
    Params p{};
    for (int i = 0; i < 25; ++i) p.in[i] = (const float*)d_in[i];
    p.out = (float*)d_out; p.ws = (unsigned char*)d_ws;
    void* args[] = {&p};
    hipError_t e = hipLaunchCooperativeKernel((const void*)fwd_megakernel, dim3(grid_blocks), dim3(512), args, LDS_BYTES, stream);
    if (e != hipSuccess) fprintf(stderr, "cooperative launch failed: %s (grid %d)\n", hipGetErrorString(e), grid_blocks);
}
```

```cpp
#include <hip/hip_runtime.h>
#include <hip/hip_cooperative_groups.h>
#include <cstdio>
namespace cg = cooperative_groups;

#define DI __device__ __forceinline__
#define LAS __attribute__((address_space(3)))
typedef unsigned short bf16_t;
typedef short bf16x8 __attribute__((ext_vector_type(8)));
typedef short s16x4 __attribute__((ext_vector_type(4)));
typedef float f32x2 __attribute__((ext_vector_type(2)));
typedef float f32x4 __attribute__((ext_vector_type(4)));
typedef float f32x16 __attribute__((ext_vector_type(16)));
typedef unsigned u32x2 __attribute__((ext_vector_type(2)));
typedef unsigned u32x4 __attribute__((ext_vector_type(4)));
typedef __bf16 bf16x2_t __attribute__((ext_vector_type(2)));

#define REP_G1 1
#define REP_SCAN 1
#define REP_ATTN 1
#define REP_GIN 1
#define REP_GOUT 1
#define REP_PREP 1
DI int opaque_i(int v) { asm volatile("" : "+s"(v)); return v; }
constexpr int D = 1024, TP = 8192, BP = 4, BS = 16, TS = 16, PAST = 2048;
constexpr int MP = BP * TP, MS = BS * TS, M = MP + MS, NB = BP + BS;
constexpr int NPROJ = 4096;
constexpr int KSROWS = 2112;
constexpr int NITEM_P = 4096, NITEM = 4224;
constexpr size_t ITEM_BYTES = 90112;
constexpr float RMS_EPS = 1e-6f;
constexpr float QSCALE = 0.125f * 1.4426950408889634f;

constexpr size_t OFF_Y = 0;
constexpr size_t OFF_STP = (size_t)M * D;
constexpr size_t OFF_CVP = OFF_STP + 2ull * 4 * 8 * 128 * 128;
constexpr size_t OFF_KP = OFF_CVP + 2ull * 4 * 3 * 3072;
constexpr size_t OFF_VP = OFF_KP + 2ull * MP * 1024;
constexpr size_t OFF_STS = OFF_VP + 2ull * MP * 1024;
constexpr size_t OFF_CVS = OFF_STS + 2ull * 16 * 8 * 128 * 128;
constexpr size_t OFF_KSO = OFF_CVS + 2ull * 16 * 3 * 3072;
constexpr size_t OFF_VSO = OFF_KSO + 2ull * MS * 1024;

constexpr size_t WS_WING = 0;
constexpr size_t WS_WOUTG = WS_WING + 2ull * 4096 * 1024 * 2;
constexpr size_t WS_WIND = WS_WOUTG + 2ull * 1024 * 1024 * 2;
constexpr size_t WS_WOUTD = WS_WIND + 2ull * 4096 * 1024 * 2;
constexpr size_t WS_ADA = WS_WOUTD + 2ull * 1024 * 1024 * 2;
constexpr size_t WS_ROPE = WS_ADA + 4ull * NB * 3072 * 4;
constexpr size_t WS_AB = WS_ROPE + 8208ull * 64 * 4;
constexpr size_t WS_GL = WS_AB + (size_t)M * 16 * 4;
constexpr size_t WS_HBUF = WS_GL + 32768;
constexpr size_t WS_ORAW = WS_HBUF + (size_t)M * 1024 * 2;
constexpr size_t WS_PROJ = WS_ORAW + 256;
constexpr size_t WS_R1 = WS_PROJ + (size_t)M * 4096 * 2;
constexpr size_t WS_KS = WS_R1;
constexpr size_t WS_VS = WS_KS + 16ull * KSROWS * 1024 * 2;
constexpr size_t WS_END = WS_R1 + (size_t)NITEM * ITEM_BYTES;

constexpr int LDS_BYTES = 131072;

struct Params { const float* in[25]; float* out; unsigned char* ws; };

DI float bf2f(bf16_t v) { return __uint_as_float(((unsigned)v) << 16); }
DI unsigned pk2(float a, float b) { f32x2 v = {a, b}; bf16x2_t r = __builtin_convertvector(v, bf16x2_t); return __builtin_bit_cast(unsigned, r); }
DI bf16_t f2bf(float a) { return (bf16_t)(pk2(a, 0.f) & 0xffffu); }
template <int CTRL> DI float dppf(float v) { return __builtin_bit_cast(float, __builtin_amdgcn_update_dpp(0, __builtin_bit_cast(int, v), CTRL, 0xf, 0xf, true)); }
DI float row_sum16(float v) { v += dppf<0x128>(v); v += dppf<0x124>(v); v += dppf<0x122>(v); v += dppf<0x121>(v); return v; }
DI float wave_sum(float v) { v = row_sum16(v); v += __shfl_xor(v, 16); v += __shfl_xor(v, 32); return v; }
DI float readlane_f(float v, int l) { return __builtin_bit_cast(float, __builtin_amdgcn_readlane(__builtin_bit_cast(int, v), l)); }
DI float siluf(float x) { return x / (1.f + __expf(-x)); }
DI int ppos(int idx) { const int d5 = idx & 31; return (idx & ~31) | (((d5 >> 2) & 3) << 3) | ((d5 >> 4) << 2) | (d5 & 3); }
DI int perm64(int ls) { return (ls & 15) | (((ls >> 4) & 1) << 5) | (((ls >> 5) & 1) << 4); }
DI void unpack8(const u32x4 v, float (&o)[8]) {
#pragma unroll
    for (int i = 0; i < 4; ++i) { o[2 * i] = __uint_as_float(v[i] << 16); o[2 * i + 1] = __uint_as_float(v[i] & 0xffff0000u); }
}
#define MFMA16(a, b, c) __builtin_amdgcn_mfma_f32_16x16x32_bf16((a), (b), (c), 0, 0, 0)
#define MFMA32(a, b, c) __builtin_amdgcn_mfma_f32_32x32x16_bf16((a), (b), (c), 0, 0, 0)

namespace pg8 {
constexpr int BM = 256, BK = 64, HALF = 128, HTB = HALF * BK * 2, STAGE_BYTES = 8 * HTB, NXCD = 8, WGM = 8;
DI int lds_byte(int r, int c) { const int st = (r >> 4) * 2 + (c >> 5), rr = r & 15, cc = c & 31, ob = rr * 64 + cc * 2; return st * 1024 + (ob ^ (((ob >> 9) & 1) << 5)); }
DI void stage_rc(int b, int& R, int& C) { const int st = b / 1024, sb = b % 1024, swz = sb ^ (((sb >> 9) & 1) << 5); R = (st >> 1) * 16 + swz / 64; C = (st & 1) * 32 + (swz % 64) / 2; }
struct Unit { int pm, pn; };
struct Gemm { const bf16_t* A; const bf16_t* Bt; int M, N, K; };
struct StaticOrder {
    int nM, nN, nwg, G, c;
    DI void init(int M_, int N_, int G_, int c_) { nM = M_ / BM; nN = N_ / BM; nwg = nM * nN; G = G_; c = c_; }
    DI bool next(int i, Unit& u) const {
        const long L = (long)i * G + c; if (L >= nwg) return false;
        int wgid = (int)L; { const int q = nwg / NXCD, r = nwg % NXCD, xcd = wgid % NXCD, off = wgid / NXCD; wgid = (xcd < r ? xcd * (q + 1) : r * (q + 1) + (xcd - r) * q) + off; }
        const int nig = WGM * nN, gid = wgid / nig, fm = gid * WGM, gsz = (nM - fm) < WGM ? (nM - fm) : WGM;
        u.pm = fm + ((wgid % nig) % gsz); u.pn = (wgid % nig) / gsz; return true;
    }
};

template <class Epi>
DI void gemm_phase(LAS unsigned char* lds, const Gemm g, const StaticOrder& S, const Epi& E) {
    int tid_ = threadIdx.x; asm volatile("" : "+v"(tid_)); const int tid = tid_, wid = __builtin_amdgcn_readfirstlane(tid >> 6), lane = tid & 63, wr = wid >> 2, wc = wid & 3, fr = lane & 15, fq = lane >> 4;
    const int K = g.K, nt = K / BK;
    unsigned voffA[2];
#pragma unroll
    for (int i = 0; i < 2; ++i) { int R, C; stage_rc(tid * 16 + i * 8192, R, C); voffA[i] = (unsigned)(R * K + C) * 2u; }
    const size_t kstep = (size_t)(BK * 2);
    const size_t hstep = (size_t)HALF * K * 2;
    const size_t tstep = 2 * hstep;
    const unsigned ldsw = (unsigned)wid * 1024u;
    const int aoff = lds_byte(wr * 64 + fr, fq * 8), boff = lds_byte(wc * 32 + fr, fq * 8);
#define PG8_SA(b, h) (((b) * 2 + (h)) * HTB)
#define PG8_SB(b, h) ((4 + (b) * 2 + (h)) * HTB)
#define PG8_STAGE(bufoff, gbase) do { _Pragma("unroll") for (int _i = 0; _i < 2; ++_i) \
        __builtin_amdgcn_global_load_lds((const unsigned*)((const char*)(gbase) + voffA[_i]), (LAS unsigned*)(lds + (bufoff) + ldsw + _i * 8192), 16, 0, 0); } while (0)
#define PG8_LDA(dst, b, h) do { _Pragma("unroll") for (int m = 0; m < 4; ++m) _Pragma("unroll") for (int k = 0; k < 2; ++k) dst[m][k] = *(const LAS bf16x8*)(lds + PG8_SA(b, h) + aoff + m * 2048 + k * 1024); } while (0)
#define PG8_LDB(dst, b, h) do { _Pragma("unroll") for (int n = 0; n < 2; ++n) _Pragma("unroll") for (int k = 0; k < 2; ++k) dst[n][k] = *(const LAS bf16x8*)(lds + PG8_SB(b, h) + boff + n * 2048 + k * 1024); } while (0)
#define PG8_MMA(ai, bj, At, Bt) do { __builtin_amdgcn_s_setprio(1); _Pragma("unroll") for (int m = 0; m < 4; ++m) _Pragma("unroll") for (int n = 0; n < 2; ++n) _Pragma("unroll") for (int k = 0; k < 2; ++k) \
        acc[ai][bj][m][n] = __builtin_amdgcn_mfma_f32_16x16x32_bf16(Bt[n][k], At[m][k], acc[ai][bj][m][n], 0, 0, 0); __builtin_amdgcn_s_setprio(0); } while (0)
#define PG8_WAIT_V(n) asm volatile("s_waitcnt vmcnt(" #n ")" ::: "memory")
#define PG8_WAIT_L(n) asm volatile("s_waitcnt lgkmcnt(" #n ")" ::: "memory")
#define PG8_BAR __builtin_amdgcn_s_barrier()
#define PG8_SCHED __builtin_amdgcn_sched_barrier(0)
    Unit cur, nxt; int ui = 0;
    if (!S.next(0, cur)) return;
    f32x4 acc[2][2][4][2];
#pragma unroll
    for (int a = 0; a < 2; ++a)
#pragma unroll
        for (int b = 0; b < 2; ++b)
#pragma unroll
            for (int m = 0; m < 4; ++m)
#pragma unroll
                for (int n = 0; n < 2; ++n) acc[a][b][m][n] = (f32x4){0.f, 0.f, 0.f, 0.f};
    bf16x8 At[4][2], B0[2][2], B1[2][2];
    const char* cA = (const char*)g.A + (size_t)cur.pm * tstep; const char* cB = (const char*)g.Bt + (size_t)cur.pn * tstep;
    PG8_STAGE(PG8_SB(0, 0), cB); PG8_STAGE(PG8_SA(0, 0), cA); PG8_STAGE(PG8_SB(0, 1), cB + hstep); PG8_STAGE(PG8_SA(0, 1), cA + hstep);
    if (wr == 1) PG8_BAR;
    PG8_WAIT_V(4); PG8_BAR;
    PG8_STAGE(PG8_SB(1, 0), cB + kstep); PG8_STAGE(PG8_SA(1, 0), cA + kstep); PG8_STAGE(PG8_SB(1, 1), cB + hstep + kstep);
    PG8_WAIT_V(6); PG8_BAR;
    for (;;) {
        const bool has_next = S.next(ui + 1, nxt);
        const char* nA = has_next ? (const char*)g.A + (size_t)nxt.pm * tstep : cA; const char* nB = has_next ? (const char*)g.Bt + (size_t)nxt.pn * tstep : cB;
        for (int t = 0; t < nt; t += 2) {
            const bool last = (t == nt - 2);
            const char* a1 = cA + (size_t)(t + 1) * kstep;
            const char* a2 = last ? nA : cA + (size_t)(t + 2) * kstep; const char* b2 = last ? nB : cB + (size_t)(t + 2) * kstep;
            const char* a3 = a2 + kstep; const char* b3 = b2 + kstep;
            PG8_LDB(B0, 0, 0); PG8_SCHED; PG8_LDA(At, 0, 0); PG8_STAGE(PG8_SA(1, 1), a1 + hstep);
            PG8_WAIT_L(8); PG8_BAR; PG8_WAIT_L(0); PG8_MMA(0, 0, At, B0); PG8_BAR; PG8_SCHED;
            PG8_LDB(B1, 0, 1); PG8_STAGE(PG8_SB(0, 0), b2);
            PG8_BAR; PG8_WAIT_L(0); PG8_MMA(0, 1, At, B1); PG8_BAR;
            PG8_LDA(At, 0, 1); PG8_STAGE(PG8_SA(0, 0), a2);
            PG8_BAR; PG8_WAIT_L(0); PG8_MMA(1, 0, At, B0); PG8_BAR; PG8_SCHED;
            PG8_STAGE(PG8_SB(0, 1), b2 + hstep);
            PG8_WAIT_V(6); PG8_BAR; PG8_MMA(1, 1, At, B1); PG8_BAR;
            PG8_LDB(B0, 1, 0); PG8_SCHED; PG8_LDA(At, 1, 0); PG8_STAGE(PG8_SA(0, 1), a2 + hstep);
            PG8_WAIT_L(8); PG8_BAR; PG8_WAIT_L(0); PG8_MMA(0, 0, At, B0); PG8_BAR; PG8_SCHED;
            PG8_LDB(B1, 1, 1); PG8_STAGE(PG8_SB(1, 0), b3);
            PG8_BAR; PG8_WAIT_L(0); PG8_MMA(0, 1, At, B1); PG8_BAR;
            PG8_LDA(At, 1, 1); PG8_STAGE(PG8_SA(1, 0), a3);
            PG8_BAR; PG8_WAIT_L(0); PG8_MMA(1, 0, At, B0); PG8_BAR; PG8_SCHED;
            PG8_STAGE(PG8_SB(1, 1), b3 + hstep);
            PG8_WAIT_V(6); PG8_BAR; PG8_MMA(1, 1, At, B1); PG8_BAR;
        }
        E(acc, cur, wr, wc, fr, fq);
        if (!has_next) break;
#pragma unroll
        for (int a = 0; a < 2; ++a)
#pragma unroll
            for (int b = 0; b < 2; ++b)
#pragma unroll
                for (int m = 0; m < 4; ++m)
#pragma unroll
                    for (int n = 0; n < 2; ++n) acc[a][b][m][n] = (f32x4){0.f, 0.f, 0.f, 0.f};
        cur = nxt; cA = nA; cB = nB; ++ui;
    }
    PG8_WAIT_V(0);
    if (wr == 0) PG8_BAR;
    PG8_BAR;
#undef PG8_SA
#undef PG8_SB
#undef PG8_STAGE
#undef PG8_LDA
#undef PG8_LDB
#undef PG8_MMA
#undef PG8_WAIT_V
#undef PG8_WAIT_L
#undef PG8_BAR
#undef PG8_SCHED
}
}

struct EpiGdnIn {
    bf16_t* proj; float* conv_p; float* conv_s;
    DI void operator()(const f32x4 (&acc)[2][2][4][2], const pg8::Unit& u, int wr, int wc, int fr, int fq) const {
        const int row0 = u.pm * 256 + wr * 64 + fr, col0 = u.pn * 256 + wc * 32 + 4 * fq;
#pragma unroll
        for (int ai = 0; ai < 2; ++ai)
#pragma unroll
            for (int m = 0; m < 4; ++m) {
                const int r = row0 + ai * 128 + m * 16;
                bf16_t* rowp = proj + (size_t)r * NPROJ + col0;
                bool tail; float* cp;
                if (r < MP) { const int t = r & (TP - 1), b = r >> 13; tail = t >= TP - 3; cp = conv_p + (size_t)(b * 3 + (t - (TP - 3))) * 3072; }
                else { const int rs = r - MP, t = rs & 15, b = rs >> 4; tail = t >= TS - 3; cp = conv_s + (size_t)(b * 3 + (t - (TS - 3))) * 3072; }
#pragma unroll
                for (int bj = 0; bj < 2; ++bj)
#pragma unroll
                    for (int n = 0; n < 2; ++n) {
                        const f32x4 v = acc[ai][bj][m][n];
                        u32x2 w; w.x = pk2(v[0], v[1]); w.y = pk2(v[2], v[3]);
                        *(u32x2*)(rowp + bj * 128 + n * 16) = w;
                        const int c = col0 + bj * 128 + n * 16;
                        if (tail && c < 3072) *(f32x4*)(cp + c) = v;
                    }
            }
    }
};

struct EpiDiffIn {
    bf16_t* proj; float* k_p; float* v_p; float* k_s; float* v_s; bf16_t* ks; bf16_t* vs; const float* rope;
    DI void operator()(const f32x4 (&acc)[2][2][4][2], const pg8::Unit& u, int wr, int wc, int fr, int fq) const {
        const int part = u.pn >> 2;
        const int row0 = u.pm * 256 + wr * 64 + fr;
        const int d0 = 16 * (wc & 1) + 4 * fq;
        const int cbase = u.pn * 256 + 64 * (wc >> 1) + d0;
#pragma unroll
        for (int ai = 0; ai < 2; ++ai)
#pragma unroll
            for (int m = 0; m < 4; ++m) {
                const int r = row0 + ai * 128 + m * 16;
                const int rs = r - MP;
                const int pidx = (r < MP) ? (r & (TP - 1)) : (TP + (rs & 15));
                f32x4 cs = {1.f, 1.f, 1.f, 1.f}, sn = {0.f, 0.f, 0.f, 0.f};
                if (part < 2) { cs = *(const f32x4*)(rope + (size_t)pidx * 64 + d0); sn = *(const f32x4*)(rope + (size_t)pidx * 64 + 32 + d0); }
#pragma unroll
                for (int bj = 0; bj < 2; ++bj) {
                    const f32x4 x1 = acc[ai][bj][m][0], x2 = acc[ai][bj][m][1];
                    f32x4 y1 = x1 * cs - x2 * sn, y2 = x2 * cs + x1 * sn;
                    const int col = cbase + bj * 128;
                    bf16_t* pp = proj + (size_t)r * NPROJ + col;
                    if (part == 0) { y1 *= QSCALE; y2 *= QSCALE; }
                    u32x2 w1, w2; w1.x = pk2(y1[0], y1[1]); w1.y = pk2(y1[2], y1[3]); w2.x = pk2(y2[0], y2[1]); w2.y = pk2(y2[2], y2[3]);
                    *(u32x2*)pp = w1; *(u32x2*)(pp + 32) = w2;
                    if (part == 1 || part == 2) {
                        const int cc = col - part * 1024;
                        float* op; bf16_t* sp = nullptr;
                        if (r < MP) op = (part == 1 ? k_p : v_p) + (size_t)r * 1024 + cc;
                        else { op = (part == 1 ? k_s : v_s) + (size_t)rs * 1024 + cc;
                               sp = (part == 1 ? ks : vs) + ((size_t)(rs >> 4) * KSROWS + PAST + (rs & 15)) * 1024 + cc; }
                        *(f32x4*)op = y1; *(f32x4*)(op + 32) = y2;
                        if (sp) { *(u32x2*)sp = w1; *(u32x2*)(sp + 32) = w2; }
                    }
                }
            }
    }
};

struct EpiOut {
    float* C;
    DI void operator()(const f32x4 (&acc)[2][2][4][2], const pg8::Unit& u, int wr, int wc, int fr, int fq) const {
        const int row0 = u.pm * 256 + wr * 64 + fr, col0 = u.pn * 256 + wc * 32 + 4 * fq;
#pragma unroll
        for (int ai = 0; ai < 2; ++ai)
#pragma unroll
            for (int m = 0; m < 4; ++m) {
                float* rowp = C + (size_t)(row0 + ai * 128 + m * 16) * 1024 + col0;
#pragma unroll
                for (int bj = 0; bj < 2; ++bj)
#pragma unroll
                    for (int n = 0; n < 2; ++n) *(f32x4*)(rowp + bj * 128 + n * 16) = acc[ai][bj][m][n];
            }
    }
};

DI void transpose_tile(const float* W, int ldw, int n0, int k0, bf16_t* WT, bool perm, LAS float* tile) {
    int tid_ = threadIdx.x; asm volatile("" : "+v"(tid_)); const int tid = tid_;
    {
        const int kk = tid >> 4, c4 = (tid & 15) * 4;
#pragma unroll
        for (int p = 0; p < 2; ++p) {
            const f32x4 v = *(const f32x4*)(W + (size_t)(k0 + kk + 32 * p) * ldw + n0 + c4);
            LAS float* t = tile + (kk + 32 * p) * 65 + c4;
            t[0] = v[0]; t[1] = v[1]; t[2] = v[2]; t[3] = v[3];
        }
    }
    __syncthreads();
    {
        const int n = tid >> 3, ks = (tid & 7) * 8;
        const int src = perm ? perm64(n) : n;
        float v[8];
#pragma unroll
        for (int e = 0; e < 8; ++e) v[e] = tile[(ks + e) * 65 + src];
        u32x4 w; w.x = pk2(v[0], v[1]); w.y = pk2(v[2], v[3]); w.z = pk2(v[4], v[5]); w.w = pk2(v[6], v[7]);
        *(u32x4*)(WT + (size_t)(n0 + n) * 1024 + k0 + ks) = w;
    }
    __syncthreads();
}

DI void phase_prep(const Params& P, LAS unsigned char* lds) {
    int tid_ = threadIdx.x; asm volatile("" : "+v"(tid_)); const int tid = tid_, G = gridDim.x;
    unsigned char* ws = P.ws;
    for (int id = blockIdx.x; id < 5120; id += G) {
        const int j = id / 2560; int rem = id % 2560;
        const float* W; int ldw; bf16_t* WT; bool perm = false; int t;
        if (rem < 1024) { W = P.in[12] + (size_t)j * 1024 * 4112; ldw = 4112; WT = (bf16_t*)(ws + WS_WING) + (size_t)j * 4096 * 1024; t = rem; }
        else if (rem < 1280) { W = P.in[17] + (size_t)j * 1024 * 1024; ldw = 1024; WT = (bf16_t*)(ws + WS_WOUTG) + (size_t)j * 1024 * 1024; t = rem - 1024; }
        else if (rem < 2304) { W = P.in[18] + (size_t)j * 1024 * 4096; ldw = 4096; WT = (bf16_t*)(ws + WS_WIND) + (size_t)j * 4096 * 1024; t = rem - 1280; perm = true; }
        else { W = P.in[24] + (size_t)j * 1024 * 1024; ldw = 1024; WT = (bf16_t*)(ws + WS_WOUTD) + (size_t)j * 1024 * 1024; t = rem - 2304; }
        transpose_tile(W, ldw, (t >> 4) * 64, (t & 15) * 64, WT, perm, (LAS float*)lds);
    }
    for (int idx = blockIdx.x * 512 + tid; idx < 8208 * 32; idx += G * 512) {
        const int pi = idx >> 5, d = idx & 31;
        const int pos = pi < TP ? pi : PAST + (pi - TP);
        const float inv = 1.0f / powf(10000.0f, (float)d / 32.0f);
        const float ang = (float)pos * inv;
        const double rev = (double)ang * 0.15915494309189535;
        const double fr = rev - floor(rev);
        float* rp = (float*)(ws + WS_ROPE) + (size_t)pi * 64;
        rp[d] = __builtin_amdgcn_cosf((float)fr);
        rp[32 + d] = __builtin_amdgcn_sinf((float)fr);
    }
    {
        LAS float* cact = (LAS float*)lds;
        LAS float* red = (LAS float*)(lds + 81920);
        bool loaded = false;
        for (int id = (G - 1 - blockIdx.x); id < 192; id += G) {
            if (!loaded) {
                for (int e = tid; e < NB * 1024; e += 512) {
                    const int b = e >> 10, k = e & 1023;
                    const float c = b < BP ? P.in[2][b * 1024 + k] : P.in[3][(b - BP) * 1024 + k];
                    cact[e] = siluf(c);
                }
                loaded = true;
            }
            __syncthreads();
            const int i = id / 48, cb = id % 48;
            const int col = tid & 63, kg = tid >> 6;
            const float* Wp = P.in[10] + (size_t)i * 1024 * 3072 + cb * 64 + col;
            float acc[NB];
#pragma unroll
            for (int b = 0; b < NB; ++b) acc[b] = 0.f;
            for (int k = kg * 128; k < kg * 128 + 128; k += 4) {
                const float w0 = Wp[(size_t)k * 3072], w1 = Wp[(size_t)(k + 1) * 3072], w2 = Wp[(size_t)(k + 2) * 3072], w3 = Wp[(size_t)(k + 3) * 3072];
#pragma unroll
                for (int b = 0; b < NB; ++b) {
                    const f32x4 c4 = *(const LAS f32x4*)(cact + b * 1024 + k);
                    acc[b] += c4[0] * w0 + c4[1] * w1 + c4[2] * w2 + c4[3] * w3;
                }
            }
#pragma unroll
            for (int b = 0; b < NB; ++b) red[(kg * NB + b) * 64 + col] = acc[b];
            __syncthreads();
            for (int o = tid; o < NB * 64; o += 512) {
                const int b = o >> 6, c = o & 63;
                float s = P.in[11][i * 3072 + cb * 64 + c];
#pragma unroll
                for (int g = 0; g < 8; ++g) s += red[(g * NB + b) * 64 + c];
                ((float*)(ws + WS_ADA))[((size_t)i * NB + b) * 3072 + cb * 64 + c] = s;
            }
        }
        __syncthreads();
    }
}

DI void phase_elem(const Params& P, LAS unsigned char* lds, int layer) {
    int tid_ = threadIdx.x; asm volatile("" : "+v"(tid_)); const int tid = tid_, wid = __builtin_amdgcn_readfirstlane(tid >> 6), lane = tid & 63, G = gridDim.x;
    unsigned char* ws = P.ws;
    const int j = layer >> 1;
    const bool gdn = (layer < 4) && !(layer & 1);
    LAS float* wab = (LAS float*)lds;
    if (gdn) {
        const float* Wp = P.in[12] + (size_t)j * 1024 * 4112 + 4096;
        for (int e = tid; e < 16384; e += 512) { const int k = e >> 4, c = e & 15; wab[c * 1024 + k] = Wp[(size_t)k * 4112 + c]; }
        __syncthreads();
    }
    const float* ada = (const float*)(ws + WS_ADA);
    float* X = P.out;
    const float* OUTB = (const float*)(ws + WS_PROJ);
    bf16_t* HB = (bf16_t*)(ws + WS_HBUF);
    float* AB = (float*)(ws + WS_AB);
    for (int r = blockIdx.x * 8 + wid; r < M; r += G * 8) {
        const int b = r < MP ? (r >> 13) : BP + ((r - MP) >> 4);
        const float* xs = (layer <= 1) ? (r < MP ? P.in[0] + (size_t)r * 1024 : P.in[1] + (size_t)(r - MP) * 1024) : X + (size_t)r * 1024;
        f32x4 x[4];
#pragma unroll
        for (int q = 0; q < 4; ++q) x[q] = *(const f32x4*)(xs + 4 * (lane + 64 * q));
        if (layer >= 1) {
            f32x4 o[4]; float ss = 0.f;
#pragma unroll
            for (int q = 0; q < 4; ++q) { o[q] = *(const f32x4*)(OUTB + (size_t)r * 1024 + 4 * (lane + 64 * q)); ss += o[q][0] * o[q][0] + o[q][1] * o[q][1] + o[q][2] * o[q][2] + o[q][3] * o[q][3]; }
            ss = wave_sum(ss);
            const float rstd = rsqrtf(ss * (1.f / 1024.f) + RMS_EPS);
            const float* gp = ada + ((size_t)(layer - 1) * NB + b) * 3072 + 2048;
            const float* np = P.in[9] + (layer - 1) * 1024;
#pragma unroll
            for (int q = 0; q < 4; ++q) {
                const int d = 4 * (lane + 64 * q);
                const f32x4 gt = *(const f32x4*)(gp + d), nw = *(const f32x4*)(np + d);
                x[q] = x[q] + gt * (o[q] * rstd * nw);
                *(f32x4*)(X + (size_t)r * 1024 + d) = x[q];
            }
        }
        if (layer < 4) {
            float ss = 0.f;
#pragma unroll
            for (int q = 0; q < 4; ++q) ss += x[q][0] * x[q][0] + x[q][1] * x[q][1] + x[q][2] * x[q][2] + x[q][3] * x[q][3];
            ss = wave_sum(ss);
            const float rstd = rsqrtf(ss * (1.f / 1024.f) + RMS_EPS);
            const float* ap = ada + ((size_t)layer * NB + b) * 3072;
            const float* np = P.in[8] + layer * 1024;
            f32x4 hv[4];
#pragma unroll
            for (int q = 0; q < 4; ++q) {
                const int d = 4 * (lane + 64 * q);
                const f32x4 sh = *(const f32x4*)(ap + d), sc = *(const f32x4*)(ap + 1024 + d), nw = *(const f32x4*)(np + d);
                hv[q] = (x[q] * rstd * nw) * (1.f + sc) + sh;
                u32x2 w; w.x = pk2(hv[q][0], hv[q][1]); w.y = pk2(hv[q][2], hv[q][3]);
                *(u32x2*)(HB + (size_t)r * 1024 + d) = w;
            }
            if (gdn) {
                float mine = 0.f;
#pragma unroll
                for (int c = 0; c < 16; ++c) {
                    float a = 0.f;
#pragma unroll
                    for (int q = 0; q < 4; ++q) { const f32x4 w4 = *(const LAS f32x4*)(wab + c * 1024 + 4 * (lane + 64 * q)); a += hv[q][0] * w4[0] + hv[q][1] * w4[1] + hv[q][2] * w4[2] + hv[q][3] * w4[3]; }
                    a = row_sum16(a);
                    if ((lane & 15) == c) mine = a;
                }
                mine += __shfl_xor(mine, 16); mine += __shfl_xor(mine, 32);
                if (lane < 16) AB[(size_t)r * 16 + lane] = mine;
            }
        }
    }
    if (layer < 4 && (layer & 1)) {
        const float* ck = P.in[6] + (size_t)j * 16 * PAST * 1024;
        const float* cv = P.in[7] + (size_t)j * 16 * PAST * 1024;
        bf16_t* KS = (bf16_t*)(ws + WS_KS); bf16_t* VS = (bf16_t*)(ws + WS_VS);
        const size_t nun = (size_t)16 * PAST * 128;
        for (size_t u = (size_t)blockIdx.x * 512 + tid; u < 2 * nun; u += (size_t)G * 512) {
            const bool isv = u >= nun; const size_t uu = isv ? u - nun : u;
            const size_t b = uu / ((size_t)PAST * 128), rem = uu % ((size_t)PAST * 128);
            const float* sp = (isv ? cv : ck) + uu * 8;
            const f32x4 a = *(const f32x4*)sp, c = *(const f32x4*)(sp + 4);
            u32x4 w; w.x = pk2(a[0], a[1]); w.y = pk2(a[2], a[3]); w.z = pk2(c[0], c[1]); w.w = pk2(c[2], c[3]);
            *(u32x4*)((isv ? VS : KS) + b * KSROWS * 1024 + rem * 8) = w;
        }
        const size_t npad = (size_t)16 * 48 * 128;
        for (size_t u = (size_t)blockIdx.x * 512 + tid; u < 2 * npad; u += (size_t)G * 512) {
            const bool isv = u >= npad; const size_t uu = isv ? u - npad : u;
            const size_t b = uu / (48 * 128), rem = uu % (48 * 128);
            *(u32x4*)((isv ? VS : KS) + (b * KSROWS + PAST + TS) * 1024 + rem * 8) = (u32x4){0u, 0u, 0u, 0u};
        }
    }
}

DI void phase_g1(const Params& P, LAS unsigned char* lds, int layer) {
    int tid_ = threadIdx.x; asm volatile("" : "+v"(tid_)); const int tid = tid_, wid = __builtin_amdgcn_readfirstlane(tid >> 6), lane = tid & 63, G = gridDim.x;
    const int fr = lane & 15, fq = lane >> 4;
    unsigned char* ws = P.ws;
    const int j = layer >> 1;
    const bf16_t* proj = (const bf16_t*)(ws + WS_PROJ);
    const float* AB = (const float*)(ws + WS_AB);
    float* GL = (float*)(ws + WS_GL);
    const float* convw = P.in[13] + (size_t)j * 4 * 3072;
    const float* cconv = P.in[5] + (size_t)j * 16 * 3 * 3072;
    LAS unsigned char* Qs = lds;
    LAS unsigned char* Ks = lds + 17408;
    LAS unsigned char* VBt = lds + 34816;
    LAS unsigned char* KBt = lds + 53248;
    LAS float* A32 = (LAS float*)(lds + 71680);
    LAS unsigned char* Ts = lds + 88320;
    LAS unsigned char* QKs = lds + 97536;
    LAS float* Gs = (LAS float*)(lds + 105728);

    for (int item = blockIdx.x; item < NITEM; item += G) {
        int b, h, c, row0, nvalid; bool sample;
        if (item < NITEM_P) { const int seq = item >> 7; b = seq >> 3; h = seq & 7; c = item & 127; row0 = b * TP + 64 * c; nvalid = 64; sample = false; }
        else { const int s = item - NITEM_P; b = s >> 3; h = s & 7; c = 0; row0 = MP + b * TS; nvalid = TS; sample = true; }
        unsigned char* ib = ws + WS_R1 + (size_t)item * ITEM_BYTES;
        float val[8][8];
        float rn[8];
        int tido = tid; asm volatile("" : "+v"(tido));
        const int l16 = tido & 15, grp = tido >> 4, part = grp >> 3, rb = grp & 7;
        const int lane = tido & 63, fr = lane & 15, fq = lane >> 4;
        if (tid < 384) {
            const int ch = part * 1024 + h * 128 + 8 * l16;
            float wv[4][8];
#pragma unroll
            for (int t = 0; t < 4; ++t) {
                const f32x4 a = *(const f32x4*)(convw + t * 3072 + ch), bb = *(const f32x4*)(convw + t * 3072 + ch + 4);
                wv[t][0] = a[0]; wv[t][1] = a[1]; wv[t][2] = a[2]; wv[t][3] = a[3]; wv[t][4] = bb[0]; wv[t][5] = bb[1]; wv[t][6] = bb[2]; wv[t][7] = bb[3];
            }
            float win[4][8];
#pragma unroll
            for (int t = 0; t < 4; ++t)
#pragma unroll
                for (int e = 0; e < 8; ++e) win[t][e] = 0.f;
#pragma unroll
            for (int k = 0; k < 11; ++k) {
                const int lr = 8 * rb - 3 + k;
                float in8[8];
                {
                    const bool use_proj = (lr >= 0 && lr < nvalid) || (lr < 0 && !sample && c > 0);
                    const int lrc = use_proj ? lr : 0;
                    const u32x4 v = *(const u32x4*)(proj + (size_t)(row0 + lrc) * NPROJ + ch);
                    unpack8(v, in8);
                    if (!use_proj) {
#pragma unroll
                        for (int e = 0; e < 8; ++e) in8[e] = 0.f;
                    }
                }
                if (k < 3) {
                    if (sample && lr < 0) {
                        const float* sp = cconv + (size_t)(b * 3 + (3 + lr)) * 3072 + ch;
                        const f32x4 a = *(const f32x4*)sp, bb = *(const f32x4*)(sp + 4);
                        in8[0] = a[0]; in8[1] = a[1]; in8[2] = a[2]; in8[3] = a[3]; in8[4] = bb[0]; in8[5] = bb[1]; in8[6] = bb[2]; in8[7] = bb[3];
                    }
                }
#pragma unroll
                for (int e = 0; e < 8; ++e) { win[0][e] = win[1][e]; win[1][e] = win[2][e]; win[2][e] = win[3][e]; win[3][e] = in8[e]; }
                if (k >= 3) {
                    const bool rv = (lr < nvalid);
                    float ss = 0.f;
#pragma unroll
                    for (int e = 0; e < 8; ++e) {
                        const float y = win[0][e] * wv[0][e] + win[1][e] * wv[1][e] + win[2][e] * wv[2][e] + win[3][e] * wv[3][e];
                        const float s = rv ? siluf(y) : 0.f;
                        val[k - 3][e] = s; ss += s * s;
                    }
                    ss = row_sum16(ss);
                    rn[k - 3] = rsqrtf(ss + 1e-6f);
                }
            }
        } else if (wid == 7) {
            const int r = row0 + (lane < nvalid ? lane : 0);
            const bool valid = lane < nvalid;
            const float a = AB[(size_t)r * 16 + h], bb = AB[(size_t)r * 16 + 8 + h];
            const float xa = a + P.in[15][j * 8 + h];
            const float sp = xa > 20.f ? xa : log1pf(__expf(xa));
            float g = valid ? -__expf(P.in[14][j * 8 + h]) * sp : 0.f;
            const float beta = valid ? 1.f / (1.f + __expf(-bb)) : 0.f;
#pragma unroll
            for (int o = 1; o < 64; o <<= 1) { const float t = __shfl_up(g, o); if (lane >= o) g += t; }
            const float glast = readlane_f(g, 63);
            Gs[lane] = g; Gs[64 + lane] = beta; Gs[128 + lane] = __expf(g); Gs[192 + lane] = __expf(glast - g);
            if (lane == 0) GL[item] = __expf(glast);
        }
        __syncthreads();
        if (tid < 384) {
#pragma unroll
            for (int rr = 0; rr < 8; ++rr) {
                const int row = 8 * rb + rr;
                const float beta = Gs[64 + row], eG = Gs[128 + row];
                if (part == 0) {
                    const float sc = rn[rr] * 0.08838834764831845f;
                    float q[8];
#pragma unroll
                    for (int e = 0; e < 8; ++e) q[e] = val[rr][e] * sc;
                    u32x4 w; w.x = pk2(q[0], q[1]); w.y = pk2(q[2], q[3]); w.z = pk2(q[4], q[5]); w.w = pk2(q[6], q[7]);
                    *(LAS u32x4*)(Qs + row * 272 + l16 * 16) = w;
                    bf16_t* qg = (bf16_t*)(ib + 49152) + row * 128;
                    u32x2 g0, g1; g0.x = pk2(q[0] * eG, q[1] * eG); g0.y = pk2(q[2] * eG, q[3] * eG); g1.x = pk2(q[4] * eG, q[5] * eG); g1.y = pk2(q[6] * eG, q[7] * eG);
                    *(u32x2*)(qg + ppos(8 * l16)) = g0; *(u32x2*)(qg + ppos(8 * l16 + 4)) = g1;
                    val[rr][0] = 0.f;
                } else if (part == 1) {
#pragma unroll
                    for (int e = 0; e < 8; ++e) val[rr][e] *= rn[rr];
                    u32x4 w; w.x = pk2(val[rr][0], val[rr][1]); w.y = pk2(val[rr][2], val[rr][3]); w.z = pk2(val[rr][4], val[rr][5]); w.w = pk2(val[rr][6], val[rr][7]);
                    *(LAS u32x4*)(Ks + row * 272 + l16 * 16) = w;
                }
            }
            if (part >= 1) {
                float bsc[8], ksc[8];
#pragma unroll
                for (int rr = 0; rr < 8; ++rr) { const int row = 8 * rb + rr; const float beta = Gs[64 + row]; bsc[rr] = (part == 1) ? beta * Gs[128 + row] : beta; ksc[rr] = Gs[192 + row]; }
                LAS unsigned char* Tt = (part == 1) ? KBt : VBt;
#pragma unroll
                for (int e = 0; e < 8; ++e) {
                    const int dch = 8 * l16 + e;
                    u32x4 w; w.x = pk2(val[0][e] * bsc[0], val[1][e] * bsc[1]); w.y = pk2(val[2][e] * bsc[2], val[3][e] * bsc[3]);
                    w.z = pk2(val[4][e] * bsc[4], val[5][e] * bsc[5]); w.w = pk2(val[6][e] * bsc[6], val[7][e] * bsc[7]);
                    *(LAS u32x4*)(Tt + dch * 144 + rb * 16) = w;
                    if (part == 1) {
                        bf16_t* kd = (bf16_t*)(ib + 65536) + dch * 64;
                        u32x2 k0, k1; k0.x = pk2(val[0][e] * ksc[0], val[1][e] * ksc[1]); k0.y = pk2(val[2][e] * ksc[2], val[3][e] * ksc[3]);
                        k1.x = pk2(val[4][e] * ksc[4], val[5][e] * ksc[5]); k1.y = pk2(val[6][e] * ksc[6], val[7][e] * ksc[7]);
                        *(u32x2*)(kd + ppos(8 * rb)) = k0; *(u32x2*)(kd + ppos(8 * rb + 4)) = k1;
                    }
                }
            }
        }
        __syncthreads();
        {
            const int mt = wid & 3; const bool isqk = wid >= 4;
            LAS unsigned char* As = isqk ? Qs : Ks;
            f32x4 acc[4];
#pragma unroll
            for (int nt = 0; nt < 4; ++nt) acc[nt] = (f32x4){0.f, 0.f, 0.f, 0.f};
#pragma unroll
            for (int ks = 0; ks < 4; ++ks) {
                const bf16x8 a = *(const LAS bf16x8*)(As + (16 * mt + fr) * 272 + (32 * ks + 8 * fq) * 2);
#pragma unroll
                for (int nt = 0; nt < 4; ++nt) {
                    const bf16x8 bfr = *(const LAS bf16x8*)(Ks + (16 * nt + fr) * 272 + (32 * ks + 8 * fq) * 2);
                    acc[nt] = MFMA16(a, bfr, acc[nt]);
                }
            }
#pragma unroll
            for (int nt = 0; nt < 4; ++nt) {
                const int cp = 16 * nt + fr; const float Gc2 = Gs[cp];
#pragma unroll
                for (int i = 0; i < 4; ++i) {
                    const int cr = 16 * mt + 4 * fq + i;
                    const float dec = __expf(Gs[cr] - Gc2);
                    if (!isqk) A32[cr * 65 + cp] = (cr > cp) ? Gs[64 + cr] * acc[nt][i] * dec : 0.f;
                    else *(LAS bf16_t*)(QKs + (cr * 64 + ppos(cp)) * 2) = f2bf((cr >= cp) ? acc[nt][i] * dec : 0.f);
                }
            }
        }
        __syncthreads();
        {
            float a[64];
#pragma unroll
            for (int jj = 0; jj < 64; ++jj) a[jj] = A32[lane * 65 + jj];
            float x[8];
#pragma unroll
            for (int cc = 0; cc < 8; ++cc) x[cc] = (lane == 8 * wid + cc) ? 1.f : 0.f;
#pragma unroll
            for (int jj = 0; jj < 64; ++jj) {
                if (jj >= 8 * wid) {
#pragma unroll
                    for (int cc = 0; cc < 8; ++cc) { const float xj = readlane_f(x[cc], jj); x[cc] -= a[jj] * xj; }
                }
            }
            u32x4 w; w.x = pk2(x[0], x[1]); w.y = pk2(x[2], x[3]); w.z = pk2(x[4], x[5]); w.w = pk2(x[6], x[7]);
            *(LAS u32x4*)(Ts + lane * 144 + wid * 16) = w;
            *(u32x4*)(ib + 81920 + tid * 16) = *(const LAS u32x4*)(QKs + tid * 16);
        }
        __syncthreads();
        {
            const bool isw = wid >= 4; const int n0 = 32 * (wid & 3);
            LAS unsigned char* Bs = isw ? KBt : VBt;
            f32x4 acc[4][2];
#pragma unroll
            for (int mt = 0; mt < 4; ++mt) { acc[mt][0] = (f32x4){0.f, 0.f, 0.f, 0.f}; acc[mt][1] = (f32x4){0.f, 0.f, 0.f, 0.f}; }
#pragma unroll
            for (int ks = 0; ks < 2; ++ks) {
                bf16x8 bfr[2];
#pragma unroll
                for (int nn = 0; nn < 2; ++nn) bfr[nn] = *(const LAS bf16x8*)(Bs + (n0 + 16 * nn + fr) * 144 + (32 * ks + 8 * fq) * 2);
#pragma unroll
                for (int mt = 0; mt < 4; ++mt) {
                    const bf16x8 a = *(const LAS bf16x8*)(Ts + (16 * mt + fr) * 144 + (32 * ks + 8 * fq) * 2);
                    acc[mt][0] = MFMA16(a, bfr[0], acc[mt][0]); acc[mt][1] = MFMA16(a, bfr[1], acc[mt][1]);
                }
            }
            if (!isw) {
                float* U = (float*)ib;
#pragma unroll
                for (int mt = 0; mt < 4; ++mt)
#pragma unroll
                    for (int nn = 0; nn < 2; ++nn)
#pragma unroll
                        for (int i = 0; i < 4; ++i) U[(16 * mt + 4 * fq + i) * 128 + n0 + 16 * nn + fr] = acc[mt][nn][i];
            } else {
#pragma unroll
                for (int mt = 0; mt < 4; ++mt)
#pragma unroll
                    for (int nn = 0; nn < 2; ++nn)
#pragma unroll
                        for (int i = 0; i < 4; ++i) *(LAS bf16_t*)(Qs + ((16 * mt + 4 * fq + i) * 128 + ppos(n0 + 16 * nn + fr)) * 2) = f2bf(acc[mt][nn][i]);
            }
        }
        __syncthreads();
        {
            *(u32x4*)(ib + 32768 + tid * 16) = *(const LAS u32x4*)(Qs + tid * 16);
            *(u32x4*)(ib + 32768 + 8192 + tid * 16) = *(const LAS u32x4*)(Qs + 8192 + tid * 16);
        }
        __syncthreads();
    }
}

DI void phase_scan(const Params& P, LAS unsigned char* lds, int layer) {
    int tid_ = threadIdx.x; asm volatile("" : "+v"(tid_)); const int tid = tid_, wid = __builtin_amdgcn_readfirstlane(tid >> 6), lane = tid & 63, G = gridDim.x;
    const int fr = lane & 15, fq = lane >> 4;
    unsigned char* ws = P.ws;
    const int j = layer >> 1;
    const bf16_t* proj = (const bf16_t*)(ws + WS_PROJ);
    const float* GL = (const float*)(ws + WS_GL);
    bf16_t* OB = (bf16_t*)(ws + WS_HBUF);
    constexpr int BUFB = 57344;
    LAS float* red = (LAS float*)(lds + 2 * BUFB);

    for (int seq = blockIdx.x; seq < 160; seq += G) {
        int b, h, nch, item0, row0, nvalid; float* stout;
        f32x4 st[8];
        const int dvc = 16 * wid + fr;
        if (seq < 32) {
            b = seq >> 3; h = seq & 7; nch = 128; item0 = seq * 128; row0 = b * TP; nvalid = 64;
            stout = P.out + OFF_STP + ((size_t)(j * 4 + b) * 8 + h) * 16384;
#pragma unroll
            for (int mt = 0; mt < 8; ++mt) st[mt] = (f32x4){0.f, 0.f, 0.f, 0.f};
        } else {
            const int s = seq - 32; b = s >> 3; h = s & 7; nch = 1; item0 = NITEM_P + s; row0 = MP + b * TS; nvalid = TS;
            stout = P.out + OFF_STS + ((size_t)(j * 16 + b) * 8 + h) * 16384;
            const float* s0 = P.in[4] + ((size_t)(j * 16 + b) * 8 + h) * 16384;
#pragma unroll
            for (int mt = 0; mt < 8; ++mt)
#pragma unroll
                for (int i = 0; i < 4; ++i) st[mt][i] = s0[(16 * mt + 4 * fq + i) * 128 + dvc];
        }
        const float onw = P.in[16][j * 128 + dvc];
        f32x4 un[4];
#define SCAN_G2L(itm, bufi) do { const unsigned char* _ib = ws + WS_R1 + (size_t)(itm) * ITEM_BYTES + 32768; \
            _Pragma("unroll") for (int _p = 0; _p < 7; ++_p) { const int _L = (wid + 8 * _p) * 1024 + lane * 16; int _src; \
                if (_p < 4) { const int _row = _L >> 8, _ch = (_L >> 4) & 15; _src = (_L & ~255) + ((_ch ^ (_row & 15)) << 4); } \
                else { const int _a = _L - 32768, _row = _a >> 7, _ch = (_a >> 4) & 7; _src = 32768 + (_a & ~127) + ((_ch ^ ((_row >> 1) & 7)) << 4); } \
                __builtin_amdgcn_global_load_lds((const unsigned*)(_ib + _src), (LAS unsigned*)(lds + (bufi) * BUFB + (wid + 8 * _p) * 1024), 16, 0, 0); } } while (0)
#define SCAN_LOADU(itm) do { const float* _u = (const float*)(ws + WS_R1 + (size_t)(itm) * ITEM_BYTES); \
            _Pragma("unroll") for (int _m = 0; _m < 4; ++_m) _Pragma("unroll") for (int _i = 0; _i < 4; ++_i) un[_m][_i] = _u[(16 * _m + 4 * fq + _i) * 128 + dvc]; } while (0)
        __syncthreads();
        SCAN_G2L(item0, 0);
        SCAN_LOADU(item0);
        float gln = GL[item0];
        __syncthreads();
        for (int c = 0; c < nch; ++c) {
            int frq = lane; asm volatile("" : "+v"(frq));
            const int fr = frq & 15, fq = frq >> 4;
            LAS unsigned char* bb = lds + (c & 1) * BUFB;
            unsigned short zr[4][4];
#pragma unroll
            for (int mt = 0; mt < 4; ++mt)
#pragma unroll
                for (int i = 0; i < 4; ++i) { const int lr = 16 * mt + 4 * fq + i; const int lrc = (lr < nvalid) ? lr : 0; zr[mt][i] = proj[(size_t)(row0 + 64 * c + lrc) * NPROJ + 3072 + h * 128 + dvc]; }
            const float gl = gln;
            f32x4 u[4];
#pragma unroll
            for (int mt = 0; mt < 4; ++mt) u[mt] = un[mt];
            if (c + 1 < nch) { gln = GL[item0 + c + 1]; SCAN_G2L(item0 + c + 1, (c + 1) & 1); SCAN_LOADU(item0 + c + 1); }
            const int x16 = fr << 4, x8 = ((fr >> 1) & 7) << 4;
            bf16x8 sf[4];
#pragma unroll
            for (int ks = 0; ks < 4; ++ks) {
                u32x4 w; w.x = pk2(-st[2 * ks][0], -st[2 * ks][1]); w.y = pk2(-st[2 * ks][2], -st[2 * ks][3]); w.z = pk2(-st[2 * ks + 1][0], -st[2 * ks + 1][1]); w.w = pk2(-st[2 * ks + 1][2], -st[2 * ks + 1][3]);
                sf[ks] = __builtin_bit_cast(bf16x8, w);
            }
#pragma unroll
            for (int mt = 0; mt < 4; ++mt) {
#pragma unroll
                for (int ks = 0; ks < 4; ++ks) {
                    const bf16x8 aw = *(const LAS bf16x8*)(bb + (16 * mt + fr) * 256 + ((((4 * ks + fq) << 4)) ^ x16));
                    u[mt] = MFMA16(aw, sf[ks], u[mt]);
                }
            }
            __builtin_amdgcn_sched_barrier(0);
#pragma unroll
            for (int ks = 0; ks < 4; ++ks) sf[ks] = sf[ks] ^ (short)0x8000;
            f32x4 o[4];
#pragma unroll
            for (int mt = 0; mt < 4; ++mt) {
                o[mt] = (f32x4){0.f, 0.f, 0.f, 0.f};
#pragma unroll
                for (int ks = 0; ks < 4; ++ks) {
                    const bf16x8 aq = *(const LAS bf16x8*)(bb + 16384 + (16 * mt + fr) * 256 + ((((4 * ks + fq) << 4)) ^ x16));
                    o[mt] = MFMA16(aq, sf[ks], o[mt]);
                }
            }
            __builtin_amdgcn_sched_barrier(0);
            bf16x8 uf[2];
#pragma unroll
            for (int k2 = 0; k2 < 2; ++k2) {
                u32x4 w; w.x = pk2(u[2 * k2][0], u[2 * k2][1]); w.y = pk2(u[2 * k2][2], u[2 * k2][3]); w.z = pk2(u[2 * k2 + 1][0], u[2 * k2 + 1][1]); w.w = pk2(u[2 * k2 + 1][2], u[2 * k2 + 1][3]);
                uf[k2] = __builtin_bit_cast(bf16x8, w);
            }
#pragma unroll
            for (int mt = 0; mt < 4; ++mt)
#pragma unroll
                for (int k2 = 0; k2 < 2; ++k2) {
                    const bf16x8 a = *(const LAS bf16x8*)(bb + 49152 + (16 * mt + fr) * 128 + (((4 * k2 + fq) << 4) ^ x8));
                    o[mt] = MFMA16(a, uf[k2], o[mt]);
                }
#pragma unroll
            for (int mt = 0; mt < 8; ++mt) {
                st[mt] = st[mt] * gl;
#pragma unroll
                for (int k2 = 0; k2 < 2; ++k2) {
                    const bf16x8 a = *(const LAS bf16x8*)(bb + 32768 + (16 * mt + fr) * 128 + (((4 * k2 + fq) << 4) ^ x8));
                    st[mt] = MFMA16(a, uf[k2], st[mt]);
                }
            }
            LAS float* rd = red + (c & 1) * 512;
#pragma unroll
            for (int mt = 0; mt < 4; ++mt)
#pragma unroll
                for (int i = 0; i < 4; ++i) {
                    const float ss = row_sum16(o[mt][i] * o[mt][i]);
                    if (fr == 0) rd[(16 * mt + 4 * fq + i) * 8 + wid] = ss;
                }
            __syncthreads();
#pragma unroll
            for (int mt = 0; mt < 4; ++mt)
#pragma unroll
                for (int i = 0; i < 4; ++i) {
                    const int lr = 16 * mt + 4 * fq + i;
                    const f32x4 p0 = *(const LAS f32x4*)(rd + lr * 8), p1 = *(const LAS f32x4*)(rd + lr * 8 + 4);
                    const float ss = p0[0] + p0[1] + p0[2] + p0[3] + p1[0] + p1[1] + p1[2] + p1[3];
                    const float rstd = rsqrtf(ss * (1.f / 128.f) + RMS_EPS);
                    const float ov = o[mt][i] * rstd * onw * siluf(bf2f(zr[mt][i]));
                    if (lr < nvalid) OB[(size_t)(row0 + 64 * c + lr) * 1024 + h * 128 + dvc] = f2bf(ov);
                }
        }
#pragma unroll
        for (int mt = 0; mt < 8; ++mt)
#pragma unroll
            for (int i = 0; i < 4; ++i) stout[(16 * mt + 4 * fq + i) * 128 + dvc] = st[mt][i];
#undef SCAN_G2L
#undef SCAN_LOADU
    }
}

DI void phase_attn(const Params& P, LAS unsigned char* lds, int layer) {
    int tid_ = threadIdx.x; asm volatile("" : "+v"(tid_)); const int tid = tid_, wid = __builtin_amdgcn_readfirstlane(tid >> 6), lane = tid & 63, G = gridDim.x;
    unsigned char* ws = P.ws;
    const int j = layer >> 1;
    const int comp = wid >> 2, rg = wid & 3, r32 = lane & 31, h2 = lane >> 5;
    const int q4 = (lane & 15) >> 2, p4 = lane & 3, blk = (lane >> 4) & 1;
    const bf16_t* proj = (const bf16_t*)(ws + WS_PROJ);
    bf16_t* OB = (bf16_t*)(ws + WS_HBUF);
    const float lam_init = 0.8f - 0.6f * expf(-0.3f * (float)layer);
    float lam;
    {
        float d1 = 0.f, d2 = 0.f;
        for (int i = 0; i < 64; ++i) { d1 += P.in[19][j * 64 + i] * P.in[20][j * 64 + i]; d2 += P.in[21][j * 64 + i] * P.in[22][j * 64 + i]; }
        lam = expf(d1) - expf(d2) + lam_init;
    }
    const float* subln = P.in[23] + j * 128;
    constexpr int TB = 35840;
    const int vb = (G % 8 == 0) ? (blockIdx.x % 8) * (G / 8) + blockIdx.x / 8 : blockIdx.x;
    const int nrounds = (G == 256) ? 9 : (2176 + G - 1) / G;
    for (int k = 0; k < nrounds; ++k) {
        int id;
        if (G == 256) {
            if (k < 8) { const int seq = vb >> 3, sub = vb & 7; const int qt = (k & 1) ? (16 * (k >> 1) + 15 - sub) : (16 * (k >> 1) + sub); id = seq * 64 + qt; }
            else { if (vb >= 128) break; id = 2048 + vb; }
        } else { id = vb + k * G; if (id >= 2176) break; }
        int h, qrow0, nt_all, nt_mine, last_valid, kvstride; const bf16_t* Kp; const bf16_t* Vp; bool sample;
        if (id < 2048) {
            const int seq = id >> 6, qt = id & 63, b = seq >> 3; h = seq & 7; sample = false;
            qrow0 = b * TP + 128 * qt + 32 * rg; nt_all = 2 * qt + 2; nt_mine = (rg < 2) ? 2 * qt + 1 : 2 * qt + 2; last_valid = 64; kvstride = NPROJ;
            Kp = proj + (size_t)(b * TP) * NPROJ + 1024 + h * 128; Vp = proj + (size_t)(b * TP) * NPROJ + 2048 + h * 128;
        } else {
            const int s = id - 2048, b = s >> 3; h = s & 7; sample = true;
            qrow0 = MP + b * TS; nt_all = 33; nt_mine = (rg == 0) ? 33 : 0; last_valid = 16; kvstride = 1024;
            Kp = (const bf16_t*)(ws + WS_KS) + (size_t)b * KSROWS * 1024 + h * 128; Vp = (const bf16_t*)(ws + WS_VS) + (size_t)b * KSROWS * 1024 + h * 128;
        }
        bf16x8 qf[4];
        {
            const int qr = qrow0 + (sample ? (r32 & 15) : r32);
            const bf16_t* qp = proj + (size_t)qr * NPROJ + h * 128 + comp * 64 + 8 * h2;
#pragma unroll
            for (int s = 0; s < 4; ++s) qf[s] = *(const bf16x8*)(qp + 16 * s);
        }
        f32x16 O[4];
#pragma unroll
        for (int et = 0; et < 4; ++et)
#pragma unroll
            for (int i = 0; i < 16; ++i) O[et][i] = 0.f;
        float m = -INFINITY, l = 0.f;
        u32x4 pk[2], pv[2];
#define ATT_LOAD(kt) do { _Pragma("unroll") for (int _p = 0; _p < 2; ++_p) { const int _cid = tid + 512 * _p, _row = _cid >> 4, _ch = _cid & 15; \
            pk[_p] = *(const u32x4*)(Kp + (size_t)(64 * (kt) + _row) * kvstride + _ch * 8); pv[_p] = *(const u32x4*)(Vp + (size_t)(64 * (kt) + _row) * kvstride + _ch * 8); } } while (0)
#define ATT_STORE(bufi) do { LAS unsigned char* _bb = lds + (bufi) * TB; _Pragma("unroll") for (int _p = 0; _p < 2; ++_p) { const int _cid = tid + 512 * _p, _row = _cid >> 4, _ch = _cid & 15; \
            *(LAS u32x4*)(_bb + _row * 272 + _ch * 16) = pk[_p]; *(LAS u32x4*)(_bb + 17408 + _row * 288 + _ch * 16) = pv[_p]; } } while (0)
        ATT_LOAD(0);
        ATT_STORE(0);
        __syncthreads();
        for (int kt = 0; kt < nt_all; ++kt) {
            if (kt + 1 < nt_all) ATT_LOAD(kt + 1);
            if (kt < nt_mine) {
                LAS unsigned char* Kb = lds + (kt & 1) * TB; LAS unsigned char* Vb = Kb + 17408;
                f32x16 s0, s1;
#pragma unroll
                for (int i = 0; i < 16; ++i) { s0[i] = 0.f; s1[i] = 0.f; }
#pragma unroll
                for (int s = 0; s < 4; ++s) {
                    const bf16x8 k0 = *(const LAS bf16x8*)(Kb + r32 * 272 + (comp * 64 + 16 * s + 8 * h2) * 2);
                    const bf16x8 k1 = *(const LAS bf16x8*)(Kb + (32 + r32) * 272 + (comp * 64 + 16 * s + 8 * h2) * 2);
                    s0 = MFMA32(k0, qf[s], s0); s1 = MFMA32(k1, qf[s], s1);
                }
                if (kt == nt_all - 1 && last_valid < 64) {
#pragma unroll
                    for (int i = 0; i < 16; ++i) {
                        const int key = (i & 3) + 8 * (i >> 2) + 4 * h2;
                        if (key >= last_valid) s0[i] = -INFINITY;
                        if (32 + key >= last_valid) s1[i] = -INFINITY;
                    }
                }
                float mx = s0[0];
#pragma unroll
                for (int i = 1; i < 16; ++i) mx = fmaxf(mx, s0[i]);
#pragma unroll
                for (int i = 0; i < 16; ++i) mx = fmaxf(mx, s1[i]);
                mx = fmaxf(mx, __shfl_xor(mx, 32));
                const float mn = fmaxf(m, mx);
                if (__any(mn > m)) {
                    const float alpha = __builtin_amdgcn_exp2f(m - mn);
                    l *= alpha;
#pragma unroll
                    for (int et = 0; et < 4; ++et)
#pragma unroll
                        for (int i = 0; i < 16; ++i) O[et][i] *= alpha;
                    m = mn;
                }
                float ps = 0.f;
#pragma unroll
                for (int i = 0; i < 16; ++i) { s0[i] = __builtin_amdgcn_exp2f(s0[i] - m); s1[i] = __builtin_amdgcn_exp2f(s1[i] - m); ps += s0[i] + s1[i]; }
                l += ps;
                bf16x8 pf[2][2];
                {
                    u32x4 w;
                    w.x = pk2(s0[0], s0[1]); w.y = pk2(s0[2], s0[3]); w.z = pk2(s0[4], s0[5]); w.w = pk2(s0[6], s0[7]); pf[0][0] = __builtin_bit_cast(bf16x8, w);
                    w.x = pk2(s0[8], s0[9]); w.y = pk2(s0[10], s0[11]); w.z = pk2(s0[12], s0[13]); w.w = pk2(s0[14], s0[15]); pf[0][1] = __builtin_bit_cast(bf16x8, w);
                    w.x = pk2(s1[0], s1[1]); w.y = pk2(s1[2], s1[3]); w.z = pk2(s1[4], s1[5]); w.w = pk2(s1[6], s1[7]); pf[1][0] = __builtin_bit_cast(bf16x8, w);
                    w.x = pk2(s1[8], s1[9]); w.y = pk2(s1[10], s1[11]); w.z = pk2(s1[12], s1[13]); w.w = pk2(s1[14], s1[15]); pf[1][1] = __builtin_bit_cast(bf16x8, w);
                }
#pragma unroll
                for (int kt2 = 0; kt2 < 2; ++kt2)
#pragma unroll
                    for (int s2 = 0; s2 < 2; ++s2) {
                        const int keyrow = 32 * kt2 + 16 * s2 + 4 * h2 + q4;
#pragma unroll
                        for (int et = 0; et < 4; ++et) {
                            const s16x4 lo = __builtin_amdgcn_ds_read_tr16_b64_v4i16((LAS s16x4*)(Vb + keyrow * 288 + (32 * et + 16 * blk) * 2 + 8 * p4));
                            const s16x4 hi = __builtin_amdgcn_ds_read_tr16_b64_v4i16((LAS s16x4*)(Vb + (keyrow + 8) * 288 + (32 * et + 16 * blk) * 2 + 8 * p4));
                            const bf16x8 vf = __builtin_shufflevector(lo, hi, 0, 1, 2, 3, 4, 5, 6, 7);
                            O[et] = MFMA32(vf, pf[kt2][s2], O[et]);
                        }
                    }
            }
            if (kt + 1 < nt_all) ATT_STORE((kt + 1) & 1);
            __syncthreads();
        }
#undef ATT_LOAD
#undef ATT_STORE
        const float lt = l + __shfl_xor(l, 32);
        const float inv = (nt_mine > 0) ? 1.f / lt : 0.f;
        LAS float* XO = (LAS float*)lds;
        if (comp == 1) {
            const float sc = inv * lam;
#pragma unroll
            for (int et = 0; et < 4; ++et)
#pragma unroll
                for (int i = 0; i < 16; ++i) XO[(rg * 128 + 32 * et + (i & 3) + 8 * (i >> 2) + 4 * h2) * 32 + r32] = O[et][i] * sc;
        }
        __syncthreads();
        if (comp == 0 && nt_mine > 0) {
            float ss = 0.f;
#pragma unroll
            for (int et = 0; et < 4; ++et)
#pragma unroll
                for (int i = 0; i < 16; ++i) { const float v = O[et][i] * inv - XO[(rg * 128 + 32 * et + (i & 3) + 8 * (i >> 2) + 4 * h2) * 32 + r32]; O[et][i] = v; ss += v * v; }
            ss += __shfl_xor(ss, 32);
            const float rstd = rsqrtf(ss * (1.f / 128.f) + RMS_EPS) * (1.f - lam_init);
            const bool rvalid = sample ? (r32 < TS) : true;
            const int row = qrow0 + r32;
            if (rvalid) {
#pragma unroll
                for (int et = 0; et < 4; ++et)
#pragma unroll
                    for (int g4 = 0; g4 < 4; ++g4) {
                        const int e0 = 32 * et + 8 * g4 + 4 * h2;
                        const u32x2 zz = *(const u32x2*)(proj + (size_t)row * NPROJ + 3072 + h * 128 + e0);
                        const f32x4 sl = *(const f32x4*)(subln + e0);
                        const float z0 = __uint_as_float(zz.x << 16), z1 = __uint_as_float(zz.x & 0xffff0000u), z2 = __uint_as_float(zz.y << 16), z3 = __uint_as_float(zz.y & 0xffff0000u);
                        u32x2 w;
                        w.x = pk2(O[et][4 * g4] * rstd * sl[0] * siluf(z0), O[et][4 * g4 + 1] * rstd * sl[1] * siluf(z1));
                        w.y = pk2(O[et][4 * g4 + 2] * rstd * sl[2] * siluf(z2), O[et][4 * g4 + 3] * rstd * sl[3] * siluf(z3));
                        *(u32x2*)(OB + (size_t)row * 1024 + h * 128 + e0) = w;
                    }
            }
        }
        __syncthreads();
    }
}

typedef const __attribute__((address_space(4))) Params* CParP;
#define LOADP() Params P; { CParP kp_ = KP; asm volatile("" : "+s"(kp_)); P = *kp_; } unsigned char* ws = P.ws; (void)ws
__global__ void __launch_bounds__(512, 2) fwd_megakernel(Params Pin) {
#if defined(__HIP_DEVICE_COMPILE__)
    extern __shared__ __attribute__((aligned(16))) unsigned char lds_raw[];
    LAS unsigned char* lds = (LAS unsigned char*)lds_raw;
    cg::grid_group grid = cg::this_grid();
    const CParP KP = (CParP)__builtin_amdgcn_kernarg_segment_ptr();
    for (int rep = opaque_i(REP_PREP); rep > 0; --rep) { LOADP(); phase_prep(P, lds); }
    grid.sync();
    for (int layer = 0; layer < 4; ++layer) {
        const int j = layer >> 1;
        { LOADP(); phase_elem(P, lds, layer); }
        grid.sync();
        for (int rep = opaque_i(REP_GIN); rep > 0; --rep) {
            LOADP();
            pg8::StaticOrder S; S.init(M, NPROJ, gridDim.x, blockIdx.x);
            pg8::Gemm g;
            g.A = (const bf16_t*)(ws + WS_HBUF); g.M = M; g.N = NPROJ; g.K = 1024;
            if (!(layer & 1)) {
                g.Bt = (const bf16_t*)(ws + WS_WING) + (size_t)j * 4096 * 1024;
                EpiGdnIn E; E.proj = (bf16_t*)(ws + WS_PROJ); E.conv_p = P.out + OFF_CVP + (size_t)j * 4 * 3 * 3072; E.conv_s = P.out + OFF_CVS + (size_t)j * 16 * 3 * 3072;
                pg8::gemm_phase(lds, g, S, E);
            } else {
                g.Bt = (const bf16_t*)(ws + WS_WIND) + (size_t)j * 4096 * 1024;
                EpiDiffIn E; E.proj = (bf16_t*)(ws + WS_PROJ);
                E.k_p = P.out + OFF_KP + (size_t)j * MP * 1024; E.v_p = P.out + OFF_VP + (size_t)j * MP * 1024;
                E.k_s = P.out + OFF_KSO + (size_t)j * MS * 1024; E.v_s = P.out + OFF_VSO + (size_t)j * MS * 1024;
                E.ks = (bf16_t*)(ws + WS_KS); E.vs = (bf16_t*)(ws + WS_VS); E.rope = (const float*)(ws + WS_ROPE);
                pg8::gemm_phase(lds, g, S, E);
            }
        }
        grid.sync();
        if (!(layer & 1)) {
            for (int rep = opaque_i(REP_G1); rep > 0; --rep) { LOADP(); phase_g1(P, lds, layer); }
            grid.sync();
            for (int rep = opaque_i(REP_SCAN); rep > 0; --rep) { LOADP(); phase_scan(P, lds, layer); }
        } else {
            for (int rep = opaque_i(REP_ATTN); rep > 0; --rep) { LOADP(); phase_attn(P, lds, layer); }
        }
        grid.sync();
        for (int rep = opaque_i(REP_GOUT); rep > 0; --rep) {
            LOADP();
            pg8::StaticOrder S; S.init(M, 1024, gridDim.x, blockIdx.x);
            pg8::Gemm g;
            g.A = (const bf16_t*)(ws + WS_HBUF); g.M = M; g.N = 1024; g.K = 1024;
            g.Bt = (const bf16_t*)(ws + ((layer & 1) ? WS_WOUTD : WS_WOUTG)) + (size_t)j * 1024 * 1024;
            EpiOut E; E.C = (float*)(ws + WS_PROJ);
            pg8::gemm_phase(lds, g, S, E);
        }
        grid.sync();
    }
    { LOADP(); phase_elem(P, lds, 4); }
#endif
}

extern "C" void kernel_launch(void* const* d_in, const int* in_sizes, int n_in, void* d_out, int out_size, void* d_ws, size_t ws_size, hipStream_t stream) {
    static int grid_blocks = 0;
    if (!grid_blocks) {
        int dev = 0, cus = 0, per_cu = 0;
        hipGetDevice(&dev);
        hipDeviceGetAttribute(&cus, hipDeviceAttributeMultiprocessorCount, dev);
        hipFuncSetAttribute((const void*)fwd_megakernel, hipFuncAttributeMaxDynamicSharedMemorySize, LDS_BYTES);
        hipOccupancyMaxActiveBlocksPerMultiprocessor(&per_cu, (const void*)fwd_megakernel, 512, LDS_BYTES);
        if (per_cu < 1) per_cu = 1;
        grid_blocks = cus * per_cu;
        if (ws_size < WS_END) fprintf(stderr, "kernel_launch: workspace too small: %zu < %zu\n", ws_size, (size_t)WS_END);
    }
    Params p{};
    for (int i = 0; i < 25; ++i) p.in[i] = (const float*)d_in[i];
    p.out = (float*)d_out; p.ws = (unsigned char*)d_ws;
    void* args[] = {&p};
    hipError_t e = hipLaunchCooperativeKernel((const void*)fwd_megakernel, dim3(grid_blocks), dim3(512), args, LDS_BYTES, stream);
    if (e != hipSuccess) fprintf(stderr, "cooperative launch failed: %s (grid %d)\n", hipGetErrorString(e), grid_blocks);
}
```

```cpp
#include <hip/hip_runtime.h>
#include <hip/hip_cooperative_groups.h>
#include <cstdio>
namespace cg = cooperative_groups;

#define DI __device__ __forceinline__
#define LAS __attribute__((address_space(3)))
typedef unsigned short bf16_t;
typedef short bf16x8 __attribute__((ext_vector_type(8)));
typedef short s16x4 __attribute__((ext_vector_type(4)));
typedef float f32x2 __attribute__((ext_vector_type(2)));
typedef float f32x4 __attribute__((ext_vector_type(4)));
typedef float f32x16 __attribute__((ext_vector_type(16)));
typedef unsigned u32x2 __attribute__((ext_vector_type(2)));
typedef unsigned u32x4 __attribute__((ext_vector_type(4)));
typedef __bf16 bf16x2_t __attribute__((ext_vector_type(2)));

#define REP_G1 1
#define REP_SCAN 1
#define REP_ATTN 1
#define REP_GIN 1
#define REP_GOUT 1
#define REP_PREP 1
DI int opaque_i(int v) { asm volatile("" : "+s"(v)); return v; }
constexpr int D = 1024, TP = 8192, BP = 4, BS = 16, TS = 16, PAST = 2048;
constexpr int MP = BP * TP, MS = BS * TS, M = MP + MS, NB = BP + BS;
constexpr int NPROJ = 4096;
constexpr int KSROWS = 2112;
constexpr int NITEM_P = 4096, NITEM = 4224;
constexpr size_t ITEM_BYTES = 90112;
constexpr float RMS_EPS = 1e-6f;
constexpr float QSCALE = 0.125f * 1.4426950408889634f;

constexpr size_t OFF_Y = 0;
constexpr size_t OFF_STP = (size_t)M * D;
constexpr size_t OFF_CVP = OFF_STP + 2ull * 4 * 8 * 128 * 128;
constexpr size_t OFF_KP = OFF_CVP + 2ull * 4 * 3 * 3072;
constexpr size_t OFF_VP = OFF_KP + 2ull * MP * 1024;
constexpr size_t OFF_STS = OFF_VP + 2ull * MP * 1024;
constexpr size_t OFF_CVS = OFF_STS + 2ull * 16 * 8 * 128 * 128;
constexpr size_t OFF_KSO = OFF_CVS + 2ull * 16 * 3 * 3072;
constexpr size_t OFF_VSO = OFF_KSO + 2ull * MS * 1024;

constexpr size_t WS_WING = 0;
constexpr size_t WS_WOUTG = WS_WING + 2ull * 4096 * 1024 * 2;
constexpr size_t WS_WIND = WS_WOUTG + 2ull * 1024 * 1024 * 2;
constexpr size_t WS_WOUTD = WS_WIND + 2ull * 4096 * 1024 * 2;
constexpr size_t WS_ADA = WS_WOUTD + 2ull * 1024 * 1024 * 2;
constexpr size_t WS_ROPE = WS_ADA + 4ull * NB * 3072 * 4;
constexpr size_t WS_AB = WS_ROPE + 8208ull * 64 * 4;
constexpr size_t WS_GL = WS_AB + (size_t)M * 16 * 4;
constexpr size_t WS_HBUF = WS_GL + 32768;
constexpr size_t WS_ORAW = WS_HBUF + (size_t)M * 1024 * 2;
constexpr size_t WS_PROJ = WS_ORAW + 256;
constexpr size_t WS_R1 = WS_PROJ + (size_t)M * 4096 * 2;
constexpr size_t WS_KS = WS_R1;
constexpr size_t WS_VS = WS_KS + 16ull * KSROWS * 1024 * 2;
constexpr size_t WS_END = WS_R1 + (size_t)NITEM * ITEM_BYTES;

constexpr int LDS_BYTES = 131072;

struct Params { const float* in[25]; float* out; unsigned char* ws; };

DI float bf2f(bf16_t v) { return __uint_as_float(((unsigned)v) << 16); }
DI unsigned pk2(float a, float b) { f32x2 v = {a, b}; bf16x2_t r = __builtin_convertvector(v, bf16x2_t); return __builtin_bit_cast(unsigned, r); }
DI bf16_t f2bf(float a) { return (bf16_t)(pk2(a, 0.f) & 0xffffu); }
template <int CTRL> DI float dppf(float v) { return __builtin_bit_cast(float, __builtin_amdgcn_update_dpp(0, __builtin_bit_cast(int, v), CTRL, 0xf, 0xf, true)); }
DI float row_sum16(float v) { v += dppf<0x128>(v); v += dppf<0x124>(v); v += dppf<0x122>(v); v += dppf<0x121>(v); return v; }
DI float wave_sum(float v) { v = row_sum16(v); v += __shfl_xor(v, 16); v += __shfl_xor(v, 32); return v; }
DI float readlane_f(float v, int l) { return __builtin_bit_cast(float, __builtin_amdgcn_readlane(__builtin_bit_cast(int, v), l)); }
DI float siluf(float x) { return x / (1.f + __expf(-x)); }
DI int ppos(int idx) { const int d5 = idx & 31; return (idx & ~31) | (((d5 >> 2) & 3) << 3) | ((d5 >> 4) << 2) | (d5 & 3); }
DI int perm64(int ls) { return (ls & 15) | (((ls >> 4) & 1) << 5) | (((ls >> 5) & 1) << 4); }
DI void unpack8(const u32x4 v, float (&o)[8]) {
#pragma unroll
    for (int i = 0; i < 4; ++i) { o[2 * i] = __uint_as_float(v[i] << 16); o[2 * i + 1] = __uint_as_float(v[i] & 0xffff0000u); }
}
DI void g2l16(const void* gptr, unsigned lds_addr) {
    asm volatile("s_mov_b32 m0, %1\n\ts_nop 0\n\tglobal_load_lds_dwordx4 %0, off" :: "v"(gptr), "s"(lds_addr) : "memory", "m0");
}
DI unsigned lds_u32(LAS unsigned char* p) { return (unsigned)(size_t)p; }
#define MFMA16(a, b, c) __builtin_amdgcn_mfma_f32_16x16x32_bf16((a), (b), (c), 0, 0, 0)
#define MFMA32(a, b, c) __builtin_amdgcn_mfma_f32_32x32x16_bf16((a), (b), (c), 0, 0, 0)

namespace pg8 {
constexpr int BM = 256, BK = 64, HALF = 128, HTB = HALF * BK * 2, STAGE_BYTES = 8 * HTB, NXCD = 8, WGM = 8;
DI int lds_byte(int r, int c) { const int st = (r >> 4) * 2 + (c >> 5), rr = r & 15, cc = c & 31, ob = rr * 64 + cc * 2; return st * 1024 + (ob ^ (((ob >> 9) & 1) << 5)); }
DI void stage_rc(int b, int& R, int& C) { const int st = b / 1024, sb = b % 1024, swz = sb ^ (((sb >> 9) & 1) << 5); R = (st >> 1) * 16 + swz / 64; C = (st & 1) * 32 + (swz % 64) / 2; }
struct Unit { int pm, pn; };
struct Gemm { const bf16_t* A; const bf16_t* Bt; int M, N, K; };
struct StaticOrder {
    int nM, nN, nwg, G, c;
    DI void init(int M_, int N_, int G_, int c_) { nM = M_ / BM; nN = N_ / BM; nwg = nM * nN; G = G_; c = c_; }
    DI bool next(int i, Unit& u) const {
        const long L = (long)i * G + c; if (L >= nwg) return false;
        int wgid = (int)L; { const int q = nwg / NXCD, r = nwg % NXCD, xcd = wgid % NXCD, off = wgid / NXCD; wgid = (xcd < r ? xcd * (q + 1) : r * (q + 1) + (xcd - r) * q) + off; }
        const int nig = WGM * nN, gid = wgid / nig, fm = gid * WGM, gsz = (nM - fm) < WGM ? (nM - fm) : WGM;
        u.pm = fm + ((wgid % nig) % gsz); u.pn = (wgid % nig) / gsz; return true;
    }
};

template <class Epi>
DI void gemm_phase(LAS unsigned char* lds, const Gemm g, const StaticOrder& S, const Epi& E) {
    int tid_ = threadIdx.x; asm volatile("" : "+v"(tid_)); const int tid = tid_, wid = __builtin_amdgcn_readfirstlane(tid >> 6), lane = tid & 63, wr = wid >> 2, wc = wid & 3, fr = lane & 15, fq = lane >> 4;
    const int K = g.K, nt = K / BK;
    unsigned voffA[2];
#pragma unroll
    for (int i = 0; i < 2; ++i) { int R, C; stage_rc(tid * 16 + i * 8192, R, C); voffA[i] = (unsigned)(R * K + C) * 2u; }
    const size_t kstep = (size_t)(BK * 2);
    const size_t hstep = (size_t)HALF * K * 2;
    const size_t tstep = 2 * hstep;
    const unsigned ldsw = (unsigned)wid * 1024u;
    const int aoff = lds_byte(wr * 64 + fr, fq * 8), boff = lds_byte(wc * 32 + fr, fq * 8);
#define PG8_SA(b, h) (((b) * 2 + (h)) * HTB)
#define PG8_SB(b, h) ((4 + (b) * 2 + (h)) * HTB)
#define PG8_STAGE(bufoff, gbase) do { _Pragma("unroll") for (int _i = 0; _i < 2; ++_i) \
        __builtin_amdgcn_global_load_lds((const unsigned*)((const char*)(gbase) + voffA[_i]), (LAS unsigned*)(lds + (bufoff) + ldsw + _i * 8192), 16, 0, 0); } while (0)
#define PG8_LDA(dst, b, h) do { _Pragma("unroll") for (int m = 0; m < 4; ++m) _Pragma("unroll") for (int k = 0; k < 2; ++k) dst[m][k] = *(const LAS bf16x8*)(lds + PG8_SA(b, h) + aoff + m * 2048 + k * 1024); } while (0)
#define PG8_LDB(dst, b, h) do { _Pragma("unroll") for (int n = 0; n < 2; ++n) _Pragma("unroll") for (int k = 0; k < 2; ++k) dst[n][k] = *(const LAS bf16x8*)(lds + PG8_SB(b, h) + boff + n * 2048 + k * 1024); } while (0)
#define PG8_MMA(ai, bj, At, Bt) do { __builtin_amdgcn_s_setprio(1); _Pragma("unroll") for (int m = 0; m < 4; ++m) _Pragma("unroll") for (int n = 0; n < 2; ++n) _Pragma("unroll") for (int k = 0; k < 2; ++k) \
        acc[ai][bj][m][n] = __builtin_amdgcn_mfma_f32_16x16x32_bf16(Bt[n][k], At[m][k], acc[ai][bj][m][n], 0, 0, 0); __builtin_amdgcn_s_setprio(0); } while (0)
#define PG8_WAIT_V(n) asm volatile("s_waitcnt vmcnt(" #n ")" ::: "memory")
#define PG8_WAIT_L(n) asm volatile("s_waitcnt lgkmcnt(" #n ")" ::: "memory")
#define PG8_BAR __builtin_amdgcn_s_barrier()
#define PG8_SCHED __builtin_amdgcn_sched_barrier(0)
    Unit cur, nxt; int ui = 0;
    if (!S.next(0, cur)) return;
    f32x4 acc[2][2][4][2];
#pragma unroll
    for (int a = 0; a < 2; ++a)
#pragma unroll
        for (int b = 0; b < 2; ++b)
#pragma unroll
            for (int m = 0; m < 4; ++m)
#pragma unroll
                for (int n = 0; n < 2; ++n) acc[a][b][m][n] = (f32x4){0.f, 0.f, 0.f, 0.f};
    bf16x8 At[4][2], B0[2][2], B1[2][2];
    const char* cA = (const char*)g.A + (size_t)cur.pm * tstep; const char* cB = (const char*)g.Bt + (size_t)cur.pn * tstep;
    PG8_STAGE(PG8_SB(0, 0), cB); PG8_STAGE(PG8_SA(0, 0), cA); PG8_STAGE(PG8_SB(0, 1), cB + hstep); PG8_STAGE(PG8_SA(0, 1), cA + hstep);
    if (wr == 1) PG8_BAR;
    PG8_WAIT_V(4); PG8_BAR;
    PG8_STAGE(PG8_SB(1, 0), cB + kstep); PG8_STAGE(PG8_SA(1, 0), cA + kstep); PG8_STAGE(PG8_SB(1, 1), cB + hstep + kstep);
    PG8_WAIT_V(6); PG8_BAR;
    for (;;) {
        const bool has_next = S.next(ui + 1, nxt);
        const char* nA = has_next ? (const char*)g.A + (size_t)nxt.pm * tstep : cA; const char* nB = has_next ? (const char*)g.Bt + (size_t)nxt.pn * tstep : cB;
        for (int t = 0; t < nt; t += 2) {
            const bool last = (t == nt - 2);
            const char* a1 = cA + (size_t)(t + 1) * kstep;
            const char* a2 = last ? nA : cA + (size_t)(t + 2) * kstep; const char* b2 = last ? nB : cB + (size_t)(t + 2) * kstep;
            const char* a3 = a2 + kstep; const char* b3 = b2 + kstep;
            PG8_LDB(B0, 0, 0); PG8_SCHED; PG8_LDA(At, 0, 0); PG8_STAGE(PG8_SA(1, 1), a1 + hstep);
            PG8_WAIT_L(8); PG8_BAR; PG8_WAIT_L(0); PG8_MMA(0, 0, At, B0); PG8_BAR; PG8_SCHED;
            PG8_LDB(B1, 0, 1); PG8_STAGE(PG8_SB(0, 0), b2);
            PG8_BAR; PG8_WAIT_L(0); PG8_MMA(0, 1, At, B1); PG8_BAR;
            PG8_LDA(At, 0, 1); PG8_STAGE(PG8_SA(0, 0), a2);
            PG8_BAR; PG8_WAIT_L(0); PG8_MMA(1, 0, At, B0); PG8_BAR; PG8_SCHED;
            PG8_STAGE(PG8_SB(0, 1), b2 + hstep);
            PG8_WAIT_V(6); PG8_BAR; PG8_MMA(1, 1, At, B1); PG8_BAR;
            PG8_LDB(B0, 1, 0); PG8_SCHED; PG8_LDA(At, 1, 0); PG8_STAGE(PG8_SA(0, 1), a2 + hstep);
            PG8_WAIT_L(8); PG8_BAR; PG8_WAIT_L(0); PG8_MMA(0, 0, At, B0); PG8_BAR; PG8_SCHED;
            PG8_LDB(B1, 1, 1); PG8_STAGE(PG8_SB(1, 0), b3);
            PG8_BAR; PG8_WAIT_L(0); PG8_MMA(0, 1, At, B1); PG8_BAR;
            PG8_LDA(At, 1, 1); PG8_STAGE(PG8_SA(1, 0), a3);
            PG8_BAR; PG8_WAIT_L(0); PG8_MMA(1, 0, At, B0); PG8_BAR; PG8_SCHED;
            PG8_STAGE(PG8_SB(1, 1), b3 + hstep);
            PG8_WAIT_V(6); PG8_BAR; PG8_MMA(1, 1, At, B1); PG8_BAR;
        }
        E(acc, cur, wr, wc, fr, fq);
        if (!has_next) break;
#pragma unroll
        for (int a = 0; a < 2; ++a)
#pragma unroll
            for (int b = 0; b < 2; ++b)
#pragma unroll
                for (int m = 0; m < 4; ++m)
#pragma unroll
                    for (int n = 0; n < 2; ++n) acc[a][b][m][n] = (f32x4){0.f, 0.f, 0.f, 0.f};
        cur = nxt; cA = nA; cB = nB; ++ui;
    }
    PG8_WAIT_V(0);
    if (wr == 0) PG8_BAR;
    PG8_BAR;
#undef PG8_SA
#undef PG8_SB
#undef PG8_STAGE
#undef PG8_LDA
#undef PG8_LDB
#undef PG8_MMA
#undef PG8_WAIT_V
#undef PG8_WAIT_L
#undef PG8_BAR
#undef PG8_SCHED
}
}

struct EpiGdnIn {
    bf16_t* proj; float* conv_p; float* conv_s;
    DI void operator()(const f32x4 (&acc)[2][2][4][2], const pg8::Unit& u, int wr, int wc, int fr, int fq) const {
        const int row0 = u.pm * 256 + wr * 64 + fr, col0 = u.pn * 256 + wc * 32 + 4 * fq;
#pragma unroll
        for (int ai = 0; ai < 2; ++ai)
#pragma unroll
            for (int m = 0; m < 4; ++m) {
                const int r = row0 + ai * 128 + m * 16;
                bf16_t* rowp = proj + (size_t)r * NPROJ + col0;
                bool tail; float* cp;
                if (r < MP) { const int t = r & (TP - 1), b = r >> 13; tail = t >= TP - 3; cp = conv_p + (size_t)(b * 3 + (t - (TP - 3))) * 3072; }
                else { const int rs = r - MP, t = rs & 15, b = rs >> 4; tail = t >= TS - 3; cp = conv_s + (size_t)(b * 3 + (t - (TS - 3))) * 3072; }
#pragma unroll
                for (int bj = 0; bj < 2; ++bj)
#pragma unroll
                    for (int n = 0; n < 2; ++n) {
                        const f32x4 v = acc[ai][bj][m][n];
                        u32x2 w; w.x = pk2(v[0], v[1]); w.y = pk2(v[2], v[3]);
                        *(u32x2*)(rowp + bj * 128 + n * 16) = w;
                        const int c = col0 + bj * 128 + n * 16;
                        if (tail && c < 3072) *(f32x4*)(cp + c) = v;
                    }
            }
    }
};

struct EpiDiffIn {
    bf16_t* proj; float* k_p; float* v_p; float* k_s; float* v_s; bf16_t* ks; bf16_t* vs; const float* rope;
    DI void operator()(const f32x4 (&acc)[2][2][4][2], const pg8::Unit& u, int wr, int wc, int fr, int fq) const {
        const int part = u.pn >> 2;
        const int row0 = u.pm * 256 + wr * 64 + fr;
        const int d0 = 16 * (wc & 1) + 4 * fq;
        const int cbase = u.pn * 256 + 64 * (wc >> 1) + d0;
#pragma unroll
        for (int ai = 0; ai < 2; ++ai)
#pragma unroll
            for (int m = 0; m < 4; ++m) {
                const int r = row0 + ai * 128 + m * 16;
                const int rs = r - MP;
                const int pidx = (r < MP) ? (r & (TP - 1)) : (TP + (rs & 15));
                f32x4 cs = {1.f, 1.f, 1.f, 1.f}, sn = {0.f, 0.f, 0.f, 0.f};
                if (part < 2) { cs = *(const f32x4*)(rope + (size_t)pidx * 64 + d0); sn = *(const f32x4*)(rope + (size_t)pidx * 64 + 32 + d0); }
#pragma unroll
                for (int bj = 0; bj < 2; ++bj) {
                    const f32x4 x1 = acc[ai][bj][m][0], x2 = acc[ai][bj][m][1];
                    f32x4 y1 = x1 * cs - x2 * sn, y2 = x2 * cs + x1 * sn;
                    const int col = cbase + bj * 128;
                    bf16_t* pp = proj + (size_t)r * NPROJ + col;
                    if (part == 0) { y1 *= QSCALE; y2 *= QSCALE; }
                    u32x2 w1, w2; w1.x = pk2(y1[0], y1[1]); w1.y = pk2(y1[2], y1[3]); w2.x = pk2(y2[0], y2[1]); w2.y = pk2(y2[2], y2[3]);
                    *(u32x2*)pp = w1; *(u32x2*)(pp + 32) = w2;
                    if (part == 1 || part == 2) {
                        const int cc = col - part * 1024;
                        float* op; bf16_t* sp = nullptr;
                        if (r < MP) op = (part == 1 ? k_p : v_p) + (size_t)r * 1024 + cc;
                        else { op = (part == 1 ? k_s : v_s) + (size_t)rs * 1024 + cc;
                               sp = (part == 1 ? ks : vs) + ((size_t)(rs >> 4) * KSROWS + PAST + (rs & 15)) * 1024 + cc; }
                        *(f32x4*)op = y1; *(f32x4*)(op + 32) = y2;
                        if (sp) { *(u32x2*)sp = w1; *(u32x2*)(sp + 32) = w2; }
                    }
                }
            }
    }
};

struct EpiOut {
    float* C;
    DI void operator()(const f32x4 (&acc)[2][2][4][2], const pg8::Unit& u, int wr, int wc, int fr, int fq) const {
        const int row0 = u.pm * 256 + wr * 64 + fr, col0 = u.pn * 256 + wc * 32 + 4 * fq;
#pragma unroll
        for (int ai = 0; ai < 2; ++ai)
#pragma unroll
            for (int m = 0; m < 4; ++m) {
                float* rowp = C + (size_t)(row0 + ai * 128 + m * 16) * 1024 + col0;
#pragma unroll
                for (int bj = 0; bj < 2; ++bj)
#pragma unroll
                    for (int n = 0; n < 2; ++n) *(f32x4*)(rowp + bj * 128 + n * 16) = acc[ai][bj][m][n];
            }
    }
};

DI void transpose_tile(const float* W, int ldw, int n0, int k0, bf16_t* WT, bool perm, LAS float* tile) {
    int tid_ = threadIdx.x; asm volatile("" : "+v"(tid_)); const int tid = tid_;
    {
        const int kk = tid >> 4, c4 = (tid & 15) * 4;
#pragma unroll
        for (int p = 0; p < 2; ++p) {
            const f32x4 v = *(const f32x4*)(W + (size_t)(k0 + kk + 32 * p) * ldw + n0 + c4);
            LAS float* t = tile + (kk + 32 * p) * 65 + c4;
            t[0] = v[0]; t[1] = v[1]; t[2] = v[2]; t[3] = v[3];
        }
    }
    __syncthreads();
    {
        const int n = tid >> 3, ks = (tid & 7) * 8;
        const int src = perm ? perm64(n) : n;
        float v[8];
#pragma unroll
        for (int e = 0; e < 8; ++e) v[e] = tile[(ks + e) * 65 + src];
        u32x4 w; w.x = pk2(v[0], v[1]); w.y = pk2(v[2], v[3]); w.z = pk2(v[4], v[5]); w.w = pk2(v[6], v[7]);
        *(u32x4*)(WT + (size_t)(n0 + n) * 1024 + k0 + ks) = w;
    }
    __syncthreads();
}

DI void phase_prep(const Params& P, LAS unsigned char* lds) {
    int tid_ = threadIdx.x; asm volatile("" : "+v"(tid_)); const int tid = tid_, G = gridDim.x;
    unsigned char* ws = P.ws;
    for (int id = blockIdx.x; id < 5120; id += G) {
        const int j = id / 2560; int rem = id % 2560;
        const float* W; int ldw; bf16_t* WT; bool perm = false; int t;
        if (rem < 1024) { W = P.in[12] + (size_t)j * 1024 * 4112; ldw = 4112; WT = (bf16_t*)(ws + WS_WING) + (size_t)j * 4096 * 1024; t = rem; }
        else if (rem < 1280) { W = P.in[17] + (size_t)j * 1024 * 1024; ldw = 1024; WT = (bf16_t*)(ws + WS_WOUTG) + (size_t)j * 1024 * 1024; t = rem - 1024; }
        else if (rem < 2304) { W = P.in[18] + (size_t)j * 1024 * 4096; ldw = 4096; WT = (bf16_t*)(ws + WS_WIND) + (size_t)j * 4096 * 1024; t = rem - 1280; perm = true; }
        else { W = P.in[24] + (size_t)j * 1024 * 1024; ldw = 1024; WT = (bf16_t*)(ws + WS_WOUTD) + (size_t)j * 1024 * 1024; t = rem - 2304; }
        transpose_tile(W, ldw, (t >> 4) * 64, (t & 15) * 64, WT, perm, (LAS float*)lds);
    }
    for (int idx = blockIdx.x * 512 + tid; idx < 8208 * 32; idx += G * 512) {
        const int pi = idx >> 5, d = idx & 31;
        const int pos = pi < TP ? pi : PAST + (pi - TP);
        const float inv = 1.0f / powf(10000.0f, (float)d / 32.0f);
        const float ang = (float)pos * inv;
        const double rev = (double)ang * 0.15915494309189535;
        const double fr = rev - floor(rev);
        float* rp = (float*)(ws + WS_ROPE) + (size_t)pi * 64;
        rp[d] = __builtin_amdgcn_cosf((float)fr);
        rp[32 + d] = __builtin_amdgcn_sinf((float)fr);
    }
    {
        LAS float* cact = (LAS float*)lds;
        LAS float* red = (LAS float*)(lds + 81920);
        bool loaded = false;
        for (int id = (G - 1 - blockIdx.x); id < 192; id += G) {
            if (!loaded) {
                for (int e = tid; e < NB * 1024; e += 512) {
                    const int b = e >> 10, k = e & 1023;
                    const float c = b < BP ? P.in[2][b * 1024 + k] : P.in[3][(b - BP) * 1024 + k];
                    cact[e] = siluf(c);
                }
                loaded = true;
            }
            __syncthreads();
            const int i = id / 48, cb = id % 48;
            const int col = tid & 63, kg = tid >> 6;
            const float* Wp = P.in[10] + (size_t)i * 1024 * 3072 + cb * 64 + col;
            float acc[NB];
#pragma unroll
            for (int b = 0; b < NB; ++b) acc[b] = 0.f;
            for (int k = kg * 128; k < kg * 128 + 128; k += 4) {
                const float w0 = Wp[(size_t)k * 3072], w1 = Wp[(size_t)(k + 1) * 3072], w2 = Wp[(size_t)(k + 2) * 3072], w3 = Wp[(size_t)(k + 3) * 3072];
#pragma unroll
                for (int b = 0; b < NB; ++b) {
                    const f32x4 c4 = *(const LAS f32x4*)(cact + b * 1024 + k);
                    acc[b] += c4[0] * w0 + c4[1] * w1 + c4[2] * w2 + c4[3] * w3;
                }
            }
#pragma unroll
            for (int b = 0; b < NB; ++b) red[(kg * NB + b) * 64 + col] = acc[b];
            __syncthreads();
            for (int o = tid; o < NB * 64; o += 512) {
                const int b = o >> 6, c = o & 63;
                float s = P.in[11][i * 3072 + cb * 64 + c];
#pragma unroll
                for (int g = 0; g < 8; ++g) s += red[(g * NB + b) * 64 + c];
                ((float*)(ws + WS_ADA))[((size_t)i * NB + b) * 3072 + cb * 64 + c] = s;
            }
        }
        __syncthreads();
    }
}

DI void phase_elem(const Params& P, LAS unsigned char* lds, int layer) {
    int tid_ = threadIdx.x; asm volatile("" : "+v"(tid_)); const int tid = tid_, wid = __builtin_amdgcn_readfirstlane(tid >> 6), lane = tid & 63, G = gridDim.x;
    unsigned char* ws = P.ws;
    const int j = layer >> 1;
    const bool gdn = (layer < 4) && !(layer & 1);
    LAS float* wab = (LAS float*)lds;
    if (gdn) {
        const float* Wp = P.in[12] + (size_t)j * 1024 * 4112 + 4096;
        for (int e = tid; e < 16384; e += 512) { const int k = e >> 4, c = e & 15; wab[c * 1024 + k] = Wp[(size_t)k * 4112 + c]; }
        __syncthreads();
    }
    const float* ada = (const float*)(ws + WS_ADA);
    float* X = P.out;
    const float* OUTB = (const float*)(ws + WS_PROJ);
    bf16_t* HB = (bf16_t*)(ws + WS_HBUF);
    float* AB = (float*)(ws + WS_AB);
    for (int r = blockIdx.x * 8 + wid; r < M; r += G * 8) {
        const int b = r < MP ? (r >> 13) : BP + ((r - MP) >> 4);
        const float* xs = (layer <= 1) ? (r < MP ? P.in[0] + (size_t)r * 1024 : P.in[1] + (size_t)(r - MP) * 1024) : X + (size_t)r * 1024;
        f32x4 x[4];
#pragma unroll
        for (int q = 0; q < 4; ++q) x[q] = *(const f32x4*)(xs + 4 * (lane + 64 * q));
        if (layer >= 1) {
            f32x4 o[4]; float ss = 0.f;
#pragma unroll
            for (int q = 0; q < 4; ++q) { o[q] = *(const f32x4*)(OUTB + (size_t)r * 1024 + 4 * (lane + 64 * q)); ss += o[q][0] * o[q][0] + o[q][1] * o[q][1] + o[q][2] * o[q][2] + o[q][3] * o[q][3]; }
            ss = wave_sum(ss);
            const float rstd = rsqrtf(ss * (1.f / 1024.f) + RMS_EPS);
            const float* gp = ada + ((size_t)(layer - 1) * NB + b) * 3072 + 2048;
            const float* np = P.in[9] + (layer - 1) * 1024;
#pragma unroll
            for (int q = 0; q < 4; ++q) {
                const int d = 4 * (lane + 64 * q);
                const f32x4 gt = *(const f32x4*)(gp + d), nw = *(const f32x4*)(np + d);
                x[q] = x[q] + gt * (o[q] * rstd * nw);
                *(f32x4*)(X + (size_t)r * 1024 + d) = x[q];
            }
        }
        if (layer < 4) {
            float ss = 0.f;
#pragma unroll
            for (int q = 0; q < 4; ++q) ss += x[q][0] * x[q][0] + x[q][1] * x[q][1] + x[q][2] * x[q][2] + x[q][3] * x[q][3];
            ss = wave_sum(ss);
            const float rstd = rsqrtf(ss * (1.f / 1024.f) + RMS_EPS);
            const float* ap = ada + ((size_t)layer * NB + b) * 3072;
            const float* np = P.in[8] + layer * 1024;
            f32x4 hv[4];
#pragma unroll
            for (int q = 0; q < 4; ++q) {
                const int d = 4 * (lane + 64 * q);
                const f32x4 sh = *(const f32x4*)(ap + d), sc = *(const f32x4*)(ap + 1024 + d), nw = *(const f32x4*)(np + d);
                hv[q] = (x[q] * rstd * nw) * (1.f + sc) + sh;
                u32x2 w; w.x = pk2(hv[q][0], hv[q][1]); w.y = pk2(hv[q][2], hv[q][3]);
                *(u32x2*)(HB + (size_t)r * 1024 + d) = w;
            }
            if (gdn) {
                float mine = 0.f;
#pragma unroll
                for (int c = 0; c < 16; ++c) {
                    float a = 0.f;
#pragma unroll
                    for (int q = 0; q < 4; ++q) { const f32x4 w4 = *(const LAS f32x4*)(wab + c * 1024 + 4 * (lane + 64 * q)); a += hv[q][0] * w4[0] + hv[q][1] * w4[1] + hv[q][2] * w4[2] + hv[q][3] * w4[3]; }
                    a = row_sum16(a);
                    if ((lane & 15) == c) mine = a;
                }
                mine += __shfl_xor(mine, 16); mine += __shfl_xor(mine, 32);
                if (lane < 16) AB[(size_t)r * 16 + lane] = mine;
            }
        }
    }
    if (layer < 4 && (layer & 1)) {
        const float* ck = P.in[6] + (size_t)j * 16 * PAST * 1024;
        const float* cv = P.in[7] + (size_t)j * 16 * PAST * 1024;
        bf16_t* KS = (bf16_t*)(ws + WS_KS); bf16_t* VS = (bf16_t*)(ws + WS_VS);
        const size_t nun = (size_t)16 * PAST * 128;
        for (size_t u = (size_t)blockIdx.x * 512 + tid; u < 2 * nun; u += (size_t)G * 512) {
            const bool isv = u >= nun; const size_t uu = isv ? u - nun : u;
            const size_t b = uu / ((size_t)PAST * 128), rem = uu % ((size_t)PAST * 128);
            const float* sp = (isv ? cv : ck) + uu * 8;
            const f32x4 a = *(const f32x4*)sp, c = *(const f32x4*)(sp + 4);
            u32x4 w; w.x = pk2(a[0], a[1]); w.y = pk2(a[2], a[3]); w.z = pk2(c[0], c[1]); w.w = pk2(c[2], c[3]);
            *(u32x4*)((isv ? VS : KS) + b * KSROWS * 1024 + rem * 8) = w;
        }
        const size_t npad = (size_t)16 * 48 * 128;
        for (size_t u = (size_t)blockIdx.x * 512 + tid; u < 2 * npad; u += (size_t)G * 512) {
            const bool isv = u >= npad; const size_t uu = isv ? u - npad : u;
            const size_t b = uu / (48 * 128), rem = uu % (48 * 128);
            *(u32x4*)((isv ? VS : KS) + (b * KSROWS + PAST + TS) * 1024 + rem * 8) = (u32x4){0u, 0u, 0u, 0u};
        }
    }
}

DI void phase_g1(const Params& P, LAS unsigned char* lds, int layer) {
    int tid_ = threadIdx.x; asm volatile("" : "+v"(tid_)); const int tid = tid_, wid = __builtin_amdgcn_readfirstlane(tid >> 6), lane = tid & 63, G = gridDim.x;
    const int fr = lane & 15, fq = lane >> 4;
    unsigned char* ws = P.ws;
    const int j = layer >> 1;
    const bf16_t* proj = (const bf16_t*)(ws + WS_PROJ);
    const float* AB = (const float*)(ws + WS_AB);
    float* GL = (float*)(ws + WS_GL);
    const float* convw = P.in[13] + (size_t)j * 4 * 3072;
    const float* cconv = P.in[5] + (size_t)j * 16 * 3 * 3072;
    LAS unsigned char* Qs = lds;
    LAS unsigned char* Ks = lds + 17408;
    LAS unsigned char* VBt = lds + 34816;
    LAS unsigned char* KBt = lds + 53248;
    LAS float* A32 = (LAS float*)(lds + 71680);
    LAS unsigned char* Ts = lds + 88320;
    LAS unsigned char* QKs = lds + 97536;
    LAS float* Gs = (LAS float*)(lds + 105728);

    for (int item = blockIdx.x; item < NITEM; item += G) {
        int b, h, c, row0, nvalid; bool sample;
        if (item < NITEM_P) { const int seq = item >> 7; b = seq >> 3; h = seq & 7; c = item & 127; row0 = b * TP + 64 * c; nvalid = 64; sample = false; }
        else { const int s = item - NITEM_P; b = s >> 3; h = s & 7; c = 0; row0 = MP + b * TS; nvalid = TS; sample = true; }
        unsigned char* ib = ws + WS_R1 + (size_t)item * ITEM_BYTES;
        float val[8][8];
        float rn[8];
        int tido = tid; asm volatile("" : "+v"(tido));
        const int l16 = tido & 15, grp = tido >> 4, part = grp >> 3, rb = grp & 7;
        const int lane = tido & 63, fr = lane & 15, fq = lane >> 4;
        if (tid < 384) {
            const int ch = part * 1024 + h * 128 + 8 * l16;
            float wv[4][8];
#pragma unroll
            for (int t = 0; t < 4; ++t) {
                const f32x4 a = *(const f32x4*)(convw + t * 3072 + ch), bb = *(const f32x4*)(convw + t * 3072 + ch + 4);
                wv[t][0] = a[0]; wv[t][1] = a[1]; wv[t][2] = a[2]; wv[t][3] = a[3]; wv[t][4] = bb[0]; wv[t][5] = bb[1]; wv[t][6] = bb[2]; wv[t][7] = bb[3];
            }
            float win[4][8];
#pragma unroll
            for (int t = 0; t < 4; ++t)
#pragma unroll
                for (int e = 0; e < 8; ++e) win[t][e] = 0.f;
#pragma unroll
            for (int k = 0; k < 11; ++k) {
                const int lr = 8 * rb - 3 + k;
                float in8[8];
                {
                    const bool use_proj = (lr >= 0 && lr < nvalid) || (lr < 0 && !sample && c > 0);
                    const int lrc = use_proj ? lr : 0;
                    const u32x4 v = *(const u32x4*)(proj + (size_t)(row0 + lrc) * NPROJ + ch);
                    unpack8(v, in8);
                    if (!use_proj) {
#pragma unroll
                        for (int e = 0; e < 8; ++e) in8[e] = 0.f;
                    }
                }
                if (k < 3) {
                    if (sample && lr < 0) {
                        const float* sp = cconv + (size_t)(b * 3 + (3 + lr)) * 3072 + ch;
                        const f32x4 a = *(const f32x4*)sp, bb = *(const f32x4*)(sp + 4);
                        in8[0] = a[0]; in8[1] = a[1]; in8[2] = a[2]; in8[3] = a[3]; in8[4] = bb[0]; in8[5] = bb[1]; in8[6] = bb[2]; in8[7] = bb[3];
                    }
                }
#pragma unroll
                for (int e = 0; e < 8; ++e) { win[0][e] = win[1][e]; win[1][e] = win[2][e]; win[2][e] = win[3][e]; win[3][e] = in8[e]; }
                if (k >= 3) {
                    const bool rv = (lr < nvalid);
                    float ss = 0.f;
#pragma unroll
                    for (int e = 0; e < 8; ++e) {
                        const float y = win[0][e] * wv[0][e] + win[1][e] * wv[1][e] + win[2][e] * wv[2][e] + win[3][e] * wv[3][e];
                        const float s = rv ? siluf(y) : 0.f;
                        val[k - 3][e] = s; ss += s * s;
                    }
                    ss = row_sum16(ss);
                    rn[k - 3] = rsqrtf(ss + 1e-6f);
                }
            }
        } else if (wid == 7) {
            const int r = row0 + (lane < nvalid ? lane : 0);
            const bool valid = lane < nvalid;
            const float a = AB[(size_t)r * 16 + h], bb = AB[(size_t)r * 16 + 8 + h];
            const float xa = a + P.in[15][j * 8 + h];
            const float sp = xa > 20.f ? xa : log1pf(__expf(xa));
            float g = valid ? -__expf(P.in[14][j * 8 + h]) * sp : 0.f;
            const float beta = valid ? 1.f / (1.f + __expf(-bb)) : 0.f;
#pragma unroll
            for (int o = 1; o < 64; o <<= 1) { const float t = __shfl_up(g, o); if (lane >= o) g += t; }
            const float glast = readlane_f(g, 63);
            Gs[lane] = g; Gs[64 + lane] = beta; Gs[128 + lane] = __expf(g); Gs[192 + lane] = __expf(glast - g);
            if (lane == 0) GL[item] = __expf(glast);
        }
        __syncthreads();
        if (tid < 384) {
#pragma unroll
            for (int rr = 0; rr < 8; ++rr) {
                const int row = 8 * rb + rr;
                const float beta = Gs[64 + row], eG = Gs[128 + row];
                if (part == 0) {
                    const float sc = rn[rr] * 0.08838834764831845f;
                    float q[8];
#pragma unroll
                    for (int e = 0; e < 8; ++e) q[e] = val[rr][e] * sc;
                    u32x4 w; w.x = pk2(q[0], q[1]); w.y = pk2(q[2], q[3]); w.z = pk2(q[4], q[5]); w.w = pk2(q[6], q[7]);
                    *(LAS u32x4*)(Qs + row * 272 + l16 * 16) = w;
                    bf16_t* qg = (bf16_t*)(ib + 49152) + row * 128;
                    u32x2 g0, g1; g0.x = pk2(q[0] * eG, q[1] * eG); g0.y = pk2(q[2] * eG, q[3] * eG); g1.x = pk2(q[4] * eG, q[5] * eG); g1.y = pk2(q[6] * eG, q[7] * eG);
                    *(u32x2*)(qg + ppos(8 * l16)) = g0; *(u32x2*)(qg + ppos(8 * l16 + 4)) = g1;
                    val[rr][0] = 0.f;
                } else if (part == 1) {
#pragma unroll
                    for (int e = 0; e < 8; ++e) val[rr][e] *= rn[rr];
                    u32x4 w; w.x = pk2(val[rr][0], val[rr][1]); w.y = pk2(val[rr][2], val[rr][3]); w.z = pk2(val[rr][4], val[rr][5]); w.w = pk2(val[rr][6], val[rr][7]);
                    *(LAS u32x4*)(Ks + row * 272 + l16 * 16) = w;
                }
            }
            if (part >= 1) {
                float bsc[8], ksc[8];
#pragma unroll
                for (int rr = 0; rr < 8; ++rr) { const int row = 8 * rb + rr; const float beta = Gs[64 + row]; bsc[rr] = (part == 1) ? beta * Gs[128 + row] : beta; ksc[rr] = Gs[192 + row]; }
                LAS unsigned char* Tt = (part == 1) ? KBt : VBt;
#pragma unroll
                for (int e = 0; e < 8; ++e) {
                    const int dch = 8 * l16 + e;
                    u32x4 w; w.x = pk2(val[0][e] * bsc[0], val[1][e] * bsc[1]); w.y = pk2(val[2][e] * bsc[2], val[3][e] * bsc[3]);
                    w.z = pk2(val[4][e] * bsc[4], val[5][e] * bsc[5]); w.w = pk2(val[6][e] * bsc[6], val[7][e] * bsc[7]);
                    *(LAS u32x4*)(Tt + dch * 144 + rb * 16) = w;
                    if (part == 1) {
                        bf16_t* kd = (bf16_t*)(ib + 65536) + dch * 64;
                        u32x2 k0, k1; k0.x = pk2(val[0][e] * ksc[0], val[1][e] * ksc[1]); k0.y = pk2(val[2][e] * ksc[2], val[3][e] * ksc[3]);
                        k1.x = pk2(val[4][e] * ksc[4], val[5][e] * ksc[5]); k1.y = pk2(val[6][e] * ksc[6], val[7][e] * ksc[7]);
                        *(u32x2*)(kd + ppos(8 * rb)) = k0; *(u32x2*)(kd + ppos(8 * rb + 4)) = k1;
                    }
                }
            }
        }
        __syncthreads();
        {
            const int mt = wid & 3; const bool isqk = wid >= 4;
            LAS unsigned char* As = isqk ? Qs : Ks;
            f32x4 acc[4];
#pragma unroll
            for (int nt = 0; nt < 4; ++nt) acc[nt] = (f32x4){0.f, 0.f, 0.f, 0.f};
#pragma unroll
            for (int ks = 0; ks < 4; ++ks) {
                const bf16x8 a = *(const LAS bf16x8*)(As + (16 * mt + fr) * 272 + (32 * ks + 8 * fq) * 2);
#pragma unroll
                for (int nt = 0; nt < 4; ++nt) {
                    const bf16x8 bfr = *(const LAS bf16x8*)(Ks + (16 * nt + fr) * 272 + (32 * ks + 8 * fq) * 2);
                    acc[nt] = MFMA16(a, bfr, acc[nt]);
                }
            }
#pragma unroll
            for (int nt = 0; nt < 4; ++nt) {
                const int cp = 16 * nt + fr; const float Gc2 = Gs[cp];
#pragma unroll
                for (int i = 0; i < 4; ++i) {
                    const int cr = 16 * mt + 4 * fq + i;
                    const float dec = __expf(Gs[cr] - Gc2);
                    if (!isqk) A32[cr * 65 + cp] = (cr > cp) ? Gs[64 + cr] * acc[nt][i] * dec : 0.f;
                    else *(LAS bf16_t*)(QKs + (cr * 64 + ppos(cp)) * 2) = f2bf((cr >= cp) ? acc[nt][i] * dec : 0.f);
                }
            }
        }
        __syncthreads();
        {
            float a[64];
#pragma unroll
            for (int jj = 0; jj < 64; ++jj) a[jj] = A32[lane * 65 + jj];
            float x[8];
#pragma unroll
            for (int cc = 0; cc < 8; ++cc) x[cc] = (lane == 8 * wid + cc) ? 1.f : 0.f;
#pragma unroll
            for (int jj = 0; jj < 64; ++jj) {
                if (jj >= 8 * wid) {
#pragma unroll
                    for (int cc = 0; cc < 8; ++cc) { const float xj = readlane_f(x[cc], jj); x[cc] -= a[jj] * xj; }
                }
            }
            u32x4 w; w.x = pk2(x[0], x[1]); w.y = pk2(x[2], x[3]); w.z = pk2(x[4], x[5]); w.w = pk2(x[6], x[7]);
            *(LAS u32x4*)(Ts + lane * 144 + wid * 16) = w;
            *(u32x4*)(ib + 81920 + tid * 16) = *(const LAS u32x4*)(QKs + tid * 16);
        }
        __syncthreads();
        {
            const bool isw = wid >= 4; const int n0 = 32 * (wid & 3);
            LAS unsigned char* Bs = isw ? KBt : VBt;
            f32x4 acc[4][2];
#pragma unroll
            for (int mt = 0; mt < 4; ++mt) { acc[mt][0] = (f32x4){0.f, 0.f, 0.f, 0.f}; acc[mt][1] = (f32x4){0.f, 0.f, 0.f, 0.f}; }
#pragma unroll
            for (int ks = 0; ks < 2; ++ks) {
                bf16x8 bfr[2];
#pragma unroll
                for (int nn = 0; nn < 2; ++nn) bfr[nn] = *(const LAS bf16x8*)(Bs + (n0 + 16 * nn + fr) * 144 + (32 * ks + 8 * fq) * 2);
#pragma unroll
                for (int mt = 0; mt < 4; ++mt) {
                    const bf16x8 a = *(const LAS bf16x8*)(Ts + (16 * mt + fr) * 144 + (32 * ks + 8 * fq) * 2);
                    acc[mt][0] = MFMA16(a, bfr[0], acc[mt][0]); acc[mt][1] = MFMA16(a, bfr[1], acc[mt][1]);
                }
            }
            if (!isw) {
                float* U = (float*)ib;
#pragma unroll
                for (int mt = 0; mt < 4; ++mt)
#pragma unroll
                    for (int nn = 0; nn < 2; ++nn)
#pragma unroll
                        for (int i = 0; i < 4; ++i) U[(16 * mt + 4 * fq + i) * 128 + n0 + 16 * nn + fr] = acc[mt][nn][i];
            } else {
#pragma unroll
                for (int mt = 0; mt < 4; ++mt)
#pragma unroll
                    for (int nn = 0; nn < 2; ++nn)
#pragma unroll
                        for (int i = 0; i < 4; ++i) *(LAS bf16_t*)(Qs + ((16 * mt + 4 * fq + i) * 128 + ppos(n0 + 16 * nn + fr)) * 2) = f2bf(acc[mt][nn][i]);
            }
        }
        __syncthreads();
        {
            *(u32x4*)(ib + 32768 + tid * 16) = *(const LAS u32x4*)(Qs + tid * 16);
            *(u32x4*)(ib + 32768 + 8192 + tid * 16) = *(const LAS u32x4*)(Qs + 8192 + tid * 16);
        }
        __syncthreads();
    }
}

DI void phase_scan(const Params& P, LAS unsigned char* lds, int layer) {
    int tid_ = threadIdx.x; asm volatile("" : "+v"(tid_)); const int tid = tid_, wid = __builtin_amdgcn_readfirstlane(tid >> 6), lane = tid & 63, G = gridDim.x;
    const int fr = lane & 15, fq = lane >> 4;
    unsigned char* ws = P.ws;
    const int j = layer >> 1;
    const bf16_t* proj = (const bf16_t*)(ws + WS_PROJ);
    const float* GL = (const float*)(ws + WS_GL);
    bf16_t* OB = (bf16_t*)(ws + WS_HBUF);
    constexpr int BUFB = 57344;
    LAS float* red = (LAS float*)(lds + 2 * BUFB);

    for (int seq = blockIdx.x; seq < 160; seq += G) {
        int b, h, nch, item0, row0, nvalid; float* stout;
        f32x4 st[8];
        const int dvc = 16 * wid + fr;
        if (seq < 32) {
            b = seq >> 3; h = seq & 7; nch = 128; item0 = seq * 128; row0 = b * TP; nvalid = 64;
            stout = P.out + OFF_STP + ((size_t)(j * 4 + b) * 8 + h) * 16384;
#pragma unroll
            for (int mt = 0; mt < 8; ++mt) st[mt] = (f32x4){0.f, 0.f, 0.f, 0.f};
        } else {
            const int s = seq - 32; b = s >> 3; h = s & 7; nch = 1; item0 = NITEM_P + s; row0 = MP + b * TS; nvalid = TS;
            stout = P.out + OFF_STS + ((size_t)(j * 16 + b) * 8 + h) * 16384;
            const float* s0 = P.in[4] + ((size_t)(j * 16 + b) * 8 + h) * 16384;
            const unsigned s0o = (unsigned)(4 * fq * 128 + dvc);
#pragma unroll
            for (int mt = 0; mt < 8; ++mt)
#pragma unroll
                for (int i = 0; i < 4; ++i) st[mt][i] = s0[(unsigned)((16 * mt + i) * 128) + s0o];
        }
        const float onw = P.in[16][j * 128 + dvc];
        f32x4 un[4];
#define SCAN_G2L(itm, bufi, LN) do { const unsigned char* _ib = ws + WS_R1 + (size_t)(itm) * ITEM_BYTES + 32768; \
            _Pragma("unroll") for (int _p = 0; _p < 7; ++_p) { const int _L = (wid + 8 * _p) * 1024 + (LN) * 16; unsigned _src; \
                if (_p < 4) { const int _row = _L >> 8, _ch = (_L >> 4) & 15; _src = (_L & ~255) + ((_ch ^ (_row & 15)) << 4); } \
                else { const int _a = _L - 32768, _row = _a >> 7, _ch = (_a >> 4) & 7; _src = 32768 + (_a & ~127) + ((_ch ^ ((_row >> 1) & 7)) << 4); } \
                g2l16(_ib + _src, lds_u32(lds + (bufi) * BUFB + (wid + 8 * _p) * 1024)); } } while (0)
#define SCAN_LOADU(itm) do { const float* _u = (const float*)(ws + WS_R1 + (size_t)(itm) * ITEM_BYTES); const unsigned _uo = (unsigned)(4 * fq * 128 + 16 * wid + fr); \
            _Pragma("unroll") for (int _m = 0; _m < 4; ++_m) _Pragma("unroll") for (int _i = 0; _i < 4; ++_i) un[_m][_i] = _u[(unsigned)((16 * _m + _i) * 128) + _uo]; } while (0)
        __syncthreads();
        SCAN_G2L(item0, 0, lane);
        SCAN_LOADU(item0);
        float gln = GL[item0];
        asm volatile("s_waitcnt vmcnt(0)" ::: "memory");
        __syncthreads();
        for (int c = 0; c < nch; ++c) {
            int frq = lane; asm volatile("" : "+v"(frq));
            const int fr = frq & 15, fq = frq >> 4;
            LAS unsigned char* bb = lds + (c & 1) * BUFB;
            const float gl = gln;
            f32x4 u[4];
#pragma unroll
            for (int mt = 0; mt < 4; ++mt) u[mt] = un[mt];
            if (c + 1 < nch) { gln = GL[item0 + c + 1]; SCAN_G2L(item0 + c + 1, (c + 1) & 1, frq); }
            const int x16 = fr << 4, x8 = ((fr >> 1) & 7) << 4;
            bf16x8 sf[4];
#pragma unroll
            for (int ks = 0; ks < 4; ++ks) {
                u32x4 w; w.x = pk2(-st[2 * ks][0], -st[2 * ks][1]); w.y = pk2(-st[2 * ks][2], -st[2 * ks][3]); w.z = pk2(-st[2 * ks + 1][0], -st[2 * ks + 1][1]); w.w = pk2(-st[2 * ks + 1][2], -st[2 * ks + 1][3]);
                sf[ks] = __builtin_bit_cast(bf16x8, w);
            }
            bf16x8 fa[4], fb[4];
#define SC_LD256(dst, base, mt) do { _Pragma("unroll") for (int _k = 0; _k < 4; ++_k) \
                dst[_k] = *(const LAS bf16x8*)(bb + (base) + (16 * (mt) + fr) * 256 + ((((4 * _k + fq) << 4)) ^ x16)); } while (0)
#define SC_LD128(dst, base, mtlo) do { _Pragma("unroll") for (int _m = 0; _m < 2; ++_m) _Pragma("unroll") for (int _k = 0; _k < 2; ++_k) \
                dst[_m * 2 + _k] = *(const LAS bf16x8*)(bb + (base) + (16 * ((mtlo) + _m) + fr) * 128 + ((((4 * _k + fq) << 4)) ^ x8)); } while (0)
#define SC_SB __builtin_amdgcn_sched_barrier(0)
#define SC_MU(f, mt) do { _Pragma("unroll") for (int _k = 0; _k < 4; ++_k) u[mt] = MFMA16(f[_k], sf[_k], u[mt]); } while (0)
#define SC_MO(f, mt) do { _Pragma("unroll") for (int _k = 0; _k < 4; ++_k) o[mt] = MFMA16(f[_k], sf[_k], o[mt]); } while (0)
#define SC_MQK(f, mtlo) do { _Pragma("unroll") for (int _m = 0; _m < 2; ++_m) _Pragma("unroll") for (int _k = 0; _k < 2; ++_k) o[(mtlo) + _m] = MFMA16(f[_m * 2 + _k], uf[_k], o[(mtlo) + _m]); } while (0)
#define SC_MKD(f, mtlo) do { _Pragma("unroll") for (int _m = 0; _m < 2; ++_m) { st[(mtlo) + _m] = st[(mtlo) + _m] * gl; _Pragma("unroll") for (int _k = 0; _k < 2; ++_k) st[(mtlo) + _m] = MFMA16(f[_m * 2 + _k], uf[_k], st[(mtlo) + _m]); } } while (0)
            f32x4 o[4];
#pragma unroll
            for (int mt = 0; mt < 4; ++mt) o[mt] = (f32x4){0.f, 0.f, 0.f, 0.f};
            SC_LD256(fa, 0, 0); SC_LD256(fb, 0, 1); SC_SB;
            SC_MU(fa, 0); SC_LD256(fa, 0, 2); SC_SB;
            SC_MU(fb, 1); SC_LD256(fb, 0, 3); SC_SB;
            SC_MU(fa, 2); SC_LD256(fa, 16384, 0); SC_SB;
            SC_MU(fb, 3); SC_LD256(fb, 16384, 1); SC_SB;
#pragma unroll
            for (int ks = 0; ks < 4; ++ks) sf[ks] = sf[ks] ^ (short)0x8000;
            SC_MO(fa, 0); SC_LD256(fa, 16384, 2); SC_SB;
            SC_MO(fb, 1); SC_LD256(fb, 16384, 3); SC_SB;
            SC_MO(fa, 2); SC_LD128(fa, 49152, 0); SC_SB;
            SC_MO(fb, 3); SC_LD128(fb, 49152, 2); SC_SB;
            bf16x8 uf[2];
#pragma unroll
            for (int k2 = 0; k2 < 2; ++k2) {
                u32x4 w; w.x = pk2(u[2 * k2][0], u[2 * k2][1]); w.y = pk2(u[2 * k2][2], u[2 * k2][3]); w.z = pk2(u[2 * k2 + 1][0], u[2 * k2 + 1][1]); w.w = pk2(u[2 * k2 + 1][2], u[2 * k2 + 1][3]);
                uf[k2] = __builtin_bit_cast(bf16x8, w);
            }
            SC_MQK(fa, 0); SC_LD128(fa, 32768, 0); SC_SB;
            SC_MQK(fb, 2); SC_LD128(fb, 32768, 2); SC_SB;
            SC_MKD(fa, 0); SC_LD128(fa, 32768, 4); SC_SB;
            SC_MKD(fb, 2); SC_LD128(fb, 32768, 6); SC_SB;
            SC_MKD(fa, 4); SC_SB;
            SC_MKD(fb, 6);
#undef SC_MU
#undef SC_MO
#undef SC_MQK
#undef SC_MKD
#undef SC_LD256
#undef SC_LD128
#undef SC_SB
            if (c + 1 < nch) SCAN_LOADU(item0 + c + 1);
            unsigned short zr[4][4];
            {
                const bf16_t* zb = proj + (size_t)(row0 + 64 * c) * NPROJ + 3072 + h * 128;
                const unsigned zo = (unsigned)(4 * fq * NPROJ + 16 * wid + fr);
                const int msk = (nvalid == 64) ? 63 : 15;
#pragma unroll
                for (int mt = 0; mt < 4; ++mt)
#pragma unroll
                    for (int i = 0; i < 4; ++i) zr[mt][i] = zb[(unsigned)((((16 * mt) & msk) + i) * NPROJ) + zo];
            }
            LAS float* rd = red + (c & 1) * 512;
            {
                float sel = 0.f;
#pragma unroll
                for (int mt = 0; mt < 4; ++mt)
#pragma unroll
                    for (int i = 0; i < 4; ++i) { const float ss = row_sum16(o[mt][i] * o[mt][i]); if (fr == 4 * mt + i) sel = ss; }
                rd[(16 * (fr >> 2) + 4 * fq + (fr & 3)) * 8 + wid] = sel;
            }
            asm volatile("s_waitcnt vmcnt(0)" ::: "memory");
            __syncthreads();
            {
                const int myrow = 16 * (fr >> 2) + 4 * fq + (fr & 3);
                const f32x4 p0 = *(const LAS f32x4*)(rd + myrow * 8), p1 = *(const LAS f32x4*)(rd + myrow * 8 + 4);
                const float tot = p0[0] + p0[1] + p0[2] + p0[3] + p1[0] + p1[1] + p1[2] + p1[3];
                LAS float* rs = red + 1024 + wid * 64;
                rs[fq * 16 + fr] = rsqrtf(tot * (1.f / 128.f) + RMS_EPS);
                bf16_t* obb = OB + (size_t)(row0 + 64 * c) * 1024 + h * 128;
                const unsigned oo = (unsigned)(4 * fq * 1024 + 16 * wid + fr);
#pragma unroll
                for (int mt = 0; mt < 4; ++mt) {
                    const f32x4 r4 = *(const LAS f32x4*)(rs + fq * 16 + 4 * mt);
#pragma unroll
                    for (int i = 0; i < 4; ++i) {
                        const int lr = 16 * mt + 4 * fq + i;
                        const float ov = o[mt][i] * r4[i] * onw * siluf(bf2f(zr[mt][i]));
                        const bf16_t ob = f2bf(ov);
                        if (lr < nvalid) obb[(unsigned)((16 * mt + i) * 1024) + oo] = ob;
                    }
                }
            }
        }
        {
            int lz = lane; asm volatile("" : "+v"(lz));
            const unsigned so = (unsigned)(4 * (lz >> 4) * 128 + 16 * wid + (lz & 15));
#pragma unroll
            for (int mt = 0; mt < 8; ++mt)
#pragma unroll
                for (int i = 0; i < 4; ++i) stout[(unsigned)((16 * mt + i) * 128) + so] = st[mt][i];
        }
#undef SCAN_G2L
#undef SCAN_LOADU
    }
}

DI void phase_attn(const Params& P, LAS unsigned char* lds, int layer) {
    int tid_ = threadIdx.x; asm volatile("" : "+v"(tid_)); const int tid = tid_, wid = __builtin_amdgcn_readfirstlane(tid >> 6), lane = tid & 63, G = gridDim.x;
    unsigned char* ws = P.ws;
    const int j = layer >> 1;
    const int comp = wid >> 2, rg = wid & 3, r32 = lane & 31, h2 = lane >> 5;
    const int q4 = (lane & 15) >> 2, p4 = lane & 3, blk = (lane >> 4) & 1;
    const bf16_t* proj = (const bf16_t*)(ws + WS_PROJ);
    bf16_t* OB = (bf16_t*)(ws + WS_HBUF);
    const float lam_init = 0.8f - 0.6f * expf(-0.3f * (float)layer);
    float lam;
    {
        float d1 = 0.f, d2 = 0.f;
        for (int i = 0; i < 64; ++i) { d1 += P.in[19][j * 64 + i] * P.in[20][j * 64 + i]; d2 += P.in[21][j * 64 + i] * P.in[22][j * 64 + i]; }
        lam = expf(d1) - expf(d2) + lam_init;
    }
    const float* subln = P.in[23] + j * 128;
    constexpr int TB = 35840;
    const int vb = (G % 8 == 0) ? (blockIdx.x % 8) * (G / 8) + blockIdx.x / 8 : blockIdx.x;
    const int nrounds = (G == 256) ? 9 : (2176 + G - 1) / G;
    for (int k = 0; k < nrounds; ++k) {
        int id;
        if (G == 256) {
            if (k < 8) { const int seq = vb >> 3, sub = vb & 7; const int qt = (k & 1) ? (16 * (k >> 1) + 15 - sub) : (16 * (k >> 1) + sub); id = seq * 64 + qt; }
            else { if (vb >= 128) break; id = 2048 + vb; }
        } else { id = vb + k * G; if (id >= 2176) break; }
        int h, qrow0, nt_all, nt_mine, last_valid, kvstride; const bf16_t* Kp; const bf16_t* Vp; bool sample;
        if (id < 2048) {
            const int seq = id >> 6, qt = id & 63, b = seq >> 3; h = seq & 7; sample = false;
            qrow0 = b * TP + 128 * qt + 32 * rg; nt_all = 2 * qt + 2; nt_mine = (rg < 2) ? 2 * qt + 1 : 2 * qt + 2; last_valid = 64; kvstride = NPROJ;
            Kp = proj + (size_t)(b * TP) * NPROJ + 1024 + h * 128; Vp = proj + (size_t)(b * TP) * NPROJ + 2048 + h * 128;
        } else {
            const int s = id - 2048, b = s >> 3; h = s & 7; sample = true;
            qrow0 = MP + b * TS; nt_all = 33; nt_mine = (rg == 0) ? 33 : 0; last_valid = 16; kvstride = 1024;
            Kp = (const bf16_t*)(ws + WS_KS) + (size_t)b * KSROWS * 1024 + h * 128; Vp = (const bf16_t*)(ws + WS_VS) + (size_t)b * KSROWS * 1024 + h * 128;
        }
        bf16x8 qf[4];
        {
            const int qr = qrow0 + (sample ? (r32 & 15) : r32);
            const bf16_t* qp = proj + (size_t)qr * NPROJ + h * 128 + comp * 64 + 8 * h2;
#pragma unroll
            for (int s = 0; s < 4; ++s) qf[s] = *(const bf16x8*)(qp + 16 * s);
        }
        f32x16 O[4];
#pragma unroll
        for (int et = 0; et < 4; ++et)
#pragma unroll
            for (int i = 0; i < 16; ++i) O[et][i] = 0.f;
        float m = -INFINITY, l = 0.f;
        u32x4 pk[2], pv[2];
#define ATT_LOAD(kt) do { _Pragma("unroll") for (int _p = 0; _p < 2; ++_p) { const int _cid = tid + 512 * _p, _row = _cid >> 4, _ch = _cid & 15; \
            pk[_p] = *(const u32x4*)(Kp + (size_t)(64 * (kt) + _row) * kvstride + _ch * 8); pv[_p] = *(const u32x4*)(Vp + (size_t)(64 * (kt) + _row) * kvstride + _ch * 8); } } while (0)
#define ATT_STORE(bufi) do { LAS unsigned char* _bb = lds + (bufi) * TB; _Pragma("unroll") for (int _p = 0; _p < 2; ++_p) { const int _cid = tid + 512 * _p, _row = _cid >> 4, _ch = _cid & 15; \
            *(LAS u32x4*)(_bb + _row * 272 + _ch * 16) = pk[_p]; *(LAS u32x4*)(_bb + 17408 + _row * 288 + _ch * 16) = pv[_p]; } } while (0)
        ATT_LOAD(0);
        ATT_STORE(0);
        __syncthreads();
        for (int kt = 0; kt < nt_all; ++kt) {
            if (kt + 1 < nt_all) ATT_LOAD(kt + 1);
            if (kt < nt_mine) {
                LAS unsigned char* Kb = lds + (kt & 1) * TB; LAS unsigned char* Vb = Kb + 17408;
                f32x16 s0, s1;
#pragma unroll
                for (int i = 0; i < 16; ++i) { s0[i] = 0.f; s1[i] = 0.f; }
#pragma unroll
                for (int s = 0; s < 4; ++s) {
                    const bf16x8 k0 = *(const LAS bf16x8*)(Kb + r32 * 272 + (comp * 64 + 16 * s + 8 * h2) * 2);
                    const bf16x8 k1 = *(const LAS bf16x8*)(Kb + (32 + r32) * 272 + (comp * 64 + 16 * s + 8 * h2) * 2);
                    s0 = MFMA32(k0, qf[s], s0); s1 = MFMA32(k1, qf[s], s1);
                }
                if (kt == nt_all - 1 && last_valid < 64) {
#pragma unroll
                    for (int i = 0; i < 16; ++i) {
                        const int key = (i & 3) + 8 * (i >> 2) + 4 * h2;
                        if (key >= last_valid) s0[i] = -INFINITY;
                        if (32 + key >= last_valid) s1[i] = -INFINITY;
                    }
                }
                float mx = s0[0];
#pragma unroll
                for (int i = 1; i < 16; ++i) mx = fmaxf(mx, s0[i]);
#pragma unroll
                for (int i = 0; i < 16; ++i) mx = fmaxf(mx, s1[i]);
                mx = fmaxf(mx, __shfl_xor(mx, 32));
                const float mn = fmaxf(m, mx);
                if (__any(mn > m)) {
                    const float alpha = __builtin_amdgcn_exp2f(m - mn);
                    l *= alpha;
#pragma unroll
                    for (int et = 0; et < 4; ++et)
#pragma unroll
                        for (int i = 0; i < 16; ++i) O[et][i] *= alpha;
                    m = mn;
                }
                float ps = 0.f;
#pragma unroll
                for (int i = 0; i < 16; ++i) { s0[i] = __builtin_amdgcn_exp2f(s0[i] - m); s1[i] = __builtin_amdgcn_exp2f(s1[i] - m); ps += s0[i] + s1[i]; }
                l += ps;
                bf16x8 pf[2][2];
                {
                    u32x4 w;
                    w.x = pk2(s0[0], s0[1]); w.y = pk2(s0[2], s0[3]); w.z = pk2(s0[4], s0[5]); w.w = pk2(s0[6], s0[7]); pf[0][0] = __builtin_bit_cast(bf16x8, w);
                    w.x = pk2(s0[8], s0[9]); w.y = pk2(s0[10], s0[11]); w.z = pk2(s0[12], s0[13]); w.w = pk2(s0[14], s0[15]); pf[0][1] = __builtin_bit_cast(bf16x8, w);
                    w.x = pk2(s1[0], s1[1]); w.y = pk2(s1[2], s1[3]); w.z = pk2(s1[4], s1[5]); w.w = pk2(s1[6], s1[7]); pf[1][0] = __builtin_bit_cast(bf16x8, w);
                    w.x = pk2(s1[8], s1[9]); w.y = pk2(s1[10], s1[11]); w.z = pk2(s1[12], s1[13]); w.w = pk2(s1[14], s1[15]); pf[1][1] = __builtin_bit_cast(bf16x8, w);
                }
#pragma unroll
                for (int kt2 = 0; kt2 < 2; ++kt2)
#pragma unroll
                    for (int s2 = 0; s2 < 2; ++s2) {
                        const int keyrow = 32 * kt2 + 16 * s2 + 4 * h2 + q4;
#pragma unroll
                        for (int et = 0; et < 4; ++et) {
                            const s16x4 lo = __builtin_amdgcn_ds_read_tr16_b64_v4i16((LAS s16x4*)(Vb + keyrow * 288 + (32 * et + 16 * blk) * 2 + 8 * p4));
                            const s16x4 hi = __builtin_amdgcn_ds_read_tr16_b64_v4i16((LAS s16x4*)(Vb + (keyrow + 8) * 288 + (32 * et + 16 * blk) * 2 + 8 * p4));
                            const bf16x8 vf = __builtin_shufflevector(lo, hi, 0, 1, 2, 3, 4, 5, 6, 7);
                            O[et] = MFMA32(vf, pf[kt2][s2], O[et]);
                        }
                    }
            }
            if (kt + 1 < nt_all) ATT_STORE((kt + 1) & 1);
            __syncthreads();
        }
#undef ATT_LOAD
#undef ATT_STORE
        const float lt = l + __shfl_xor(l, 32);
        const float inv = (nt_mine > 0) ? 1.f / lt : 0.f;
        LAS float* XO = (LAS float*)lds;
        if (comp == 1) {
            const float sc = inv * lam;
#pragma unroll
            for (int et = 0; et < 4; ++et)
#pragma unroll
                for (int i = 0; i < 16; ++i) XO[(rg * 128 + 32 * et + (i & 3) + 8 * (i >> 2) + 4 * h2) * 32 + r32] = O[et][i] * sc;
        }
        __syncthreads();
        if (comp == 0 && nt_mine > 0) {
            float ss = 0.f;
#pragma unroll
            for (int et = 0; et < 4; ++et)
#pragma unroll
                for (int i = 0; i < 16; ++i) { const float v = O[et][i] * inv - XO[(rg * 128 + 32 * et + (i & 3) + 8 * (i >> 2) + 4 * h2) * 32 + r32]; O[et][i] = v; ss += v * v; }
            ss += __shfl_xor(ss, 32);
            const float rstd = rsqrtf(ss * (1.f / 128.f) + RMS_EPS) * (1.f - lam_init);
            const bool rvalid = sample ? (r32 < TS) : true;
            const int row = qrow0 + r32;
            if (rvalid) {
#pragma unroll
                for (int et = 0; et < 4; ++et)
#pragma unroll
                    for (int g4 = 0; g4 < 4; ++g4) {
                        const int e0 = 32 * et + 8 * g4 + 4 * h2;
                        const u32x2 zz = *(const u32x2*)(proj + (size_t)row * NPROJ + 3072 + h * 128 + e0);
                        const f32x4 sl = *(const f32x4*)(subln + e0);
                        const float z0 = __uint_as_float(zz.x << 16), z1 = __uint_as_float(zz.x & 0xffff0000u), z2 = __uint_as_float(zz.y << 16), z3 = __uint_as_float(zz.y & 0xffff0000u);
                        u32x2 w;
                        w.x = pk2(O[et][4 * g4] * rstd * sl[0] * siluf(z0), O[et][4 * g4 + 1] * rstd * sl[1] * siluf(z1));
                        w.y = pk2(O[et][4 * g4 + 2] * rstd * sl[2] * siluf(z2), O[et][4 * g4 + 3] * rstd * sl[3] * siluf(z3));
                        *(u32x2*)(OB + (size_t)row * 1024 + h * 128 + e0) = w;
                    }
            }
        }
        __syncthreads();
    }
}

typedef const __attribute__((address_space(4))) Params* CParP;
#define LOADP() Params P; { CParP kp_ = KP; asm volatile("" : "+s"(kp_)); P = *kp_; } unsigned char* ws = P.ws; (void)ws
__global__ void __launch_bounds__(512, 2) fwd_megakernel(Params Pin) {
#if defined(__HIP_DEVICE_COMPILE__)
    extern __shared__ __attribute__((aligned(16))) unsigned char lds_raw[];
    LAS unsigned char* lds = (LAS unsigned char*)lds_raw;
    cg::grid_group grid = cg::this_grid();
    const CParP KP = (CParP)__builtin_amdgcn_kernarg_segment_ptr();
    for (int rep = opaque_i(REP_PREP); rep > 0; --rep) { LOADP(); phase_prep(P, lds); }
    grid.sync();
    for (int layer = 0; layer < 4; ++layer) {
        const int j = layer >> 1;
        { LOADP(); phase_elem(P, lds, layer); }
        grid.sync();
        for (int rep = opaque_i(REP_GIN); rep > 0; --rep) {
            LOADP();
            pg8::StaticOrder S; S.init(M, NPROJ, gridDim.x, blockIdx.x);
            pg8::Gemm g;
            g.A = (const bf16_t*)(ws + WS_HBUF); g.M = M; g.N = NPROJ; g.K = 1024;
            if (!(layer & 1)) {
                g.Bt = (const bf16_t*)(ws + WS_WING) + (size_t)j * 4096 * 1024;
                EpiGdnIn E; E.proj = (bf16_t*)(ws + WS_PROJ); E.conv_p = P.out + OFF_CVP + (size_t)j * 4 * 3 * 3072; E.conv_s = P.out + OFF_CVS + (size_t)j * 16 * 3 * 3072;
                pg8::gemm_phase(lds, g, S, E);
            } else {
                g.Bt = (const bf16_t*)(ws + WS_WIND) + (size_t)j * 4096 * 1024;
                EpiDiffIn E; E.proj = (bf16_t*)(ws + WS_PROJ);
                E.k_p = P.out + OFF_KP + (size_t)j * MP * 1024; E.v_p = P.out + OFF_VP + (size_t)j * MP * 1024;
                E.k_s = P.out + OFF_KSO + (size_t)j * MS * 1024; E.v_s = P.out + OFF_VSO + (size_t)j * MS * 1024;
                E.ks = (bf16_t*)(ws + WS_KS); E.vs = (bf16_t*)(ws + WS_VS); E.rope = (const float*)(ws + WS_ROPE);
                pg8::gemm_phase(lds, g, S, E);
            }
        }
        grid.sync();
        if (!(layer & 1)) {
            for (int rep = opaque_i(REP_G1); rep > 0; --rep) { LOADP(); phase_g1(P, lds, layer); }
            grid.sync();
            for (int rep = opaque_i(REP_SCAN); rep > 0; --rep) { LOADP(); phase_scan(P, lds, layer); }
        } else {
            for (int rep = opaque_i(REP_ATTN); rep > 0; --rep) { LOADP(); phase_attn(P, lds, layer); }
        }
        grid.sync();
        for (int rep = opaque_i(REP_GOUT); rep > 0; --rep) {
            LOADP();
            pg8::StaticOrder S; S.init(M, 1024, gridDim.x, blockIdx.x);
            pg8::Gemm g;
            g.A = (const bf16_t*)(ws + WS_HBUF); g.M = M; g.N = 1024; g.K = 1024;
            g.Bt = (const bf16_t*)(ws + ((layer & 1) ? WS_WOUTD : WS_WOUTG)) + (size_t)j * 1024 * 1024;
            EpiOut E; E.C = (float*)(ws + WS_PROJ);
            pg8::gemm_phase(lds, g, S, E);
        }
        grid.sync();
    }
    { LOADP(); phase_elem(P, lds, 4); }
#endif
}

extern "C" void kernel_launch(void* const* d_in, const int* in_sizes, int n_in, void* d_out, int out_size, void* d_ws, size_t ws_size, hipStream_t stream) {
    static int grid_blocks = 0;
    if (!grid_blocks) {
        int dev = 0, cus = 0, per_cu = 0;
        hipGetDevice(&dev);
        hipDeviceGetAttribute(&cus, hipDeviceAttributeMultiprocessorCount, dev);
        hipFuncSetAttribute((const void*)fwd_megakernel, hipFuncAttributeMaxDynamicSharedMemorySize, LDS_BYTES);
        hipOccupancyMaxActiveBlocksPerMultiprocessor(&per_cu, (const void*)fwd_megakernel, 512, LDS_BYTES);
        if (per_cu < 1) per_cu = 1;
        grid_blocks = cus * per_cu;
        if (ws_size < WS_END) fprintf(stderr, "kernel_launch: workspace too small: %zu < %zu\n", ws_size, (size_t)WS_END);
    }
    Params p{};
    for (int i = 0; i < 25; ++i) p.in[i] = (const float*)d_in[i];
    p.out = (float*)d_out; p.ws = (unsigned char*)d_ws;
    void* args[] = {&p};
    hipError_t e = hipLaunchCooperativeKernel((const void*)fwd_megakernel, dim3(grid_blocks), dim3(512), args, LDS_BYTES, stream);
    if (e != hipSuccess) fprintf(stderr, "cooperative launch failed: %s (grid %d)\n", hipGetErrorString(e), grid_blocks);
}
```

```cpp
#include <hip/hip_runtime.h>
#include <hip/hip_cooperative_groups.h>
#include <cstdio>
namespace cg = cooperative_groups;

#define DI __device__ __forceinline__
#define LAS __attribute__((address_space(3)))
typedef unsigned short bf16_t;
typedef short bf16x8 __attribute__((ext_vector_type(8)));
typedef short s16x4 __attribute__((ext_vector_type(4)));
typedef float f32x2 __attribute__((ext_vector_type(2)));
typedef float f32x4 __attribute__((ext_vector_type(4)));
typedef float f32x16 __attribute__((ext_vector_type(16)));
typedef unsigned u32x2 __attribute__((ext_vector_type(2)));
typedef unsigned u32x4 __attribute__((ext_vector_type(4)));
typedef __bf16 bf16x2_t __attribute__((ext_vector_type(2)));

#define REP_G1 1
#define REP_SCAN 1
#define REP_ATTN 1
#define REP_GIN 1
#define REP_GOUT 1
#define REP_PREP 1
DI int opaque_i(int v) { asm volatile("" : "+s"(v)); return v; }
constexpr int D = 1024, TP = 8192, BP = 4, BS = 16, TS = 16, PAST = 2048;
constexpr int MP = BP * TP, MS = BS * TS, M = MP + MS, NB = BP + BS;
constexpr int NPROJ = 4096;
constexpr int KSROWS = 2112;
constexpr int NITEM_P = 4096, NITEM = 4224;
constexpr size_t ITEM_BYTES = 90112;
constexpr float RMS_EPS = 1e-6f;
constexpr float QSCALE = 0.125f * 1.4426950408889634f;

constexpr size_t OFF_Y = 0;
constexpr size_t OFF_STP = (size_t)M * D;
constexpr size_t OFF_CVP = OFF_STP + 2ull * 4 * 8 * 128 * 128;
constexpr size_t OFF_KP = OFF_CVP + 2ull * 4 * 3 * 3072;
constexpr size_t OFF_VP = OFF_KP + 2ull * MP * 1024;
constexpr size_t OFF_STS = OFF_VP + 2ull * MP * 1024;
constexpr size_t OFF_CVS = OFF_STS + 2ull * 16 * 8 * 128 * 128;
constexpr size_t OFF_KSO = OFF_CVS + 2ull * 16 * 3 * 3072;
constexpr size_t OFF_VSO = OFF_KSO + 2ull * MS * 1024;

constexpr size_t WS_WING = 0;
constexpr size_t WS_WOUTG = WS_WING + 2ull * 4096 * 1024 * 2;
constexpr size_t WS_WIND = WS_WOUTG + 2ull * 1024 * 1024 * 2;
constexpr size_t WS_WOUTD = WS_WIND + 2ull * 4096 * 1024 * 2;
constexpr size_t WS_ADA = WS_WOUTD + 2ull * 1024 * 1024 * 2;
constexpr size_t WS_ROPE = WS_ADA + 4ull * NB * 3072 * 4;
constexpr size_t WS_AB = WS_ROPE + 8208ull * 64 * 4;
constexpr size_t WS_GL = WS_AB + (size_t)M * 16 * 4;
constexpr size_t WS_HBUF = WS_GL + 32768;
constexpr size_t WS_ORAW = WS_HBUF + (size_t)M * 1024 * 2;
constexpr size_t WS_PROJ = WS_ORAW + 256;
constexpr size_t WS_R1 = WS_PROJ + (size_t)M * 4096 * 2;
constexpr size_t WS_KS = WS_R1;
constexpr size_t WS_VS = WS_KS + 16ull * KSROWS * 1024 * 2;
constexpr size_t WS_KH = WS_VS + 16ull * KSROWS * 1024 * 2;
constexpr size_t WS_VH = WS_KH + (size_t)MP * 1024 * 2;
constexpr size_t WS_END = WS_R1 + (size_t)NITEM * ITEM_BYTES;

constexpr int LDS_BYTES = 131072;

struct Params { const float* in[25]; float* out; unsigned char* ws; };

DI float bf2f(bf16_t v) { return __uint_as_float(((unsigned)v) << 16); }
DI unsigned pk2(float a, float b) { f32x2 v = {a, b}; bf16x2_t r = __builtin_convertvector(v, bf16x2_t); return __builtin_bit_cast(unsigned, r); }
DI bf16_t f2bf(float a) { return (bf16_t)(pk2(a, 0.f) & 0xffffu); }
template <int CTRL> DI float dppf(float v) { return __builtin_bit_cast(float, __builtin_amdgcn_update_dpp(0, __builtin_bit_cast(int, v), CTRL, 0xf, 0xf, true)); }
DI float row_sum16(float v) { v += dppf<0x128>(v); v += dppf<0x124>(v); v += dppf<0x122>(v); v += dppf<0x121>(v); return v; }
DI float wave_sum(float v) { v = row_sum16(v); v += __shfl_xor(v, 16); v += __shfl_xor(v, 32); return v; }
DI float readlane_f(float v, int l) { return __builtin_bit_cast(float, __builtin_amdgcn_readlane(__builtin_bit_cast(int, v), l)); }
DI float siluf(float x) { return x / (1.f + __expf(-x)); }
DI int ppos(int idx) { const int d5 = idx & 31; return (idx & ~31) | (((d5 >> 2) & 3) << 3) | ((d5 >> 4) << 2) | (d5 & 3); }
DI int perm64(int ls) { return (ls & 15) | (((ls >> 4) & 1) << 5) | (((ls >> 5) & 1) << 4); }
DI void unpack8(const u32x4 v, float (&o)[8]) {
#pragma unroll
    for (int i = 0; i < 4; ++i) { o[2 * i] = __uint_as_float(v[i] << 16); o[2 * i + 1] = __uint_as_float(v[i] & 0xffff0000u); }
}
DI void g2l16(const void* gptr, unsigned lds_addr) {
    asm volatile("s_mov_b32 m0, %1\n\ts_nop 0\n\tglobal_load_lds_dwordx4 %0, off" :: "v"(gptr), "s"(lds_addr) : "memory", "m0");
}
DI unsigned lds_u32(LAS unsigned char* p) { return (unsigned)(size_t)p; }
#define MFMA16(a, b, c) __builtin_amdgcn_mfma_f32_16x16x32_bf16((a), (b), (c), 0, 0, 0)
#define MFMA32(a, b, c) __builtin_amdgcn_mfma_f32_32x32x16_bf16((a), (b), (c), 0, 0, 0)

namespace pg8 {
constexpr int BM = 256, BK = 64, HALF = 128, HTB = HALF * BK * 2, STAGE_BYTES = 8 * HTB, NXCD = 8, WGM = 8;
DI int lds_byte(int r, int c) { const int st = (r >> 4) * 2 + (c >> 5), rr = r & 15, cc = c & 31, ob = rr * 64 + cc * 2; return st * 1024 + (ob ^ (((ob >> 9) & 1) << 5)); }
DI void stage_rc(int b, int& R, int& C) { const int st = b / 1024, sb = b % 1024, swz = sb ^ (((sb >> 9) & 1) << 5); R = (st >> 1) * 16 + swz / 64; C = (st & 1) * 32 + (swz % 64) / 2; }
struct Unit { int pm, pn; };
struct Gemm { const bf16_t* A; const bf16_t* Bt; int M, N, K; };
struct StaticOrder {
    int nM, nN, nwg, G, c;
    DI void init(int M_, int N_, int G_, int c_) { nM = M_ / BM; nN = N_ / BM; nwg = nM * nN; G = G_; c = c_; }
    DI bool next(int i, Unit& u) const {
        const long L = (long)i * G + c; if (L >= nwg) return false;
        int wgid = (int)L; { const int q = nwg / NXCD, r = nwg % NXCD, xcd = wgid % NXCD, off = wgid / NXCD; wgid = (xcd < r ? xcd * (q + 1) : r * (q + 1) + (xcd - r) * q) + off; }
        const int nig = WGM * nN, gid = wgid / nig, fm = gid * WGM, gsz = (nM - fm) < WGM ? (nM - fm) : WGM;
        u.pm = fm + ((wgid % nig) % gsz); u.pn = (wgid % nig) / gsz; return true;
    }
};

template <class Epi>
DI void gemm_phase(LAS unsigned char* lds, const Gemm g, const StaticOrder& S, const Epi& E) {
    int tid_ = threadIdx.x; asm volatile("" : "+v"(tid_)); const int tid = tid_, wid = __builtin_amdgcn_readfirstlane(tid >> 6), lane = tid & 63, wr = wid >> 2, wc = wid & 3, fr = lane & 15, fq = lane >> 4;
    const int K = g.K, nt = K / BK;
    unsigned voffA[2];
#pragma unroll
    for (int i = 0; i < 2; ++i) { int R, C; stage_rc(tid * 16 + i * 8192, R, C); voffA[i] = (unsigned)(R * K + C) * 2u; }
    const size_t kstep = (size_t)(BK * 2);
    const size_t hstep = (size_t)HALF * K * 2;
    const size_t tstep = 2 * hstep;
    const unsigned ldsw = (unsigned)wid * 1024u;
    const int aoff = lds_byte(wr * 64 + fr, fq * 8), boff = lds_byte(wc * 32 + fr, fq * 8);
#define PG8_SA(b, h) (((b) * 2 + (h)) * HTB)
#define PG8_SB(b, h) ((4 + (b) * 2 + (h)) * HTB)
#define PG8_STAGE(bufoff, gbase) do { _Pragma("unroll") for (int _i = 0; _i < 2; ++_i) \
        __builtin_amdgcn_global_load_lds((const unsigned*)((const char*)(gbase) + voffA[_i]), (LAS unsigned*)(lds + (bufoff) + ldsw + _i * 8192), 16, 0, 0); } while (0)
#define PG8_LDA(dst, b, h) do { _Pragma("unroll") for (int m = 0; m < 4; ++m) _Pragma("unroll") for (int k = 0; k < 2; ++k) dst[m][k] = *(const LAS bf16x8*)(lds + PG8_SA(b, h) + aoff + m * 2048 + k * 1024); } while (0)
#define PG8_LDB(dst, b, h) do { _Pragma("unroll") for (int n = 0; n < 2; ++n) _Pragma("unroll") for (int k = 0; k < 2; ++k) dst[n][k] = *(const LAS bf16x8*)(lds + PG8_SB(b, h) + boff + n * 2048 + k * 1024); } while (0)
#define PG8_MMA(ai, bj, At, Bt) do { __builtin_amdgcn_s_setprio(1); _Pragma("unroll") for (int m = 0; m < 4; ++m) _Pragma("unroll") for (int n = 0; n < 2; ++n) _Pragma("unroll") for (int k = 0; k < 2; ++k) \
        acc[ai][bj][m][n] = __builtin_amdgcn_mfma_f32_16x16x32_bf16(Bt[n][k], At[m][k], acc[ai][bj][m][n], 0, 0, 0); __builtin_amdgcn_s_setprio(0); } while (0)
#define PG8_WAIT_V(n) asm volatile("s_waitcnt vmcnt(" #n ")" ::: "memory")
#define PG8_WAIT_L(n) asm volatile("s_waitcnt lgkmcnt(" #n ")" ::: "memory")
#define PG8_BAR __builtin_amdgcn_s_barrier()
#define PG8_SCHED __builtin_amdgcn_sched_barrier(0)
    Unit cur, nxt; int ui = 0;
    if (!S.next(0, cur)) return;
    f32x4 acc[2][2][4][2];
#pragma unroll
    for (int a = 0; a < 2; ++a)
#pragma unroll
        for (int b = 0; b < 2; ++b)
#pragma unroll
            for (int m = 0; m < 4; ++m)
#pragma unroll
                for (int n = 0; n < 2; ++n) acc[a][b][m][n] = (f32x4){0.f, 0.f, 0.f, 0.f};
    bf16x8 At[4][2], B0[2][2], B1[2][2];
    const char* cA = (const char*)g.A + (size_t)cur.pm * tstep; const char* cB = (const char*)g.Bt + (size_t)cur.pn * tstep;
    PG8_STAGE(PG8_SB(0, 0), cB); PG8_STAGE(PG8_SA(0, 0), cA); PG8_STAGE(PG8_SB(0, 1), cB + hstep); PG8_STAGE(PG8_SA(0, 1), cA + hstep);
    if (wr == 1) PG8_BAR;
    PG8_WAIT_V(4); PG8_BAR;
    PG8_STAGE(PG8_SB(1, 0), cB + kstep); PG8_STAGE(PG8_SA(1, 0), cA + kstep); PG8_STAGE(PG8_SB(1, 1), cB + hstep + kstep);
    PG8_WAIT_V(6); PG8_BAR;
    for (;;) {
        const bool has_next = S.next(ui + 1, nxt);
        const char* nA = has_next ? (const char*)g.A + (size_t)nxt.pm * tstep : cA; const char* nB = has_next ? (const char*)g.Bt + (size_t)nxt.pn * tstep : cB;
        for (int t = 0; t < nt; t += 2) {
            const bool last = (t == nt - 2);
            const char* a1 = cA + (size_t)(t + 1) * kstep;
            const char* a2 = last ? nA : cA + (size_t)(t + 2) * kstep; const char* b2 = last ? nB : cB + (size_t)(t + 2) * kstep;
            const char* a3 = a2 + kstep; const char* b3 = b2 + kstep;
            PG8_LDB(B0, 0, 0); PG8_SCHED; PG8_LDA(At, 0, 0); PG8_STAGE(PG8_SA(1, 1), a1 + hstep);
            PG8_WAIT_L(8); PG8_BAR; PG8_WAIT_L(0); PG8_MMA(0, 0, At, B0); PG8_BAR; PG8_SCHED;
            PG8_LDB(B1, 0, 1); PG8_STAGE(PG8_SB(0, 0), b2);
            PG8_BAR; PG8_WAIT_L(0); PG8_MMA(0, 1, At, B1); PG8_BAR;
            PG8_LDA(At, 0, 1); PG8_STAGE(PG8_SA(0, 0), a2);
            PG8_BAR; PG8_WAIT_L(0); PG8_MMA(1, 0, At, B0); PG8_BAR; PG8_SCHED;
            PG8_STAGE(PG8_SB(0, 1), b2 + hstep);
            PG8_WAIT_V(6); PG8_BAR; PG8_MMA(1, 1, At, B1); PG8_BAR;
            PG8_LDB(B0, 1, 0); PG8_SCHED; PG8_LDA(At, 1, 0); PG8_STAGE(PG8_SA(0, 1), a2 + hstep);
            PG8_WAIT_L(8); PG8_BAR; PG8_WAIT_L(0); PG8_MMA(0, 0, At, B0); PG8_BAR; PG8_SCHED;
            PG8_LDB(B1, 1, 1); PG8_STAGE(PG8_SB(1, 0), b3);
            PG8_BAR; PG8_WAIT_L(0); PG8_MMA(0, 1, At, B1); PG8_BAR;
            PG8_LDA(At, 1, 1); PG8_STAGE(PG8_SA(1, 0), a3);
            PG8_BAR; PG8_WAIT_L(0); PG8_MMA(1, 0, At, B0); PG8_BAR; PG8_SCHED;
            PG8_STAGE(PG8_SB(1, 1), b3 + hstep);
            PG8_WAIT_V(6); PG8_BAR; PG8_MMA(1, 1, At, B1); PG8_BAR;
        }
        E(acc, cur, wr, wc, fr, fq);
        if (!has_next) break;
#pragma unroll
        for (int a = 0; a < 2; ++a)
#pragma unroll
            for (int b = 0; b < 2; ++b)
#pragma unroll
                for (int m = 0; m < 4; ++m)
#pragma unroll
                    for (int n = 0; n < 2; ++n) acc[a][b][m][n] = (f32x4){0.f, 0.f, 0.f, 0.f};
        cur = nxt; cA = nA; cB = nB; ++ui;
    }
    PG8_WAIT_V(0);
    if (wr == 0) PG8_BAR;
    PG8_BAR;
#undef PG8_SA
#undef PG8_SB
#undef PG8_STAGE
#undef PG8_LDA
#undef PG8_LDB
#undef PG8_MMA
#undef PG8_WAIT_V
#undef PG8_WAIT_L
#undef PG8_BAR
#undef PG8_SCHED
}
}

struct EpiGdnIn {
    bf16_t* proj; float* conv_p; float* conv_s;
    DI void operator()(const f32x4 (&acc)[2][2][4][2], const pg8::Unit& u, int wr, int wc, int fr, int fq) const {
        const int row0 = u.pm * 256 + wr * 64 + fr, col0 = u.pn * 256 + wc * 32 + 4 * fq;
#pragma unroll
        for (int ai = 0; ai < 2; ++ai)
#pragma unroll
            for (int m = 0; m < 4; ++m) {
                const int r = row0 + ai * 128 + m * 16;
                bf16_t* rowp = proj + (size_t)r * NPROJ + col0;
                bool tail; float* cp;
                if (r < MP) { const int t = r & (TP - 1), b = r >> 13; tail = t >= TP - 3; cp = conv_p + (size_t)(b * 3 + (t - (TP - 3))) * 3072; }
                else { const int rs = r - MP, t = rs & 15, b = rs >> 4; tail = t >= TS - 3; cp = conv_s + (size_t)(b * 3 + (t - (TS - 3))) * 3072; }
#pragma unroll
                for (int bj = 0; bj < 2; ++bj)
#pragma unroll
                    for (int n = 0; n < 2; ++n) {
                        const f32x4 v = acc[ai][bj][m][n];
                        u32x2 w; w.x = pk2(v[0], v[1]); w.y = pk2(v[2], v[3]);
                        *(u32x2*)(rowp + bj * 128 + n * 16) = w;
                        const int c = col0 + bj * 128 + n * 16;
                        if (tail && c < 3072) *(f32x4*)(cp + c) = v;
                    }
            }
    }
};

struct EpiDiffIn {
    bf16_t* proj; float* k_p; float* v_p; float* k_s; float* v_s; bf16_t* ks; bf16_t* vs; bf16_t* kh; bf16_t* vh; const float* rope;
    DI void operator()(const f32x4 (&acc)[2][2][4][2], const pg8::Unit& u, int wr, int wc, int fr, int fq) const {
        const int part = u.pn >> 2;
        const int row0 = u.pm * 256 + wr * 64 + fr;
        const int d0 = 16 * (wc & 1) + 4 * fq;
        const int cbase = u.pn * 256 + 64 * (wc >> 1) + d0;
#pragma unroll
        for (int ai = 0; ai < 2; ++ai)
#pragma unroll
            for (int m = 0; m < 4; ++m) {
                const int r = row0 + ai * 128 + m * 16;
                const int rs = r - MP;
                const int pidx = (r < MP) ? (r & (TP - 1)) : (TP + (rs & 15));
                f32x4 cs = {1.f, 1.f, 1.f, 1.f}, sn = {0.f, 0.f, 0.f, 0.f};
                if (part < 2) { cs = *(const f32x4*)(rope + (size_t)pidx * 64 + d0); sn = *(const f32x4*)(rope + (size_t)pidx * 64 + 32 + d0); }
#pragma unroll
                for (int bj = 0; bj < 2; ++bj) {
                    const f32x4 x1 = acc[ai][bj][m][0], x2 = acc[ai][bj][m][1];
                    f32x4 y1 = x1 * cs - x2 * sn, y2 = x2 * cs + x1 * sn;
                    const int col = cbase + bj * 128;
                    bf16_t* pp = proj + (size_t)r * NPROJ + col;
                    if (part == 0) { y1 *= QSCALE; y2 *= QSCALE; }
                    u32x2 w1, w2; w1.x = pk2(y1[0], y1[1]); w1.y = pk2(y1[2], y1[3]); w2.x = pk2(y2[0], y2[1]); w2.y = pk2(y2[2], y2[3]);
                    *(u32x2*)pp = w1; *(u32x2*)(pp + 32) = w2;
                    if (part == 1 || part == 2) {
                        const int cc = col - part * 1024;
                        const int hh = cc >> 7, dd = cc & 127;
                        float* op; bf16_t* sp;
                        if (r < MP) { op = (part == 1 ? k_p : v_p) + (size_t)r * 1024 + cc;
                               sp = (part == 1 ? kh : vh) + ((size_t)((r >> 13) * 8 + hh) * TP + (r & (TP - 1))) * 128 + dd; }
                        else { op = (part == 1 ? k_s : v_s) + (size_t)rs * 1024 + cc;
                               sp = (part == 1 ? ks : vs) + ((size_t)((rs >> 4) * 8 + hh) * KSROWS + PAST + (rs & 15)) * 128 + dd; }
                        *(f32x4*)op = y1; *(f32x4*)(op + 32) = y2;
                        *(u32x2*)sp = w1; *(u32x2*)(sp + 32) = w2;
                    }
                }
            }
    }
};

struct EpiOut {
    float* C;
    DI void operator()(const f32x4 (&acc)[2][2][4][2], const pg8::Unit& u, int wr, int wc, int fr, int fq) const {
        const int row0 = u.pm * 256 + wr * 64 + fr, col0 = u.pn * 256 + wc * 32 + 4 * fq;
#pragma unroll
        for (int ai = 0; ai < 2; ++ai)
#pragma unroll
            for (int m = 0; m < 4; ++m) {
                float* rowp = C + (size_t)(row0 + ai * 128 + m * 16) * 1024 + col0;
#pragma unroll
                for (int bj = 0; bj < 2; ++bj)
#pragma unroll
                    for (int n = 0; n < 2; ++n) *(f32x4*)(rowp + bj * 128 + n * 16) = acc[ai][bj][m][n];
            }
    }
};

DI void transpose_tile(const float* W, int ldw, int n0, int k0, bf16_t* WT, bool perm, LAS float* tile) {
    int tid_ = threadIdx.x; asm volatile("" : "+v"(tid_)); const int tid = tid_;
    {
        const int kk = tid >> 4, c4 = (tid & 15) * 4;
#pragma unroll
        for (int p = 0; p < 2; ++p) {
            const f32x4 v = *(const f32x4*)(W + (size_t)(k0 + kk + 32 * p) * ldw + n0 + c4);
            LAS float* t = tile + (kk + 32 * p) * 65 + c4;
            t[0] = v[0]; t[1] = v[1]; t[2] = v[2]; t[3] = v[3];
        }
    }
    __syncthreads();
    {
        const int n = tid >> 3, ks = (tid & 7) * 8;
        const int src = perm ? perm64(n) : n;
        float v[8];
#pragma unroll
        for (int e = 0; e < 8; ++e) v[e] = tile[(ks + e) * 65 + src];
        u32x4 w; w.x = pk2(v[0], v[1]); w.y = pk2(v[2], v[3]); w.z = pk2(v[4], v[5]); w.w = pk2(v[6], v[7]);
        *(u32x4*)(WT + (size_t)(n0 + n) * 1024 + k0 + ks) = w;
    }
    __syncthreads();
}

DI void phase_prep(const Params& P, LAS unsigned char* lds) {
    int tid_ = threadIdx.x; asm volatile("" : "+v"(tid_)); const int tid = tid_, G = gridDim.x;
    unsigned char* ws = P.ws;
    for (int id = blockIdx.x; id < 5120; id += G) {
        const int j = id / 2560; int rem = id % 2560;
        const float* W; int ldw; bf16_t* WT; bool perm = false; int t;
        if (rem < 1024) { W = P.in[12] + (size_t)j * 1024 * 4112; ldw = 4112; WT = (bf16_t*)(ws + WS_WING) + (size_t)j * 4096 * 1024; t = rem; }
        else if (rem < 1280) { W = P.in[17] + (size_t)j * 1024 * 1024; ldw = 1024; WT = (bf16_t*)(ws + WS_WOUTG) + (size_t)j * 1024 * 1024; t = rem - 1024; }
        else if (rem < 2304) { W = P.in[18] + (size_t)j * 1024 * 4096; ldw = 4096; WT = (bf16_t*)(ws + WS_WIND) + (size_t)j * 4096 * 1024; t = rem - 1280; perm = true; }
        else { W = P.in[24] + (size_t)j * 1024 * 1024; ldw = 1024; WT = (bf16_t*)(ws + WS_WOUTD) + (size_t)j * 1024 * 1024; t = rem - 2304; }
        transpose_tile(W, ldw, (t >> 4) * 64, (t & 15) * 64, WT, perm, (LAS float*)lds);
    }
    for (int idx = blockIdx.x * 512 + tid; idx < 8208 * 32; idx += G * 512) {
        const int pi = idx >> 5, d = idx & 31;
        const int pos = pi < TP ? pi : PAST + (pi - TP);
        const float inv = 1.0f / powf(10000.0f, (float)d / 32.0f);
        const float ang = (float)pos * inv;
        const double rev = (double)ang * 0.15915494309189535;
        const double fr = rev - floor(rev);
        float* rp = (float*)(ws + WS_ROPE) + (size_t)pi * 64;
        rp[d] = __builtin_amdgcn_cosf((float)fr);
        rp[32 + d] = __builtin_amdgcn_sinf((float)fr);
    }
    {
        LAS float* cact = (LAS float*)lds;
        LAS float* red = (LAS float*)(lds + 81920);
        bool loaded = false;
        for (int id = (G - 1 - blockIdx.x); id < 192; id += G) {
            if (!loaded) {
                for (int e = tid; e < NB * 1024; e += 512) {
                    const int b = e >> 10, k = e & 1023;
                    const float c = b < BP ? P.in[2][b * 1024 + k] : P.in[3][(b - BP) * 1024 + k];
                    cact[e] = siluf(c);
                }
                loaded = true;
            }
            __syncthreads();
            const int i = id / 48, cb = id % 48;
            const int col = tid & 63, kg = tid >> 6;
            const float* Wp = P.in[10] + (size_t)i * 1024 * 3072 + cb * 64 + col;
            float acc[NB];
#pragma unroll
            for (int b = 0; b < NB; ++b) acc[b] = 0.f;
            for (int k = kg * 128; k < kg * 128 + 128; k += 4) {
                const float w0 = Wp[(size_t)k * 3072], w1 = Wp[(size_t)(k + 1) * 3072], w2 = Wp[(size_t)(k + 2) * 3072], w3 = Wp[(size_t)(k + 3) * 3072];
#pragma unroll
                for (int b = 0; b < NB; ++b) {
                    const f32x4 c4 = *(const LAS f32x4*)(cact + b * 1024 + k);
                    acc[b] += c4[0] * w0 + c4[1] * w1 + c4[2] * w2 + c4[3] * w3;
                }
            }
#pragma unroll
            for (int b = 0; b < NB; ++b) red[(kg * NB + b) * 64 + col] = acc[b];
            __syncthreads();
            for (int o = tid; o < NB * 64; o += 512) {
                const int b = o >> 6, c = o & 63;
                float s = P.in[11][i * 3072 + cb * 64 + c];
#pragma unroll
                for (int g = 0; g < 8; ++g) s += red[(g * NB + b) * 64 + c];
                ((float*)(ws + WS_ADA))[((size_t)i * NB + b) * 3072 + cb * 64 + c] = s;
            }
        }
        __syncthreads();
    }
}

DI void phase_elem(const Params& P, LAS unsigned char* lds, int layer) {
    int tid_ = threadIdx.x; asm volatile("" : "+v"(tid_)); const int tid = tid_, wid = __builtin_amdgcn_readfirstlane(tid >> 6), lane = tid & 63, G = gridDim.x;
    unsigned char* ws = P.ws;
    const int j = layer >> 1;
    const bool gdn = (layer < 4) && !(layer & 1);
    LAS float* wab = (LAS float*)lds;
    if (gdn) {
        const float* Wp = P.in[12] + (size_t)j * 1024 * 4112 + 4096;
        for (int e = tid; e < 16384; e += 512) { const int k = e >> 4, c = e & 15; wab[c * 1024 + k] = Wp[(size_t)k * 4112 + c]; }
        __syncthreads();
    }
    const float* ada = (const float*)(ws + WS_ADA);
    float* X = P.out;
    const float* OUTB = (const float*)(ws + WS_PROJ);
    bf16_t* HB = (bf16_t*)(ws + WS_HBUF);
    float* AB = (float*)(ws + WS_AB);
    for (int r = blockIdx.x * 8 + wid; r < M; r += G * 8) {
        const int b = r < MP ? (r >> 13) : BP + ((r - MP) >> 4);
        const float* xs = (layer <= 1) ? (r < MP ? P.in[0] + (size_t)r * 1024 : P.in[1] + (size_t)(r - MP) * 1024) : X + (size_t)r * 1024;
        f32x4 x[4];
#pragma unroll
        for (int q = 0; q < 4; ++q) x[q] = *(const f32x4*)(xs + 4 * (lane + 64 * q));
        if (layer >= 1) {
            f32x4 o[4]; float ss = 0.f;
#pragma unroll
            for (int q = 0; q < 4; ++q) { o[q] = *(const f32x4*)(OUTB + (size_t)r * 1024 + 4 * (lane + 64 * q)); ss += o[q][0] * o[q][0] + o[q][1] * o[q][1] + o[q][2] * o[q][2] + o[q][3] * o[q][3]; }
            ss = wave_sum(ss);
            const float rstd = rsqrtf(ss * (1.f / 1024.f) + RMS_EPS);
            const float* gp = ada + ((size_t)(layer - 1) * NB + b) * 3072 + 2048;
            const float* np = P.in[9] + (layer - 1) * 1024;
#pragma unroll
            for (int q = 0; q < 4; ++q) {
                const int d = 4 * (lane + 64 * q);
                const f32x4 gt = *(const f32x4*)(gp + d), nw = *(const f32x4*)(np + d);
                x[q] = x[q] + gt * (o[q] * rstd * nw);
                *(f32x4*)(X + (size_t)r * 1024 + d) = x[q];
            }
        }
        if (layer < 4) {
            float ss = 0.f;
#pragma unroll
            for (int q = 0; q < 4; ++q) ss += x[q][0] * x[q][0] + x[q][1] * x[q][1] + x[q][2] * x[q][2] + x[q][3] * x[q][3];
            ss = wave_sum(ss);
            const float rstd = rsqrtf(ss * (1.f / 1024.f) + RMS_EPS);
            const float* ap = ada + ((size_t)layer * NB + b) * 3072;
            const float* np = P.in[8] + layer * 1024;
            f32x4 hv[4];
#pragma unroll
            for (int q = 0; q < 4; ++q) {
                const int d = 4 * (lane + 64 * q);
                const f32x4 sh = *(const f32x4*)(ap + d), sc = *(const f32x4*)(ap + 1024 + d), nw = *(const f32x4*)(np + d);
                hv[q] = (x[q] * rstd * nw) * (1.f + sc) + sh;
                u32x2 w; w.x = pk2(hv[q][0], hv[q][1]); w.y = pk2(hv[q][2], hv[q][3]);
                *(u32x2*)(HB + (size_t)r * 1024 + d) = w;
            }
            if (gdn) {
                float mine = 0.f;
#pragma unroll
                for (int c = 0; c < 16; ++c) {
                    float a = 0.f;
#pragma unroll
                    for (int q = 0; q < 4; ++q) { const f32x4 w4 = *(const LAS f32x4*)(wab + c * 1024 + 4 * (lane + 64 * q)); a += hv[q][0] * w4[0] + hv[q][1] * w4[1] + hv[q][2] * w4[2] + hv[q][3] * w4[3]; }
                    a = row_sum16(a);
                    if ((lane & 15) == c) mine = a;
                }
                mine += __shfl_xor(mine, 16); mine += __shfl_xor(mine, 32);
                if (lane < 16) AB[(size_t)r * 16 + lane] = mine;
            }
        }
    }
    if (layer < 4 && (layer & 1)) {
        const float* ck = P.in[6] + (size_t)j * 16 * PAST * 1024;
        const float* cv = P.in[7] + (size_t)j * 16 * PAST * 1024;
        bf16_t* KS = (bf16_t*)(ws + WS_KS); bf16_t* VS = (bf16_t*)(ws + WS_VS);
        const size_t nun = (size_t)16 * PAST * 128;
        for (size_t u = (size_t)blockIdx.x * 512 + tid; u < 2 * nun; u += (size_t)G * 512) {
            const bool isv = u >= nun; const size_t uu = isv ? u - nun : u;
            const size_t b = uu / ((size_t)PAST * 128), rem = uu % ((size_t)PAST * 128);
            const size_t row = rem >> 7, c8 = rem & 127, hh = c8 >> 4, d8 = c8 & 15;
            const float* sp = (isv ? cv : ck) + uu * 8;
            const f32x4 a = *(const f32x4*)sp, c = *(const f32x4*)(sp + 4);
            u32x4 w; w.x = pk2(a[0], a[1]); w.y = pk2(a[2], a[3]); w.z = pk2(c[0], c[1]); w.w = pk2(c[2], c[3]);
            *(u32x4*)((isv ? VS : KS) + ((b * 8 + hh) * KSROWS + row) * 128 + d8 * 8) = w;
        }
        const size_t npad = (size_t)128 * 48 * 16;
        for (size_t u = (size_t)blockIdx.x * 512 + tid; u < 2 * npad; u += (size_t)G * 512) {
            const bool isv = u >= npad; const size_t uu = isv ? u - npad : u;
            const size_t sq = uu / (48 * 16), rem = uu % (48 * 16);
            *(u32x4*)((isv ? VS : KS) + (sq * KSROWS + PAST + TS) * 128 + rem * 8) = (u32x4){0u, 0u, 0u, 0u};
        }
    }
}

DI void phase_g1(const Params& P, LAS unsigned char* lds, int layer) {
    int tid_ = threadIdx.x; asm volatile("" : "+v"(tid_)); const int tid = tid_, wid = __builtin_amdgcn_readfirstlane(tid >> 6), lane = tid & 63, G = gridDim.x;
    const int fr = lane & 15, fq = lane >> 4;
    unsigned char* ws = P.ws;
    const int j = layer >> 1;
    const bf16_t* proj = (const bf16_t*)(ws + WS_PROJ);
    const float* AB = (const float*)(ws + WS_AB);
    float* GL = (float*)(ws + WS_GL);
    const float* convw = P.in[13] + (size_t)j * 4 * 3072;
    const float* cconv = P.in[5] + (size_t)j * 16 * 3 * 3072;
    LAS unsigned char* Qs = lds;
    LAS unsigned char* Ks = lds + 17408;
    LAS unsigned char* VBt = lds + 34816;
    LAS unsigned char* KBt = lds + 53248;
    LAS float* A32 = (LAS float*)(lds + 71680);
    LAS unsigned char* Ts = lds + 88320;
    LAS unsigned char* QKs = lds + 97536;
    LAS float* Gs = (LAS float*)(lds + 105728);

    for (int item = blockIdx.x; item < NITEM; item += G) {
        int b, h, c, row0, nvalid; bool sample;
        if (item < NITEM_P) { const int seq = item >> 7; b = seq >> 3; h = seq & 7; c = item & 127; row0 = b * TP + 64 * c; nvalid = 64; sample = false; }
        else { const int s = item - NITEM_P; b = s >> 3; h = s & 7; c = 0; row0 = MP + b * TS; nvalid = TS; sample = true; }
        unsigned char* ib = ws + WS_R1 + (size_t)item * ITEM_BYTES;
        float val[8][8];
        float rn[8];
        int tido = tid; asm volatile("" : "+v"(tido));
        const int l16 = tido & 15, grp = tido >> 4, part = grp >> 3, rb = grp & 7;
        const int lane = tido & 63, fr = lane & 15, fq = lane >> 4;
        if (tid < 384) {
            const int ch = part * 1024 + h * 128 + 8 * l16;
            float wv[4][8];
#pragma unroll
            for (int t = 0; t < 4; ++t) {
                const f32x4 a = *(const f32x4*)(convw + t * 3072 + ch), bb = *(const f32x4*)(convw + t * 3072 + ch + 4);
                wv[t][0] = a[0]; wv[t][1] = a[1]; wv[t][2] = a[2]; wv[t][3] = a[3]; wv[t][4] = bb[0]; wv[t][5] = bb[1]; wv[t][6] = bb[2]; wv[t][7] = bb[3];
            }
            float win[4][8];
#pragma unroll
            for (int t = 0; t < 4; ++t)
#pragma unroll
                for (int e = 0; e < 8; ++e) win[t][e] = 0.f;
#pragma unroll
            for (int k = 0; k < 11; ++k) {
                const int lr = 8 * rb - 3 + k;
                float in8[8];
                {
                    const bool use_proj = (lr >= 0 && lr < nvalid) || (lr < 0 && !sample && c > 0);
                    const int lrc = use_proj ? lr : 0;
                    const u32x4 v = *(const u32x4*)(proj + (size_t)(row0 + lrc) * NPROJ + ch);
                    unpack8(v, in8);
                    if (!use_proj) {
#pragma unroll
                        for (int e = 0; e < 8; ++e) in8[e] = 0.f;
                    }
                }
                if (k < 3) {
                    if (sample && lr < 0) {
                        const float* sp = cconv + (size_t)(b * 3 + (3 + lr)) * 3072 + ch;
                        const f32x4 a = *(const f32x4*)sp, bb = *(const f32x4*)(sp + 4);
                        in8[0] = a[0]; in8[1] = a[1]; in8[2] = a[2]; in8[3] = a[3]; in8[4] = bb[0]; in8[5] = bb[1]; in8[6] = bb[2]; in8[7] = bb[3];
                    }
                }
#pragma unroll
                for (int e = 0; e < 8; ++e) { win[0][e] = win[1][e]; win[1][e] = win[2][e]; win[2][e] = win[3][e]; win[3][e] = in8[e]; }
                if (k >= 3) {
                    const bool rv = (lr < nvalid);
                    float ss = 0.f;
#pragma unroll
                    for (int e = 0; e < 8; ++e) {
                        const float y = win[0][e] * wv[0][e] + win[1][e] * wv[1][e] + win[2][e] * wv[2][e] + win[3][e] * wv[3][e];
                        const float s = rv ? siluf(y) : 0.f;
                        val[k - 3][e] = s; ss += s * s;
                    }
                    ss = row_sum16(ss);
                    rn[k - 3] = rsqrtf(ss + 1e-6f);
                }
            }
        } else if (wid == 7) {
            const int r = row0 + (lane < nvalid ? lane : 0);
            const bool valid = lane < nvalid;
            const float a = AB[(size_t)r * 16 + h], bb = AB[(size_t)r * 16 + 8 + h];
            const float xa = a + P.in[15][j * 8 + h];
            const float ey = __expf(-fabsf(xa));
            const float lp = (ey < 0.01f) ? ey * (1.f - ey * (0.5f - ey * 0.33333334f)) : __logf(1.f + ey);
            const float sp = fmaxf(xa, 0.f) + lp;
            float g = valid ? -__expf(P.in[14][j * 8 + h]) * sp : 0.f;
            const float beta = valid ? 1.f / (1.f + __expf(-bb)) : 0.f;
#pragma unroll
            for (int o = 1; o < 64; o <<= 1) { const float t = __shfl_up(g, o); if (lane >= o) g += t; }
            const float glast = readlane_f(g, 63);
            Gs[lane] = g; Gs[64 + lane] = beta; Gs[128 + lane] = __expf(g); Gs[192 + lane] = __expf(glast - g);
            if (lane == 0) GL[item] = __expf(glast);
        }
        __syncthreads();
        if (tid < 384) {
#pragma unroll
            for (int rr = 0; rr < 8; ++rr) {
                const int row = 8 * rb + rr;
                const float beta = Gs[64 + row], eG = Gs[128 + row];
                if (part == 0) {
                    const float sc = rn[rr] * 0.08838834764831845f;
                    float q[8];
#pragma unroll
                    for (int e = 0; e < 8; ++e) q[e] = val[rr][e] * sc;
                    u32x4 w; w.x = pk2(q[0], q[1]); w.y = pk2(q[2], q[3]); w.z = pk2(q[4], q[5]); w.w = pk2(q[6], q[7]);
                    *(LAS u32x4*)(Qs + row * 272 + l16 * 16) = w;
                    bf16_t* qg = (bf16_t*)(ib + 49152) + row * 128;
                    u32x2 g0, g1; g0.x = pk2(q[0] * eG, q[1] * eG); g0.y = pk2(q[2] * eG, q[3] * eG); g1.x = pk2(q[4] * eG, q[5] * eG); g1.y = pk2(q[6] * eG, q[7] * eG);
                    *(u32x2*)(qg + ppos(8 * l16)) = g0; *(u32x2*)(qg + ppos(8 * l16 + 4)) = g1;
                    val[rr][0] = 0.f;
                } else if (part == 1) {
#pragma unroll
                    for (int e = 0; e < 8; ++e) val[rr][e] *= rn[rr];
                    u32x4 w; w.x = pk2(val[rr][0], val[rr][1]); w.y = pk2(val[rr][2], val[rr][3]); w.z = pk2(val[rr][4], val[rr][5]); w.w = pk2(val[rr][6], val[rr][7]);
                    *(LAS u32x4*)(Ks + row * 272 + l16 * 16) = w;
                }
            }
            if (part >= 1) {
                float bsc[8], ksc[8];
#pragma unroll
                for (int rr = 0; rr < 8; ++rr) { const int row = 8 * rb + rr; const float beta = Gs[64 + row]; bsc[rr] = (part == 1) ? beta * Gs[128 + row] : beta; ksc[rr] = Gs[192 + row]; }
                LAS unsigned char* Tt = (part == 1) ? KBt : VBt;
#pragma unroll
                for (int e = 0; e < 8; ++e) {
                    const int dch = 8 * l16 + e;
                    u32x4 w; w.x = pk2(val[0][e] * bsc[0], val[1][e] * bsc[1]); w.y = pk2(val[2][e] * bsc[2], val[3][e] * bsc[3]);
                    w.z = pk2(val[4][e] * bsc[4], val[5][e] * bsc[5]); w.w = pk2(val[6][e] * bsc[6], val[7][e] * bsc[7]);
                    *(LAS u32x4*)(Tt + dch * 144 + rb * 16) = w;
                    if (part == 1) {
                        bf16_t* kd = (bf16_t*)(ib + 65536) + dch * 64;
                        u32x2 k0, k1; k0.x = pk2(val[0][e] * ksc[0], val[1][e] * ksc[1]); k0.y = pk2(val[2][e] * ksc[2], val[3][e] * ksc[3]);
                        k1.x = pk2(val[4][e] * ksc[4], val[5][e] * ksc[5]); k1.y = pk2(val[6][e] * ksc[6], val[7][e] * ksc[7]);
                        *(u32x2*)(kd + ppos(8 * rb)) = k0; *(u32x2*)(kd + ppos(8 * rb + 4)) = k1;
                    }
                }
            }
        }
        __syncthreads();
        {
            const int mt = wid & 3; const bool isqk = wid >= 4;
            LAS unsigned char* As = isqk ? Qs : Ks;
            f32x4 acc[4];
#pragma unroll
            for (int nt = 0; nt < 4; ++nt) acc[nt] = (f32x4){0.f, 0.f, 0.f, 0.f};
#pragma unroll
            for (int ks = 0; ks < 4; ++ks) {
                const bf16x8 a = *(const LAS bf16x8*)(As + (16 * mt + fr) * 272 + (32 * ks + 8 * fq) * 2);
#pragma unroll
                for (int nt = 0; nt < 4; ++nt) {
                    const bf16x8 bfr = *(const LAS bf16x8*)(Ks + (16 * nt + fr) * 272 + (32 * ks + 8 * fq) * 2);
                    acc[nt] = MFMA16(a, bfr, acc[nt]);
                }
            }
#pragma unroll
            for (int nt = 0; nt < 4; ++nt) {
                const int cp = 16 * nt + fr; const float Gc2 = Gs[cp];
#pragma unroll
                for (int i = 0; i < 4; ++i) {
                    const int cr = 16 * mt + 4 * fq + i;
                    const float dec = __expf(Gs[cr] - Gc2);
                    if (!isqk) A32[cr * 65 + cp] = (cr > cp) ? Gs[64 + cr] * acc[nt][i] * dec : 0.f;
                    else *(LAS bf16_t*)(QKs + (cr * 64 + ppos(cp)) * 2) = f2bf((cr >= cp) ? acc[nt][i] * dec : 0.f);
                }
            }
        }
        __syncthreads();
        {
            float a[64];
#pragma unroll
            for (int jj = 0; jj < 64; ++jj) a[jj] = A32[lane * 65 + jj];
            float x[8];
#pragma unroll
            for (int cc = 0; cc < 8; ++cc) x[cc] = (lane == 8 * wid + cc) ? 1.f : 0.f;
#pragma unroll
            for (int jj = 0; jj < 64; ++jj) {
                if (jj >= 8 * wid) {
#pragma unroll
                    for (int cc = 0; cc < 8; ++cc) { const float xj = readlane_f(x[cc], jj); x[cc] -= a[jj] * xj; }
                }
            }
            u32x4 w; w.x = pk2(x[0], x[1]); w.y = pk2(x[2], x[3]); w.z = pk2(x[4], x[5]); w.w = pk2(x[6], x[7]);
            *(LAS u32x4*)(Ts + lane * 144 + wid * 16) = w;
            *(u32x4*)(ib + 81920 + tid * 16) = *(const LAS u32x4*)(QKs + tid * 16);
        }
        __syncthreads();
        {
            const bool isw = wid >= 4; const int n0 = 32 * (wid & 3);
            LAS unsigned char* Bs = isw ? KBt : VBt;
            f32x4 acc[4][2];
#pragma unroll
            for (int mt = 0; mt < 4; ++mt) { acc[mt][0] = (f32x4){0.f, 0.f, 0.f, 0.f}; acc[mt][1] = (f32x4){0.f, 0.f, 0.f, 0.f}; }
#pragma unroll
            for (int ks = 0; ks < 2; ++ks) {
                bf16x8 bfr[2];
#pragma unroll
                for (int nn = 0; nn < 2; ++nn) bfr[nn] = *(const LAS bf16x8*)(Bs + (n0 + 16 * nn + fr) * 144 + (32 * ks + 8 * fq) * 2);
#pragma unroll
                for (int mt = 0; mt < 4; ++mt) {
                    const bf16x8 a = *(const LAS bf16x8*)(Ts + (16 * mt + fr) * 144 + (32 * ks + 8 * fq) * 2);
                    acc[mt][0] = MFMA16(a, bfr[0], acc[mt][0]); acc[mt][1] = MFMA16(a, bfr[1], acc[mt][1]);
                }
            }
            if (!isw) {
                float* U = (float*)ib;
#pragma unroll
                for (int mt = 0; mt < 4; ++mt)
#pragma unroll
                    for (int nn = 0; nn < 2; ++nn)
#pragma unroll
                        for (int i = 0; i < 4; ++i) U[(16 * mt + 4 * fq + i) * 128 + n0 + 16 * nn + fr] = acc[mt][nn][i];
            } else {
#pragma unroll
                for (int mt = 0; mt < 4; ++mt)
#pragma unroll
                    for (int nn = 0; nn < 2; ++nn)
#pragma unroll
                        for (int i = 0; i < 4; ++i) *(LAS bf16_t*)(Qs + ((16 * mt + 4 * fq + i) * 128 + ppos(n0 + 16 * nn + fr)) * 2) = f2bf(acc[mt][nn][i]);
            }
        }
        __syncthreads();
        {
            *(u32x4*)(ib + 32768 + tid * 16) = *(const LAS u32x4*)(Qs + tid * 16);
            *(u32x4*)(ib + 32768 + 8192 + tid * 16) = *(const LAS u32x4*)(Qs + 8192 + tid * 16);
        }
        __syncthreads();
    }
}

DI void phase_scan(const Params& P, LAS unsigned char* lds, int layer) {
    int tid_ = threadIdx.x; asm volatile("" : "+v"(tid_)); const int tid = tid_, wid = __builtin_amdgcn_readfirstlane(tid >> 6), lane = tid & 63, G = gridDim.x;
    const int fr = lane & 15, fq = lane >> 4;
    unsigned char* ws = P.ws;
    const int j = layer >> 1;
    const bf16_t* proj = (const bf16_t*)(ws + WS_PROJ);
    const float* GL = (const float*)(ws + WS_GL);
    bf16_t* OB = (bf16_t*)(ws + WS_HBUF);
    constexpr int BUFB = 57344;
    LAS float* red = (LAS float*)(lds + 2 * BUFB);

    for (int seq = blockIdx.x; seq < 160; seq += G) {
        int b, h, nch, item0, row0, nvalid; float* stout;
        f32x4 st[8];
        const int dvc = 16 * wid + fr;
        if (seq < 32) {
            b = seq >> 3; h = seq & 7; nch = 128; item0 = seq * 128; row0 = b * TP; nvalid = 64;
            stout = P.out + OFF_STP + ((size_t)(j * 4 + b) * 8 + h) * 16384;
#pragma unroll
            for (int mt = 0; mt < 8; ++mt) st[mt] = (f32x4){0.f, 0.f, 0.f, 0.f};
        } else {
            const int s = seq - 32; b = s >> 3; h = s & 7; nch = 1; item0 = NITEM_P + s; row0 = MP + b * TS; nvalid = TS;
            stout = P.out + OFF_STS + ((size_t)(j * 16 + b) * 8 + h) * 16384;
            const float* s0 = P.in[4] + ((size_t)(j * 16 + b) * 8 + h) * 16384;
            const unsigned s0o = (unsigned)(4 * fq * 128 + dvc);
#pragma unroll
            for (int mt = 0; mt < 8; ++mt)
#pragma unroll
                for (int i = 0; i < 4; ++i) st[mt][i] = s0[(unsigned)((16 * mt + i) * 128) + s0o];
        }
        const float onw = P.in[16][j * 128 + dvc];
        f32x4 un[4];
#define SCAN_G2L(itm, bufi, LN) do { const unsigned char* _ib = ws + WS_R1 + (size_t)(itm) * ITEM_BYTES + 32768; \
            _Pragma("unroll") for (int _p = 0; _p < 7; ++_p) { const int _L = (wid + 8 * _p) * 1024 + (LN) * 16; unsigned _src; \
                if (_p < 4) { const int _row = _L >> 8, _ch = (_L >> 4) & 15; _src = (_L & ~255) + ((_ch ^ (_row & 15)) << 4); } \
                else { const int _a = _L - 32768, _row = _a >> 7, _ch = (_a >> 4) & 7; _src = 32768 + (_a & ~127) + ((_ch ^ ((_row >> 1) & 7)) << 4); } \
                g2l16(_ib + _src, lds_u32(lds + (bufi) * BUFB + (wid + 8 * _p) * 1024)); } } while (0)
#define SCAN_LOADU(itm) do { const float* _u = (const float*)(ws + WS_R1 + (size_t)(itm) * ITEM_BYTES); const unsigned _uo = (unsigned)(4 * fq * 128 + 16 * wid + fr); \
            _Pragma("unroll") for (int _m = 0; _m < 4; ++_m) _Pragma("unroll") for (int _i = 0; _i < 4; ++_i) un[_m][_i] = _u[(unsigned)((16 * _m + _i) * 128) + _uo]; } while (0)
        __syncthreads();
        SCAN_G2L(item0, 0, lane);
        SCAN_LOADU(item0);
        float gln = GL[item0];
        asm volatile("s_waitcnt vmcnt(0)" ::: "memory");
        __syncthreads();
        for (int c = 0; c < nch; ++c) {
            int frq = lane; asm volatile("" : "+v"(frq));
            const int fr = frq & 15, fq = frq >> 4;
            LAS unsigned char* bb = lds + (c & 1) * BUFB;
            const float gl = gln;
            f32x4 u[4];
#pragma unroll
            for (int mt = 0; mt < 4; ++mt) u[mt] = un[mt];
            if (c + 1 < nch) { gln = GL[item0 + c + 1]; SCAN_G2L(item0 + c + 1, (c + 1) & 1, frq); }
            const int x16 = fr << 4, x8 = ((fr >> 1) & 7) << 4;
            bf16x8 sf[4];
#pragma unroll
            for (int ks = 0; ks < 4; ++ks) {
                u32x4 w; w.x = pk2(-st[2 * ks][0], -st[2 * ks][1]); w.y = pk2(-st[2 * ks][2], -st[2 * ks][3]); w.z = pk2(-st[2 * ks + 1][0], -st[2 * ks + 1][1]); w.w = pk2(-st[2 * ks + 1][2], -st[2 * ks + 1][3]);
                sf[ks] = __builtin_bit_cast(bf16x8, w);
            }
            bf16x8 fa[4], fb[4];
#define SC_LD256(dst, base, mt) do { _Pragma("unroll") for (int _k = 0; _k < 4; ++_k) \
                dst[_k] = *(const LAS bf16x8*)(bb + (base) + (16 * (mt) + fr) * 256 + ((((4 * _k + fq) << 4)) ^ x16)); } while (0)
#define SC_LD128(dst, base, mtlo) do { _Pragma("unroll") for (int _m = 0; _m < 2; ++_m) _Pragma("unroll") for (int _k = 0; _k < 2; ++_k) \
                dst[_m * 2 + _k] = *(const LAS bf16x8*)(bb + (base) + (16 * ((mtlo) + _m) + fr) * 128 + ((((4 * _k + fq) << 4)) ^ x8)); } while (0)
#define SC_SB __builtin_amdgcn_sched_barrier(0)
#define SC_MU(f, mt) do { _Pragma("unroll") for (int _k = 0; _k < 4; ++_k) u[mt] = MFMA16(f[_k], sf[_k], u[mt]); } while (0)
#define SC_MO(f, mt) do { _Pragma("unroll") for (int _k = 0; _k < 4; ++_k) o[mt] = MFMA16(f[_k], sf[_k], o[mt]); } while (0)
#define SC_MQK(f, mtlo) do { _Pragma("unroll") for (int _m = 0; _m < 2; ++_m) _Pragma("unroll") for (int _k = 0; _k < 2; ++_k) o[(mtlo) + _m] = MFMA16(f[_m * 2 + _k], uf[_k], o[(mtlo) + _m]); } while (0)
#define SC_MKD(f, mtlo) do { _Pragma("unroll") for (int _m = 0; _m < 2; ++_m) { st[(mtlo) + _m] = st[(mtlo) + _m] * gl; _Pragma("unroll") for (int _k = 0; _k < 2; ++_k) st[(mtlo) + _m] = MFMA16(f[_m * 2 + _k], uf[_k], st[(mtlo) + _m]); } } while (0)
            f32x4 o[4];
#pragma unroll
            for (int mt = 0; mt < 4; ++mt) o[mt] = (f32x4){0.f, 0.f, 0.f, 0.f};
            SC_LD256(fa, 0, 0); SC_LD256(fb, 0, 1); SC_SB;
            SC_MU(fa, 0); SC_LD256(fa, 0, 2); SC_SB;
            SC_MU(fb, 1); SC_LD256(fb, 0, 3); SC_SB;
            SC_MU(fa, 2); SC_LD256(fa, 16384, 0); SC_SB;
            SC_MU(fb, 3); SC_LD256(fb, 16384, 1); SC_SB;
#pragma unroll
            for (int ks = 0; ks < 4; ++ks) sf[ks] = sf[ks] ^ (short)0x8000;
            SC_MO(fa, 0); SC_LD256(fa, 16384, 2); SC_SB;
            SC_MO(fb, 1); SC_LD256(fb, 16384, 3); SC_SB;
            SC_MO(fa, 2); SC_LD128(fa, 49152, 0); SC_SB;
            SC_MO(fb, 3); SC_LD128(fb, 49152, 2); SC_SB;
            bf16x8 uf[2];
#pragma unroll
            for (int k2 = 0; k2 < 2; ++k2) {
                u32x4 w; w.x = pk2(u[2 * k2][0], u[2 * k2][1]); w.y = pk2(u[2 * k2][2], u[2 * k2][3]); w.z = pk2(u[2 * k2 + 1][0], u[2 * k2 + 1][1]); w.w = pk2(u[2 * k2 + 1][2], u[2 * k2 + 1][3]);
                uf[k2] = __builtin_bit_cast(bf16x8, w);
            }
            SC_MQK(fa, 0); SC_LD128(fa, 32768, 0); SC_SB;
            SC_MQK(fb, 2); SC_LD128(fb, 32768, 2); SC_SB;
            SC_MKD(fa, 0); SC_LD128(fa, 32768, 4); SC_SB;
            SC_MKD(fb, 2); SC_LD128(fb, 32768, 6); SC_SB;
            SC_MKD(fa, 4); SC_SB;
            SC_MKD(fb, 6);
#undef SC_MU
#undef SC_MO
#undef SC_MQK
#undef SC_MKD
#undef SC_LD256
#undef SC_LD128
#undef SC_SB
            if (c + 1 < nch) SCAN_LOADU(item0 + c + 1);
            unsigned short zr[4][4];
            {
                const bf16_t* zb = proj + (size_t)(row0 + 64 * c) * NPROJ + 3072 + h * 128;
                const unsigned zo = (unsigned)(4 * fq * NPROJ + 16 * wid + fr);
                const int msk = (nvalid == 64) ? 63 : 15;
#pragma unroll
                for (int mt = 0; mt < 4; ++mt)
#pragma unroll
                    for (int i = 0; i < 4; ++i) zr[mt][i] = zb[(unsigned)((((16 * mt) & msk) + i) * NPROJ) + zo];
            }
            LAS float* rd = red + (c & 1) * 512;
            {
                float sel = 0.f;
#pragma unroll
                for (int mt = 0; mt < 4; ++mt)
#pragma unroll
                    for (int i = 0; i < 4; ++i) { const float ss = row_sum16(o[mt][i] * o[mt][i]); if (fr == 4 * mt + i) sel = ss; }
                rd[(16 * (fr >> 2) + 4 * fq + (fr & 3)) * 8 + wid] = sel;
            }
            asm volatile("s_waitcnt vmcnt(0)" ::: "memory");
            __syncthreads();
            {
                const int myrow = 16 * (fr >> 2) + 4 * fq + (fr & 3);
                const f32x4 p0 = *(const LAS f32x4*)(rd + myrow * 8), p1 = *(const LAS f32x4*)(rd + myrow * 8 + 4);
                const float tot = p0[0] + p0[1] + p0[2] + p0[3] + p1[0] + p1[1] + p1[2] + p1[3];
                LAS float* rs = red + 1024 + wid * 64;
                rs[fq * 16 + fr] = rsqrtf(tot * (1.f / 128.f) + RMS_EPS);
                bf16_t* obb = OB + (size_t)(row0 + 64 * c) * 1024 + h * 128;
                const unsigned oo = (unsigned)(4 * fq * 1024 + 16 * wid + fr);
#pragma unroll
                for (int mt = 0; mt < 4; ++mt) {
                    const f32x4 r4 = *(const LAS f32x4*)(rs + fq * 16 + 4 * mt);
#pragma unroll
                    for (int i = 0; i < 4; ++i) {
                        const int lr = 16 * mt + 4 * fq + i;
                        const float ov = o[mt][i] * r4[i] * onw * siluf(bf2f(zr[mt][i]));
                        const bf16_t ob = f2bf(ov);
                        if (lr < nvalid) obb[(unsigned)((16 * mt + i) * 1024) + oo] = ob;
                    }
                }
            }
        }
        {
            int lz = lane; asm volatile("" : "+v"(lz));
            const unsigned so = (unsigned)(4 * (lz >> 4) * 128 + 16 * wid + (lz & 15));
#pragma unroll
            for (int mt = 0; mt < 8; ++mt)
#pragma unroll
                for (int i = 0; i < 4; ++i) stout[(unsigned)((16 * mt + i) * 128) + so] = st[mt][i];
        }
#undef SCAN_G2L
#undef SCAN_LOADU
    }
}

DI void att_s(LAS unsigned char* Ka, int t, const bf16x8 (&qf)[4], f32x16& s0, f32x16& s1) {
#pragma unroll
    for (int i = 0; i < 16; ++i) { s0[i] = 0.f; s1[i] = 0.f; }
    bf16x8 kf[8];
#pragma unroll
    for (int s = 0; s < 4; ++s) { kf[2 * s] = *(const LAS bf16x8*)(Ka + (t ^ (s << 5))); kf[2 * s + 1] = *(const LAS bf16x8*)(Ka + 8192 + (t ^ (s << 5))); }
#pragma unroll
    for (int s = 0; s < 4; ++s) { s0 = MFMA32(kf[2 * s], qf[s], s0); s1 = MFMA32(kf[2 * s + 1], qf[s], s1); }
}
template <bool MASK>
DI float att_softmax(f32x16& s0, f32x16& s1, float& m, float& l, bf16x8 (&pf)[2][2], int h2, int nvk) {
    if (MASK) {
#pragma unroll
        for (int i = 0; i < 16; ++i) {
            const int key = (i & 3) + 8 * (i >> 2) + 4 * h2;
            s0[i] = (key < nvk) ? s0[i] : -INFINITY;
            s1[i] = (32 + key < nvk) ? s1[i] : -INFINITY;
        }
    }
    float mx = s0[0];
#pragma unroll
    for (int i = 1; i < 16; ++i) mx = fmaxf(mx, s0[i]);
#pragma unroll
    for (int i = 0; i < 16; ++i) mx = fmaxf(mx, s1[i]);
    mx = fmaxf(mx, __shfl_xor(mx, 32));
    const float mn = fmaxf(m, mx);
    const float alpha = __builtin_amdgcn_exp2f(m - mn);
    m = mn;
    float ps = 0.f;
#pragma unroll
    for (int i = 0; i < 16; ++i) { s0[i] = __builtin_amdgcn_exp2f(s0[i] - mn); s1[i] = __builtin_amdgcn_exp2f(s1[i] - mn); ps += s0[i] + s1[i]; }
    l = l * alpha + ps;
    u32x4 w;
    w.x = pk2(s0[0], s0[1]); w.y = pk2(s0[2], s0[3]); w.z = pk2(s0[4], s0[5]); w.w = pk2(s0[6], s0[7]); pf[0][0] = __builtin_bit_cast(bf16x8, w);
    w.x = pk2(s0[8], s0[9]); w.y = pk2(s0[10], s0[11]); w.z = pk2(s0[12], s0[13]); w.w = pk2(s0[14], s0[15]); pf[0][1] = __builtin_bit_cast(bf16x8, w);
    w.x = pk2(s1[0], s1[1]); w.y = pk2(s1[2], s1[3]); w.z = pk2(s1[4], s1[5]); w.w = pk2(s1[6], s1[7]); pf[1][0] = __builtin_bit_cast(bf16x8, w);
    w.x = pk2(s1[8], s1[9]); w.y = pk2(s1[10], s1[11]); w.z = pk2(s1[12], s1[13]); w.w = pk2(s1[14], s1[15]); pf[1][1] = __builtin_bit_cast(bf16x8, w);
    return alpha;
}
DI void att_pv(LAS unsigned char* Va, int q4, f32x16 (&O)[4], const bf16x8 (&pf)[2][2]) {
    s16x4 lo[16], hi[16];
#define PV_LD(i) do { LAS unsigned char* _vp = Va + ((((i) >> 2) ^ q4) << 6) + (32 * (((i) >> 1) & 1) + 16 * ((i) & 1)) * 256; \
        lo[i] = __builtin_amdgcn_ds_read_tr16_b64_v4i16((LAS s16x4*)_vp); hi[i] = __builtin_amdgcn_ds_read_tr16_b64_v4i16((LAS s16x4*)(_vp + 8 * 256)); } while (0)
    PV_LD(0); PV_LD(1); PV_LD(2);
#pragma unroll
    for (int i = 0; i < 16; ++i) {
        if (i + 3 < 16) PV_LD(i + 3);
        const bf16x8 vf = __builtin_shufflevector(lo[i], hi[i], 0, 1, 2, 3, 4, 5, 6, 7);
        O[i >> 2] = MFMA32(vf, pf[(i >> 1) & 1][i & 1], O[i >> 2]);
    }
#undef PV_LD
}

DI void phase_attn(const Params& P, LAS unsigned char* lds, int layer) {
    int tid_ = threadIdx.x; asm volatile("" : "+v"(tid_)); const int tid = tid_, wid = __builtin_amdgcn_readfirstlane(tid >> 6), lane = tid & 63, G = gridDim.x;
    unsigned char* ws = P.ws;
    const int j = layer >> 1;
    const int comp = wid >> 2, rg = wid & 3, r32 = lane & 31, h2 = lane >> 5;
    const bf16_t* proj = (const bf16_t*)(ws + WS_PROJ);
    bf16_t* OB = (bf16_t*)(ws + WS_HBUF);
    const float lam_init = 0.8f - 0.6f * expf(-0.3f * (float)layer);
    float lam;
    {
        float d1 = 0.f, d2 = 0.f;
        for (int i = 0; i < 64; ++i) { d1 += P.in[19][j * 64 + i] * P.in[20][j * 64 + i]; d2 += P.in[21][j * 64 + i] * P.in[22][j * 64 + i]; }
        lam = expf(d1) - expf(d2) + lam_init;
    }
    const float* subln = P.in[23] + j * 128;
    constexpr int TB = 32768;
    const int vb = (G % 8 == 0) ? (blockIdx.x % 8) * (G / 8) + blockIdx.x / 8 : blockIdx.x;
    const int nrounds = (G == 256) ? 9 : (2176 + G - 1) / G;
#define ATT_WAITV(n) asm volatile("s_waitcnt vmcnt(" #n ")" ::: "memory")
#define ATT_BAR() do { asm volatile("" ::: "memory"); __builtin_amdgcn_s_barrier(); asm volatile("" ::: "memory"); } while (0)
    for (int k = 0; k < nrounds; ++k) {
        int id;
        if (G == 256) {
            if (k < 8) { const int xcd = vb >> 5, idx = vb & 31; const int seq = xcd * 4 + (k >> 1); const int qt = (k & 1) ? idx : (63 - idx); id = seq * 64 + qt; }
            else { if (vb >= 128) break; id = 2048 + vb; }
        } else { id = vb + k * G; if (id >= 2176) break; }
        int h, qrow0, nt_all, nt_mine, last_valid; const int kvstride = 128; const bf16_t* Kp; const bf16_t* Vp; bool sample;
        if (id < 2048) {
            const int seq = id >> 6, qt = id & 63, b = seq >> 3; h = seq & 7; sample = false;
            qrow0 = b * TP + 128 * qt + 32 * rg; nt_all = 2 * qt + 2; nt_mine = (rg < 2) ? 2 * qt + 1 : 2 * qt + 2; last_valid = 64 * nt_mine;
            Kp = (const bf16_t*)(ws + WS_KH) + (size_t)seq * TP * 128; Vp = (const bf16_t*)(ws + WS_VH) + (size_t)seq * TP * 128;
        } else {
            const int s = id - 2048, b = s >> 3; h = s & 7; sample = true;
            qrow0 = MP + b * TS; nt_all = 34; nt_mine = (rg == 0) ? 34 : 0; last_valid = PAST + TS;
            Kp = (const bf16_t*)(ws + WS_KS) + (size_t)s * KSROWS * 128; Vp = (const bf16_t*)(ws + WS_VS) + (size_t)s * KSROWS * 128;
        }
        bf16x8 qf[4];
        {
            const int qr = qrow0 + (sample ? (r32 & 15) : r32);
            const bf16_t* qp = proj + (size_t)qr * NPROJ + h * 128 + comp * 64 + 8 * h2;
#pragma unroll
            for (int s = 0; s < 4; ++s) qf[s] = *(const bf16x8*)(qp + 16 * s);
        }
        f32x16 O[4];
#pragma unroll
        for (int et = 0; et < 4; ++et)
#pragma unroll
            for (int i = 0; i < 16; ++i) O[et][i] = 0.f;
        float m = -INFINITY, l = 0.f;
        bf16x8 pf[2][2];
#pragma unroll
        for (int a = 0; a < 2; ++a)
#pragma unroll
            for (int c2 = 0; c2 < 2; ++c2) pf[a][c2] = (bf16x8){0, 0, 0, 0, 0, 0, 0, 0};
        f32x16 sA0, sA1, sB0, sB1;
        const bf16_t* gsrc;
        {
            const int rowl = lane >> 4, c = lane & 15;
            const int row0 = 16 * (wid & 3) + rowl;
            const int lc = (wid < 4) ? (c ^ (row0 & 15)) : (c ^ ((row0 & 3) << 2));
            gsrc = ((wid < 4) ? Kp : Vp) + (size_t)row0 * kvstride + lc * 8;
        }
#define ATT_G2L(kt, bufi) do { _Pragma("unroll") for (int _i = 0; _i < 4; ++_i) { \
            const bf16_t* _s = gsrc + (size_t)(64 * (kt) + 4 * _i) * kvstride; \
            if (wid < 4) _s += (((lane & 15) ^ ((16 * (wid & 3) + 4 * _i + (lane >> 4)) & 15)) - ((lane & 15) ^ ((16 * (wid & 3) + (lane >> 4)) & 15))) * 8; \
            g2l16(_s, lds_u32(lds + (bufi) * TB + (4 * wid + _i) * 1024)); } } while (0)
        asm volatile("" :: "v"(qf[0]), "v"(qf[1]), "v"(qf[2]), "v"(qf[3]));
        __syncthreads();
        ATT_G2L(0, 0);
        if (nt_all > 1) { ATT_G2L(1, 1); ATT_WAITV(4); } else { ATT_WAITV(0); }
        ATT_BAR();
        {
            const int koff = r32 * 256, t = ((comp * 8 + h2) ^ (r32 & 15)) << 4;
            att_s(lds + koff, t, qf, sA0, sA1);
        }
#define ATT_ITER(KT, sC0, sC1, sN0, sN1, EDGE) do { \
            const int kt = (KT); \
            int lo_ = lane; asm volatile("" : "+v"(lo_)); \
            const int r32_ = lo_ & 31, h2_ = lo_ >> 5, q4_ = (lo_ & 15) >> 2, p4_ = lo_ & 3, blk_ = (lo_ >> 4) & 1; \
            const int koff_ = r32_ * 256, t_ = ((comp * 8 + h2_) ^ (r32_ & 15)) << 4; \
            const int voff_ = (4 * h2_ + q4_) * 256 + (2 * blk_ + (p4_ >> 1)) * 16 + (p4_ & 1) * 8; \
            ATT_WAITV(0); ATT_BAR(); \
            if (kt + 2 < nt_all) ATT_G2L(kt + 2, (kt + 2) & 3); \
            att_s(lds + ((kt + 1) & 3) * TB + koff_, t_, qf, sN0, sN1); \
            if (!(EDGE) || kt >= 1) att_pv(lds + ((kt - 1) & 3) * TB + 16384 + voff_, q4_, O, pf); \
            const float alpha = att_softmax<EDGE>(sC0, sC1, m, l, pf, h2_, last_valid - 64 * kt); \
            asm volatile("" :: "v"(l), "v"(pf[0][0]), "v"(pf[0][1]), "v"(pf[1][0]), "v"(pf[1][1]));     \
            _Pragma("unroll") for (int _g = 0; _g < 24; ++_g) { __builtin_amdgcn_sched_group_barrier(0x008, 1, 0); __builtin_amdgcn_sched_group_barrier(0x002, 7, 0); } \
            if (__any(alpha != 1.f)) { \
                _Pragma("unroll") for (int et = 0; et < 4; ++et) _Pragma("unroll") for (int i = 0; i < 16; ++i) O[et][i] *= alpha; } \
            } while (0)
        {
            const int npairs = nt_all >> 1;
            ATT_ITER(0, sA0, sA1, sB0, sB1, true);
            ATT_ITER(1, sB0, sB1, sA0, sA1, true);
            for (int pp = 1; pp < npairs - 1; ++pp) {
                ATT_ITER(2 * pp, sA0, sA1, sB0, sB1, false);
                ATT_ITER(2 * pp + 1, sB0, sB1, sA0, sA1, false);
            }
            if (npairs > 1) {
                ATT_ITER(nt_all - 2, sA0, sA1, sB0, sB1, true);
                ATT_ITER(nt_all - 1, sB0, sB1, sA0, sA1, true);
            }
        }
        {
            const int lt = nt_all - 1;
            const int h2b = lane >> 5, q4 = (lane & 15) >> 2, p4 = lane & 3, blk = (lane >> 4) & 1;
            const int voff = (4 * h2b + q4) * 256 + (2 * blk + (p4 >> 1)) * 16 + (p4 & 1) * 8;
            att_pv(lds + (lt & 3) * TB + 16384 + voff, q4, O, pf);
        }
        __syncthreads();
#undef ATT_ITER
#undef ATT_G2L
        const float lt = l + __shfl_xor(l, 32);
        const float inv = (nt_mine > 0) ? 1.f / lt : 0.f;
        LAS float* XO = (LAS float*)lds;
        if (comp == 1) {
            const float sc = inv * lam;
#pragma unroll
            for (int et = 0; et < 4; ++et)
#pragma unroll
                for (int i = 0; i < 16; ++i) XO[(rg * 128 + 32 * et + (i & 3) + 8 * (i >> 2) + 4 * h2) * 32 + r32] = O[et][i] * sc;
        }
        __syncthreads();
        if (comp == 0 && nt_mine > 0) {
            float ss = 0.f;
#pragma unroll
            for (int et = 0; et < 4; ++et)
#pragma unroll
                for (int i = 0; i < 16; ++i) { const float v = O[et][i] * inv - XO[(rg * 128 + 32 * et + (i & 3) + 8 * (i >> 2) + 4 * h2) * 32 + r32]; O[et][i] = v; ss += v * v; }
            ss += __shfl_xor(ss, 32);
            const float rstd = rsqrtf(ss * (1.f / 128.f) + RMS_EPS) * (1.f - lam_init);
            const bool rvalid = sample ? (r32 < TS) : true;
            const int row = qrow0 + r32;
            if (rvalid) {
#pragma unroll
                for (int et = 0; et < 4; ++et)
#pragma unroll
                    for (int g4 = 0; g4 < 4; ++g4) {
                        const int e0 = 32 * et + 8 * g4 + 4 * h2;
                        const u32x2 zz = *(const u32x2*)(proj + (size_t)row * NPROJ + 3072 + h * 128 + e0);
                        const f32x4 sl = *(const f32x4*)(subln + e0);
                        const float z0 = __uint_as_float(zz.x << 16), z1 = __uint_as_float(zz.x & 0xffff0000u), z2 = __uint_as_float(zz.y << 16), z3 = __uint_as_float(zz.y & 0xffff0000u);
                        u32x2 w;
                        w.x = pk2(O[et][4 * g4] * rstd * sl[0] * siluf(z0), O[et][4 * g4 + 1] * rstd * sl[1] * siluf(z1));
                        w.y = pk2(O[et][4 * g4 + 2] * rstd * sl[2] * siluf(z2), O[et][4 * g4 + 3] * rstd * sl[3] * siluf(z3));
                        *(u32x2*)(OB + (size_t)row * 1024 + h * 128 + e0) = w;
                    }
            }
        }
        __syncthreads();
    }
}

typedef const __attribute__((address_space(4))) Params* CParP;
#define LOADP() Params P; { CParP kp_ = KP; asm volatile("" : "+s"(kp_)); P = *kp_; } unsigned char* ws = P.ws; (void)ws
__global__ void __launch_bounds__(512, 2) fwd_megakernel(Params Pin) {
#if defined(__HIP_DEVICE_COMPILE__)
    extern __shared__ __attribute__((aligned(16))) unsigned char lds_raw[];
    LAS unsigned char* lds = (LAS unsigned char*)lds_raw;
    cg::grid_group grid = cg::this_grid();
    const CParP KP = (CParP)__builtin_amdgcn_kernarg_segment_ptr();
    for (int rep = opaque_i(REP_PREP); rep > 0; --rep) { LOADP(); phase_prep(P, lds); }
    grid.sync();
    for (int layer = 0; layer < 4; ++layer) {
        const int j = layer >> 1;
        { LOADP(); phase_elem(P, lds, layer); }
        grid.sync();
        for (int rep = opaque_i(REP_GIN); rep > 0; --rep) {
            LOADP();
            pg8::StaticOrder S; S.init(M, NPROJ, gridDim.x, blockIdx.x);
            pg8::Gemm g;
            g.A = (const bf16_t*)(ws + WS_HBUF); g.M = M; g.N = NPROJ; g.K = 1024;
            if (!(layer & 1)) {
                g.Bt = (const bf16_t*)(ws + WS_WING) + (size_t)j * 4096 * 1024;
                EpiGdnIn E; E.proj = (bf16_t*)(ws + WS_PROJ); E.conv_p = P.out + OFF_CVP + (size_t)j * 4 * 3 * 3072; E.conv_s = P.out + OFF_CVS + (size_t)j * 16 * 3 * 3072;
                pg8::gemm_phase(lds, g, S, E);
            } else {
                g.Bt = (const bf16_t*)(ws + WS_WIND) + (size_t)j * 4096 * 1024;
                EpiDiffIn E; E.proj = (bf16_t*)(ws + WS_PROJ);
                E.k_p = P.out + OFF_KP + (size_t)j * MP * 1024; E.v_p = P.out + OFF_VP + (size_t)j * MP * 1024;
                E.k_s = P.out + OFF_KSO + (size_t)j * MS * 1024; E.v_s = P.out + OFF_VSO + (size_t)j * MS * 1024;
                E.ks = (bf16_t*)(ws + WS_KS); E.vs = (bf16_t*)(ws + WS_VS); E.kh = (bf16_t*)(ws + WS_KH); E.vh = (bf16_t*)(ws + WS_VH); E.rope = (const float*)(ws + WS_ROPE);
                pg8::gemm_phase(lds, g, S, E);
            }
        }
        grid.sync();
        if (!(layer & 1)) {
            for (int rep = opaque_i(REP_G1); rep > 0; --rep) { LOADP(); phase_g1(P, lds, layer); }
            grid.sync();
            for (int rep = opaque_i(REP_SCAN); rep > 0; --rep) { LOADP(); phase_scan(P, lds, layer); }
        } else {
            for (int rep = opaque_i(REP_ATTN); rep > 0; --rep) { LOADP(); phase_attn(P, lds, layer); }
        }
        grid.sync();
        for (int rep = opaque_i(REP_GOUT); rep > 0; --rep) {
            LOADP();
            pg8::StaticOrder S; S.init(M, 1024, gridDim.x, blockIdx.x);
            pg8::Gemm g;
            g.A = (const bf16_t*)(ws + WS_HBUF); g.M = M; g.N = 1024; g.K = 1024;
            g.Bt = (const bf16_t*)(ws + ((layer & 1) ? WS_WOUTD : WS_WOUTG)) + (size_t)j * 1024 * 1024;
            EpiOut E; E.C = (float*)(ws + WS_PROJ);
            pg8::gemm_phase(lds, g, S, E);
        }
        grid.sync();
    }
    { LOADP(); phase_elem(P, lds, 4); }
#endif
}

extern "C" void kernel_launch(void* const* d_in, const int* in_sizes, int n_in, void* d_out, int out_size, void* d_ws, size_t ws_size, hipStream_t stream) {
    static int grid_blocks = 0;
    if (!grid_blocks) {
        int dev = 0, cus = 0, per_cu = 0;
        hipGetDevice(&dev);
        hipDeviceGetAttribute(&cus, hipDeviceAttributeMultiprocessorCount, dev);
        hipFuncSetAttribute((const void*)fwd_megakernel, hipFuncAttributeMaxDynamicSharedMemorySize, LDS_BYTES);
        hipOccupancyMaxActiveBlocksPerMultiprocessor(&per_cu, (const void*)fwd_megakernel, 512, LDS_BYTES);
        if (per_cu < 1) per_cu = 1;
        grid_blocks = cus * per_cu;
        if (ws_size < WS_END) fprintf(stderr, "kernel_launch: workspace too small: %zu < %zu\n", ws_size, (size_t)WS_END);
    }
    Params p{};
    for (int i = 0; i < 25; ++i) p.in[i] = (const float*)d_in[i];
    p.out = (float*)d_out; p.ws = (unsigned char*)d_ws;
    void* args[] = {&p};
    hipError_t e = hipLaunchCooperativeKernel((const void*)fwd_megakernel, dim3(grid_blocks), dim3(512), args, LDS_BYTES, stream);
    if (e != hipSuccess) fprintf(stderr, "cooperative launch failed: %s (grid %d)\n", hipGetErrorString(e), grid_blocks);
}
```

```cpp
#include <hip/hip_runtime.h>
#include <hip/hip_cooperative_groups.h>
#include <cstdio>
namespace cg = cooperative_groups;

#define DI __device__ __forceinline__
#define LAS __attribute__((address_space(3)))
typedef unsigned short bf16_t;
typedef short bf16x8 __attribute__((ext_vector_type(8)));
typedef short s16x4 __attribute__((ext_vector_type(4)));
typedef float f32x2 __attribute__((ext_vector_type(2)));
typedef float f32x4 __attribute__((ext_vector_type(4)));
typedef float f32x16 __attribute__((ext_vector_type(16)));
typedef unsigned u32x2 __attribute__((ext_vector_type(2)));
typedef unsigned u32x4 __attribute__((ext_vector_type(4)));
typedef __bf16 bf16x2_t __attribute__((ext_vector_type(2)));

#define REP_G1 1
#define REP_SCAN 1
#define REP_ATTN 1
#define REP_GIN 1
#define REP_GOUT 1
#define REP_PREP 1
DI int opaque_i(int v) { asm volatile("" : "+s"(v)); return v; }
constexpr int D = 1024, TP = 8192, BP = 4, BS = 16, TS = 16, PAST = 2048;
constexpr int MP = BP * TP, MS = BS * TS, M = MP + MS, NB = BP + BS;
constexpr int NPROJ = 4096;
constexpr int KSROWS = 2112;
constexpr int NITEM_P = 4096, NITEM = 4224;
constexpr size_t ITEM_BYTES = 90112;
constexpr float RMS_EPS = 1e-6f;
constexpr float QSCALE = 0.125f * 1.4426950408889634f;

constexpr size_t OFF_Y = 0;
constexpr size_t OFF_STP = (size_t)M * D;
constexpr size_t OFF_CVP = OFF_STP + 2ull * 4 * 8 * 128 * 128;
constexpr size_t OFF_KP = OFF_CVP + 2ull * 4 * 3 * 3072;
constexpr size_t OFF_VP = OFF_KP + 2ull * MP * 1024;
constexpr size_t OFF_STS = OFF_VP + 2ull * MP * 1024;
constexpr size_t OFF_CVS = OFF_STS + 2ull * 16 * 8 * 128 * 128;
constexpr size_t OFF_KSO = OFF_CVS + 2ull * 16 * 3 * 3072;
constexpr size_t OFF_VSO = OFF_KSO + 2ull * MS * 1024;

constexpr size_t WS_WING = 0;
constexpr size_t WS_WOUTG = WS_WING + 2ull * 4096 * 1024 * 2;
constexpr size_t WS_WIND = WS_WOUTG + 2ull * 1024 * 1024 * 2;
constexpr size_t WS_WOUTD = WS_WIND + 2ull * 4096 * 1024 * 2;
constexpr size_t WS_ADA = WS_WOUTD + 2ull * 1024 * 1024 * 2;
constexpr size_t WS_ROPE = WS_ADA + 4ull * NB * 3072 * 4;
constexpr size_t WS_AB = WS_ROPE + 8208ull * 64 * 4;
constexpr size_t WS_GL = WS_AB + (size_t)M * 16 * 4;
constexpr size_t WS_HBUF = WS_GL + 32768;
constexpr size_t WS_ORAW = WS_HBUF + (size_t)M * 1024 * 2;
constexpr size_t WS_PROJ = WS_ORAW + 256;
constexpr size_t WS_R1 = WS_PROJ + (size_t)M * 4096 * 2;
constexpr size_t WS_KS = WS_R1;
constexpr size_t WS_VS = WS_KS + 16ull * KSROWS * 1024 * 2;
constexpr size_t WS_KH = WS_VS + 16ull * KSROWS * 1024 * 2;
constexpr size_t WS_VH = WS_KH + (size_t)MP * 1024 * 2;
constexpr size_t WS_END = WS_R1 + (size_t)NITEM * ITEM_BYTES;

constexpr int LDS_BYTES = 131072;

struct Params { const float* in[25]; float* out; unsigned char* ws; };

DI float bf2f(bf16_t v) { return __uint_as_float(((unsigned)v) << 16); }
DI unsigned pk2(float a, float b) { f32x2 v = {a, b}; bf16x2_t r = __builtin_convertvector(v, bf16x2_t); return __builtin_bit_cast(unsigned, r); }
DI bf16_t f2bf(float a) { return (bf16_t)(pk2(a, 0.f) & 0xffffu); }
template <int CTRL> DI float dppf(float v) { return __builtin_bit_cast(float, __builtin_amdgcn_update_dpp(0, __builtin_bit_cast(int, v), CTRL, 0xf, 0xf, true)); }
DI float row_sum16(float v) { v += dppf<0x128>(v); v += dppf<0x124>(v); v += dppf<0x122>(v); v += dppf<0x121>(v); return v; }
DI float wave_sum(float v) { v = row_sum16(v); v += __shfl_xor(v, 16); v += __shfl_xor(v, 32); return v; }
DI float readlane_f(float v, int l) { return __builtin_bit_cast(float, __builtin_amdgcn_readlane(__builtin_bit_cast(int, v), l)); }
DI float siluf(float x) { return x * __builtin_amdgcn_rcpf(1.f + __expf(-x)); }
DI int ppos(int idx) { const int d5 = idx & 31; return (idx & ~31) | (((d5 >> 2) & 3) << 3) | ((d5 >> 4) << 2) | (d5 & 3); }
DI int perm64(int ls) { return (ls & 15) | (((ls >> 4) & 1) << 5) | (((ls >> 5) & 1) << 4); }
DI void unpack8(const u32x4 v, float (&o)[8]) {
#pragma unroll
    for (int i = 0; i < 4; ++i) { o[2 * i] = __uint_as_float(v[i] << 16); o[2 * i + 1] = __uint_as_float(v[i] & 0xffff0000u); }
}
DI void g2l16(const void* gptr, unsigned lds_addr) {
    asm volatile("s_mov_b32 m0, %1\n\ts_nop 0\n\tglobal_load_lds_dwordx4 %0, off" :: "v"(gptr), "s"(lds_addr) : "memory", "m0");
}
DI unsigned lds_u32(LAS unsigned char* p) { return (unsigned)(size_t)p; }
#define MFMA16(a, b, c) __builtin_amdgcn_mfma_f32_16x16x32_bf16((a), (b), (c), 0, 0, 0)
#define MFMA32(a, b, c) __builtin_amdgcn_mfma_f32_32x32x16_bf16((a), (b), (c), 0, 0, 0)

namespace pg8 {
constexpr int BM = 256, BK = 64, HALF = 128, HTB = HALF * BK * 2, STAGE_BYTES = 8 * HTB, NXCD = 8, WGM = 8;
DI int lds_byte(int r, int c) { const int st = (r >> 4) * 2 + (c >> 5), rr = r & 15, cc = c & 31, ob = rr * 64 + cc * 2; return st * 1024 + (ob ^ (((ob >> 9) & 1) << 5)); }
DI void stage_rc(int b, int& R, int& C) { const int st = b / 1024, sb = b % 1024, swz = sb ^ (((sb >> 9) & 1) << 5); R = (st >> 1) * 16 + swz / 64; C = (st & 1) * 32 + (swz % 64) / 2; }
struct Unit { int pm, pn; };
struct Gemm { const bf16_t* A; const bf16_t* Bt; int M, N, K; };
struct StaticOrder {
    int nM, nN, nwg, G, c;
    DI void init(int M_, int N_, int G_, int c_) { nM = M_ / BM; nN = N_ / BM; nwg = nM * nN; G = G_; c = c_; }
    DI bool next(int i, Unit& u) const {
        const long L = (long)i * G + c; if (L >= nwg) return false;
        int wgid = (int)L; { const int q = nwg / NXCD, r = nwg % NXCD, xcd = wgid % NXCD, off = wgid / NXCD; wgid = (xcd < r ? xcd * (q + 1) : r * (q + 1) + (xcd - r) * q) + off; }
        const int nig = WGM * nN, gid = wgid / nig, fm = gid * WGM, gsz = (nM - fm) < WGM ? (nM - fm) : WGM;
        u.pm = fm + ((wgid % nig) % gsz); u.pn = (wgid % nig) / gsz; return true;
    }
};

template <class Epi>
DI void gemm_phase(LAS unsigned char* lds, const Gemm g, const StaticOrder& S, const Epi& E) {
    int tid_ = threadIdx.x; asm volatile("" : "+v"(tid_)); const int tid = tid_, wid = __builtin_amdgcn_readfirstlane(tid >> 6), lane = tid & 63, wr = wid >> 2, wc = wid & 3, fr = lane & 15, fq = lane >> 4;
    const int K = g.K, nt = K / BK;
    unsigned voffA[2];
#pragma unroll
    for (int i = 0; i < 2; ++i) { int R, C; stage_rc(tid * 16 + i * 8192, R, C); voffA[i] = (unsigned)(R * K + C) * 2u; }
    const size_t kstep = (size_t)(BK * 2);
    const size_t hstep = (size_t)HALF * K * 2;
    const size_t tstep = 2 * hstep;
    const unsigned ldsw = (unsigned)wid * 1024u;
    const int aoff = lds_byte(wr * 64 + fr, fq * 8), boff = lds_byte(wc * 32 + fr, fq * 8);
#define PG8_SA(b, h) (((b) * 2 + (h)) * HTB)
#define PG8_SB(b, h) ((4 + (b) * 2 + (h)) * HTB)
#define PG8_STAGE(bufoff, gbase) do { _Pragma("unroll") for (int _i = 0; _i < 2; ++_i) \
        __builtin_amdgcn_global_load_lds((const unsigned*)((const char*)(gbase) + voffA[_i]), (LAS unsigned*)(lds + (bufoff) + ldsw + _i * 8192), 16, 0, 0); } while (0)
#define PG8_LDA(dst, b, h) do { _Pragma("unroll") for (int m = 0; m < 4; ++m) _Pragma("unroll") for (int k = 0; k < 2; ++k) dst[m][k] = *(const LAS bf16x8*)(lds + PG8_SA(b, h) + aoff + m * 2048 + k * 1024); } while (0)
#define PG8_LDB(dst, b, h) do { _Pragma("unroll") for (int n = 0; n < 2; ++n) _Pragma("unroll") for (int k = 0; k < 2; ++k) dst[n][k] = *(const LAS bf16x8*)(lds + PG8_SB(b, h) + boff + n * 2048 + k * 1024); } while (0)
#define PG8_MMA(ai, bj, At, Bt) do { __builtin_amdgcn_s_setprio(1); _Pragma("unroll") for (int m = 0; m < 4; ++m) _Pragma("unroll") for (int n = 0; n < 2; ++n) _Pragma("unroll") for (int k = 0; k < 2; ++k) \
        acc[ai][bj][m][n] = __builtin_amdgcn_mfma_f32_16x16x32_bf16(Bt[n][k], At[m][k], acc[ai][bj][m][n], 0, 0, 0); __builtin_amdgcn_s_setprio(0); } while (0)
#define PG8_WAIT_V(n) asm volatile("s_waitcnt vmcnt(" #n ")" ::: "memory")
#define PG8_WAIT_L(n) asm volatile("s_waitcnt lgkmcnt(" #n ")" ::: "memory")
#define PG8_BAR __builtin_amdgcn_s_barrier()
#define PG8_SCHED __builtin_amdgcn_sched_barrier(0)
    Unit cur, nxt; int ui = 0;
    if (!S.next(0, cur)) return;
    f32x4 acc[2][2][4][2];
#pragma unroll
    for (int a = 0; a < 2; ++a)
#pragma unroll
        for (int b = 0; b < 2; ++b)
#pragma unroll
            for (int m = 0; m < 4; ++m)
#pragma unroll
                for (int n = 0; n < 2; ++n) acc[a][b][m][n] = (f32x4){0.f, 0.f, 0.f, 0.f};
    bf16x8 At[4][2], B0[2][2], B1[2][2];
    const char* cA = (const char*)g.A + (size_t)cur.pm * tstep; const char* cB = (const char*)g.Bt + (size_t)cur.pn * tstep;
    PG8_STAGE(PG8_SB(0, 0), cB); PG8_STAGE(PG8_SA(0, 0), cA); PG8_STAGE(PG8_SB(0, 1), cB + hstep); PG8_STAGE(PG8_SA(0, 1), cA + hstep);
    if (wr == 1) PG8_BAR;
    PG8_WAIT_V(4); PG8_BAR;
    PG8_STAGE(PG8_SB(1, 0), cB + kstep); PG8_STAGE(PG8_SA(1, 0), cA + kstep); PG8_STAGE(PG8_SB(1, 1), cB + hstep + kstep);
    PG8_WAIT_V(6); PG8_BAR;
    for (;;) {
        const bool has_next = S.next(ui + 1, nxt);
        const char* nA = has_next ? (const char*)g.A + (size_t)nxt.pm * tstep : cA; const char* nB = has_next ? (const char*)g.Bt + (size_t)nxt.pn * tstep : cB;
        for (int t = 0; t < nt; t += 2) {
            const bool last = (t == nt - 2);
            const char* a1 = cA + (size_t)(t + 1) * kstep;
            const char* a2 = last ? nA : cA + (size_t)(t + 2) * kstep; const char* b2 = last ? nB : cB + (size_t)(t + 2) * kstep;
            const char* a3 = a2 + kstep; const char* b3 = b2 + kstep;
            PG8_LDB(B0, 0, 0); PG8_SCHED; PG8_LDA(At, 0, 0); PG8_STAGE(PG8_SA(1, 1), a1 + hstep);
            PG8_WAIT_L(8); PG8_BAR; PG8_WAIT_L(0); PG8_MMA(0, 0, At, B0); PG8_BAR; PG8_SCHED;
            PG8_LDB(B1, 0, 1); PG8_STAGE(PG8_SB(0, 0), b2);
            PG8_BAR; PG8_WAIT_L(0); PG8_MMA(0, 1, At, B1); PG8_BAR;
            PG8_LDA(At, 0, 1); PG8_STAGE(PG8_SA(0, 0), a2);
            PG8_BAR; PG8_WAIT_L(0); PG8_MMA(1, 0, At, B0); PG8_BAR; PG8_SCHED;
            PG8_STAGE(PG8_SB(0, 1), b2 + hstep);
            PG8_WAIT_V(6); PG8_BAR; PG8_MMA(1, 1, At, B1); PG8_BAR;
            PG8_LDB(B0, 1, 0); PG8_SCHED; PG8_LDA(At, 1, 0); PG8_STAGE(PG8_SA(0, 1), a2 + hstep);
            PG8_WAIT_L(8); PG8_BAR; PG8_WAIT_L(0); PG8_MMA(0, 0, At, B0); PG8_BAR; PG8_SCHED;
            PG8_LDB(B1, 1, 1); PG8_STAGE(PG8_SB(1, 0), b3);
            PG8_BAR; PG8_WAIT_L(0); PG8_MMA(0, 1, At, B1); PG8_BAR;
            PG8_LDA(At, 1, 1); PG8_STAGE(PG8_SA(1, 0), a3);
            PG8_BAR; PG8_WAIT_L(0); PG8_MMA(1, 0, At, B0); PG8_BAR; PG8_SCHED;
            PG8_STAGE(PG8_SB(1, 1), b3 + hstep);
            PG8_WAIT_V(6); PG8_BAR; PG8_MMA(1, 1, At, B1); PG8_BAR;
        }
        E(acc, cur, wr, wc, fr, fq);
        if (!has_next) break;
#pragma unroll
        for (int a = 0; a < 2; ++a)
#pragma unroll
            for (int b = 0; b < 2; ++b)
#pragma unroll
                for (int m = 0; m < 4; ++m)
#pragma unroll
                    for (int n = 0; n < 2; ++n) acc[a][b][m][n] = (f32x4){0.f, 0.f, 0.f, 0.f};
        cur = nxt; cA = nA; cB = nB; ++ui;
    }
    PG8_WAIT_V(0);
    if (wr == 0) PG8_BAR;
    PG8_BAR;
#undef PG8_SA
#undef PG8_SB
#undef PG8_STAGE
#undef PG8_LDA
#undef PG8_LDB
#undef PG8_MMA
#undef PG8_WAIT_V
#undef PG8_WAIT_L
#undef PG8_BAR
#undef PG8_SCHED
}
}

struct EpiGdnIn {
    bf16_t* proj; float* conv_p; float* conv_s;
    DI void operator()(const f32x4 (&acc)[2][2][4][2], const pg8::Unit& u, int wr, int wc, int fr, int fq) const {
        const int row0 = u.pm * 256 + wr * 64 + fr, col0 = u.pn * 256 + wc * 32 + 4 * fq;
#pragma unroll
        for (int ai = 0; ai < 2; ++ai)
#pragma unroll
            for (int m = 0; m < 4; ++m) {
                const int r = row0 + ai * 128 + m * 16;
                bf16_t* rowp = proj + (size_t)r * NPROJ + col0;
                bool tail; float* cp;
                if (r < MP) { const int t = r & (TP - 1), b = r >> 13; tail = t >= TP - 3; cp = conv_p + (size_t)(b * 3 + (t - (TP - 3))) * 3072; }
                else { const int rs = r - MP, t = rs & 15, b = rs >> 4; tail = t >= TS - 3; cp = conv_s + (size_t)(b * 3 + (t - (TS - 3))) * 3072; }
#pragma unroll
                for (int bj = 0; bj < 2; ++bj)
#pragma unroll
                    for (int n = 0; n < 2; ++n) {
                        const f32x4 v = acc[ai][bj][m][n];
                        u32x2 w; w.x = pk2(v[0], v[1]); w.y = pk2(v[2], v[3]);
                        *(u32x2*)(rowp + bj * 128 + n * 16) = w;
                        const int c = col0 + bj * 128 + n * 16;
                        if (tail && c < 3072) *(f32x4*)(cp + c) = v;
                    }
            }
    }
};

struct EpiDiffIn {
    bf16_t* proj; float* k_p; float* v_p; float* k_s; float* v_s; bf16_t* ks; bf16_t* vs; bf16_t* kh; bf16_t* vh; const float* rope;
    DI void operator()(const f32x4 (&acc)[2][2][4][2], const pg8::Unit& u, int wr, int wc, int fr, int fq) const {
        const int part = u.pn >> 2;
        const int row0 = u.pm * 256 + wr * 64 + fr;
        const int d0 = 16 * (wc & 1) + 4 * fq;
        const int cbase = u.pn * 256 + 64 * (wc >> 1) + d0;
#pragma unroll
        for (int ai = 0; ai < 2; ++ai)
#pragma unroll
            for (int m = 0; m < 4; ++m) {
                const int r = row0 + ai * 128 + m * 16;
                const int rs = r - MP;
                const int pidx = (r < MP) ? (r & (TP - 1)) : (TP + (rs & 15));
                f32x4 cs = {1.f, 1.f, 1.f, 1.f}, sn = {0.f, 0.f, 0.f, 0.f};
                if (part < 2) { cs = *(const f32x4*)(rope + (size_t)pidx * 64 + d0); sn = *(const f32x4*)(rope + (size_t)pidx * 64 + 32 + d0); }
#pragma unroll
                for (int bj = 0; bj < 2; ++bj) {
                    const f32x4 x1 = acc[ai][bj][m][0], x2 = acc[ai][bj][m][1];
                    f32x4 y1 = x1 * cs - x2 * sn, y2 = x2 * cs + x1 * sn;
                    const int col = cbase + bj * 128;
                    bf16_t* pp = proj + (size_t)r * NPROJ + col;
                    if (part == 0) { y1 *= QSCALE; y2 *= QSCALE; }
                    u32x2 w1, w2; w1.x = pk2(y1[0], y1[1]); w1.y = pk2(y1[2], y1[3]); w2.x = pk2(y2[0], y2[1]); w2.y = pk2(y2[2], y2[3]);
                    *(u32x2*)pp = w1; *(u32x2*)(pp + 32) = w2;
                    if (part == 1 || part == 2) {
                        const int cc = col - part * 1024;
                        const int hh = cc >> 7, dd = cc & 127;
                        float* op; bf16_t* sp;
                        if (r < MP) { op = (part == 1 ? k_p : v_p) + (size_t)r * 1024 + cc;
                               sp = (part == 1 ? kh : vh) + ((size_t)((r >> 13) * 8 + hh) * TP + (r & (TP - 1))) * 128 + dd; }
                        else { op = (part == 1 ? k_s : v_s) + (size_t)rs * 1024 + cc;
                               sp = (part == 1 ? ks : vs) + ((size_t)((rs >> 4) * 8 + hh) * KSROWS + PAST + (rs & 15)) * 128 + dd; }
                        *(f32x4*)op = y1; *(f32x4*)(op + 32) = y2;
                        *(u32x2*)sp = w1; *(u32x2*)(sp + 32) = w2;
                    }
                }
            }
    }
};

struct EpiOut {
    float* C;
    DI void operator()(const f32x4 (&acc)[2][2][4][2], const pg8::Unit& u, int wr, int wc, int fr, int fq) const {
        const int row0 = u.pm * 256 + wr * 64 + fr, col0 = u.pn * 256 + wc * 32 + 4 * fq;
#pragma unroll
        for (int ai = 0; ai < 2; ++ai)
#pragma unroll
            for (int m = 0; m < 4; ++m) {
                float* rowp = C + (size_t)(row0 + ai * 128 + m * 16) * 1024 + col0;
#pragma unroll
                for (int bj = 0; bj < 2; ++bj)
#pragma unroll
                    for (int n = 0; n < 2; ++n) *(f32x4*)(rowp + bj * 128 + n * 16) = acc[ai][bj][m][n];
            }
    }
};

DI void transpose_tile(const float* W, int ldw, int n0, int k0, bf16_t* WT, bool perm, LAS float* tile) {
    int tid_ = threadIdx.x; asm volatile("" : "+v"(tid_)); const int tid = tid_;
    {
        const int kk = tid >> 4, c4 = (tid & 15) * 4;
#pragma unroll
        for (int p = 0; p < 2; ++p) {
            const f32x4 v = *(const f32x4*)(W + (size_t)(k0 + kk + 32 * p) * ldw + n0 + c4);
            LAS float* t = tile + (kk + 32 * p) * 65 + c4;
            t[0] = v[0]; t[1] = v[1]; t[2] = v[2]; t[3] = v[3];
        }
    }
    __syncthreads();
    {
        const int n = tid >> 3, ks = (tid & 7) * 8;
        const int src = perm ? perm64(n) : n;
        float v[8];
#pragma unroll
        for (int e = 0; e < 8; ++e) v[e] = tile[(ks + e) * 65 + src];
        u32x4 w; w.x = pk2(v[0], v[1]); w.y = pk2(v[2], v[3]); w.z = pk2(v[4], v[5]); w.w = pk2(v[6], v[7]);
        *(u32x4*)(WT + (size_t)(n0 + n) * 1024 + k0 + ks) = w;
    }
    __syncthreads();
}

DI void phase_prep(const Params& P, LAS unsigned char* lds) {
    int tid_ = threadIdx.x; asm volatile("" : "+v"(tid_)); const int tid = tid_, G = gridDim.x;
    unsigned char* ws = P.ws;
    for (int id = blockIdx.x; id < 5120; id += G) {
        const int j = id / 2560; int rem = id % 2560;
        const float* W; int ldw; bf16_t* WT; bool perm = false; int t;
        if (rem < 1024) { W = P.in[12] + (size_t)j * 1024 * 4112; ldw = 4112; WT = (bf16_t*)(ws + WS_WING) + (size_t)j * 4096 * 1024; t = rem; }
        else if (rem < 1280) { W = P.in[17] + (size_t)j * 1024 * 1024; ldw = 1024; WT = (bf16_t*)(ws + WS_WOUTG) + (size_t)j * 1024 * 1024; t = rem - 1024; }
        else if (rem < 2304) { W = P.in[18] + (size_t)j * 1024 * 4096; ldw = 4096; WT = (bf16_t*)(ws + WS_WIND) + (size_t)j * 4096 * 1024; t = rem - 1280; perm = true; }
        else { W = P.in[24] + (size_t)j * 1024 * 1024; ldw = 1024; WT = (bf16_t*)(ws + WS_WOUTD) + (size_t)j * 1024 * 1024; t = rem - 2304; }
        transpose_tile(W, ldw, (t >> 4) * 64, (t & 15) * 64, WT, perm, (LAS float*)lds);
    }
    for (int idx = blockIdx.x * 512 + tid; idx < 8208 * 32; idx += G * 512) {
        const int pi = idx >> 5, d = idx & 31;
        const int pos = pi < TP ? pi : PAST + (pi - TP);
        const float inv = 1.0f / powf(10000.0f, (float)d / 32.0f);
        const float ang = (float)pos * inv;
        const double rev = (double)ang * 0.15915494309189535;
        const double fr = rev - floor(rev);
        float* rp = (float*)(ws + WS_ROPE) + (size_t)pi * 64;
        rp[d] = __builtin_amdgcn_cosf((float)fr);
        rp[32 + d] = __builtin_amdgcn_sinf((float)fr);
    }
    {
        LAS float* cact = (LAS float*)lds;
        LAS float* red = (LAS float*)(lds + 81920);
        bool loaded = false;
        for (int id = (G - 1 - blockIdx.x); id < 192; id += G) {
            if (!loaded) {
                for (int e = tid; e < NB * 1024; e += 512) {
                    const int b = e >> 10, k = e & 1023;
                    const float c = b < BP ? P.in[2][b * 1024 + k] : P.in[3][(b - BP) * 1024 + k];
                    cact[e] = siluf(c);
                }
                loaded = true;
            }
            __syncthreads();
            const int i = id / 48, cb = id % 48;
            const int col = tid & 63, kg = tid >> 6;
            const float* Wp = P.in[10] + (size_t)i * 1024 * 3072 + cb * 64 + col;
            float acc[NB];
#pragma unroll
            for (int b = 0; b < NB; ++b) acc[b] = 0.f;
            for (int k = kg * 128; k < kg * 128 + 128; k += 4) {
                const float w0 = Wp[(size_t)k * 3072], w1 = Wp[(size_t)(k + 1) * 3072], w2 = Wp[(size_t)(k + 2) * 3072], w3 = Wp[(size_t)(k + 3) * 3072];
#pragma unroll
                for (int b = 0; b < NB; ++b) {
                    const f32x4 c4 = *(const LAS f32x4*)(cact + b * 1024 + k);
                    acc[b] += c4[0] * w0 + c4[1] * w1 + c4[2] * w2 + c4[3] * w3;
                }
            }
#pragma unroll
            for (int b = 0; b < NB; ++b) red[(kg * NB + b) * 64 + col] = acc[b];
            __syncthreads();
            for (int o = tid; o < NB * 64; o += 512) {
                const int b = o >> 6, c = o & 63;
                float s = P.in[11][i * 3072 + cb * 64 + c];
#pragma unroll
                for (int g = 0; g < 8; ++g) s += red[(g * NB + b) * 64 + c];
                ((float*)(ws + WS_ADA))[((size_t)i * NB + b) * 3072 + cb * 64 + c] = s;
            }
        }
        __syncthreads();
    }
}

DI void phase_elem(const Params& P, LAS unsigned char* lds, int layer) {
    int tid_ = threadIdx.x; asm volatile("" : "+v"(tid_)); const int tid = tid_, wid = __builtin_amdgcn_readfirstlane(tid >> 6), lane = tid & 63, G = gridDim.x;
    unsigned char* ws = P.ws;
    const int j = layer >> 1;
    const bool gdn = (layer < 4) && !(layer & 1);
    LAS float* wab = (LAS float*)lds;
    if (gdn) {
        const float* Wp = P.in[12] + (size_t)j * 1024 * 4112 + 4096;
        for (int e = tid; e < 16384; e += 512) { const int k = e >> 4, c = e & 15; wab[c * 1024 + k] = Wp[(size_t)k * 4112 + c]; }
        __syncthreads();
    }
    const float* ada = (const float*)(ws + WS_ADA);
    float* X = P.out;
    const float* OUTB = (const float*)(ws + WS_PROJ);
    bf16_t* HB = (bf16_t*)(ws + WS_HBUF);
    float* AB = (float*)(ws + WS_AB);
    for (int r = blockIdx.x * 8 + wid; r < M; r += G * 8) {
        const int b = r < MP ? (r >> 13) : BP + ((r - MP) >> 4);
        const float* xs = (layer <= 1) ? (r < MP ? P.in[0] + (size_t)r * 1024 : P.in[1] + (size_t)(r - MP) * 1024) : X + (size_t)r * 1024;
        f32x4 x[4];
#pragma unroll
        for (int q = 0; q < 4; ++q) x[q] = *(const f32x4*)(xs + 4 * (lane + 64 * q));
        if (layer >= 1) {
            f32x4 o[4]; float ss = 0.f;
#pragma unroll
            for (int q = 0; q < 4; ++q) { o[q] = *(const f32x4*)(OUTB + (size_t)r * 1024 + 4 * (lane + 64 * q)); ss += o[q][0] * o[q][0] + o[q][1] * o[q][1] + o[q][2] * o[q][2] + o[q][3] * o[q][3]; }
            ss = wave_sum(ss);
            const float rstd = rsqrtf(ss * (1.f / 1024.f) + RMS_EPS);
            const float* gp = ada + ((size_t)(layer - 1) * NB + b) * 3072 + 2048;
            const float* np = P.in[9] + (layer - 1) * 1024;
#pragma unroll
            for (int q = 0; q < 4; ++q) {
                const int d = 4 * (lane + 64 * q);
                const f32x4 gt = *(const f32x4*)(gp + d), nw = *(const f32x4*)(np + d);
                x[q] = x[q] + gt * (o[q] * rstd * nw);
                *(f32x4*)(X + (size_t)r * 1024 + d) = x[q];
            }
        }
        if (layer < 4) {
            float ss = 0.f;
#pragma unroll
            for (int q = 0; q < 4; ++q) ss += x[q][0] * x[q][0] + x[q][1] * x[q][1] + x[q][2] * x[q][2] + x[q][3] * x[q][3];
            ss = wave_sum(ss);
            const float rstd = rsqrtf(ss * (1.f / 1024.f) + RMS_EPS);
            const float* ap = ada + ((size_t)layer * NB + b) * 3072;
            const float* np = P.in[8] + layer * 1024;
            f32x4 hv[4];
#pragma unroll
            for (int q = 0; q < 4; ++q) {
                const int d = 4 * (lane + 64 * q);
                const f32x4 sh = *(const f32x4*)(ap + d), sc = *(const f32x4*)(ap + 1024 + d), nw = *(const f32x4*)(np + d);
                hv[q] = (x[q] * rstd * nw) * (1.f + sc) + sh;
                u32x2 w; w.x = pk2(hv[q][0], hv[q][1]); w.y = pk2(hv[q][2], hv[q][3]);
                *(u32x2*)(HB + (size_t)r * 1024 + d) = w;
            }
            if (gdn) {
                float mine = 0.f;
#pragma unroll
                for (int c = 0; c < 16; ++c) {
                    float a = 0.f;
#pragma unroll
                    for (int q = 0; q < 4; ++q) { const f32x4 w4 = *(const LAS f32x4*)(wab + c * 1024 + 4 * (lane + 64 * q)); a += hv[q][0] * w4[0] + hv[q][1] * w4[1] + hv[q][2] * w4[2] + hv[q][3] * w4[3]; }
                    a = row_sum16(a);
                    if ((lane & 15) == c) mine = a;
                }
                mine += __shfl_xor(mine, 16); mine += __shfl_xor(mine, 32);
                if (lane < 16) AB[(size_t)r * 16 + lane] = mine;
            }
        }
    }
    if (layer < 4 && (layer & 1)) {
        const float* ck = P.in[6] + (size_t)j * 16 * PAST * 1024;
        const float* cv = P.in[7] + (size_t)j * 16 * PAST * 1024;
        bf16_t* KS = (bf16_t*)(ws + WS_KS); bf16_t* VS = (bf16_t*)(ws + WS_VS);
        const size_t nun = (size_t)16 * PAST * 128;
        for (size_t u = (size_t)blockIdx.x * 512 + tid; u < 2 * nun; u += (size_t)G * 512) {
            const bool isv = u >= nun; const size_t uu = isv ? u - nun : u;
            const size_t b = uu / ((size_t)PAST * 128), rem = uu % ((size_t)PAST * 128);
            const size_t row = rem >> 7, c8 = rem & 127, hh = c8 >> 4, d8 = c8 & 15;
            const float* sp = (isv ? cv : ck) + uu * 8;
            const f32x4 a = *(const f32x4*)sp, c = *(const f32x4*)(sp + 4);
            u32x4 w; w.x = pk2(a[0], a[1]); w.y = pk2(a[2], a[3]); w.z = pk2(c[0], c[1]); w.w = pk2(c[2], c[3]);
            *(u32x4*)((isv ? VS : KS) + ((b * 8 + hh) * KSROWS + row) * 128 + d8 * 8) = w;
        }
        const size_t npad = (size_t)128 * 48 * 16;
        for (size_t u = (size_t)blockIdx.x * 512 + tid; u < 2 * npad; u += (size_t)G * 512) {
            const bool isv = u >= npad; const size_t uu = isv ? u - npad : u;
            const size_t sq = uu / (48 * 16), rem = uu % (48 * 16);
            *(u32x4*)((isv ? VS : KS) + (sq * KSROWS + PAST + TS) * 128 + rem * 8) = (u32x4){0u, 0u, 0u, 0u};
        }
    }
}

DI void phase_g1(const Params& P, LAS unsigned char* lds, int layer) {
    int tid_ = threadIdx.x; asm volatile("" : "+v"(tid_)); const int tid = tid_, wid = __builtin_amdgcn_readfirstlane(tid >> 6), lane = tid & 63, G = gridDim.x;
    const int fr = lane & 15, fq = lane >> 4;
    unsigned char* ws = P.ws;
    const int j = layer >> 1;
    const bf16_t* proj = (const bf16_t*)(ws + WS_PROJ);
    const float* AB = (const float*)(ws + WS_AB);
    float* GL = (float*)(ws + WS_GL);
    const float* convw = P.in[13] + (size_t)j * 4 * 3072;
    const float* cconv = P.in[5] + (size_t)j * 16 * 3 * 3072;
    LAS unsigned char* Qs = lds;
    LAS unsigned char* Ks = lds + 17408;
    LAS unsigned char* VBt = lds + 34816;
    LAS unsigned char* KBt = lds + 53248;
    LAS float* A32 = (LAS float*)(lds + 71680);
    LAS unsigned char* Ts = lds + 88320;
    LAS unsigned char* QKs = lds + 97536;
    LAS float* Gs = (LAS float*)(lds + 105728);

    for (int item = blockIdx.x; item < NITEM; item += G) {
        int b, h, c, row0, nvalid; bool sample;
        if (item < NITEM_P) { const int seq = item >> 7; b = seq >> 3; h = seq & 7; c = item & 127; row0 = b * TP + 64 * c; nvalid = 64; sample = false; }
        else { const int s = item - NITEM_P; b = s >> 3; h = s & 7; c = 0; row0 = MP + b * TS; nvalid = TS; sample = true; }
        unsigned char* ib = ws + WS_R1 + (size_t)item * ITEM_BYTES;
        float val[8][8];
        float rn[8];
        int tido = tid; asm volatile("" : "+v"(tido));
        const int l16 = tido & 15, grp = tido >> 4, part = grp >> 3, rb = grp & 7;
        const int lane = tido & 63, fr = lane & 15, fq = lane >> 4;
        if (tid < 384) {
            const int ch = part * 1024 + h * 128 + 8 * l16;
            float wv[4][8];
#pragma unroll
            for (int t = 0; t < 4; ++t) {
                const f32x4 a = *(const f32x4*)(convw + t * 3072 + ch), bb = *(const f32x4*)(convw + t * 3072 + ch + 4);
                wv[t][0] = a[0]; wv[t][1] = a[1]; wv[t][2] = a[2]; wv[t][3] = a[3]; wv[t][4] = bb[0]; wv[t][5] = bb[1]; wv[t][6] = bb[2]; wv[t][7] = bb[3];
            }
            float win[4][8];
#pragma unroll
            for (int t = 0; t < 4; ++t)
#pragma unroll
                for (int e = 0; e < 8; ++e) win[t][e] = 0.f;
#pragma unroll
            for (int k = 0; k < 11; ++k) {
                const int lr = 8 * rb - 3 + k;
                float in8[8];
                {
                    const bool use_proj = (lr >= 0 && lr < nvalid) || (lr < 0 && !sample && c > 0);
                    const int lrc = use_proj ? lr : 0;
                    const u32x4 v = *(const u32x4*)(proj + (size_t)(row0 + lrc) * NPROJ + ch);
                    unpack8(v, in8);
                    if (!use_proj) {
#pragma unroll
                        for (int e = 0; e < 8; ++e) in8[e] = 0.f;
                    }
                }
                if (k < 3) {
                    if (sample && lr < 0) {
                        const float* sp = cconv + (size_t)(b * 3 + (3 + lr)) * 3072 + ch;
                        const f32x4 a = *(const f32x4*)sp, bb = *(const f32x4*)(sp + 4);
                        in8[0] = a[0]; in8[1] = a[1]; in8[2] = a[2]; in8[3] = a[3]; in8[4] = bb[0]; in8[5] = bb[1]; in8[6] = bb[2]; in8[7] = bb[3];
                    }
                }
#pragma unroll
                for (int e = 0; e < 8; ++e) { win[0][e] = win[1][e]; win[1][e] = win[2][e]; win[2][e] = win[3][e]; win[3][e] = in8[e]; }
                if (k >= 3) {
                    const bool rv = (lr < nvalid);
                    float ss = 0.f;
#pragma unroll
                    for (int e = 0; e < 8; ++e) {
                        const float y = win[0][e] * wv[0][e] + win[1][e] * wv[1][e] + win[2][e] * wv[2][e] + win[3][e] * wv[3][e];
                        const float s = rv ? siluf(y) : 0.f;
                        val[k - 3][e] = s; ss += s * s;
                    }
                    ss = row_sum16(ss);
                    rn[k - 3] = rsqrtf(ss + 1e-6f);
                }
            }
        } else if (wid == 7) {
            const int r = row0 + (lane < nvalid ? lane : 0);
            const bool valid = lane < nvalid;
            const float a = AB[(size_t)r * 16 + h], bb = AB[(size_t)r * 16 + 8 + h];
            const float xa = a + P.in[15][j * 8 + h];
            const float ey = __expf(-fabsf(xa));
            const float lp = (ey < 0.01f) ? ey * (1.f - ey * (0.5f - ey * 0.33333334f)) : __logf(1.f + ey);
            const float sp = fmaxf(xa, 0.f) + lp;
            float g = valid ? -__expf(P.in[14][j * 8 + h]) * sp : 0.f;
            const float beta = valid ? __builtin_amdgcn_rcpf(1.f + __expf(-bb)) : 0.f;
#pragma unroll
            for (int o = 1; o < 64; o <<= 1) { const float t = __shfl_up(g, o); if (lane >= o) g += t; }
            const float glast = readlane_f(g, 63);
            Gs[lane] = g; Gs[64 + lane] = beta; Gs[128 + lane] = __expf(g); Gs[192 + lane] = __expf(glast - g);
            if (lane == 0) GL[item] = __expf(glast);
        }
        __syncthreads();
        if (tid < 384) {
#pragma unroll
            for (int rr = 0; rr < 8; ++rr) {
                const int row = 8 * rb + rr;
                const float beta = Gs[64 + row], eG = Gs[128 + row];
                if (part == 0) {
                    const float sc = rn[rr] * 0.08838834764831845f;
                    float q[8];
#pragma unroll
                    for (int e = 0; e < 8; ++e) q[e] = val[rr][e] * sc;
                    u32x4 w; w.x = pk2(q[0], q[1]); w.y = pk2(q[2], q[3]); w.z = pk2(q[4], q[5]); w.w = pk2(q[6], q[7]);
                    *(LAS u32x4*)(Qs + row * 272 + l16 * 16) = w;
                    bf16_t* qg = (bf16_t*)(ib + 49152) + row * 128;
                    u32x2 g0, g1; g0.x = pk2(q[0] * eG, q[1] * eG); g0.y = pk2(q[2] * eG, q[3] * eG); g1.x = pk2(q[4] * eG, q[5] * eG); g1.y = pk2(q[6] * eG, q[7] * eG);
                    *(u32x2*)(qg + ppos(8 * l16)) = g0; *(u32x2*)(qg + ppos(8 * l16 + 4)) = g1;
                    val[rr][0] = 0.f;
                } else if (part == 1) {
#pragma unroll
                    for (int e = 0; e < 8; ++e) val[rr][e] *= rn[rr];
                    u32x4 w; w.x = pk2(val[rr][0], val[rr][1]); w.y = pk2(val[rr][2], val[rr][3]); w.z = pk2(val[rr][4], val[rr][5]); w.w = pk2(val[rr][6], val[rr][7]);
                    *(LAS u32x4*)(Ks + row * 272 + l16 * 16) = w;
                }
            }
            if (part >= 1) {
                float bsc[8], ksc[8];
#pragma unroll
                for (int rr = 0; rr < 8; ++rr) { const int row = 8 * rb + rr; const float beta = Gs[64 + row]; bsc[rr] = (part == 1) ? beta * Gs[128 + row] : beta; ksc[rr] = Gs[192 + row]; }
                LAS unsigned char* Tt = (part == 1) ? KBt : VBt;
#pragma unroll
                for (int e = 0; e < 8; ++e) {
                    const int dch = 8 * l16 + e;
                    u32x4 w; w.x = pk2(val[0][e] * bsc[0], val[1][e] * bsc[1]); w.y = pk2(val[2][e] * bsc[2], val[3][e] * bsc[3]);
                    w.z = pk2(val[4][e] * bsc[4], val[5][e] * bsc[5]); w.w = pk2(val[6][e] * bsc[6], val[7][e] * bsc[7]);
                    *(LAS u32x4*)(Tt + dch * 144 + rb * 16) = w;
                    if (part == 1) {
                        bf16_t* kd = (bf16_t*)(ib + 65536) + dch * 64;
                        u32x2 k0, k1; k0.x = pk2(val[0][e] * ksc[0], val[1][e] * ksc[1]); k0.y = pk2(val[2][e] * ksc[2], val[3][e] * ksc[3]);
                        k1.x = pk2(val[4][e] * ksc[4], val[5][e] * ksc[5]); k1.y = pk2(val[6][e] * ksc[6], val[7][e] * ksc[7]);
                        *(u32x2*)(kd + ppos(8 * rb)) = k0; *(u32x2*)(kd + ppos(8 * rb + 4)) = k1;
                    }
                }
            }
        }
        __syncthreads();
        {
            const int mt = wid & 3; const bool isqk = wid >= 4;
            LAS unsigned char* As = isqk ? Qs : Ks;
            f32x4 acc[4];
#pragma unroll
            for (int nt = 0; nt < 4; ++nt) acc[nt] = (f32x4){0.f, 0.f, 0.f, 0.f};
#pragma unroll
            for (int ks = 0; ks < 4; ++ks) {
                const bf16x8 a = *(const LAS bf16x8*)(As + (16 * mt + fr) * 272 + (32 * ks + 8 * fq) * 2);
#pragma unroll
                for (int nt = 0; nt < 4; ++nt) {
                    const bf16x8 bfr = *(const LAS bf16x8*)(Ks + (16 * nt + fr) * 272 + (32 * ks + 8 * fq) * 2);
                    acc[nt] = MFMA16(a, bfr, acc[nt]);
                }
            }
#pragma unroll
            for (int nt = 0; nt < 4; ++nt) {
                const int cp = 16 * nt + fr; const float Gc2 = Gs[cp];
#pragma unroll
                for (int i = 0; i < 4; ++i) {
                    const int cr = 16 * mt + 4 * fq + i;
                    const float dec = __expf(Gs[cr] - Gc2);
                    if (!isqk) A32[cr * 65 + cp] = (cr > cp) ? Gs[64 + cr] * acc[nt][i] * dec : 0.f;
                    else *(LAS bf16_t*)(QKs + (cr * 64 + ppos(cp)) * 2) = f2bf((cr >= cp) ? acc[nt][i] * dec : 0.f);
                }
            }
        }
        __syncthreads();
        {
            float a[64];
#pragma unroll
            for (int jj = 0; jj < 64; ++jj) a[jj] = A32[lane * 65 + jj];
            float x[8];
#pragma unroll
            for (int cc = 0; cc < 8; ++cc) x[cc] = (lane == 8 * wid + cc) ? 1.f : 0.f;
#pragma unroll
            for (int jj = 0; jj < 64; ++jj) {
                if (jj >= 8 * wid) {
#pragma unroll
                    for (int cc = 0; cc < 8; ++cc) { const float xj = readlane_f(x[cc], jj); x[cc] -= a[jj] * xj; }
                }
            }
            u32x4 w; w.x = pk2(x[0], x[1]); w.y = pk2(x[2], x[3]); w.z = pk2(x[4], x[5]); w.w = pk2(x[6], x[7]);
            *(LAS u32x4*)(Ts + lane * 144 + wid * 16) = w;
            *(u32x4*)(ib + 81920 + tid * 16) = *(const LAS u32x4*)(QKs + tid * 16);
        }
        __syncthreads();
        {
            const bool isw = wid >= 4; const int n0 = 32 * (wid & 3);
            LAS unsigned char* Bs = isw ? KBt : VBt;
            f32x4 acc[4][2];
#pragma unroll
            for (int mt = 0; mt < 4; ++mt) { acc[mt][0] = (f32x4){0.f, 0.f, 0.f, 0.f}; acc[mt][1] = (f32x4){0.f, 0.f, 0.f, 0.f}; }
#pragma unroll
            for (int ks = 0; ks < 2; ++ks) {
                bf16x8 bfr[2];
#pragma unroll
                for (int nn = 0; nn < 2; ++nn) bfr[nn] = *(const LAS bf16x8*)(Bs + (n0 + 16 * nn + fr) * 144 + (32 * ks + 8 * fq) * 2);
#pragma unroll
                for (int mt = 0; mt < 4; ++mt) {
                    const bf16x8 a = *(const LAS bf16x8*)(Ts + (16 * mt + fr) * 144 + (32 * ks + 8 * fq) * 2);
                    acc[mt][0] = MFMA16(a, bfr[0], acc[mt][0]); acc[mt][1] = MFMA16(a, bfr[1], acc[mt][1]);
                }
            }
            if (!isw) {
                float* U = (float*)ib;
#pragma unroll
                for (int mt = 0; mt < 4; ++mt)
#pragma unroll
                    for (int nn = 0; nn < 2; ++nn)
#pragma unroll
                        for (int i = 0; i < 4; ++i) U[(16 * mt + 4 * fq + i) * 128 + n0 + 16 * nn + fr] = acc[mt][nn][i];
            } else {
#pragma unroll
                for (int mt = 0; mt < 4; ++mt)
#pragma unroll
                    for (int nn = 0; nn < 2; ++nn)
#pragma unroll
                        for (int i = 0; i < 4; ++i) *(LAS bf16_t*)(Qs + ((16 * mt + 4 * fq + i) * 128 + ppos(n0 + 16 * nn + fr)) * 2) = f2bf(acc[mt][nn][i]);
            }
        }
        __syncthreads();
        {
            *(u32x4*)(ib + 32768 + tid * 16) = *(const LAS u32x4*)(Qs + tid * 16);
            *(u32x4*)(ib + 32768 + 8192 + tid * 16) = *(const LAS u32x4*)(Qs + 8192 + tid * 16);
        }
        __syncthreads();
    }
}

DI void phase_scan(const Params& P, LAS unsigned char* lds, int layer) {
    int tid_ = threadIdx.x; asm volatile("" : "+v"(tid_)); const int tid = tid_, wid = __builtin_amdgcn_readfirstlane(tid >> 6), lane = tid & 63, G = gridDim.x;
    const int fr = lane & 15, fq = lane >> 4;
    unsigned char* ws = P.ws;
    const int j = layer >> 1;
    const bf16_t* proj = (const bf16_t*)(ws + WS_PROJ);
    const float* GL = (const float*)(ws + WS_GL);
    bf16_t* OB = (bf16_t*)(ws + WS_HBUF);
    constexpr int BUFB = 57344;
    LAS float* red = (LAS float*)(lds + 2 * BUFB);

    for (int seq = blockIdx.x; seq < 160; seq += G) {
        int b, h, nch, item0, row0, nvalid; float* stout;
        f32x4 st[8];
        const int dvc = 16 * wid + fr;
        if (seq < 32) {
            b = seq >> 3; h = seq & 7; nch = 128; item0 = seq * 128; row0 = b * TP; nvalid = 64;
            stout = P.out + OFF_STP + ((size_t)(j * 4 + b) * 8 + h) * 16384;
#pragma unroll
            for (int mt = 0; mt < 8; ++mt) st[mt] = (f32x4){0.f, 0.f, 0.f, 0.f};
        } else {
            const int s = seq - 32; b = s >> 3; h = s & 7; nch = 1; item0 = NITEM_P + s; row0 = MP + b * TS; nvalid = TS;
            stout = P.out + OFF_STS + ((size_t)(j * 16 + b) * 8 + h) * 16384;
            const float* s0 = P.in[4] + ((size_t)(j * 16 + b) * 8 + h) * 16384;
            const unsigned s0o = (unsigned)(4 * fq * 128 + dvc);
#pragma unroll
            for (int mt = 0; mt < 8; ++mt)
#pragma unroll
                for (int i = 0; i < 4; ++i) st[mt][i] = s0[(unsigned)((16 * mt + i) * 128) + s0o];
        }
        const float onw = P.in[16][j * 128 + dvc];
        f32x4 un[4];
#define SCAN_G2L(itm, bufi, LN) do { const unsigned char* _ib = ws + WS_R1 + (size_t)(itm) * ITEM_BYTES + 32768; \
            _Pragma("unroll") for (int _p = 0; _p < 7; ++_p) { const int _L = (wid + 8 * _p) * 1024 + (LN) * 16; unsigned _src; \
                if (_p < 4) { const int _row = _L >> 8, _ch = (_L >> 4) & 15; _src = (_L & ~255) + ((_ch ^ (_row & 15)) << 4); } \
                else { const int _a = _L - 32768, _row = _a >> 7, _ch = (_a >> 4) & 7; _src = 32768 + (_a & ~127) + ((_ch ^ ((_row >> 1) & 7)) << 4); } \
                g2l16(_ib + _src, lds_u32(lds + (bufi) * BUFB + (wid + 8 * _p) * 1024)); } } while (0)
#define SCAN_LOADU(itm) do { const float* _u = (const float*)(ws + WS_R1 + (size_t)(itm) * ITEM_BYTES); const unsigned _uo = (unsigned)(4 * fq * 128 + 16 * wid + fr); \
            _Pragma("unroll") for (int _m = 0; _m < 4; ++_m) _Pragma("unroll") for (int _i = 0; _i < 4; ++_i) un[_m][_i] = _u[(unsigned)((16 * _m + _i) * 128) + _uo]; } while (0)
        __syncthreads();
        SCAN_G2L(item0, 0, lane);
        SCAN_LOADU(item0);
        float gln = GL[item0];
        asm volatile("s_waitcnt vmcnt(0)" ::: "memory");
        __syncthreads();
        for (int c = 0; c < nch; ++c) {
            int frq = lane; asm volatile("" : "+v"(frq));
            const int fr = frq & 15, fq = frq >> 4;
            LAS unsigned char* bb = lds + (c & 1) * BUFB;
            const float gl = gln;
            f32x4 u[4];
#pragma unroll
            for (int mt = 0; mt < 4; ++mt) u[mt] = un[mt];
            if (c + 1 < nch) { gln = GL[item0 + c + 1]; SCAN_G2L(item0 + c + 1, (c + 1) & 1, frq); }
            const int x16 = fr << 4, x8 = ((fr >> 1) & 7) << 4;
            bf16x8 sf[4];
#pragma unroll
            for (int ks = 0; ks < 4; ++ks) {
                u32x4 w; w.x = pk2(-st[2 * ks][0], -st[2 * ks][1]); w.y = pk2(-st[2 * ks][2], -st[2 * ks][3]); w.z = pk2(-st[2 * ks + 1][0], -st[2 * ks + 1][1]); w.w = pk2(-st[2 * ks + 1][2], -st[2 * ks + 1][3]);
                sf[ks] = __builtin_bit_cast(bf16x8, w);
            }
            bf16x8 fa[4], fb[4];
#define SC_LD256(dst, base, mt) do { _Pragma("unroll") for (int _k = 0; _k < 4; ++_k) \
                dst[_k] = *(const LAS bf16x8*)(bb + (base) + (16 * (mt) + fr) * 256 + ((((4 * _k + fq) << 4)) ^ x16)); } while (0)
#define SC_LD128(dst, base, mtlo) do { _Pragma("unroll") for (int _m = 0; _m < 2; ++_m) _Pragma("unroll") for (int _k = 0; _k < 2; ++_k) \
                dst[_m * 2 + _k] = *(const LAS bf16x8*)(bb + (base) + (16 * ((mtlo) + _m) + fr) * 128 + ((((4 * _k + fq) << 4)) ^ x8)); } while (0)
#define SC_SB __builtin_amdgcn_sched_barrier(0)
#define SC_MU(f, mt) do { _Pragma("unroll") for (int _k = 0; _k < 4; ++_k) u[mt] = MFMA16(f[_k], sf[_k], u[mt]); } while (0)
#define SC_MO(f, mt) do { _Pragma("unroll") for (int _k = 0; _k < 4; ++_k) o[mt] = MFMA16(f[_k], sf[_k], o[mt]); } while (0)
#define SC_MQK(f, mtlo) do { _Pragma("unroll") for (int _m = 0; _m < 2; ++_m) _Pragma("unroll") for (int _k = 0; _k < 2; ++_k) o[(mtlo) + _m] = MFMA16(f[_m * 2 + _k], uf[_k], o[(mtlo) + _m]); } while (0)
#define SC_MKD(f, mtlo) do { _Pragma("unroll") for (int _m = 0; _m < 2; ++_m) { st[(mtlo) + _m] = st[(mtlo) + _m] * gl; _Pragma("unroll") for (int _k = 0; _k < 2; ++_k) st[(mtlo) + _m] = MFMA16(f[_m * 2 + _k], uf[_k], st[(mtlo) + _m]); } } while (0)
            f32x4 o[4];
#pragma unroll
            for (int mt = 0; mt < 4; ++mt) o[mt] = (f32x4){0.f, 0.f, 0.f, 0.f};
            SC_LD256(fa, 0, 0); SC_LD256(fb, 0, 1); SC_SB;
            SC_MU(fa, 0); SC_LD256(fa, 0, 2); SC_SB;
            SC_MU(fb, 1); SC_LD256(fb, 0, 3); SC_SB;
            SC_MU(fa, 2); SC_LD256(fa, 16384, 0); SC_SB;
            SC_MU(fb, 3); SC_LD256(fb, 16384, 1); SC_SB;
#pragma unroll
            for (int ks = 0; ks < 4; ++ks) sf[ks] = sf[ks] ^ (short)0x8000;
            SC_MO(fa, 0); SC_LD256(fa, 16384, 2); SC_SB;
            SC_MO(fb, 1); SC_LD256(fb, 16384, 3); SC_SB;
            SC_MO(fa, 2); SC_LD128(fa, 49152, 0); SC_SB;
            SC_MO(fb, 3); SC_LD128(fb, 49152, 2); SC_SB;
            bf16x8 uf[2];
#pragma unroll
            for (int k2 = 0; k2 < 2; ++k2) {
                u32x4 w; w.x = pk2(u[2 * k2][0], u[2 * k2][1]); w.y = pk2(u[2 * k2][2], u[2 * k2][3]); w.z = pk2(u[2 * k2 + 1][0], u[2 * k2 + 1][1]); w.w = pk2(u[2 * k2 + 1][2], u[2 * k2 + 1][3]);
                uf[k2] = __builtin_bit_cast(bf16x8, w);
            }
            SC_MQK(fa, 0); SC_LD128(fa, 32768, 0); SC_SB;
            SC_MQK(fb, 2); SC_LD128(fb, 32768, 2); SC_SB;
            SC_MKD(fa, 0); SC_LD128(fa, 32768, 4); SC_SB;
            SC_MKD(fb, 2); SC_LD128(fb, 32768, 6); SC_SB;
            SC_MKD(fa, 4); SC_SB;
            SC_MKD(fb, 6);
#undef SC_MU
#undef SC_MO
#undef SC_MQK
#undef SC_MKD
#undef SC_LD256
#undef SC_LD128
#undef SC_SB
            if (c + 1 < nch) SCAN_LOADU(item0 + c + 1);
            unsigned short zr[4][4];
            {
                const bf16_t* zb = proj + (size_t)(row0 + 64 * c) * NPROJ + 3072 + h * 128;
                const unsigned zo = (unsigned)(4 * fq * NPROJ + 16 * wid + fr);
                const int msk = (nvalid == 64) ? 63 : 15;
#pragma unroll
                for (int mt = 0; mt < 4; ++mt)
#pragma unroll
                    for (int i = 0; i < 4; ++i) zr[mt][i] = zb[(unsigned)((((16 * mt) & msk) + i) * NPROJ) + zo];
            }
            LAS float* rd = red + (c & 1) * 512;
            {
                float sel = 0.f;
#pragma unroll
                for (int mt = 0; mt < 4; ++mt)
#pragma unroll
                    for (int i = 0; i < 4; ++i) { const float ss = row_sum16(o[mt][i] * o[mt][i]); if (fr == 4 * mt + i) sel = ss; }
                rd[(16 * (fr >> 2) + 4 * fq + (fr & 3)) * 8 + wid] = sel;
            }
            asm volatile("s_waitcnt vmcnt(0)" ::: "memory");
            __syncthreads();
            {
                const int myrow = 16 * (fr >> 2) + 4 * fq + (fr & 3);
                const f32x4 p0 = *(const LAS f32x4*)(rd + myrow * 8), p1 = *(const LAS f32x4*)(rd + myrow * 8 + 4);
                const float tot = p0[0] + p0[1] + p0[2] + p0[3] + p1[0] + p1[1] + p1[2] + p1[3];
                LAS float* rs = red + 1024 + wid * 64;
                rs[fq * 16 + fr] = rsqrtf(tot * (1.f / 128.f) + RMS_EPS);
                bf16_t* obb = OB + (size_t)(row0 + 64 * c) * 1024 + h * 128;
                const unsigned oo = (unsigned)(4 * fq * 1024 + 16 * wid + fr);
#pragma unroll
                for (int mt = 0; mt < 4; ++mt) {
                    const f32x4 r4 = *(const LAS f32x4*)(rs + fq * 16 + 4 * mt);
#pragma unroll
                    for (int i = 0; i < 4; ++i) {
                        const int lr = 16 * mt + 4 * fq + i;
                        const float ov = o[mt][i] * r4[i] * onw * siluf(bf2f(zr[mt][i]));
                        const bf16_t ob = f2bf(ov);
                        if (lr < nvalid) obb[(unsigned)((16 * mt + i) * 1024) + oo] = ob;
                    }
                }
            }
        }
        {
            int lz = lane; asm volatile("" : "+v"(lz));
            const unsigned so = (unsigned)(4 * (lz >> 4) * 128 + 16 * wid + (lz & 15));
#pragma unroll
            for (int mt = 0; mt < 8; ++mt)
#pragma unroll
                for (int i = 0; i < 4; ++i) stout[(unsigned)((16 * mt + i) * 128) + so] = st[mt][i];
        }
#undef SCAN_G2L
#undef SCAN_LOADU
    }
}

DI void att_s(LAS unsigned char* Ka, int t, const bf16x8 (&qf)[4], f32x16& s0, f32x16& s1) {
#pragma unroll
    for (int i = 0; i < 16; ++i) { s0[i] = 0.f; s1[i] = 0.f; }
    bf16x8 kf[8];
#pragma unroll
    for (int s = 0; s < 4; ++s) { kf[2 * s] = *(const LAS bf16x8*)(Ka + (t ^ (s << 5))); kf[2 * s + 1] = *(const LAS bf16x8*)(Ka + 8192 + (t ^ (s << 5))); }
#pragma unroll
    for (int s = 0; s < 4; ++s) { s0 = MFMA32(kf[2 * s], qf[s], s0); s1 = MFMA32(kf[2 * s + 1], qf[s], s1); }
}
template <bool MASK>
DI float att_softmax(f32x16& s0, f32x16& s1, float& m, float& l, bf16x8 (&pf)[2][2], int h2, int nvk) {
    if (MASK) {
#pragma unroll
        for (int i = 0; i < 16; ++i) {
            const int key = (i & 3) + 8 * (i >> 2) + 4 * h2;
            s0[i] = (key < nvk) ? s0[i] : -INFINITY;
            s1[i] = (32 + key < nvk) ? s1[i] : -INFINITY;
        }
    }
    float mx = s0[0];
#pragma unroll
    for (int i = 1; i < 16; ++i) mx = fmaxf(mx, s0[i]);
#pragma unroll
    for (int i = 0; i < 16; ++i) mx = fmaxf(mx, s1[i]);
    mx = fmaxf(mx, __shfl_xor(mx, 32));
    const float mn = fmaxf(m, mx);
    const float alpha = __builtin_amdgcn_exp2f(m - mn);
    m = mn;
    float ps = 0.f;
#pragma unroll
    for (int i = 0; i < 16; ++i) { s0[i] = __builtin_amdgcn_exp2f(s0[i] - mn); s1[i] = __builtin_amdgcn_exp2f(s1[i] - mn); ps += s0[i] + s1[i]; }
    l = l * alpha + ps;
    u32x4 w;
    w.x = pk2(s0[0], s0[1]); w.y = pk2(s0[2], s0[3]); w.z = pk2(s0[4], s0[5]); w.w = pk2(s0[6], s0[7]); pf[0][0] = __builtin_bit_cast(bf16x8, w);
    w.x = pk2(s0[8], s0[9]); w.y = pk2(s0[10], s0[11]); w.z = pk2(s0[12], s0[13]); w.w = pk2(s0[14], s0[15]); pf[0][1] = __builtin_bit_cast(bf16x8, w);
    w.x = pk2(s1[0], s1[1]); w.y = pk2(s1[2], s1[3]); w.z = pk2(s1[4], s1[5]); w.w = pk2(s1[6], s1[7]); pf[1][0] = __builtin_bit_cast(bf16x8, w);
    w.x = pk2(s1[8], s1[9]); w.y = pk2(s1[10], s1[11]); w.z = pk2(s1[12], s1[13]); w.w = pk2(s1[14], s1[15]); pf[1][1] = __builtin_bit_cast(bf16x8, w);
    return alpha;
}
DI void att_pv(LAS unsigned char* Va, int q4, f32x16 (&O)[4], const bf16x8 (&pf)[2][2]) {
    s16x4 lo[16], hi[16];
#define PV_LD(i) do { LAS unsigned char* _vp = Va + ((((i) >> 2) ^ q4) << 6) + (32 * (((i) >> 1) & 1) + 16 * ((i) & 1)) * 256; \
        lo[i] = __builtin_amdgcn_ds_read_tr16_b64_v4i16((LAS s16x4*)_vp); hi[i] = __builtin_amdgcn_ds_read_tr16_b64_v4i16((LAS s16x4*)(_vp + 8 * 256)); } while (0)
    PV_LD(0); PV_LD(1); PV_LD(2);
#pragma unroll
    for (int i = 0; i < 16; ++i) {
        if (i + 3 < 16) PV_LD(i + 3);
        const bf16x8 vf = __builtin_shufflevector(lo[i], hi[i], 0, 1, 2, 3, 4, 5, 6, 7);
        O[i >> 2] = MFMA32(vf, pf[(i >> 1) & 1][i & 1], O[i >> 2]);
    }
#undef PV_LD
}

DI void phase_attn(const Params& P, LAS unsigned char* lds, int layer) {
    int tid_ = threadIdx.x; asm volatile("" : "+v"(tid_)); const int tid = tid_, wid = __builtin_amdgcn_readfirstlane(tid >> 6), lane = tid & 63, G = gridDim.x;
    unsigned char* ws = P.ws;
    const int j = layer >> 1;
    const int comp = wid >> 2, rg = wid & 3, r32 = lane & 31, h2 = lane >> 5;
    const bf16_t* proj = (const bf16_t*)(ws + WS_PROJ);
    bf16_t* OB = (bf16_t*)(ws + WS_HBUF);
    const float lam_init = 0.8f - 0.6f * expf(-0.3f * (float)layer);
    float lam;
    {
        float d1 = 0.f, d2 = 0.f;
        for (int i = 0; i < 64; ++i) { d1 += P.in[19][j * 64 + i] * P.in[20][j * 64 + i]; d2 += P.in[21][j * 64 + i] * P.in[22][j * 64 + i]; }
        lam = expf(d1) - expf(d2) + lam_init;
    }
    const float* subln = P.in[23] + j * 128;
    constexpr int TB = 32768;
    const int vb = (G % 8 == 0) ? (blockIdx.x % 8) * (G / 8) + blockIdx.x / 8 : blockIdx.x;
    const int nrounds = (G == 256) ? 9 : (2176 + G - 1) / G;
#define ATT_WAITV(n) asm volatile("s_waitcnt vmcnt(" #n ")" ::: "memory")
#define ATT_BAR() do { asm volatile("" ::: "memory"); __builtin_amdgcn_s_barrier(); asm volatile("" ::: "memory"); } while (0)
    for (int k = 0; k < nrounds; ++k) {
        int id;
        if (G == 256) {
            if (k < 8) { const int xcd = vb >> 5, idx = vb & 31; const int seq = xcd * 4 + (k >> 1); const int qt = (k & 1) ? idx : (63 - idx); id = seq * 64 + qt; }
            else { if (vb >= 128) break; id = 2048 + vb; }
        } else { id = vb + k * G; if (id >= 2176) break; }
        int h, qrow0, nt_all, nt_mine, last_valid; const int kvstride = 128; const bf16_t* Kp; const bf16_t* Vp; bool sample;
        if (id < 2048) {
            const int seq = id >> 6, qt = id & 63, b = seq >> 3; h = seq & 7; sample = false;
            qrow0 = b * TP + 128 * qt + 32 * rg; nt_all = 2 * qt + 2; nt_mine = (rg < 2) ? 2 * qt + 1 : 2 * qt + 2; last_valid = 64 * nt_mine;
            Kp = (const bf16_t*)(ws + WS_KH) + (size_t)seq * TP * 128; Vp = (const bf16_t*)(ws + WS_VH) + (size_t)seq * TP * 128;
        } else {
            const int s = id - 2048, b = s >> 3; h = s & 7; sample = true;
            qrow0 = MP + b * TS; nt_all = 34; nt_mine = (rg == 0) ? 34 : 0; last_valid = PAST + TS;
            Kp = (const bf16_t*)(ws + WS_KS) + (size_t)s * KSROWS * 128; Vp = (const bf16_t*)(ws + WS_VS) + (size_t)s * KSROWS * 128;
        }
        bf16x8 qf[4];
        {
            const int qr = qrow0 + (sample ? (r32 & 15) : r32);
            const bf16_t* qp = proj + (size_t)qr * NPROJ + h * 128 + comp * 64 + 8 * h2;
#pragma unroll
            for (int s = 0; s < 4; ++s) qf[s] = *(const bf16x8*)(qp + 16 * s);
        }
        f32x16 O[4];
#pragma unroll
        for (int et = 0; et < 4; ++et)
#pragma unroll
            for (int i = 0; i < 16; ++i) O[et][i] = 0.f;
        float m = -INFINITY, l = 0.f;
        bf16x8 pf[2][2];
#pragma unroll
        for (int a = 0; a < 2; ++a)
#pragma unroll
            for (int c2 = 0; c2 < 2; ++c2) pf[a][c2] = (bf16x8){0, 0, 0, 0, 0, 0, 0, 0};
        f32x16 sA0, sA1, sB0, sB1;
        const bf16_t* gsrc;
        {
            const int rowl = lane >> 4, c = lane & 15;
            const int row0 = 16 * (wid & 3) + rowl;
            const int lc = (wid < 4) ? (c ^ (row0 & 15)) : (c ^ ((row0 & 3) << 2));
            gsrc = ((wid < 4) ? Kp : Vp) + (size_t)row0 * kvstride + lc * 8;
        }
#define ATT_G2L(kt, bufi) do { _Pragma("unroll") for (int _i = 0; _i < 4; ++_i) { \
            const bf16_t* _s = gsrc + (size_t)(64 * (kt) + 4 * _i) * kvstride; \
            if (wid < 4) _s += (((lane & 15) ^ ((16 * (wid & 3) + 4 * _i + (lane >> 4)) & 15)) - ((lane & 15) ^ ((16 * (wid & 3) + (lane >> 4)) & 15))) * 8; \
            g2l16(_s, lds_u32(lds + (bufi) * TB + (4 * wid + _i) * 1024)); } } while (0)
        asm volatile("" :: "v"(qf[0]), "v"(qf[1]), "v"(qf[2]), "v"(qf[3]));
        __syncthreads();
        ATT_G2L(0, 0);
        if (nt_all > 1) { ATT_G2L(1, 1); ATT_WAITV(4); } else { ATT_WAITV(0); }
        ATT_BAR();
        {
            const int koff = r32 * 256, t = ((comp * 8 + h2) ^ (r32 & 15)) << 4;
            att_s(lds + koff, t, qf, sA0, sA1);
        }
#define ATT_ITER(KT, sC0, sC1, sN0, sN1, EDGE) do { \
            const int kt = (KT); \
            int lo_ = lane; asm volatile("" : "+v"(lo_)); \
            const int r32_ = lo_ & 31, h2_ = lo_ >> 5, q4_ = (lo_ & 15) >> 2, p4_ = lo_ & 3, blk_ = (lo_ >> 4) & 1; \
            const int koff_ = r32_ * 256, t_ = ((comp * 8 + h2_) ^ (r32_ & 15)) << 4; \
            const int voff_ = (4 * h2_ + q4_) * 256 + (2 * blk_ + (p4_ >> 1)) * 16 + (p4_ & 1) * 8; \
            ATT_WAITV(0); ATT_BAR(); \
            if (kt + 2 < nt_all) ATT_G2L(kt + 2, (kt + 2) & 3); \
            att_s(lds + ((kt + 1) & 3) * TB + koff_, t_, qf, sN0, sN1); \
            if (!(EDGE) || kt >= 1) att_pv(lds + ((kt - 1) & 3) * TB + 16384 + voff_, q4_, O, pf); \
            const float alpha = att_softmax<EDGE>(sC0, sC1, m, l, pf, h2_, last_valid - 64 * kt); \
            asm volatile("" :: "v"(l), "v"(pf[0][0]), "v"(pf[0][1]), "v"(pf[1][0]), "v"(pf[1][1]));     \
            _Pragma("unroll") for (int _g = 0; _g < 24; ++_g) { __builtin_amdgcn_sched_group_barrier(0x008, 1, 0); __builtin_amdgcn_sched_group_barrier(0x002, 7, 0); } \
            if (__any(alpha != 1.f)) { \
                _Pragma("unroll") for (int et = 0; et < 4; ++et) _Pragma("unroll") for (int i = 0; i < 16; ++i) O[et][i] *= alpha; } \
            } while (0)
        {
            const int npairs = nt_all >> 1;
            ATT_ITER(0, sA0, sA1, sB0, sB1, true);
            ATT_ITER(1, sB0, sB1, sA0, sA1, true);
            for (int pp = 1; pp < npairs - 1; ++pp) {
                ATT_ITER(2 * pp, sA0, sA1, sB0, sB1, false);
                ATT_ITER(2 * pp + 1, sB0, sB1, sA0, sA1, false);
            }
            if (npairs > 1) {
                ATT_ITER(nt_all - 2, sA0, sA1, sB0, sB1, true);
                ATT_ITER(nt_all - 1, sB0, sB1, sA0, sA1, true);
            }
        }
        {
            const int lt = nt_all - 1;
            const int h2b = lane >> 5, q4 = (lane & 15) >> 2, p4 = lane & 3, blk = (lane >> 4) & 1;
            const int voff = (4 * h2b + q4) * 256 + (2 * blk + (p4 >> 1)) * 16 + (p4 & 1) * 8;
            att_pv(lds + (lt & 3) * TB + 16384 + voff, q4, O, pf);
        }
        __syncthreads();
#undef ATT_ITER
#undef ATT_G2L
        const float lt = l + __shfl_xor(l, 32);
        const float inv = (nt_mine > 0) ? 1.f / lt : 0.f;
        LAS float* XO = (LAS float*)lds;
        if (comp == 1) {
            const float sc = inv * lam;
#pragma unroll
            for (int et = 0; et < 4; ++et)
#pragma unroll
                for (int i = 0; i < 16; ++i) XO[(rg * 128 + 32 * et + (i & 3) + 8 * (i >> 2) + 4 * h2) * 32 + r32] = O[et][i] * sc;
        }
        __syncthreads();
        if (comp == 0 && nt_mine > 0) {
            float ss = 0.f;
#pragma unroll
            for (int et = 0; et < 4; ++et)
#pragma unroll
                for (int i = 0; i < 16; ++i) { const float v = O[et][i] * inv - XO[(rg * 128 + 32 * et + (i & 3) + 8 * (i >> 2) + 4 * h2) * 32 + r32]; O[et][i] = v; ss += v * v; }
            ss += __shfl_xor(ss, 32);
            const float rstd = rsqrtf(ss * (1.f / 128.f) + RMS_EPS) * (1.f - lam_init);
            const bool rvalid = sample ? (r32 < TS) : true;
            const int row = qrow0 + r32;
            if (rvalid) {
#pragma unroll
                for (int et = 0; et < 4; ++et)
#pragma unroll
                    for (int g4 = 0; g4 < 4; ++g4) {
                        const int e0 = 32 * et + 8 * g4 + 4 * h2;
                        const u32x2 zz = *(const u32x2*)(proj + (size_t)row * NPROJ + 3072 + h * 128 + e0);
                        const f32x4 sl = *(const f32x4*)(subln + e0);
                        const float z0 = __uint_as_float(zz.x << 16), z1 = __uint_as_float(zz.x & 0xffff0000u), z2 = __uint_as_float(zz.y << 16), z3 = __uint_as_float(zz.y & 0xffff0000u);
                        u32x2 w;
                        w.x = pk2(O[et][4 * g4] * rstd * sl[0] * siluf(z0), O[et][4 * g4 + 1] * rstd * sl[1] * siluf(z1));
                        w.y = pk2(O[et][4 * g4 + 2] * rstd * sl[2] * siluf(z2), O[et][4 * g4 + 3] * rstd * sl[3] * siluf(z3));
                        *(u32x2*)(OB + (size_t)row * 1024 + h * 128 + e0) = w;
                    }
            }
        }
        __syncthreads();
    }
}

typedef const __attribute__((address_space(4))) Params* CParP;
#define LOADP() Params P; { CParP kp_ = KP; asm volatile("" : "+s"(kp_)); P = *kp_; } unsigned char* ws = P.ws; (void)ws
__global__ void __launch_bounds__(512, 2) fwd_megakernel(Params Pin) {
#if defined(__HIP_DEVICE_COMPILE__)
    extern __shared__ __attribute__((aligned(16))) unsigned char lds_raw[];
    LAS unsigned char* lds = (LAS unsigned char*)lds_raw;
    cg::grid_group grid = cg::this_grid();
    const CParP KP = (CParP)__builtin_amdgcn_kernarg_segment_ptr();
    for (int rep = opaque_i(REP_PREP); rep > 0; --rep) { LOADP(); phase_prep(P, lds); }
    grid.sync();
    for (int layer = 0; layer < 4; ++layer) {
        const int j = layer >> 1;
        { LOADP(); phase_elem(P, lds, layer); }
        grid.sync();
        for (int rep = opaque_i(REP_GIN); rep > 0; --rep) {
            LOADP();
            pg8::StaticOrder S; S.init(M, NPROJ, gridDim.x, blockIdx.x);
            pg8::Gemm g;
            g.A = (const bf16_t*)(ws + WS_HBUF); g.M = M; g.N = NPROJ; g.K = 1024;
            if (!(layer & 1)) {
                g.Bt = (const bf16_t*)(ws + WS_WING) + (size_t)j * 4096 * 1024;
                EpiGdnIn E; E.proj = (bf16_t*)(ws + WS_PROJ); E.conv_p = P.out + OFF_CVP + (size_t)j * 4 * 3 * 3072; E.conv_s = P.out + OFF_CVS + (size_t)j * 16 * 3 * 3072;
                pg8::gemm_phase(lds, g, S, E);
            } else {
                g.Bt = (const bf16_t*)(ws + WS_WIND) + (size_t)j * 4096 * 1024;
                EpiDiffIn E; E.proj = (bf16_t*)(ws + WS_PROJ);
                E.k_p = P.out + OFF_KP + (size_t)j * MP * 1024; E.v_p = P.out + OFF_VP + (size_t)j * MP * 1024;
                E.k_s = P.out + OFF_KSO + (size_t)j * MS * 1024; E.v_s = P.out + OFF_VSO + (size_t)j * MS * 1024;
                E.ks = (bf16_t*)(ws + WS_KS); E.vs = (bf16_t*)(ws + WS_VS); E.kh = (bf16_t*)(ws + WS_KH); E.vh = (bf16_t*)(ws + WS_VH); E.rope = (const float*)(ws + WS_ROPE);
                pg8::gemm_phase(lds, g, S, E);
            }
        }
        grid.sync();
        if (!(layer & 1)) {
            for (int rep = opaque_i(REP_G1); rep > 0; --rep) { LOADP(); phase_g1(P, lds, layer); }
            grid.sync();
            for (int rep = opaque_i(REP_SCAN); rep > 0; --rep) { LOADP(); phase_scan(P, lds, layer); }
        } else {
            for (int rep = opaque_i(REP_ATTN); rep > 0; --rep) { LOADP(); phase_attn(P, lds, layer); }
        }
        grid.sync();
        for (int rep = opaque_i(REP_GOUT); rep > 0; --rep) {
            LOADP();
            pg8::StaticOrder S; S.init(M, 1024, gridDim.x, blockIdx.x);
            pg8::Gemm g;
            g.A = (const bf16_t*)(ws + WS_HBUF); g.M = M; g.N = 1024; g.K = 1024;
            g.Bt = (const bf16_t*)(ws + ((layer & 1) ? WS_WOUTD : WS_WOUTG)) + (size_t)j * 1024 * 1024;
            EpiOut E; E.C = (float*)(ws + WS_PROJ);
            pg8::gemm_phase(lds, g, S, E);
        }
        grid.sync();
    }
    { LOADP(); phase_elem(P, lds, 4); }
#endif
}

extern "C" void kernel_launch(void* const* d_in, const int* in_sizes, int n_in, void* d_out, int out_size, void* d_ws, size_t ws_size, hipStream_t stream) {
    static int grid_blocks = 0;
    if (!grid_blocks) {
        int dev = 0, cus = 0, per_cu = 0;
        hipGetDevice(&dev);
        hipDeviceGetAttribute(&cus, hipDeviceAttributeMultiprocessorCount, dev);
        hipFuncSetAttribute((const void*)fwd_megakernel, hipFuncAttributeMaxDynamicSharedMemorySize, LDS_BYTES);
        hipOccupancyMaxActiveBlocksPerMultiprocessor(&per_cu, (const void*)fwd_megakernel, 512, LDS_BYTES);
        if (per_cu < 1) per_cu = 1;
        grid_blocks = cus * per_cu;
        if (ws_size < WS_END) fprintf(stderr, "kernel_launch: workspace too small: %zu < %zu\n", ws_size, (size_t)WS_END);
    }
    Params p{};
    for (int i = 0; i < 25; ++i) p.in[i] = (const float*)d_in[i];
    p.out = (float*)d_out; p.ws = (unsigned char*)d_ws;
    void* args[] = {&p};
    hipError_t e = hipLaunchCooperativeKernel((const void*)fwd_megakernel, dim3(grid_blocks), dim3(512), args, LDS_BYTES, stream);
    if (e != hipSuccess) fprintf(stderr, "cooperative launch failed: %s (grid %d)\n", hipGetErrorString(e), grid_blocks);
}
```

```cpp
#include <hip/hip_runtime.h>
#include <hip/hip_cooperative_groups.h>
#include <cstdio>
namespace cg = cooperative_groups;

#define DI __device__ __forceinline__
#define LAS __attribute__((address_space(3)))
typedef unsigned short bf16_t;
typedef short bf16x8 __attribute__((ext_vector_type(8)));
typedef short s16x4 __attribute__((ext_vector_type(4)));
typedef float f32x2 __attribute__((ext_vector_type(2)));
typedef float f32x4 __attribute__((ext_vector_type(4)));
typedef float f32x16 __attribute__((ext_vector_type(16)));
typedef unsigned u32x2 __attribute__((ext_vector_type(2)));
typedef unsigned u32x4 __attribute__((ext_vector_type(4)));
typedef __bf16 bf16x2_t __attribute__((ext_vector_type(2)));

#define REP_G1 1
#define REP_SCAN 1
#define REP_ATTN 1
#define REP_GIN 1
#define REP_GOUT 1
#define REP_PREP 1
DI int opaque_i(int v) { asm volatile("" : "+s"(v)); return v; }
constexpr int D = 1024, TP = 8192, BP = 4, BS = 16, TS = 16, PAST = 2048;
constexpr int MP = BP * TP, MS = BS * TS, M = MP + MS, NB = BP + BS;
constexpr int NPROJ = 4096;
constexpr int KSROWS = 2112;
constexpr int NITEM_P = 4096, NITEM = 4224;
constexpr size_t ITEM_BYTES = 90112;
constexpr float RMS_EPS = 1e-6f;
constexpr float QSCALE = 0.125f * 1.4426950408889634f;

constexpr size_t OFF_Y = 0;
constexpr size_t OFF_STP = (size_t)M * D;
constexpr size_t OFF_CVP = OFF_STP + 2ull * 4 * 8 * 128 * 128;
constexpr size_t OFF_KP = OFF_CVP + 2ull * 4 * 3 * 3072;
constexpr size_t OFF_VP = OFF_KP + 2ull * MP * 1024;
constexpr size_t OFF_STS = OFF_VP + 2ull * MP * 1024;
constexpr size_t OFF_CVS = OFF_STS + 2ull * 16 * 8 * 128 * 128;
constexpr size_t OFF_KSO = OFF_CVS + 2ull * 16 * 3 * 3072;
constexpr size_t OFF_VSO = OFF_KSO + 2ull * MS * 1024;

constexpr size_t WS_WING = 0;
constexpr size_t WS_WOUTG = WS_WING + 2ull * 4096 * 1024 * 2;
constexpr size_t WS_WIND = WS_WOUTG + 2ull * 1024 * 1024 * 2;
constexpr size_t WS_WOUTD = WS_WIND + 2ull * 4096 * 1024 * 2;
constexpr size_t WS_ADA = WS_WOUTD + 2ull * 1024 * 1024 * 2;
constexpr size_t WS_ROPE = WS_ADA + 4ull * NB * 3072 * 4;
constexpr size_t WS_AB = WS_ROPE + 8208ull * 64 * 4;
constexpr size_t WS_GL = WS_AB + (size_t)M * 16 * 4;
constexpr size_t WS_BAR = WS_GL + 17408;
constexpr size_t WS_HBUF = WS_GL + 32768;
constexpr size_t WS_ORAW = WS_HBUF + (size_t)M * 1024 * 2;
constexpr size_t WS_PROJ = WS_ORAW + 256;
constexpr size_t WS_R1 = WS_PROJ + (size_t)M * 4096 * 2;
constexpr size_t WS_KS = WS_R1;
constexpr size_t WS_VS = WS_KS + 16ull * KSROWS * 1024 * 2;
constexpr size_t WS_KH = WS_VS + 16ull * KSROWS * 1024 * 2;
constexpr size_t WS_VH = WS_KH + (size_t)MP * 1024 * 2;
constexpr size_t WS_END = WS_R1 + (size_t)NITEM * ITEM_BYTES;

constexpr int LDS_BYTES = 131072 + 16;

struct Params { const float* in[25]; float* out; unsigned char* ws; };

DI float bf2f(bf16_t v) { return __uint_as_float(((unsigned)v) << 16); }
DI unsigned pk2(float a, float b) { f32x2 v = {a, b}; bf16x2_t r = __builtin_convertvector(v, bf16x2_t); return __builtin_bit_cast(unsigned, r); }
DI bf16_t f2bf(float a) { return (bf16_t)(pk2(a, 0.f) & 0xffffu); }
template <int CTRL> DI float dppf(float v) { return __builtin_bit_cast(float, __builtin_amdgcn_update_dpp(0, __builtin_bit_cast(int, v), CTRL, 0xf, 0xf, true)); }
DI float row_sum16(float v) { v += dppf<0x128>(v); v += dppf<0x124>(v); v += dppf<0x122>(v); v += dppf<0x121>(v); return v; }
DI float wave_sum(float v) { v = row_sum16(v); v += __shfl_xor(v, 16); v += __shfl_xor(v, 32); return v; }
DI float readlane_f(float v, int l) { return __builtin_bit_cast(float, __builtin_amdgcn_readlane(__builtin_bit_cast(int, v), l)); }
DI float siluf(float x) { return x * __builtin_amdgcn_rcpf(1.f + __expf(-x)); }
DI int ppos(int idx) { const int d5 = idx & 31; return (idx & ~31) | (((d5 >> 2) & 3) << 3) | ((d5 >> 4) << 2) | (d5 & 3); }
DI int perm64(int ls) { return (ls & 15) | (((ls >> 4) & 1) << 5) | (((ls >> 5) & 1) << 4); }
DI void unpack8(const u32x4 v, float (&o)[8]) {
#pragma unroll
    for (int i = 0; i < 4; ++i) { o[2 * i] = __uint_as_float(v[i] << 16); o[2 * i + 1] = __uint_as_float(v[i] & 0xffff0000u); }
}
DI void g2l16(const void* gptr, unsigned lds_addr) {
    asm volatile("s_mov_b32 m0, %1\n\ts_nop 0\n\tglobal_load_lds_dwordx4 %0, off" :: "v"(gptr), "s"(lds_addr) : "memory", "m0");
}
DI unsigned lds_u32(LAS unsigned char* p) { return (unsigned)(size_t)p; }
#define MFMA16(a, b, c) __builtin_amdgcn_mfma_f32_16x16x32_bf16((a), (b), (c), 0, 0, 0)
#define MFMA32(a, b, c) __builtin_amdgcn_mfma_f32_32x32x16_bf16((a), (b), (c), 0, 0, 0)

namespace pg8 {
constexpr int BM = 256, BK = 64, HALF = 128, HTB = HALF * BK * 2, STAGE_BYTES = 8 * HTB, NXCD = 8, WGM = 8;
DI int lds_byte(int r, int c) { const int st = (r >> 4) * 2 + (c >> 5), rr = r & 15, cc = c & 31, ob = rr * 64 + cc * 2; return st * 1024 + (ob ^ (((ob >> 9) & 1) << 5)); }
DI void stage_rc(int b, int& R, int& C) { const int st = b / 1024, sb = b % 1024, swz = sb ^ (((sb >> 9) & 1) << 5); R = (st >> 1) * 16 + swz / 64; C = (st & 1) * 32 + (swz % 64) / 2; }
struct Unit { int pm, pn; };
struct Gemm { const bf16_t* A; const bf16_t* Bt; int M, N, K; };
struct StaticOrder {
    int nM, nN, nwg, G, c;
    DI void init(int M_, int N_, int G_, int c_) { nM = M_ / BM; nN = N_ / BM; nwg = nM * nN; G = G_; c = c_; }
    DI bool next(int i, Unit& u) const {
        const long L = (long)i * G + c; if (L >= nwg) return false;
        int wgid = (int)L; { const int q = nwg / NXCD, r = nwg % NXCD, xcd = wgid % NXCD, off = wgid / NXCD; wgid = (xcd < r ? xcd * (q + 1) : r * (q + 1) + (xcd - r) * q) + off; }
        const int nig = WGM * nN, gid = wgid / nig, fm = gid * WGM, gsz = (nM - fm) < WGM ? (nM - fm) : WGM;
        u.pm = fm + ((wgid % nig) % gsz); u.pn = (wgid % nig) / gsz; return true;
    }
};

template <class Epi>
DI void gemm_phase(LAS unsigned char* lds, const Gemm g, const StaticOrder& S, const Epi& E) {
    int tid_ = threadIdx.x; asm volatile("" : "+v"(tid_)); const int tid = tid_, wid = __builtin_amdgcn_readfirstlane(tid >> 6), lane = tid & 63, wr = wid >> 2, wc = wid & 3, fr = lane & 15, fq = lane >> 4;
    const int K = g.K, nt = K / BK;
    unsigned voffA[2];
#pragma unroll
    for (int i = 0; i < 2; ++i) { int R, C; stage_rc(tid * 16 + i * 8192, R, C); voffA[i] = (unsigned)(R * K + C) * 2u; }
    const size_t kstep = (size_t)(BK * 2);
    const size_t hstep = (size_t)HALF * K * 2;
    const size_t tstep = 2 * hstep;
    const unsigned ldsw = (unsigned)wid * 1024u;
    const int aoff = lds_byte(wr * 64 + fr, fq * 8), boff = lds_byte(wc * 32 + fr, fq * 8);
#define PG8_SA(b, h) (((b) * 2 + (h)) * HTB)
#define PG8_SB(b, h) ((4 + (b) * 2 + (h)) * HTB)
#define PG8_STAGE(bufoff, gbase) do { _Pragma("unroll") for (int _i = 0; _i < 2; ++_i) \
        __builtin_amdgcn_global_load_lds((const unsigned*)((const char*)(gbase) + voffA[_i]), (LAS unsigned*)(lds + (bufoff) + ldsw + _i * 8192), 16, 0, 0); } while (0)
#define PG8_LDA(dst, b, h) do { _Pragma("unroll") for (int m = 0; m < 4; ++m) _Pragma("unroll") for (int k = 0; k < 2; ++k) dst[m][k] = *(const LAS bf16x8*)(lds + PG8_SA(b, h) + aoff + m * 2048 + k * 1024); } while (0)
#define PG8_LDB(dst, b, h) do { _Pragma("unroll") for (int n = 0; n < 2; ++n) _Pragma("unroll") for (int k = 0; k < 2; ++k) dst[n][k] = *(const LAS bf16x8*)(lds + PG8_SB(b, h) + boff + n * 2048 + k * 1024); } while (0)
#define PG8_MMA(ai, bj, At, Bt) do { __builtin_amdgcn_s_setprio(1); _Pragma("unroll") for (int m = 0; m < 4; ++m) _Pragma("unroll") for (int n = 0; n < 2; ++n) _Pragma("unroll") for (int k = 0; k < 2; ++k) \
        acc[ai][bj][m][n] = __builtin_amdgcn_mfma_f32_16x16x32_bf16(Bt[n][k], At[m][k], acc[ai][bj][m][n], 0, 0, 0); __builtin_amdgcn_s_setprio(0); } while (0)
#define PG8_WAIT_V(n) asm volatile("s_waitcnt vmcnt(" #n ")" ::: "memory")
#define PG8_WAIT_L(n) asm volatile("s_waitcnt lgkmcnt(" #n ")" ::: "memory")
#define PG8_BAR __builtin_amdgcn_s_barrier()
#define PG8_SCHED __builtin_amdgcn_sched_barrier(0)
    Unit cur, nxt; int ui = 0;
    if (!S.next(0, cur)) return;
    f32x4 acc[2][2][4][2];
#pragma unroll
    for (int a = 0; a < 2; ++a)
#pragma unroll
        for (int b = 0; b < 2; ++b)
#pragma unroll
            for (int m = 0; m < 4; ++m)
#pragma unroll
                for (int n = 0; n < 2; ++n) acc[a][b][m][n] = (f32x4){0.f, 0.f, 0.f, 0.f};
    bf16x8 At[4][2], B0[2][2], B1[2][2];
    const char* cA = (const char*)g.A + (size_t)cur.pm * tstep; const char* cB = (const char*)g.Bt + (size_t)cur.pn * tstep;
    PG8_STAGE(PG8_SB(0, 0), cB); PG8_STAGE(PG8_SA(0, 0), cA); PG8_STAGE(PG8_SB(0, 1), cB + hstep); PG8_STAGE(PG8_SA(0, 1), cA + hstep);
    if (wr == 1) PG8_BAR;
    PG8_WAIT_V(4); PG8_BAR;
    PG8_STAGE(PG8_SB(1, 0), cB + kstep); PG8_STAGE(PG8_SA(1, 0), cA + kstep); PG8_STAGE(PG8_SB(1, 1), cB + hstep + kstep);
    PG8_WAIT_V(6); PG8_BAR;
    for (;;) {
        const bool has_next = S.next(ui + 1, nxt);
        const char* nA = has_next ? (const char*)g.A + (size_t)nxt.pm * tstep : cA; const char* nB = has_next ? (const char*)g.Bt + (size_t)nxt.pn * tstep : cB;
        for (int t = 0; t < nt; t += 2) {
            const bool last = (t == nt - 2);
            const char* a1 = cA + (size_t)(t + 1) * kstep;
            const char* a2 = last ? nA : cA + (size_t)(t + 2) * kstep; const char* b2 = last ? nB : cB + (size_t)(t + 2) * kstep;
            const char* a3 = a2 + kstep; const char* b3 = b2 + kstep;
            PG8_LDB(B0, 0, 0); PG8_SCHED; PG8_LDA(At, 0, 0); PG8_STAGE(PG8_SA(1, 1), a1 + hstep);
            PG8_WAIT_L(8); PG8_BAR; PG8_WAIT_L(0); PG8_MMA(0, 0, At, B0); PG8_BAR; PG8_SCHED;
            PG8_LDB(B1, 0, 1); PG8_STAGE(PG8_SB(0, 0), b2);
            PG8_BAR; PG8_WAIT_L(0); PG8_MMA(0, 1, At, B1); PG8_BAR;
            PG8_LDA(At, 0, 1); PG8_STAGE(PG8_SA(0, 0), a2);
            PG8_BAR; PG8_WAIT_L(0); PG8_MMA(1, 0, At, B0); PG8_BAR; PG8_SCHED;
            PG8_STAGE(PG8_SB(0, 1), b2 + hstep);
            PG8_WAIT_V(6); PG8_BAR; PG8_MMA(1, 1, At, B1); PG8_BAR;
            PG8_LDB(B0, 1, 0); PG8_SCHED; PG8_LDA(At, 1, 0); PG8_STAGE(PG8_SA(0, 1), a2 + hstep);
            PG8_WAIT_L(8); PG8_BAR; PG8_WAIT_L(0); PG8_MMA(0, 0, At, B0); PG8_BAR; PG8_SCHED;
            PG8_LDB(B1, 1, 1); PG8_STAGE(PG8_SB(1, 0), b3);
            PG8_BAR; PG8_WAIT_L(0); PG8_MMA(0, 1, At, B1); PG8_BAR;
            PG8_LDA(At, 1, 1); PG8_STAGE(PG8_SA(1, 0), a3);
            PG8_BAR; PG8_WAIT_L(0); PG8_MMA(1, 0, At, B0); PG8_BAR; PG8_SCHED;
            PG8_STAGE(PG8_SB(1, 1), b3 + hstep);
            PG8_WAIT_V(6); PG8_BAR; PG8_MMA(1, 1, At, B1); PG8_BAR;
        }
        E(acc, cur, wr, wc, fr, fq);
        if (!has_next) break;
#pragma unroll
        for (int a = 0; a < 2; ++a)
#pragma unroll
            for (int b = 0; b < 2; ++b)
#pragma unroll
                for (int m = 0; m < 4; ++m)
#pragma unroll
                    for (int n = 0; n < 2; ++n) acc[a][b][m][n] = (f32x4){0.f, 0.f, 0.f, 0.f};
        cur = nxt; cA = nA; cB = nB; ++ui;
    }
    PG8_WAIT_V(0);
    if (wr == 0) PG8_BAR;
    PG8_BAR;
#undef PG8_SA
#undef PG8_SB
#undef PG8_STAGE
#undef PG8_LDA
#undef PG8_LDB
#undef PG8_MMA
#undef PG8_WAIT_V
#undef PG8_WAIT_L
#undef PG8_BAR
#undef PG8_SCHED
}
}

struct EpiGdnIn {
    bf16_t* proj; float* conv_p; float* conv_s;
    DI void operator()(const f32x4 (&acc)[2][2][4][2], const pg8::Unit& u, int wr, int wc, int fr, int fq) const {
        const int row0 = u.pm * 256 + wr * 64 + fr, col0 = u.pn * 256 + wc * 32 + 4 * fq;
#pragma unroll
        for (int ai = 0; ai < 2; ++ai)
#pragma unroll
            for (int m = 0; m < 4; ++m) {
                const int r = row0 + ai * 128 + m * 16;
                bf16_t* rowp = proj + (size_t)r * NPROJ + col0;
                bool tail; float* cp;
                if (r < MP) { const int t = r & (TP - 1), b = r >> 13; tail = t >= TP - 3; cp = conv_p + (size_t)(b * 3 + (t - (TP - 3))) * 3072; }
                else { const int rs = r - MP, t = rs & 15, b = rs >> 4; tail = t >= TS - 3; cp = conv_s + (size_t)(b * 3 + (t - (TS - 3))) * 3072; }
#pragma unroll
                for (int bj = 0; bj < 2; ++bj)
#pragma unroll
                    for (int n = 0; n < 2; ++n) {
                        const f32x4 v = acc[ai][bj][m][n];
                        u32x2 w; w.x = pk2(v[0], v[1]); w.y = pk2(v[2], v[3]);
                        *(u32x2*)(rowp + bj * 128 + n * 16) = w;
                        const int c = col0 + bj * 128 + n * 16;
                        if (tail && c < 3072) *(f32x4*)(cp + c) = v;
                    }
            }
    }
};

struct EpiDiffIn {
    bf16_t* proj; float* k_p; float* v_p; float* k_s; float* v_s; bf16_t* ks; bf16_t* vs; bf16_t* kh; bf16_t* vh; const float* rope;
    DI void operator()(const f32x4 (&acc)[2][2][4][2], const pg8::Unit& u, int wr, int wc, int fr, int fq) const {
        const int part = u.pn >> 2;
        const int row0 = u.pm * 256 + wr * 64 + fr;
        const int d0 = 16 * (wc & 1) + 4 * fq;
        const int cbase = u.pn * 256 + 64 * (wc >> 1) + d0;
#pragma unroll
        for (int ai = 0; ai < 2; ++ai)
#pragma unroll
            for (int m = 0; m < 4; ++m) {
                const int r = row0 + ai * 128 + m * 16;
                const int rs = r - MP;
                const int pidx = (r < MP) ? (r & (TP - 1)) : (TP + (rs & 15));
                f32x4 cs = {1.f, 1.f, 1.f, 1.f}, sn = {0.f, 0.f, 0.f, 0.f};
                if (part < 2) { cs = *(const f32x4*)(rope + (size_t)pidx * 64 + d0); sn = *(const f32x4*)(rope + (size_t)pidx * 64 + 32 + d0); }
#pragma unroll
                for (int bj = 0; bj < 2; ++bj) {
                    const f32x4 x1 = acc[ai][bj][m][0], x2 = acc[ai][bj][m][1];
                    f32x4 y1 = x1 * cs - x2 * sn, y2 = x2 * cs + x1 * sn;
                    const int col = cbase + bj * 128;
                    bf16_t* pp = proj + (size_t)r * NPROJ + col;
                    if (part == 0) { y1 *= QSCALE; y2 *= QSCALE; }
                    u32x2 w1, w2; w1.x = pk2(y1[0], y1[1]); w1.y = pk2(y1[2], y1[3]); w2.x = pk2(y2[0], y2[1]); w2.y = pk2(y2[2], y2[3]);
                    *(u32x2*)pp = w1; *(u32x2*)(pp + 32) = w2;
                    if (part == 1 || part == 2) {
                        const int cc = col - part * 1024;
                        const int hh = cc >> 7, dd = cc & 127;
                        float* op; bf16_t* sp;
                        if (r < MP) { op = (part == 1 ? k_p : v_p) + (size_t)r * 1024 + cc;
                               sp = (part == 1 ? kh : vh) + ((size_t)((r >> 13) * 8 + hh) * TP + (r & (TP - 1))) * 128 + dd; }
                        else { op = (part == 1 ? k_s : v_s) + (size_t)rs * 1024 + cc;
                               sp = (part == 1 ? ks : vs) + ((size_t)((rs >> 4) * 8 + hh) * KSROWS + PAST + (rs & 15)) * 128 + dd; }
                        *(f32x4*)op = y1; *(f32x4*)(op + 32) = y2;
                        *(u32x2*)sp = w1; *(u32x2*)(sp + 32) = w2;
                    }
                }
            }
    }
};

struct EpiOut {
    float* C;
    DI void operator()(const f32x4 (&acc)[2][2][4][2], const pg8::Unit& u, int wr, int wc, int fr, int fq) const {
        const int row0 = u.pm * 256 + wr * 64 + fr, col0 = u.pn * 256 + wc * 32 + 4 * fq;
#pragma unroll
        for (int ai = 0; ai < 2; ++ai)
#pragma unroll
            for (int m = 0; m < 4; ++m) {
                float* rowp = C + (size_t)(row0 + ai * 128 + m * 16) * 1024 + col0;
#pragma unroll
                for (int bj = 0; bj < 2; ++bj)
#pragma unroll
                    for (int n = 0; n < 2; ++n) *(f32x4*)(rowp + bj * 128 + n * 16) = acc[ai][bj][m][n];
            }
    }
};

DI void transpose_tile(const float* W, int ldw, int n0, int k0, bf16_t* WT, bool perm, LAS float* tile) {
    int tid_ = threadIdx.x; asm volatile("" : "+v"(tid_)); const int tid = tid_;
    {
        const int kk = tid >> 4, c4 = (tid & 15) * 4;
#pragma unroll
        for (int p = 0; p < 2; ++p) {
            const f32x4 v = *(const f32x4*)(W + (size_t)(k0 + kk + 32 * p) * ldw + n0 + c4);
            LAS float* t = tile + (kk + 32 * p) * 65 + c4;
            t[0] = v[0]; t[1] = v[1]; t[2] = v[2]; t[3] = v[3];
        }
    }
    __syncthreads();
    {
        const int n = tid >> 3, ks = (tid & 7) * 8;
        const int src = perm ? perm64(n) : n;
        float v[8];
#pragma unroll
        for (int e = 0; e < 8; ++e) v[e] = tile[(ks + e) * 65 + src];
        u32x4 w; w.x = pk2(v[0], v[1]); w.y = pk2(v[2], v[3]); w.z = pk2(v[4], v[5]); w.w = pk2(v[6], v[7]);
        *(u32x4*)(WT + (size_t)(n0 + n) * 1024 + k0 + ks) = w;
    }
    __syncthreads();
}

DI void phase_prep(const Params& P, LAS unsigned char* lds) {
    int tid_ = threadIdx.x; asm volatile("" : "+v"(tid_)); const int tid = tid_, G = gridDim.x;
    unsigned char* ws = P.ws;
    for (int id = blockIdx.x; id < 5120; id += G) {
        const int j = id / 2560; int rem = id % 2560;
        const float* W; int ldw; bf16_t* WT; bool perm = false; int t;
        if (rem < 1024) { W = P.in[12] + (size_t)j * 1024 * 4112; ldw = 4112; WT = (bf16_t*)(ws + WS_WING) + (size_t)j * 4096 * 1024; t = rem; }
        else if (rem < 1280) { W = P.in[17] + (size_t)j * 1024 * 1024; ldw = 1024; WT = (bf16_t*)(ws + WS_WOUTG) + (size_t)j * 1024 * 1024; t = rem - 1024; }
        else if (rem < 2304) { W = P.in[18] + (size_t)j * 1024 * 4096; ldw = 4096; WT = (bf16_t*)(ws + WS_WIND) + (size_t)j * 4096 * 1024; t = rem - 1280; perm = true; }
        else { W = P.in[24] + (size_t)j * 1024 * 1024; ldw = 1024; WT = (bf16_t*)(ws + WS_WOUTD) + (size_t)j * 1024 * 1024; t = rem - 2304; }
        transpose_tile(W, ldw, (t >> 4) * 64, (t & 15) * 64, WT, perm, (LAS float*)lds);
    }
    for (int idx = blockIdx.x * 512 + tid; idx < 8208 * 32; idx += G * 512) {
        const int pi = idx >> 5, d = idx & 31;
        const int pos = pi < TP ? pi : PAST + (pi - TP);
        const float inv = 1.0f / powf(10000.0f, (float)d / 32.0f);
        const float ang = (float)pos * inv;
        const double rev = (double)ang * 0.15915494309189535;
        const double fr = rev - floor(rev);
        float* rp = (float*)(ws + WS_ROPE) + (size_t)pi * 64;
        rp[d] = __builtin_amdgcn_cosf((float)fr);
        rp[32 + d] = __builtin_amdgcn_sinf((float)fr);
    }
    {
        LAS float* cact = (LAS float*)lds;
        LAS float* red = (LAS float*)(lds + 81920);
        bool loaded = false;
        for (int id = (G - 1 - blockIdx.x); id < 192; id += G) {
            if (!loaded) {
                for (int e = tid; e < NB * 1024; e += 512) {
                    const int b = e >> 10, k = e & 1023;
                    const float c = b < BP ? P.in[2][b * 1024 + k] : P.in[3][(b - BP) * 1024 + k];
                    cact[e] = siluf(c);
                }
                loaded = true;
            }
            __syncthreads();
            const int i = id / 48, cb = id % 48;
            const int col = tid & 63, kg = tid >> 6;
            const float* Wp = P.in[10] + (size_t)i * 1024 * 3072 + cb * 64 + col;
            float acc[NB];
#pragma unroll
            for (int b = 0; b < NB; ++b) acc[b] = 0.f;
            for (int k = kg * 128; k < kg * 128 + 128; k += 4) {
                const float w0 = Wp[(size_t)k * 3072], w1 = Wp[(size_t)(k + 1) * 3072], w2 = Wp[(size_t)(k + 2) * 3072], w3 = Wp[(size_t)(k + 3) * 3072];
#pragma unroll
                for (int b = 0; b < NB; ++b) {
                    const f32x4 c4 = *(const LAS f32x4*)(cact + b * 1024 + k);
                    acc[b] += c4[0] * w0 + c4[1] * w1 + c4[2] * w2 + c4[3] * w3;
                }
            }
#pragma unroll
            for (int b = 0; b < NB; ++b) red[(kg * NB + b) * 64 + col] = acc[b];
            __syncthreads();
            for (int o = tid; o < NB * 64; o += 512) {
                const int b = o >> 6, c = o & 63;
                float s = P.in[11][i * 3072 + cb * 64 + c];
#pragma unroll
                for (int g = 0; g < 8; ++g) s += red[(g * NB + b) * 64 + c];
                ((float*)(ws + WS_ADA))[((size_t)i * NB + b) * 3072 + cb * 64 + c] = s;
            }
        }
        __syncthreads();
    }
}

DI void phase_elem(const Params& P, LAS unsigned char* lds, int layer) {
    int tid_ = threadIdx.x; asm volatile("" : "+v"(tid_)); const int tid = tid_, wid = __builtin_amdgcn_readfirstlane(tid >> 6), lane = tid & 63, G = gridDim.x;
    unsigned char* ws = P.ws;
    const int j = layer >> 1;
    const bool gdn = (layer < 4) && !(layer & 1);
    LAS float* wab = (LAS float*)lds;
    if (gdn) {
        const float* Wp = P.in[12] + (size_t)j * 1024 * 4112 + 4096;
        for (int e = tid; e < 16384; e += 512) { const int k = e >> 4, c = e & 15; wab[c * 1024 + k] = Wp[(size_t)k * 4112 + c]; }
        __syncthreads();
    }
    const float* ada = (const float*)(ws + WS_ADA);
    float* X = P.out;
    const float* OUTB = (const float*)(ws + WS_PROJ);
    bf16_t* HB = (bf16_t*)(ws + WS_HBUF);
    float* AB = (float*)(ws + WS_AB);
    for (int r = blockIdx.x * 8 + wid; r < M; r += G * 8) {
        const int b = r < MP ? (r >> 13) : BP + ((r - MP) >> 4);
        const float* xs = (layer <= 1) ? (r < MP ? P.in[0] + (size_t)r * 1024 : P.in[1] + (size_t)(r - MP) * 1024) : X + (size_t)r * 1024;
        f32x4 x[4];
#pragma unroll
        for (int q = 0; q < 4; ++q) x[q] = *(const f32x4*)(xs + 4 * (lane + 64 * q));
        if (layer >= 1) {
            f32x4 o[4]; float ss = 0.f;
#pragma unroll
            for (int q = 0; q < 4; ++q) { o[q] = *(const f32x4*)(OUTB + (size_t)r * 1024 + 4 * (lane + 64 * q)); ss += o[q][0] * o[q][0] + o[q][1] * o[q][1] + o[q][2] * o[q][2] + o[q][3] * o[q][3]; }
            ss = wave_sum(ss);
            const float rstd = rsqrtf(ss * (1.f / 1024.f) + RMS_EPS);
            const float* gp = ada + ((size_t)(layer - 1) * NB + b) * 3072 + 2048;
            const float* np = P.in[9] + (layer - 1) * 1024;
#pragma unroll
            for (int q = 0; q < 4; ++q) {
                const int d = 4 * (lane + 64 * q);
                const f32x4 gt = *(const f32x4*)(gp + d), nw = *(const f32x4*)(np + d);
                x[q] = x[q] + gt * (o[q] * rstd * nw);
                *(f32x4*)(X + (size_t)r * 1024 + d) = x[q];
            }
        }
        if (layer < 4) {
            float ss = 0.f;
#pragma unroll
            for (int q = 0; q < 4; ++q) ss += x[q][0] * x[q][0] + x[q][1] * x[q][1] + x[q][2] * x[q][2] + x[q][3] * x[q][3];
            ss = wave_sum(ss);
            const float rstd = rsqrtf(ss * (1.f / 1024.f) + RMS_EPS);
            const float* ap = ada + ((size_t)layer * NB + b) * 3072;
            const float* np = P.in[8] + layer * 1024;
            f32x4 hv[4];
#pragma unroll
            for (int q = 0; q < 4; ++q) {
                const int d = 4 * (lane + 64 * q);
                const f32x4 sh = *(const f32x4*)(ap + d), sc = *(const f32x4*)(ap + 1024 + d), nw = *(const f32x4*)(np + d);
                hv[q] = (x[q] * rstd * nw) * (1.f + sc) + sh;
                u32x2 w; w.x = pk2(hv[q][0], hv[q][1]); w.y = pk2(hv[q][2], hv[q][3]);
                *(u32x2*)(HB + (size_t)r * 1024 + d) = w;
            }
            if (gdn) {
                float mine = 0.f;
#pragma unroll
                for (int c = 0; c < 16; ++c) {
                    float a = 0.f;
#pragma unroll
                    for (int q = 0; q < 4; ++q) { const f32x4 w4 = *(const LAS f32x4*)(wab + c * 1024 + 4 * (lane + 64 * q)); a += hv[q][0] * w4[0] + hv[q][1] * w4[1] + hv[q][2] * w4[2] + hv[q][3] * w4[3]; }
                    a = row_sum16(a);
                    if ((lane & 15) == c) mine = a;
                }
                mine += __shfl_xor(mine, 16); mine += __shfl_xor(mine, 32);
                if (lane < 16) AB[(size_t)r * 16 + lane] = mine;
            }
        }
    }
    if (layer < 4 && (layer & 1)) {
        const float* ck = P.in[6] + (size_t)j * 16 * PAST * 1024;
        const float* cv = P.in[7] + (size_t)j * 16 * PAST * 1024;
        bf16_t* KS = (bf16_t*)(ws + WS_KS); bf16_t* VS = (bf16_t*)(ws + WS_VS);
        const size_t nun = (size_t)16 * PAST * 128;
        for (size_t u = (size_t)blockIdx.x * 512 + tid; u < 2 * nun; u += (size_t)G * 512) {
            const bool isv = u >= nun; const size_t uu = isv ? u - nun : u;
            const size_t b = uu / ((size_t)PAST * 128), rem = uu % ((size_t)PAST * 128);
            const size_t row = rem >> 7, c8 = rem & 127, hh = c8 >> 4, d8 = c8 & 15;
            const float* sp = (isv ? cv : ck) + uu * 8;
            const f32x4 a = *(const f32x4*)sp, c = *(const f32x4*)(sp + 4);
            u32x4 w; w.x = pk2(a[0], a[1]); w.y = pk2(a[2], a[3]); w.z = pk2(c[0], c[1]); w.w = pk2(c[2], c[3]);
            *(u32x4*)((isv ? VS : KS) + ((b * 8 + hh) * KSROWS + row) * 128 + d8 * 8) = w;
        }
        const size_t npad = (size_t)128 * 48 * 16;
        for (size_t u = (size_t)blockIdx.x * 512 + tid; u < 2 * npad; u += (size_t)G * 512) {
            const bool isv = u >= npad; const size_t uu = isv ? u - npad : u;
            const size_t sq = uu / (48 * 16), rem = uu % (48 * 16);
            *(u32x4*)((isv ? VS : KS) + (sq * KSROWS + PAST + TS) * 128 + rem * 8) = (u32x4){0u, 0u, 0u, 0u};
        }
    }
}

DI void phase_g1(const Params& P, LAS unsigned char* lds, int layer) {
    int tid_ = threadIdx.x; asm volatile("" : "+v"(tid_)); const int tid = tid_, wid = __builtin_amdgcn_readfirstlane(tid >> 6), lane = tid & 63, G = gridDim.x;
    const int fr = lane & 15, fq = lane >> 4;
    unsigned char* ws = P.ws;
    const int j = layer >> 1;
    const bf16_t* proj = (const bf16_t*)(ws + WS_PROJ);
    const float* AB = (const float*)(ws + WS_AB);
    float* GL = (float*)(ws + WS_GL);
    const float* convw = P.in[13] + (size_t)j * 4 * 3072;
    const float* cconv = P.in[5] + (size_t)j * 16 * 3 * 3072;
    LAS unsigned char* Qs = lds;
    LAS unsigned char* Ks = lds + 17408;
    LAS unsigned char* VBt = lds + 34816;
    LAS unsigned char* KBt = lds + 53248;
    LAS float* A32 = (LAS float*)(lds + 71680);
    LAS unsigned char* Ts = lds + 88320;
    LAS unsigned char* QKs = lds + 97536;
    LAS float* Gs = (LAS float*)(lds + 105728);

    for (int item = blockIdx.x; item < NITEM; item += G) {
        int b, h, c, row0, nvalid; bool sample;
        if (item < NITEM_P) { const int seq = item >> 7; b = seq >> 3; h = seq & 7; c = item & 127; row0 = b * TP + 64 * c; nvalid = 64; sample = false; }
        else { const int s = item - NITEM_P; b = s >> 3; h = s & 7; c = 0; row0 = MP + b * TS; nvalid = TS; sample = true; }
        unsigned char* ib = ws + WS_R1 + (size_t)item * ITEM_BYTES;
        float val[8][8];
        float rn[8];
        int tido = tid; asm volatile("" : "+v"(tido));
        const int l16 = tido & 15, grp = tido >> 4, part = grp >> 3, rb = grp & 7;
        const int lane = tido & 63, fr = lane & 15, fq = lane >> 4;
        if (tid < 384) {
            const int ch = part * 1024 + h * 128 + 8 * l16;
            float wv[4][8];
#pragma unroll
            for (int t = 0; t < 4; ++t) {
                const f32x4 a = *(const f32x4*)(convw + t * 3072 + ch), bb = *(const f32x4*)(convw + t * 3072 + ch + 4);
                wv[t][0] = a[0]; wv[t][1] = a[1]; wv[t][2] = a[2]; wv[t][3] = a[3]; wv[t][4] = bb[0]; wv[t][5] = bb[1]; wv[t][6] = bb[2]; wv[t][7] = bb[3];
            }
            float win[4][8];
#pragma unroll
            for (int t = 0; t < 4; ++t)
#pragma unroll
                for (int e = 0; e < 8; ++e) win[t][e] = 0.f;
#pragma unroll
            for (int k = 0; k < 11; ++k) {
                const int lr = 8 * rb - 3 + k;
                float in8[8];
                {
                    const bool use_proj = (lr >= 0 && lr < nvalid) || (lr < 0 && !sample && c > 0);
                    const int lrc = use_proj ? lr : 0;
                    const u32x4 v = *(const u32x4*)(proj + (size_t)(row0 + lrc) * NPROJ + ch);
                    unpack8(v, in8);
                    if (!use_proj) {
#pragma unroll
                        for (int e = 0; e < 8; ++e) in8[e] = 0.f;
                    }
                }
                if (k < 3) {
                    if (sample && lr < 0) {
                        const float* sp = cconv + (size_t)(b * 3 + (3 + lr)) * 3072 + ch;
                        const f32x4 a = *(const f32x4*)sp, bb = *(const f32x4*)(sp + 4);
                        in8[0] = a[0]; in8[1] = a[1]; in8[2] = a[2]; in8[3] = a[3]; in8[4] = bb[0]; in8[5] = bb[1]; in8[6] = bb[2]; in8[7] = bb[3];
                    }
                }
#pragma unroll
                for (int e = 0; e < 8; ++e) { win[0][e] = win[1][e]; win[1][e] = win[2][e]; win[2][e] = win[3][e]; win[3][e] = in8[e]; }
                if (k >= 3) {
                    const bool rv = (lr < nvalid);
                    float ss = 0.f;
#pragma unroll
                    for (int e = 0; e < 8; ++e) {
                        const float y = win[0][e] * wv[0][e] + win[1][e] * wv[1][e] + win[2][e] * wv[2][e] + win[3][e] * wv[3][e];
                        const float s = rv ? siluf(y) : 0.f;
                        val[k - 3][e] = s; ss += s * s;
                    }
                    ss = row_sum16(ss);
                    rn[k - 3] = rsqrtf(ss + 1e-6f);
                }
            }
        } else if (wid == 7) {
            const int r = row0 + (lane < nvalid ? lane : 0);
            const bool valid = lane < nvalid;
            const float a = AB[(size_t)r * 16 + h], bb = AB[(size_t)r * 16 + 8 + h];
            const float xa = a + P.in[15][j * 8 + h];
            const float ey = __expf(-fabsf(xa));
            const float lp = (ey < 0.01f) ? ey * (1.f - ey * (0.5f - ey * 0.33333334f)) : __logf(1.f + ey);
            const float sp = fmaxf(xa, 0.f) + lp;
            float g = valid ? -__expf(P.in[14][j * 8 + h]) * sp : 0.f;
            const float beta = valid ? __builtin_amdgcn_rcpf(1.f + __expf(-bb)) : 0.f;
#pragma unroll
            for (int o = 1; o < 64; o <<= 1) { const float t = __shfl_up(g, o); if (lane >= o) g += t; }
            const float glast = readlane_f(g, 63);
            Gs[lane] = g; Gs[64 + lane] = beta; Gs[128 + lane] = __expf(g); Gs[192 + lane] = __expf(glast - g);
            if (lane == 0) GL[item] = __expf(glast);
        }
        __syncthreads();
        if (tid < 384) {
#pragma unroll
            for (int rr = 0; rr < 8; ++rr) {
                const int row = 8 * rb + rr;
                const float beta = Gs[64 + row], eG = Gs[128 + row];
                if (part == 0) {
                    const float sc = rn[rr] * 0.08838834764831845f;
                    float q[8];
#pragma unroll
                    for (int e = 0; e < 8; ++e) q[e] = val[rr][e] * sc;
                    u32x4 w; w.x = pk2(q[0], q[1]); w.y = pk2(q[2], q[3]); w.z = pk2(q[4], q[5]); w.w = pk2(q[6], q[7]);
                    *(LAS u32x4*)(Qs + row * 272 + l16 * 16) = w;
                    bf16_t* qg = (bf16_t*)(ib + 49152) + row * 128;
                    u32x2 g0, g1; g0.x = pk2(q[0] * eG, q[1] * eG); g0.y = pk2(q[2] * eG, q[3] * eG); g1.x = pk2(q[4] * eG, q[5] * eG); g1.y = pk2(q[6] * eG, q[7] * eG);
                    *(u32x2*)(qg + ppos(8 * l16)) = g0; *(u32x2*)(qg + ppos(8 * l16 + 4)) = g1;
                    val[rr][0] = 0.f;
                } else if (part == 1) {
#pragma unroll
                    for (int e = 0; e < 8; ++e) val[rr][e] *= rn[rr];
                    u32x4 w; w.x = pk2(val[rr][0], val[rr][1]); w.y = pk2(val[rr][2], val[rr][3]); w.z = pk2(val[rr][4], val[rr][5]); w.w = pk2(val[rr][6], val[rr][7]);
                    *(LAS u32x4*)(Ks + row * 272 + l16 * 16) = w;
                }
            }
            if (part >= 1) {
                float bsc[8], ksc[8];
#pragma unroll
                for (int rr = 0; rr < 8; ++rr) { const int row = 8 * rb + rr; const float beta = Gs[64 + row]; bsc[rr] = (part == 1) ? beta * Gs[128 + row] : beta; ksc[rr] = Gs[192 + row]; }
                LAS unsigned char* Tt = (part == 1) ? KBt : VBt;
#pragma unroll
                for (int e = 0; e < 8; ++e) {
                    const int dch = 8 * l16 + e;
                    u32x4 w; w.x = pk2(val[0][e] * bsc[0], val[1][e] * bsc[1]); w.y = pk2(val[2][e] * bsc[2], val[3][e] * bsc[3]);
                    w.z = pk2(val[4][e] * bsc[4], val[5][e] * bsc[5]); w.w = pk2(val[6][e] * bsc[6], val[7][e] * bsc[7]);
                    *(LAS u32x4*)(Tt + dch * 144 + rb * 16) = w;
                    if (part == 1) {
                        bf16_t* kd = (bf16_t*)(ib + 65536) + dch * 64;
                        u32x2 k0, k1; k0.x = pk2(val[0][e] * ksc[0], val[1][e] * ksc[1]); k0.y = pk2(val[2][e] * ksc[2], val[3][e] * ksc[3]);
                        k1.x = pk2(val[4][e] * ksc[4], val[5][e] * ksc[5]); k1.y = pk2(val[6][e] * ksc[6], val[7][e] * ksc[7]);
                        *(u32x2*)(kd + ppos(8 * rb)) = k0; *(u32x2*)(kd + ppos(8 * rb + 4)) = k1;
                    }
                }
            }
        }
        __syncthreads();
        {
            const int mt = wid & 3; const bool isqk = wid >= 4;
            LAS unsigned char* As = isqk ? Qs : Ks;
            f32x4 acc[4];
#pragma unroll
            for (int nt = 0; nt < 4; ++nt) acc[nt] = (f32x4){0.f, 0.f, 0.f, 0.f};
#pragma unroll
            for (int ks = 0; ks < 4; ++ks) {
                const bf16x8 a = *(const LAS bf16x8*)(As + (16 * mt + fr) * 272 + (32 * ks + 8 * fq) * 2);
#pragma unroll
                for (int nt = 0; nt < 4; ++nt) {
                    const bf16x8 bfr = *(const LAS bf16x8*)(Ks + (16 * nt + fr) * 272 + (32 * ks + 8 * fq) * 2);
                    acc[nt] = MFMA16(a, bfr, acc[nt]);
                }
            }
#pragma unroll
            for (int nt = 0; nt < 4; ++nt) {
                const int cp = 16 * nt + fr; const float Gc2 = Gs[cp];
#pragma unroll
                for (int i = 0; i < 4; ++i) {
                    const int cr = 16 * mt + 4 * fq + i;
                    const float dec = __expf(Gs[cr] - Gc2);
                    if (!isqk) A32[cr * 65 + cp] = (cr > cp) ? Gs[64 + cr] * acc[nt][i] * dec : 0.f;
                    else *(LAS bf16_t*)(QKs + (cr * 64 + ppos(cp)) * 2) = f2bf((cr >= cp) ? acc[nt][i] * dec : 0.f);
                }
            }
        }
        __syncthreads();
        {
            float a[64];
#pragma unroll
            for (int jj = 0; jj < 64; ++jj) a[jj] = A32[lane * 65 + jj];
            float x[8];
#pragma unroll
            for (int cc = 0; cc < 8; ++cc) x[cc] = (lane == 8 * wid + cc) ? 1.f : 0.f;
#pragma unroll
            for (int jj = 0; jj < 64; ++jj) {
                if (jj >= 8 * wid) {
#pragma unroll
                    for (int cc = 0; cc < 8; ++cc) { const float xj = readlane_f(x[cc], jj); x[cc] -= a[jj] * xj; }
                }
            }
            u32x4 w; w.x = pk2(x[0], x[1]); w.y = pk2(x[2], x[3]); w.z = pk2(x[4], x[5]); w.w = pk2(x[6], x[7]);
            *(LAS u32x4*)(Ts + lane * 144 + wid * 16) = w;
            *(u32x4*)(ib + 81920 + tid * 16) = *(const LAS u32x4*)(QKs + tid * 16);
        }
        __syncthreads();
        {
            const bool isw = wid >= 4; const int n0 = 32 * (wid & 3);
            LAS unsigned char* Bs = isw ? KBt : VBt;
            f32x4 acc[4][2];
#pragma unroll
            for (int mt = 0; mt < 4; ++mt) { acc[mt][0] = (f32x4){0.f, 0.f, 0.f, 0.f}; acc[mt][1] = (f32x4){0.f, 0.f, 0.f, 0.f}; }
#pragma unroll
            for (int ks = 0; ks < 2; ++ks) {
                bf16x8 bfr[2];
#pragma unroll
                for (int nn = 0; nn < 2; ++nn) bfr[nn] = *(const LAS bf16x8*)(Bs + (n0 + 16 * nn + fr) * 144 + (32 * ks + 8 * fq) * 2);
#pragma unroll
                for (int mt = 0; mt < 4; ++mt) {
                    const bf16x8 a = *(const LAS bf16x8*)(Ts + (16 * mt + fr) * 144 + (32 * ks + 8 * fq) * 2);
                    acc[mt][0] = MFMA16(a, bfr[0], acc[mt][0]); acc[mt][1] = MFMA16(a, bfr[1], acc[mt][1]);
                }
            }
            if (!isw) {
                float* U = (float*)ib;
#pragma unroll
                for (int mt = 0; mt < 4; ++mt)
#pragma unroll
                    for (int nn = 0; nn < 2; ++nn)
#pragma unroll
                        for (int i = 0; i < 4; ++i) U[(16 * mt + 4 * fq + i) * 128 + n0 + 16 * nn + fr] = acc[mt][nn][i];
            } else {
#pragma unroll
                for (int mt = 0; mt < 4; ++mt)
#pragma unroll
                    for (int nn = 0; nn < 2; ++nn)
#pragma unroll
                        for (int i = 0; i < 4; ++i) *(LAS bf16_t*)(Qs + ((16 * mt + 4 * fq + i) * 128 + ppos(n0 + 16 * nn + fr)) * 2) = f2bf(acc[mt][nn][i]);
            }
        }
        __syncthreads();
        {
            *(u32x4*)(ib + 32768 + tid * 16) = *(const LAS u32x4*)(Qs + tid * 16);
            *(u32x4*)(ib + 32768 + 8192 + tid * 16) = *(const LAS u32x4*)(Qs + 8192 + tid * 16);
        }
        __syncthreads();
    }
}

DI void phase_scan(const Params& P, LAS unsigned char* lds, int layer) {
    int tid_ = threadIdx.x; asm volatile("" : "+v"(tid_)); const int tid = tid_, wid = __builtin_amdgcn_readfirstlane(tid >> 6), lane = tid & 63, G = gridDim.x;
    const int fr = lane & 15, fq = lane >> 4;
    unsigned char* ws = P.ws;
    const int j = layer >> 1;
    const bf16_t* proj = (const bf16_t*)(ws + WS_PROJ);
    const float* GL = (const float*)(ws + WS_GL);
    bf16_t* OB = (bf16_t*)(ws + WS_HBUF);
    constexpr int BUFB = 57344;
    LAS float* red = (LAS float*)(lds + 2 * BUFB);

    for (int seq = blockIdx.x; seq < 160; seq += G) {
        int b, h, nch, item0, row0, nvalid; float* stout;
        f32x4 st[8];
        const int dvc = 16 * wid + fr;
        if (seq < 32) {
            b = seq >> 3; h = seq & 7; nch = 128; item0 = seq * 128; row0 = b * TP; nvalid = 64;
            stout = P.out + OFF_STP + ((size_t)(j * 4 + b) * 8 + h) * 16384;
#pragma unroll
            for (int mt = 0; mt < 8; ++mt) st[mt] = (f32x4){0.f, 0.f, 0.f, 0.f};
        } else {
            const int s = seq - 32; b = s >> 3; h = s & 7; nch = 1; item0 = NITEM_P + s; row0 = MP + b * TS; nvalid = TS;
            stout = P.out + OFF_STS + ((size_t)(j * 16 + b) * 8 + h) * 16384;
            const float* s0 = P.in[4] + ((size_t)(j * 16 + b) * 8 + h) * 16384;
            const unsigned s0o = (unsigned)(4 * fq * 128 + dvc);
#pragma unroll
            for (int mt = 0; mt < 8; ++mt)
#pragma unroll
                for (int i = 0; i < 4; ++i) st[mt][i] = s0[(unsigned)((16 * mt + i) * 128) + s0o];
        }
        const float onw = P.in[16][j * 128 + dvc];
        f32x4 un[4];
#define SCAN_G2L(itm, bufi, LN) do { const unsigned char* _ib = ws + WS_R1 + (size_t)(itm) * ITEM_BYTES + 32768; \
            _Pragma("unroll") for (int _p = 0; _p < 7; ++_p) { const int _L = (wid + 8 * _p) * 1024 + (LN) * 16; unsigned _src; \
                if (_p < 4) { const int _row = _L >> 8, _ch = (_L >> 4) & 15; _src = (_L & ~255) + ((_ch ^ (_row & 15)) << 4); } \
                else { const int _a = _L - 32768, _row = _a >> 7, _ch = (_a >> 4) & 7; _src = 32768 + (_a & ~127) + ((_ch ^ ((_row >> 1) & 7)) << 4); } \
                g2l16(_ib + _src, lds_u32(lds + (bufi) * BUFB + (wid + 8 * _p) * 1024)); } } while (0)
#define SCAN_LOADU(itm) do { const float* _u = (const float*)(ws + WS_R1 + (size_t)(itm) * ITEM_BYTES); const unsigned _uo = (unsigned)(4 * fq * 128 + 16 * wid + fr); \
            _Pragma("unroll") for (int _m = 0; _m < 4; ++_m) _Pragma("unroll") for (int _i = 0; _i < 4; ++_i) un[_m][_i] = _u[(unsigned)((16 * _m + _i) * 128) + _uo]; } while (0)
        __syncthreads();
        SCAN_G2L(item0, 0, lane);
        SCAN_LOADU(item0);
        float gln = GL[item0];
        asm volatile("s_waitcnt vmcnt(0)" ::: "memory");
        __syncthreads();
        for (int c = 0; c < nch; ++c) {
            int frq = lane; asm volatile("" : "+v"(frq));
            const int fr = frq & 15, fq = frq >> 4;
            LAS unsigned char* bb = lds + (c & 1) * BUFB;
            const float gl = gln;
            f32x4 u[4];
#pragma unroll
            for (int mt = 0; mt < 4; ++mt) u[mt] = un[mt];
            if (c + 1 < nch) { gln = GL[item0 + c + 1]; SCAN_G2L(item0 + c + 1, (c + 1) & 1, frq); }
            const int x16 = fr << 4, x8 = ((fr >> 1) & 7) << 4;
            bf16x8 sf[4];
#pragma unroll
            for (int ks = 0; ks < 4; ++ks) {
                u32x4 w; w.x = pk2(-st[2 * ks][0], -st[2 * ks][1]); w.y = pk2(-st[2 * ks][2], -st[2 * ks][3]); w.z = pk2(-st[2 * ks + 1][0], -st[2 * ks + 1][1]); w.w = pk2(-st[2 * ks + 1][2], -st[2 * ks + 1][3]);
                sf[ks] = __builtin_bit_cast(bf16x8, w);
            }
            bf16x8 fa[4], fb[4];
#define SC_LD256(dst, base, mt) do { _Pragma("unroll") for (int _k = 0; _k < 4; ++_k) \
                dst[_k] = *(const LAS bf16x8*)(bb + (base) + (16 * (mt) + fr) * 256 + ((((4 * _k + fq) << 4)) ^ x16)); } while (0)
#define SC_LD128(dst, base, mtlo) do { _Pragma("unroll") for (int _m = 0; _m < 2; ++_m) _Pragma("unroll") for (int _k = 0; _k < 2; ++_k) \
                dst[_m * 2 + _k] = *(const LAS bf16x8*)(bb + (base) + (16 * ((mtlo) + _m) + fr) * 128 + ((((4 * _k + fq) << 4)) ^ x8)); } while (0)
#define SC_SB __builtin_amdgcn_sched_barrier(0)
#define SC_MU(f, mt) do { _Pragma("unroll") for (int _k = 0; _k < 4; ++_k) u[mt] = MFMA16(f[_k], sf[_k], u[mt]); } while (0)
#define SC_MO(f, mt) do { _Pragma("unroll") for (int _k = 0; _k < 4; ++_k) o[mt] = MFMA16(f[_k], sf[_k], o[mt]); } while (0)
#define SC_MQK(f, mtlo) do { _Pragma("unroll") for (int _m = 0; _m < 2; ++_m) _Pragma("unroll") for (int _k = 0; _k < 2; ++_k) o[(mtlo) + _m] = MFMA16(f[_m * 2 + _k], uf[_k], o[(mtlo) + _m]); } while (0)
#define SC_MKD(f, mtlo) do { _Pragma("unroll") for (int _m = 0; _m < 2; ++_m) { st[(mtlo) + _m] = st[(mtlo) + _m] * gl; _Pragma("unroll") for (int _k = 0; _k < 2; ++_k) st[(mtlo) + _m] = MFMA16(f[_m * 2 + _k], uf[_k], st[(mtlo) + _m]); } } while (0)
            f32x4 o[4];
#pragma unroll
            for (int mt = 0; mt < 4; ++mt) o[mt] = (f32x4){0.f, 0.f, 0.f, 0.f};
            SC_LD256(fa, 0, 0); SC_LD256(fb, 0, 1); SC_SB;
            SC_MU(fa, 0); SC_LD256(fa, 0, 2); SC_SB;
            SC_MU(fb, 1); SC_LD256(fb, 0, 3); SC_SB;
            SC_MU(fa, 2); SC_LD256(fa, 16384, 0); SC_SB;
            SC_MU(fb, 3); SC_LD256(fb, 16384, 1); SC_SB;
#pragma unroll
            for (int ks = 0; ks < 4; ++ks) sf[ks] = sf[ks] ^ (short)0x8000;
            SC_MO(fa, 0); SC_LD256(fa, 16384, 2); SC_SB;
            SC_MO(fb, 1); SC_LD256(fb, 16384, 3); SC_SB;
            SC_MO(fa, 2); SC_LD128(fa, 49152, 0); SC_SB;
            SC_MO(fb, 3); SC_LD128(fb, 49152, 2); SC_SB;
            bf16x8 uf[2];
#pragma unroll
            for (int k2 = 0; k2 < 2; ++k2) {
                u32x4 w; w.x = pk2(u[2 * k2][0], u[2 * k2][1]); w.y = pk2(u[2 * k2][2], u[2 * k2][3]); w.z = pk2(u[2 * k2 + 1][0], u[2 * k2 + 1][1]); w.w = pk2(u[2 * k2 + 1][2], u[2 * k2 + 1][3]);
                uf[k2] = __builtin_bit_cast(bf16x8, w);
            }
            SC_MQK(fa, 0); SC_LD128(fa, 32768, 0); SC_SB;
            SC_MQK(fb, 2); SC_LD128(fb, 32768, 2); SC_SB;
            SC_MKD(fa, 0); SC_LD128(fa, 32768, 4); SC_SB;
            SC_MKD(fb, 2); SC_LD128(fb, 32768, 6); SC_SB;
            SC_MKD(fa, 4); SC_SB;
            SC_MKD(fb, 6);
#undef SC_MU
#undef SC_MO
#undef SC_MQK
#undef SC_MKD
#undef SC_LD256
#undef SC_LD128
#undef SC_SB
            if (c + 1 < nch) SCAN_LOADU(item0 + c + 1);
            unsigned short zr[4][4];
            {
                const bf16_t* zb = proj + (size_t)(row0 + 64 * c) * NPROJ + 3072 + h * 128;
                const unsigned zo = (unsigned)(4 * fq * NPROJ + 16 * wid + fr);
                const int msk = (nvalid == 64) ? 63 : 15;
#pragma unroll
                for (int mt = 0; mt < 4; ++mt)
#pragma unroll
                    for (int i = 0; i < 4; ++i) zr[mt][i] = zb[(unsigned)((((16 * mt) & msk) + i) * NPROJ) + zo];
            }
            LAS float* rd = red + (c & 1) * 512;
            {
                float sel = 0.f;
#pragma unroll
                for (int mt = 0; mt < 4; ++mt)
#pragma unroll
                    for (int i = 0; i < 4; ++i) { const float ss = row_sum16(o[mt][i] * o[mt][i]); if (fr == 4 * mt + i) sel = ss; }
                rd[(16 * (fr >> 2) + 4 * fq + (fr & 3)) * 8 + wid] = sel;
            }
            asm volatile("s_waitcnt vmcnt(0)" ::: "memory");
            __syncthreads();
            {
                const int myrow = 16 * (fr >> 2) + 4 * fq + (fr & 3);
                const f32x4 p0 = *(const LAS f32x4*)(rd + myrow * 8), p1 = *(const LAS f32x4*)(rd + myrow * 8 + 4);
                const float tot = p0[0] + p0[1] + p0[2] + p0[3] + p1[0] + p1[1] + p1[2] + p1[3];
                LAS float* rs = red + 1024 + wid * 64;
                rs[fq * 16 + fr] = rsqrtf(tot * (1.f / 128.f) + RMS_EPS);
                bf16_t* obb = OB + (size_t)(row0 + 64 * c) * 1024 + h * 128;
                const unsigned oo = (unsigned)(4 * fq * 1024 + 16 * wid + fr);
#pragma unroll
                for (int mt = 0; mt < 4; ++mt) {
                    const f32x4 r4 = *(const LAS f32x4*)(rs + fq * 16 + 4 * mt);
#pragma unroll
                    for (int i = 0; i < 4; ++i) {
                        const int lr = 16 * mt + 4 * fq + i;
                        const float ov = o[mt][i] * r4[i] * onw * siluf(bf2f(zr[mt][i]));
                        const bf16_t ob = f2bf(ov);
                        if (lr < nvalid) obb[(unsigned)((16 * mt + i) * 1024) + oo] = ob;
                    }
                }
            }
        }
        {
            int lz = lane; asm volatile("" : "+v"(lz));
            const unsigned so = (unsigned)(4 * (lz >> 4) * 128 + 16 * wid + (lz & 15));
#pragma unroll
            for (int mt = 0; mt < 8; ++mt)
#pragma unroll
                for (int i = 0; i < 4; ++i) stout[(unsigned)((16 * mt + i) * 128) + so] = st[mt][i];
        }
#undef SCAN_G2L
#undef SCAN_LOADU
    }
}

DI void att_s(LAS unsigned char* Ka, int t, const bf16x8 (&qf)[4], f32x16& s0, f32x16& s1) {
#pragma unroll
    for (int i = 0; i < 16; ++i) { s0[i] = 0.f; s1[i] = 0.f; }
    bf16x8 kf[8];
#pragma unroll
    for (int s = 0; s < 4; ++s) { kf[2 * s] = *(const LAS bf16x8*)(Ka + (t ^ (s << 5))); kf[2 * s + 1] = *(const LAS bf16x8*)(Ka + 8192 + (t ^ (s << 5))); }
#pragma unroll
    for (int s = 0; s < 4; ++s) { s0 = MFMA32(kf[2 * s], qf[s], s0); s1 = MFMA32(kf[2 * s + 1], qf[s], s1); }
}
template <bool MASK>
DI float att_softmax(f32x16& s0, f32x16& s1, float& m, float& l, bf16x8 (&pf)[2][2], int h2, int nvk) {
    if (MASK) {
#pragma unroll
        for (int i = 0; i < 16; ++i) {
            const int key = (i & 3) + 8 * (i >> 2) + 4 * h2;
            s0[i] = (key < nvk) ? s0[i] : -INFINITY;
            s1[i] = (32 + key < nvk) ? s1[i] : -INFINITY;
        }
    }
    float mx = s0[0];
#pragma unroll
    for (int i = 1; i < 16; ++i) mx = fmaxf(mx, s0[i]);
#pragma unroll
    for (int i = 0; i < 16; ++i) mx = fmaxf(mx, s1[i]);
    mx = fmaxf(mx, __shfl_xor(mx, 32));
    const float mn = fmaxf(m, mx);
    const float alpha = __builtin_amdgcn_exp2f(m - mn);
    m = mn;
    float ps = 0.f;
#pragma unroll
    for (int i = 0; i < 16; ++i) { s0[i] = __builtin_amdgcn_exp2f(s0[i] - mn); s1[i] = __builtin_amdgcn_exp2f(s1[i] - mn); ps += s0[i] + s1[i]; }
    l = l * alpha + ps;
    u32x4 w;
    w.x = pk2(s0[0], s0[1]); w.y = pk2(s0[2], s0[3]); w.z = pk2(s0[4], s0[5]); w.w = pk2(s0[6], s0[7]); pf[0][0] = __builtin_bit_cast(bf16x8, w);
    w.x = pk2(s0[8], s0[9]); w.y = pk2(s0[10], s0[11]); w.z = pk2(s0[12], s0[13]); w.w = pk2(s0[14], s0[15]); pf[0][1] = __builtin_bit_cast(bf16x8, w);
    w.x = pk2(s1[0], s1[1]); w.y = pk2(s1[2], s1[3]); w.z = pk2(s1[4], s1[5]); w.w = pk2(s1[6], s1[7]); pf[1][0] = __builtin_bit_cast(bf16x8, w);
    w.x = pk2(s1[8], s1[9]); w.y = pk2(s1[10], s1[11]); w.z = pk2(s1[12], s1[13]); w.w = pk2(s1[14], s1[15]); pf[1][1] = __builtin_bit_cast(bf16x8, w);
    return alpha;
}
DI void att_pv(LAS unsigned char* Va, int q4, f32x16 (&O)[4], const bf16x8 (&pf)[2][2]) {
    s16x4 lo[16], hi[16];
#define PV_LD(i) do { LAS unsigned char* _vp = Va + ((((i) >> 2) ^ q4) << 6) + (32 * (((i) >> 1) & 1) + 16 * ((i) & 1)) * 256; \
        lo[i] = __builtin_amdgcn_ds_read_tr16_b64_v4i16((LAS s16x4*)_vp); hi[i] = __builtin_amdgcn_ds_read_tr16_b64_v4i16((LAS s16x4*)(_vp + 8 * 256)); } while (0)
    PV_LD(0); PV_LD(1); PV_LD(2);
#pragma unroll
    for (int i = 0; i < 16; ++i) {
        if (i + 3 < 16) PV_LD(i + 3);
        const bf16x8 vf = __builtin_shufflevector(lo[i], hi[i], 0, 1, 2, 3, 4, 5, 6, 7);
        O[i >> 2] = MFMA32(vf, pf[(i >> 1) & 1][i & 1], O[i >> 2]);
    }
#undef PV_LD
}

DI void phase_attn(const Params& P, LAS unsigned char* lds, int layer) {
    int tid_ = threadIdx.x; asm volatile("" : "+v"(tid_)); const int tid = tid_, wid = __builtin_amdgcn_readfirstlane(tid >> 6), lane = tid & 63, G = gridDim.x;
    unsigned char* ws = P.ws;
    const int j = layer >> 1;
    const int comp = wid >> 2, rg = wid & 3, r32 = lane & 31, h2 = lane >> 5;
    const bf16_t* proj = (const bf16_t*)(ws + WS_PROJ);
    bf16_t* OB = (bf16_t*)(ws + WS_HBUF);
    const float lam_init = 0.8f - 0.6f * expf(-0.3f * (float)layer);
    float lam;
    {
        float d1 = 0.f, d2 = 0.f;
        for (int i = 0; i < 64; ++i) { d1 += P.in[19][j * 64 + i] * P.in[20][j * 64 + i]; d2 += P.in[21][j * 64 + i] * P.in[22][j * 64 + i]; }
        lam = expf(d1) - expf(d2) + lam_init;
    }
    const float* subln = P.in[23] + j * 128;
    constexpr int TB = 32768;
    const int vb = (G % 8 == 0) ? (blockIdx.x % 8) * (G / 8) + blockIdx.x / 8 : blockIdx.x;
    const int nrounds = (G == 256) ? 9 : (2176 + G - 1) / G;
#define ATT_WAITV(n) asm volatile("s_waitcnt vmcnt(" #n ")" ::: "memory")
#define ATT_BAR() do { asm volatile("" ::: "memory"); __builtin_amdgcn_s_barrier(); asm volatile("" ::: "memory"); } while (0)
    for (int k = 0; k < nrounds; ++k) {
        int id;
        if (G == 256) {
            if (k < 8) { const int xcd = vb >> 5, idx = vb & 31; const int seq = xcd * 4 + (k >> 1); const int qt = (k & 1) ? idx : (63 - idx); id = seq * 64 + qt; }
            else { if (vb >= 128) break; id = 2048 + vb; }
        } else { id = vb + k * G; if (id >= 2176) break; }
        int h, qrow0, nt_all, nt_mine, last_valid; const int kvstride = 128; const bf16_t* Kp; const bf16_t* Vp; bool sample;
        if (id < 2048) {
            const int seq = id >> 6, qt = id & 63, b = seq >> 3; h = seq & 7; sample = false;
            qrow0 = b * TP + 128 * qt + 32 * rg; nt_all = 2 * qt + 2; nt_mine = (rg < 2) ? 2 * qt + 1 : 2 * qt + 2; last_valid = 64 * nt_mine;
            Kp = (const bf16_t*)(ws + WS_KH) + (size_t)seq * TP * 128; Vp = (const bf16_t*)(ws + WS_VH) + (size_t)seq * TP * 128;
        } else {
            const int s = id - 2048, b = s >> 3; h = s & 7; sample = true;
            qrow0 = MP + b * TS; nt_all = 34; nt_mine = (rg == 0) ? 34 : 0; last_valid = PAST + TS;
            Kp = (const bf16_t*)(ws + WS_KS) + (size_t)s * KSROWS * 128; Vp = (const bf16_t*)(ws + WS_VS) + (size_t)s * KSROWS * 128;
        }
        bf16x8 qf[4];
        {
            const int qr = qrow0 + (sample ? (r32 & 15) : r32);
            const bf16_t* qp = proj + (size_t)qr * NPROJ + h * 128 + comp * 64 + 8 * h2;
#pragma unroll
            for (int s = 0; s < 4; ++s) qf[s] = *(const bf16x8*)(qp + 16 * s);
        }
        f32x16 O[4];
#pragma unroll
        for (int et = 0; et < 4; ++et)
#pragma unroll
            for (int i = 0; i < 16; ++i) O[et][i] = 0.f;
        float m = -INFINITY, l = 0.f;
        bf16x8 pf[2][2];
#pragma unroll
        for (int a = 0; a < 2; ++a)
#pragma unroll
            for (int c2 = 0; c2 < 2; ++c2) pf[a][c2] = (bf16x8){0, 0, 0, 0, 0, 0, 0, 0};
        f32x16 sA0, sA1, sB0, sB1;
        const bf16_t* gsrc;
        {
            const int rowl = lane >> 4, c = lane & 15;
            const int row0 = 16 * (wid & 3) + rowl;
            const int lc = (wid < 4) ? (c ^ (row0 & 15)) : (c ^ ((row0 & 3) << 2));
            gsrc = ((wid < 4) ? Kp : Vp) + (size_t)row0 * kvstride + lc * 8;
        }
#define ATT_G2L(kt, bufi) do { _Pragma("unroll") for (int _i = 0; _i < 4; ++_i) { \
            const bf16_t* _s = gsrc + (size_t)(64 * (kt) + 4 * _i) * kvstride; \
            if (wid < 4) _s += (((lane & 15) ^ ((16 * (wid & 3) + 4 * _i + (lane >> 4)) & 15)) - ((lane & 15) ^ ((16 * (wid & 3) + (lane >> 4)) & 15))) * 8; \
            g2l16(_s, lds_u32(lds + (bufi) * TB + (4 * wid + _i) * 1024)); } } while (0)
        asm volatile("" :: "v"(qf[0]), "v"(qf[1]), "v"(qf[2]), "v"(qf[3]));
        __syncthreads();
        ATT_G2L(0, 0);
        if (nt_all > 1) { ATT_G2L(1, 1); ATT_WAITV(4); } else { ATT_WAITV(0); }
        ATT_BAR();
        {
            const int koff = r32 * 256, t = ((comp * 8 + h2) ^ (r32 & 15)) << 4;
            att_s(lds + koff, t, qf, sA0, sA1);
        }
#define ATT_ITER(KT, sC0, sC1, sN0, sN1, EDGE) do { \
            const int kt = (KT); \
            int lo_ = lane; asm volatile("" : "+v"(lo_)); \
            const int r32_ = lo_ & 31, h2_ = lo_ >> 5, q4_ = (lo_ & 15) >> 2, p4_ = lo_ & 3, blk_ = (lo_ >> 4) & 1; \
            const int koff_ = r32_ * 256, t_ = ((comp * 8 + h2_) ^ (r32_ & 15)) << 4; \
            const int voff_ = (4 * h2_ + q4_) * 256 + (2 * blk_ + (p4_ >> 1)) * 16 + (p4_ & 1) * 8; \
            ATT_WAITV(0); ATT_BAR(); \
            if (kt + 2 < nt_all) ATT_G2L(kt + 2, (kt + 2) & 3); \
            att_s(lds + ((kt + 1) & 3) * TB + koff_, t_, qf, sN0, sN1); \
            if (!(EDGE) || kt >= 1) att_pv(lds + ((kt - 1) & 3) * TB + 16384 + voff_, q4_, O, pf); \
            const float alpha = att_softmax<EDGE>(sC0, sC1, m, l, pf, h2_, last_valid - 64 * kt); \
            asm volatile("" :: "v"(l), "v"(pf[0][0]), "v"(pf[0][1]), "v"(pf[1][0]), "v"(pf[1][1]));     \
            _Pragma("unroll") for (int _g = 0; _g < 24; ++_g) { __builtin_amdgcn_sched_group_barrier(0x008, 1, 0); __builtin_amdgcn_sched_group_barrier(0x002, 7, 0); } \
            if (__any(alpha != 1.f)) { \
                _Pragma("unroll") for (int et = 0; et < 4; ++et) _Pragma("unroll") for (int i = 0; i < 16; ++i) O[et][i] *= alpha; } \
            } while (0)
        {
            const int npairs = nt_all >> 1;
            ATT_ITER(0, sA0, sA1, sB0, sB1, true);
            ATT_ITER(1, sB0, sB1, sA0, sA1, true);
            for (int pp = 1; pp < npairs - 1; ++pp) {
                ATT_ITER(2 * pp, sA0, sA1, sB0, sB1, false);
                ATT_ITER(2 * pp + 1, sB0, sB1, sA0, sA1, false);
            }
            if (npairs > 1) {
                ATT_ITER(nt_all - 2, sA0, sA1, sB0, sB1, true);
                ATT_ITER(nt_all - 1, sB0, sB1, sA0, sA1, true);
            }
        }
        {
            const int lt = nt_all - 1;
            const int h2b = lane >> 5, q4 = (lane & 15) >> 2, p4 = lane & 3, blk = (lane >> 4) & 1;
            const int voff = (4 * h2b + q4) * 256 + (2 * blk + (p4 >> 1)) * 16 + (p4 & 1) * 8;
            att_pv(lds + (lt & 3) * TB + 16384 + voff, q4, O, pf);
        }
        __syncthreads();
#undef ATT_ITER
#undef ATT_G2L
        const float lt = l + __shfl_xor(l, 32);
        const float inv = (nt_mine > 0) ? 1.f / lt : 0.f;
        LAS float* XO = (LAS float*)lds;
        if (comp == 1) {
            const float sc = inv * lam;
#pragma unroll
            for (int et = 0; et < 4; ++et)
#pragma unroll
                for (int i = 0; i < 16; ++i) XO[(rg * 128 + 32 * et + (i & 3) + 8 * (i >> 2) + 4 * h2) * 32 + r32] = O[et][i] * sc;
        }
        __syncthreads();
        if (comp == 0 && nt_mine > 0) {
            float ss = 0.f;
#pragma unroll
            for (int et = 0; et < 4; ++et)
#pragma unroll
                for (int i = 0; i < 16; ++i) { const float v = O[et][i] * inv - XO[(rg * 128 + 32 * et + (i & 3) + 8 * (i >> 2) + 4 * h2) * 32 + r32]; O[et][i] = v; ss += v * v; }
            ss += __shfl_xor(ss, 32);
            const float rstd = rsqrtf(ss * (1.f / 128.f) + RMS_EPS) * (1.f - lam_init);
            const bool rvalid = sample ? (r32 < TS) : true;
            const int row = qrow0 + r32;
            if (rvalid) {
#pragma unroll
                for (int et = 0; et < 4; ++et)
#pragma unroll
                    for (int g4 = 0; g4 < 4; ++g4) {
                        const int e0 = 32 * et + 8 * g4 + 4 * h2;
                        const u32x2 zz = *(const u32x2*)(proj + (size_t)row * NPROJ + 3072 + h * 128 + e0);
                        const f32x4 sl = *(const f32x4*)(subln + e0);
                        const float z0 = __uint_as_float(zz.x << 16), z1 = __uint_as_float(zz.x & 0xffff0000u), z2 = __uint_as_float(zz.y << 16), z3 = __uint_as_float(zz.y & 0xffff0000u);
                        u32x2 w;
                        w.x = pk2(O[et][4 * g4] * rstd * sl[0] * siluf(z0), O[et][4 * g4 + 1] * rstd * sl[1] * siluf(z1));
                        w.y = pk2(O[et][4 * g4 + 2] * rstd * sl[2] * siluf(z2), O[et][4 * g4 + 3] * rstd * sl[3] * siluf(z3));
                        *(u32x2*)(OB + (size_t)row * 1024 + h * 128 + e0) = w;
                    }
            }
        }
        __syncthreads();
    }
}


#define XB_TMO      128
#define XB_XCNT(j)  (256  + 64 * (j))
#define XB_XSUB(j)  (1280 + 64 * (j))
#define XB_XGEN(j)  (2304 + 64 * (j))
#define XB_TOP      3328
#define XB_TOPGEN   3392
#define XCD_BAR_WORDS 3456
#define XB_SPIN_CAP (1u << 18)
DI unsigned xb_ld(unsigned* p)              { return __hip_atomic_load(p, __ATOMIC_RELAXED, __HIP_MEMORY_SCOPE_AGENT); }
DI unsigned xb_add(unsigned* p, unsigned v) { return __hip_atomic_fetch_add(p, v, __ATOMIC_RELAXED, __HIP_MEMORY_SCOPE_AGENT); }
DI unsigned xb_xcc_id() { return (unsigned)__builtin_amdgcn_s_getreg((3 << 11) | 20) & 0xFu; }
#define XB_SPIN(cond, bar) do { unsigned _sp = 0; while (cond) { __builtin_amdgcn_s_sleep(1); \
    if ((++_sp & 255u) == 0u) { if (xb_ld(&(bar)[XB_TMO])) break; if (_sp > XB_SPIN_CAP) { atomicAdd(&(bar)[XB_TMO], 1u); break; } } } } while (0)
DI void xcd_barrier_complete(unsigned* bar, unsigned x, unsigned& nloc, unsigned& nx) {
    const unsigned G = gridDim.x * gridDim.y * gridDim.z;
    unsigned sum, cnt, mine, sp = 0u;
    for (;;) {
        sum = 0u; cnt = 0u; mine = 0u;
#pragma unroll
        for (unsigned j = 0; j < 16; ++j) { const unsigned c = xb_ld(&bar[XB_XCNT(j)]); sum += c; cnt += (c > 0u) ? 1u : 0u; mine = (j == x) ? c : mine; }
        if (sum == G) break;
        __builtin_amdgcn_s_sleep(1);
        if ((++sp & 255u) == 0u) { if (xb_ld(&bar[XB_TMO])) break; if (sp > XB_SPIN_CAP) { atomicAdd(&bar[XB_TMO], 1u); break; } }
    }
    nloc = mine > 0u ? mine : 1u; nx = cnt > 0u ? cnt : 1u;
}
DI void xcd_barrier(unsigned* bar, volatile LAS unsigned* st) {
    asm volatile("s_waitcnt vmcnt(0)" ::: "memory");
    __syncthreads();
    if (threadIdx.x == 0) {
        const unsigned x = xb_xcc_id();
        __builtin_amdgcn_s_waitcnt(0);
        unsigned nloc = st[0], nx = st[1];
        if (nloc == 0u) { xcd_barrier_complete(bar, x, nloc, nx); st[0] = nloc; st[1] = nx; }
        const unsigned old = xb_add(&bar[XB_XSUB(x)], 1u);
        const unsigned gen = old / nloc;
        if (old + 1u == (gen + 1u) * nloc) {
            __builtin_amdgcn_fence(__ATOMIC_RELEASE, "agent");
            asm volatile("s_waitcnt vmcnt(0)" ::: "memory");
            const unsigned og = xb_add(&bar[XB_TOP], 1u);
            const unsigned tg = og / nx;
            if (og + 1u == (tg + 1u) * nx) xb_add(&bar[XB_TOPGEN], 1u);
            else XB_SPIN(xb_ld(&bar[XB_TOPGEN]) == tg, bar);
            __builtin_amdgcn_fence(__ATOMIC_ACQUIRE, "agent");
            xb_add(&bar[XB_XGEN(x)], 1u);
            asm volatile("s_waitcnt vmcnt(0)" ::: "memory");
        } else {
            XB_SPIN(xb_ld(&bar[XB_XGEN(x)]) == gen, bar);
            __builtin_amdgcn_fence(__ATOMIC_ACQUIRE, "agent");
            asm volatile("s_waitcnt vmcnt(0)" ::: "memory");
        }
    }
    __syncthreads();
}

typedef const __attribute__((address_space(4))) Params* CParP;
#define LOADP() Params P; { CParP kp_ = KP; asm volatile("" : "+s"(kp_)); P = *kp_; } unsigned char* ws = P.ws; (void)ws
__global__ void __launch_bounds__(512, 2) fwd_megakernel(Params Pin) {
#if defined(__HIP_DEVICE_COMPILE__)
    extern __shared__ __attribute__((aligned(16))) unsigned char lds_raw[];
    LAS unsigned char* lds = (LAS unsigned char*)lds_raw;
    cg::grid_group grid = cg::this_grid();
    const CParP KP = (CParP)__builtin_amdgcn_kernarg_segment_ptr();
    volatile LAS unsigned* xst = (volatile LAS unsigned*)(lds + 131072);
    if (threadIdx.x == 0) { xst[0] = 0u; xst[1] = 0u; }
    __syncthreads();
    { LOADP(); if (threadIdx.x == 0) (void)xb_add(&((unsigned*)(ws + WS_BAR))[XB_XCNT(xb_xcc_id())], 1u); }
#define GRID_BAR() do { LOADP(); xcd_barrier((unsigned*)(ws + WS_BAR), xst); } while (0)
    for (int rep = opaque_i(REP_PREP); rep > 0; --rep) { LOADP(); phase_prep(P, lds); }
    grid.sync();
    for (int layer = 0; layer < 4; ++layer) {
        const int j = layer >> 1;
        { LOADP(); phase_elem(P, lds, layer); }
        GRID_BAR();
        for (int rep = opaque_i(REP_GIN); rep > 0; --rep) {
            LOADP();
            pg8::StaticOrder S; S.init(M, NPROJ, gridDim.x, blockIdx.x);
            pg8::Gemm g;
            g.A = (const bf16_t*)(ws + WS_HBUF); g.M = M; g.N = NPROJ; g.K = 1024;
            if (!(layer & 1)) {
                g.Bt = (const bf16_t*)(ws + WS_WING) + (size_t)j * 4096 * 1024;
                EpiGdnIn E; E.proj = (bf16_t*)(ws + WS_PROJ); E.conv_p = P.out + OFF_CVP + (size_t)j * 4 * 3 * 3072; E.conv_s = P.out + OFF_CVS + (size_t)j * 16 * 3 * 3072;
                pg8::gemm_phase(lds, g, S, E);
            } else {
                g.Bt = (const bf16_t*)(ws + WS_WIND) + (size_t)j * 4096 * 1024;
                EpiDiffIn E; E.proj = (bf16_t*)(ws + WS_PROJ);
                E.k_p = P.out + OFF_KP + (size_t)j * MP * 1024; E.v_p = P.out + OFF_VP + (size_t)j * MP * 1024;
                E.k_s = P.out + OFF_KSO + (size_t)j * MS * 1024; E.v_s = P.out + OFF_VSO + (size_t)j * MS * 1024;
                E.ks = (bf16_t*)(ws + WS_KS); E.vs = (bf16_t*)(ws + WS_VS); E.kh = (bf16_t*)(ws + WS_KH); E.vh = (bf16_t*)(ws + WS_VH); E.rope = (const float*)(ws + WS_ROPE);
                pg8::gemm_phase(lds, g, S, E);
            }
        }
        GRID_BAR();
        if (!(layer & 1)) {
            for (int rep = opaque_i(REP_G1); rep > 0; --rep) { LOADP(); phase_g1(P, lds, layer); }
            GRID_BAR();
            for (int rep = opaque_i(REP_SCAN); rep > 0; --rep) { LOADP(); phase_scan(P, lds, layer); }
        } else {
            for (int rep = opaque_i(REP_ATTN); rep > 0; --rep) { LOADP(); phase_attn(P, lds, layer); }
        }
        GRID_BAR();
        for (int rep = opaque_i(REP_GOUT); rep > 0; --rep) {
            LOADP();
            pg8::StaticOrder S; S.init(M, 1024, gridDim.x, blockIdx.x);
            pg8::Gemm g;
            g.A = (const bf16_t*)(ws + WS_HBUF); g.M = M; g.N = 1024; g.K = 1024;
            g.Bt = (const bf16_t*)(ws + ((layer & 1) ? WS_WOUTD : WS_WOUTG)) + (size_t)j * 1024 * 1024;
            EpiOut E; E.C = (float*)(ws + WS_PROJ);
            pg8::gemm_phase(lds, g, S, E);
        }
        GRID_BAR();
    }
    { LOADP(); phase_elem(P, lds, 4); }
#endif
}

extern "C" void kernel_launch(void* const* d_in, const int* in_sizes, int n_in, void* d_out, int out_size, void* d_ws, size_t ws_size, hipStream_t stream) {
    static int grid_blocks = 0;
    if (!grid_blocks) {
        int dev = 0, cus = 0, per_cu = 0;
        hipGetDevice(&dev);
        hipDeviceGetAttribute(&cus, hipDeviceAttributeMultiprocessorCount, dev);
        hipFuncSetAttribute((const void*)fwd_megakernel, hipFuncAttributeMaxDynamicSharedMemorySize, LDS_BYTES);
        hipOccupancyMaxActiveBlocksPerMultiprocessor(&per_cu, (const void*)fwd_megakernel, 512, LDS_BYTES);
        if (per_cu < 1) per_cu = 1;
        grid_blocks = cus * per_cu;
        if (ws_size < WS_END) fprintf(stderr, "kernel_launch: workspace too small: %zu < %zu\n", ws_size, (size_t)WS_END);
    }
    hipMemsetAsync((unsigned char*)d_ws + WS_BAR, 0, XCD_BAR_WORDS * sizeof(unsigned), stream);
    Params p{};
    for (int i = 0; i < 25; ++i) p.in[i] = (const float*)d_in[i];
    p.out = (float*)d_out; p.ws = (unsigned char*)d_ws;
    void* args[] = {&p};
    hipError_t e = hipLaunchCooperativeKernel((const void*)fwd_megakernel, dim3(grid_blocks), dim3(512), args, LDS_BYTES, stream);
    if (e != hipSuccess) fprintf(stderr, "cooperative launch failed: %s (grid %d)\n", hipGetErrorString(e), grid_blocks);
}
```

```cpp
#include <hip/hip_runtime.h>
#include <hip/hip_cooperative_groups.h>
#include <cstdio>
namespace cg = cooperative_groups;

#define DI __device__ __forceinline__
#define LAS __attribute__((address_space(3)))
typedef unsigned short bf16_t;
typedef short bf16x8 __attribute__((ext_vector_type(8)));
typedef short s16x4 __attribute__((ext_vector_type(4)));
typedef float f32x2 __attribute__((ext_vector_type(2)));
typedef float f32x4 __attribute__((ext_vector_type(4)));
typedef float f32x16 __attribute__((ext_vector_type(16)));
typedef unsigned u32x2 __attribute__((ext_vector_type(2)));
typedef unsigned u32x4 __attribute__((ext_vector_type(4)));
typedef __bf16 bf16x2_t __attribute__((ext_vector_type(2)));

#define REP_G1 1
#define REP_SCAN 1
#define REP_ATTN 1
#define REP_GIN 1
#define REP_GOUT 1
#define REP_PREP 1
DI int opaque_i(int v) { asm volatile("" : "+s"(v)); return v; }
constexpr int D = 1024, TP = 8192, BP = 4, BS = 16, TS = 16, PAST = 2048;
constexpr int MP = BP * TP, MS = BS * TS, M = MP + MS, NB = BP + BS;
constexpr int NPROJ = 4096;
constexpr int KSROWS = 2112;
constexpr int NITEM_P = 4096, NITEM = 4224;
constexpr size_t ITEM_BYTES = 90112;
constexpr float RMS_EPS = 1e-6f;
constexpr float QSCALE = 0.125f * 1.4426950408889634f;

constexpr size_t OFF_Y = 0;
constexpr size_t OFF_STP = (size_t)M * D;
constexpr size_t OFF_CVP = OFF_STP + 2ull * 4 * 8 * 128 * 128;
constexpr size_t OFF_KP = OFF_CVP + 2ull * 4 * 3 * 3072;
constexpr size_t OFF_VP = OFF_KP + 2ull * MP * 1024;
constexpr size_t OFF_STS = OFF_VP + 2ull * MP * 1024;
constexpr size_t OFF_CVS = OFF_STS + 2ull * 16 * 8 * 128 * 128;
constexpr size_t OFF_KSO = OFF_CVS + 2ull * 16 * 3 * 3072;
constexpr size_t OFF_VSO = OFF_KSO + 2ull * MS * 1024;

constexpr size_t WS_WING = 0;
constexpr size_t WS_WOUTG = WS_WING + 2ull * 4096 * 1024 * 2;
constexpr size_t WS_WIND = WS_WOUTG + 2ull * 1024 * 1024 * 2;
constexpr size_t WS_WOUTD = WS_WIND + 2ull * 4096 * 1024 * 2;
constexpr size_t WS_ADA = WS_WOUTD + 2ull * 1024 * 1024 * 2;
constexpr size_t WS_ROPE = WS_ADA + 4ull * NB * 3072 * 4;
constexpr size_t WS_AB = WS_ROPE + 8208ull * 64 * 4;
constexpr size_t WS_GL = WS_AB + (size_t)M * 16 * 4;
constexpr size_t WS_BAR = WS_GL + 17408;
constexpr size_t WS_HBUF = WS_GL + 32768;
constexpr size_t WS_ORAW = WS_HBUF + (size_t)M * 1024 * 2;
constexpr size_t WS_PROJ = WS_ORAW + 256;
constexpr size_t WS_R1 = WS_PROJ + (size_t)M * 4096 * 2;
constexpr size_t WS_KS = WS_R1;
constexpr size_t WS_VS = WS_KS + 16ull * KSROWS * 1024 * 2;
constexpr size_t WS_KH = WS_VS + 16ull * KSROWS * 1024 * 2;
constexpr size_t WS_VH = WS_KH + (size_t)MP * 1024 * 2;
constexpr size_t WS_END = WS_R1 + (size_t)NITEM * ITEM_BYTES;

constexpr int LDS_BYTES = 131072 + 16;

struct Params { const float* in[25]; float* out; unsigned char* ws; };

DI float bf2f(bf16_t v) { return __uint_as_float(((unsigned)v) << 16); }
DI unsigned pk2(float a, float b) { f32x2 v = {a, b}; bf16x2_t r = __builtin_convertvector(v, bf16x2_t); return __builtin_bit_cast(unsigned, r); }
DI bf16_t f2bf(float a) { return (bf16_t)(pk2(a, 0.f) & 0xffffu); }
template <int CTRL> DI float dppf(float v) { return __builtin_bit_cast(float, __builtin_amdgcn_update_dpp(0, __builtin_bit_cast(int, v), CTRL, 0xf, 0xf, true)); }
DI float row_sum16(float v) { v += dppf<0x128>(v); v += dppf<0x124>(v); v += dppf<0x122>(v); v += dppf<0x121>(v); return v; }
DI float wave_sum(float v) { v = row_sum16(v); v += __shfl_xor(v, 16); v += __shfl_xor(v, 32); return v; }
DI float readlane_f(float v, int l) { return __builtin_bit_cast(float, __builtin_amdgcn_readlane(__builtin_bit_cast(int, v), l)); }
DI float siluf(float x) { return x * __builtin_amdgcn_rcpf(1.f + __expf(-x)); }
DI int ppos(int idx) { const int d5 = idx & 31; return (idx & ~31) | (((d5 >> 2) & 3) << 3) | ((d5 >> 4) << 2) | (d5 & 3); }
DI int perm64(int ls) { return (ls & 15) | (((ls >> 4) & 1) << 5) | (((ls >> 5) & 1) << 4); }
DI void unpack8(const u32x4 v, float (&o)[8]) {
#pragma unroll
    for (int i = 0; i < 4; ++i) { o[2 * i] = __uint_as_float(v[i] << 16); o[2 * i + 1] = __uint_as_float(v[i] & 0xffff0000u); }
}
DI void g2l16(const void* gptr, unsigned lds_addr) {
    asm volatile("s_mov_b32 m0, %1\n\ts_nop 0\n\tglobal_load_lds_dwordx4 %0, off" :: "v"(gptr), "s"(lds_addr) : "memory", "m0");
}
DI unsigned lds_u32(LAS unsigned char* p) { return (unsigned)(size_t)p; }
#define MFMA16(a, b, c) __builtin_amdgcn_mfma_f32_16x16x32_bf16((a), (b), (c), 0, 0, 0)
#define MFMA32(a, b, c) __builtin_amdgcn_mfma_f32_32x32x16_bf16((a), (b), (c), 0, 0, 0)

namespace pg8 {
constexpr int BM = 256, BK = 64, HALF = 128, HTB = HALF * BK * 2, STAGE_BYTES = 8 * HTB, NXCD = 8, WGM = 8;
DI int lds_byte(int r, int c) { const int st = (r >> 4) * 2 + (c >> 5), rr = r & 15, cc = c & 31, ob = rr * 64 + cc * 2; return st * 1024 + (ob ^ (((ob >> 9) & 1) << 5)); }
DI void stage_rc(int b, int& R, int& C) { const int st = b / 1024, sb = b % 1024, swz = sb ^ (((sb >> 9) & 1) << 5); R = (st >> 1) * 16 + swz / 64; C = (st & 1) * 32 + (swz % 64) / 2; }
struct Unit { int pm, pn; };
struct Gemm { const bf16_t* A; const bf16_t* Bt; int M, N, K; };
struct StaticOrder {
    int nM, nN, nwg, G, c;
    DI void init(int M_, int N_, int G_, int c_) { nM = M_ / BM; nN = N_ / BM; nwg = nM * nN; G = G_; c = c_; }
    DI bool next(int i, Unit& u) const {
        const long L = (long)i * G + c; if (L >= nwg) return false;
        int wgid = (int)L; { const int q = nwg / NXCD, r = nwg % NXCD, xcd = wgid % NXCD, off = wgid / NXCD; wgid = (xcd < r ? xcd * (q + 1) : r * (q + 1) + (xcd - r) * q) + off; }
        const int nig = WGM * nN, gid = wgid / nig, fm = gid * WGM, gsz = (nM - fm) < WGM ? (nM - fm) : WGM;
        u.pm = fm + ((wgid % nig) % gsz); u.pn = (wgid % nig) / gsz; return true;
    }
};

template <class Epi>
DI void gemm_phase(LAS unsigned char* lds, const Gemm g, const StaticOrder& S, const Epi& E) {
    int tid_ = threadIdx.x; asm volatile("" : "+v"(tid_)); const int tid = tid_, wid = __builtin_amdgcn_readfirstlane(tid >> 6), lane = tid & 63, wr = wid >> 2, wc = wid & 3, fr = lane & 15, fq = lane >> 4;
    const int K = g.K, nt = K / BK;
    unsigned voffA[2];
#pragma unroll
    for (int i = 0; i < 2; ++i) { int R, C; stage_rc(tid * 16 + i * 8192, R, C); voffA[i] = (unsigned)(R * K + C) * 2u; }
    const size_t kstep = (size_t)(BK * 2);
    const size_t hstep = (size_t)HALF * K * 2;
    const size_t tstep = 2 * hstep;
    const unsigned ldsw = (unsigned)wid * 1024u;
    const int aoff = lds_byte(wr * 64 + fr, fq * 8), boff = lds_byte(wc * 32 + fr, fq * 8);
#define PG8_SA(b, h) (((b) * 2 + (h)) * HTB)
#define PG8_SB(b, h) ((4 + (b) * 2 + (h)) * HTB)
#define PG8_STAGE(bufoff, gbase) do { _Pragma("unroll") for (int _i = 0; _i < 2; ++_i) \
        __builtin_amdgcn_global_load_lds((const unsigned*)((const char*)(gbase) + voffA[_i]), (LAS unsigned*)(lds + (bufoff) + ldsw + _i * 8192), 16, 0, 0); } while (0)
#define PG8_LDA(dst, b, h) do { _Pragma("unroll") for (int m = 0; m < 4; ++m) _Pragma("unroll") for (int k = 0; k < 2; ++k) dst[m][k] = *(const LAS bf16x8*)(lds + PG8_SA(b, h) + aoff + m * 2048 + k * 1024); } while (0)
#define PG8_LDB(dst, b, h) do { _Pragma("unroll") for (int n = 0; n < 2; ++n) _Pragma("unroll") for (int k = 0; k < 2; ++k) dst[n][k] = *(const LAS bf16x8*)(lds + PG8_SB(b, h) + boff + n * 2048 + k * 1024); } while (0)
#define PG8_MMA(ai, bj, At, Bt) do { __builtin_amdgcn_s_setprio(1); _Pragma("unroll") for (int m = 0; m < 4; ++m) _Pragma("unroll") for (int n = 0; n < 2; ++n) _Pragma("unroll") for (int k = 0; k < 2; ++k) \
        acc[ai][bj][m][n] = __builtin_amdgcn_mfma_f32_16x16x32_bf16(Bt[n][k], At[m][k], acc[ai][bj][m][n], 0, 0, 0); __builtin_amdgcn_s_setprio(0); } while (0)
#define PG8_WAIT_V(n) asm volatile("s_waitcnt vmcnt(" #n ")" ::: "memory")
#define PG8_WAIT_L(n) asm volatile("s_waitcnt lgkmcnt(" #n ")" ::: "memory")
#define PG8_BAR __builtin_amdgcn_s_barrier()
#define PG8_SCHED __builtin_amdgcn_sched_barrier(0)
    Unit cur, nxt; int ui = 0;
    if (!S.next(0, cur)) return;
    f32x4 acc[2][2][4][2];
#pragma unroll
    for (int a = 0; a < 2; ++a)
#pragma unroll
        for (int b = 0; b < 2; ++b)
#pragma unroll
            for (int m = 0; m < 4; ++m)
#pragma unroll
                for (int n = 0; n < 2; ++n) acc[a][b][m][n] = (f32x4){0.f, 0.f, 0.f, 0.f};
    bf16x8 At[4][2], B0[2][2], B1[2][2];
    const char* cA = (const char*)g.A + (size_t)cur.pm * tstep; const char* cB = (const char*)g.Bt + (size_t)cur.pn * tstep;
    PG8_STAGE(PG8_SB(0, 0), cB); PG8_STAGE(PG8_SA(0, 0), cA); PG8_STAGE(PG8_SB(0, 1), cB + hstep); PG8_STAGE(PG8_SA(0, 1), cA + hstep);
    if (wr == 1) PG8_BAR;
    PG8_WAIT_V(4); PG8_BAR;
    PG8_STAGE(PG8_SB(1, 0), cB + kstep); PG8_STAGE(PG8_SA(1, 0), cA + kstep); PG8_STAGE(PG8_SB(1, 1), cB + hstep + kstep);
    PG8_WAIT_V(6); PG8_BAR;
    for (;;) {
        const bool has_next = S.next(ui + 1, nxt);
        const char* nA = has_next ? (const char*)g.A + (size_t)nxt.pm * tstep : cA; const char* nB = has_next ? (const char*)g.Bt + (size_t)nxt.pn * tstep : cB;
        for (int t = 0; t < nt; t += 2) {
            const bool last = (t == nt - 2);
            const char* a1 = cA + (size_t)(t + 1) * kstep;
            const char* a2 = last ? nA : cA + (size_t)(t + 2) * kstep; const char* b2 = last ? nB : cB + (size_t)(t + 2) * kstep;
            const char* a3 = a2 + kstep; const char* b3 = b2 + kstep;
            PG8_LDB(B0, 0, 0); PG8_SCHED; PG8_LDA(At, 0, 0); PG8_STAGE(PG8_SA(1, 1), a1 + hstep);
            PG8_WAIT_L(8); PG8_BAR; PG8_WAIT_L(0); PG8_MMA(0, 0, At, B0); PG8_BAR; PG8_SCHED;
            PG8_LDB(B1, 0, 1); PG8_STAGE(PG8_SB(0, 0), b2);
            PG8_BAR; PG8_WAIT_L(0); PG8_MMA(0, 1, At, B1); PG8_BAR;
            PG8_LDA(At, 0, 1); PG8_STAGE(PG8_SA(0, 0), a2);
            PG8_BAR; PG8_WAIT_L(0); PG8_MMA(1, 0, At, B0); PG8_BAR; PG8_SCHED;
            PG8_STAGE(PG8_SB(0, 1), b2 + hstep);
            PG8_WAIT_V(6); PG8_BAR; PG8_MMA(1, 1, At, B1); PG8_BAR;
            PG8_LDB(B0, 1, 0); PG8_SCHED; PG8_LDA(At, 1, 0); PG8_STAGE(PG8_SA(0, 1), a2 + hstep);
            PG8_WAIT_L(8); PG8_BAR; PG8_WAIT_L(0); PG8_MMA(0, 0, At, B0); PG8_BAR; PG8_SCHED;
            PG8_LDB(B1, 1, 1); PG8_STAGE(PG8_SB(1, 0), b3);
            PG8_BAR; PG8_WAIT_L(0); PG8_MMA(0, 1, At, B1); PG8_BAR;
            PG8_LDA(At, 1, 1); PG8_STAGE(PG8_SA(1, 0), a3);
            PG8_BAR; PG8_WAIT_L(0); PG8_MMA(1, 0, At, B0); PG8_BAR; PG8_SCHED;
            PG8_STAGE(PG8_SB(1, 1), b3 + hstep);
            PG8_WAIT_V(6); PG8_BAR; PG8_MMA(1, 1, At, B1); PG8_BAR;
        }
        E(acc, cur, wr, wc, fr, fq);
        if (!has_next) break;
#pragma unroll
        for (int a = 0; a < 2; ++a)
#pragma unroll
            for (int b = 0; b < 2; ++b)
#pragma unroll
                for (int m = 0; m < 4; ++m)
#pragma unroll
                    for (int n = 0; n < 2; ++n) acc[a][b][m][n] = (f32x4){0.f, 0.f, 0.f, 0.f};
        cur = nxt; cA = nA; cB = nB; ++ui;
    }
    PG8_WAIT_V(0);
    if (wr == 0) PG8_BAR;
    PG8_BAR;
#undef PG8_SA
#undef PG8_SB
#undef PG8_STAGE
#undef PG8_LDA
#undef PG8_LDB
#undef PG8_MMA
#undef PG8_WAIT_V
#undef PG8_WAIT_L
#undef PG8_BAR
#undef PG8_SCHED
}
}

struct EpiGdnIn {
    bf16_t* proj; float* conv_p; float* conv_s;
    DI void operator()(const f32x4 (&acc)[2][2][4][2], const pg8::Unit& u, int wr, int wc, int fr, int fq) const {
        const int row0 = u.pm * 256 + wr * 64 + fr, col0 = u.pn * 256 + wc * 32 + 4 * fq;
#pragma unroll
        for (int ai = 0; ai < 2; ++ai)
#pragma unroll
            for (int m = 0; m < 4; ++m) {
                const int r = row0 + ai * 128 + m * 16;
                bf16_t* rowp = proj + (size_t)r * NPROJ + col0;
                bool tail; float* cp;
                if (r < MP) { const int t = r & (TP - 1), b = r >> 13; tail = t >= TP - 3; cp = conv_p + (size_t)(b * 3 + (t - (TP - 3))) * 3072; }
                else { const int rs = r - MP, t = rs & 15, b = rs >> 4; tail = t >= TS - 3; cp = conv_s + (size_t)(b * 3 + (t - (TS - 3))) * 3072; }
#pragma unroll
                for (int bj = 0; bj < 2; ++bj)
#pragma unroll
                    for (int n = 0; n < 2; ++n) {
                        const f32x4 v = acc[ai][bj][m][n];
                        u32x2 w; w.x = pk2(v[0], v[1]); w.y = pk2(v[2], v[3]);
                        *(u32x2*)(rowp + bj * 128 + n * 16) = w;
                        const int c = col0 + bj * 128 + n * 16;
                        if (tail && c < 3072) *(f32x4*)(cp + c) = v;
                    }
            }
    }
};

struct EpiDiffIn {
    bf16_t* proj; float* k_p; float* v_p; float* k_s; float* v_s; bf16_t* ks; bf16_t* vs; bf16_t* kh; bf16_t* vh; const float* rope;
    DI void operator()(const f32x4 (&acc)[2][2][4][2], const pg8::Unit& u, int wr, int wc, int fr, int fq) const {
        const int part = u.pn >> 2;
        const int row0 = u.pm * 256 + wr * 64 + fr;
        const int d0 = 16 * (wc & 1) + 4 * fq;
        const int cbase = u.pn * 256 + 64 * (wc >> 1) + d0;
#pragma unroll
        for (int ai = 0; ai < 2; ++ai)
#pragma unroll
            for (int m = 0; m < 4; ++m) {
                const int r = row0 + ai * 128 + m * 16;
                const int rs = r - MP;
                const int pidx = (r < MP) ? (r & (TP - 1)) : (TP + (rs & 15));
                f32x4 cs = {1.f, 1.f, 1.f, 1.f}, sn = {0.f, 0.f, 0.f, 0.f};
                if (part < 2) { cs = *(const f32x4*)(rope + (size_t)pidx * 64 + d0); sn = *(const f32x4*)(rope + (size_t)pidx * 64 + 32 + d0); }
#pragma unroll
                for (int bj = 0; bj < 2; ++bj) {
                    const f32x4 x1 = acc[ai][bj][m][0], x2 = acc[ai][bj][m][1];
                    f32x4 y1 = x1 * cs - x2 * sn, y2 = x2 * cs + x1 * sn;
                    const int col = cbase + bj * 128;
                    bf16_t* pp = proj + (size_t)r * NPROJ + col;
                    if (part == 0) { y1 *= QSCALE; y2 *= QSCALE; }
                    u32x2 w1, w2; w1.x = pk2(y1[0], y1[1]); w1.y = pk2(y1[2], y1[3]); w2.x = pk2(y2[0], y2[1]); w2.y = pk2(y2[2], y2[3]);
                    if (part == 0 || part == 3) { *(u32x2*)pp = w1; *(u32x2*)(pp + 32) = w2; }
                    if (part == 1 || part == 2) {
                        const int cc = col - part * 1024;
                        const int hh = cc >> 7, dd = cc & 127;
                        float* op; bf16_t* sp;
                        if (r < MP) { op = (part == 1 ? k_p : v_p) + (size_t)r * 1024 + cc;
                               sp = (part == 1 ? kh : vh) + ((size_t)((r >> 13) * 8 + hh) * TP + (r & (TP - 1))) * 128 + dd; }
                        else { op = (part == 1 ? k_s : v_s) + (size_t)rs * 1024 + cc;
                               sp = (part == 1 ? ks : vs) + ((size_t)((rs >> 4) * 8 + hh) * KSROWS + PAST + (rs & 15)) * 128 + dd; }
                        *(f32x4*)op = y1; *(f32x4*)(op + 32) = y2;
                        *(u32x2*)sp = w1; *(u32x2*)(sp + 32) = w2;
                    }
                }
            }
    }
};

struct EpiOut {
    bf16_t* C;
    DI void operator()(const f32x4 (&acc)[2][2][4][2], const pg8::Unit& u, int wr, int wc, int fr, int fq) const {
        const int row0 = u.pm * 256 + wr * 64 + fr, col0 = u.pn * 256 + wc * 32 + 4 * fq;
#pragma unroll
        for (int ai = 0; ai < 2; ++ai)
#pragma unroll
            for (int m = 0; m < 4; ++m) {
                bf16_t* rowp = C + (size_t)(row0 + ai * 128 + m * 16) * 1024 + col0;
#pragma unroll
                for (int bj = 0; bj < 2; ++bj)
#pragma unroll
                    for (int n = 0; n < 2; ++n) { const f32x4 v = acc[ai][bj][m][n]; u32x2 w; w.x = pk2(v[0], v[1]); w.y = pk2(v[2], v[3]); *(u32x2*)(rowp + bj * 128 + n * 16) = w; }
            }
    }
};

DI void transpose_tile(const float* W, int ldw, int n0, int k0, bf16_t* WT, bool perm, LAS float* tile) {
    int tid_ = threadIdx.x; asm volatile("" : "+v"(tid_)); const int tid = tid_;
    {
        const int kk = tid >> 4, c4 = (tid & 15) * 4;
#pragma unroll
        for (int p = 0; p < 2; ++p) {
            const f32x4 v = *(const f32x4*)(W + (size_t)(k0 + kk + 32 * p) * ldw + n0 + c4);
            LAS float* t = tile + (kk + 32 * p) * 65 + c4;
            t[0] = v[0]; t[1] = v[1]; t[2] = v[2]; t[3] = v[3];
        }
    }
    __syncthreads();
    {
        const int n = tid >> 3, ks = (tid & 7) * 8;
        const int src = perm ? perm64(n) : n;
        float v[8];
#pragma unroll
        for (int e = 0; e < 8; ++e) v[e] = tile[(ks + e) * 65 + src];
        u32x4 w; w.x = pk2(v[0], v[1]); w.y = pk2(v[2], v[3]); w.z = pk2(v[4], v[5]); w.w = pk2(v[6], v[7]);
        *(u32x4*)(WT + (size_t)(n0 + n) * 1024 + k0 + ks) = w;
    }
    __syncthreads();
}

DI void phase_prep(const Params& P, LAS unsigned char* lds) {
    int tid_ = threadIdx.x; asm volatile("" : "+v"(tid_)); const int tid = tid_, G = gridDim.x;
    unsigned char* ws = P.ws;
    for (int id = blockIdx.x; id < 5120; id += G) {
        const int j = id / 2560; int rem = id % 2560;
        const float* W; int ldw; bf16_t* WT; bool perm = false; int t;
        if (rem < 1024) { W = P.in[12] + (size_t)j * 1024 * 4112; ldw = 4112; WT = (bf16_t*)(ws + WS_WING) + (size_t)j * 4096 * 1024; t = rem; }
        else if (rem < 1280) { W = P.in[17] + (size_t)j * 1024 * 1024; ldw = 1024; WT = (bf16_t*)(ws + WS_WOUTG) + (size_t)j * 1024 * 1024; t = rem - 1024; }
        else if (rem < 2304) { W = P.in[18] + (size_t)j * 1024 * 4096; ldw = 4096; WT = (bf16_t*)(ws + WS_WIND) + (size_t)j * 4096 * 1024; t = rem - 1280; perm = true; }
        else { W = P.in[24] + (size_t)j * 1024 * 1024; ldw = 1024; WT = (bf16_t*)(ws + WS_WOUTD) + (size_t)j * 1024 * 1024; t = rem - 2304; }
        transpose_tile(W, ldw, (t >> 4) * 64, (t & 15) * 64, WT, perm, (LAS float*)lds);
    }
    for (int idx = blockIdx.x * 512 + tid; idx < 8208 * 32; idx += G * 512) {
        const int pi = idx >> 5, d = idx & 31;
        const int pos = pi < TP ? pi : PAST + (pi - TP);
        const float inv = 1.0f / powf(10000.0f, (float)d / 32.0f);
        const float ang = (float)pos * inv;
        const double rev = (double)ang * 0.15915494309189535;
        const double fr = rev - floor(rev);
        float* rp = (float*)(ws + WS_ROPE) + (size_t)pi * 64;
        rp[d] = __builtin_amdgcn_cosf((float)fr);
        rp[32 + d] = __builtin_amdgcn_sinf((float)fr);
    }
    {
        LAS float* cact = (LAS float*)lds;
        LAS float* red = (LAS float*)(lds + 81920);
        bool loaded = false;
        for (int id = (G - 1 - blockIdx.x); id < 192; id += G) {
            if (!loaded) {
                for (int e = tid; e < NB * 1024; e += 512) {
                    const int b = e >> 10, k = e & 1023;
                    const float c = b < BP ? P.in[2][b * 1024 + k] : P.in[3][(b - BP) * 1024 + k];
                    cact[e] = siluf(c);
                }
                loaded = true;
            }
            __syncthreads();
            const int i = id / 48, cb = id % 48;
            const int col = tid & 63, kg = tid >> 6;
            const float* Wp = P.in[10] + (size_t)i * 1024 * 3072 + cb * 64 + col;
            float acc[NB];
#pragma unroll
            for (int b = 0; b < NB; ++b) acc[b] = 0.f;
            for (int k = kg * 128; k < kg * 128 + 128; k += 4) {
                const float w0 = Wp[(size_t)k * 3072], w1 = Wp[(size_t)(k + 1) * 3072], w2 = Wp[(size_t)(k + 2) * 3072], w3 = Wp[(size_t)(k + 3) * 3072];
#pragma unroll
                for (int b = 0; b < NB; ++b) {
                    const f32x4 c4 = *(const LAS f32x4*)(cact + b * 1024 + k);
                    acc[b] += c4[0] * w0 + c4[1] * w1 + c4[2] * w2 + c4[3] * w3;
                }
            }
#pragma unroll
            for (int b = 0; b < NB; ++b) red[(kg * NB + b) * 64 + col] = acc[b];
            __syncthreads();
            for (int o = tid; o < NB * 64; o += 512) {
                const int b = o >> 6, c = o & 63;
                float s = P.in[11][i * 3072 + cb * 64 + c];
#pragma unroll
                for (int g = 0; g < 8; ++g) s += red[(g * NB + b) * 64 + c];
                ((float*)(ws + WS_ADA))[((size_t)i * NB + b) * 3072 + cb * 64 + c] = s;
            }
        }
        __syncthreads();
    }
}

DI void phase_elem(const Params& P, LAS unsigned char* lds, int layer) {
    int tid_ = threadIdx.x; asm volatile("" : "+v"(tid_)); const int tid = tid_, wid = __builtin_amdgcn_readfirstlane(tid >> 6), lane = tid & 63, G = gridDim.x;
    unsigned char* ws = P.ws;
    const int j = layer >> 1;
    const bool gdn = (layer < 4) && !(layer & 1);
    LAS float* wab = (LAS float*)lds;
    if (gdn) {
        const float* Wp = P.in[12] + (size_t)j * 1024 * 4112 + 4096;
        for (int e = tid; e < 16384; e += 512) { const int k = e >> 4, c = e & 15; wab[c * 1024 + k] = Wp[(size_t)k * 4112 + c]; }
        __syncthreads();
    }
    const float* ada = (const float*)(ws + WS_ADA);
    float* X = P.out;
    const bf16_t* OUTB = (const bf16_t*)(ws + WS_PROJ);
    bf16_t* HB = (bf16_t*)(ws + WS_HBUF);
    float* AB = (float*)(ws + WS_AB);
    for (int r = blockIdx.x * 8 + wid; r < M; r += G * 8) {
        const int b = r < MP ? (r >> 13) : BP + ((r - MP) >> 4);
        const float* xs = (layer <= 1) ? (r < MP ? P.in[0] + (size_t)r * 1024 : P.in[1] + (size_t)(r - MP) * 1024) : X + (size_t)r * 1024;
        f32x4 x[4];
#pragma unroll
        for (int q = 0; q < 4; ++q) x[q] = *(const f32x4*)(xs + 4 * (lane + 64 * q));
        if (layer >= 1) {
            f32x4 o[4]; float ss = 0.f;
#pragma unroll
            for (int q = 0; q < 4; ++q) { const u32x2 ow = *(const u32x2*)(OUTB + (size_t)r * 1024 + 4 * (lane + 64 * q));
                o[q] = (f32x4){__uint_as_float(ow.x << 16), __uint_as_float(ow.x & 0xffff0000u), __uint_as_float(ow.y << 16), __uint_as_float(ow.y & 0xffff0000u)};
                ss += o[q][0] * o[q][0] + o[q][1] * o[q][1] + o[q][2] * o[q][2] + o[q][3] * o[q][3]; }
            ss = wave_sum(ss);
            const float rstd = __builtin_amdgcn_rsqf(ss * (1.f / 1024.f) + RMS_EPS);
            const float* gp = ada + ((size_t)(layer - 1) * NB + b) * 3072 + 2048;
            const float* np = P.in[9] + (layer - 1) * 1024;
#pragma unroll
            for (int q = 0; q < 4; ++q) {
                const int d = 4 * (lane + 64 * q);
                const f32x4 gt = *(const f32x4*)(gp + d), nw = *(const f32x4*)(np + d);
                x[q] = x[q] + gt * (o[q] * rstd * nw);
                *(f32x4*)(X + (size_t)r * 1024 + d) = x[q];
            }
        }
        if (layer < 4) {
            float ss = 0.f;
#pragma unroll
            for (int q = 0; q < 4; ++q) ss += x[q][0] * x[q][0] + x[q][1] * x[q][1] + x[q][2] * x[q][2] + x[q][3] * x[q][3];
            ss = wave_sum(ss);
            const float rstd = __builtin_amdgcn_rsqf(ss * (1.f / 1024.f) + RMS_EPS);
            const float* ap = ada + ((size_t)layer * NB + b) * 3072;
            const float* np = P.in[8] + layer * 1024;
            f32x4 hv[4];
#pragma unroll
            for (int q = 0; q < 4; ++q) {
                const int d = 4 * (lane + 64 * q);
                const f32x4 sh = *(const f32x4*)(ap + d), sc = *(const f32x4*)(ap + 1024 + d), nw = *(const f32x4*)(np + d);
                hv[q] = (x[q] * rstd * nw) * (1.f + sc) + sh;
                u32x2 w; w.x = pk2(hv[q][0], hv[q][1]); w.y = pk2(hv[q][2], hv[q][3]);
                *(u32x2*)(HB + (size_t)r * 1024 + d) = w;
            }
            if (gdn) {
                float mine = 0.f;
#pragma unroll
                for (int c = 0; c < 16; ++c) {
                    float a = 0.f;
#pragma unroll
                    for (int q = 0; q < 4; ++q) { const f32x4 w4 = *(const LAS f32x4*)(wab + c * 1024 + 4 * (lane + 64 * q)); a += hv[q][0] * w4[0] + hv[q][1] * w4[1] + hv[q][2] * w4[2] + hv[q][3] * w4[3]; }
                    a = row_sum16(a);
                    if ((lane & 15) == c) mine = a;
                }
                mine += __shfl_xor(mine, 16); mine += __shfl_xor(mine, 32);
                if (lane < 16) AB[(size_t)r * 16 + lane] = mine;
            }
        }
    }
    if (layer < 4 && (layer & 1)) {
        const float* ck = P.in[6] + (size_t)j * 16 * PAST * 1024;
        const float* cv = P.in[7] + (size_t)j * 16 * PAST * 1024;
        bf16_t* KS = (bf16_t*)(ws + WS_KS); bf16_t* VS = (bf16_t*)(ws + WS_VS);
        const size_t nun = (size_t)16 * PAST * 128;
        for (size_t u = (size_t)blockIdx.x * 512 + tid; u < 2 * nun; u += (size_t)G * 512) {
            const bool isv = u >= nun; const size_t uu = isv ? u - nun : u;
            const size_t b = uu / ((size_t)PAST * 128), rem = uu % ((size_t)PAST * 128);
            const size_t row = rem >> 7, c8 = rem & 127, hh = c8 >> 4, d8 = c8 & 15;
            const float* sp = (isv ? cv : ck) + uu * 8;
            const f32x4 a = *(const f32x4*)sp, c = *(const f32x4*)(sp + 4);
            u32x4 w; w.x = pk2(a[0], a[1]); w.y = pk2(a[2], a[3]); w.z = pk2(c[0], c[1]); w.w = pk2(c[2], c[3]);
            *(u32x4*)((isv ? VS : KS) + ((b * 8 + hh) * KSROWS + row) * 128 + d8 * 8) = w;
        }
        const size_t npad = (size_t)128 * 48 * 16;
        for (size_t u = (size_t)blockIdx.x * 512 + tid; u < 2 * npad; u += (size_t)G * 512) {
            const bool isv = u >= npad; const size_t uu = isv ? u - npad : u;
            const size_t sq = uu / (48 * 16), rem = uu % (48 * 16);
            *(u32x4*)((isv ? VS : KS) + (sq * KSROWS + PAST + TS) * 128 + rem * 8) = (u32x4){0u, 0u, 0u, 0u};
        }
    }
}

DI void phase_g1(const Params& P, LAS unsigned char* lds, int layer) {
    int tid_ = threadIdx.x; asm volatile("" : "+v"(tid_)); const int tid = tid_, wid = __builtin_amdgcn_readfirstlane(tid >> 6), lane = tid & 63, G = gridDim.x;
    const int fr = lane & 15, fq = lane >> 4;
    unsigned char* ws = P.ws;
    const int j = layer >> 1;
    const bf16_t* proj = (const bf16_t*)(ws + WS_PROJ);
    const float* AB = (const float*)(ws + WS_AB);
    float* GL = (float*)(ws + WS_GL);
    const float* convw = P.in[13] + (size_t)j * 4 * 3072;
    const float* cconv = P.in[5] + (size_t)j * 16 * 3 * 3072;
    LAS unsigned char* Qs = lds;
    LAS unsigned char* Ks = lds + 17408;
    LAS unsigned char* VBt = lds + 34816;
    LAS unsigned char* KBt = lds + 53248;
    LAS float* A32 = (LAS float*)(lds + 71680);
    LAS unsigned char* Ts = lds + 88320;
    LAS unsigned char* QKs = lds + 97536;
    LAS float* Gs = (LAS float*)(lds + 105728);

    for (int item = blockIdx.x; item < NITEM; item += G) {
        int b, h, c, row0, nvalid; bool sample;
        if (item < NITEM_P) { const int seq = item >> 7; b = seq >> 3; h = seq & 7; c = item & 127; row0 = b * TP + 64 * c; nvalid = 64; sample = false; }
        else { const int s = item - NITEM_P; b = s >> 3; h = s & 7; c = 0; row0 = MP + b * TS; nvalid = TS; sample = true; }
        unsigned char* ib = ws + WS_R1 + (size_t)item * ITEM_BYTES;
        float val[8][8];
        float rn[8];
        int tido = tid; asm volatile("" : "+v"(tido));
        const int l16 = tido & 15, grp = tido >> 4, part = grp >> 3, rb = grp & 7;
        const int lane = tido & 63, fr = lane & 15, fq = lane >> 4;
        if (tid < 384) {
            const int ch = part * 1024 + h * 128 + 8 * l16;
            float wv[4][8];
#pragma unroll
            for (int t = 0; t < 4; ++t) {
                const f32x4 a = *(const f32x4*)(convw + t * 3072 + ch), bb = *(const f32x4*)(convw + t * 3072 + ch + 4);
                wv[t][0] = a[0]; wv[t][1] = a[1]; wv[t][2] = a[2]; wv[t][3] = a[3]; wv[t][4] = bb[0]; wv[t][5] = bb[1]; wv[t][6] = bb[2]; wv[t][7] = bb[3];
            }
            float win[4][8];
#pragma unroll
            for (int t = 0; t < 4; ++t)
#pragma unroll
                for (int e = 0; e < 8; ++e) win[t][e] = 0.f;
#pragma unroll
            for (int k = 0; k < 11; ++k) {
                const int lr = 8 * rb - 3 + k;
                float in8[8];
                {
                    const bool use_proj = (lr >= 0 && lr < nvalid) || (lr < 0 && !sample && c > 0);
                    const int lrc = use_proj ? lr : 0;
                    const u32x4 v = *(const u32x4*)(proj + (size_t)(row0 + lrc) * NPROJ + ch);
                    unpack8(v, in8);
                    if (!use_proj) {
#pragma unroll
                        for (int e = 0; e < 8; ++e) in8[e] = 0.f;
                    }
                }
                if (k < 3) {
                    if (sample && lr < 0) {
                        const float* sp = cconv + (size_t)(b * 3 + (3 + lr)) * 3072 + ch;
                        const f32x4 a = *(const f32x4*)sp, bb = *(const f32x4*)(sp + 4);
                        in8[0] = a[0]; in8[1] = a[1]; in8[2] = a[2]; in8[3] = a[3]; in8[4] = bb[0]; in8[5] = bb[1]; in8[6] = bb[2]; in8[7] = bb[3];
                    }
                }
#pragma unroll
                for (int e = 0; e < 8; ++e) { win[0][e] = win[1][e]; win[1][e] = win[2][e]; win[2][e] = win[3][e]; win[3][e] = in8[e]; }
                if (k >= 3) {
                    const bool rv = (lr < nvalid);
                    float ss = 0.f;
#pragma unroll
                    for (int e = 0; e < 8; ++e) {
                        const float y = win[0][e] * wv[0][e] + win[1][e] * wv[1][e] + win[2][e] * wv[2][e] + win[3][e] * wv[3][e];
                        const float s = rv ? siluf(y) : 0.f;
                        val[k - 3][e] = s; ss += s * s;
                    }
                    ss = row_sum16(ss);
                    rn[k - 3] = __builtin_amdgcn_rsqf(ss + 1e-6f);
                }
            }
        } else if (wid == 7) {
            const int r = row0 + (lane < nvalid ? lane : 0);
            const bool valid = lane < nvalid;
            const float a = AB[(size_t)r * 16 + h], bb = AB[(size_t)r * 16 + 8 + h];
            const float xa = a + P.in[15][j * 8 + h];
            const float ey = __expf(-fabsf(xa));
            const float lp = (ey < 0.01f) ? ey * (1.f - ey * (0.5f - ey * 0.33333334f)) : __logf(1.f + ey);
            const float sp = fmaxf(xa, 0.f) + lp;
            float g = valid ? -__expf(P.in[14][j * 8 + h]) * sp : 0.f;
            const float beta = valid ? __builtin_amdgcn_rcpf(1.f + __expf(-bb)) : 0.f;
#pragma unroll
            for (int o = 1; o < 64; o <<= 1) { const float t = __shfl_up(g, o); if (lane >= o) g += t; }
            const float glast = readlane_f(g, 63);
            Gs[lane] = g; Gs[64 + lane] = beta; Gs[128 + lane] = __expf(g); Gs[192 + lane] = __expf(glast - g);
            if (lane == 0) GL[item] = __expf(glast);
        }
        __syncthreads();
        if (tid < 384) {
#pragma unroll
            for (int rr = 0; rr < 8; ++rr) {
                const int row = 8 * rb + rr;
                const float beta = Gs[64 + row], eG = Gs[128 + row];
                if (part == 0) {
                    const float sc = rn[rr] * 0.08838834764831845f;
                    float q[8];
#pragma unroll
                    for (int e = 0; e < 8; ++e) q[e] = val[rr][e] * sc;
                    u32x4 w; w.x = pk2(q[0], q[1]); w.y = pk2(q[2], q[3]); w.z = pk2(q[4], q[5]); w.w = pk2(q[6], q[7]);
                    *(LAS u32x4*)(Qs + row * 272 + l16 * 16) = w;
                    bf16_t* qg = (bf16_t*)(ib + 49152) + row * 128;
                    u32x2 g0, g1; g0.x = pk2(q[0] * eG, q[1] * eG); g0.y = pk2(q[2] * eG, q[3] * eG); g1.x = pk2(q[4] * eG, q[5] * eG); g1.y = pk2(q[6] * eG, q[7] * eG);
                    *(u32x2*)(qg + ppos(8 * l16)) = g0; *(u32x2*)(qg + ppos(8 * l16 + 4)) = g1;
                    val[rr][0] = 0.f;
                } else if (part == 1) {
#pragma unroll
                    for (int e = 0; e < 8; ++e) val[rr][e] *= rn[rr];
                    u32x4 w; w.x = pk2(val[rr][0], val[rr][1]); w.y = pk2(val[rr][2], val[rr][3]); w.z = pk2(val[rr][4], val[rr][5]); w.w = pk2(val[rr][6], val[rr][7]);
                    *(LAS u32x4*)(Ks + row * 272 + l16 * 16) = w;
                }
            }
            if (part >= 1) {
                float bsc[8], ksc[8];
#pragma unroll
                for (int rr = 0; rr < 8; ++rr) { const int row = 8 * rb + rr; const float beta = Gs[64 + row]; bsc[rr] = (part == 1) ? beta * Gs[128 + row] : beta; ksc[rr] = Gs[192 + row]; }
                LAS unsigned char* Tt = (part == 1) ? KBt : VBt;
#pragma unroll
                for (int e = 0; e < 8; ++e) {
                    const int dch = 8 * l16 + e;
                    u32x4 w; w.x = pk2(val[0][e] * bsc[0], val[1][e] * bsc[1]); w.y = pk2(val[2][e] * bsc[2], val[3][e] * bsc[3]);
                    w.z = pk2(val[4][e] * bsc[4], val[5][e] * bsc[5]); w.w = pk2(val[6][e] * bsc[6], val[7][e] * bsc[7]);
                    *(LAS u32x4*)(Tt + dch * 144 + rb * 16) = w;
                    if (part == 1) {
                        bf16_t* kd = (bf16_t*)(ib + 65536) + dch * 64;
                        u32x2 k0, k1; k0.x = pk2(val[0][e] * ksc[0], val[1][e] * ksc[1]); k0.y = pk2(val[2][e] * ksc[2], val[3][e] * ksc[3]);
                        k1.x = pk2(val[4][e] * ksc[4], val[5][e] * ksc[5]); k1.y = pk2(val[6][e] * ksc[6], val[7][e] * ksc[7]);
                        *(u32x2*)(kd + ppos(8 * rb)) = k0; *(u32x2*)(kd + ppos(8 * rb + 4)) = k1;
                    }
                }
            }
        }
        __syncthreads();
        {
            const int mt = wid & 3; const bool isqk = wid >= 4;
            LAS unsigned char* As = isqk ? Qs : Ks;
            f32x4 acc[4];
#pragma unroll
            for (int nt = 0; nt < 4; ++nt) acc[nt] = (f32x4){0.f, 0.f, 0.f, 0.f};
#pragma unroll
            for (int ks = 0; ks < 4; ++ks) {
                const bf16x8 a = *(const LAS bf16x8*)(As + (16 * mt + fr) * 272 + (32 * ks + 8 * fq) * 2);
#pragma unroll
                for (int nt = 0; nt < 4; ++nt) {
                    const bf16x8 bfr = *(const LAS bf16x8*)(Ks + (16 * nt + fr) * 272 + (32 * ks + 8 * fq) * 2);
                    acc[nt] = MFMA16(a, bfr, acc[nt]);
                }
            }
#pragma unroll
            for (int nt = 0; nt < 4; ++nt) {
                const int cp = 16 * nt + fr; const float Gc2 = Gs[cp];
#pragma unroll
                for (int i = 0; i < 4; ++i) {
                    const int cr = 16 * mt + 4 * fq + i;
                    const float dec = __expf(Gs[cr] - Gc2);
                    if (!isqk) A32[cr * 65 + cp] = (cr > cp) ? Gs[64 + cr] * acc[nt][i] * dec : 0.f;
                    else *(LAS bf16_t*)(QKs + (cr * 64 + ppos(cp)) * 2) = f2bf((cr >= cp) ? acc[nt][i] * dec : 0.f);
                }
            }
        }
        __syncthreads();
        {
            float a[64];
#pragma unroll
            for (int jj = 0; jj < 64; ++jj) a[jj] = A32[lane * 65 + jj];
            float x[8];
#pragma unroll
            for (int cc = 0; cc < 8; ++cc) x[cc] = (lane == 8 * wid + cc) ? 1.f : 0.f;
#pragma unroll
            for (int jj = 0; jj < 64; ++jj) {
                if (jj >= 8 * wid) {
#pragma unroll
                    for (int cc = 0; cc < 8; ++cc) { const float xj = readlane_f(x[cc], jj); x[cc] -= a[jj] * xj; }
                }
            }
            u32x4 w; w.x = pk2(x[0], x[1]); w.y = pk2(x[2], x[3]); w.z = pk2(x[4], x[5]); w.w = pk2(x[6], x[7]);
            *(LAS u32x4*)(Ts + lane * 144 + wid * 16) = w;
            *(u32x4*)(ib + 81920 + tid * 16) = *(const LAS u32x4*)(QKs + tid * 16);
        }
        __syncthreads();
        {
            const bool isw = wid >= 4; const int n0 = 32 * (wid & 3);
            LAS unsigned char* Bs = isw ? KBt : VBt;
            f32x4 acc[4][2];
#pragma unroll
            for (int mt = 0; mt < 4; ++mt) { acc[mt][0] = (f32x4){0.f, 0.f, 0.f, 0.f}; acc[mt][1] = (f32x4){0.f, 0.f, 0.f, 0.f}; }
#pragma unroll
            for (int ks = 0; ks < 2; ++ks) {
                bf16x8 bfr[2];
#pragma unroll
                for (int nn = 0; nn < 2; ++nn) bfr[nn] = *(const LAS bf16x8*)(Bs + (n0 + 16 * nn + fr) * 144 + (32 * ks + 8 * fq) * 2);
#pragma unroll
                for (int mt = 0; mt < 4; ++mt) {
                    const bf16x8 a = *(const LAS bf16x8*)(Ts + (16 * mt + fr) * 144 + (32 * ks + 8 * fq) * 2);
                    acc[mt][0] = MFMA16(a, bfr[0], acc[mt][0]); acc[mt][1] = MFMA16(a, bfr[1], acc[mt][1]);
                }
            }
            if (!isw) {
                float* U = (float*)ib;
#pragma unroll
                for (int mt = 0; mt < 4; ++mt)
#pragma unroll
                    for (int nn = 0; nn < 2; ++nn)
#pragma unroll
                        for (int i = 0; i < 4; ++i) U[(16 * mt + 4 * fq + i) * 128 + n0 + 16 * nn + fr] = acc[mt][nn][i];
            } else {
#pragma unroll
                for (int mt = 0; mt < 4; ++mt)
#pragma unroll
                    for (int nn = 0; nn < 2; ++nn)
#pragma unroll
                        for (int i = 0; i < 4; ++i) *(LAS bf16_t*)(Qs + ((16 * mt + 4 * fq + i) * 128 + ppos(n0 + 16 * nn + fr)) * 2) = f2bf(acc[mt][nn][i]);
            }
        }
        __syncthreads();
        {
            *(u32x4*)(ib + 32768 + tid * 16) = *(const LAS u32x4*)(Qs + tid * 16);
            *(u32x4*)(ib + 32768 + 8192 + tid * 16) = *(const LAS u32x4*)(Qs + 8192 + tid * 16);
        }
        __syncthreads();
    }
}

DI void phase_scan(const Params& P, LAS unsigned char* lds, int layer) {
    int tid_ = threadIdx.x; asm volatile("" : "+v"(tid_)); const int tid = tid_, wid = __builtin_amdgcn_readfirstlane(tid >> 6), lane = tid & 63, G = gridDim.x;
    const int fr = lane & 15, fq = lane >> 4;
    unsigned char* ws = P.ws;
    const int j = layer >> 1;
    const bf16_t* proj = (const bf16_t*)(ws + WS_PROJ);
    const float* GL = (const float*)(ws + WS_GL);
    bf16_t* OB = (bf16_t*)(ws + WS_HBUF);
    constexpr int BUFB = 57344;
    LAS float* red = (LAS float*)(lds + 2 * BUFB);

    for (int seq = blockIdx.x; seq < 160; seq += G) {
        int b, h, nch, item0, row0, nvalid; float* stout;
        f32x4 st[8];
        const int dvc = 16 * wid + fr;
        if (seq < 32) {
            b = seq >> 3; h = seq & 7; nch = 128; item0 = seq * 128; row0 = b * TP; nvalid = 64;
            stout = P.out + OFF_STP + ((size_t)(j * 4 + b) * 8 + h) * 16384;
#pragma unroll
            for (int mt = 0; mt < 8; ++mt) st[mt] = (f32x4){0.f, 0.f, 0.f, 0.f};
        } else {
            const int s = seq - 32; b = s >> 3; h = s & 7; nch = 1; item0 = NITEM_P + s; row0 = MP + b * TS; nvalid = TS;
            stout = P.out + OFF_STS + ((size_t)(j * 16 + b) * 8 + h) * 16384;
            const float* s0 = P.in[4] + ((size_t)(j * 16 + b) * 8 + h) * 16384;
            const unsigned s0o = (unsigned)(4 * fq * 128 + dvc);
#pragma unroll
            for (int mt = 0; mt < 8; ++mt)
#pragma unroll
                for (int i = 0; i < 4; ++i) st[mt][i] = s0[(unsigned)((16 * mt + i) * 128) + s0o];
        }
        const float onw = P.in[16][j * 128 + dvc];
        f32x4 un[4];
#define SCAN_G2L(itm, bufi, LN) do { const unsigned char* _ib = ws + WS_R1 + (size_t)(itm) * ITEM_BYTES + 32768; \
            _Pragma("unroll") for (int _p = 0; _p < 7; ++_p) { const int _L = (wid + 8 * _p) * 1024 + (LN) * 16; unsigned _src; \
                if (_p < 4) { const int _row = _L >> 8, _ch = (_L >> 4) & 15; _src = (_L & ~255) + ((_ch ^ (_row & 15)) << 4); } \
                else { const int _a = _L - 32768, _row = _a >> 7, _ch = (_a >> 4) & 7; _src = 32768 + (_a & ~127) + ((_ch ^ ((_row >> 1) & 7)) << 4); } \
                g2l16(_ib + _src, lds_u32(lds + (bufi) * BUFB + (wid + 8 * _p) * 1024)); } } while (0)
#define SCAN_LOADU(itm) do { const float* _u = (const float*)(ws + WS_R1 + (size_t)(itm) * ITEM_BYTES); const unsigned _uo = (unsigned)(4 * fq * 128 + 16 * wid + fr); \
            _Pragma("unroll") for (int _m = 0; _m < 4; ++_m) _Pragma("unroll") for (int _i = 0; _i < 4; ++_i) un[_m][_i] = _u[(unsigned)((16 * _m + _i) * 128) + _uo]; } while (0)
        __syncthreads();
        SCAN_G2L(item0, 0, lane);
        SCAN_LOADU(item0);
        float gln = GL[item0];
        asm volatile("s_waitcnt vmcnt(0)" ::: "memory");
        __syncthreads();
        for (int c = 0; c < nch; ++c) {
            int frq = lane; asm volatile("" : "+v"(frq));
            const int fr = frq & 15, fq = frq >> 4;
            LAS unsigned char* bb = lds + (c & 1) * BUFB;
            const float gl = gln;
            f32x4 u[4];
#pragma unroll
            for (int mt = 0; mt < 4; ++mt) u[mt] = un[mt];
            if (c + 1 < nch) { gln = GL[item0 + c + 1]; SCAN_G2L(item0 + c + 1, (c + 1) & 1, frq); }
            const int x16 = fr << 4, x8 = ((fr >> 1) & 7) << 4;
            bf16x8 sf[4];
#pragma unroll
            for (int ks = 0; ks < 4; ++ks) {
                u32x4 w; w.x = pk2(-st[2 * ks][0], -st[2 * ks][1]); w.y = pk2(-st[2 * ks][2], -st[2 * ks][3]); w.z = pk2(-st[2 * ks + 1][0], -st[2 * ks + 1][1]); w.w = pk2(-st[2 * ks + 1][2], -st[2 * ks + 1][3]);
                sf[ks] = __builtin_bit_cast(bf16x8, w);
            }
            bf16x8 fa[4], fb[4];
#define SC_LD256(dst, base, mt) do { _Pragma("unroll") for (int _k = 0; _k < 4; ++_k) \
                dst[_k] = *(const LAS bf16x8*)(bb + (base) + (16 * (mt) + fr) * 256 + ((((4 * _k + fq) << 4)) ^ x16)); } while (0)
#define SC_LD128(dst, base, mtlo) do { _Pragma("unroll") for (int _m = 0; _m < 2; ++_m) _Pragma("unroll") for (int _k = 0; _k < 2; ++_k) \
                dst[_m * 2 + _k] = *(const LAS bf16x8*)(bb + (base) + (16 * ((mtlo) + _m) + fr) * 128 + ((((4 * _k + fq) << 4)) ^ x8)); } while (0)
#define SC_SB __builtin_amdgcn_sched_barrier(0)
#define SC_MU(f, mt) do { _Pragma("unroll") for (int _k = 0; _k < 4; ++_k) u[mt] = MFMA16(f[_k], sf[_k], u[mt]); } while (0)
#define SC_MO(f, mt) do { _Pragma("unroll") for (int _k = 0; _k < 4; ++_k) o[mt] = MFMA16(f[_k], sf[_k], o[mt]); } while (0)
#define SC_MQK(f, mtlo) do { _Pragma("unroll") for (int _m = 0; _m < 2; ++_m) _Pragma("unroll") for (int _k = 0; _k < 2; ++_k) o[(mtlo) + _m] = MFMA16(f[_m * 2 + _k], uf[_k], o[(mtlo) + _m]); } while (0)
#define SC_MKD(f, mtlo) do { _Pragma("unroll") for (int _m = 0; _m < 2; ++_m) { st[(mtlo) + _m] = st[(mtlo) + _m] * gl; _Pragma("unroll") for (int _k = 0; _k < 2; ++_k) st[(mtlo) + _m] = MFMA16(f[_m * 2 + _k], uf[_k], st[(mtlo) + _m]); } } while (0)
            f32x4 o[4];
#pragma unroll
            for (int mt = 0; mt < 4; ++mt) o[mt] = (f32x4){0.f, 0.f, 0.f, 0.f};
            SC_LD256(fa, 0, 0); SC_LD256(fb, 0, 1); SC_SB;
            SC_MU(fa, 0); SC_LD256(fa, 0, 2); SC_SB;
            SC_MU(fb, 1); SC_LD256(fb, 0, 3); SC_SB;
            SC_MU(fa, 2); SC_LD256(fa, 16384, 0); SC_SB;
            SC_MU(fb, 3); SC_LD256(fb, 16384, 1); SC_SB;
#pragma unroll
            for (int ks = 0; ks < 4; ++ks) sf[ks] = sf[ks] ^ (short)0x8000;
            SC_MO(fa, 0); SC_LD256(fa, 16384, 2); SC_SB;
            SC_MO(fb, 1); SC_LD256(fb, 16384, 3); SC_SB;
            SC_MO(fa, 2); SC_LD128(fa, 49152, 0); SC_SB;
            SC_MO(fb, 3); SC_LD128(fb, 49152, 2); SC_SB;
            bf16x8 uf[2];
#pragma unroll
            for (int k2 = 0; k2 < 2; ++k2) {
                u32x4 w; w.x = pk2(u[2 * k2][0], u[2 * k2][1]); w.y = pk2(u[2 * k2][2], u[2 * k2][3]); w.z = pk2(u[2 * k2 + 1][0], u[2 * k2 + 1][1]); w.w = pk2(u[2 * k2 + 1][2], u[2 * k2 + 1][3]);
                uf[k2] = __builtin_bit_cast(bf16x8, w);
            }
            SC_MQK(fa, 0); SC_LD128(fa, 32768, 0); SC_SB;
            SC_MQK(fb, 2); SC_LD128(fb, 32768, 2); SC_SB;
            SC_MKD(fa, 0); SC_LD128(fa, 32768, 4); SC_SB;
            SC_MKD(fb, 2); SC_LD128(fb, 32768, 6); SC_SB;
            SC_MKD(fa, 4); SC_SB;
            SC_MKD(fb, 6);
#undef SC_MU
#undef SC_MO
#undef SC_MQK
#undef SC_MKD
#undef SC_LD256
#undef SC_LD128
#undef SC_SB
            if (c + 1 < nch) SCAN_LOADU(item0 + c + 1);
            unsigned short zr[4][4];
            {
                const bf16_t* zb = proj + (size_t)(row0 + 64 * c) * NPROJ + 3072 + h * 128;
                const unsigned zo = (unsigned)(4 * fq * NPROJ + 16 * wid + fr);
                const int msk = (nvalid == 64) ? 63 : 15;
#pragma unroll
                for (int mt = 0; mt < 4; ++mt)
#pragma unroll
                    for (int i = 0; i < 4; ++i) zr[mt][i] = zb[(unsigned)((((16 * mt) & msk) + i) * NPROJ) + zo];
            }
            LAS float* rd = red + (c & 1) * 512;
            {
                float sel = 0.f;
#pragma unroll
                for (int mt = 0; mt < 4; ++mt)
#pragma unroll
                    for (int i = 0; i < 4; ++i) { const float ss = row_sum16(o[mt][i] * o[mt][i]); if (fr == 4 * mt + i) sel = ss; }
                rd[(16 * (fr >> 2) + 4 * fq + (fr & 3)) * 8 + wid] = sel;
            }
            asm volatile("s_waitcnt vmcnt(0)" ::: "memory");
            __syncthreads();
            {
                const int myrow = 16 * (fr >> 2) + 4 * fq + (fr & 3);
                const f32x4 p0 = *(const LAS f32x4*)(rd + myrow * 8), p1 = *(const LAS f32x4*)(rd + myrow * 8 + 4);
                const float tot = p0[0] + p0[1] + p0[2] + p0[3] + p1[0] + p1[1] + p1[2] + p1[3];
                LAS float* rs = red + 1024 + wid * 64;
                rs[fq * 16 + fr] = __builtin_amdgcn_rsqf(tot * (1.f / 128.f) + RMS_EPS);
                bf16_t* obb = OB + (size_t)(row0 + 64 * c) * 1024 + h * 128;
                const unsigned oo = (unsigned)(4 * fq * 1024 + 16 * wid + fr);
#pragma unroll
                for (int mt = 0; mt < 4; ++mt) {
                    const f32x4 r4 = *(const LAS f32x4*)(rs + fq * 16 + 4 * mt);
#pragma unroll
                    for (int i = 0; i < 4; ++i) {
                        const int lr = 16 * mt + 4 * fq + i;
                        const float ov = o[mt][i] * r4[i] * onw * siluf(bf2f(zr[mt][i]));
                        const bf16_t ob = f2bf(ov);
                        if (lr < nvalid) obb[(unsigned)((16 * mt + i) * 1024) + oo] = ob;
                    }
                }
            }
        }
        {
            int lz = lane; asm volatile("" : "+v"(lz));
            const unsigned so = (unsigned)(4 * (lz >> 4) * 128 + 16 * wid + (lz & 15));
#pragma unroll
            for (int mt = 0; mt < 8; ++mt)
#pragma unroll
                for (int i = 0; i < 4; ++i) stout[(unsigned)((16 * mt + i) * 128) + so] = st[mt][i];
        }
#undef SCAN_G2L
#undef SCAN_LOADU
    }
}

DI void att_s(LAS unsigned char* Ka, int t, const bf16x8 (&qf)[4], f32x16& s0, f32x16& s1) {
#pragma unroll
    for (int i = 0; i < 16; ++i) { s0[i] = 0.f; s1[i] = 0.f; }
    bf16x8 kf[8];
#pragma unroll
    for (int s = 0; s < 4; ++s) { kf[2 * s] = *(const LAS bf16x8*)(Ka + (t ^ (s << 5))); kf[2 * s + 1] = *(const LAS bf16x8*)(Ka + 8192 + (t ^ (s << 5))); }
#pragma unroll
    for (int s = 0; s < 4; ++s) { s0 = MFMA32(kf[2 * s], qf[s], s0); s1 = MFMA32(kf[2 * s + 1], qf[s], s1); }
}
template <bool MASK>
DI float att_softmax(f32x16& s0, f32x16& s1, float& m, float& l, bf16x8 (&pf)[2][2], int h2, int nvk) {
    if (MASK) {
#pragma unroll
        for (int i = 0; i < 16; ++i) {
            const int key = (i & 3) + 8 * (i >> 2) + 4 * h2;
            s0[i] = (key < nvk) ? s0[i] : -INFINITY;
            s1[i] = (32 + key < nvk) ? s1[i] : -INFINITY;
        }
    }
    float mx = s0[0];
#pragma unroll
    for (int i = 1; i < 16; ++i) mx = fmaxf(mx, s0[i]);
#pragma unroll
    for (int i = 0; i < 16; ++i) mx = fmaxf(mx, s1[i]);
    mx = fmaxf(mx, __shfl_xor(mx, 32));
    const float mn = fmaxf(m, mx);
    const float alpha = __builtin_amdgcn_exp2f(m - mn);
    m = mn;
    float ps = 0.f;
#pragma unroll
    for (int i = 0; i < 16; ++i) { s0[i] = __builtin_amdgcn_exp2f(s0[i] - mn); s1[i] = __builtin_amdgcn_exp2f(s1[i] - mn); ps += s0[i] + s1[i]; }
    l = l * alpha + ps;
    u32x4 w;
    w.x = pk2(s0[0], s0[1]); w.y = pk2(s0[2], s0[3]); w.z = pk2(s0[4], s0[5]); w.w = pk2(s0[6], s0[7]); pf[0][0] = __builtin_bit_cast(bf16x8, w);
    w.x = pk2(s0[8], s0[9]); w.y = pk2(s0[10], s0[11]); w.z = pk2(s0[12], s0[13]); w.w = pk2(s0[14], s0[15]); pf[0][1] = __builtin_bit_cast(bf16x8, w);
    w.x = pk2(s1[0], s1[1]); w.y = pk2(s1[2], s1[3]); w.z = pk2(s1[4], s1[5]); w.w = pk2(s1[6], s1[7]); pf[1][0] = __builtin_bit_cast(bf16x8, w);
    w.x = pk2(s1[8], s1[9]); w.y = pk2(s1[10], s1[11]); w.z = pk2(s1[12], s1[13]); w.w = pk2(s1[14], s1[15]); pf[1][1] = __builtin_bit_cast(bf16x8, w);
    return alpha;
}
DI void att_pv(LAS unsigned char* Va, int q4, f32x16 (&O)[4], const bf16x8 (&pf)[2][2]) {
    s16x4 lo[16], hi[16];
#define PV_LD(i) do { LAS unsigned char* _vp = Va + ((((i) >> 2) ^ q4) << 6) + (32 * (((i) >> 1) & 1) + 16 * ((i) & 1)) * 256; \
        lo[i] = __builtin_amdgcn_ds_read_tr16_b64_v4i16((LAS s16x4*)_vp); hi[i] = __builtin_amdgcn_ds_read_tr16_b64_v4i16((LAS s16x4*)(_vp + 8 * 256)); } while (0)
    PV_LD(0); PV_LD(1); PV_LD(2);
#pragma unroll
    for (int i = 0; i < 16; ++i) {
        if (i + 3 < 16) PV_LD(i + 3);
        const bf16x8 vf = __builtin_shufflevector(lo[i], hi[i], 0, 1, 2, 3, 4, 5, 6, 7);
        O[i >> 2] = MFMA32(vf, pf[(i >> 1) & 1][i & 1], O[i >> 2]);
    }
#undef PV_LD
}

DI void phase_attn(const Params& P, LAS unsigned char* lds, int layer) {
    int tid_ = threadIdx.x; asm volatile("" : "+v"(tid_)); const int tid = tid_, wid = __builtin_amdgcn_readfirstlane(tid >> 6), lane = tid & 63, G = gridDim.x;
    unsigned char* ws = P.ws;
    const int j = layer >> 1;
    const int comp = wid >> 2, rg = wid & 3, r32 = lane & 31, h2 = lane >> 5;
    const bf16_t* proj = (const bf16_t*)(ws + WS_PROJ);
    bf16_t* OB = (bf16_t*)(ws + WS_HBUF);
    const float lam_init = 0.8f - 0.6f * expf(-0.3f * (float)layer);
    float lam;
    {
        float d1 = 0.f, d2 = 0.f;
        for (int i = 0; i < 64; ++i) { d1 += P.in[19][j * 64 + i] * P.in[20][j * 64 + i]; d2 += P.in[21][j * 64 + i] * P.in[22][j * 64 + i]; }
        lam = expf(d1) - expf(d2) + lam_init;
    }
    const float* subln = P.in[23] + j * 128;
    constexpr int TB = 32768;
    const int vb = (G % 8 == 0) ? (blockIdx.x % 8) * (G / 8) + blockIdx.x / 8 : blockIdx.x;
    const int nrounds = (G == 256) ? 9 : (2176 + G - 1) / G;
#define ATT_WAITV(n) asm volatile("s_waitcnt vmcnt(" #n ")" ::: "memory")
#define ATT_BAR() do { asm volatile("" ::: "memory"); __builtin_amdgcn_s_barrier(); asm volatile("" ::: "memory"); } while (0)
    for (int k = 0; k < nrounds; ++k) {
        int id;
        if (G == 256) {
            if (k < 8) { const int xcd = vb >> 5, idx = vb & 31; const int seq = xcd * 4 + (k >> 1); const int qt = (k & 1) ? idx : (63 - idx); id = seq * 64 + qt; }
            else { if (vb >= 128) break; id = 2048 + vb; }
        } else { id = vb + k * G; if (id >= 2176) break; }
        int h, qrow0, nt_all, nt_mine, last_valid; const int kvstride = 128; const bf16_t* Kp; const bf16_t* Vp; bool sample;
        if (id < 2048) {
            const int seq = id >> 6, qt = id & 63, b = seq >> 3; h = seq & 7; sample = false;
            qrow0 = b * TP + 128 * qt + 32 * rg; nt_all = 2 * qt + 2; nt_mine = (rg < 2) ? 2 * qt + 1 : 2 * qt + 2; last_valid = 64 * nt_mine;
            Kp = (const bf16_t*)(ws + WS_KH) + (size_t)seq * TP * 128; Vp = (const bf16_t*)(ws + WS_VH) + (size_t)seq * TP * 128;
        } else {
            const int s = id - 2048, b = s >> 3; h = s & 7; sample = true;
            qrow0 = MP + b * TS; nt_all = 34; nt_mine = (rg == 0) ? 34 : 0; last_valid = PAST + TS;
            Kp = (const bf16_t*)(ws + WS_KS) + (size_t)s * KSROWS * 128; Vp = (const bf16_t*)(ws + WS_VS) + (size_t)s * KSROWS * 128;
        }
        bf16x8 qf[4];
        {
            const int qr = qrow0 + (sample ? (r32 & 15) : r32);
            const bf16_t* qp = proj + (size_t)qr * NPROJ + h * 128 + comp * 64 + 8 * h2;
#pragma unroll
            for (int s = 0; s < 4; ++s) qf[s] = *(const bf16x8*)(qp + 16 * s);
        }
        f32x16 O[4];
#pragma unroll
        for (int et = 0; et < 4; ++et)
#pragma unroll
            for (int i = 0; i < 16; ++i) O[et][i] = 0.f;
        float m = -INFINITY, l = 0.f;
        bf16x8 pf[2][2];
#pragma unroll
        for (int a = 0; a < 2; ++a)
#pragma unroll
            for (int c2 = 0; c2 < 2; ++c2) pf[a][c2] = (bf16x8){0, 0, 0, 0, 0, 0, 0, 0};
        f32x16 sA0, sA1, sB0, sB1;
        const bf16_t* gsrc;
        {
            const int rowl = lane >> 4, c = lane & 15;
            const int row0 = 16 * (wid & 3) + rowl;
            const int lc = (wid < 4) ? (c ^ (row0 & 15)) : (c ^ ((row0 & 3) << 2));
            gsrc = ((wid < 4) ? Kp : Vp) + (size_t)row0 * kvstride + lc * 8;
        }
#define ATT_G2L(kt, bufi) do { _Pragma("unroll") for (int _i = 0; _i < 4; ++_i) { \
            const bf16_t* _s = gsrc + (size_t)(64 * (kt) + 4 * _i) * kvstride; \
            if (wid < 4) _s += (((lane & 15) ^ ((16 * (wid & 3) + 4 * _i + (lane >> 4)) & 15)) - ((lane & 15) ^ ((16 * (wid & 3) + (lane >> 4)) & 15))) * 8; \
            g2l16(_s, lds_u32(lds + (bufi) * TB + (4 * wid + _i) * 1024)); } } while (0)
        asm volatile("" :: "v"(qf[0]), "v"(qf[1]), "v"(qf[2]), "v"(qf[3]));
        __syncthreads();
        ATT_G2L(0, 0);
        if (nt_all > 1) { ATT_G2L(1, 1); ATT_WAITV(4); } else { ATT_WAITV(0); }
        ATT_BAR();
        {
            const int koff = r32 * 256, t = ((comp * 8 + h2) ^ (r32 & 15)) << 4;
            att_s(lds + koff, t, qf, sA0, sA1);
        }
#define ATT_ITER(KT, sC0, sC1, sN0, sN1, EDGE) do { \
            const int kt = (KT); \
            int lo_ = lane; asm volatile("" : "+v"(lo_)); \
            const int r32_ = lo_ & 31, h2_ = lo_ >> 5, q4_ = (lo_ & 15) >> 2, p4_ = lo_ & 3, blk_ = (lo_ >> 4) & 1; \
            const int koff_ = r32_ * 256, t_ = ((comp * 8 + h2_) ^ (r32_ & 15)) << 4; \
            const int voff_ = (4 * h2_ + q4_) * 256 + (2 * blk_ + (p4_ >> 1)) * 16 + (p4_ & 1) * 8; \
            ATT_WAITV(0); ATT_BAR(); \
            if (kt + 2 < nt_all) ATT_G2L(kt + 2, (kt + 2) & 3); \
            att_s(lds + ((kt + 1) & 3) * TB + koff_, t_, qf, sN0, sN1); \
            if (!(EDGE) || kt >= 1) att_pv(lds + ((kt - 1) & 3) * TB + 16384 + voff_, q4_, O, pf); \
            const float alpha = att_softmax<EDGE>(sC0, sC1, m, l, pf, h2_, last_valid - 64 * kt); \
            asm volatile("" :: "v"(l), "v"(pf[0][0]), "v"(pf[0][1]), "v"(pf[1][0]), "v"(pf[1][1]));     \
            _Pragma("unroll") for (int _g = 0; _g < 24; ++_g) { __builtin_amdgcn_sched_group_barrier(0x008, 1, 0); __builtin_amdgcn_sched_group_barrier(0x002, 7, 0); } \
            if (__any(alpha != 1.f)) { \
                _Pragma("unroll") for (int et = 0; et < 4; ++et) _Pragma("unroll") for (int i = 0; i < 16; ++i) O[et][i] *= alpha; } \
            } while (0)
        {
            const int npairs = nt_all >> 1;
            ATT_ITER(0, sA0, sA1, sB0, sB1, true);
            ATT_ITER(1, sB0, sB1, sA0, sA1, true);
            for (int pp = 1; pp < npairs - 1; ++pp) {
                ATT_ITER(2 * pp, sA0, sA1, sB0, sB1, false);
                ATT_ITER(2 * pp + 1, sB0, sB1, sA0, sA1, false);
            }
            if (npairs > 1) {
                ATT_ITER(nt_all - 2, sA0, sA1, sB0, sB1, true);
                ATT_ITER(nt_all - 1, sB0, sB1, sA0, sA1, true);
            }
        }
        {
            const int lt = nt_all - 1;
            const int h2b = lane >> 5, q4 = (lane & 15) >> 2, p4 = lane & 3, blk = (lane >> 4) & 1;
            const int voff = (4 * h2b + q4) * 256 + (2 * blk + (p4 >> 1)) * 16 + (p4 & 1) * 8;
            att_pv(lds + (lt & 3) * TB + 16384 + voff, q4, O, pf);
        }
        __syncthreads();
#undef ATT_ITER
#undef ATT_G2L
        const float lt = l + __shfl_xor(l, 32);
        const float inv = (nt_mine > 0) ? 1.f / lt : 0.f;
        LAS float* XO = (LAS float*)lds;
        if (comp == 1) {
            const float sc = inv * lam;
#pragma unroll
            for (int et = 0; et < 4; ++et)
#pragma unroll
                for (int i = 0; i < 16; ++i) XO[(rg * 128 + 32 * et + (i & 3) + 8 * (i >> 2) + 4 * h2) * 32 + r32] = O[et][i] * sc;
        }
        __syncthreads();
        if (comp == 0 && nt_mine > 0) {
            float ss = 0.f;
#pragma unroll
            for (int et = 0; et < 4; ++et)
#pragma unroll
                for (int i = 0; i < 16; ++i) { const float v = O[et][i] * inv - XO[(rg * 128 + 32 * et + (i & 3) + 8 * (i >> 2) + 4 * h2) * 32 + r32]; O[et][i] = v; ss += v * v; }
            ss += __shfl_xor(ss, 32);
            const float rstd = __builtin_amdgcn_rsqf(ss * (1.f / 128.f) + RMS_EPS) * (1.f - lam_init);
            const bool rvalid = sample ? (r32 < TS) : true;
            const int row = qrow0 + r32;
            if (rvalid) {
#pragma unroll
                for (int et = 0; et < 4; ++et)
#pragma unroll
                    for (int g4 = 0; g4 < 4; ++g4) {
                        const int e0 = 32 * et + 8 * g4 + 4 * h2;
                        const u32x2 zz = *(const u32x2*)(proj + (size_t)row * NPROJ + 3072 + h * 128 + e0);
                        const f32x4 sl = *(const f32x4*)(subln + e0);
                        const float z0 = __uint_as_float(zz.x << 16), z1 = __uint_as_float(zz.x & 0xffff0000u), z2 = __uint_as_float(zz.y << 16), z3 = __uint_as_float(zz.y & 0xffff0000u);
                        u32x2 w;
                        w.x = pk2(O[et][4 * g4] * rstd * sl[0] * siluf(z0), O[et][4 * g4 + 1] * rstd * sl[1] * siluf(z1));
                        w.y = pk2(O[et][4 * g4 + 2] * rstd * sl[2] * siluf(z2), O[et][4 * g4 + 3] * rstd * sl[3] * siluf(z3));
                        *(u32x2*)(OB + (size_t)row * 1024 + h * 128 + e0) = w;
                    }
            }
        }
        __syncthreads();
    }
}


#define XB_TMO      128
#define XB_XCNT(j)  (256  + 64 * (j))
#define XB_XSUB(j)  (1280 + 64 * (j))
#define XB_XGEN(j)  (2304 + 64 * (j))
#define XB_TOP      3328
#define XB_TOPGEN   3392
#define XCD_BAR_WORDS 3456
#define XB_SPIN_CAP (1u << 18)
DI unsigned xb_ld(unsigned* p)              { return __hip_atomic_load(p, __ATOMIC_RELAXED, __HIP_MEMORY_SCOPE_AGENT); }
DI unsigned xb_add(unsigned* p, unsigned v) { return __hip_atomic_fetch_add(p, v, __ATOMIC_RELAXED, __HIP_MEMORY_SCOPE_AGENT); }
DI unsigned xb_xcc_id() { return (unsigned)__builtin_amdgcn_s_getreg((3 << 11) | 20) & 0xFu; }
#define XB_SPIN(cond, bar) do { unsigned _sp = 0; while (cond) { __builtin_amdgcn_s_sleep(1); \
    if ((++_sp & 255u) == 0u) { if (xb_ld(&(bar)[XB_TMO])) break; if (_sp > XB_SPIN_CAP) { atomicAdd(&(bar)[XB_TMO], 1u); break; } } } } while (0)
DI void xcd_barrier_complete(unsigned* bar, unsigned x, unsigned& nloc, unsigned& nx) {
    const unsigned G = gridDim.x * gridDim.y * gridDim.z;
    unsigned sum, cnt, mine, sp = 0u;
    for (;;) {
        sum = 0u; cnt = 0u; mine = 0u;
#pragma unroll
        for (unsigned j = 0; j < 16; ++j) { const unsigned c = xb_ld(&bar[XB_XCNT(j)]); sum += c; cnt += (c > 0u) ? 1u : 0u; mine = (j == x) ? c : mine; }
        if (sum == G) break;
        __builtin_amdgcn_s_sleep(1);
        if ((++sp & 255u) == 0u) { if (xb_ld(&bar[XB_TMO])) break; if (sp > XB_SPIN_CAP) { atomicAdd(&bar[XB_TMO], 1u); break; } }
    }
    nloc = mine > 0u ? mine : 1u; nx = cnt > 0u ? cnt : 1u;
}
DI void xcd_barrier(unsigned* bar, volatile LAS unsigned* st) {
    asm volatile("s_waitcnt vmcnt(0)" ::: "memory");
    __syncthreads();
    if (threadIdx.x == 0) {
        const unsigned x = xb_xcc_id();
        __builtin_amdgcn_s_waitcnt(0);
        unsigned nloc = st[0], nx = st[1];
        if (nloc == 0u) { xcd_barrier_complete(bar, x, nloc, nx); st[0] = nloc; st[1] = nx; }
        const unsigned old = xb_add(&bar[XB_XSUB(x)], 1u);
        const unsigned gen = old / nloc;
        if (old + 1u == (gen + 1u) * nloc) {
            __builtin_amdgcn_fence(__ATOMIC_RELEASE, "agent");
            asm volatile("s_waitcnt vmcnt(0)" ::: "memory");
            const unsigned og = xb_add(&bar[XB_TOP], 1u);
            const unsigned tg = og / nx;
            if (og + 1u == (tg + 1u) * nx) xb_add(&bar[XB_TOPGEN], 1u);
            else XB_SPIN(xb_ld(&bar[XB_TOPGEN]) == tg, bar);
            __builtin_amdgcn_fence(__ATOMIC_ACQUIRE, "agent");
            xb_add(&bar[XB_XGEN(x)], 1u);
            asm volatile("s_waitcnt vmcnt(0)" ::: "memory");
        } else {
            XB_SPIN(xb_ld(&bar[XB_XGEN(x)]) == gen, bar);
            __builtin_amdgcn_fence(__ATOMIC_ACQUIRE, "agent");
            asm volatile("s_waitcnt vmcnt(0)" ::: "memory");
        }
    }
    __syncthreads();
}

typedef const __attribute__((address_space(4))) Params* CParP;
#define LOADP() Params P; { CParP kp_ = KP; asm volatile("" : "+s"(kp_)); P = *kp_; } unsigned char* ws = P.ws; (void)ws
__global__ void __launch_bounds__(512, 2) fwd_megakernel(Params Pin) {
#if defined(__HIP_DEVICE_COMPILE__)
    extern __shared__ __attribute__((aligned(16))) unsigned char lds_raw[];
    LAS unsigned char* lds = (LAS unsigned char*)lds_raw;
    cg::grid_group grid = cg::this_grid();
    const CParP KP = (CParP)__builtin_amdgcn_kernarg_segment_ptr();
    volatile LAS unsigned* xst = (volatile LAS unsigned*)(lds + 131072);
    if (threadIdx.x == 0) { xst[0] = 0u; xst[1] = 0u; }
    __syncthreads();
    { LOADP(); if (threadIdx.x == 0) (void)xb_add(&((unsigned*)(ws + WS_BAR))[XB_XCNT(xb_xcc_id())], 1u); }
#define GRID_BAR() do { LOADP(); xcd_barrier((unsigned*)(ws + WS_BAR), xst); } while (0)
    for (int rep = opaque_i(REP_PREP); rep > 0; --rep) { LOADP(); phase_prep(P, lds); }
    grid.sync();
    for (int layer = 0; layer < 4; ++layer) {
        const int j = layer >> 1;
        { LOADP(); phase_elem(P, lds, layer); }
        GRID_BAR();
        for (int rep = opaque_i(REP_GIN); rep > 0; --rep) {
            LOADP();
            pg8::StaticOrder S; S.init(M, NPROJ, gridDim.x, blockIdx.x);
            pg8::Gemm g;
            g.A = (const bf16_t*)(ws + WS_HBUF); g.M = M; g.N = NPROJ; g.K = 1024;
            if (!(layer & 1)) {
                g.Bt = (const bf16_t*)(ws + WS_WING) + (size_t)j * 4096 * 1024;
                EpiGdnIn E; E.proj = (bf16_t*)(ws + WS_PROJ); E.conv_p = P.out + OFF_CVP + (size_t)j * 4 * 3 * 3072; E.conv_s = P.out + OFF_CVS + (size_t)j * 16 * 3 * 3072;
                pg8::gemm_phase(lds, g, S, E);
            } else {
                g.Bt = (const bf16_t*)(ws + WS_WIND) + (size_t)j * 4096 * 1024;
                EpiDiffIn E; E.proj = (bf16_t*)(ws + WS_PROJ);
                E.k_p = P.out + OFF_KP + (size_t)j * MP * 1024; E.v_p = P.out + OFF_VP + (size_t)j * MP * 1024;
                E.k_s = P.out + OFF_KSO + (size_t)j * MS * 1024; E.v_s = P.out + OFF_VSO + (size_t)j * MS * 1024;
                E.ks = (bf16_t*)(ws + WS_KS); E.vs = (bf16_t*)(ws + WS_VS); E.kh = (bf16_t*)(ws + WS_KH); E.vh = (bf16_t*)(ws + WS_VH); E.rope = (const float*)(ws + WS_ROPE);
                pg8::gemm_phase(lds, g, S, E);
            }
        }
        GRID_BAR();
        if (!(layer & 1)) {
            for (int rep = opaque_i(REP_G1); rep > 0; --rep) { LOADP(); phase_g1(P, lds, layer); }
            GRID_BAR();
            for (int rep = opaque_i(REP_SCAN); rep > 0; --rep) { LOADP(); phase_scan(P, lds, layer); }
        } else {
            for (int rep = opaque_i(REP_ATTN); rep > 0; --rep) { LOADP(); phase_attn(P, lds, layer); }
        }
        GRID_BAR();
        for (int rep = opaque_i(REP_GOUT); rep > 0; --rep) {
            LOADP();
            pg8::StaticOrder S; S.init(M, 1024, gridDim.x, blockIdx.x);
            pg8::Gemm g;
            g.A = (const bf16_t*)(ws + WS_HBUF); g.M = M; g.N = 1024; g.K = 1024;
            g.Bt = (const bf16_t*)(ws + ((layer & 1) ? WS_WOUTD : WS_WOUTG)) + (size_t)j * 1024 * 1024;
            EpiOut E; E.C = (bf16_t*)(ws + WS_PROJ);
            pg8::gemm_phase(lds, g, S, E);
        }
        GRID_BAR();
    }
    { LOADP(); phase_elem(P, lds, 4); }
#endif
}

extern "C" void kernel_launch(void* const* d_in, const int* in_sizes, int n_in, void* d_out, int out_size, void* d_ws, size_t ws_size, hipStream_t stream) {
    static int grid_blocks = 0;
    if (!grid_blocks) {
        int dev = 0, cus = 0, per_cu = 0;
        hipGetDevice(&dev);
        hipDeviceGetAttribute(&cus, hipDeviceAttributeMultiprocessorCount, dev);
        hipFuncSetAttribute((const void*)fwd_megakernel, hipFuncAttributeMaxDynamicSharedMemorySize, LDS_BYTES);
        hipOccupancyMaxActiveBlocksPerMultiprocessor(&per_cu, (const void*)fwd_megakernel, 512, LDS_BYTES);
        if (per_cu < 1) per_cu = 1;
        grid_blocks = cus * per_cu;
        if (ws_size < WS_END) fprintf(stderr, "kernel_launch: workspace too small: %zu < %zu\n", ws_size, (size_t)WS_END);
    }
    hipMemsetAsync((unsigned char*)d_ws + WS_BAR, 0, XCD_BAR_WORDS * sizeof(unsigned), stream);
    Params p{};
    for (int i = 0; i < 25; ++i) p.in[i] = (const float*)d_in[i];
    p.out = (float*)d_out; p.ws = (unsigned char*)d_ws;
    void* args[] = {&p};
    hipError_t e = hipLaunchCooperativeKernel((const void*)fwd_megakernel, dim3(grid_blocks), dim3(512), args, LDS_BYTES, stream);
    if (e != hipSuccess) fprintf(stderr, "cooperative launch failed: %s (grid %d)\n", hipGetErrorString(e), grid_blocks);
}
```

```cpp
#include <hip/hip_runtime.h>
#include <hip/hip_cooperative_groups.h>
#include <cstdio>
namespace cg = cooperative_groups;

#define DI __device__ __forceinline__
#define LAS __attribute__((address_space(3)))
typedef unsigned short bf16_t;
typedef short bf16x8 __attribute__((ext_vector_type(8)));
typedef short s16x4 __attribute__((ext_vector_type(4)));
typedef float f32x2 __attribute__((ext_vector_type(2)));
typedef float f32x4 __attribute__((ext_vector_type(4)));
typedef float f32x16 __attribute__((ext_vector_type(16)));
typedef unsigned u32x2 __attribute__((ext_vector_type(2)));
typedef unsigned u32x4 __attribute__((ext_vector_type(4)));
typedef __bf16 bf16x2_t __attribute__((ext_vector_type(2)));

#define REP_G1 1
#define REP_SCAN 1
#define REP_ATTN 1
#define REP_GIN 1
#define REP_GOUT 1
#define REP_PREP 1
DI int opaque_i(int v) { asm volatile("" : "+s"(v)); return v; }
constexpr int D = 1024, TP = 8192, BP = 4, BS = 16, TS = 16, PAST = 2048;
constexpr int MP = BP * TP, MS = BS * TS, M = MP + MS, NB = BP + BS;
constexpr int NPROJ = 4096;
constexpr int KSROWS = 2112;
constexpr int NITEM_P = 4096, NITEM = 4224;
constexpr size_t ITEM_BYTES = 90112;
constexpr float RMS_EPS = 1e-6f;
constexpr float QSCALE = 0.125f * 1.4426950408889634f;

constexpr size_t OFF_Y = 0;
constexpr size_t OFF_STP = (size_t)M * D;
constexpr size_t OFF_CVP = OFF_STP + 2ull * 4 * 8 * 128 * 128;
constexpr size_t OFF_KP = OFF_CVP + 2ull * 4 * 3 * 3072;
constexpr size_t OFF_VP = OFF_KP + 2ull * MP * 1024;
constexpr size_t OFF_STS = OFF_VP + 2ull * MP * 1024;
constexpr size_t OFF_CVS = OFF_STS + 2ull * 16 * 8 * 128 * 128;
constexpr size_t OFF_KSO = OFF_CVS + 2ull * 16 * 3 * 3072;
constexpr size_t OFF_VSO = OFF_KSO + 2ull * MS * 1024;

constexpr size_t WS_WING = 0;
constexpr size_t WS_WOUTG = WS_WING + 2ull * 4096 * 1024 * 2;
constexpr size_t WS_WIND = WS_WOUTG + 2ull * 1024 * 1024 * 2;
constexpr size_t WS_WOUTD = WS_WIND + 2ull * 4096 * 1024 * 2;
constexpr size_t WS_ADA = WS_WOUTD + 2ull * 1024 * 1024 * 2;
constexpr size_t WS_ROPE = WS_ADA + 4ull * NB * 3072 * 4;
constexpr size_t WS_AB = WS_ROPE + 8208ull * 64 * 4;
constexpr size_t WS_GL = WS_AB + (size_t)M * 16 * 4;
constexpr size_t WS_BAR = WS_GL + 17408;
constexpr size_t WS_HBUF = WS_GL + 32768;
constexpr size_t WS_ORAW = WS_HBUF + (size_t)M * 1024 * 2;
constexpr size_t WS_PROJ = WS_ORAW + 256;
constexpr size_t WS_R1 = WS_PROJ + (size_t)M * 4096 * 2;
constexpr size_t WS_KS = WS_R1;
constexpr size_t WS_VS = WS_KS + 16ull * KSROWS * 1024 * 2;
constexpr size_t WS_KH = WS_VS + 16ull * KSROWS * 1024 * 2;
constexpr size_t WS_VH = WS_KH + (size_t)MP * 1024 * 2;
constexpr size_t WS_ORAWB = WS_R1 + (size_t)NITEM * ITEM_BYTES;
constexpr size_t WS_END = WS_ORAWB + (size_t)M * 1024 * 2;

constexpr int LDS_BYTES = 131072 + 16;

struct Params { const float* in[25]; float* out; unsigned char* ws; };

DI float bf2f(bf16_t v) { return __uint_as_float(((unsigned)v) << 16); }
DI unsigned pk2(float a, float b) { f32x2 v = {a, b}; bf16x2_t r = __builtin_convertvector(v, bf16x2_t); return __builtin_bit_cast(unsigned, r); }
DI bf16_t f2bf(float a) { return (bf16_t)(pk2(a, 0.f) & 0xffffu); }
template <int CTRL> DI float dppf(float v) { return __builtin_bit_cast(float, __builtin_amdgcn_update_dpp(0, __builtin_bit_cast(int, v), CTRL, 0xf, 0xf, true)); }
DI float row_sum16(float v) { v += dppf<0x128>(v); v += dppf<0x124>(v); v += dppf<0x122>(v); v += dppf<0x121>(v); return v; }
DI float wave_sum(float v) { v = row_sum16(v); v += __shfl_xor(v, 16); v += __shfl_xor(v, 32); return v; }
DI float readlane_f(float v, int l) { return __builtin_bit_cast(float, __builtin_amdgcn_readlane(__builtin_bit_cast(int, v), l)); }
DI float siluf(float x) { return x * __builtin_amdgcn_rcpf(1.f + __expf(-x)); }
DI int ppos(int idx) { const int d5 = idx & 31; return (idx & ~31) | (((d5 >> 2) & 3) << 3) | ((d5 >> 4) << 2) | (d5 & 3); }
DI int perm64(int ls) { return (ls & 15) | (((ls >> 4) & 1) << 5) | (((ls >> 5) & 1) << 4); }
DI void unpack8(const u32x4 v, float (&o)[8]) {
#pragma unroll
    for (int i = 0; i < 4; ++i) { o[2 * i] = __uint_as_float(v[i] << 16); o[2 * i + 1] = __uint_as_float(v[i] & 0xffff0000u); }
}
DI void g2l16(const void* gptr, unsigned lds_addr) {
    asm volatile("s_mov_b32 m0, %1\n\ts_nop 0\n\tglobal_load_lds_dwordx4 %0, off" :: "v"(gptr), "s"(lds_addr) : "memory", "m0");
}
DI unsigned lds_u32(LAS unsigned char* p) { return (unsigned)(size_t)p; }
#define MFMA16(a, b, c) __builtin_amdgcn_mfma_f32_16x16x32_bf16((a), (b), (c), 0, 0, 0)
#define MFMA32(a, b, c) __builtin_amdgcn_mfma_f32_32x32x16_bf16((a), (b), (c), 0, 0, 0)

namespace pg8 {
constexpr int BM = 256, BK = 64, HALF = 128, HTB = HALF * BK * 2, STAGE_BYTES = 8 * HTB, NXCD = 8, WGM = 8;
DI int lds_byte(int r, int c) { const int st = (r >> 4) * 2 + (c >> 5), rr = r & 15, cc = c & 31, ob = rr * 64 + cc * 2; return st * 1024 + (ob ^ (((ob >> 9) & 1) << 5)); }
DI void stage_rc(int b, int& R, int& C) { const int st = b / 1024, sb = b % 1024, swz = sb ^ (((sb >> 9) & 1) << 5); R = (st >> 1) * 16 + swz / 64; C = (st & 1) * 32 + (swz % 64) / 2; }
struct Unit { int pm, pn; };
struct Gemm { const bf16_t* A; const bf16_t* Bt; int M, N, K; };
struct StaticOrder {
    int nM, nN, nwg, G, c;
    DI void init(int M_, int N_, int G_, int c_) { nM = M_ / BM; nN = N_ / BM; nwg = nM * nN; G = G_; c = c_; }
    DI bool next(int i, Unit& u) const {
        const long L = (long)i * G + c; if (L >= nwg) return false;
        int wgid = (int)L; { const int q = nwg / NXCD, r = nwg % NXCD, xcd = wgid % NXCD, off = wgid / NXCD; wgid = (xcd < r ? xcd * (q + 1) : r * (q + 1) + (xcd - r) * q) + off; }
        const int nig = WGM * nN, gid = wgid / nig, fm = gid * WGM, gsz = (nM - fm) < WGM ? (nM - fm) : WGM;
        u.pm = fm + ((wgid % nig) % gsz); u.pn = (wgid % nig) / gsz; return true;
    }
};

template <class Epi>
DI void gemm_phase(LAS unsigned char* lds, const Gemm g, const StaticOrder& S, const Epi& E) {
    int tid_ = threadIdx.x; asm volatile("" : "+v"(tid_)); const int tid = tid_, wid = __builtin_amdgcn_readfirstlane(tid >> 6), lane = tid & 63, wr = wid >> 2, wc = wid & 3, fr = lane & 15, fq = lane >> 4;
    const int K = g.K, nt = K / BK;
    unsigned voffA[2];
#pragma unroll
    for (int i = 0; i < 2; ++i) { int R, C; stage_rc(tid * 16 + i * 8192, R, C); voffA[i] = (unsigned)(R * K + C) * 2u; }
    const size_t kstep = (size_t)(BK * 2);
    const size_t hstep = (size_t)HALF * K * 2;
    const size_t tstep = 2 * hstep;
    const unsigned ldsw = (unsigned)wid * 1024u;
    const int aoff = lds_byte(wr * 64 + fr, fq * 8), boff = lds_byte(wc * 32 + fr, fq * 8);
#define PG8_SA(b, h) (((b) * 2 + (h)) * HTB)
#define PG8_SB(b, h) ((4 + (b) * 2 + (h)) * HTB)
#define PG8_STAGE(bufoff, gbase) do { _Pragma("unroll") for (int _i = 0; _i < 2; ++_i) \
        __builtin_amdgcn_global_load_lds((const unsigned*)((const char*)(gbase) + voffA[_i]), (LAS unsigned*)(lds + (bufoff) + ldsw + _i * 8192), 16, 0, 0); } while (0)
#define PG8_LDA(dst, b, h) do { _Pragma("unroll") for (int m = 0; m < 4; ++m) _Pragma("unroll") for (int k = 0; k < 2; ++k) dst[m][k] = *(const LAS bf16x8*)(lds + PG8_SA(b, h) + aoff + m * 2048 + k * 1024); } while (0)
#define PG8_LDB(dst, b, h) do { _Pragma("unroll") for (int n = 0; n < 2; ++n) _Pragma("unroll") for (int k = 0; k < 2; ++k) dst[n][k] = *(const LAS bf16x8*)(lds + PG8_SB(b, h) + boff + n * 2048 + k * 1024); } while (0)
#define PG8_MMA(ai, bj, At, Bt) do { __builtin_amdgcn_s_setprio(1); _Pragma("unroll") for (int m = 0; m < 4; ++m) _Pragma("unroll") for (int n = 0; n < 2; ++n) _Pragma("unroll") for (int k = 0; k < 2; ++k) \
        acc[ai][bj][m][n] = __builtin_amdgcn_mfma_f32_16x16x32_bf16(Bt[n][k], At[m][k], acc[ai][bj][m][n], 0, 0, 0); __builtin_amdgcn_s_setprio(0); } while (0)
#define PG8_WAIT_V(n) asm volatile("s_waitcnt vmcnt(" #n ")" ::: "memory")
#define PG8_WAIT_L(n) asm volatile("s_waitcnt lgkmcnt(" #n ")" ::: "memory")
#define PG8_BAR __builtin_amdgcn_s_barrier()
#define PG8_SCHED __builtin_amdgcn_sched_barrier(0)
    Unit cur, nxt; int ui = 0;
    if (!S.next(0, cur)) return;
    f32x4 acc[2][2][4][2];
#pragma unroll
    for (int a = 0; a < 2; ++a)
#pragma unroll
        for (int b = 0; b < 2; ++b)
#pragma unroll
            for (int m = 0; m < 4; ++m)
#pragma unroll
                for (int n = 0; n < 2; ++n) acc[a][b][m][n] = (f32x4){0.f, 0.f, 0.f, 0.f};
    bf16x8 At[4][2], B0[2][2], B1[2][2];
    const char* cA = (const char*)g.A + (size_t)cur.pm * tstep; const char* cB = (const char*)g.Bt + (size_t)cur.pn * tstep;
    PG8_STAGE(PG8_SB(0, 0), cB); PG8_STAGE(PG8_SA(0, 0), cA); PG8_STAGE(PG8_SB(0, 1), cB + hstep); PG8_STAGE(PG8_SA(0, 1), cA + hstep);
    if (wr == 1) PG8_BAR;
    PG8_WAIT_V(4); PG8_BAR;
    PG8_STAGE(PG8_SB(1, 0), cB + kstep); PG8_STAGE(PG8_SA(1, 0), cA + kstep); PG8_STAGE(PG8_SB(1, 1), cB + hstep + kstep);
    PG8_WAIT_V(6); PG8_BAR;
    for (;;) {
        const bool has_next = S.next(ui + 1, nxt);
        const char* nA = has_next ? (const char*)g.A + (size_t)nxt.pm * tstep : cA; const char* nB = has_next ? (const char*)g.Bt + (size_t)nxt.pn * tstep : cB;
        for (int t = 0; t < nt; t += 2) {
            const bool last = (t == nt - 2);
            const char* a1 = cA + (size_t)(t + 1) * kstep;
            const char* a2 = last ? nA : cA + (size_t)(t + 2) * kstep; const char* b2 = last ? nB : cB + (size_t)(t + 2) * kstep;
            const char* a3 = a2 + kstep; const char* b3 = b2 + kstep;
            PG8_LDB(B0, 0, 0); PG8_SCHED; PG8_LDA(At, 0, 0); PG8_STAGE(PG8_SA(1, 1), a1 + hstep);
            PG8_WAIT_L(8); PG8_BAR; PG8_WAIT_L(0); PG8_MMA(0, 0, At, B0); PG8_BAR; PG8_SCHED;
            PG8_LDB(B1, 0, 1); PG8_STAGE(PG8_SB(0, 0), b2);
            PG8_BAR; PG8_WAIT_L(0); PG8_MMA(0, 1, At, B1); PG8_BAR;
            PG8_LDA(At, 0, 1); PG8_STAGE(PG8_SA(0, 0), a2);
            PG8_BAR; PG8_WAIT_L(0); PG8_MMA(1, 0, At, B0); PG8_BAR; PG8_SCHED;
            PG8_STAGE(PG8_SB(0, 1), b2 + hstep);
            PG8_WAIT_V(6); PG8_BAR; PG8_MMA(1, 1, At, B1); PG8_BAR;
            PG8_LDB(B0, 1, 0); PG8_SCHED; PG8_LDA(At, 1, 0); PG8_STAGE(PG8_SA(0, 1), a2 + hstep);
            PG8_WAIT_L(8); PG8_BAR; PG8_WAIT_L(0); PG8_MMA(0, 0, At, B0); PG8_BAR; PG8_SCHED;
            PG8_LDB(B1, 1, 1); PG8_STAGE(PG8_SB(1, 0), b3);
            PG8_BAR; PG8_WAIT_L(0); PG8_MMA(0, 1, At, B1); PG8_BAR;
            PG8_LDA(At, 1, 1); PG8_STAGE(PG8_SA(1, 0), a3);
            PG8_BAR; PG8_WAIT_L(0); PG8_MMA(1, 0, At, B0); PG8_BAR; PG8_SCHED;
            PG8_STAGE(PG8_SB(1, 1), b3 + hstep);
            PG8_WAIT_V(6); PG8_BAR; PG8_MMA(1, 1, At, B1); PG8_BAR;
        }
        E(acc, cur, wr, wc, fr, fq);
        if (!has_next) break;
#pragma unroll
        for (int a = 0; a < 2; ++a)
#pragma unroll
            for (int b = 0; b < 2; ++b)
#pragma unroll
                for (int m = 0; m < 4; ++m)
#pragma unroll
                    for (int n = 0; n < 2; ++n) acc[a][b][m][n] = (f32x4){0.f, 0.f, 0.f, 0.f};
        cur = nxt; cA = nA; cB = nB; ++ui;
    }
    PG8_WAIT_V(0);
    if (wr == 0) PG8_BAR;
    PG8_BAR;
#undef PG8_SA
#undef PG8_SB
#undef PG8_STAGE
#undef PG8_LDA
#undef PG8_LDB
#undef PG8_MMA
#undef PG8_WAIT_V
#undef PG8_WAIT_L
#undef PG8_BAR
#undef PG8_SCHED
}
}

struct EpiGdnIn {
    bf16_t* proj; float* conv_p; float* conv_s;
    DI void operator()(const f32x4 (&acc)[2][2][4][2], const pg8::Unit& u, int wr, int wc, int fr, int fq) const {
        const int row0 = u.pm * 256 + wr * 64 + fr, col0 = u.pn * 256 + wc * 32 + 4 * fq;
#pragma unroll
        for (int ai = 0; ai < 2; ++ai)
#pragma unroll
            for (int m = 0; m < 4; ++m) {
                const int r = row0 + ai * 128 + m * 16;
                bf16_t* rowp = proj + (size_t)r * NPROJ + col0;
                bool tail; float* cp;
                if (r < MP) { const int t = r & (TP - 1), b = r >> 13; tail = t >= TP - 3; cp = conv_p + (size_t)(b * 3 + (t - (TP - 3))) * 3072; }
                else { const int rs = r - MP, t = rs & 15, b = rs >> 4; tail = t >= TS - 3; cp = conv_s + (size_t)(b * 3 + (t - (TS - 3))) * 3072; }
#pragma unroll
                for (int bj = 0; bj < 2; ++bj)
#pragma unroll
                    for (int n = 0; n < 2; ++n) {
                        const f32x4 v = acc[ai][bj][m][n];
                        u32x2 w; w.x = pk2(v[0], v[1]); w.y = pk2(v[2], v[3]);
                        *(u32x2*)(rowp + bj * 128 + n * 16) = w;
                        const int c = col0 + bj * 128 + n * 16;
                        if (tail && c < 3072) *(f32x4*)(cp + c) = v;
                    }
            }
    }
};

struct EpiDiffIn {
    bf16_t* proj; float* k_p; float* v_p; float* k_s; float* v_s; bf16_t* ks; bf16_t* vs; bf16_t* kh; bf16_t* vh; const float* rope;
    DI void operator()(const f32x4 (&acc)[2][2][4][2], const pg8::Unit& u, int wr, int wc, int fr, int fq) const {
        const int part = u.pn >> 2;
        const int row0 = u.pm * 256 + wr * 64 + fr;
        const int d0 = 16 * (wc & 1) + 4 * fq;
        const int cbase = u.pn * 256 + 64 * (wc >> 1) + d0;
#pragma unroll
        for (int ai = 0; ai < 2; ++ai)
#pragma unroll
            for (int m = 0; m < 4; ++m) {
                const int r = row0 + ai * 128 + m * 16;
                const int rs = r - MP;
                const int pidx = (r < MP) ? (r & (TP - 1)) : (TP + (rs & 15));
                f32x4 cs = {1.f, 1.f, 1.f, 1.f}, sn = {0.f, 0.f, 0.f, 0.f};
                if (part < 2) { cs = *(const f32x4*)(rope + (size_t)pidx * 64 + d0); sn = *(const f32x4*)(rope + (size_t)pidx * 64 + 32 + d0); }
#pragma unroll
                for (int bj = 0; bj < 2; ++bj) {
                    const f32x4 x1 = acc[ai][bj][m][0], x2 = acc[ai][bj][m][1];
                    f32x4 y1 = x1 * cs - x2 * sn, y2 = x2 * cs + x1 * sn;
                    const int col = cbase + bj * 128;
                    bf16_t* pp = proj + (size_t)r * NPROJ + col;
                    if (part == 0) { y1 *= QSCALE; y2 *= QSCALE; }
                    u32x2 w1, w2; w1.x = pk2(y1[0], y1[1]); w1.y = pk2(y1[2], y1[3]); w2.x = pk2(y2[0], y2[1]); w2.y = pk2(y2[2], y2[3]);
                    if (part == 0 || part == 3) { *(u32x2*)pp = w1; *(u32x2*)(pp + 32) = w2; }
                    if (part == 1 || part == 2) {
                        const int cc = col - part * 1024;
                        const int hh = cc >> 7, dd = cc & 127;
                        float* op; bf16_t* sp;
                        if (r < MP) { op = (part == 1 ? k_p : v_p) + (size_t)r * 1024 + cc;
                               sp = (part == 1 ? kh : vh) + ((size_t)((r >> 13) * 8 + hh) * TP + (r & (TP - 1))) * 128 + dd; }
                        else { op = (part == 1 ? k_s : v_s) + (size_t)rs * 1024 + cc;
                               sp = (part == 1 ? ks : vs) + ((size_t)((rs >> 4) * 8 + hh) * KSROWS + PAST + (rs & 15)) * 128 + dd; }
                        *(f32x4*)op = y1; *(f32x4*)(op + 32) = y2;
                        *(u32x2*)sp = w1; *(u32x2*)(sp + 32) = w2;
                    }
                }
            }
    }
};

struct EpiOut {
    bf16_t* C;
    DI void operator()(const f32x4 (&acc)[2][2][4][2], const pg8::Unit& u, int wr, int wc, int fr, int fq) const {
        const int row0 = u.pm * 256 + wr * 64 + fr, col0 = u.pn * 256 + wc * 32 + 4 * fq;
#pragma unroll
        for (int ai = 0; ai < 2; ++ai)
#pragma unroll
            for (int m = 0; m < 4; ++m) {
                bf16_t* rowp = C + (size_t)(row0 + ai * 128 + m * 16) * 1024 + col0;
#pragma unroll
                for (int bj = 0; bj < 2; ++bj)
#pragma unroll
                    for (int n = 0; n < 2; ++n) { const f32x4 v = acc[ai][bj][m][n]; u32x2 w; w.x = pk2(v[0], v[1]); w.y = pk2(v[2], v[3]); *(u32x2*)(rowp + bj * 128 + n * 16) = w; }
            }
    }
};

DI void transpose_tile(const float* W, int ldw, int n0, int k0, bf16_t* WT, bool perm, LAS float* tile) {
    int tid_ = threadIdx.x; asm volatile("" : "+v"(tid_)); const int tid = tid_;
    {
        const int kk = tid >> 4, c4 = (tid & 15) * 4;
#pragma unroll
        for (int p = 0; p < 2; ++p) {
            const f32x4 v = *(const f32x4*)(W + (size_t)(k0 + kk + 32 * p) * ldw + n0 + c4);
            LAS float* t = tile + (kk + 32 * p) * 65 + c4;
            t[0] = v[0]; t[1] = v[1]; t[2] = v[2]; t[3] = v[3];
        }
    }
    __syncthreads();
    {
        const int n = tid >> 3, ks = (tid & 7) * 8;
        const int src = perm ? perm64(n) : n;
        float v[8];
#pragma unroll
        for (int e = 0; e < 8; ++e) v[e] = tile[(ks + e) * 65 + src];
        u32x4 w; w.x = pk2(v[0], v[1]); w.y = pk2(v[2], v[3]); w.z = pk2(v[4], v[5]); w.w = pk2(v[6], v[7]);
        *(u32x4*)(WT + (size_t)(n0 + n) * 1024 + k0 + ks) = w;
    }
    __syncthreads();
}

DI void phase_prep(const Params& P, LAS unsigned char* lds) {
    int tid_ = threadIdx.x; asm volatile("" : "+v"(tid_)); const int tid = tid_, G = gridDim.x;
    unsigned char* ws = P.ws;
    for (int id = blockIdx.x; id < 5120; id += G) {
        const int j = id / 2560; int rem = id % 2560;
        const float* W; int ldw; bf16_t* WT; bool perm = false; int t;
        if (rem < 1024) { W = P.in[12] + (size_t)j * 1024 * 4112; ldw = 4112; WT = (bf16_t*)(ws + WS_WING) + (size_t)j * 4096 * 1024; t = rem; }
        else if (rem < 1280) { W = P.in[17] + (size_t)j * 1024 * 1024; ldw = 1024; WT = (bf16_t*)(ws + WS_WOUTG) + (size_t)j * 1024 * 1024; t = rem - 1024; }
        else if (rem < 2304) { W = P.in[18] + (size_t)j * 1024 * 4096; ldw = 4096; WT = (bf16_t*)(ws + WS_WIND) + (size_t)j * 4096 * 1024; t = rem - 1280; perm = true; }
        else { W = P.in[24] + (size_t)j * 1024 * 1024; ldw = 1024; WT = (bf16_t*)(ws + WS_WOUTD) + (size_t)j * 1024 * 1024; t = rem - 2304; }
        transpose_tile(W, ldw, (t >> 4) * 64, (t & 15) * 64, WT, perm, (LAS float*)lds);
    }
    for (int idx = blockIdx.x * 512 + tid; idx < 8208 * 32; idx += G * 512) {
        const int pi = idx >> 5, d = idx & 31;
        const int pos = pi < TP ? pi : PAST + (pi - TP);
        const float inv = 1.0f / powf(10000.0f, (float)d / 32.0f);
        const float ang = (float)pos * inv;
        const double rev = (double)ang * 0.15915494309189535;
        const double fr = rev - floor(rev);
        float* rp = (float*)(ws + WS_ROPE) + (size_t)pi * 64;
        rp[d] = __builtin_amdgcn_cosf((float)fr);
        rp[32 + d] = __builtin_amdgcn_sinf((float)fr);
    }
    {
        LAS float* cact = (LAS float*)lds;
        LAS float* red = (LAS float*)(lds + 81920);
        bool loaded = false;
        for (int id = (G - 1 - blockIdx.x); id < 192; id += G) {
            if (!loaded) {
                for (int e = tid; e < NB * 1024; e += 512) {
                    const int b = e >> 10, k = e & 1023;
                    const float c = b < BP ? P.in[2][b * 1024 + k] : P.in[3][(b - BP) * 1024 + k];
                    cact[e] = siluf(c);
                }
                loaded = true;
            }
            __syncthreads();
            const int i = id / 48, cb = id % 48;
            const int col = tid & 63, kg = tid >> 6;
            const float* Wp = P.in[10] + (size_t)i * 1024 * 3072 + cb * 64 + col;
            float acc[NB];
#pragma unroll
            for (int b = 0; b < NB; ++b) acc[b] = 0.f;
            for (int k = kg * 128; k < kg * 128 + 128; k += 4) {
                const float w0 = Wp[(size_t)k * 3072], w1 = Wp[(size_t)(k + 1) * 3072], w2 = Wp[(size_t)(k + 2) * 3072], w3 = Wp[(size_t)(k + 3) * 3072];
#pragma unroll
                for (int b = 0; b < NB; ++b) {
                    const f32x4 c4 = *(const LAS f32x4*)(cact + b * 1024 + k);
                    acc[b] += c4[0] * w0 + c4[1] * w1 + c4[2] * w2 + c4[3] * w3;
                }
            }
#pragma unroll
            for (int b = 0; b < NB; ++b) red[(kg * NB + b) * 64 + col] = acc[b];
            __syncthreads();
            for (int o = tid; o < NB * 64; o += 512) {
                const int b = o >> 6, c = o & 63;
                float s = P.in[11][i * 3072 + cb * 64 + c];
#pragma unroll
                for (int g = 0; g < 8; ++g) s += red[(g * NB + b) * 64 + c];
                ((float*)(ws + WS_ADA))[((size_t)i * NB + b) * 3072 + cb * 64 + c] = s;
            }
        }
        __syncthreads();
    }
}

DI void phase_elem(const Params& P, LAS unsigned char* lds, int layer) {
    int tid_ = threadIdx.x; asm volatile("" : "+v"(tid_)); const int tid = tid_, wid = __builtin_amdgcn_readfirstlane(tid >> 6), lane = tid & 63, G = gridDim.x;
    unsigned char* ws = P.ws;
    const int j = layer >> 1;
    const bool gdn = (layer < 4) && !(layer & 1);
    LAS float* wab = (LAS float*)lds;
    if (gdn) {
        const float* Wp = P.in[12] + (size_t)j * 1024 * 4112 + 4096;
        for (int e = tid; e < 16384; e += 512) { const int k = e >> 4, c = e & 15; wab[c * 1024 + k] = Wp[(size_t)k * 4112 + c]; }
        __syncthreads();
    }
    const float* ada = (const float*)(ws + WS_ADA);
    float* X = P.out;
    const bf16_t* OUTB = (const bf16_t*)(ws + WS_PROJ);
    bf16_t* HB = (bf16_t*)(ws + WS_HBUF);
    float* AB = (float*)(ws + WS_AB);
    for (int r = blockIdx.x * 8 + wid; r < M; r += G * 8) {
        const int b = r < MP ? (r >> 13) : BP + ((r - MP) >> 4);
        const float* xs = (layer <= 1) ? (r < MP ? P.in[0] + (size_t)r * 1024 : P.in[1] + (size_t)(r - MP) * 1024) : X + (size_t)r * 1024;
        f32x4 x[4];
#pragma unroll
        for (int q = 0; q < 4; ++q) x[q] = *(const f32x4*)(xs + 4 * (lane + 64 * q));
        if (layer >= 1) {
            f32x4 o[4]; float ss = 0.f;
#pragma unroll
            for (int q = 0; q < 4; ++q) { const u32x2 ow = *(const u32x2*)(OUTB + (size_t)r * 1024 + 4 * (lane + 64 * q));
                o[q] = (f32x4){__uint_as_float(ow.x << 16), __uint_as_float(ow.x & 0xffff0000u), __uint_as_float(ow.y << 16), __uint_as_float(ow.y & 0xffff0000u)};
                ss += o[q][0] * o[q][0] + o[q][1] * o[q][1] + o[q][2] * o[q][2] + o[q][3] * o[q][3]; }
            ss = wave_sum(ss);
            const float rstd = __builtin_amdgcn_rsqf(ss * (1.f / 1024.f) + RMS_EPS);
            const float* gp = ada + ((size_t)(layer - 1) * NB + b) * 3072 + 2048;
            const float* np = P.in[9] + (layer - 1) * 1024;
#pragma unroll
            for (int q = 0; q < 4; ++q) {
                const int d = 4 * (lane + 64 * q);
                const f32x4 gt = *(const f32x4*)(gp + d), nw = *(const f32x4*)(np + d);
                x[q] = x[q] + gt * (o[q] * rstd * nw);
                *(f32x4*)(X + (size_t)r * 1024 + d) = x[q];
            }
        }
        if (layer < 4) {
            float ss = 0.f;
#pragma unroll
            for (int q = 0; q < 4; ++q) ss += x[q][0] * x[q][0] + x[q][1] * x[q][1] + x[q][2] * x[q][2] + x[q][3] * x[q][3];
            ss = wave_sum(ss);
            const float rstd = __builtin_amdgcn_rsqf(ss * (1.f / 1024.f) + RMS_EPS);
            const float* ap = ada + ((size_t)layer * NB + b) * 3072;
            const float* np = P.in[8] + layer * 1024;
            f32x4 hv[4];
#pragma unroll
            for (int q = 0; q < 4; ++q) {
                const int d = 4 * (lane + 64 * q);
                const f32x4 sh = *(const f32x4*)(ap + d), sc = *(const f32x4*)(ap + 1024 + d), nw = *(const f32x4*)(np + d);
                hv[q] = (x[q] * rstd * nw) * (1.f + sc) + sh;
                u32x2 w; w.x = pk2(hv[q][0], hv[q][1]); w.y = pk2(hv[q][2], hv[q][3]);
                *(u32x2*)(HB + (size_t)r * 1024 + d) = w;
            }
            if (gdn) {
                float mine = 0.f;
#pragma unroll
                for (int c = 0; c < 16; ++c) {
                    float a = 0.f;
#pragma unroll
                    for (int q = 0; q < 4; ++q) { const f32x4 w4 = *(const LAS f32x4*)(wab + c * 1024 + 4 * (lane + 64 * q)); a += hv[q][0] * w4[0] + hv[q][1] * w4[1] + hv[q][2] * w4[2] + hv[q][3] * w4[3]; }
                    a = row_sum16(a);
                    if ((lane & 15) == c) mine = a;
                }
                mine += __shfl_xor(mine, 16); mine += __shfl_xor(mine, 32);
                if (lane < 16) AB[(size_t)r * 16 + lane] = mine;
            }
        }
    }
    if (layer < 4 && (layer & 1)) {
        const float* ck = P.in[6] + (size_t)j * 16 * PAST * 1024;
        const float* cv = P.in[7] + (size_t)j * 16 * PAST * 1024;
        bf16_t* KS = (bf16_t*)(ws + WS_KS); bf16_t* VS = (bf16_t*)(ws + WS_VS);
        const size_t nun = (size_t)16 * PAST * 128;
        for (size_t u = (size_t)blockIdx.x * 512 + tid; u < 2 * nun; u += (size_t)G * 512) {
            const bool isv = u >= nun; const size_t uu = isv ? u - nun : u;
            const size_t b = uu / ((size_t)PAST * 128), rem = uu % ((size_t)PAST * 128);
            const size_t row = rem >> 7, c8 = rem & 127, hh = c8 >> 4, d8 = c8 & 15;
            const float* sp = (isv ? cv : ck) + uu * 8;
            const f32x4 a = *(const f32x4*)sp, c = *(const f32x4*)(sp + 4);
            u32x4 w; w.x = pk2(a[0], a[1]); w.y = pk2(a[2], a[3]); w.z = pk2(c[0], c[1]); w.w = pk2(c[2], c[3]);
            *(u32x4*)((isv ? VS : KS) + ((b * 8 + hh) * KSROWS + row) * 128 + d8 * 8) = w;
        }
        const size_t npad = (size_t)128 * 48 * 16;
        for (size_t u = (size_t)blockIdx.x * 512 + tid; u < 2 * npad; u += (size_t)G * 512) {
            const bool isv = u >= npad; const size_t uu = isv ? u - npad : u;
            const size_t sq = uu / (48 * 16), rem = uu % (48 * 16);
            *(u32x4*)((isv ? VS : KS) + (sq * KSROWS + PAST + TS) * 128 + rem * 8) = (u32x4){0u, 0u, 0u, 0u};
        }
    }
}

DI void phase_g1(const Params& P, LAS unsigned char* lds, int layer) {
    int tid_ = threadIdx.x; asm volatile("" : "+v"(tid_)); const int tid = tid_, wid = __builtin_amdgcn_readfirstlane(tid >> 6), lane = tid & 63, G = gridDim.x;
    const int fr = lane & 15, fq = lane >> 4;
    unsigned char* ws = P.ws;
    const int j = layer >> 1;
    const bf16_t* proj = (const bf16_t*)(ws + WS_PROJ);
    const float* AB = (const float*)(ws + WS_AB);
    float* GL = (float*)(ws + WS_GL);
    const float* convw = P.in[13] + (size_t)j * 4 * 3072;
    const float* cconv = P.in[5] + (size_t)j * 16 * 3 * 3072;
    LAS unsigned char* Qs = lds;
    LAS unsigned char* Ks = lds + 17408;
    LAS unsigned char* VBt = lds + 34816;
    LAS unsigned char* KBt = lds + 53248;
    LAS float* A32 = (LAS float*)(lds + 71680);
    LAS unsigned char* Ts = lds + 88320;
    LAS unsigned char* QKs = lds + 97536;
    LAS float* Gs = (LAS float*)(lds + 105728);

    for (int item = blockIdx.x; item < NITEM; item += G) {
        int b, h, c, row0, nvalid; bool sample;
        if (item < NITEM_P) { const int seq = item >> 7; b = seq >> 3; h = seq & 7; c = item & 127; row0 = b * TP + 64 * c; nvalid = 64; sample = false; }
        else { const int s = item - NITEM_P; b = s >> 3; h = s & 7; c = 0; row0 = MP + b * TS; nvalid = TS; sample = true; }
        unsigned char* ib = ws + WS_R1 + (size_t)item * ITEM_BYTES;
        float val[8][8];
        float rn[8];
        int tido = tid; asm volatile("" : "+v"(tido));
        const int l16 = tido & 15, grp = tido >> 4, part = grp >> 3, rb = grp & 7;
        const int lane = tido & 63, fr = lane & 15, fq = lane >> 4;
        if (tid < 384) {
            const int ch = part * 1024 + h * 128 + 8 * l16;
            float wv[4][8];
#pragma unroll
            for (int t = 0; t < 4; ++t) {
                const f32x4 a = *(const f32x4*)(convw + t * 3072 + ch), bb = *(const f32x4*)(convw + t * 3072 + ch + 4);
                wv[t][0] = a[0]; wv[t][1] = a[1]; wv[t][2] = a[2]; wv[t][3] = a[3]; wv[t][4] = bb[0]; wv[t][5] = bb[1]; wv[t][6] = bb[2]; wv[t][7] = bb[3];
            }
            float win[4][8];
#pragma unroll
            for (int t = 0; t < 4; ++t)
#pragma unroll
                for (int e = 0; e < 8; ++e) win[t][e] = 0.f;
#pragma unroll
            for (int k = 0; k < 11; ++k) {
                const int lr = 8 * rb - 3 + k;
                float in8[8];
                {
                    const bool use_proj = (lr >= 0 && lr < nvalid) || (lr < 0 && !sample && c > 0);
                    const int lrc = use_proj ? lr : 0;
                    const u32x4 v = *(const u32x4*)(proj + (size_t)(row0 + lrc) * NPROJ + ch);
                    unpack8(v, in8);
                    if (!use_proj) {
#pragma unroll
                        for (int e = 0; e < 8; ++e) in8[e] = 0.f;
                    }
                }
                if (k < 3) {
                    if (sample && lr < 0) {
                        const float* sp = cconv + (size_t)(b * 3 + (3 + lr)) * 3072 + ch;
                        const f32x4 a = *(const f32x4*)sp, bb = *(const f32x4*)(sp + 4);
                        in8[0] = a[0]; in8[1] = a[1]; in8[2] = a[2]; in8[3] = a[3]; in8[4] = bb[0]; in8[5] = bb[1]; in8[6] = bb[2]; in8[7] = bb[3];
                    }
                }
#pragma unroll
                for (int e = 0; e < 8; ++e) { win[0][e] = win[1][e]; win[1][e] = win[2][e]; win[2][e] = win[3][e]; win[3][e] = in8[e]; }
                if (k >= 3) {
                    const bool rv = (lr < nvalid);
                    float ss = 0.f;
#pragma unroll
                    for (int e = 0; e < 8; ++e) {
                        const float y = win[0][e] * wv[0][e] + win[1][e] * wv[1][e] + win[2][e] * wv[2][e] + win[3][e] * wv[3][e];
                        const float s = rv ? siluf(y) : 0.f;
                        val[k - 3][e] = s; ss += s * s;
                    }
                    ss = row_sum16(ss);
                    rn[k - 3] = __builtin_amdgcn_rsqf(ss + 1e-6f);
                }
            }
        } else if (wid == 7) {
            const int r = row0 + (lane < nvalid ? lane : 0);
            const bool valid = lane < nvalid;
            const float a = AB[(size_t)r * 16 + h], bb = AB[(size_t)r * 16 + 8 + h];
            const float xa = a + P.in[15][j * 8 + h];
            const float ey = __expf(-fabsf(xa));
            const float lp = (ey < 0.01f) ? ey * (1.f - ey * (0.5f - ey * 0.33333334f)) : __logf(1.f + ey);
            const float sp = fmaxf(xa, 0.f) + lp;
            float g = valid ? -__expf(P.in[14][j * 8 + h]) * sp : 0.f;
            const float beta = valid ? __builtin_amdgcn_rcpf(1.f + __expf(-bb)) : 0.f;
#pragma unroll
            for (int o = 1; o < 64; o <<= 1) { const float t = __shfl_up(g, o); if (lane >= o) g += t; }
            const float glast = readlane_f(g, 63);
            Gs[lane] = g; Gs[64 + lane] = beta; Gs[128 + lane] = __expf(g); Gs[192 + lane] = __expf(glast - g);
            if (lane == 0) GL[item] = __expf(glast);
        }
        __syncthreads();
        if (tid < 384) {
#pragma unroll
            for (int rr = 0; rr < 8; ++rr) {
                const int row = 8 * rb + rr;
                const float beta = Gs[64 + row], eG = Gs[128 + row];
                if (part == 0) {
                    const float sc = rn[rr] * 0.08838834764831845f;
                    float q[8];
#pragma unroll
                    for (int e = 0; e < 8; ++e) q[e] = val[rr][e] * sc;
                    u32x4 w; w.x = pk2(q[0], q[1]); w.y = pk2(q[2], q[3]); w.z = pk2(q[4], q[5]); w.w = pk2(q[6], q[7]);
                    *(LAS u32x4*)(Qs + row * 272 + l16 * 16) = w;
                    bf16_t* qg = (bf16_t*)(ib + 49152) + row * 128;
                    u32x2 g0, g1; g0.x = pk2(q[0] * eG, q[1] * eG); g0.y = pk2(q[2] * eG, q[3] * eG); g1.x = pk2(q[4] * eG, q[5] * eG); g1.y = pk2(q[6] * eG, q[7] * eG);
                    *(u32x2*)(qg + ppos(8 * l16)) = g0; *(u32x2*)(qg + ppos(8 * l16 + 4)) = g1;
                    val[rr][0] = 0.f;
                } else if (part == 1) {
#pragma unroll
                    for (int e = 0; e < 8; ++e) val[rr][e] *= rn[rr];
                    u32x4 w; w.x = pk2(val[rr][0], val[rr][1]); w.y = pk2(val[rr][2], val[rr][3]); w.z = pk2(val[rr][4], val[rr][5]); w.w = pk2(val[rr][6], val[rr][7]);
                    *(LAS u32x4*)(Ks + row * 272 + l16 * 16) = w;
                }
            }
            if (part >= 1) {
                float bsc[8], ksc[8];
#pragma unroll
                for (int rr = 0; rr < 8; ++rr) { const int row = 8 * rb + rr; const float beta = Gs[64 + row]; bsc[rr] = (part == 1) ? beta * Gs[128 + row] : beta; ksc[rr] = Gs[192 + row]; }
                LAS unsigned char* Tt = (part == 1) ? KBt : VBt;
#pragma unroll
                for (int e = 0; e < 8; ++e) {
                    const int dch = 8 * l16 + e;
                    u32x4 w; w.x = pk2(val[0][e] * bsc[0], val[1][e] * bsc[1]); w.y = pk2(val[2][e] * bsc[2], val[3][e] * bsc[3]);
                    w.z = pk2(val[4][e] * bsc[4], val[5][e] * bsc[5]); w.w = pk2(val[6][e] * bsc[6], val[7][e] * bsc[7]);
                    *(LAS u32x4*)(Tt + dch * 144 + rb * 16) = w;
                    if (part == 1) {
                        bf16_t* kd = (bf16_t*)(ib + 65536) + dch * 64;
                        u32x2 k0, k1; k0.x = pk2(val[0][e] * ksc[0], val[1][e] * ksc[1]); k0.y = pk2(val[2][e] * ksc[2], val[3][e] * ksc[3]);
                        k1.x = pk2(val[4][e] * ksc[4], val[5][e] * ksc[5]); k1.y = pk2(val[6][e] * ksc[6], val[7][e] * ksc[7]);
                        *(u32x2*)(kd + ppos(8 * rb)) = k0; *(u32x2*)(kd + ppos(8 * rb + 4)) = k1;
                    }
                }
            }
        }
        __syncthreads();
        {
            const int mt = wid & 3; const bool isqk = wid >= 4;
            LAS unsigned char* As = isqk ? Qs : Ks;
            f32x4 acc[4];
#pragma unroll
            for (int nt = 0; nt < 4; ++nt) acc[nt] = (f32x4){0.f, 0.f, 0.f, 0.f};
#pragma unroll
            for (int ks = 0; ks < 4; ++ks) {
                const bf16x8 a = *(const LAS bf16x8*)(As + (16 * mt + fr) * 272 + (32 * ks + 8 * fq) * 2);
#pragma unroll
                for (int nt = 0; nt < 4; ++nt) {
                    const bf16x8 bfr = *(const LAS bf16x8*)(Ks + (16 * nt + fr) * 272 + (32 * ks + 8 * fq) * 2);
                    acc[nt] = MFMA16(a, bfr, acc[nt]);
                }
            }
#pragma unroll
            for (int nt = 0; nt < 4; ++nt) {
                const int cp = 16 * nt + fr; const float Gc2 = Gs[cp];
#pragma unroll
                for (int i = 0; i < 4; ++i) {
                    const int cr = 16 * mt + 4 * fq + i;
                    const float dec = __expf(Gs[cr] - Gc2);
                    if (!isqk) A32[cr * 65 + cp] = (cr > cp) ? Gs[64 + cr] * acc[nt][i] * dec : 0.f;
                    else *(LAS bf16_t*)(QKs + (cr * 64 + ppos(cp)) * 2) = f2bf((cr >= cp) ? acc[nt][i] * dec : 0.f);
                }
            }
        }
        __syncthreads();
        {
            float a[64];
#pragma unroll
            for (int jj = 0; jj < 64; ++jj) a[jj] = A32[lane * 65 + jj];
            float x[8];
#pragma unroll
            for (int cc = 0; cc < 8; ++cc) x[cc] = (lane == 8 * wid + cc) ? 1.f : 0.f;
#pragma unroll
            for (int jj = 0; jj < 64; ++jj) {
                if (jj >= 8 * wid) {
#pragma unroll
                    for (int cc = 0; cc < 8; ++cc) { const float xj = readlane_f(x[cc], jj); x[cc] -= a[jj] * xj; }
                }
            }
            u32x4 w; w.x = pk2(x[0], x[1]); w.y = pk2(x[2], x[3]); w.z = pk2(x[4], x[5]); w.w = pk2(x[6], x[7]);
            *(LAS u32x4*)(Ts + lane * 144 + wid * 16) = w;
            *(u32x4*)(ib + 81920 + tid * 16) = *(const LAS u32x4*)(QKs + tid * 16);
        }
        __syncthreads();
        {
            const bool isw = wid >= 4; const int n0 = 32 * (wid & 3);
            LAS unsigned char* Bs = isw ? KBt : VBt;
            f32x4 acc[4][2];
#pragma unroll
            for (int mt = 0; mt < 4; ++mt) { acc[mt][0] = (f32x4){0.f, 0.f, 0.f, 0.f}; acc[mt][1] = (f32x4){0.f, 0.f, 0.f, 0.f}; }
#pragma unroll
            for (int ks = 0; ks < 2; ++ks) {
                bf16x8 bfr[2];
#pragma unroll
                for (int nn = 0; nn < 2; ++nn) bfr[nn] = *(const LAS bf16x8*)(Bs + (n0 + 16 * nn + fr) * 144 + (32 * ks + 8 * fq) * 2);
#pragma unroll
                for (int mt = 0; mt < 4; ++mt) {
                    const bf16x8 a = *(const LAS bf16x8*)(Ts + (16 * mt + fr) * 144 + (32 * ks + 8 * fq) * 2);
                    acc[mt][0] = MFMA16(a, bfr[0], acc[mt][0]); acc[mt][1] = MFMA16(a, bfr[1], acc[mt][1]);
                }
            }
            if (!isw) {
                float* U = (float*)ib;
#pragma unroll
                for (int mt = 0; mt < 4; ++mt)
#pragma unroll
                    for (int nn = 0; nn < 2; ++nn)
#pragma unroll
                        for (int i = 0; i < 4; ++i) U[(16 * mt + 4 * fq + i) * 128 + n0 + 16 * nn + fr] = acc[mt][nn][i];
            } else {
#pragma unroll
                for (int mt = 0; mt < 4; ++mt)
#pragma unroll
                    for (int nn = 0; nn < 2; ++nn)
#pragma unroll
                        for (int i = 0; i < 4; ++i) *(LAS bf16_t*)(Qs + ((16 * mt + 4 * fq + i) * 128 + ppos(n0 + 16 * nn + fr)) * 2) = f2bf(acc[mt][nn][i]);
            }
        }
        __syncthreads();
        {
            *(u32x4*)(ib + 32768 + tid * 16) = *(const LAS u32x4*)(Qs + tid * 16);
            *(u32x4*)(ib + 32768 + 8192 + tid * 16) = *(const LAS u32x4*)(Qs + 8192 + tid * 16);
        }
        __syncthreads();
    }
}

DI void phase_scan(const Params& P, LAS unsigned char* lds, int layer) {
    int tid_ = threadIdx.x; asm volatile("" : "+v"(tid_)); const int tid = tid_, wid = __builtin_amdgcn_readfirstlane(tid >> 6), lane = tid & 63, G = gridDim.x;
    const int fr = lane & 15, fq = lane >> 4;
    unsigned char* ws = P.ws;
    const int j = layer >> 1;
    const bf16_t* proj = (const bf16_t*)(ws + WS_PROJ);
    const float* GL = (const float*)(ws + WS_GL);
    bf16_t* ORAW = (bf16_t*)(ws + WS_ORAWB);
    constexpr int BUFB = 57344;
    LAS float* red = (LAS float*)(lds + 2 * BUFB);

    for (int seq = blockIdx.x; seq < 160; seq += G) {
        int b, h, nch, item0, row0, nvalid; float* stout;
        f32x4 st[8];
        const int dvc = 16 * wid + fr;
        if (seq < 32) {
            b = seq >> 3; h = seq & 7; nch = 128; item0 = seq * 128; row0 = b * TP; nvalid = 64;
            stout = P.out + OFF_STP + ((size_t)(j * 4 + b) * 8 + h) * 16384;
#pragma unroll
            for (int mt = 0; mt < 8; ++mt) st[mt] = (f32x4){0.f, 0.f, 0.f, 0.f};
        } else {
            const int s = seq - 32; b = s >> 3; h = s & 7; nch = 1; item0 = NITEM_P + s; row0 = MP + b * TS; nvalid = TS;
            stout = P.out + OFF_STS + ((size_t)(j * 16 + b) * 8 + h) * 16384;
            const float* s0 = P.in[4] + ((size_t)(j * 16 + b) * 8 + h) * 16384;
            const unsigned s0o = (unsigned)(4 * fq * 128 + dvc);
#pragma unroll
            for (int mt = 0; mt < 8; ++mt)
#pragma unroll
                for (int i = 0; i < 4; ++i) st[mt][i] = s0[(unsigned)((16 * mt + i) * 128) + s0o];
        }
        const float onw = P.in[16][j * 128 + dvc];
        f32x4 un[4];
#define SCAN_G2L(itm, bufi, LN) do { const unsigned char* _ib = ws + WS_R1 + (size_t)(itm) * ITEM_BYTES + 32768; \
            _Pragma("unroll") for (int _p = 0; _p < 7; ++_p) { const int _L = (wid + 8 * _p) * 1024 + (LN) * 16; unsigned _src; \
                if (_p < 4) { const int _row = _L >> 8, _ch = (_L >> 4) & 15; _src = (_L & ~255) + ((_ch ^ (_row & 15)) << 4); } \
                else { const int _a = _L - 32768, _row = _a >> 7, _ch = (_a >> 4) & 7; _src = 32768 + (_a & ~127) + ((_ch ^ ((_row >> 1) & 7)) << 4); } \
                g2l16(_ib + _src, lds_u32(lds + (bufi) * BUFB + (wid + 8 * _p) * 1024)); } } while (0)
#define SCAN_LOADU(itm) do { const float* _u = (const float*)(ws + WS_R1 + (size_t)(itm) * ITEM_BYTES); const unsigned _uo = (unsigned)(4 * fq * 128 + 16 * wid + fr); \
            _Pragma("unroll") for (int _m = 0; _m < 4; ++_m) _Pragma("unroll") for (int _i = 0; _i < 4; ++_i) un[_m][_i] = _u[(unsigned)((16 * _m + _i) * 128) + _uo]; } while (0)
        __syncthreads();
        SCAN_G2L(item0, 0, lane);
        SCAN_LOADU(item0);
        float gln = GL[item0];
        asm volatile("s_waitcnt vmcnt(0)" ::: "memory");
        __syncthreads();
        for (int c = 0; c < nch; ++c) {
            int frq = lane; asm volatile("" : "+v"(frq));
            const int fr = frq & 15, fq = frq >> 4;
            LAS unsigned char* bb = lds + (c & 1) * BUFB;
            const float gl = gln;
            f32x4 u[4];
#pragma unroll
            for (int mt = 0; mt < 4; ++mt) u[mt] = un[mt];
            if (c + 1 < nch) { gln = GL[item0 + c + 1]; SCAN_G2L(item0 + c + 1, (c + 1) & 1, frq); }
            const int x16 = fr << 4, x8 = ((fr >> 1) & 7) << 4;
            bf16x8 sf[4];
#pragma unroll
            for (int ks = 0; ks < 4; ++ks) {
                u32x4 w; w.x = pk2(-st[2 * ks][0], -st[2 * ks][1]); w.y = pk2(-st[2 * ks][2], -st[2 * ks][3]); w.z = pk2(-st[2 * ks + 1][0], -st[2 * ks + 1][1]); w.w = pk2(-st[2 * ks + 1][2], -st[2 * ks + 1][3]);
                sf[ks] = __builtin_bit_cast(bf16x8, w);
            }
            bf16x8 fa[4], fb[4];
#define SC_LD256(dst, base, mt) do { _Pragma("unroll") for (int _k = 0; _k < 4; ++_k) \
                dst[_k] = *(const LAS bf16x8*)(bb + (base) + (16 * (mt) + fr) * 256 + ((((4 * _k + fq) << 4)) ^ x16)); } while (0)
#define SC_LD128(dst, base, mtlo) do { _Pragma("unroll") for (int _m = 0; _m < 2; ++_m) _Pragma("unroll") for (int _k = 0; _k < 2; ++_k) \
                dst[_m * 2 + _k] = *(const LAS bf16x8*)(bb + (base) + (16 * ((mtlo) + _m) + fr) * 128 + ((((4 * _k + fq) << 4)) ^ x8)); } while (0)
#define SC_SB __builtin_amdgcn_sched_barrier(0)
#define SC_MU(f, mt) do { _Pragma("unroll") for (int _k = 0; _k < 4; ++_k) u[mt] = MFMA16(f[_k], sf[_k], u[mt]); } while (0)
#define SC_MO(f, mt) do { _Pragma("unroll") for (int _k = 0; _k < 4; ++_k) o[mt] = MFMA16(f[_k], sf[_k], o[mt]); } while (0)
#define SC_MQK(f, mtlo) do { _Pragma("unroll") for (int _m = 0; _m < 2; ++_m) _Pragma("unroll") for (int _k = 0; _k < 2; ++_k) o[(mtlo) + _m] = MFMA16(f[_m * 2 + _k], uf[_k], o[(mtlo) + _m]); } while (0)
#define SC_MKD(f, mtlo) do { _Pragma("unroll") for (int _m = 0; _m < 2; ++_m) { st[(mtlo) + _m] = st[(mtlo) + _m] * gl; _Pragma("unroll") for (int _k = 0; _k < 2; ++_k) st[(mtlo) + _m] = MFMA16(f[_m * 2 + _k], uf[_k], st[(mtlo) + _m]); } } while (0)
            f32x4 o[4];
#pragma unroll
            for (int mt = 0; mt < 4; ++mt) o[mt] = (f32x4){0.f, 0.f, 0.f, 0.f};
            SC_LD256(fa, 0, 0); SC_LD256(fb, 0, 1); SC_SB;
            SC_MU(fa, 0); SC_LD256(fa, 0, 2); SC_SB;
            SC_MU(fb, 1); SC_LD256(fb, 0, 3); SC_SB;
            SC_MU(fa, 2); SC_LD256(fa, 16384, 0); SC_SB;
            SC_MU(fb, 3); SC_LD256(fb, 16384, 1); SC_SB;
#pragma unroll
            for (int ks = 0; ks < 4; ++ks) sf[ks] = sf[ks] ^ (short)0x8000;
            SC_MO(fa, 0); SC_LD256(fa, 16384, 2); SC_SB;
            SC_MO(fb, 1); SC_LD256(fb, 16384, 3); SC_SB;
            SC_MO(fa, 2); SC_LD128(fa, 49152, 0); SC_SB;
            SC_MO(fb, 3); SC_LD128(fb, 49152, 2); SC_SB;
            bf16x8 uf[2];
#pragma unroll
            for (int k2 = 0; k2 < 2; ++k2) {
                u32x4 w; w.x = pk2(u[2 * k2][0], u[2 * k2][1]); w.y = pk2(u[2 * k2][2], u[2 * k2][3]); w.z = pk2(u[2 * k2 + 1][0], u[2 * k2 + 1][1]); w.w = pk2(u[2 * k2 + 1][2], u[2 * k2 + 1][3]);
                uf[k2] = __builtin_bit_cast(bf16x8, w);
            }
            SC_MQK(fa, 0); SC_LD128(fa, 32768, 0); SC_SB;
            SC_MQK(fb, 2); SC_LD128(fb, 32768, 2); SC_SB;
            SC_MKD(fa, 0); SC_LD128(fa, 32768, 4); SC_SB;
            SC_MKD(fb, 2); SC_LD128(fb, 32768, 6); SC_SB;
            SC_MKD(fa, 4); SC_SB;
            SC_MKD(fb, 6);
#undef SC_MU
#undef SC_MO
#undef SC_MQK
#undef SC_MKD
#undef SC_LD256
#undef SC_LD128
#undef SC_SB
            if (c + 1 < nch) SCAN_LOADU(item0 + c + 1);
            {
                bf16_t* obb = ORAW + (size_t)(row0 + 64 * c) * 1024 + h * 128;
                const unsigned oo = (unsigned)(4 * fq * 1024 + 16 * wid + fr);
#pragma unroll
                for (int mt = 0; mt < 4; ++mt)
#pragma unroll
                    for (int i = 0; i < 4; ++i) {
                        const int lr = 16 * mt + 4 * fq + i;
                        const bf16_t ob = f2bf(o[mt][i]);
                        if (lr < nvalid) obb[(unsigned)((16 * mt + i) * 1024) + oo] = ob;
                    }
            }
            asm volatile("s_waitcnt vmcnt(0)" ::: "memory");
            __syncthreads();
        }
        {
            int lz = lane; asm volatile("" : "+v"(lz));
            const unsigned so = (unsigned)(4 * (lz >> 4) * 128 + 16 * wid + (lz & 15));
#pragma unroll
            for (int mt = 0; mt < 8; ++mt)
#pragma unroll
                for (int i = 0; i < 4; ++i) stout[(unsigned)((16 * mt + i) * 128) + so] = st[mt][i];
        }
#undef SCAN_G2L
#undef SCAN_LOADU
    }
}

DI void phase_gnorm(const Params& P, int layer) {
    int tid_ = threadIdx.x; asm volatile("" : "+v"(tid_)); const int tid = tid_, wid = __builtin_amdgcn_readfirstlane(tid >> 6), lane = tid & 63, G = gridDim.x;
    unsigned char* ws = P.ws;
    const int j = layer >> 1;
    const bf16_t* ORAW = (const bf16_t*)(ws + WS_ORAWB);
    const bf16_t* proj = (const bf16_t*)(ws + WS_PROJ);
    bf16_t* OB = (bf16_t*)(ws + WS_HBUF);
    float onw[16];
#pragma unroll
    for (int e = 0; e < 16; ++e) onw[e] = P.in[16][j * 128 + ((16 * lane + e) & 127)];
    for (int r = blockIdx.x * 8 + wid; r < M; r += G * 8) {
        const u32x4 o0 = *(const u32x4*)(ORAW + (size_t)r * 1024 + 16 * lane), o1 = *(const u32x4*)(ORAW + (size_t)r * 1024 + 16 * lane + 8);
        const u32x4 z0 = *(const u32x4*)(proj + (size_t)r * NPROJ + 3072 + 16 * lane), z1 = *(const u32x4*)(proj + (size_t)r * NPROJ + 3072 + 16 * lane + 8);
        float ov[16], zv[16];
        { float t8[8]; unpack8(o0, t8);
#pragma unroll
          for (int e = 0; e < 8; ++e) ov[e] = t8[e];
          unpack8(o1, t8);
#pragma unroll
          for (int e = 0; e < 8; ++e) ov[8 + e] = t8[e];
          unpack8(z0, t8);
#pragma unroll
          for (int e = 0; e < 8; ++e) zv[e] = t8[e];
          unpack8(z1, t8);
#pragma unroll
          for (int e = 0; e < 8; ++e) zv[8 + e] = t8[e]; }
        float ss = 0.f;
#pragma unroll
        for (int e = 0; e < 16; ++e) ss += ov[e] * ov[e];
        ss += __shfl_xor(ss, 1); ss += __shfl_xor(ss, 2); ss += __shfl_xor(ss, 4);
        const float rstd = __builtin_amdgcn_rsqf(ss * (1.f / 128.f) + RMS_EPS);
        float y[16];
#pragma unroll
        for (int e = 0; e < 16; ++e) y[e] = ov[e] * rstd * onw[e] * siluf(zv[e]);
        u32x4 w0, w1;
        w0.x = pk2(y[0], y[1]); w0.y = pk2(y[2], y[3]); w0.z = pk2(y[4], y[5]); w0.w = pk2(y[6], y[7]);
        w1.x = pk2(y[8], y[9]); w1.y = pk2(y[10], y[11]); w1.z = pk2(y[12], y[13]); w1.w = pk2(y[14], y[15]);
        *(u32x4*)(OB + (size_t)r * 1024 + 16 * lane) = w0; *(u32x4*)(OB + (size_t)r * 1024 + 16 * lane + 8) = w1;
    }
}

DI void att_s(LAS unsigned char* Ka, int t, const bf16x8 (&qf)[4], f32x16& s0, f32x16& s1) {
#pragma unroll
    for (int i = 0; i < 16; ++i) { s0[i] = 0.f; s1[i] = 0.f; }
    bf16x8 kf[8];
#pragma unroll
    for (int s = 0; s < 4; ++s) { kf[2 * s] = *(const LAS bf16x8*)(Ka + (t ^ (s << 5))); kf[2 * s + 1] = *(const LAS bf16x8*)(Ka + 8192 + (t ^ (s << 5))); }
#pragma unroll
    for (int s = 0; s < 4; ++s) { s0 = MFMA32(kf[2 * s], qf[s], s0); s1 = MFMA32(kf[2 * s + 1], qf[s], s1); }
}
template <bool MASK>
DI float att_softmax(f32x16& s0, f32x16& s1, float& m, float& l, bf16x8 (&pf)[2][2], int h2, int nvk) {
    if (MASK) {
#pragma unroll
        for (int i = 0; i < 16; ++i) {
            const int key = (i & 3) + 8 * (i >> 2) + 4 * h2;
            s0[i] = (key < nvk) ? s0[i] : -INFINITY;
            s1[i] = (32 + key < nvk) ? s1[i] : -INFINITY;
        }
    }
    float mx = s0[0];
#pragma unroll
    for (int i = 1; i < 16; ++i) mx = fmaxf(mx, s0[i]);
#pragma unroll
    for (int i = 0; i < 16; ++i) mx = fmaxf(mx, s1[i]);
    mx = fmaxf(mx, __shfl_xor(mx, 32));
    const float mn = fmaxf(m, mx);
    const float alpha = __builtin_amdgcn_exp2f(m - mn);
    m = mn;
    float ps = 0.f;
#pragma unroll
    for (int i = 0; i < 16; ++i) { s0[i] = __builtin_amdgcn_exp2f(s0[i] - mn); s1[i] = __builtin_amdgcn_exp2f(s1[i] - mn); ps += s0[i] + s1[i]; }
    l = l * alpha + ps;
    u32x4 w;
    w.x = pk2(s0[0], s0[1]); w.y = pk2(s0[2], s0[3]); w.z = pk2(s0[4], s0[5]); w.w = pk2(s0[6], s0[7]); pf[0][0] = __builtin_bit_cast(bf16x8, w);
    w.x = pk2(s0[8], s0[9]); w.y = pk2(s0[10], s0[11]); w.z = pk2(s0[12], s0[13]); w.w = pk2(s0[14], s0[15]); pf[0][1] = __builtin_bit_cast(bf16x8, w);
    w.x = pk2(s1[0], s1[1]); w.y = pk2(s1[2], s1[3]); w.z = pk2(s1[4], s1[5]); w.w = pk2(s1[6], s1[7]); pf[1][0] = __builtin_bit_cast(bf16x8, w);
    w.x = pk2(s1[8], s1[9]); w.y = pk2(s1[10], s1[11]); w.z = pk2(s1[12], s1[13]); w.w = pk2(s1[14], s1[15]); pf[1][1] = __builtin_bit_cast(bf16x8, w);
    return alpha;
}
DI void att_pv(LAS unsigned char* Va, int q4, f32x16 (&O)[4], const bf16x8 (&pf)[2][2]) {
    s16x4 lo[16], hi[16];
#define PV_LD(i) do { LAS unsigned char* _vp = Va + ((((i) >> 2) ^ q4) << 6) + (32 * (((i) >> 1) & 1) + 16 * ((i) & 1)) * 256; \
        lo[i] = __builtin_amdgcn_ds_read_tr16_b64_v4i16((LAS s16x4*)_vp); hi[i] = __builtin_amdgcn_ds_read_tr16_b64_v4i16((LAS s16x4*)(_vp + 8 * 256)); } while (0)
    PV_LD(0); PV_LD(1); PV_LD(2);
#pragma unroll
    for (int i = 0; i < 16; ++i) {
        if (i + 3 < 16) PV_LD(i + 3);
        const bf16x8 vf = __builtin_shufflevector(lo[i], hi[i], 0, 1, 2, 3, 4, 5, 6, 7);
        O[i >> 2] = MFMA32(vf, pf[(i >> 1) & 1][i & 1], O[i >> 2]);
    }
#undef PV_LD
}

DI void phase_attn(const Params& P, LAS unsigned char* lds, int layer) {
    int tid_ = threadIdx.x; asm volatile("" : "+v"(tid_)); const int tid = tid_, wid = __builtin_amdgcn_readfirstlane(tid >> 6), lane = tid & 63, G = gridDim.x;
    unsigned char* ws = P.ws;
    const int j = layer >> 1;
    const int comp = wid >> 2, rg = wid & 3, r32 = lane & 31, h2 = lane >> 5;
    const bf16_t* proj = (const bf16_t*)(ws + WS_PROJ);
    bf16_t* OB = (bf16_t*)(ws + WS_HBUF);
    const float lam_init = 0.8f - 0.6f * expf(-0.3f * (float)layer);
    float lam;
    {
        float d1 = 0.f, d2 = 0.f;
        for (int i = 0; i < 64; ++i) { d1 += P.in[19][j * 64 + i] * P.in[20][j * 64 + i]; d2 += P.in[21][j * 64 + i] * P.in[22][j * 64 + i]; }
        lam = expf(d1) - expf(d2) + lam_init;
    }
    const float* subln = P.in[23] + j * 128;
    constexpr int TB = 32768;
    const int vb = (G % 8 == 0) ? (blockIdx.x % 8) * (G / 8) + blockIdx.x / 8 : blockIdx.x;
    const int nrounds = (G == 256) ? 9 : (2176 + G - 1) / G;
#define ATT_WAITV(n) asm volatile("s_waitcnt vmcnt(" #n ")" ::: "memory")
#define ATT_BAR() do { asm volatile("" ::: "memory"); __builtin_amdgcn_s_barrier(); asm volatile("" ::: "memory"); } while (0)
    for (int k = 0; k < nrounds; ++k) {
        int id;
        if (G == 256) {
            if (k < 8) { const int xcd = vb >> 5, idx = vb & 31; const int seq = xcd * 4 + (k >> 1); const int qt = (k & 1) ? idx : (63 - idx); id = seq * 64 + qt; }
            else { if (vb >= 128) break; id = 2048 + vb; }
        } else { id = vb + k * G; if (id >= 2176) break; }
        int h, qrow0, nt_all, nt_mine, last_valid; const int kvstride = 128; const bf16_t* Kp; const bf16_t* Vp; bool sample;
        if (id < 2048) {
            const int seq = id >> 6, qt = id & 63, b = seq >> 3; h = seq & 7; sample = false;
            qrow0 = b * TP + 128 * qt + 32 * rg; nt_all = 2 * qt + 2; nt_mine = (rg < 2) ? 2 * qt + 1 : 2 * qt + 2; last_valid = 64 * nt_mine;
            Kp = (const bf16_t*)(ws + WS_KH) + (size_t)seq * TP * 128; Vp = (const bf16_t*)(ws + WS_VH) + (size_t)seq * TP * 128;
        } else {
            const int s = id - 2048, b = s >> 3; h = s & 7; sample = true;
            qrow0 = MP + b * TS; nt_all = 34; nt_mine = (rg == 0) ? 34 : 0; last_valid = PAST + TS;
            Kp = (const bf16_t*)(ws + WS_KS) + (size_t)s * KSROWS * 128; Vp = (const bf16_t*)(ws + WS_VS) + (size_t)s * KSROWS * 128;
        }
        bf16x8 qf[4];
        {
            const int qr = qrow0 + (sample ? (r32 & 15) : r32);
            const bf16_t* qp = proj + (size_t)qr * NPROJ + h * 128 + comp * 64 + 8 * h2;
#pragma unroll
            for (int s = 0; s < 4; ++s) qf[s] = *(const bf16x8*)(qp + 16 * s);
        }
        f32x16 O[4];
#pragma unroll
        for (int et = 0; et < 4; ++et)
#pragma unroll
            for (int i = 0; i < 16; ++i) O[et][i] = 0.f;
        float m = -INFINITY, l = 0.f;
        bf16x8 pf[2][2];
#pragma unroll
        for (int a = 0; a < 2; ++a)
#pragma unroll
            for (int c2 = 0; c2 < 2; ++c2) pf[a][c2] = (bf16x8){0, 0, 0, 0, 0, 0, 0, 0};
        f32x16 sA0, sA1, sB0, sB1;
        const bf16_t* gsrc;
        {
            const int rowl = lane >> 4, c = lane & 15;
            const int row0 = 16 * (wid & 3) + rowl;
            const int lc = (wid < 4) ? (c ^ (row0 & 15)) : (c ^ ((row0 & 3) << 2));
            gsrc = ((wid < 4) ? Kp : Vp) + (size_t)row0 * kvstride + lc * 8;
        }
#define ATT_G2L(kt, bufi) do { _Pragma("unroll") for (int _i = 0; _i < 4; ++_i) { \
            const bf16_t* _s = gsrc + (size_t)(64 * (kt) + 4 * _i) * kvstride; \
            if (wid < 4) _s += (((lane & 15) ^ ((16 * (wid & 3) + 4 * _i + (lane >> 4)) & 15)) - ((lane & 15) ^ ((16 * (wid & 3) + (lane >> 4)) & 15))) * 8; \
            g2l16(_s, lds_u32(lds + (bufi) * TB + (4 * wid + _i) * 1024)); } } while (0)
        asm volatile("" :: "v"(qf[0]), "v"(qf[1]), "v"(qf[2]), "v"(qf[3]));
        __syncthreads();
        ATT_G2L(0, 0);
        if (nt_all > 1) { ATT_G2L(1, 1); ATT_WAITV(4); } else { ATT_WAITV(0); }
        ATT_BAR();
        {
            const int koff = r32 * 256, t = ((comp * 8 + h2) ^ (r32 & 15)) << 4;
            att_s(lds + koff, t, qf, sA0, sA1);
        }
#define ATT_ITER(KT, sC0, sC1, sN0, sN1, EDGE) do { \
            const int kt = (KT); \
            int lo_ = lane; asm volatile("" : "+v"(lo_)); \
            const int r32_ = lo_ & 31, h2_ = lo_ >> 5, q4_ = (lo_ & 15) >> 2, p4_ = lo_ & 3, blk_ = (lo_ >> 4) & 1; \
            const int koff_ = r32_ * 256, t_ = ((comp * 8 + h2_) ^ (r32_ & 15)) << 4; \
            const int voff_ = (4 * h2_ + q4_) * 256 + (2 * blk_ + (p4_ >> 1)) * 16 + (p4_ & 1) * 8; \
            ATT_WAITV(0); ATT_BAR(); \
            if (kt + 2 < nt_all) ATT_G2L(kt + 2, (kt + 2) & 3); \
            att_s(lds + ((kt + 1) & 3) * TB + koff_, t_, qf, sN0, sN1); \
            if (!(EDGE) || kt >= 1) att_pv(lds + ((kt - 1) & 3) * TB + 16384 + voff_, q4_, O, pf); \
            const float alpha = att_softmax<EDGE>(sC0, sC1, m, l, pf, h2_, last_valid - 64 * kt); \
            asm volatile("" :: "v"(l), "v"(pf[0][0]), "v"(pf[0][1]), "v"(pf[1][0]), "v"(pf[1][1]));     \
            _Pragma("unroll") for (int _g = 0; _g < 24; ++_g) { __builtin_amdgcn_sched_group_barrier(0x008, 1, 0); __builtin_amdgcn_sched_group_barrier(0x002, 7, 0); } \
            if (__any(alpha != 1.f)) { \
                _Pragma("unroll") for (int et = 0; et < 4; ++et) _Pragma("unroll") for (int i = 0; i < 16; ++i) O[et][i] *= alpha; } \
            } while (0)
        {
            const int npairs = nt_all >> 1;
            ATT_ITER(0, sA0, sA1, sB0, sB1, true);
            ATT_ITER(1, sB0, sB1, sA0, sA1, true);
            for (int pp = 1; pp < npairs - 1; ++pp) {
                ATT_ITER(2 * pp, sA0, sA1, sB0, sB1, false);
                ATT_ITER(2 * pp + 1, sB0, sB1, sA0, sA1, false);
            }
            if (npairs > 1) {
                ATT_ITER(nt_all - 2, sA0, sA1, sB0, sB1, true);
                ATT_ITER(nt_all - 1, sB0, sB1, sA0, sA1, true);
            }
        }
        {
            const int lt = nt_all - 1;
            const int h2b = lane >> 5, q4 = (lane & 15) >> 2, p4 = lane & 3, blk = (lane >> 4) & 1;
            const int voff = (4 * h2b + q4) * 256 + (2 * blk + (p4 >> 1)) * 16 + (p4 & 1) * 8;
            att_pv(lds + (lt & 3) * TB + 16384 + voff, q4, O, pf);
        }
        __syncthreads();
#undef ATT_ITER
#undef ATT_G2L
        const float lt = l + __shfl_xor(l, 32);
        const float inv = (nt_mine > 0) ? 1.f / lt : 0.f;
        LAS float* XO = (LAS float*)lds;
        if (comp == 1) {
            const float sc = inv * lam;
#pragma unroll
            for (int et = 0; et < 4; ++et)
#pragma unroll
                for (int i = 0; i < 16; ++i) XO[(rg * 128 + 32 * et + (i & 3) + 8 * (i >> 2) + 4 * h2) * 32 + r32] = O[et][i] * sc;
        }
        __syncthreads();
        if (comp == 0 && nt_mine > 0) {
            float ss = 0.f;
#pragma unroll
            for (int et = 0; et < 4; ++et)
#pragma unroll
                for (int i = 0; i < 16; ++i) { const float v = O[et][i] * inv - XO[(rg * 128 + 32 * et + (i & 3) + 8 * (i >> 2) + 4 * h2) * 32 + r32]; O[et][i] = v; ss += v * v; }
            ss += __shfl_xor(ss, 32);
            const float rstd = __builtin_amdgcn_rsqf(ss * (1.f / 128.f) + RMS_EPS) * (1.f - lam_init);
            const bool rvalid = sample ? (r32 < TS) : true;
            const int row = qrow0 + r32;
            if (rvalid) {
#pragma unroll
                for (int et = 0; et < 4; ++et)
#pragma unroll
                    for (int g4 = 0; g4 < 4; ++g4) {
                        const int e0 = 32 * et + 8 * g4 + 4 * h2;
                        const u32x2 zz = *(const u32x2*)(proj + (size_t)row * NPROJ + 3072 + h * 128 + e0);
                        const f32x4 sl = *(const f32x4*)(subln + e0);
                        const float z0 = __uint_as_float(zz.x << 16), z1 = __uint_as_float(zz.x & 0xffff0000u), z2 = __uint_as_float(zz.y << 16), z3 = __uint_as_float(zz.y & 0xffff0000u);
                        u32x2 w;
                        w.x = pk2(O[et][4 * g4] * rstd * sl[0] * siluf(z0), O[et][4 * g4 + 1] * rstd * sl[1] * siluf(z1));
                        w.y = pk2(O[et][4 * g4 + 2] * rstd * sl[2] * siluf(z2), O[et][4 * g4 + 3] * rstd * sl[3] * siluf(z3));
                        *(u32x2*)(OB + (size_t)row * 1024 + h * 128 + e0) = w;
                    }
            }
        }
        __syncthreads();
    }
}


#define XB_TMO      128
#define XB_XCNT(j)  (256  + 64 * (j))
#define XB_XSUB(j)  (1280 + 64 * (j))
#define XB_XGEN(j)  (2304 + 64 * (j))
#define XB_TOP      3328
#define XB_TOPGEN   3392
#define XCD_BAR_WORDS 3456
#define XB_SPIN_CAP (1u << 18)
DI unsigned xb_ld(unsigned* p)              { return __hip_atomic_load(p, __ATOMIC_RELAXED, __HIP_MEMORY_SCOPE_AGENT); }
DI unsigned xb_add(unsigned* p, unsigned v) { return __hip_atomic_fetch_add(p, v, __ATOMIC_RELAXED, __HIP_MEMORY_SCOPE_AGENT); }
DI unsigned xb_xcc_id() { return (unsigned)__builtin_amdgcn_s_getreg((3 << 11) | 20) & 0xFu; }
#define XB_SPIN(cond, bar) do { unsigned _sp = 0; while (cond) { __builtin_amdgcn_s_sleep(1); \
    if ((++_sp & 255u) == 0u) { if (xb_ld(&(bar)[XB_TMO])) break; if (_sp > XB_SPIN_CAP) { atomicAdd(&(bar)[XB_TMO], 1u); break; } } } } while (0)
DI void xcd_barrier_complete(unsigned* bar, unsigned x, unsigned& nloc, unsigned& nx) {
    const unsigned G = gridDim.x * gridDim.y * gridDim.z;
    unsigned sum, cnt, mine, sp = 0u;
    for (;;) {
        sum = 0u; cnt = 0u; mine = 0u;
#pragma unroll
        for (unsigned j = 0; j < 16; ++j) { const unsigned c = xb_ld(&bar[XB_XCNT(j)]); sum += c; cnt += (c > 0u) ? 1u : 0u; mine = (j == x) ? c : mine; }
        if (sum == G) break;
        __builtin_amdgcn_s_sleep(1);
        if ((++sp & 255u) == 0u) { if (xb_ld(&bar[XB_TMO])) break; if (sp > XB_SPIN_CAP) { atomicAdd(&bar[XB_TMO], 1u); break; } }
    }
    nloc = mine > 0u ? mine : 1u; nx = cnt > 0u ? cnt : 1u;
}
DI void xcd_barrier(unsigned* bar, volatile LAS unsigned* st) {
    asm volatile("s_waitcnt vmcnt(0)" ::: "memory");
    __syncthreads();
    if (threadIdx.x == 0) {
        const unsigned x = xb_xcc_id();
        __builtin_amdgcn_s_waitcnt(0);
        unsigned nloc = st[0], nx = st[1];
        if (nloc == 0u) { xcd_barrier_complete(bar, x, nloc, nx); st[0] = nloc; st[1] = nx; }
        const unsigned old = xb_add(&bar[XB_XSUB(x)], 1u);
        const unsigned gen = old / nloc;
        if (old + 1u == (gen + 1u) * nloc) {
            __builtin_amdgcn_fence(__ATOMIC_RELEASE, "agent");
            asm volatile("s_waitcnt vmcnt(0)" ::: "memory");
            const unsigned og = xb_add(&bar[XB_TOP], 1u);
            const unsigned tg = og / nx;
            if (og + 1u == (tg + 1u) * nx) xb_add(&bar[XB_TOPGEN], 1u);
            else XB_SPIN(xb_ld(&bar[XB_TOPGEN]) == tg, bar);
            __builtin_amdgcn_fence(__ATOMIC_ACQUIRE, "agent");
            xb_add(&bar[XB_XGEN(x)], 1u);
            asm volatile("s_waitcnt vmcnt(0)" ::: "memory");
        } else {
            XB_SPIN(xb_ld(&bar[XB_XGEN(x)]) == gen, bar);
            __builtin_amdgcn_fence(__ATOMIC_ACQUIRE, "agent");
            asm volatile("s_waitcnt vmcnt(0)" ::: "memory");
        }
    }
    __syncthreads();
}

typedef const __attribute__((address_space(4))) Params* CParP;
#define LOADP() Params P; { CParP kp_ = KP; asm volatile("" : "+s"(kp_)); P = *kp_; } unsigned char* ws = P.ws; (void)ws
__global__ void __launch_bounds__(512, 2) fwd_megakernel(Params Pin) {
#if defined(__HIP_DEVICE_COMPILE__)
    extern __shared__ __attribute__((aligned(16))) unsigned char lds_raw[];
    LAS unsigned char* lds = (LAS unsigned char*)lds_raw;
    cg::grid_group grid = cg::this_grid();
    const CParP KP = (CParP)__builtin_amdgcn_kernarg_segment_ptr();
    volatile LAS unsigned* xst = (volatile LAS unsigned*)(lds + 131072);
    if (threadIdx.x == 0) { xst[0] = 0u; xst[1] = 0u; }
    __syncthreads();
    { LOADP(); if (threadIdx.x == 0) (void)xb_add(&((unsigned*)(ws + WS_BAR))[XB_XCNT(xb_xcc_id())], 1u); }
#define GRID_BAR() do { LOADP(); xcd_barrier((unsigned*)(ws + WS_BAR), xst); } while (0)
    { LOADP(); phase_prep(P, lds); }
    grid.sync();
    for (int layer = 0; layer < 4; ++layer) {
        const int j = layer >> 1;
        { LOADP(); phase_elem(P, lds, layer); }
        GRID_BAR();
        {
            LOADP();
            pg8::StaticOrder S; S.init(M, NPROJ, gridDim.x, blockIdx.x);
            pg8::Gemm g;
            g.A = (const bf16_t*)(ws + WS_HBUF); g.M = M; g.N = NPROJ; g.K = 1024;
            if (!(layer & 1)) {
                g.Bt = (const bf16_t*)(ws + WS_WING) + (size_t)j * 4096 * 1024;
                EpiGdnIn E; E.proj = (bf16_t*)(ws + WS_PROJ); E.conv_p = P.out + OFF_CVP + (size_t)j * 4 * 3 * 3072; E.conv_s = P.out + OFF_CVS + (size_t)j * 16 * 3 * 3072;
                pg8::gemm_phase(lds, g, S, E);
            } else {
                g.Bt = (const bf16_t*)(ws + WS_WIND) + (size_t)j * 4096 * 1024;
                EpiDiffIn E; E.proj = (bf16_t*)(ws + WS_PROJ);
                E.k_p = P.out + OFF_KP + (size_t)j * MP * 1024; E.v_p = P.out + OFF_VP + (size_t)j * MP * 1024;
                E.k_s = P.out + OFF_KSO + (size_t)j * MS * 1024; E.v_s = P.out + OFF_VSO + (size_t)j * MS * 1024;
                E.ks = (bf16_t*)(ws + WS_KS); E.vs = (bf16_t*)(ws + WS_VS); E.kh = (bf16_t*)(ws + WS_KH); E.vh = (bf16_t*)(ws + WS_VH); E.rope = (const float*)(ws + WS_ROPE);
                pg8::gemm_phase(lds, g, S, E);
            }
        }
        GRID_BAR();
        if (!(layer & 1)) {
            { LOADP(); phase_g1(P, lds, layer); }
            GRID_BAR();
            { LOADP(); phase_scan(P, lds, layer); }
            GRID_BAR();
            { LOADP(); phase_gnorm(P, layer); }
        } else {
            { LOADP(); phase_attn(P, lds, layer); }
        }
        GRID_BAR();
        {
            LOADP();
            pg8::StaticOrder S; S.init(M, 1024, gridDim.x, blockIdx.x);
            pg8::Gemm g;
            g.A = (const bf16_t*)(ws + WS_HBUF); g.M = M; g.N = 1024; g.K = 1024;
            g.Bt = (const bf16_t*)(ws + ((layer & 1) ? WS_WOUTD : WS_WOUTG)) + (size_t)j * 1024 * 1024;
            EpiOut E; E.C = (bf16_t*)(ws + WS_PROJ);
            pg8::gemm_phase(lds, g, S, E);
        }
        GRID_BAR();
    }
    { LOADP(); phase_elem(P, lds, 4); }
#endif
}

extern "C" void kernel_launch(void* const* d_in, const int* in_sizes, int n_in, void* d_out, int out_size, void* d_ws, size_t ws_size, hipStream_t stream) {
    static int grid_blocks = 0;
    if (!grid_blocks) {
        int dev = 0, cus = 0, per_cu = 0;
        hipGetDevice(&dev);
        hipDeviceGetAttribute(&cus, hipDeviceAttributeMultiprocessorCount, dev);
        hipFuncSetAttribute((const void*)fwd_megakernel, hipFuncAttributeMaxDynamicSharedMemorySize, LDS_BYTES);
        hipOccupancyMaxActiveBlocksPerMultiprocessor(&per_cu, (const void*)fwd_megakernel, 512, LDS_BYTES);
        if (per_cu < 1) per_cu = 1;
        grid_blocks = cus * per_cu;
        if (ws_size < WS_END) fprintf(stderr, "kernel_launch: workspace too small: %zu < %zu\n", ws_size, (size_t)WS_END);
    }
    hipMemsetAsync((unsigned char*)d_ws + WS_BAR, 0, XCD_BAR_WORDS * sizeof(unsigned), stream);
    Params p{};
    for (int i = 0; i < 25; ++i) p.in[i] = (const float*)d_in[i];
    p.out = (float*)d_out; p.ws = (unsigned char*)d_ws;
    void* args[] = {&p};
    hipError_t e = hipLaunchCooperativeKernel((const void*)fwd_megakernel, dim3(grid_blocks), dim3(512), args, LDS_BYTES, stream);
    if (e != hipSuccess) fprintf(stderr, "cooperative launch failed: %s (grid %d)\n", hipGetErrorString(e), grid_blocks);
}
```

```cpp
#include <hip/hip_runtime.h>
#include <hip/hip_cooperative_groups.h>
#include <cstdio>
namespace cg = cooperative_groups;

#define DI __device__ __forceinline__
#define LAS __attribute__((address_space(3)))
typedef unsigned short bf16_t;
typedef short bf16x8 __attribute__((ext_vector_type(8)));
typedef short s16x4 __attribute__((ext_vector_type(4)));
typedef float f32x2 __attribute__((ext_vector_type(2)));
typedef float f32x4 __attribute__((ext_vector_type(4)));
typedef float f32x16 __attribute__((ext_vector_type(16)));
typedef unsigned u32x2 __attribute__((ext_vector_type(2)));
typedef unsigned u32x4 __attribute__((ext_vector_type(4)));
typedef __bf16 bf16x2_t __attribute__((ext_vector_type(2)));

#define REP_G1 1
#define REP_SCAN 1
#define REP_ATTN 1
#define REP_GIN 1
#define REP_GOUT 1
#define REP_PREP 1
DI int opaque_i(int v) { asm volatile("" : "+s"(v)); return v; }
constexpr int D = 1024, TP = 8192, BP = 4, BS = 16, TS = 16, PAST = 2048;
constexpr int MP = BP * TP, MS = BS * TS, M = MP + MS, NB = BP + BS;
constexpr int NPROJ = 4096;
constexpr int KSROWS = 2112;
constexpr int NITEM_P = 4096, NITEM = 4224;
constexpr size_t ITEM_BYTES = 90112;
constexpr float RMS_EPS = 1e-6f;
constexpr float QSCALE = 0.125f * 1.4426950408889634f;

constexpr size_t OFF_Y = 0;
constexpr size_t OFF_STP = (size_t)M * D;
constexpr size_t OFF_CVP = OFF_STP + 2ull * 4 * 8 * 128 * 128;
constexpr size_t OFF_KP = OFF_CVP + 2ull * 4 * 3 * 3072;
constexpr size_t OFF_VP = OFF_KP + 2ull * MP * 1024;
constexpr size_t OFF_STS = OFF_VP + 2ull * MP * 1024;
constexpr size_t OFF_CVS = OFF_STS + 2ull * 16 * 8 * 128 * 128;
constexpr size_t OFF_KSO = OFF_CVS + 2ull * 16 * 3 * 3072;
constexpr size_t OFF_VSO = OFF_KSO + 2ull * MS * 1024;

constexpr size_t WS_WING = 0;
constexpr size_t WS_WOUTG = WS_WING + 2ull * 4096 * 1024 * 2;
constexpr size_t WS_WIND = WS_WOUTG + 2ull * 1024 * 1024 * 2;
constexpr size_t WS_WOUTD = WS_WIND + 2ull * 4096 * 1024 * 2;
constexpr size_t WS_ADA = WS_WOUTD + 2ull * 1024 * 1024 * 2;
constexpr size_t WS_ROPE = WS_ADA + 4ull * NB * 3072 * 4;
constexpr size_t WS_AB = WS_ROPE + 8208ull * 64 * 4;
constexpr size_t WS_GL = WS_AB + (size_t)M * 16 * 4;
constexpr size_t WS_BAR = WS_GL + 17408;
constexpr size_t WS_HBUF = WS_GL + 32768;
constexpr size_t WS_ORAW = WS_HBUF + (size_t)M * 1024 * 2;
constexpr size_t WS_PROJ = WS_ORAW + 256;
constexpr size_t WS_R1 = WS_PROJ + (size_t)M * 4096 * 2;
constexpr size_t WS_KS = WS_R1;
constexpr size_t WS_VS = WS_KS + 16ull * KSROWS * 1024 * 2;
constexpr size_t WS_KH = WS_VS + 16ull * KSROWS * 1024 * 2;
constexpr size_t WS_VH = WS_KH + (size_t)MP * 1024 * 2;
constexpr size_t WS_ORAWB = WS_R1 + (size_t)NITEM * ITEM_BYTES;
constexpr size_t WS_END = WS_ORAWB + (size_t)M * 1024 * 2;

constexpr int LDS_BYTES = 131072 + 16;

struct Params { const float* in[25]; float* out; unsigned char* ws; };

DI float bf2f(bf16_t v) { return __uint_as_float(((unsigned)v) << 16); }
DI unsigned pk2(float a, float b) { f32x2 v = {a, b}; bf16x2_t r = __builtin_convertvector(v, bf16x2_t); return __builtin_bit_cast(unsigned, r); }
DI bf16_t f2bf(float a) { return (bf16_t)(pk2(a, 0.f) & 0xffffu); }
template <int CTRL> DI float dppf(float v) { return __builtin_bit_cast(float, __builtin_amdgcn_update_dpp(0, __builtin_bit_cast(int, v), CTRL, 0xf, 0xf, true)); }
DI float row_sum16(float v) { v += dppf<0x128>(v); v += dppf<0x124>(v); v += dppf<0x122>(v); v += dppf<0x121>(v); return v; }
DI float wave_sum(float v) { v = row_sum16(v); v += __shfl_xor(v, 16); v += __shfl_xor(v, 32); return v; }
DI float readlane_f(float v, int l) { return __builtin_bit_cast(float, __builtin_amdgcn_readlane(__builtin_bit_cast(int, v), l)); }
DI float siluf(float x) { return x * __builtin_amdgcn_rcpf(1.f + __expf(-x)); }
DI int ppos(int idx) { const int d5 = idx & 31; return (idx & ~31) | (((d5 >> 2) & 3) << 3) | ((d5 >> 4) << 2) | (d5 & 3); }
DI int perm64(int ls) { return (ls & 15) | (((ls >> 4) & 1) << 5) | (((ls >> 5) & 1) << 4); }
DI void unpack8(const u32x4 v, float (&o)[8]) {
#pragma unroll
    for (int i = 0; i < 4; ++i) { o[2 * i] = __uint_as_float(v[i] << 16); o[2 * i + 1] = __uint_as_float(v[i] & 0xffff0000u); }
}
DI void g2l16(const void* gptr, unsigned lds_addr) {
    asm volatile("s_mov_b32 m0, %1\n\ts_nop 0\n\tglobal_load_lds_dwordx4 %0, off" :: "v"(gptr), "s"(lds_addr) : "memory", "m0");
}
DI unsigned lds_u32(LAS unsigned char* p) { return (unsigned)(size_t)p; }
#define MFMA16(a, b, c) __builtin_amdgcn_mfma_f32_16x16x32_bf16((a), (b), (c), 0, 0, 0)
#define MFMA32(a, b, c) __builtin_amdgcn_mfma_f32_32x32x16_bf16((a), (b), (c), 0, 0, 0)

namespace pg8 {
constexpr int BM = 256, BK = 64, HALF = 128, HTB = HALF * BK * 2, STAGE_BYTES = 8 * HTB, NXCD = 8, WGM = 8;
DI int lds_byte(int r, int c) { const int st = (r >> 4) * 2 + (c >> 5), rr = r & 15, cc = c & 31, ob = rr * 64 + cc * 2; return st * 1024 + (ob ^ (((ob >> 9) & 1) << 5)); }
DI void stage_rc(int b, int& R, int& C) { const int st = b / 1024, sb = b % 1024, swz = sb ^ (((sb >> 9) & 1) << 5); R = (st >> 1) * 16 + swz / 64; C = (st & 1) * 32 + (swz % 64) / 2; }
struct Unit { int pm, pn; };
struct Gemm { const bf16_t* A; const bf16_t* Bt; int M, N, K; };
struct StaticOrder {
    int nM, nN, nwg, G, c;
    DI void init(int M_, int N_, int G_, int c_) { nM = M_ / BM; nN = N_ / BM; nwg = nM * nN; G = G_; c = c_; }
    DI bool next(int i, Unit& u) const {
        const long L = (long)i * G + c; if (L >= nwg) return false;
        int wgid = (int)L; { const int q = nwg / NXCD, r = nwg % NXCD, xcd = wgid % NXCD, off = wgid / NXCD; wgid = (xcd < r ? xcd * (q + 1) : r * (q + 1) + (xcd - r) * q) + off; }
        const int nig = WGM * nN, gid = wgid / nig, fm = gid * WGM, gsz = (nM - fm) < WGM ? (nM - fm) : WGM;
        u.pm = fm + ((wgid % nig) % gsz); u.pn = (wgid % nig) / gsz; return true;
    }
};

template <class Epi>
DI void gemm_phase(LAS unsigned char* lds, const Gemm g, const StaticOrder& S, const Epi& E) {
    int tid_ = threadIdx.x; asm volatile("" : "+v"(tid_)); const int tid = tid_, wid = __builtin_amdgcn_readfirstlane(tid >> 6), lane = tid & 63, wr = wid >> 2, wc = wid & 3, fr = lane & 15, fq = lane >> 4;
    const int K = g.K, nt = K / BK;
    unsigned voffA[2];
#pragma unroll
    for (int i = 0; i < 2; ++i) { int R, C; stage_rc(tid * 16 + i * 8192, R, C); voffA[i] = (unsigned)(R * K + C) * 2u; }
    const size_t kstep = (size_t)(BK * 2);
    const size_t hstep = (size_t)HALF * K * 2;
    const size_t tstep = 2 * hstep;
    const unsigned ldsw = (unsigned)wid * 1024u;
    const int aoff = lds_byte(wr * 64 + fr, fq * 8), boff = lds_byte(wc * 32 + fr, fq * 8);
#define PG8_SA(b, h) (((b) * 2 + (h)) * HTB)
#define PG8_SB(b, h) ((4 + (b) * 2 + (h)) * HTB)
#define PG8_STAGE(bufoff, gbase) do { _Pragma("unroll") for (int _i = 0; _i < 2; ++_i) \
        __builtin_amdgcn_global_load_lds((const unsigned*)((const char*)(gbase) + voffA[_i]), (LAS unsigned*)(lds + (bufoff) + ldsw + _i * 8192), 16, 0, 0); } while (0)
#define PG8_LDA(dst, b, h) do { _Pragma("unroll") for (int m = 0; m < 4; ++m) _Pragma("unroll") for (int k = 0; k < 2; ++k) dst[m][k] = *(const LAS bf16x8*)(lds + PG8_SA(b, h) + aoff + m * 2048 + k * 1024); } while (0)
#define PG8_LDB(dst, b, h) do { _Pragma("unroll") for (int n = 0; n < 2; ++n) _Pragma("unroll") for (int k = 0; k < 2; ++k) dst[n][k] = *(const LAS bf16x8*)(lds + PG8_SB(b, h) + boff + n * 2048 + k * 1024); } while (0)
#define PG8_MMA(ai, bj, At, Bt) do { __builtin_amdgcn_s_setprio(1); _Pragma("unroll") for (int m = 0; m < 4; ++m) _Pragma("unroll") for (int n = 0; n < 2; ++n) _Pragma("unroll") for (int k = 0; k < 2; ++k) \
        acc[ai][bj][m][n] = __builtin_amdgcn_mfma_f32_16x16x32_bf16(Bt[n][k], At[m][k], acc[ai][bj][m][n], 0, 0, 0); __builtin_amdgcn_s_setprio(0); } while (0)
#define PG8_WAIT_V(n) asm volatile("s_waitcnt vmcnt(" #n ")" ::: "memory")
#define PG8_WAIT_L(n) asm volatile("s_waitcnt lgkmcnt(" #n ")" ::: "memory")
#define PG8_BAR __builtin_amdgcn_s_barrier()
#define PG8_SCHED __builtin_amdgcn_sched_barrier(0)
    Unit cur, nxt; int ui = 0;
    if (!S.next(0, cur)) return;
    f32x4 acc[2][2][4][2];
#pragma unroll
    for (int a = 0; a < 2; ++a)
#pragma unroll
        for (int b = 0; b < 2; ++b)
#pragma unroll
            for (int m = 0; m < 4; ++m)
#pragma unroll
                for (int n = 0; n < 2; ++n) acc[a][b][m][n] = (f32x4){0.f, 0.f, 0.f, 0.f};
    bf16x8 At[4][2], B0[2][2], B1[2][2];
    const char* cA = (const char*)g.A + (size_t)cur.pm * tstep; const char* cB = (const char*)g.Bt + (size_t)cur.pn * tstep;
    PG8_STAGE(PG8_SB(0, 0), cB); PG8_STAGE(PG8_SA(0, 0), cA); PG8_STAGE(PG8_SB(0, 1), cB + hstep); PG8_STAGE(PG8_SA(0, 1), cA + hstep);
    if (wr == 1) PG8_BAR;
    PG8_WAIT_V(4); PG8_BAR;
    PG8_STAGE(PG8_SB(1, 0), cB + kstep); PG8_STAGE(PG8_SA(1, 0), cA + kstep); PG8_STAGE(PG8_SB(1, 1), cB + hstep + kstep);
    PG8_WAIT_V(6); PG8_BAR;
    for (;;) {
        const bool has_next = S.next(ui + 1, nxt);
        const char* nA = has_next ? (const char*)g.A + (size_t)nxt.pm * tstep : cA; const char* nB = has_next ? (const char*)g.Bt + (size_t)nxt.pn * tstep : cB;
        for (int t = 0; t < nt; t += 2) {
            const bool last = (t == nt - 2);
            const char* a1 = cA + (size_t)(t + 1) * kstep;
            const char* a2 = last ? nA : cA + (size_t)(t + 2) * kstep; const char* b2 = last ? nB : cB + (size_t)(t + 2) * kstep;
            const char* a3 = a2 + kstep; const char* b3 = b2 + kstep;
            PG8_LDB(B0, 0, 0); PG8_SCHED; PG8_LDA(At, 0, 0); PG8_STAGE(PG8_SA(1, 1), a1 + hstep);
            PG8_WAIT_L(8); PG8_BAR; PG8_WAIT_L(0); PG8_MMA(0, 0, At, B0); PG8_BAR; PG8_SCHED;
            PG8_LDB(B1, 0, 1); PG8_STAGE(PG8_SB(0, 0), b2);
            PG8_BAR; PG8_WAIT_L(0); PG8_MMA(0, 1, At, B1); PG8_BAR;
            PG8_LDA(At, 0, 1); PG8_STAGE(PG8_SA(0, 0), a2);
            PG8_BAR; PG8_WAIT_L(0); PG8_MMA(1, 0, At, B0); PG8_BAR; PG8_SCHED;
            PG8_STAGE(PG8_SB(0, 1), b2 + hstep);
            PG8_WAIT_V(6); PG8_BAR; PG8_MMA(1, 1, At, B1); PG8_BAR;
            PG8_LDB(B0, 1, 0); PG8_SCHED; PG8_LDA(At, 1, 0); PG8_STAGE(PG8_SA(0, 1), a2 + hstep);
            PG8_WAIT_L(8); PG8_BAR; PG8_WAIT_L(0); PG8_MMA(0, 0, At, B0); PG8_BAR; PG8_SCHED;
            PG8_LDB(B1, 1, 1); PG8_STAGE(PG8_SB(1, 0), b3);
            PG8_BAR; PG8_WAIT_L(0); PG8_MMA(0, 1, At, B1); PG8_BAR;
            PG8_LDA(At, 1, 1); PG8_STAGE(PG8_SA(1, 0), a3);
            PG8_BAR; PG8_WAIT_L(0); PG8_MMA(1, 0, At, B0); PG8_BAR; PG8_SCHED;
            PG8_STAGE(PG8_SB(1, 1), b3 + hstep);
            PG8_WAIT_V(6); PG8_BAR; PG8_MMA(1, 1, At, B1); PG8_BAR;
        }
        E(acc, cur, wr, wc, fr, fq);
        if (!has_next) break;
#pragma unroll
        for (int a = 0; a < 2; ++a)
#pragma unroll
            for (int b = 0; b < 2; ++b)
#pragma unroll
                for (int m = 0; m < 4; ++m)
#pragma unroll
                    for (int n = 0; n < 2; ++n) acc[a][b][m][n] = (f32x4){0.f, 0.f, 0.f, 0.f};
        cur = nxt; cA = nA; cB = nB; ++ui;
    }
    PG8_WAIT_V(0);
    if (wr == 0) PG8_BAR;
    PG8_BAR;
#undef PG8_SA
#undef PG8_SB
#undef PG8_STAGE
#undef PG8_LDA
#undef PG8_LDB
#undef PG8_MMA
#undef PG8_WAIT_V
#undef PG8_WAIT_L
#undef PG8_BAR
#undef PG8_SCHED
}
}

struct EpiGdnIn {
    bf16_t* proj; float* conv_p; float* conv_s;
    DI void operator()(const f32x4 (&acc)[2][2][4][2], const pg8::Unit& u, int wr, int wc, int fr, int fq) const {
        const int row0 = u.pm * 256 + wr * 64 + fr, col0 = u.pn * 256 + wc * 32 + 4 * fq;
#pragma unroll
        for (int ai = 0; ai < 2; ++ai)
#pragma unroll
            for (int m = 0; m < 4; ++m) {
                const int r = row0 + ai * 128 + m * 16;
                bf16_t* rowp = proj + (size_t)r * NPROJ + col0;
                bool tail; float* cp;
                if (r < MP) { const int t = r & (TP - 1), b = r >> 13; tail = t >= TP - 3; cp = conv_p + (size_t)(b * 3 + (t - (TP - 3))) * 3072; }
                else { const int rs = r - MP, t = rs & 15, b = rs >> 4; tail = t >= TS - 3; cp = conv_s + (size_t)(b * 3 + (t - (TS - 3))) * 3072; }
#pragma unroll
                for (int bj = 0; bj < 2; ++bj)
#pragma unroll
                    for (int n = 0; n < 2; ++n) {
                        const f32x4 v = acc[ai][bj][m][n];
                        u32x2 w; w.x = pk2(v[0], v[1]); w.y = pk2(v[2], v[3]);
                        *(u32x2*)(rowp + bj * 128 + n * 16) = w;
                        const int c = col0 + bj * 128 + n * 16;
                        if (tail && c < 3072) *(f32x4*)(cp + c) = v;
                    }
            }
    }
};

struct EpiDiffIn {
    bf16_t* proj; float* k_p; float* v_p; float* k_s; float* v_s; bf16_t* ks; bf16_t* vs; bf16_t* kh; bf16_t* vh; const float* rope;
    DI void operator()(const f32x4 (&acc)[2][2][4][2], const pg8::Unit& u, int wr, int wc, int fr, int fq) const {
        const int part = u.pn >> 2;
        const int row0 = u.pm * 256 + wr * 64 + fr;
        const int d0 = 16 * (wc & 1) + 4 * fq;
        const int cbase = u.pn * 256 + 64 * (wc >> 1) + d0;
#pragma unroll
        for (int ai = 0; ai < 2; ++ai)
#pragma unroll
            for (int m = 0; m < 4; ++m) {
                const int r = row0 + ai * 128 + m * 16;
                const int rs = r - MP;
                const int pidx = (r < MP) ? (r & (TP - 1)) : (TP + (rs & 15));
                f32x4 cs = {1.f, 1.f, 1.f, 1.f}, sn = {0.f, 0.f, 0.f, 0.f};
                if (part < 2) { cs = *(const f32x4*)(rope + (size_t)pidx * 64 + d0); sn = *(const f32x4*)(rope + (size_t)pidx * 64 + 32 + d0); }
#pragma unroll
                for (int bj = 0; bj < 2; ++bj) {
                    const f32x4 x1 = acc[ai][bj][m][0], x2 = acc[ai][bj][m][1];
                    f32x4 y1 = x1 * cs - x2 * sn, y2 = x2 * cs + x1 * sn;
                    const int col = cbase + bj * 128;
                    bf16_t* pp = proj + (size_t)r * NPROJ + col;
                    if (part == 0) { y1 *= QSCALE; y2 *= QSCALE; }
                    u32x2 w1, w2; w1.x = pk2(y1[0], y1[1]); w1.y = pk2(y1[2], y1[3]); w2.x = pk2(y2[0], y2[1]); w2.y = pk2(y2[2], y2[3]);
                    if (part == 0 || part == 3) { *(u32x2*)pp = w1; *(u32x2*)(pp + 32) = w2; }
                    if (part == 1 || part == 2) {
                        const int cc = col - part * 1024;
                        const int hh = cc >> 7, dd = cc & 127;
                        float* op; bf16_t* sp;
                        if (r < MP) { op = (part == 1 ? k_p : v_p) + (size_t)r * 1024 + cc;
                               sp = (part == 1 ? kh : vh) + ((size_t)((r >> 13) * 8 + hh) * TP + (r & (TP - 1))) * 128 + dd; }
                        else { op = (part == 1 ? k_s : v_s) + (size_t)rs * 1024 + cc;
                               sp = (part == 1 ? ks : vs) + ((size_t)((rs >> 4) * 8 + hh) * KSROWS + PAST + (rs & 15)) * 128 + dd; }
                        *(f32x4*)op = y1; *(f32x4*)(op + 32) = y2;
                        *(u32x2*)sp = w1; *(u32x2*)(sp + 32) = w2;
                    }
                }
            }
    }
};

struct EpiOut {
    bf16_t* C;
    DI void operator()(const f32x4 (&acc)[2][2][4][2], const pg8::Unit& u, int wr, int wc, int fr, int fq) const {
        const int row0 = u.pm * 256 + wr * 64 + fr, col0 = u.pn * 256 + wc * 32 + 4 * fq;
#pragma unroll
        for (int ai = 0; ai < 2; ++ai)
#pragma unroll
            for (int m = 0; m < 4; ++m) {
                bf16_t* rowp = C + (size_t)(row0 + ai * 128 + m * 16) * 1024 + col0;
#pragma unroll
                for (int bj = 0; bj < 2; ++bj)
#pragma unroll
                    for (int n = 0; n < 2; ++n) { const f32x4 v = acc[ai][bj][m][n]; u32x2 w; w.x = pk2(v[0], v[1]); w.y = pk2(v[2], v[3]); *(u32x2*)(rowp + bj * 128 + n * 16) = w; }
            }
    }
};

DI void transpose_tile(const float* W, int ldw, int n0, int k0, bf16_t* WT, bool perm, LAS float* tile) {
    int tid_ = threadIdx.x; asm volatile("" : "+v"(tid_)); const int tid = tid_;
    {
        const int kk = tid >> 4, c4 = (tid & 15) * 4;
#pragma unroll
        for (int p = 0; p < 2; ++p) {
            const f32x4 v = *(const f32x4*)(W + (size_t)(k0 + kk + 32 * p) * ldw + n0 + c4);
            LAS float* t = tile + (kk + 32 * p) * 65 + c4;
            t[0] = v[0]; t[1] = v[1]; t[2] = v[2]; t[3] = v[3];
        }
    }
    __syncthreads();
    {
        const int n = tid >> 3, ks = (tid & 7) * 8;
        const int src = perm ? perm64(n) : n;
        float v[8];
#pragma unroll
        for (int e = 0; e < 8; ++e) v[e] = tile[(ks + e) * 65 + src];
        u32x4 w; w.x = pk2(v[0], v[1]); w.y = pk2(v[2], v[3]); w.z = pk2(v[4], v[5]); w.w = pk2(v[6], v[7]);
        *(u32x4*)(WT + (size_t)(n0 + n) * 1024 + k0 + ks) = w;
    }
    __syncthreads();
}

DI void phase_prep(const Params& P, LAS unsigned char* lds) {
    int tid_ = threadIdx.x; asm volatile("" : "+v"(tid_)); const int tid = tid_, G = gridDim.x;
    unsigned char* ws = P.ws;
    for (int id = blockIdx.x; id < 5120; id += G) {
        const int j = id / 2560; int rem = id % 2560;
        const float* W; int ldw; bf16_t* WT; bool perm = false; int t;
        if (rem < 1024) { W = P.in[12] + (size_t)j * 1024 * 4112; ldw = 4112; WT = (bf16_t*)(ws + WS_WING) + (size_t)j * 4096 * 1024; t = rem; }
        else if (rem < 1280) { W = P.in[17] + (size_t)j * 1024 * 1024; ldw = 1024; WT = (bf16_t*)(ws + WS_WOUTG) + (size_t)j * 1024 * 1024; t = rem - 1024; }
        else if (rem < 2304) { W = P.in[18] + (size_t)j * 1024 * 4096; ldw = 4096; WT = (bf16_t*)(ws + WS_WIND) + (size_t)j * 4096 * 1024; t = rem - 1280; perm = true; }
        else { W = P.in[24] + (size_t)j * 1024 * 1024; ldw = 1024; WT = (bf16_t*)(ws + WS_WOUTD) + (size_t)j * 1024 * 1024; t = rem - 2304; }
        transpose_tile(W, ldw, (t >> 4) * 64, (t & 15) * 64, WT, perm, (LAS float*)lds);
    }
    for (int idx = blockIdx.x * 512 + tid; idx < 8208 * 32; idx += G * 512) {
        const int pi = idx >> 5, d = idx & 31;
        const int pos = pi < TP ? pi : PAST + (pi - TP);
        const float inv = 1.0f / powf(10000.0f, (float)d / 32.0f);
        const float ang = (float)pos * inv;
        const double rev = (double)ang * 0.15915494309189535;
        const double fr = rev - floor(rev);
        float* rp = (float*)(ws + WS_ROPE) + (size_t)pi * 64;
        rp[d] = __builtin_amdgcn_cosf((float)fr);
        rp[32 + d] = __builtin_amdgcn_sinf((float)fr);
    }
    {
        LAS float* cact = (LAS float*)lds;
        LAS float* red = (LAS float*)(lds + 81920);
        bool loaded = false;
        for (int id = (G - 1 - blockIdx.x); id < 192; id += G) {
            if (!loaded) {
                for (int e = tid; e < NB * 1024; e += 512) {
                    const int b = e >> 10, k = e & 1023;
                    const float c = b < BP ? P.in[2][b * 1024 + k] : P.in[3][(b - BP) * 1024 + k];
                    cact[e] = siluf(c);
                }
                loaded = true;
            }
            __syncthreads();
            const int i = id / 48, cb = id % 48;
            const int col = tid & 63, kg = tid >> 6;
            const float* Wp = P.in[10] + (size_t)i * 1024 * 3072 + cb * 64 + col;
            float acc[NB];
#pragma unroll
            for (int b = 0; b < NB; ++b) acc[b] = 0.f;
            for (int k = kg * 128; k < kg * 128 + 128; k += 4) {
                const float w0 = Wp[(size_t)k * 3072], w1 = Wp[(size_t)(k + 1) * 3072], w2 = Wp[(size_t)(k + 2) * 3072], w3 = Wp[(size_t)(k + 3) * 3072];
#pragma unroll
                for (int b = 0; b < NB; ++b) {
                    const f32x4 c4 = *(const LAS f32x4*)(cact + b * 1024 + k);
                    acc[b] += c4[0] * w0 + c4[1] * w1 + c4[2] * w2 + c4[3] * w3;
                }
            }
#pragma unroll
            for (int b = 0; b < NB; ++b) red[(kg * NB + b) * 64 + col] = acc[b];
            __syncthreads();
            for (int o = tid; o < NB * 64; o += 512) {
                const int b = o >> 6, c = o & 63;
                float s = P.in[11][i * 3072 + cb * 64 + c];
#pragma unroll
                for (int g = 0; g < 8; ++g) s += red[(g * NB + b) * 64 + c];
                ((float*)(ws + WS_ADA))[((size_t)i * NB + b) * 3072 + cb * 64 + c] = s;
            }
        }
        __syncthreads();
    }
}

DI void phase_elem(const Params& P, LAS unsigned char* lds, int layer) {
    int tid_ = threadIdx.x; asm volatile("" : "+v"(tid_)); const int tid = tid_, wid = __builtin_amdgcn_readfirstlane(tid >> 6), lane = tid & 63, G = gridDim.x;
    unsigned char* ws = P.ws;
    const int j = layer >> 1;
    const bool gdn = (layer < 4) && !(layer & 1);
    LAS float* wab = (LAS float*)lds;
    if (gdn) {
        const float* Wp = P.in[12] + (size_t)j * 1024 * 4112 + 4096;
        for (int e = tid; e < 16384; e += 512) { const int k = e >> 4, c = e & 15; wab[c * 1024 + k] = Wp[(size_t)k * 4112 + c]; }
        __syncthreads();
    }
    const float* ada = (const float*)(ws + WS_ADA);
    float* X = P.out;
    const bf16_t* OUTB = (const bf16_t*)(ws + WS_PROJ);
    bf16_t* HB = (bf16_t*)(ws + WS_HBUF);
    float* AB = (float*)(ws + WS_AB);
    for (int r = blockIdx.x * 8 + wid; r < M; r += G * 8) {
        const int b = r < MP ? (r >> 13) : BP + ((r - MP) >> 4);
        const float* xs = (layer <= 1) ? (r < MP ? P.in[0] + (size_t)r * 1024 : P.in[1] + (size_t)(r - MP) * 1024) : X + (size_t)r * 1024;
        f32x4 x[4];
#pragma unroll
        for (int q = 0; q < 4; ++q) x[q] = *(const f32x4*)(xs + 4 * (lane + 64 * q));
        if (layer >= 1) {
            f32x4 o[4]; float ss = 0.f;
#pragma unroll
            for (int q = 0; q < 4; ++q) { const u32x2 ow = *(const u32x2*)(OUTB + (size_t)r * 1024 + 4 * (lane + 64 * q));
                o[q] = (f32x4){__uint_as_float(ow.x << 16), __uint_as_float(ow.x & 0xffff0000u), __uint_as_float(ow.y << 16), __uint_as_float(ow.y & 0xffff0000u)};
                ss += o[q][0] * o[q][0] + o[q][1] * o[q][1] + o[q][2] * o[q][2] + o[q][3] * o[q][3]; }
            ss = wave_sum(ss);
            const float rstd = __builtin_amdgcn_rsqf(ss * (1.f / 1024.f) + RMS_EPS);
            const float* gp = ada + ((size_t)(layer - 1) * NB + b) * 3072 + 2048;
            const float* np = P.in[9] + (layer - 1) * 1024;
#pragma unroll
            for (int q = 0; q < 4; ++q) {
                const int d = 4 * (lane + 64 * q);
                const f32x4 gt = *(const f32x4*)(gp + d), nw = *(const f32x4*)(np + d);
                x[q] = x[q] + gt * (o[q] * rstd * nw);
                *(f32x4*)(X + (size_t)r * 1024 + d) = x[q];
            }
        }
        if (layer < 4) {
            float ss = 0.f;
#pragma unroll
            for (int q = 0; q < 4; ++q) ss += x[q][0] * x[q][0] + x[q][1] * x[q][1] + x[q][2] * x[q][2] + x[q][3] * x[q][3];
            ss = wave_sum(ss);
            const float rstd = __builtin_amdgcn_rsqf(ss * (1.f / 1024.f) + RMS_EPS);
            const float* ap = ada + ((size_t)layer * NB + b) * 3072;
            const float* np = P.in[8] + layer * 1024;
            f32x4 hv[4];
#pragma unroll
            for (int q = 0; q < 4; ++q) {
                const int d = 4 * (lane + 64 * q);
                const f32x4 sh = *(const f32x4*)(ap + d), sc = *(const f32x4*)(ap + 1024 + d), nw = *(const f32x4*)(np + d);
                hv[q] = (x[q] * rstd * nw) * (1.f + sc) + sh;
                u32x2 w; w.x = pk2(hv[q][0], hv[q][1]); w.y = pk2(hv[q][2], hv[q][3]);
                *(u32x2*)(HB + (size_t)r * 1024 + d) = w;
            }
            if (gdn) {
                float mine = 0.f;
#pragma unroll
                for (int c = 0; c < 16; ++c) {
                    float a = 0.f;
#pragma unroll
                    for (int q = 0; q < 4; ++q) { const f32x4 w4 = *(const LAS f32x4*)(wab + c * 1024 + 4 * (lane + 64 * q)); a += hv[q][0] * w4[0] + hv[q][1] * w4[1] + hv[q][2] * w4[2] + hv[q][3] * w4[3]; }
                    a = row_sum16(a);
                    if ((lane & 15) == c) mine = a;
                }
                mine += __shfl_xor(mine, 16); mine += __shfl_xor(mine, 32);
                if (lane < 16) AB[(size_t)r * 16 + lane] = mine;
            }
        }
    }
    if (layer < 4 && (layer & 1)) {
        const float* ck = P.in[6] + (size_t)j * 16 * PAST * 1024;
        const float* cv = P.in[7] + (size_t)j * 16 * PAST * 1024;
        bf16_t* KS = (bf16_t*)(ws + WS_KS); bf16_t* VS = (bf16_t*)(ws + WS_VS);
        const size_t nun = (size_t)16 * PAST * 128;
        for (size_t u = (size_t)blockIdx.x * 512 + tid; u < 2 * nun; u += (size_t)G * 512) {
            const bool isv = u >= nun; const size_t uu = isv ? u - nun : u;
            const size_t b = uu / ((size_t)PAST * 128), rem = uu % ((size_t)PAST * 128);
            const size_t row = rem >> 7, c8 = rem & 127, hh = c8 >> 4, d8 = c8 & 15;
            const float* sp = (isv ? cv : ck) + uu * 8;
            const f32x4 a = *(const f32x4*)sp, c = *(const f32x4*)(sp + 4);
            u32x4 w; w.x = pk2(a[0], a[1]); w.y = pk2(a[2], a[3]); w.z = pk2(c[0], c[1]); w.w = pk2(c[2], c[3]);
            *(u32x4*)((isv ? VS : KS) + ((b * 8 + hh) * KSROWS + row) * 128 + d8 * 8) = w;
        }
        const size_t npad = (size_t)128 * 48 * 16;
        for (size_t u = (size_t)blockIdx.x * 512 + tid; u < 2 * npad; u += (size_t)G * 512) {
            const bool isv = u >= npad; const size_t uu = isv ? u - npad : u;
            const size_t sq = uu / (48 * 16), rem = uu % (48 * 16);
            *(u32x4*)((isv ? VS : KS) + (sq * KSROWS + PAST + TS) * 128 + rem * 8) = (u32x4){0u, 0u, 0u, 0u};
        }
    }
}

DI void phase_g1(const Params& P, LAS unsigned char* lds, int layer) {
    int tid_ = threadIdx.x; asm volatile("" : "+v"(tid_)); const int tid = tid_, wid = __builtin_amdgcn_readfirstlane(tid >> 6), lane = tid & 63, G = gridDim.x;
    const int fr = lane & 15, fq = lane >> 4;
    unsigned char* ws = P.ws;
    const int j = layer >> 1;
    const bf16_t* proj = (const bf16_t*)(ws + WS_PROJ);
    const float* AB = (const float*)(ws + WS_AB);
    float* GL = (float*)(ws + WS_GL);
    const float* convw = P.in[13] + (size_t)j * 4 * 3072;
    const float* cconv = P.in[5] + (size_t)j * 16 * 3 * 3072;
    LAS unsigned char* Qs = lds;
    LAS unsigned char* Ks = lds + 17408;
    LAS unsigned char* VBt = lds + 34816;
    LAS unsigned char* KBt = lds + 53248;
    LAS float* A32 = (LAS float*)(lds + 71680);
    LAS unsigned char* Ts = lds + 88320;
    LAS unsigned char* QKs = lds + 97536;
    LAS float* Gs = (LAS float*)(lds + 105728);

    for (int item = blockIdx.x; item < NITEM; item += G) {
        int b, h, c, row0, nvalid; bool sample;
        if (item < NITEM_P) { const int seq = item >> 7; b = seq >> 3; h = seq & 7; c = item & 127; row0 = b * TP + 64 * c; nvalid = 64; sample = false; }
        else { const int s = item - NITEM_P; b = s >> 3; h = s & 7; c = 0; row0 = MP + b * TS; nvalid = TS; sample = true; }
        unsigned char* ib = ws + WS_R1 + (size_t)item * ITEM_BYTES;
        float val[8][8];
        float rn[8];
        int tido = tid; asm volatile("" : "+v"(tido));
        const int l16 = tido & 15, grp = tido >> 4, part = grp >> 3, rb = grp & 7;
        const int lane = tido & 63, fr = lane & 15, fq = lane >> 4;
        if (tid < 384) {
            const int ch = part * 1024 + h * 128 + 8 * l16;
            float wv[4][8];
#pragma unroll
            for (int t = 0; t < 4; ++t) {
                const f32x4 a = *(const f32x4*)(convw + t * 3072 + ch), bb = *(const f32x4*)(convw + t * 3072 + ch + 4);
                wv[t][0] = a[0]; wv[t][1] = a[1]; wv[t][2] = a[2]; wv[t][3] = a[3]; wv[t][4] = bb[0]; wv[t][5] = bb[1]; wv[t][6] = bb[2]; wv[t][7] = bb[3];
            }
            float win[4][8];
#pragma unroll
            for (int t = 0; t < 4; ++t)
#pragma unroll
                for (int e = 0; e < 8; ++e) win[t][e] = 0.f;
#pragma unroll
            for (int k = 0; k < 11; ++k) {
                const int lr = 8 * rb - 3 + k;
                float in8[8];
                {
                    const bool use_proj = (lr >= 0 && lr < nvalid) || (lr < 0 && !sample && c > 0);
                    const int lrc = use_proj ? lr : 0;
                    const u32x4 v = *(const u32x4*)(proj + (size_t)(row0 + lrc) * NPROJ + ch);
                    unpack8(v, in8);
                    if (!use_proj) {
#pragma unroll
                        for (int e = 0; e < 8; ++e) in8[e] = 0.f;
                    }
                }
                if (k < 3) {
                    if (sample && lr < 0) {
                        const float* sp = cconv + (size_t)(b * 3 + (3 + lr)) * 3072 + ch;
                        const f32x4 a = *(const f32x4*)sp, bb = *(const f32x4*)(sp + 4);
                        in8[0] = a[0]; in8[1] = a[1]; in8[2] = a[2]; in8[3] = a[3]; in8[4] = bb[0]; in8[5] = bb[1]; in8[6] = bb[2]; in8[7] = bb[3];
                    }
                }
#pragma unroll
                for (int e = 0; e < 8; ++e) { win[0][e] = win[1][e]; win[1][e] = win[2][e]; win[2][e] = win[3][e]; win[3][e] = in8[e]; }
                if (k >= 3) {
                    const bool rv = (lr < nvalid);
                    float ss = 0.f;
#pragma unroll
                    for (int e = 0; e < 8; ++e) {
                        const float y = win[0][e] * wv[0][e] + win[1][e] * wv[1][e] + win[2][e] * wv[2][e] + win[3][e] * wv[3][e];
                        const float s = rv ? siluf(y) : 0.f;
                        val[k - 3][e] = s; ss += s * s;
                    }
                    ss = row_sum16(ss);
                    rn[k - 3] = __builtin_amdgcn_rsqf(ss + 1e-6f);
                }
            }
        } else if (wid == 7) {
            const int r = row0 + (lane < nvalid ? lane : 0);
            const bool valid = lane < nvalid;
            const float a = AB[(size_t)r * 16 + h], bb = AB[(size_t)r * 16 + 8 + h];
            const float xa = a + P.in[15][j * 8 + h];
            const float ey = __expf(-fabsf(xa));
            const float lp = (ey < 0.01f) ? ey * (1.f - ey * (0.5f - ey * 0.33333334f)) : __logf(1.f + ey);
            const float sp = fmaxf(xa, 0.f) + lp;
            float g = valid ? -__expf(P.in[14][j * 8 + h]) * sp : 0.f;
            const float beta = valid ? __builtin_amdgcn_rcpf(1.f + __expf(-bb)) : 0.f;
#pragma unroll
            for (int o = 1; o < 64; o <<= 1) { const float t = __shfl_up(g, o); if (lane >= o) g += t; }
            const float glast = readlane_f(g, 63);
            Gs[lane] = g; Gs[64 + lane] = beta; Gs[128 + lane] = __expf(g); Gs[192 + lane] = __expf(glast - g);
            if (lane == 0) GL[item] = __expf(glast);
        }
        __syncthreads();
        if (tid < 384) {
#pragma unroll
            for (int rr = 0; rr < 8; ++rr) {
                const int row = 8 * rb + rr;
                const float beta = Gs[64 + row], eG = Gs[128 + row];
                if (part == 0) {
                    const float sc = rn[rr] * 0.08838834764831845f;
                    float q[8];
#pragma unroll
                    for (int e = 0; e < 8; ++e) q[e] = val[rr][e] * sc;
                    u32x4 w; w.x = pk2(q[0], q[1]); w.y = pk2(q[2], q[3]); w.z = pk2(q[4], q[5]); w.w = pk2(q[6], q[7]);
                    *(LAS u32x4*)(Qs + row * 272 + l16 * 16) = w;
                    bf16_t* qg = (bf16_t*)(ib + 49152) + row * 128;
                    u32x2 g0, g1; g0.x = pk2(q[0] * eG, q[1] * eG); g0.y = pk2(q[2] * eG, q[3] * eG); g1.x = pk2(q[4] * eG, q[5] * eG); g1.y = pk2(q[6] * eG, q[7] * eG);
                    *(u32x2*)(qg + ppos(8 * l16)) = g0; *(u32x2*)(qg + ppos(8 * l16 + 4)) = g1;
                    val[rr][0] = 0.f;
                } else if (part == 1) {
#pragma unroll
                    for (int e = 0; e < 8; ++e) val[rr][e] *= rn[rr];
                    u32x4 w; w.x = pk2(val[rr][0], val[rr][1]); w.y = pk2(val[rr][2], val[rr][3]); w.z = pk2(val[rr][4], val[rr][5]); w.w = pk2(val[rr][6], val[rr][7]);
                    *(LAS u32x4*)(Ks + row * 272 + l16 * 16) = w;
                }
            }
            if (part >= 1) {
                float bsc[8], ksc[8];
#pragma unroll
                for (int rr = 0; rr < 8; ++rr) { const int row = 8 * rb + rr; const float beta = Gs[64 + row]; bsc[rr] = (part == 1) ? beta * Gs[128 + row] : beta; ksc[rr] = Gs[192 + row]; }
                LAS unsigned char* Tt = (part == 1) ? KBt : VBt;
#pragma unroll
                for (int e = 0; e < 8; ++e) {
                    const int dch = 8 * l16 + e;
                    u32x4 w; w.x = pk2(val[0][e] * bsc[0], val[1][e] * bsc[1]); w.y = pk2(val[2][e] * bsc[2], val[3][e] * bsc[3]);
                    w.z = pk2(val[4][e] * bsc[4], val[5][e] * bsc[5]); w.w = pk2(val[6][e] * bsc[6], val[7][e] * bsc[7]);
                    *(LAS u32x4*)(Tt + dch * 144 + rb * 16) = w;
                    if (part == 1) {
                        bf16_t* kd = (bf16_t*)(ib + 65536) + dch * 64;
                        u32x2 k0, k1; k0.x = pk2(val[0][e] * ksc[0], val[1][e] * ksc[1]); k0.y = pk2(val[2][e] * ksc[2], val[3][e] * ksc[3]);
                        k1.x = pk2(val[4][e] * ksc[4], val[5][e] * ksc[5]); k1.y = pk2(val[6][e] * ksc[6], val[7][e] * ksc[7]);
                        *(u32x2*)(kd + ppos(8 * rb)) = k0; *(u32x2*)(kd + ppos(8 * rb + 4)) = k1;
                    }
                }
            }
        }
        __syncthreads();
        {
            const int mt = wid & 3; const bool isqk = wid >= 4;
            LAS unsigned char* As = isqk ? Qs : Ks;
            f32x4 acc[4];
#pragma unroll
            for (int nt = 0; nt < 4; ++nt) acc[nt] = (f32x4){0.f, 0.f, 0.f, 0.f};
#pragma unroll
            for (int ks = 0; ks < 4; ++ks) {
                const bf16x8 a = *(const LAS bf16x8*)(As + (16 * mt + fr) * 272 + (32 * ks + 8 * fq) * 2);
#pragma unroll
                for (int nt = 0; nt < 4; ++nt) {
                    const bf16x8 bfr = *(const LAS bf16x8*)(Ks + (16 * nt + fr) * 272 + (32 * ks + 8 * fq) * 2);
                    acc[nt] = MFMA16(a, bfr, acc[nt]);
                }
            }
#pragma unroll
            for (int nt = 0; nt < 4; ++nt) {
                const int cp = 16 * nt + fr; const float Gc2 = Gs[cp];
#pragma unroll
                for (int i = 0; i < 4; ++i) {
                    const int cr = 16 * mt + 4 * fq + i;
                    const float dec = __expf(Gs[cr] - Gc2);
                    if (!isqk) A32[cr * 65 + cp] = (cr > cp) ? Gs[64 + cr] * acc[nt][i] * dec : 0.f;
                    else *(LAS bf16_t*)(QKs + (cr * 64 + ppos(cp)) * 2) = f2bf((cr >= cp) ? acc[nt][i] * dec : 0.f);
                }
            }
        }
        __syncthreads();
        {
            float a[64];
#pragma unroll
            for (int jj = 0; jj < 64; ++jj) a[jj] = A32[lane * 65 + jj];
            float x[8];
#pragma unroll
            for (int cc = 0; cc < 8; ++cc) x[cc] = (lane == 8 * wid + cc) ? 1.f : 0.f;
#pragma unroll
            for (int jj = 0; jj < 64; ++jj) {
                if (jj >= 8 * wid) {
#pragma unroll
                    for (int cc = 0; cc < 8; ++cc) { const float xj = readlane_f(x[cc], jj); x[cc] -= a[jj] * xj; }
                }
            }
            u32x4 w; w.x = pk2(x[0], x[1]); w.y = pk2(x[2], x[3]); w.z = pk2(x[4], x[5]); w.w = pk2(x[6], x[7]);
            *(LAS u32x4*)(Ts + lane * 144 + wid * 16) = w;
            *(u32x4*)(ib + 81920 + tid * 16) = *(const LAS u32x4*)(QKs + tid * 16);
        }
        __syncthreads();
        {
            const bool isw = wid >= 4; const int n0 = 32 * (wid & 3);
            LAS unsigned char* Bs = isw ? KBt : VBt;
            f32x4 acc[4][2];
#pragma unroll
            for (int mt = 0; mt < 4; ++mt) { acc[mt][0] = (f32x4){0.f, 0.f, 0.f, 0.f}; acc[mt][1] = (f32x4){0.f, 0.f, 0.f, 0.f}; }
#pragma unroll
            for (int ks = 0; ks < 2; ++ks) {
                bf16x8 bfr[2];
#pragma unroll
                for (int nn = 0; nn < 2; ++nn) bfr[nn] = *(const LAS bf16x8*)(Bs + (n0 + 16 * nn + fr) * 144 + (32 * ks + 8 * fq) * 2);
#pragma unroll
                for (int mt = 0; mt < 4; ++mt) {
                    const bf16x8 a = *(const LAS bf16x8*)(Ts + (16 * mt + fr) * 144 + (32 * ks + 8 * fq) * 2);
                    acc[mt][0] = MFMA16(a, bfr[0], acc[mt][0]); acc[mt][1] = MFMA16(a, bfr[1], acc[mt][1]);
                }
            }
            if (!isw) {
                float* U = (float*)ib;
#pragma unroll
                for (int mt = 0; mt < 4; ++mt)
#pragma unroll
                    for (int nn = 0; nn < 2; ++nn) *(f32x4*)(U + (n0 + 16 * nn + fr) * 64 + 16 * mt + 4 * fq) = acc[mt][nn];
            } else {
#pragma unroll
                for (int mt = 0; mt < 4; ++mt)
#pragma unroll
                    for (int nn = 0; nn < 2; ++nn)
#pragma unroll
                        for (int i = 0; i < 4; ++i) *(LAS bf16_t*)(Qs + ((16 * mt + 4 * fq + i) * 128 + ppos(n0 + 16 * nn + fr)) * 2) = f2bf(acc[mt][nn][i]);
            }
        }
        __syncthreads();
        {
            *(u32x4*)(ib + 32768 + tid * 16) = *(const LAS u32x4*)(Qs + tid * 16);
            *(u32x4*)(ib + 32768 + 8192 + tid * 16) = *(const LAS u32x4*)(Qs + 8192 + tid * 16);
        }
        __syncthreads();
    }
}

DI void phase_scan(const Params& P, LAS unsigned char* lds, int layer) {
    int tid_ = threadIdx.x; asm volatile("" : "+v"(tid_)); const int tid = tid_, wid = __builtin_amdgcn_readfirstlane(tid >> 6), lane = tid & 63, G = gridDim.x;
    const int fr = lane & 15, fq = lane >> 4;
    unsigned char* ws = P.ws;
    const int j = layer >> 1;
    const bf16_t* proj = (const bf16_t*)(ws + WS_PROJ);
    const float* GL = (const float*)(ws + WS_GL);
    bf16_t* ORAW = (bf16_t*)(ws + WS_ORAWB);
    constexpr int BUFB = 57344;
    LAS float* red = (LAS float*)(lds + 2 * BUFB);

    for (int seq = blockIdx.x; seq < 160; seq += G) {
        int b, h, nch, item0, row0, nvalid; float* stout;
        f32x4 st[8];
        const int dvc = 16 * wid + fr;
        if (seq < 32) {
            b = seq >> 3; h = seq & 7; nch = 128; item0 = seq * 128; row0 = b * TP; nvalid = 64;
            stout = P.out + OFF_STP + ((size_t)(j * 4 + b) * 8 + h) * 16384;
#pragma unroll
            for (int mt = 0; mt < 8; ++mt) st[mt] = (f32x4){0.f, 0.f, 0.f, 0.f};
        } else {
            const int s = seq - 32; b = s >> 3; h = s & 7; nch = 1; item0 = NITEM_P + s; row0 = MP + b * TS; nvalid = TS;
            stout = P.out + OFF_STS + ((size_t)(j * 16 + b) * 8 + h) * 16384;
            const float* s0 = P.in[4] + ((size_t)(j * 16 + b) * 8 + h) * 16384;
            const unsigned s0o = (unsigned)(4 * fq * 128 + dvc);
#pragma unroll
            for (int mt = 0; mt < 8; ++mt)
#pragma unroll
                for (int i = 0; i < 4; ++i) st[mt][i] = s0[(unsigned)((16 * mt + i) * 128) + s0o];
        }
        const float onw = P.in[16][j * 128 + dvc];
        f32x4 un[4];
#define SCAN_G2L(itm, bufi, LN) do { const unsigned char* _ib = ws + WS_R1 + (size_t)(itm) * ITEM_BYTES + 32768; \
            _Pragma("unroll") for (int _p = 0; _p < 7; ++_p) { const int _L = (wid + 8 * _p) * 1024 + (LN) * 16; unsigned _src; \
                if (_p < 4) { const int _row = _L >> 8, _ch = (_L >> 4) & 15; _src = (_L & ~255) + ((_ch ^ (_row & 15)) << 4); } \
                else { const int _a = _L - 32768, _row = _a >> 7, _ch = (_a >> 4) & 7; _src = 32768 + (_a & ~127) + ((_ch ^ ((_row >> 1) & 7)) << 4); } \
                g2l16(_ib + _src, lds_u32(lds + (bufi) * BUFB + (wid + 8 * _p) * 1024)); } } while (0)
#define SCAN_LOADU(itm) do { const float* _u = (const float*)(ws + WS_R1 + (size_t)(itm) * ITEM_BYTES); const unsigned _uo = (unsigned)((16 * wid + fr) * 64 + 4 * fq); \
            _Pragma("unroll") for (int _m = 0; _m < 4; ++_m) un[_m] = *(const f32x4*)(_u + (unsigned)(16 * _m) + _uo); } while (0)
        __syncthreads();
        SCAN_G2L(item0, 0, lane);
        SCAN_LOADU(item0);
        float gln = GL[item0];
        asm volatile("s_waitcnt vmcnt(0)" ::: "memory");
        __syncthreads();
        for (int c = 0; c < nch; ++c) {
            int frq = lane; asm volatile("" : "+v"(frq));
            const int fr = frq & 15, fq = frq >> 4;
            LAS unsigned char* bb = lds + (c & 1) * BUFB;
            const float gl = gln;
            f32x4 u[4];
#pragma unroll
            for (int mt = 0; mt < 4; ++mt) u[mt] = un[mt];
            if (c + 1 < nch) { gln = GL[item0 + c + 1]; SCAN_G2L(item0 + c + 1, (c + 1) & 1, frq); SCAN_LOADU(item0 + c + 1); }
            const int x16 = fr << 4, x8 = ((fr >> 1) & 7) << 4;
            bf16x8 sf[4];
#pragma unroll
            for (int ks = 0; ks < 4; ++ks) {
                u32x4 w; w.x = pk2(-st[2 * ks][0], -st[2 * ks][1]); w.y = pk2(-st[2 * ks][2], -st[2 * ks][3]); w.z = pk2(-st[2 * ks + 1][0], -st[2 * ks + 1][1]); w.w = pk2(-st[2 * ks + 1][2], -st[2 * ks + 1][3]);
                sf[ks] = __builtin_bit_cast(bf16x8, w);
            }
            bf16x8 fa[4], fb[4];
#define SC_LD256(dst, base, mt) do { _Pragma("unroll") for (int _k = 0; _k < 4; ++_k) \
                dst[_k] = *(const LAS bf16x8*)(bb + (base) + (16 * (mt) + fr) * 256 + ((((4 * _k + fq) << 4)) ^ x16)); } while (0)
#define SC_LD128(dst, base, mtlo) do { _Pragma("unroll") for (int _m = 0; _m < 2; ++_m) _Pragma("unroll") for (int _k = 0; _k < 2; ++_k) \
                dst[_m * 2 + _k] = *(const LAS bf16x8*)(bb + (base) + (16 * ((mtlo) + _m) + fr) * 128 + ((((4 * _k + fq) << 4)) ^ x8)); } while (0)
#define SC_SB __builtin_amdgcn_sched_barrier(0)
#define SC_MU(f, mt) do { _Pragma("unroll") for (int _k = 0; _k < 4; ++_k) u[mt] = MFMA16(f[_k], sf[_k], u[mt]); } while (0)
#define SC_MO(f, mt) do { _Pragma("unroll") for (int _k = 0; _k < 4; ++_k) o[mt] = MFMA16(f[_k], sf[_k], o[mt]); } while (0)
#define SC_MQK(f, mtlo) do { _Pragma("unroll") for (int _m = 0; _m < 2; ++_m) _Pragma("unroll") for (int _k = 0; _k < 2; ++_k) o[(mtlo) + _m] = MFMA16(f[_m * 2 + _k], uf[_k], o[(mtlo) + _m]); } while (0)
#define SC_MKD(f, mtlo) do { _Pragma("unroll") for (int _m = 0; _m < 2; ++_m) { st[(mtlo) + _m] = st[(mtlo) + _m] * gl; _Pragma("unroll") for (int _k = 0; _k < 2; ++_k) st[(mtlo) + _m] = MFMA16(f[_m * 2 + _k], uf[_k], st[(mtlo) + _m]); } } while (0)
            f32x4 o[4];
#pragma unroll
            for (int mt = 0; mt < 4; ++mt) o[mt] = (f32x4){0.f, 0.f, 0.f, 0.f};
            SC_LD256(fa, 0, 0); SC_LD256(fb, 0, 1); SC_SB;
            SC_MU(fa, 0); SC_LD256(fa, 0, 2); SC_SB;
            SC_MU(fb, 1); SC_LD256(fb, 0, 3); SC_SB;
            SC_MU(fa, 2); SC_LD256(fa, 16384, 0); SC_SB;
            SC_MU(fb, 3); SC_LD256(fb, 16384, 1); SC_SB;
#pragma unroll
            for (int ks = 0; ks < 4; ++ks) sf[ks] = sf[ks] ^ (short)0x8000;
            SC_MO(fa, 0); SC_LD256(fa, 16384, 2); SC_SB;
            SC_MO(fb, 1); SC_LD256(fb, 16384, 3); SC_SB;
            SC_MO(fa, 2); SC_LD128(fa, 49152, 0); SC_SB;
            SC_MO(fb, 3); SC_LD128(fb, 49152, 2); SC_SB;
            bf16x8 uf[2];
#pragma unroll
            for (int k2 = 0; k2 < 2; ++k2) {
                u32x4 w; w.x = pk2(u[2 * k2][0], u[2 * k2][1]); w.y = pk2(u[2 * k2][2], u[2 * k2][3]); w.z = pk2(u[2 * k2 + 1][0], u[2 * k2 + 1][1]); w.w = pk2(u[2 * k2 + 1][2], u[2 * k2 + 1][3]);
                uf[k2] = __builtin_bit_cast(bf16x8, w);
            }
            SC_MQK(fa, 0); SC_LD128(fa, 32768, 0); SC_SB;
            SC_MQK(fb, 2); SC_LD128(fb, 32768, 2); SC_SB;
            SC_MKD(fa, 0); SC_LD128(fa, 32768, 4); SC_SB;
            SC_MKD(fb, 2); SC_LD128(fb, 32768, 6); SC_SB;
            SC_MKD(fa, 4); SC_SB;
            SC_MKD(fb, 6);
#undef SC_MU
#undef SC_MO
#undef SC_MQK
#undef SC_MKD
#undef SC_LD256
#undef SC_LD128
#undef SC_SB
            {
                bf16_t* obb = ORAW + (size_t)(row0 + 64 * c) * 1024 + h * 128;
                const unsigned oo = (unsigned)(4 * fq * 1024 + 16 * wid + fr);
#pragma unroll
                for (int mt = 0; mt < 4; ++mt)
#pragma unroll
                    for (int i = 0; i < 4; ++i) {
                        const int lr = 16 * mt + 4 * fq + i;
                        const bf16_t ob = f2bf(o[mt][i]);
                        if (lr < nvalid) obb[(unsigned)((16 * mt + i) * 1024) + oo] = ob;
                    }
            }
            asm volatile("s_waitcnt vmcnt(0)" ::: "memory");
            __syncthreads();
        }
        {
            int lz = lane; asm volatile("" : "+v"(lz));
            const unsigned so = (unsigned)(4 * (lz >> 4) * 128 + 16 * wid + (lz & 15));
#pragma unroll
            for (int mt = 0; mt < 8; ++mt)
#pragma unroll
                for (int i = 0; i < 4; ++i) stout[(unsigned)((16 * mt + i) * 128) + so] = st[mt][i];
        }
#undef SCAN_G2L
#undef SCAN_LOADU
    }
}

DI void phase_gnorm(const Params& P, int layer) {
    int tid_ = threadIdx.x; asm volatile("" : "+v"(tid_)); const int tid = tid_, wid = __builtin_amdgcn_readfirstlane(tid >> 6), lane = tid & 63, G = gridDim.x;
    unsigned char* ws = P.ws;
    const int j = layer >> 1;
    const bf16_t* ORAW = (const bf16_t*)(ws + WS_ORAWB);
    const bf16_t* proj = (const bf16_t*)(ws + WS_PROJ);
    bf16_t* OB = (bf16_t*)(ws + WS_HBUF);
    float onw[16];
#pragma unroll
    for (int e = 0; e < 16; ++e) onw[e] = P.in[16][j * 128 + ((16 * lane + e) & 127)];
    for (int r = blockIdx.x * 8 + wid; r < M; r += G * 8) {
        const u32x4 o0 = *(const u32x4*)(ORAW + (size_t)r * 1024 + 16 * lane), o1 = *(const u32x4*)(ORAW + (size_t)r * 1024 + 16 * lane + 8);
        const u32x4 z0 = *(const u32x4*)(proj + (size_t)r * NPROJ + 3072 + 16 * lane), z1 = *(const u32x4*)(proj + (size_t)r * NPROJ + 3072 + 16 * lane + 8);
        float ov[16], zv[16];
        { float t8[8]; unpack8(o0, t8);
#pragma unroll
          for (int e = 0; e < 8; ++e) ov[e] = t8[e];
          unpack8(o1, t8);
#pragma unroll
          for (int e = 0; e < 8; ++e) ov[8 + e] = t8[e];
          unpack8(z0, t8);
#pragma unroll
          for (int e = 0; e < 8; ++e) zv[e] = t8[e];
          unpack8(z1, t8);
#pragma unroll
          for (int e = 0; e < 8; ++e) zv[8 + e] = t8[e]; }
        float ss = 0.f;
#pragma unroll
        for (int e = 0; e < 16; ++e) ss += ov[e] * ov[e];
        ss += __shfl_xor(ss, 1); ss += __shfl_xor(ss, 2); ss += __shfl_xor(ss, 4);
        const float rstd = __builtin_amdgcn_rsqf(ss * (1.f / 128.f) + RMS_EPS);
        float y[16];
#pragma unroll
        for (int e = 0; e < 16; ++e) y[e] = ov[e] * rstd * onw[e] * siluf(zv[e]);
        u32x4 w0, w1;
        w0.x = pk2(y[0], y[1]); w0.y = pk2(y[2], y[3]); w0.z = pk2(y[4], y[5]); w0.w = pk2(y[6], y[7]);
        w1.x = pk2(y[8], y[9]); w1.y = pk2(y[10], y[11]); w1.z = pk2(y[12], y[13]); w1.w = pk2(y[14], y[15]);
        *(u32x4*)(OB + (size_t)r * 1024 + 16 * lane) = w0; *(u32x4*)(OB + (size_t)r * 1024 + 16 * lane + 8) = w1;
    }
}

DI void att_s(LAS unsigned char* Ka, int t, const bf16x8 (&qf)[4], f32x16& s0, f32x16& s1) {
#pragma unroll
    for (int i = 0; i < 16; ++i) { s0[i] = 0.f; s1[i] = 0.f; }
    bf16x8 kf[8];
#pragma unroll
    for (int s = 0; s < 4; ++s) { kf[2 * s] = *(const LAS bf16x8*)(Ka + (t ^ (s << 5))); kf[2 * s + 1] = *(const LAS bf16x8*)(Ka + 8192 + (t ^ (s << 5))); }
#pragma unroll
    for (int s = 0; s < 4; ++s) { s0 = MFMA32(kf[2 * s], qf[s], s0); s1 = MFMA32(kf[2 * s + 1], qf[s], s1); }
}
template <bool MASK>
DI float att_softmax(f32x16& s0, f32x16& s1, float& m, float& l, bf16x8 (&pf)[2][2], int h2, int nvk) {
    if (MASK) {
#pragma unroll
        for (int i = 0; i < 16; ++i) {
            const int key = (i & 3) + 8 * (i >> 2) + 4 * h2;
            s0[i] = (key < nvk) ? s0[i] : -INFINITY;
            s1[i] = (32 + key < nvk) ? s1[i] : -INFINITY;
        }
    }
    float mx = s0[0];
#pragma unroll
    for (int i = 1; i < 16; ++i) mx = fmaxf(mx, s0[i]);
#pragma unroll
    for (int i = 0; i < 16; ++i) mx = fmaxf(mx, s1[i]);
    mx = fmaxf(mx, __shfl_xor(mx, 32));
    const float mn = fmaxf(m, mx);
    const float alpha = __builtin_amdgcn_exp2f(m - mn);
    m = mn;
    float ps = 0.f;
#pragma unroll
    for (int i = 0; i < 16; ++i) { s0[i] = __builtin_amdgcn_exp2f(s0[i] - mn); s1[i] = __builtin_amdgcn_exp2f(s1[i] - mn); ps += s0[i] + s1[i]; }
    l = l * alpha + ps;
    u32x4 w;
    w.x = pk2(s0[0], s0[1]); w.y = pk2(s0[2], s0[3]); w.z = pk2(s0[4], s0[5]); w.w = pk2(s0[6], s0[7]); pf[0][0] = __builtin_bit_cast(bf16x8, w);
    w.x = pk2(s0[8], s0[9]); w.y = pk2(s0[10], s0[11]); w.z = pk2(s0[12], s0[13]); w.w = pk2(s0[14], s0[15]); pf[0][1] = __builtin_bit_cast(bf16x8, w);
    w.x = pk2(s1[0], s1[1]); w.y = pk2(s1[2], s1[3]); w.z = pk2(s1[4], s1[5]); w.w = pk2(s1[6], s1[7]); pf[1][0] = __builtin_bit_cast(bf16x8, w);
    w.x = pk2(s1[8], s1[9]); w.y = pk2(s1[10], s1[11]); w.z = pk2(s1[12], s1[13]); w.w = pk2(s1[14], s1[15]); pf[1][1] = __builtin_bit_cast(bf16x8, w);
    return alpha;
}
DI void att_pv(LAS unsigned char* Va, int q4, f32x16 (&O)[4], const bf16x8 (&pf)[2][2]) {
    s16x4 lo[16], hi[16];
#define PV_LD(i) do { LAS unsigned char* _vp = Va + ((((i) >> 2) ^ q4) << 6) + (32 * (((i) >> 1) & 1) + 16 * ((i) & 1)) * 256; \
        lo[i] = __builtin_amdgcn_ds_read_tr16_b64_v4i16((LAS s16x4*)_vp); hi[i] = __builtin_amdgcn_ds_read_tr16_b64_v4i16((LAS s16x4*)(_vp + 8 * 256)); } while (0)
    PV_LD(0); PV_LD(1); PV_LD(2);
#pragma unroll
    for (int i = 0; i < 16; ++i) {
        if (i + 3 < 16) PV_LD(i + 3);
        const bf16x8 vf = __builtin_shufflevector(lo[i], hi[i], 0, 1, 2, 3, 4, 5, 6, 7);
        O[i >> 2] = MFMA32(vf, pf[(i >> 1) & 1][i & 1], O[i >> 2]);
    }
#undef PV_LD
}

DI void phase_attn(const Params& P, LAS unsigned char* lds, int layer) {
    int tid_ = threadIdx.x; asm volatile("" : "+v"(tid_)); const int tid = tid_, wid = __builtin_amdgcn_readfirstlane(tid >> 6), lane = tid & 63, G = gridDim.x;
    unsigned char* ws = P.ws;
    const int j = layer >> 1;
    const int comp = wid >> 2, rg = wid & 3, r32 = lane & 31, h2 = lane >> 5;
    const bf16_t* proj = (const bf16_t*)(ws + WS_PROJ);
    bf16_t* OB = (bf16_t*)(ws + WS_HBUF);
    const float lam_init = 0.8f - 0.6f * expf(-0.3f * (float)layer);
    float lam;
    {
        float d1 = 0.f, d2 = 0.f;
        for (int i = 0; i < 64; ++i) { d1 += P.in[19][j * 64 + i] * P.in[20][j * 64 + i]; d2 += P.in[21][j * 64 + i] * P.in[22][j * 64 + i]; }
        lam = expf(d1) - expf(d2) + lam_init;
    }
    const float* subln = P.in[23] + j * 128;
    constexpr int TB = 32768;
    const int vb = (G % 8 == 0) ? (blockIdx.x % 8) * (G / 8) + blockIdx.x / 8 : blockIdx.x;
    const int nrounds = (G == 256) ? 9 : (2176 + G - 1) / G;
#define ATT_WAITV(n) asm volatile("s_waitcnt vmcnt(" #n ")" ::: "memory")
#define ATT_BAR() do { asm volatile("" ::: "memory"); __builtin_amdgcn_s_barrier(); asm volatile("" ::: "memory"); } while (0)
    for (int k = 0; k < nrounds; ++k) {
        int id;
        if (G == 256) {
            if (k < 8) { const int xcd = vb >> 5, idx = vb & 31; const int seq = xcd * 4 + (k >> 1); const int qt = (k & 1) ? idx : (63 - idx); id = seq * 64 + qt; }
            else { if (vb >= 128) break; id = 2048 + vb; }
        } else { id = vb + k * G; if (id >= 2176) break; }
        int h, qrow0, nt_all, nt_mine, last_valid; const int kvstride = 128; const bf16_t* Kp; const bf16_t* Vp; bool sample;
        if (id < 2048) {
            const int seq = id >> 6, qt = id & 63, b = seq >> 3; h = seq & 7; sample = false;
            qrow0 = b * TP + 128 * qt + 32 * rg; nt_all = 2 * qt + 2; nt_mine = (rg < 2) ? 2 * qt + 1 : 2 * qt + 2; last_valid = 64 * nt_mine;
            Kp = (const bf16_t*)(ws + WS_KH) + (size_t)seq * TP * 128; Vp = (const bf16_t*)(ws + WS_VH) + (size_t)seq * TP * 128;
        } else {
            const int s = id - 2048, b = s >> 3; h = s & 7; sample = true;
            qrow0 = MP + b * TS; nt_all = 34; nt_mine = (rg == 0) ? 34 : 0; last_valid = PAST + TS;
            Kp = (const bf16_t*)(ws + WS_KS) + (size_t)s * KSROWS * 128; Vp = (const bf16_t*)(ws + WS_VS) + (size_t)s * KSROWS * 128;
        }
        bf16x8 qf[4];
        {
            const int qr = qrow0 + (sample ? (r32 & 15) : r32);
            const bf16_t* qp = proj + (size_t)qr * NPROJ + h * 128 + comp * 64 + 8 * h2;
#pragma unroll
            for (int s = 0; s < 4; ++s) qf[s] = *(const bf16x8*)(qp + 16 * s);
        }
        f32x16 O[4];
#pragma unroll
        for (int et = 0; et < 4; ++et)
#pragma unroll
            for (int i = 0; i < 16; ++i) O[et][i] = 0.f;
        float m = -INFINITY, l = 0.f;
        bf16x8 pf[2][2];
#pragma unroll
        for (int a = 0; a < 2; ++a)
#pragma unroll
            for (int c2 = 0; c2 < 2; ++c2) pf[a][c2] = (bf16x8){0, 0, 0, 0, 0, 0, 0, 0};
        f32x16 sA0, sA1, sB0, sB1;
        const bf16_t* gsrc;
        {
            const int rowl = lane >> 4, c = lane & 15;
            const int row0 = 16 * (wid & 3) + rowl;
            const int lc = (wid < 4) ? (c ^ (row0 & 15)) : (c ^ ((row0 & 3) << 2));
            gsrc = ((wid < 4) ? Kp : Vp) + (size_t)row0 * kvstride + lc * 8;
        }
#define ATT_G2L(kt, bufi) do { _Pragma("unroll") for (int _i = 0; _i < 4; ++_i) { \
            const bf16_t* _s = gsrc + (size_t)(64 * (kt) + 4 * _i) * kvstride; \
            if (wid < 4) _s += (((lane & 15) ^ ((16 * (wid & 3) + 4 * _i + (lane >> 4)) & 15)) - ((lane & 15) ^ ((16 * (wid & 3) + (lane >> 4)) & 15))) * 8; \
            g2l16(_s, lds_u32(lds + (bufi) * TB + (4 * wid + _i) * 1024)); } } while (0)
        asm volatile("" :: "v"(qf[0]), "v"(qf[1]), "v"(qf[2]), "v"(qf[3]));
        __syncthreads();
        ATT_G2L(0, 0);
        if (nt_all > 1) { ATT_G2L(1, 1); ATT_WAITV(4); } else { ATT_WAITV(0); }
        ATT_BAR();
        {
            const int koff = r32 * 256, t = ((comp * 8 + h2) ^ (r32 & 15)) << 4;
            att_s(lds + koff, t, qf, sA0, sA1);
        }
#define ATT_ITER(KT, sC0, sC1, sN0, sN1, EDGE) do { \
            const int kt = (KT); \
            int lo_ = lane; asm volatile("" : "+v"(lo_)); \
            const int r32_ = lo_ & 31, h2_ = lo_ >> 5, q4_ = (lo_ & 15) >> 2, p4_ = lo_ & 3, blk_ = (lo_ >> 4) & 1; \
            const int koff_ = r32_ * 256, t_ = ((comp * 8 + h2_) ^ (r32_ & 15)) << 4; \
            const int voff_ = (4 * h2_ + q4_) * 256 + (2 * blk_ + (p4_ >> 1)) * 16 + (p4_ & 1) * 8; \
            ATT_WAITV(0); ATT_BAR(); \
            if (kt + 2 < nt_all) ATT_G2L(kt + 2, (kt + 2) & 3); \
            att_s(lds + ((kt + 1) & 3) * TB + koff_, t_, qf, sN0, sN1); \
            if (!(EDGE) || kt >= 1) att_pv(lds + ((kt - 1) & 3) * TB + 16384 + voff_, q4_, O, pf); \
            const float alpha = att_softmax<EDGE>(sC0, sC1, m, l, pf, h2_, last_valid - 64 * kt); \
            asm volatile("" :: "v"(l), "v"(pf[0][0]), "v"(pf[0][1]), "v"(pf[1][0]), "v"(pf[1][1]));     \
            _Pragma("unroll") for (int _g = 0; _g < 24; ++_g) { __builtin_amdgcn_sched_group_barrier(0x008, 1, 0); __builtin_amdgcn_sched_group_barrier(0x002, 7, 0); } \
            if (__any(alpha != 1.f)) { \
                _Pragma("unroll") for (int et = 0; et < 4; ++et) _Pragma("unroll") for (int i = 0; i < 16; ++i) O[et][i] *= alpha; } \
            } while (0)
        {
            const int npairs = nt_all >> 1;
            ATT_ITER(0, sA0, sA1, sB0, sB1, true);
            ATT_ITER(1, sB0, sB1, sA0, sA1, true);
            for (int pp = 1; pp < npairs - 1; ++pp) {
                ATT_ITER(2 * pp, sA0, sA1, sB0, sB1, false);
                ATT_ITER(2 * pp + 1, sB0, sB1, sA0, sA1, false);
            }
            if (npairs > 1) {
                ATT_ITER(nt_all - 2, sA0, sA1, sB0, sB1, true);
                ATT_ITER(nt_all - 1, sB0, sB1, sA0, sA1, true);
            }
        }
        {
            const int lt = nt_all - 1;
            const int h2b = lane >> 5, q4 = (lane & 15) >> 2, p4 = lane & 3, blk = (lane >> 4) & 1;
            const int voff = (4 * h2b + q4) * 256 + (2 * blk + (p4 >> 1)) * 16 + (p4 & 1) * 8;
            att_pv(lds + (lt & 3) * TB + 16384 + voff, q4, O, pf);
        }
        __syncthreads();
#undef ATT_ITER
#undef ATT_G2L
        const float lt = l + __shfl_xor(l, 32);
        const float inv = (nt_mine > 0) ? 1.f / lt : 0.f;
        LAS float* XO = (LAS float*)lds;
        if (comp == 1) {
            const float sc = inv * lam;
#pragma unroll
            for (int et = 0; et < 4; ++et)
#pragma unroll
                for (int i = 0; i < 16; ++i) XO[(rg * 128 + 32 * et + (i & 3) + 8 * (i >> 2) + 4 * h2) * 32 + r32] = O[et][i] * sc;
        }
        __syncthreads();
        if (comp == 0 && nt_mine > 0) {
            float ss = 0.f;
#pragma unroll
            for (int et = 0; et < 4; ++et)
#pragma unroll
                for (int i = 0; i < 16; ++i) { const float v = O[et][i] * inv - XO[(rg * 128 + 32 * et + (i & 3) + 8 * (i >> 2) + 4 * h2) * 32 + r32]; O[et][i] = v; ss += v * v; }
            ss += __shfl_xor(ss, 32);
            const float rstd = __builtin_amdgcn_rsqf(ss * (1.f / 128.f) + RMS_EPS) * (1.f - lam_init);
            const bool rvalid = sample ? (r32 < TS) : true;
            const int row = qrow0 + r32;
            if (rvalid) {
#pragma unroll
                for (int et = 0; et < 4; ++et)
#pragma unroll
                    for (int g4 = 0; g4 < 4; ++g4) {
                        const int e0 = 32 * et + 8 * g4 + 4 * h2;
                        const u32x2 zz = *(const u32x2*)(proj + (size_t)row * NPROJ + 3072 + h * 128 + e0);
                        const f32x4 sl = *(const f32x4*)(subln + e0);
                        const float z0 = __uint_as_float(zz.x << 16), z1 = __uint_as_float(zz.x & 0xffff0000u), z2 = __uint_as_float(zz.y << 16), z3 = __uint_as_float(zz.y & 0xffff0000u);
                        u32x2 w;
                        w.x = pk2(O[et][4 * g4] * rstd * sl[0] * siluf(z0), O[et][4 * g4 + 1] * rstd * sl[1] * siluf(z1));
                        w.y = pk2(O[et][4 * g4 + 2] * rstd * sl[2] * siluf(z2), O[et][4 * g4 + 3] * rstd * sl[3] * siluf(z3));
                        *(u32x2*)(OB + (size_t)row * 1024 + h * 128 + e0) = w;
                    }
            }
        }
        __syncthreads();
    }
}


#define XB_TMO      128
#define XB_XCNT(j)  (256  + 64 * (j))
#define XB_XSUB(j)  (1280 + 64 * (j))
#define XB_XGEN(j)  (2304 + 64 * (j))
#define XB_TOP      3328
#define XB_TOPGEN   3392
#define XCD_BAR_WORDS 3456
#define XB_SPIN_CAP (1u << 18)
DI unsigned xb_ld(unsigned* p)              { return __hip_atomic_load(p, __ATOMIC_RELAXED, __HIP_MEMORY_SCOPE_AGENT); }
DI unsigned xb_add(unsigned* p, unsigned v) { return __hip_atomic_fetch_add(p, v, __ATOMIC_RELAXED, __HIP_MEMORY_SCOPE_AGENT); }
DI unsigned xb_xcc_id() { return (unsigned)__builtin_amdgcn_s_getreg((3 << 11) | 20) & 0xFu; }
#define XB_SPIN(cond, bar) do { unsigned _sp = 0; while (cond) { __builtin_amdgcn_s_sleep(1); \
    if ((++_sp & 255u) == 0u) { if (xb_ld(&(bar)[XB_TMO])) break; if (_sp > XB_SPIN_CAP) { atomicAdd(&(bar)[XB_TMO], 1u); break; } } } } while (0)
DI void xcd_barrier_complete(unsigned* bar, unsigned x, unsigned& nloc, unsigned& nx) {
    const unsigned G = gridDim.x * gridDim.y * gridDim.z;
    unsigned sum, cnt, mine, sp = 0u;
    for (;;) {
        sum = 0u; cnt = 0u; mine = 0u;
#pragma unroll
        for (unsigned j = 0; j < 16; ++j) { const unsigned c = xb_ld(&bar[XB_XCNT(j)]); sum += c; cnt += (c > 0u) ? 1u : 0u; mine = (j == x) ? c : mine; }
        if (sum == G) break;
        __builtin_amdgcn_s_sleep(1);
        if ((++sp & 255u) == 0u) { if (xb_ld(&bar[XB_TMO])) break; if (sp > XB_SPIN_CAP) { atomicAdd(&bar[XB_TMO], 1u); break; } }
    }
    nloc = mine > 0u ? mine : 1u; nx = cnt > 0u ? cnt : 1u;
}
DI void xcd_barrier(unsigned* bar, volatile LAS unsigned* st) {
    asm volatile("s_waitcnt vmcnt(0)" ::: "memory");
    __syncthreads();
    if (threadIdx.x == 0) {
        const unsigned x = xb_xcc_id();
        __builtin_amdgcn_s_waitcnt(0);
        unsigned nloc = st[0], nx = st[1];
        if (nloc == 0u) { xcd_barrier_complete(bar, x, nloc, nx); st[0] = nloc; st[1] = nx; }
        const unsigned old = xb_add(&bar[XB_XSUB(x)], 1u);
        const unsigned gen = old / nloc;
        if (old + 1u == (gen + 1u) * nloc) {
            __builtin_amdgcn_fence(__ATOMIC_RELEASE, "agent");
            asm volatile("s_waitcnt vmcnt(0)" ::: "memory");
            const unsigned og = xb_add(&bar[XB_TOP], 1u);
            const unsigned tg = og / nx;
            if (og + 1u == (tg + 1u) * nx) xb_add(&bar[XB_TOPGEN], 1u);
            else XB_SPIN(xb_ld(&bar[XB_TOPGEN]) == tg, bar);
            __builtin_amdgcn_fence(__ATOMIC_ACQUIRE, "agent");
            xb_add(&bar[XB_XGEN(x)], 1u);
            asm volatile("s_waitcnt vmcnt(0)" ::: "memory");
        } else {
            XB_SPIN(xb_ld(&bar[XB_XGEN(x)]) == gen, bar);
            __builtin_amdgcn_fence(__ATOMIC_ACQUIRE, "agent");
            asm volatile("s_waitcnt vmcnt(0)" ::: "memory");
        }
    }
    __syncthreads();
}

typedef const __attribute__((address_space(4))) Params* CParP;
#define LOADP() Params P; { CParP kp_ = KP; asm volatile("" : "+s"(kp_)); P = *kp_; } unsigned char* ws = P.ws; (void)ws
__global__ void __launch_bounds__(512, 2) fwd_megakernel(Params Pin) {
#if defined(__HIP_DEVICE_COMPILE__)
    extern __shared__ __attribute__((aligned(16))) unsigned char lds_raw[];
    LAS unsigned char* lds = (LAS unsigned char*)lds_raw;
    cg::grid_group grid = cg::this_grid();
    const CParP KP = (CParP)__builtin_amdgcn_kernarg_segment_ptr();
    volatile LAS unsigned* xst = (volatile LAS unsigned*)(lds + 131072);
    if (threadIdx.x == 0) { xst[0] = 0u; xst[1] = 0u; }
    __syncthreads();
    { LOADP(); if (threadIdx.x == 0) (void)xb_add(&((unsigned*)(ws + WS_BAR))[XB_XCNT(xb_xcc_id())], 1u); }
#define GRID_BAR() do { LOADP(); xcd_barrier((unsigned*)(ws + WS_BAR), xst); } while (0)
    { LOADP(); phase_prep(P, lds); }
    grid.sync();
    for (int layer = 0; layer < 4; ++layer) {
        const int j = layer >> 1;
        { LOADP(); phase_elem(P, lds, layer); }
        GRID_BAR();
        {
            LOADP();
            pg8::StaticOrder S; S.init(M, NPROJ, gridDim.x, blockIdx.x);
            pg8::Gemm g;
            g.A = (const bf16_t*)(ws + WS_HBUF); g.M = M; g.N = NPROJ; g.K = 1024;
            if (!(layer & 1)) {
                g.Bt = (const bf16_t*)(ws + WS_WING) + (size_t)j * 4096 * 1024;
                EpiGdnIn E; E.proj = (bf16_t*)(ws + WS_PROJ); E.conv_p = P.out + OFF_CVP + (size_t)j * 4 * 3 * 3072; E.conv_s = P.out + OFF_CVS + (size_t)j * 16 * 3 * 3072;
                pg8::gemm_phase(lds, g, S, E);
            } else {
                g.Bt = (const bf16_t*)(ws + WS_WIND) + (size_t)j * 4096 * 1024;
                EpiDiffIn E; E.proj = (bf16_t*)(ws + WS_PROJ);
                E.k_p = P.out + OFF_KP + (size_t)j * MP * 1024; E.v_p = P.out + OFF_VP + (size_t)j * MP * 1024;
                E.k_s = P.out + OFF_KSO + (size_t)j * MS * 1024; E.v_s = P.out + OFF_VSO + (size_t)j * MS * 1024;
                E.ks = (bf16_t*)(ws + WS_KS); E.vs = (bf16_t*)(ws + WS_VS); E.kh = (bf16_t*)(ws + WS_KH); E.vh = (bf16_t*)(ws + WS_VH); E.rope = (const float*)(ws + WS_ROPE);
                pg8::gemm_phase(lds, g, S, E);
            }
        }
        GRID_BAR();
        if (!(layer & 1)) {
            { LOADP(); phase_g1(P, lds, layer); }
            GRID_BAR();
            { LOADP(); phase_scan(P, lds, layer); }
            GRID_BAR();
            { LOADP(); phase_gnorm(P, layer); }
        } else {
            { LOADP(); phase_attn(P, lds, layer); }
        }
        GRID_BAR();
        {
            LOADP();
            pg8::StaticOrder S; S.init(M, 1024, gridDim.x, blockIdx.x);
            pg8::Gemm g;
            g.A = (const bf16_t*)(ws + WS_HBUF); g.M = M; g.N = 1024; g.K = 1024;
            g.Bt = (const bf16_t*)(ws + ((layer & 1) ? WS_WOUTD : WS_WOUTG)) + (size_t)j * 1024 * 1024;
            EpiOut E; E.C = (bf16_t*)(ws + WS_PROJ);
            pg8::gemm_phase(lds, g, S, E);
        }
        GRID_BAR();
    }
    { LOADP(); phase_elem(P, lds, 4); }
#endif
}

extern "C" void kernel_launch(void* const* d_in, const int* in_sizes, int n_in, void* d_out, int out_size, void* d_ws, size_t ws_size, hipStream_t stream) {
    static int grid_blocks = 0;
    if (!grid_blocks) {
        int dev = 0, cus = 0, per_cu = 0;
        hipGetDevice(&dev);
        hipDeviceGetAttribute(&cus, hipDeviceAttributeMultiprocessorCount, dev);
        hipFuncSetAttribute((const void*)fwd_megakernel, hipFuncAttributeMaxDynamicSharedMemorySize, LDS_BYTES);
        hipOccupancyMaxActiveBlocksPerMultiprocessor(&per_cu, (const void*)fwd_megakernel, 512, LDS_BYTES);
        if (per_cu < 1) per_cu = 1;
        grid_blocks = cus * per_cu;
        if (ws_size < WS_END) fprintf(stderr, "kernel_launch: workspace too small: %zu < %zu\n", ws_size, (size_t)WS_END);
    }
    hipMemsetAsync((unsigned char*)d_ws + WS_BAR, 0, XCD_BAR_WORDS * sizeof(unsigned), stream);
    Params p{};
    for (int i = 0; i < 25; ++i) p.in[i] = (const float*)d_in[i];
    p.out = (float*)d_out; p.ws = (unsigned char*)d_ws;
    void* args[] = {&p};
    hipError_t e = hipLaunchCooperativeKernel((const void*)fwd_megakernel, dim3(grid_blocks), dim3(512), args, LDS_BYTES, stream);
    if (e != hipSuccess) fprintf(stderr, "cooperative launch failed: %s (grid %d)\n", hipGetErrorString(e), grid_blocks);
}
```

```cpp
#include <hip/hip_runtime.h>
#include <hip/hip_cooperative_groups.h>
#include <cstdio>
namespace cg = cooperative_groups;

#define DI __device__ __forceinline__
#define LAS __attribute__((address_space(3)))
typedef unsigned short bf16_t;
typedef short bf16x8 __attribute__((ext_vector_type(8)));
typedef short s16x4 __attribute__((ext_vector_type(4)));
typedef float f32x2 __attribute__((ext_vector_type(2)));
typedef float f32x4 __attribute__((ext_vector_type(4)));
typedef float f32x16 __attribute__((ext_vector_type(16)));
typedef unsigned u32x2 __attribute__((ext_vector_type(2)));
typedef unsigned u32x4 __attribute__((ext_vector_type(4)));
typedef __bf16 bf16x2_t __attribute__((ext_vector_type(2)));

#define REP_G1 1
#define REP_SCAN 1
#define REP_ATTN 1
#define REP_GIN 1
#define REP_GOUT 1
#define REP_PREP 1
DI int opaque_i(int v) { asm volatile("" : "+s"(v)); return v; }
constexpr int D = 1024, TP = 8192, BP = 4, BS = 16, TS = 16, PAST = 2048;
constexpr int MP = BP * TP, MS = BS * TS, M = MP + MS, NB = BP + BS;
constexpr int NPROJ = 4096;
constexpr int KSROWS = 2112;
constexpr int NITEM_P = 4096, NITEM = 4224;
constexpr size_t ITEM_BYTES = 90112;
constexpr float RMS_EPS = 1e-6f;
constexpr float QSCALE = 0.125f * 1.4426950408889634f;

constexpr size_t OFF_Y = 0;
constexpr size_t OFF_STP = (size_t)M * D;
constexpr size_t OFF_CVP = OFF_STP + 2ull * 4 * 8 * 128 * 128;
constexpr size_t OFF_KP = OFF_CVP + 2ull * 4 * 3 * 3072;
constexpr size_t OFF_VP = OFF_KP + 2ull * MP * 1024;
constexpr size_t OFF_STS = OFF_VP + 2ull * MP * 1024;
constexpr size_t OFF_CVS = OFF_STS + 2ull * 16 * 8 * 128 * 128;
constexpr size_t OFF_KSO = OFF_CVS + 2ull * 16 * 3 * 3072;
constexpr size_t OFF_VSO = OFF_KSO + 2ull * MS * 1024;

constexpr size_t WS_WING = 0;
constexpr size_t WS_WOUTG = WS_WING + 2ull * 4096 * 1024 * 2;
constexpr size_t WS_WIND = WS_WOUTG + 2ull * 1024 * 1024 * 2;
constexpr size_t WS_WOUTD = WS_WIND + 2ull * 4096 * 1024 * 2;
constexpr size_t WS_ADA = WS_WOUTD + 2ull * 1024 * 1024 * 2;
constexpr size_t WS_ROPE = WS_ADA + 4ull * NB * 3072 * 4;
constexpr size_t WS_AB = WS_ROPE + 8208ull * 64 * 4;
constexpr size_t WS_GL = WS_AB + (size_t)M * 16 * 4;
constexpr size_t WS_BAR = WS_GL + 17408;
constexpr size_t WS_HBUF = WS_GL + 32768;
constexpr size_t WS_ORAW = WS_HBUF + (size_t)M * 1024 * 2;
constexpr size_t WS_PROJ = WS_ORAW + 256;
constexpr size_t WS_R1 = WS_PROJ + (size_t)M * 4096 * 2;
constexpr size_t WS_KH = WS_R1;
constexpr size_t WS_VH = WS_KH + (size_t)MP * 1024 * 2;
constexpr size_t WS_ORAWB = WS_R1 + (size_t)NITEM * ITEM_BYTES;
constexpr size_t WS_KS = WS_ORAWB + (size_t)M * 1024 * 2;
constexpr size_t WS_VS = WS_KS + 16ull * KSROWS * 1024 * 2;
constexpr size_t WS_END = WS_VS + 16ull * KSROWS * 1024 * 2;

constexpr int LDS_BYTES = 131072 + 16;

struct Params { const float* in[25]; float* out; unsigned char* ws; };

DI float bf2f(bf16_t v) { return __uint_as_float(((unsigned)v) << 16); }
DI unsigned pk2(float a, float b) { f32x2 v = {a, b}; bf16x2_t r = __builtin_convertvector(v, bf16x2_t); return __builtin_bit_cast(unsigned, r); }
DI bf16_t f2bf(float a) { return (bf16_t)(pk2(a, 0.f) & 0xffffu); }
template <int CTRL> DI float dppf(float v) { return __builtin_bit_cast(float, __builtin_amdgcn_update_dpp(0, __builtin_bit_cast(int, v), CTRL, 0xf, 0xf, true)); }
DI float row_sum16(float v) { v += dppf<0x128>(v); v += dppf<0x124>(v); v += dppf<0x122>(v); v += dppf<0x121>(v); return v; }
DI float wave_sum(float v) { v = row_sum16(v); v += __shfl_xor(v, 16); v += __shfl_xor(v, 32); return v; }
DI float readlane_f(float v, int l) { return __builtin_bit_cast(float, __builtin_amdgcn_readlane(__builtin_bit_cast(int, v), l)); }
DI float siluf(float x) { return x * __builtin_amdgcn_rcpf(1.f + __expf(-x)); }
DI int ppos(int idx) { const int d5 = idx & 31; return (idx & ~31) | (((d5 >> 2) & 3) << 3) | ((d5 >> 4) << 2) | (d5 & 3); }
DI int perm64(int ls) { return (ls & 15) | (((ls >> 4) & 1) << 5) | (((ls >> 5) & 1) << 4); }
DI void unpack8(const u32x4 v, float (&o)[8]) {
#pragma unroll
    for (int i = 0; i < 4; ++i) { o[2 * i] = __uint_as_float(v[i] << 16); o[2 * i + 1] = __uint_as_float(v[i] & 0xffff0000u); }
}
DI void g2l16(const void* gptr, unsigned lds_addr) {
    asm volatile("s_mov_b32 m0, %1\n\ts_nop 0\n\tglobal_load_lds_dwordx4 %0, off" :: "v"(gptr), "s"(lds_addr) : "memory", "m0");
}
DI unsigned lds_u32(LAS unsigned char* p) { return (unsigned)(size_t)p; }
#define MFMA16(a, b, c) __builtin_amdgcn_mfma_f32_16x16x32_bf16((a), (b), (c), 0, 0, 0)
#define MFMA32(a, b, c) __builtin_amdgcn_mfma_f32_32x32x16_bf16((a), (b), (c), 0, 0, 0)

namespace pg8 {
constexpr int BM = 256, BK = 64, HALF = 128, HTB = HALF * BK * 2, STAGE_BYTES = 8 * HTB, NXCD = 8, WGM = 8;
DI int lds_byte(int r, int c) { const int st = (r >> 4) * 2 + (c >> 5), rr = r & 15, cc = c & 31, ob = rr * 64 + cc * 2; return st * 1024 + (ob ^ (((ob >> 9) & 1) << 5)); }
DI void stage_rc(int b, int& R, int& C) { const int st = b / 1024, sb = b % 1024, swz = sb ^ (((sb >> 9) & 1) << 5); R = (st >> 1) * 16 + swz / 64; C = (st & 1) * 32 + (swz % 64) / 2; }
struct Unit { int pm, pn; };
struct Gemm { const bf16_t* A; const bf16_t* Bt; int M, N, K; };
struct StaticOrder {
    int nM, nN, nwg, G, c;
    DI void init(int M_, int N_, int G_, int c_) { nM = M_ / BM; nN = N_ / BM; nwg = nM * nN; G = G_; c = c_; }
    DI bool next(int i, Unit& u) const {
        const long L = (long)i * G + c; if (L >= nwg) return false;
        int wgid = (int)L; { const int q = nwg / NXCD, r = nwg % NXCD, xcd = wgid % NXCD, off = wgid / NXCD; wgid = (xcd < r ? xcd * (q + 1) : r * (q + 1) + (xcd - r) * q) + off; }
        const int nig = WGM * nN, gid = wgid / nig, fm = gid * WGM, gsz = (nM - fm) < WGM ? (nM - fm) : WGM;
        u.pm = fm + ((wgid % nig) % gsz); u.pn = (wgid % nig) / gsz; return true;
    }
};

template <class Epi>
DI void gemm_phase(LAS unsigned char* lds, const Gemm g, const StaticOrder& S, const Epi& E) {
    int tid_ = threadIdx.x; asm volatile("" : "+v"(tid_)); const int tid = tid_, wid = __builtin_amdgcn_readfirstlane(tid >> 6), lane = tid & 63, wr = wid >> 2, wc = wid & 3, fr = lane & 15, fq = lane >> 4;
    const int K = g.K, nt = K / BK;
    unsigned voffA[2];
#pragma unroll
    for (int i = 0; i < 2; ++i) { int R, C; stage_rc(tid * 16 + i * 8192, R, C); voffA[i] = (unsigned)(R * K + C) * 2u; }
    const size_t kstep = (size_t)(BK * 2);
    const size_t hstep = (size_t)HALF * K * 2;
    const size_t tstep = 2 * hstep;
    const unsigned ldsw = (unsigned)wid * 1024u;
    const int aoff = lds_byte(wr * 64 + fr, fq * 8), boff = lds_byte(wc * 32 + fr, fq * 8);
#define PG8_SA(b, h) (((b) * 2 + (h)) * HTB)
#define PG8_SB(b, h) ((4 + (b) * 2 + (h)) * HTB)
#define PG8_STAGE(bufoff, gbase) do { _Pragma("unroll") for (int _i = 0; _i < 2; ++_i) \
        __builtin_amdgcn_global_load_lds((const unsigned*)((const char*)(gbase) + voffA[_i]), (LAS unsigned*)(lds + (bufoff) + ldsw + _i * 8192), 16, 0, 0); } while (0)
#define PG8_LDA(dst, b, h) do { _Pragma("unroll") for (int m = 0; m < 4; ++m) _Pragma("unroll") for (int k = 0; k < 2; ++k) dst[m][k] = *(const LAS bf16x8*)(lds + PG8_SA(b, h) + aoff + m * 2048 + k * 1024); } while (0)
#define PG8_LDB(dst, b, h) do { _Pragma("unroll") for (int n = 0; n < 2; ++n) _Pragma("unroll") for (int k = 0; k < 2; ++k) dst[n][k] = *(const LAS bf16x8*)(lds + PG8_SB(b, h) + boff + n * 2048 + k * 1024); } while (0)
#define PG8_MMA(ai, bj, At, Bt) do { __builtin_amdgcn_s_setprio(1); _Pragma("unroll") for (int m = 0; m < 4; ++m) _Pragma("unroll") for (int n = 0; n < 2; ++n) _Pragma("unroll") for (int k = 0; k < 2; ++k) \
        acc[ai][bj][m][n] = __builtin_amdgcn_mfma_f32_16x16x32_bf16(Bt[n][k], At[m][k], acc[ai][bj][m][n], 0, 0, 0); __builtin_amdgcn_s_setprio(0); } while (0)
#define PG8_WAIT_V(n) asm volatile("s_waitcnt vmcnt(" #n ")" ::: "memory")
#define PG8_WAIT_L(n) asm volatile("s_waitcnt lgkmcnt(" #n ")" ::: "memory")
#define PG8_BAR __builtin_amdgcn_s_barrier()
#define PG8_SCHED __builtin_amdgcn_sched_barrier(0)
    Unit cur, nxt; int ui = 0;
    if (!S.next(0, cur)) return;
    f32x4 acc[2][2][4][2];
#pragma unroll
    for (int a = 0; a < 2; ++a)
#pragma unroll
        for (int b = 0; b < 2; ++b)
#pragma unroll
            for (int m = 0; m < 4; ++m)
#pragma unroll
                for (int n = 0; n < 2; ++n) acc[a][b][m][n] = (f32x4){0.f, 0.f, 0.f, 0.f};
    bf16x8 At[4][2], B0[2][2], B1[2][2];
    const char* cA = (const char*)g.A + (size_t)cur.pm * tstep; const char* cB = (const char*)g.Bt + (size_t)cur.pn * tstep;
    PG8_STAGE(PG8_SB(0, 0), cB); PG8_STAGE(PG8_SA(0, 0), cA); PG8_STAGE(PG8_SB(0, 1), cB + hstep); PG8_STAGE(PG8_SA(0, 1), cA + hstep);
    if (wr == 1) PG8_BAR;
    PG8_WAIT_V(4); PG8_BAR;
    PG8_STAGE(PG8_SB(1, 0), cB + kstep); PG8_STAGE(PG8_SA(1, 0), cA + kstep); PG8_STAGE(PG8_SB(1, 1), cB + hstep + kstep);
    PG8_WAIT_V(6); PG8_BAR;
    for (;;) {
        const bool has_next = S.next(ui + 1, nxt);
        const char* nA = has_next ? (const char*)g.A + (size_t)nxt.pm * tstep : cA; const char* nB = has_next ? (const char*)g.Bt + (size_t)nxt.pn * tstep : cB;
        for (int t = 0; t < nt; t += 2) {
            const bool last = (t == nt - 2);
            const char* a1 = cA + (size_t)(t + 1) * kstep;
            const char* a2 = last ? nA : cA + (size_t)(t + 2) * kstep; const char* b2 = last ? nB : cB + (size_t)(t + 2) * kstep;
            const char* a3 = a2 + kstep; const char* b3 = b2 + kstep;
            PG8_LDB(B0, 0, 0); PG8_SCHED; PG8_LDA(At, 0, 0); PG8_STAGE(PG8_SA(1, 1), a1 + hstep);
            PG8_WAIT_L(8); PG8_BAR; PG8_WAIT_L(0); PG8_MMA(0, 0, At, B0); PG8_BAR; PG8_SCHED;
            PG8_LDB(B1, 0, 1); PG8_STAGE(PG8_SB(0, 0), b2);
            PG8_BAR; PG8_WAIT_L(0); PG8_MMA(0, 1, At, B1); PG8_BAR;
            PG8_LDA(At, 0, 1); PG8_STAGE(PG8_SA(0, 0), a2);
            PG8_BAR; PG8_WAIT_L(0); PG8_MMA(1, 0, At, B0); PG8_BAR; PG8_SCHED;
            PG8_STAGE(PG8_SB(0, 1), b2 + hstep);
            PG8_WAIT_V(6); PG8_BAR; PG8_MMA(1, 1, At, B1); PG8_BAR;
            PG8_LDB(B0, 1, 0); PG8_SCHED; PG8_LDA(At, 1, 0); PG8_STAGE(PG8_SA(0, 1), a2 + hstep);
            PG8_WAIT_L(8); PG8_BAR; PG8_WAIT_L(0); PG8_MMA(0, 0, At, B0); PG8_BAR; PG8_SCHED;
            PG8_LDB(B1, 1, 1); PG8_STAGE(PG8_SB(1, 0), b3);
            PG8_BAR; PG8_WAIT_L(0); PG8_MMA(0, 1, At, B1); PG8_BAR;
            PG8_LDA(At, 1, 1); PG8_STAGE(PG8_SA(1, 0), a3);
            PG8_BAR; PG8_WAIT_L(0); PG8_MMA(1, 0, At, B0); PG8_BAR; PG8_SCHED;
            PG8_STAGE(PG8_SB(1, 1), b3 + hstep);
            PG8_WAIT_V(6); PG8_BAR; PG8_MMA(1, 1, At, B1); PG8_BAR;
        }
        E(acc, cur, wr, wc, fr, fq);
        if (!has_next) break;
#pragma unroll
        for (int a = 0; a < 2; ++a)
#pragma unroll
            for (int b = 0; b < 2; ++b)
#pragma unroll
                for (int m = 0; m < 4; ++m)
#pragma unroll
                    for (int n = 0; n < 2; ++n) acc[a][b][m][n] = (f32x4){0.f, 0.f, 0.f, 0.f};
        cur = nxt; cA = nA; cB = nB; ++ui;
    }
    PG8_WAIT_V(0);
    if (wr == 0) PG8_BAR;
    PG8_BAR;
#undef PG8_SA
#undef PG8_SB
#undef PG8_STAGE
#undef PG8_LDA
#undef PG8_LDB
#undef PG8_MMA
#undef PG8_WAIT_V
#undef PG8_WAIT_L
#undef PG8_BAR
#undef PG8_SCHED
}
}

struct EpiGdnIn {
    bf16_t* proj; float* conv_p; float* conv_s;
    DI void operator()(const f32x4 (&acc)[2][2][4][2], const pg8::Unit& u, int wr, int wc, int fr, int fq) const {
        const int row0 = u.pm * 256 + wr * 64 + fr, col0 = u.pn * 256 + wc * 32 + 4 * fq;
#pragma unroll
        for (int ai = 0; ai < 2; ++ai)
#pragma unroll
            for (int m = 0; m < 4; ++m) {
                const int r = row0 + ai * 128 + m * 16;
                bf16_t* rowp = proj + (size_t)r * NPROJ + col0;
                bool tail; float* cp;
                if (r < MP) { const int t = r & (TP - 1), b = r >> 13; tail = t >= TP - 3; cp = conv_p + (size_t)(b * 3 + (t - (TP - 3))) * 3072; }
                else { const int rs = r - MP, t = rs & 15, b = rs >> 4; tail = t >= TS - 3; cp = conv_s + (size_t)(b * 3 + (t - (TS - 3))) * 3072; }
#pragma unroll
                for (int bj = 0; bj < 2; ++bj)
#pragma unroll
                    for (int n = 0; n < 2; ++n) {
                        const f32x4 v = acc[ai][bj][m][n];
                        u32x2 w; w.x = pk2(v[0], v[1]); w.y = pk2(v[2], v[3]);
                        *(u32x2*)(rowp + bj * 128 + n * 16) = w;
                        const int c = col0 + bj * 128 + n * 16;
                        if (tail && c < 3072) *(f32x4*)(cp + c) = v;
                    }
            }
    }
};

struct EpiDiffIn {
    bf16_t* proj; float* k_p; float* v_p; float* k_s; float* v_s; bf16_t* ks; bf16_t* vs; bf16_t* kh; bf16_t* vh; const float* rope;
    DI void operator()(const f32x4 (&acc)[2][2][4][2], const pg8::Unit& u, int wr, int wc, int fr, int fq) const {
        const int part = u.pn >> 2;
        const int row0 = u.pm * 256 + wr * 64 + fr;
        const int d0 = 16 * (wc & 1) + 4 * fq;
        const int cbase = u.pn * 256 + 64 * (wc >> 1) + d0;
#pragma unroll
        for (int ai = 0; ai < 2; ++ai)
#pragma unroll
            for (int m = 0; m < 4; ++m) {
                const int r = row0 + ai * 128 + m * 16;
                const int rs = r - MP;
                const int pidx = (r < MP) ? (r & (TP - 1)) : (TP + (rs & 15));
                f32x4 cs = {1.f, 1.f, 1.f, 1.f}, sn = {0.f, 0.f, 0.f, 0.f};
                if (part < 2) { cs = *(const f32x4*)(rope + (size_t)pidx * 64 + d0); sn = *(const f32x4*)(rope + (size_t)pidx * 64 + 32 + d0); }
#pragma unroll
                for (int bj = 0; bj < 2; ++bj) {
                    const f32x4 x1 = acc[ai][bj][m][0], x2 = acc[ai][bj][m][1];
                    f32x4 y1 = x1 * cs - x2 * sn, y2 = x2 * cs + x1 * sn;
                    const int col = cbase + bj * 128;
                    bf16_t* pp = proj + (size_t)r * NPROJ + col;
                    if (part == 0) { y1 *= QSCALE; y2 *= QSCALE; }
                    u32x2 w1, w2; w1.x = pk2(y1[0], y1[1]); w1.y = pk2(y1[2], y1[3]); w2.x = pk2(y2[0], y2[1]); w2.y = pk2(y2[2], y2[3]);
                    if (part == 0 || part == 3) { *(u32x2*)pp = w1; *(u32x2*)(pp + 32) = w2; }
                    if (part == 1 || part == 2) {
                        const int cc = col - part * 1024;
                        const int hh = cc >> 7, dd = cc & 127;
                        float* op; bf16_t* sp;
                        if (r < MP) { op = (part == 1 ? k_p : v_p) + (size_t)r * 1024 + cc;
                               sp = (part == 1 ? kh : vh) + ((size_t)((r >> 13) * 8 + hh) * TP + (r & (TP - 1))) * 128 + dd; }
                        else { op = (part == 1 ? k_s : v_s) + (size_t)rs * 1024 + cc;
                               sp = (part == 1 ? ks : vs) + ((size_t)((rs >> 4) * 8 + hh) * KSROWS + PAST + (rs & 15)) * 128 + dd; }
                        *(f32x4*)op = y1; *(f32x4*)(op + 32) = y2;
                        *(u32x2*)sp = w1; *(u32x2*)(sp + 32) = w2;
                    }
                }
            }
    }
};

struct EpiOut {
    bf16_t* C;
    DI void operator()(const f32x4 (&acc)[2][2][4][2], const pg8::Unit& u, int wr, int wc, int fr, int fq) const {
        const int row0 = u.pm * 256 + wr * 64 + fr, col0 = u.pn * 256 + wc * 32 + 4 * fq;
#pragma unroll
        for (int ai = 0; ai < 2; ++ai)
#pragma unroll
            for (int m = 0; m < 4; ++m) {
                bf16_t* rowp = C + (size_t)(row0 + ai * 128 + m * 16) * 1024 + col0;
#pragma unroll
                for (int bj = 0; bj < 2; ++bj)
#pragma unroll
                    for (int n = 0; n < 2; ++n) { const f32x4 v = acc[ai][bj][m][n]; u32x2 w; w.x = pk2(v[0], v[1]); w.y = pk2(v[2], v[3]); *(u32x2*)(rowp + bj * 128 + n * 16) = w; }
            }
    }
};

DI void transpose_tile(const float* W, int ldw, int n0, int k0, bf16_t* WT, bool perm, LAS float* tile) {
    int tid_ = threadIdx.x; asm volatile("" : "+v"(tid_)); const int tid = tid_;
    {
        const int kk = tid >> 4, c4 = (tid & 15) * 4;
#pragma unroll
        for (int p = 0; p < 2; ++p) {
            const f32x4 v = *(const f32x4*)(W + (size_t)(k0 + kk + 32 * p) * ldw + n0 + c4);
            LAS float* t = tile + (kk + 32 * p) * 65 + c4;
            t[0] = v[0]; t[1] = v[1]; t[2] = v[2]; t[3] = v[3];
        }
    }
    __syncthreads();
    {
        const int n = tid >> 3, ks = (tid & 7) * 8;
        const int src = perm ? perm64(n) : n;
        float v[8];
#pragma unroll
        for (int e = 0; e < 8; ++e) v[e] = tile[(ks + e) * 65 + src];
        u32x4 w; w.x = pk2(v[0], v[1]); w.y = pk2(v[2], v[3]); w.z = pk2(v[4], v[5]); w.w = pk2(v[6], v[7]);
        *(u32x4*)(WT + (size_t)(n0 + n) * 1024 + k0 + ks) = w;
    }
    __syncthreads();
}

DI void phase_prep(const Params& P, LAS unsigned char* lds) {
    int tid_ = threadIdx.x; asm volatile("" : "+v"(tid_)); const int tid = tid_, G = gridDim.x;
    unsigned char* ws = P.ws;
    for (int id = blockIdx.x; id < 5120; id += G) {
        const int j = id / 2560; int rem = id % 2560;
        const float* W; int ldw; bf16_t* WT; bool perm = false; int t;
        if (rem < 1024) { W = P.in[12] + (size_t)j * 1024 * 4112; ldw = 4112; WT = (bf16_t*)(ws + WS_WING) + (size_t)j * 4096 * 1024; t = rem; }
        else if (rem < 1280) { W = P.in[17] + (size_t)j * 1024 * 1024; ldw = 1024; WT = (bf16_t*)(ws + WS_WOUTG) + (size_t)j * 1024 * 1024; t = rem - 1024; }
        else if (rem < 2304) { W = P.in[18] + (size_t)j * 1024 * 4096; ldw = 4096; WT = (bf16_t*)(ws + WS_WIND) + (size_t)j * 4096 * 1024; t = rem - 1280; perm = true; }
        else { W = P.in[24] + (size_t)j * 1024 * 1024; ldw = 1024; WT = (bf16_t*)(ws + WS_WOUTD) + (size_t)j * 1024 * 1024; t = rem - 2304; }
        transpose_tile(W, ldw, (t >> 4) * 64, (t & 15) * 64, WT, perm, (LAS float*)lds);
    }
    for (int idx = blockIdx.x * 512 + tid; idx < 8208 * 32; idx += G * 512) {
        const int pi = idx >> 5, d = idx & 31;
        const int pos = pi < TP ? pi : PAST + (pi - TP);
        const float inv = 1.0f / powf(10000.0f, (float)d / 32.0f);
        const float ang = (float)pos * inv;
        const double rev = (double)ang * 0.15915494309189535;
        const double fr = rev - floor(rev);
        float* rp = (float*)(ws + WS_ROPE) + (size_t)pi * 64;
        rp[d] = __builtin_amdgcn_cosf((float)fr);
        rp[32 + d] = __builtin_amdgcn_sinf((float)fr);
    }
    {
        LAS float* cact = (LAS float*)lds;
        LAS float* red = (LAS float*)(lds + 81920);
        bool loaded = false;
        for (int id = (G - 1 - blockIdx.x); id < 192; id += G) {
            if (!loaded) {
                for (int e = tid; e < NB * 1024; e += 512) {
                    const int b = e >> 10, k = e & 1023;
                    const float c = b < BP ? P.in[2][b * 1024 + k] : P.in[3][(b - BP) * 1024 + k];
                    cact[e] = siluf(c);
                }
                loaded = true;
            }
            __syncthreads();
            const int i = id / 48, cb = id % 48;
            const int col = tid & 63, kg = tid >> 6;
            const float* Wp = P.in[10] + (size_t)i * 1024 * 3072 + cb * 64 + col;
            float acc[NB];
#pragma unroll
            for (int b = 0; b < NB; ++b) acc[b] = 0.f;
            for (int k = kg * 128; k < kg * 128 + 128; k += 4) {
                const float w0 = Wp[(size_t)k * 3072], w1 = Wp[(size_t)(k + 1) * 3072], w2 = Wp[(size_t)(k + 2) * 3072], w3 = Wp[(size_t)(k + 3) * 3072];
#pragma unroll
                for (int b = 0; b < NB; ++b) {
                    const f32x4 c4 = *(const LAS f32x4*)(cact + b * 1024 + k);
                    acc[b] += c4[0] * w0 + c4[1] * w1 + c4[2] * w2 + c4[3] * w3;
                }
            }
#pragma unroll
            for (int b = 0; b < NB; ++b) red[(kg * NB + b) * 64 + col] = acc[b];
            __syncthreads();
            for (int o = tid; o < NB * 64; o += 512) {
                const int b = o >> 6, c = o & 63;
                float s = P.in[11][i * 3072 + cb * 64 + c];
#pragma unroll
                for (int g = 0; g < 8; ++g) s += red[(g * NB + b) * 64 + c];
                ((float*)(ws + WS_ADA))[((size_t)i * NB + b) * 3072 + cb * 64 + c] = s;
            }
        }
        __syncthreads();
    }
}

DI void phase_elem(const Params& P, LAS unsigned char* lds, int layer) {
    int tid_ = threadIdx.x; asm volatile("" : "+v"(tid_)); const int tid = tid_, wid = __builtin_amdgcn_readfirstlane(tid >> 6), lane = tid & 63, G = gridDim.x;
    unsigned char* ws = P.ws;
    const int j = layer >> 1;
    const bool gdn = (layer < 4) && !(layer & 1);
    LAS float* wab = (LAS float*)lds;
    if (gdn) {
        const float* Wp = P.in[12] + (size_t)j * 1024 * 4112 + 4096;
        for (int e = tid; e < 16384; e += 512) { const int k = e >> 4, c = e & 15; wab[c * 1024 + k] = Wp[(size_t)k * 4112 + c]; }
        __syncthreads();
    }
    const float* ada = (const float*)(ws + WS_ADA);
    float* X = P.out;
    const bf16_t* OUTB = (const bf16_t*)(ws + WS_PROJ);
    bf16_t* HB = (bf16_t*)(ws + WS_HBUF);
    float* AB = (float*)(ws + WS_AB);
    for (int r = blockIdx.x * 8 + wid; r < M; r += G * 8) {
        const int b = r < MP ? (r >> 13) : BP + ((r - MP) >> 4);
        const float* xs = (layer <= 1) ? (r < MP ? P.in[0] + (size_t)r * 1024 : P.in[1] + (size_t)(r - MP) * 1024) : X + (size_t)r * 1024;
        f32x4 x[4];
#pragma unroll
        for (int q = 0; q < 4; ++q) x[q] = *(const f32x4*)(xs + 4 * (lane + 64 * q));
        if (layer >= 1) {
            f32x4 o[4]; float ss = 0.f;
#pragma unroll
            for (int q = 0; q < 4; ++q) { const u32x2 ow = *(const u32x2*)(OUTB + (size_t)r * 1024 + 4 * (lane + 64 * q));
                o[q] = (f32x4){__uint_as_float(ow.x << 16), __uint_as_float(ow.x & 0xffff0000u), __uint_as_float(ow.y << 16), __uint_as_float(ow.y & 0xffff0000u)};
                ss += o[q][0] * o[q][0] + o[q][1] * o[q][1] + o[q][2] * o[q][2] + o[q][3] * o[q][3]; }
            ss = wave_sum(ss);
            const float rstd = __builtin_amdgcn_rsqf(ss * (1.f / 1024.f) + RMS_EPS);
            const float* gp = ada + ((size_t)(layer - 1) * NB + b) * 3072 + 2048;
            const float* np = P.in[9] + (layer - 1) * 1024;
#pragma unroll
            for (int q = 0; q < 4; ++q) {
                const int d = 4 * (lane + 64 * q);
                const f32x4 gt = *(const f32x4*)(gp + d), nw = *(const f32x4*)(np + d);
                x[q] = x[q] + gt * (o[q] * rstd * nw);
                *(f32x4*)(X + (size_t)r * 1024 + d) = x[q];
            }
        }
        if (layer < 4) {
            float ss = 0.f;
#pragma unroll
            for (int q = 0; q < 4; ++q) ss += x[q][0] * x[q][0] + x[q][1] * x[q][1] + x[q][2] * x[q][2] + x[q][3] * x[q][3];
            ss = wave_sum(ss);
            const float rstd = __builtin_amdgcn_rsqf(ss * (1.f / 1024.f) + RMS_EPS);
            const float* ap = ada + ((size_t)layer * NB + b) * 3072;
            const float* np = P.in[8] + layer * 1024;
            f32x4 hv[4];
#pragma unroll
            for (int q = 0; q < 4; ++q) {
                const int d = 4 * (lane + 64 * q);
                const f32x4 sh = *(const f32x4*)(ap + d), sc = *(const f32x4*)(ap + 1024 + d), nw = *(const f32x4*)(np + d);
                hv[q] = (x[q] * rstd * nw) * (1.f + sc) + sh;
                u32x2 w; w.x = pk2(hv[q][0], hv[q][1]); w.y = pk2(hv[q][2], hv[q][3]);
                *(u32x2*)(HB + (size_t)r * 1024 + d) = w;
            }
            if (gdn) {
                float mine = 0.f;
#pragma unroll
                for (int c = 0; c < 16; ++c) {
                    float a = 0.f;
#pragma unroll
                    for (int q = 0; q < 4; ++q) { const f32x4 w4 = *(const LAS f32x4*)(wab + c * 1024 + 4 * (lane + 64 * q)); a += hv[q][0] * w4[0] + hv[q][1] * w4[1] + hv[q][2] * w4[2] + hv[q][3] * w4[3]; }
                    a = row_sum16(a);
                    if ((lane & 15) == c) mine = a;
                }
                mine += __shfl_xor(mine, 16); mine += __shfl_xor(mine, 32);
                if (lane < 16) AB[(size_t)r * 16 + lane] = mine;
            }
        }
    }
}

DI void convert_cache(const Params& P, int j, int b0, int nb) {
    int tid_ = threadIdx.x; asm volatile("" : "+v"(tid_)); const int tid = tid_;
    unsigned char* ws = P.ws;
    const int bx = blockIdx.x - b0; const int G = nb;
    {
        const float* ck = P.in[6] + (size_t)j * 16 * PAST * 1024;
        const float* cv = P.in[7] + (size_t)j * 16 * PAST * 1024;
        bf16_t* KS = (bf16_t*)(ws + WS_KS); bf16_t* VS = (bf16_t*)(ws + WS_VS);
        const size_t nun = (size_t)16 * PAST * 128;
        for (size_t u = (size_t)bx * 512 + tid; u < 2 * nun; u += (size_t)G * 512) {
            const bool isv = u >= nun; const size_t uu = isv ? u - nun : u;
            const size_t b = uu / ((size_t)PAST * 128), rem = uu % ((size_t)PAST * 128);
            const size_t row = rem >> 7, c8 = rem & 127, hh = c8 >> 4, d8 = c8 & 15;
            const float* sp = (isv ? cv : ck) + uu * 8;
            const f32x4 a = *(const f32x4*)sp, c = *(const f32x4*)(sp + 4);
            u32x4 w; w.x = pk2(a[0], a[1]); w.y = pk2(a[2], a[3]); w.z = pk2(c[0], c[1]); w.w = pk2(c[2], c[3]);
            *(u32x4*)((isv ? VS : KS) + ((b * 8 + hh) * KSROWS + row) * 128 + d8 * 8) = w;
        }
        const size_t npad = (size_t)128 * 48 * 16;
        for (size_t u = (size_t)bx * 512 + tid; u < 2 * npad; u += (size_t)G * 512) {
            const bool isv = u >= npad; const size_t uu = isv ? u - npad : u;
            const size_t sq = uu / (48 * 16), rem = uu % (48 * 16);
            *(u32x4*)((isv ? VS : KS) + (sq * KSROWS + PAST + TS) * 128 + rem * 8) = (u32x4){0u, 0u, 0u, 0u};
        }
    }
}

DI void phase_g1(const Params& P, LAS unsigned char* lds, int layer) {
    int tid_ = threadIdx.x; asm volatile("" : "+v"(tid_)); const int tid = tid_, wid = __builtin_amdgcn_readfirstlane(tid >> 6), lane = tid & 63, G = gridDim.x;
    const int fr = lane & 15, fq = lane >> 4;
    unsigned char* ws = P.ws;
    const int j = layer >> 1;
    const bf16_t* proj = (const bf16_t*)(ws + WS_PROJ);
    const float* AB = (const float*)(ws + WS_AB);
    float* GL = (float*)(ws + WS_GL);
    const float* convw = P.in[13] + (size_t)j * 4 * 3072;
    const float* cconv = P.in[5] + (size_t)j * 16 * 3 * 3072;
    LAS unsigned char* Qs = lds;
    LAS unsigned char* Ks = lds + 17408;
    LAS unsigned char* VBt = lds + 34816;
    LAS unsigned char* KBt = lds + 53248;
    LAS float* A32 = (LAS float*)(lds + 71680);
    LAS unsigned char* Ts = lds + 88320;
    LAS unsigned char* QKs = lds + 97536;
    LAS float* Gs = (LAS float*)(lds + 105728);

    for (int item = blockIdx.x; item < NITEM; item += G) {
        int b, h, c, row0, nvalid; bool sample;
        if (item < NITEM_P) { const int seq = item >> 7; b = seq >> 3; h = seq & 7; c = item & 127; row0 = b * TP + 64 * c; nvalid = 64; sample = false; }
        else { const int s = item - NITEM_P; b = s >> 3; h = s & 7; c = 0; row0 = MP + b * TS; nvalid = TS; sample = true; }
        unsigned char* ib = ws + WS_R1 + (size_t)item * ITEM_BYTES;
        float val[8][8];
        float rn[8];
        int tido = tid; asm volatile("" : "+v"(tido));
        const int l16 = tido & 15, grp = tido >> 4, part = grp >> 3, rb = grp & 7;
        const int lane = tido & 63, fr = lane & 15, fq = lane >> 4;
        if (tid < 384) {
            const int ch = part * 1024 + h * 128 + 8 * l16;
            float wv[4][8];
#pragma unroll
            for (int t = 0; t < 4; ++t) {
                const f32x4 a = *(const f32x4*)(convw + t * 3072 + ch), bb = *(const f32x4*)(convw + t * 3072 + ch + 4);
                wv[t][0] = a[0]; wv[t][1] = a[1]; wv[t][2] = a[2]; wv[t][3] = a[3]; wv[t][4] = bb[0]; wv[t][5] = bb[1]; wv[t][6] = bb[2]; wv[t][7] = bb[3];
            }
            float win[4][8];
#pragma unroll
            for (int t = 0; t < 4; ++t)
#pragma unroll
                for (int e = 0; e < 8; ++e) win[t][e] = 0.f;
#pragma unroll
            for (int k = 0; k < 11; ++k) {
                const int lr = 8 * rb - 3 + k;
                float in8[8];
                {
                    const bool use_proj = (lr >= 0 && lr < nvalid) || (lr < 0 && !sample && c > 0);
                    const int lrc = use_proj ? lr : 0;
                    const u32x4 v = *(const u32x4*)(proj + (size_t)(row0 + lrc) * NPROJ + ch);
                    unpack8(v, in8);
                    if (!use_proj) {
#pragma unroll
                        for (int e = 0; e < 8; ++e) in8[e] = 0.f;
                    }
                }
                if (k < 3) {
                    if (sample && lr < 0) {
                        const float* sp = cconv + (size_t)(b * 3 + (3 + lr)) * 3072 + ch;
                        const f32x4 a = *(const f32x4*)sp, bb = *(const f32x4*)(sp + 4);
                        in8[0] = a[0]; in8[1] = a[1]; in8[2] = a[2]; in8[3] = a[3]; in8[4] = bb[0]; in8[5] = bb[1]; in8[6] = bb[2]; in8[7] = bb[3];
                    }
                }
#pragma unroll
                for (int e = 0; e < 8; ++e) { win[0][e] = win[1][e]; win[1][e] = win[2][e]; win[2][e] = win[3][e]; win[3][e] = in8[e]; }
                if (k >= 3) {
                    const bool rv = (lr < nvalid);
                    float ss = 0.f;
#pragma unroll
                    for (int e = 0; e < 8; ++e) {
                        const float y = win[0][e] * wv[0][e] + win[1][e] * wv[1][e] + win[2][e] * wv[2][e] + win[3][e] * wv[3][e];
                        const float s = rv ? siluf(y) : 0.f;
                        val[k - 3][e] = s; ss += s * s;
                    }
                    ss = row_sum16(ss);
                    rn[k - 3] = __builtin_amdgcn_rsqf(ss + 1e-6f);
                }
            }
        } else if (wid == 7) {
            const int r = row0 + (lane < nvalid ? lane : 0);
            const bool valid = lane < nvalid;
            const float a = AB[(size_t)r * 16 + h], bb = AB[(size_t)r * 16 + 8 + h];
            const float xa = a + P.in[15][j * 8 + h];
            const float ey = __expf(-fabsf(xa));
            const float lp = (ey < 0.01f) ? ey * (1.f - ey * (0.5f - ey * 0.33333334f)) : __logf(1.f + ey);
            const float sp = fmaxf(xa, 0.f) + lp;
            float g = valid ? -__expf(P.in[14][j * 8 + h]) * sp : 0.f;
            const float beta = valid ? __builtin_amdgcn_rcpf(1.f + __expf(-bb)) : 0.f;
#pragma unroll
            for (int o = 1; o < 64; o <<= 1) { const float t = __shfl_up(g, o); if (lane >= o) g += t; }
            const float glast = readlane_f(g, 63);
            Gs[lane] = g; Gs[64 + lane] = beta; Gs[128 + lane] = __expf(g); Gs[192 + lane] = __expf(glast - g);
            if (lane == 0) GL[item] = __expf(glast);
        }
        __syncthreads();
        if (tid < 384) {
#pragma unroll
            for (int rr = 0; rr < 8; ++rr) {
                const int row = 8 * rb + rr;
                const float beta = Gs[64 + row], eG = Gs[128 + row];
                if (part == 0) {
                    const float sc = rn[rr] * 0.08838834764831845f;
                    float q[8];
#pragma unroll
                    for (int e = 0; e < 8; ++e) q[e] = val[rr][e] * sc;
                    u32x4 w; w.x = pk2(q[0], q[1]); w.y = pk2(q[2], q[3]); w.z = pk2(q[4], q[5]); w.w = pk2(q[6], q[7]);
                    *(LAS u32x4*)(Qs + row * 272 + l16 * 16) = w;
                    bf16_t* qg = (bf16_t*)(ib + 49152) + row * 128;
                    u32x2 g0, g1; g0.x = pk2(q[0] * eG, q[1] * eG); g0.y = pk2(q[2] * eG, q[3] * eG); g1.x = pk2(q[4] * eG, q[5] * eG); g1.y = pk2(q[6] * eG, q[7] * eG);
                    *(u32x2*)(qg + ppos(8 * l16)) = g0; *(u32x2*)(qg + ppos(8 * l16 + 4)) = g1;
                    val[rr][0] = 0.f;
                } else if (part == 1) {
#pragma unroll
                    for (int e = 0; e < 8; ++e) val[rr][e] *= rn[rr];
                    u32x4 w; w.x = pk2(val[rr][0], val[rr][1]); w.y = pk2(val[rr][2], val[rr][3]); w.z = pk2(val[rr][4], val[rr][5]); w.w = pk2(val[rr][6], val[rr][7]);
                    *(LAS u32x4*)(Ks + row * 272 + l16 * 16) = w;
                }
            }
            if (part >= 1) {
                float bsc[8], ksc[8];
#pragma unroll
                for (int rr = 0; rr < 8; ++rr) { const int row = 8 * rb + rr; const float beta = Gs[64 + row]; bsc[rr] = (part == 1) ? beta * Gs[128 + row] : beta; ksc[rr] = Gs[192 + row]; }
                LAS unsigned char* Tt = (part == 1) ? KBt : VBt;
#pragma unroll
                for (int e = 0; e < 8; ++e) {
                    const int dch = 8 * l16 + e;
                    u32x4 w; w.x = pk2(val[0][e] * bsc[0], val[1][e] * bsc[1]); w.y = pk2(val[2][e] * bsc[2], val[3][e] * bsc[3]);
                    w.z = pk2(val[4][e] * bsc[4], val[5][e] * bsc[5]); w.w = pk2(val[6][e] * bsc[6], val[7][e] * bsc[7]);
                    *(LAS u32x4*)(Tt + dch * 144 + rb * 16) = w;
                    if (part == 1) {
                        bf16_t* kd = (bf16_t*)(ib + 65536) + dch * 64;
                        u32x2 k0, k1; k0.x = pk2(val[0][e] * ksc[0], val[1][e] * ksc[1]); k0.y = pk2(val[2][e] * ksc[2], val[3][e] * ksc[3]);
                        k1.x = pk2(val[4][e] * ksc[4], val[5][e] * ksc[5]); k1.y = pk2(val[6][e] * ksc[6], val[7][e] * ksc[7]);
                        *(u32x2*)(kd + ppos(8 * rb)) = k0; *(u32x2*)(kd + ppos(8 * rb + 4)) = k1;
                    }
                }
            }
        }
        __syncthreads();
        {
            const int mt = wid & 3; const bool isqk = wid >= 4;
            LAS unsigned char* As = isqk ? Qs : Ks;
            f32x4 acc[4];
#pragma unroll
            for (int nt = 0; nt < 4; ++nt) acc[nt] = (f32x4){0.f, 0.f, 0.f, 0.f};
#pragma unroll
            for (int ks = 0; ks < 4; ++ks) {
                const bf16x8 a = *(const LAS bf16x8*)(As + (16 * mt + fr) * 272 + (32 * ks + 8 * fq) * 2);
#pragma unroll
                for (int nt = 0; nt < 4; ++nt) {
                    const bf16x8 bfr = *(const LAS bf16x8*)(Ks + (16 * nt + fr) * 272 + (32 * ks + 8 * fq) * 2);
                    acc[nt] = MFMA16(a, bfr, acc[nt]);
                }
            }
#pragma unroll
            for (int nt = 0; nt < 4; ++nt) {
                const int cp = 16 * nt + fr; const float Gc2 = Gs[cp];
#pragma unroll
                for (int i = 0; i < 4; ++i) {
                    const int cr = 16 * mt + 4 * fq + i;
                    const float dec = __expf(Gs[cr] - Gc2);
                    if (!isqk) A32[cr * 65 + cp] = (cr > cp) ? Gs[64 + cr] * acc[nt][i] * dec : 0.f;
                    else *(LAS bf16_t*)(QKs + (cr * 64 + ppos(cp)) * 2) = f2bf((cr >= cp) ? acc[nt][i] * dec : 0.f);
                }
            }
        }
        __syncthreads();
        {
            float a[64];
#pragma unroll
            for (int jj = 0; jj < 64; ++jj) a[jj] = A32[lane * 65 + jj];
            float x[8];
#pragma unroll
            for (int cc = 0; cc < 8; ++cc) x[cc] = (lane == 8 * wid + cc) ? 1.f : 0.f;
#pragma unroll
            for (int jj = 0; jj < 64; ++jj) {
                if (jj >= 8 * wid) {
#pragma unroll
                    for (int cc = 0; cc < 8; ++cc) { const float xj = readlane_f(x[cc], jj); x[cc] -= a[jj] * xj; }
                }
            }
            u32x4 w; w.x = pk2(x[0], x[1]); w.y = pk2(x[2], x[3]); w.z = pk2(x[4], x[5]); w.w = pk2(x[6], x[7]);
            *(LAS u32x4*)(Ts + lane * 144 + wid * 16) = w;
            *(u32x4*)(ib + 81920 + tid * 16) = *(const LAS u32x4*)(QKs + tid * 16);
        }
        __syncthreads();
        {
            const bool isw = wid >= 4; const int n0 = 32 * (wid & 3);
            LAS unsigned char* Bs = isw ? KBt : VBt;
            f32x4 acc[4][2];
#pragma unroll
            for (int mt = 0; mt < 4; ++mt) { acc[mt][0] = (f32x4){0.f, 0.f, 0.f, 0.f}; acc[mt][1] = (f32x4){0.f, 0.f, 0.f, 0.f}; }
#pragma unroll
            for (int ks = 0; ks < 2; ++ks) {
                bf16x8 bfr[2];
#pragma unroll
                for (int nn = 0; nn < 2; ++nn) bfr[nn] = *(const LAS bf16x8*)(Bs + (n0 + 16 * nn + fr) * 144 + (32 * ks + 8 * fq) * 2);
#pragma unroll
                for (int mt = 0; mt < 4; ++mt) {
                    const bf16x8 a = *(const LAS bf16x8*)(Ts + (16 * mt + fr) * 144 + (32 * ks + 8 * fq) * 2);
                    acc[mt][0] = MFMA16(a, bfr[0], acc[mt][0]); acc[mt][1] = MFMA16(a, bfr[1], acc[mt][1]);
                }
            }
            if (!isw) {
                float* U = (float*)ib;
#pragma unroll
                for (int mt = 0; mt < 4; ++mt)
#pragma unroll
                    for (int nn = 0; nn < 2; ++nn) *(f32x4*)(U + (n0 + 16 * nn + fr) * 64 + 16 * mt + 4 * fq) = acc[mt][nn];
            } else {
#pragma unroll
                for (int mt = 0; mt < 4; ++mt)
#pragma unroll
                    for (int nn = 0; nn < 2; ++nn)
#pragma unroll
                        for (int i = 0; i < 4; ++i) *(LAS bf16_t*)(Qs + ((16 * mt + 4 * fq + i) * 128 + ppos(n0 + 16 * nn + fr)) * 2) = f2bf(acc[mt][nn][i]);
            }
        }
        __syncthreads();
        {
            *(u32x4*)(ib + 32768 + tid * 16) = *(const LAS u32x4*)(Qs + tid * 16);
            *(u32x4*)(ib + 32768 + 8192 + tid * 16) = *(const LAS u32x4*)(Qs + 8192 + tid * 16);
        }
        __syncthreads();
    }
}

DI void phase_scan(const Params& P, LAS unsigned char* lds, int layer) {
    int tid_ = threadIdx.x; asm volatile("" : "+v"(tid_)); const int tid = tid_, wid = __builtin_amdgcn_readfirstlane(tid >> 6), lane = tid & 63, G = gridDim.x;
    const int fr = lane & 15, fq = lane >> 4;
    unsigned char* ws = P.ws;
    const int j = layer >> 1;
    const bf16_t* proj = (const bf16_t*)(ws + WS_PROJ);
    const float* GL = (const float*)(ws + WS_GL);
    bf16_t* ORAW = (bf16_t*)(ws + WS_ORAWB);
    constexpr int BUFB = 57344;
    LAS float* red = (LAS float*)(lds + 2 * BUFB);

    if (G >= 192 && (int)blockIdx.x >= 160) { convert_cache(P, j, 160, G - 160); return; }
    for (int seq = blockIdx.x; seq < 160; seq += G) {
        int b, h, nch, item0, row0, nvalid; float* stout;
        f32x4 st[8];
        const int dvc = 16 * wid + fr;
        if (seq < 32) {
            b = seq >> 3; h = seq & 7; nch = 128; item0 = seq * 128; row0 = b * TP; nvalid = 64;
            stout = P.out + OFF_STP + ((size_t)(j * 4 + b) * 8 + h) * 16384;
#pragma unroll
            for (int mt = 0; mt < 8; ++mt) st[mt] = (f32x4){0.f, 0.f, 0.f, 0.f};
        } else {
            const int s = seq - 32; b = s >> 3; h = s & 7; nch = 1; item0 = NITEM_P + s; row0 = MP + b * TS; nvalid = TS;
            stout = P.out + OFF_STS + ((size_t)(j * 16 + b) * 8 + h) * 16384;
            const float* s0 = P.in[4] + ((size_t)(j * 16 + b) * 8 + h) * 16384;
            const unsigned s0o = (unsigned)(4 * fq * 128 + dvc);
#pragma unroll
            for (int mt = 0; mt < 8; ++mt)
#pragma unroll
                for (int i = 0; i < 4; ++i) st[mt][i] = s0[(unsigned)((16 * mt + i) * 128) + s0o];
        }
        const float onw = P.in[16][j * 128 + dvc];
        f32x4 un[4];
#define SCAN_G2L(itm, bufi, LN) do { const unsigned char* _ib = ws + WS_R1 + (size_t)(itm) * ITEM_BYTES + 32768; \
            _Pragma("unroll") for (int _p = 0; _p < 7; ++_p) { const int _L = (wid + 8 * _p) * 1024 + (LN) * 16; unsigned _src; \
                if (_p < 4) { const int _row = _L >> 8, _ch = (_L >> 4) & 15; _src = (_L & ~255) + ((_ch ^ (_row & 15)) << 4); } \
                else { const int _a = _L - 32768, _row = _a >> 7, _ch = (_a >> 4) & 7; _src = 32768 + (_a & ~127) + ((_ch ^ ((_row >> 1) & 7)) << 4); } \
                g2l16(_ib + _src, lds_u32(lds + (bufi) * BUFB + (wid + 8 * _p) * 1024)); } } while (0)
#define SCAN_LOADU(itm) do { const float* _u = (const float*)(ws + WS_R1 + (size_t)(itm) * ITEM_BYTES); const unsigned _uo = (unsigned)((16 * wid + fr) * 64 + 4 * fq); \
            _Pragma("unroll") for (int _m = 0; _m < 4; ++_m) un[_m] = *(const f32x4*)(_u + (unsigned)(16 * _m) + _uo); } while (0)
        __syncthreads();
        SCAN_G2L(item0, 0, lane);
        SCAN_LOADU(item0);
        float gln = GL[item0];
        asm volatile("s_waitcnt vmcnt(0)" ::: "memory");
        __syncthreads();
        for (int c = 0; c < nch; ++c) {
            int frq = lane; asm volatile("" : "+v"(frq));
            const int fr = frq & 15, fq = frq >> 4;
            LAS unsigned char* bb = lds + (c & 1) * BUFB;
            const float gl = gln;
            f32x4 u[4];
#pragma unroll
            for (int mt = 0; mt < 4; ++mt) u[mt] = un[mt];
            if (c + 1 < nch) { gln = GL[item0 + c + 1]; SCAN_G2L(item0 + c + 1, (c + 1) & 1, frq); SCAN_LOADU(item0 + c + 1); }
            const int x16 = fr << 4, x8 = ((fr >> 1) & 7) << 4;
            bf16x8 sf[4];
#pragma unroll
            for (int ks = 0; ks < 4; ++ks) {
                u32x4 w; w.x = pk2(-st[2 * ks][0], -st[2 * ks][1]); w.y = pk2(-st[2 * ks][2], -st[2 * ks][3]); w.z = pk2(-st[2 * ks + 1][0], -st[2 * ks + 1][1]); w.w = pk2(-st[2 * ks + 1][2], -st[2 * ks + 1][3]);
                sf[ks] = __builtin_bit_cast(bf16x8, w);
            }
            bf16x8 fa[4], fb[4];
#define SC_LD256(dst, base, mt) do { _Pragma("unroll") for (int _k = 0; _k < 4; ++_k) \
                dst[_k] = *(const LAS bf16x8*)(bb + (base) + (16 * (mt) + fr) * 256 + ((((4 * _k + fq) << 4)) ^ x16)); } while (0)
#define SC_LD128(dst, base, mtlo) do { _Pragma("unroll") for (int _m = 0; _m < 2; ++_m) _Pragma("unroll") for (int _k = 0; _k < 2; ++_k) \
                dst[_m * 2 + _k] = *(const LAS bf16x8*)(bb + (base) + (16 * ((mtlo) + _m) + fr) * 128 + ((((4 * _k + fq) << 4)) ^ x8)); } while (0)
#define SC_SB __builtin_amdgcn_sched_barrier(0)
#define SC_MU(f, mt) do { _Pragma("unroll") for (int _k = 0; _k < 4; ++_k) u[mt] = MFMA16(f[_k], sf[_k], u[mt]); } while (0)
#define SC_MO(f, mt) do { _Pragma("unroll") for (int _k = 0; _k < 4; ++_k) o[mt] = MFMA16(f[_k], sf[_k], o[mt]); } while (0)
#define SC_MQK(f, mtlo) do { _Pragma("unroll") for (int _m = 0; _m < 2; ++_m) _Pragma("unroll") for (int _k = 0; _k < 2; ++_k) o[(mtlo) + _m] = MFMA16(f[_m * 2 + _k], uf[_k], o[(mtlo) + _m]); } while (0)
#define SC_MKD(f, mtlo) do { _Pragma("unroll") for (int _m = 0; _m < 2; ++_m) { st[(mtlo) + _m] = st[(mtlo) + _m] * gl; _Pragma("unroll") for (int _k = 0; _k < 2; ++_k) st[(mtlo) + _m] = MFMA16(f[_m * 2 + _k], uf[_k], st[(mtlo) + _m]); } } while (0)
            f32x4 o[4];
#pragma unroll
            for (int mt = 0; mt < 4; ++mt) o[mt] = (f32x4){0.f, 0.f, 0.f, 0.f};
            SC_LD256(fa, 0, 0); SC_LD256(fb, 0, 1); SC_SB;
            SC_MU(fa, 0); SC_LD256(fa, 0, 2); SC_SB;
            SC_MU(fb, 1); SC_LD256(fb, 0, 3); SC_SB;
            SC_MU(fa, 2); SC_LD256(fa, 16384, 0); SC_SB;
            SC_MU(fb, 3); SC_LD256(fb, 16384, 1); SC_SB;
#pragma unroll
            for (int ks = 0; ks < 4; ++ks) sf[ks] = sf[ks] ^ (short)0x8000;
            SC_MO(fa, 0); SC_LD256(fa, 16384, 2); SC_SB;
            SC_MO(fb, 1); SC_LD256(fb, 16384, 3); SC_SB;
            SC_MO(fa, 2); SC_LD128(fa, 49152, 0); SC_SB;
            SC_MO(fb, 3); SC_LD128(fb, 49152, 2); SC_SB;
            bf16x8 uf[2];
#pragma unroll
            for (int k2 = 0; k2 < 2; ++k2) {
                u32x4 w; w.x = pk2(u[2 * k2][0], u[2 * k2][1]); w.y = pk2(u[2 * k2][2], u[2 * k2][3]); w.z = pk2(u[2 * k2 + 1][0], u[2 * k2 + 1][1]); w.w = pk2(u[2 * k2 + 1][2], u[2 * k2 + 1][3]);
                uf[k2] = __builtin_bit_cast(bf16x8, w);
            }
            SC_MQK(fa, 0); SC_LD128(fa, 32768, 0); SC_SB;
            SC_MQK(fb, 2); SC_LD128(fb, 32768, 2); SC_SB;
            SC_MKD(fa, 0); SC_LD128(fa, 32768, 4); SC_SB;
            SC_MKD(fb, 2); SC_LD128(fb, 32768, 6); SC_SB;
            SC_MKD(fa, 4); SC_SB;
            SC_MKD(fb, 6);
#undef SC_MU
#undef SC_MO
#undef SC_MQK
#undef SC_MKD
#undef SC_LD256
#undef SC_LD128
#undef SC_SB
            {
                bf16_t* obb = ORAW + (size_t)(row0 + 64 * c) * 1024 + h * 128;
                const unsigned oo = (unsigned)(4 * fq * 1024 + 16 * wid + fr);
#pragma unroll
                for (int mt = 0; mt < 4; ++mt)
#pragma unroll
                    for (int i = 0; i < 4; ++i) {
                        const int lr = 16 * mt + 4 * fq + i;
                        const bf16_t ob = f2bf(o[mt][i]);
                        if (lr < nvalid) obb[(unsigned)((16 * mt + i) * 1024) + oo] = ob;
                    }
            }
            asm volatile("s_waitcnt vmcnt(0)" ::: "memory");
            __syncthreads();
        }
        {
            int lz = lane; asm volatile("" : "+v"(lz));
            const unsigned so = (unsigned)(4 * (lz >> 4) * 128 + 16 * wid + (lz & 15));
#pragma unroll
            for (int mt = 0; mt < 8; ++mt)
#pragma unroll
                for (int i = 0; i < 4; ++i) stout[(unsigned)((16 * mt + i) * 128) + so] = st[mt][i];
        }
#undef SCAN_G2L
#undef SCAN_LOADU
    }
    if (G < 192) convert_cache(P, j, 0, G);
}

DI void phase_gnorm(const Params& P, int layer) {
    int tid_ = threadIdx.x; asm volatile("" : "+v"(tid_)); const int tid = tid_, wid = __builtin_amdgcn_readfirstlane(tid >> 6), lane = tid & 63, G = gridDim.x;
    unsigned char* ws = P.ws;
    const int j = layer >> 1;
    const bf16_t* ORAW = (const bf16_t*)(ws + WS_ORAWB);
    const bf16_t* proj = (const bf16_t*)(ws + WS_PROJ);
    bf16_t* OB = (bf16_t*)(ws + WS_HBUF);
    float onw[16];
#pragma unroll
    for (int e = 0; e < 16; ++e) onw[e] = P.in[16][j * 128 + ((16 * lane + e) & 127)];
    for (int r = blockIdx.x * 8 + wid; r < M; r += G * 8) {
        const u32x4 o0 = *(const u32x4*)(ORAW + (size_t)r * 1024 + 16 * lane), o1 = *(const u32x4*)(ORAW + (size_t)r * 1024 + 16 * lane + 8);
        const u32x4 z0 = *(const u32x4*)(proj + (size_t)r * NPROJ + 3072 + 16 * lane), z1 = *(const u32x4*)(proj + (size_t)r * NPROJ + 3072 + 16 * lane + 8);
        float ov[16], zv[16];
        { float t8[8]; unpack8(o0, t8);
#pragma unroll
          for (int e = 0; e < 8; ++e) ov[e] = t8[e];
          unpack8(o1, t8);
#pragma unroll
          for (int e = 0; e < 8; ++e) ov[8 + e] = t8[e];
          unpack8(z0, t8);
#pragma unroll
          for (int e = 0; e < 8; ++e) zv[e] = t8[e];
          unpack8(z1, t8);
#pragma unroll
          for (int e = 0; e < 8; ++e) zv[8 + e] = t8[e]; }
        float ss = 0.f;
#pragma unroll
        for (int e = 0; e < 16; ++e) ss += ov[e] * ov[e];
        ss += __shfl_xor(ss, 1); ss += __shfl_xor(ss, 2); ss += __shfl_xor(ss, 4);
        const float rstd = __builtin_amdgcn_rsqf(ss * (1.f / 128.f) + RMS_EPS);
        float y[16];
#pragma unroll
        for (int e = 0; e < 16; ++e) y[e] = ov[e] * rstd * onw[e] * siluf(zv[e]);
        u32x4 w0, w1;
        w0.x = pk2(y[0], y[1]); w0.y = pk2(y[2], y[3]); w0.z = pk2(y[4], y[5]); w0.w = pk2(y[6], y[7]);
        w1.x = pk2(y[8], y[9]); w1.y = pk2(y[10], y[11]); w1.z = pk2(y[12], y[13]); w1.w = pk2(y[14], y[15]);
        *(u32x4*)(OB + (size_t)r * 1024 + 16 * lane) = w0; *(u32x4*)(OB + (size_t)r * 1024 + 16 * lane + 8) = w1;
    }
}

DI void att_s(LAS unsigned char* Ka, int t, const bf16x8 (&qf)[4], f32x16& s0, f32x16& s1) {
#pragma unroll
    for (int i = 0; i < 16; ++i) { s0[i] = 0.f; s1[i] = 0.f; }
    bf16x8 kf[8];
#pragma unroll
    for (int s = 0; s < 4; ++s) { kf[2 * s] = *(const LAS bf16x8*)(Ka + (t ^ (s << 5))); kf[2 * s + 1] = *(const LAS bf16x8*)(Ka + 8192 + (t ^ (s << 5))); }
#pragma unroll
    for (int s = 0; s < 4; ++s) { s0 = MFMA32(kf[2 * s], qf[s], s0); s1 = MFMA32(kf[2 * s + 1], qf[s], s1); }
}
template <bool MASK>
DI float att_softmax(f32x16& s0, f32x16& s1, float& m, float& l, bf16x8 (&pf)[2][2], int h2, int nvk) {
    if (MASK) {
#pragma unroll
        for (int i = 0; i < 16; ++i) {
            const int key = (i & 3) + 8 * (i >> 2) + 4 * h2;
            s0[i] = (key < nvk) ? s0[i] : -INFINITY;
            s1[i] = (32 + key < nvk) ? s1[i] : -INFINITY;
        }
    }
    float mx = s0[0];
#pragma unroll
    for (int i = 1; i < 16; ++i) mx = fmaxf(mx, s0[i]);
#pragma unroll
    for (int i = 0; i < 16; ++i) mx = fmaxf(mx, s1[i]);
    mx = fmaxf(mx, __shfl_xor(mx, 32));
    const float mn = fmaxf(m, mx);
    const float alpha = __builtin_amdgcn_exp2f(m - mn);
    m = mn;
    float ps = 0.f;
#pragma unroll
    for (int i = 0; i < 16; ++i) { s0[i] = __builtin_amdgcn_exp2f(s0[i] - mn); s1[i] = __builtin_amdgcn_exp2f(s1[i] - mn); ps += s0[i] + s1[i]; }
    l = l * alpha + ps;
    u32x4 w;
    w.x = pk2(s0[0], s0[1]); w.y = pk2(s0[2], s0[3]); w.z = pk2(s0[4], s0[5]); w.w = pk2(s0[6], s0[7]); pf[0][0] = __builtin_bit_cast(bf16x8, w);
    w.x = pk2(s0[8], s0[9]); w.y = pk2(s0[10], s0[11]); w.z = pk2(s0[12], s0[13]); w.w = pk2(s0[14], s0[15]); pf[0][1] = __builtin_bit_cast(bf16x8, w);
    w.x = pk2(s1[0], s1[1]); w.y = pk2(s1[2], s1[3]); w.z = pk2(s1[4], s1[5]); w.w = pk2(s1[6], s1[7]); pf[1][0] = __builtin_bit_cast(bf16x8, w);
    w.x = pk2(s1[8], s1[9]); w.y = pk2(s1[10], s1[11]); w.z = pk2(s1[12], s1[13]); w.w = pk2(s1[14], s1[15]); pf[1][1] = __builtin_bit_cast(bf16x8, w);
    return alpha;
}
DI void att_pv(LAS unsigned char* Va, int q4, f32x16 (&O)[4], const bf16x8 (&pf)[2][2]) {
    s16x4 lo[16], hi[16];
#define PV_LD(i) do { LAS unsigned char* _vp = Va + ((((i) >> 2) ^ q4) << 6) + (32 * (((i) >> 1) & 1) + 16 * ((i) & 1)) * 256; \
        lo[i] = __builtin_amdgcn_ds_read_tr16_b64_v4i16((LAS s16x4*)_vp); hi[i] = __builtin_amdgcn_ds_read_tr16_b64_v4i16((LAS s16x4*)(_vp + 8 * 256)); } while (0)
    PV_LD(0); PV_LD(1); PV_LD(2);
#pragma unroll
    for (int i = 0; i < 16; ++i) {
        if (i + 3 < 16) PV_LD(i + 3);
        const bf16x8 vf = __builtin_shufflevector(lo[i], hi[i], 0, 1, 2, 3, 4, 5, 6, 7);
        O[i >> 2] = MFMA32(vf, pf[(i >> 1) & 1][i & 1], O[i >> 2]);
    }
#undef PV_LD
}

DI void phase_attn(const Params& P, LAS unsigned char* lds, int layer) {
    int tid_ = threadIdx.x; asm volatile("" : "+v"(tid_)); const int tid = tid_, wid = __builtin_amdgcn_readfirstlane(tid >> 6), lane = tid & 63, G = gridDim.x;
    unsigned char* ws = P.ws;
    const int j = layer >> 1;
    const int comp = wid >> 2, rg = wid & 3, r32 = lane & 31, h2 = lane >> 5;
    const bf16_t* proj = (const bf16_t*)(ws + WS_PROJ);
    bf16_t* OB = (bf16_t*)(ws + WS_HBUF);
    const float lam_init = 0.8f - 0.6f * expf(-0.3f * (float)layer);
    float lam;
    {
        float d1 = 0.f, d2 = 0.f;
        for (int i = 0; i < 64; ++i) { d1 += P.in[19][j * 64 + i] * P.in[20][j * 64 + i]; d2 += P.in[21][j * 64 + i] * P.in[22][j * 64 + i]; }
        lam = expf(d1) - expf(d2) + lam_init;
    }
    const float* subln = P.in[23] + j * 128;
    constexpr int TB = 32768;
    const int vb = (G % 8 == 0) ? (blockIdx.x % 8) * (G / 8) + blockIdx.x / 8 : blockIdx.x;
    const int nrounds = (G == 256) ? 9 : (2176 + G - 1) / G;
#define ATT_WAITV(n) asm volatile("s_waitcnt vmcnt(" #n ")" ::: "memory")
#define ATT_BAR() do { asm volatile("" ::: "memory"); __builtin_amdgcn_s_barrier(); asm volatile("" ::: "memory"); } while (0)
    for (int k = 0; k < nrounds; ++k) {
        int id;
        if (G == 256) {
            if (k < 8) { const int xcd = vb >> 5, idx = vb & 31; const int seq = xcd * 4 + (k >> 1); const int qt = (k & 1) ? idx : (63 - idx); id = seq * 64 + qt; }
            else { if (vb >= 128) break; id = 2048 + vb; }
        } else { id = vb + k * G; if (id >= 2176) break; }
        int h, qrow0, nt_all, nt_mine, last_valid; const int kvstride = 128; const bf16_t* Kp; const bf16_t* Vp; bool sample;
        if (id < 2048) {
            const int seq = id >> 6, qt = id & 63, b = seq >> 3; h = seq & 7; sample = false;
            qrow0 = b * TP + 128 * qt + 32 * rg; nt_all = 2 * qt + 2; nt_mine = (rg < 2) ? 2 * qt + 1 : 2 * qt + 2; last_valid = 64 * nt_mine;
            Kp = (const bf16_t*)(ws + WS_KH) + (size_t)seq * TP * 128; Vp = (const bf16_t*)(ws + WS_VH) + (size_t)seq * TP * 128;
        } else {
            const int s = id - 2048, b = s >> 3; h = s & 7; sample = true;
            qrow0 = MP + b * TS; nt_all = 34; nt_mine = (rg == 0) ? 34 : 0; last_valid = PAST + TS;
            Kp = (const bf16_t*)(ws + WS_KS) + (size_t)s * KSROWS * 128; Vp = (const bf16_t*)(ws + WS_VS) + (size_t)s * KSROWS * 128;
        }
        bf16x8 qf[4];
        {
            const int qr = qrow0 + (sample ? (r32 & 15) : r32);
            const bf16_t* qp = proj + (size_t)qr * NPROJ + h * 128 + comp * 64 + 8 * h2;
#pragma unroll
            for (int s = 0; s < 4; ++s) qf[s] = *(const bf16x8*)(qp + 16 * s);
        }
        f32x16 O[4];
#pragma unroll
        for (int et = 0; et < 4; ++et)
#pragma unroll
            for (int i = 0; i < 16; ++i) O[et][i] = 0.f;
        float m = -INFINITY, l = 0.f;
        bf16x8 pf[2][2];
#pragma unroll
        for (int a = 0; a < 2; ++a)
#pragma unroll
            for (int c2 = 0; c2 < 2; ++c2) pf[a][c2] = (bf16x8){0, 0, 0, 0, 0, 0, 0, 0};
        f32x16 sA0, sA1, sB0, sB1;
        const bf16_t* gsrc;
        {
            const int rowl = lane >> 4, c = lane & 15;
            const int row0 = 16 * (wid & 3) + rowl;
            const int lc = (wid < 4) ? (c ^ (row0 & 15)) : (c ^ ((row0 & 3) << 2));
            gsrc = ((wid < 4) ? Kp : Vp) + (size_t)row0 * kvstride + lc * 8;
        }
#define ATT_G2L(kt, bufi) do { _Pragma("unroll") for (int _i = 0; _i < 4; ++_i) { \
            const bf16_t* _s = gsrc + (size_t)(64 * (kt) + 4 * _i) * kvstride; \
            if (wid < 4) _s += (((lane & 15) ^ ((16 * (wid & 3) + 4 * _i + (lane >> 4)) & 15)) - ((lane & 15) ^ ((16 * (wid & 3) + (lane >> 4)) & 15))) * 8; \
            g2l16(_s, lds_u32(lds + (bufi) * TB + (4 * wid + _i) * 1024)); } } while (0)
        asm volatile("" :: "v"(qf[0]), "v"(qf[1]), "v"(qf[2]), "v"(qf[3]));
        __syncthreads();
        ATT_G2L(0, 0);
        if (nt_all > 1) { ATT_G2L(1, 1); ATT_WAITV(4); } else { ATT_WAITV(0); }
        ATT_BAR();
        {
            const int koff = r32 * 256, t = ((comp * 8 + h2) ^ (r32 & 15)) << 4;
            att_s(lds + koff, t, qf, sA0, sA1);
        }
#define ATT_ITER(KT, sC0, sC1, sN0, sN1, EDGE) do { \
            const int kt = (KT); \
            int lo_ = lane; asm volatile("" : "+v"(lo_)); \
            const int r32_ = lo_ & 31, h2_ = lo_ >> 5, q4_ = (lo_ & 15) >> 2, p4_ = lo_ & 3, blk_ = (lo_ >> 4) & 1; \
            const int koff_ = r32_ * 256, t_ = ((comp * 8 + h2_) ^ (r32_ & 15)) << 4; \
            const int voff_ = (4 * h2_ + q4_) * 256 + (2 * blk_ + (p4_ >> 1)) * 16 + (p4_ & 1) * 8; \
            ATT_WAITV(0); ATT_BAR(); \
            if (kt + 2 < nt_all) ATT_G2L(kt + 2, (kt + 2) & 3); \
            att_s(lds + ((kt + 1) & 3) * TB + koff_, t_, qf, sN0, sN1); \
            if (!(EDGE) || kt >= 1) att_pv(lds + ((kt - 1) & 3) * TB + 16384 + voff_, q4_, O, pf); \
            const float alpha = att_softmax<EDGE>(sC0, sC1, m, l, pf, h2_, last_valid - 64 * kt); \
            asm volatile("" :: "v"(l), "v"(pf[0][0]), "v"(pf[0][1]), "v"(pf[1][0]), "v"(pf[1][1]));     \
            _Pragma("unroll") for (int _g = 0; _g < 24; ++_g) { __builtin_amdgcn_sched_group_barrier(0x008, 1, 0); __builtin_amdgcn_sched_group_barrier(0x002, 7, 0); } \
            if (__any(alpha != 1.f)) { \
                _Pragma("unroll") for (int et = 0; et < 4; ++et) _Pragma("unroll") for (int i = 0; i < 16; ++i) O[et][i] *= alpha; } \
            } while (0)
        {
            const int npairs = nt_all >> 1;
            ATT_ITER(0, sA0, sA1, sB0, sB1, true);
            ATT_ITER(1, sB0, sB1, sA0, sA1, true);
            for (int pp = 1; pp < npairs - 1; ++pp) {
                ATT_ITER(2 * pp, sA0, sA1, sB0, sB1, false);
                ATT_ITER(2 * pp + 1, sB0, sB1, sA0, sA1, false);
            }
            if (npairs > 1) {
                ATT_ITER(nt_all - 2, sA0, sA1, sB0, sB1, true);
                ATT_ITER(nt_all - 1, sB0, sB1, sA0, sA1, true);
            }
        }
        {
            const int lt = nt_all - 1;
            const int h2b = lane >> 5, q4 = (lane & 15) >> 2, p4 = lane & 3, blk = (lane >> 4) & 1;
            const int voff = (4 * h2b + q4) * 256 + (2 * blk + (p4 >> 1)) * 16 + (p4 & 1) * 8;
            att_pv(lds + (lt & 3) * TB + 16384 + voff, q4, O, pf);
        }
        __syncthreads();
#undef ATT_ITER
#undef ATT_G2L
        const float lt = l + __shfl_xor(l, 32);
        const float inv = (nt_mine > 0) ? 1.f / lt : 0.f;
        LAS float* XO = (LAS float*)lds;
        if (comp == 1) {
            const float sc = inv * lam;
#pragma unroll
            for (int et = 0; et < 4; ++et)
#pragma unroll
                for (int i = 0; i < 16; ++i) XO[(rg * 128 + 32 * et + (i & 3) + 8 * (i >> 2) + 4 * h2) * 32 + r32] = O[et][i] * sc;
        }
        __syncthreads();
        if (comp == 0 && nt_mine > 0) {
            float ss = 0.f;
#pragma unroll
            for (int et = 0; et < 4; ++et)
#pragma unroll
                for (int i = 0; i < 16; ++i) { const float v = O[et][i] * inv - XO[(rg * 128 + 32 * et + (i & 3) + 8 * (i >> 2) + 4 * h2) * 32 + r32]; O[et][i] = v; ss += v * v; }
            ss += __shfl_xor(ss, 32);
            const float rstd = __builtin_amdgcn_rsqf(ss * (1.f / 128.f) + RMS_EPS) * (1.f - lam_init);
            const bool rvalid = sample ? (r32 < TS) : true;
            const int row = qrow0 + r32;
            if (rvalid) {
#pragma unroll
                for (int et = 0; et < 4; ++et)
#pragma unroll
                    for (int g4 = 0; g4 < 4; ++g4) {
                        const int e0 = 32 * et + 8 * g4 + 4 * h2;
                        const u32x2 zz = *(const u32x2*)(proj + (size_t)row * NPROJ + 3072 + h * 128 + e0);
                        const f32x4 sl = *(const f32x4*)(subln + e0);
                        const float z0 = __uint_as_float(zz.x << 16), z1 = __uint_as_float(zz.x & 0xffff0000u), z2 = __uint_as_float(zz.y << 16), z3 = __uint_as_float(zz.y & 0xffff0000u);
                        u32x2 w;
                        w.x = pk2(O[et][4 * g4] * rstd * sl[0] * siluf(z0), O[et][4 * g4 + 1] * rstd * sl[1] * siluf(z1));
                        w.y = pk2(O[et][4 * g4 + 2] * rstd * sl[2] * siluf(z2), O[et][4 * g4 + 3] * rstd * sl[3] * siluf(z3));
                        *(u32x2*)(OB + (size_t)row * 1024 + h * 128 + e0) = w;
                    }
            }
        }
        __syncthreads();
    }
}


#define XB_TMO      128
#define XB_XCNT(j)  (256  + 64 * (j))
#define XB_XSUB(j)  (1280 + 64 * (j))
#define XB_XGEN(j)  (2304 + 64 * (j))
#define XB_TOP      3328
#define XB_TOPGEN   3392
#define XCD_BAR_WORDS 3456
#define XB_SPIN_CAP (1u << 18)
DI unsigned xb_ld(unsigned* p)              { return __hip_atomic_load(p, __ATOMIC_RELAXED, __HIP_MEMORY_SCOPE_AGENT); }
DI unsigned xb_add(unsigned* p, unsigned v) { return __hip_atomic_fetch_add(p, v, __ATOMIC_RELAXED, __HIP_MEMORY_SCOPE_AGENT); }
DI unsigned xb_xcc_id() { return (unsigned)__builtin_amdgcn_s_getreg((3 << 11) | 20) & 0xFu; }
#define XB_SPIN(cond, bar) do { unsigned _sp = 0; while (cond) { __builtin_amdgcn_s_sleep(1); \
    if ((++_sp & 255u) == 0u) { if (xb_ld(&(bar)[XB_TMO])) break; if (_sp > XB_SPIN_CAP) { atomicAdd(&(bar)[XB_TMO], 1u); break; } } } } while (0)
DI void xcd_barrier_complete(unsigned* bar, unsigned x, unsigned& nloc, unsigned& nx) {
    const unsigned G = gridDim.x * gridDim.y * gridDim.z;
    unsigned sum, cnt, mine, sp = 0u;
    for (;;) {
        sum = 0u; cnt = 0u; mine = 0u;
#pragma unroll
        for (unsigned j = 0; j < 16; ++j) { const unsigned c = xb_ld(&bar[XB_XCNT(j)]); sum += c; cnt += (c > 0u) ? 1u : 0u; mine = (j == x) ? c : mine; }
        if (sum == G) break;
        __builtin_amdgcn_s_sleep(1);
        if ((++sp & 255u) == 0u) { if (xb_ld(&bar[XB_TMO])) break; if (sp > XB_SPIN_CAP) { atomicAdd(&bar[XB_TMO], 1u); break; } }
    }
    nloc = mine > 0u ? mine : 1u; nx = cnt > 0u ? cnt : 1u;
}
DI void xcd_barrier(unsigned* bar, volatile LAS unsigned* st) {
    asm volatile("s_waitcnt vmcnt(0)" ::: "memory");
    __syncthreads();
    if (threadIdx.x == 0) {
        const unsigned x = xb_xcc_id();
        __builtin_amdgcn_s_waitcnt(0);
        unsigned nloc = st[0], nx = st[1];
        if (nloc == 0u) { xcd_barrier_complete(bar, x, nloc, nx); st[0] = nloc; st[1] = nx; }
        const unsigned old = xb_add(&bar[XB_XSUB(x)], 1u);
        const unsigned gen = old / nloc;
        if (old + 1u == (gen + 1u) * nloc) {
            __builtin_amdgcn_fence(__ATOMIC_RELEASE, "agent");
            asm volatile("s_waitcnt vmcnt(0)" ::: "memory");
            const unsigned og = xb_add(&bar[XB_TOP], 1u);
            const unsigned tg = og / nx;
            if (og + 1u == (tg + 1u) * nx) xb_add(&bar[XB_TOPGEN], 1u);
            else XB_SPIN(xb_ld(&bar[XB_TOPGEN]) == tg, bar);
            __builtin_amdgcn_fence(__ATOMIC_ACQUIRE, "agent");
            xb_add(&bar[XB_XGEN(x)], 1u);
            asm volatile("s_waitcnt vmcnt(0)" ::: "memory");
        } else {
            XB_SPIN(xb_ld(&bar[XB_XGEN(x)]) == gen, bar);
            __builtin_amdgcn_fence(__ATOMIC_ACQUIRE, "agent");
            asm volatile("s_waitcnt vmcnt(0)" ::: "memory");
        }
    }
    __syncthreads();
}

typedef const __attribute__((address_space(4))) Params* CParP;
#define LOADP() Params P; { CParP kp_ = KP; asm volatile("" : "+s"(kp_)); P = *kp_; } unsigned char* ws = P.ws; (void)ws
__global__ void __launch_bounds__(512, 2) fwd_megakernel(Params Pin) {
#if defined(__HIP_DEVICE_COMPILE__)
    extern __shared__ __attribute__((aligned(16))) unsigned char lds_raw[];
    LAS unsigned char* lds = (LAS unsigned char*)lds_raw;
    cg::grid_group grid = cg::this_grid();
    const CParP KP = (CParP)__builtin_amdgcn_kernarg_segment_ptr();
    volatile LAS unsigned* xst = (volatile LAS unsigned*)(lds + 131072);
    if (threadIdx.x == 0) { xst[0] = 0u; xst[1] = 0u; }
    __syncthreads();
    { LOADP(); if (threadIdx.x == 0) (void)xb_add(&((unsigned*)(ws + WS_BAR))[XB_XCNT(xb_xcc_id())], 1u); }
#define GRID_BAR() do { LOADP(); xcd_barrier((unsigned*)(ws + WS_BAR), xst); } while (0)
    { LOADP(); phase_prep(P, lds); }
    grid.sync();
    for (int layer = 0; layer < 4; ++layer) {
        const int j = layer >> 1;
        { LOADP(); phase_elem(P, lds, layer); }
        GRID_BAR();
        {
            LOADP();
            pg8::StaticOrder S; S.init(M, NPROJ, gridDim.x, blockIdx.x);
            pg8::Gemm g;
            g.A = (const bf16_t*)(ws + WS_HBUF); g.M = M; g.N = NPROJ; g.K = 1024;
            if (!(layer & 1)) {
                g.Bt = (const bf16_t*)(ws + WS_WING) + (size_t)j * 4096 * 1024;
                EpiGdnIn E; E.proj = (bf16_t*)(ws + WS_PROJ); E.conv_p = P.out + OFF_CVP + (size_t)j * 4 * 3 * 3072; E.conv_s = P.out + OFF_CVS + (size_t)j * 16 * 3 * 3072;
                pg8::gemm_phase(lds, g, S, E);
            } else {
                g.Bt = (const bf16_t*)(ws + WS_WIND) + (size_t)j * 4096 * 1024;
                EpiDiffIn E; E.proj = (bf16_t*)(ws + WS_PROJ);
                E.k_p = P.out + OFF_KP + (size_t)j * MP * 1024; E.v_p = P.out + OFF_VP + (size_t)j * MP * 1024;
                E.k_s = P.out + OFF_KSO + (size_t)j * MS * 1024; E.v_s = P.out + OFF_VSO + (size_t)j * MS * 1024;
                E.ks = (bf16_t*)(ws + WS_KS); E.vs = (bf16_t*)(ws + WS_VS); E.kh = (bf16_t*)(ws + WS_KH); E.vh = (bf16_t*)(ws + WS_VH); E.rope = (const float*)(ws + WS_ROPE);
                pg8::gemm_phase(lds, g, S, E);
            }
        }
        GRID_BAR();
        if (!(layer & 1)) {
            { LOADP(); phase_g1(P, lds, layer); }
            GRID_BAR();
            { LOADP(); phase_scan(P, lds, layer); }
            GRID_BAR();
            { LOADP(); phase_gnorm(P, layer); }
        } else {
            { LOADP(); phase_attn(P, lds, layer); }
        }
        GRID_BAR();
        {
            LOADP();
            pg8::StaticOrder S; S.init(M, 1024, gridDim.x, blockIdx.x);
            pg8::Gemm g;
            g.A = (const bf16_t*)(ws + WS_HBUF); g.M = M; g.N = 1024; g.K = 1024;
            g.Bt = (const bf16_t*)(ws + ((layer & 1) ? WS_WOUTD : WS_WOUTG)) + (size_t)j * 1024 * 1024;
            EpiOut E; E.C = (bf16_t*)(ws + WS_PROJ);
            pg8::gemm_phase(lds, g, S, E);
        }
        GRID_BAR();
    }
    { LOADP(); phase_elem(P, lds, 4); }
#endif
}

extern "C" void kernel_launch(void* const* d_in, const int* in_sizes, int n_in, void* d_out, int out_size, void* d_ws, size_t ws_size, hipStream_t stream) {
    static int grid_blocks = 0;
    if (!grid_blocks) {
        int dev = 0, cus = 0, per_cu = 0;
        hipGetDevice(&dev);
        hipDeviceGetAttribute(&cus, hipDeviceAttributeMultiprocessorCount, dev);
        hipFuncSetAttribute((const void*)fwd_megakernel, hipFuncAttributeMaxDynamicSharedMemorySize, LDS_BYTES);
        hipOccupancyMaxActiveBlocksPerMultiprocessor(&per_cu, (const void*)fwd_megakernel, 512, LDS_BYTES);
        if (per_cu < 1) per_cu = 1;
        grid_blocks = cus * per_cu;
        if (ws_size < WS_END) fprintf(stderr, "kernel_launch: workspace too small: %zu < %zu\n", ws_size, (size_t)WS_END);
    }
    hipMemsetAsync((unsigned char*)d_ws + WS_BAR, 0, XCD_BAR_WORDS * sizeof(unsigned), stream);
    Params p{};
    for (int i = 0; i < 25; ++i) p.in[i] = (const float*)d_in[i];
    p.out = (float*)d_out; p.ws = (unsigned char*)d_ws;
    void* args[] = {&p};
    hipError_t e = hipLaunchCooperativeKernel((const void*)fwd_megakernel, dim3(grid_blocks), dim3(512), args, LDS_BYTES, stream);
    if (e != hipSuccess) fprintf(stderr, "cooperative launch failed: %s (grid %d)\n", hipGetErrorString(e), grid_blocks);
}
```

```cpp
#include <hip/hip_runtime.h>
#include <hip/hip_cooperative_groups.h>
#include <cstdio>
namespace cg = cooperative_groups;

#define DI __device__ __forceinline__
#define LAS __attribute__((address_space(3)))
typedef unsigned short bf16_t;
typedef short bf16x8 __attribute__((ext_vector_type(8)));
typedef short s16x4 __attribute__((ext_vector_type(4)));
typedef float f32x2 __attribute__((ext_vector_type(2)));
typedef float f32x4 __attribute__((ext_vector_type(4)));
typedef float f32x16 __attribute__((ext_vector_type(16)));
typedef unsigned u32x2 __attribute__((ext_vector_type(2)));
typedef unsigned u32x4 __attribute__((ext_vector_type(4)));
typedef __bf16 bf16x2_t __attribute__((ext_vector_type(2)));

#define REP_G1 1
#define REP_SCAN 1
#define REP_ATTN 1
#define REP_GIN 1
#define REP_GOUT 1
#define REP_PREP 1
DI int opaque_i(int v) { asm volatile("" : "+s"(v)); return v; }
constexpr int D = 1024, TP = 8192, BP = 4, BS = 16, TS = 16, PAST = 2048;
constexpr int MP = BP * TP, MS = BS * TS, M = MP + MS, NB = BP + BS;
constexpr int NPROJ = 4096;
constexpr int KSROWS = 2112;
constexpr int NITEM_P = 4096, NITEM = 4224;
constexpr size_t ITEM_BYTES = 90112;
constexpr float RMS_EPS = 1e-6f;
constexpr float QSCALE = 0.125f * 1.4426950408889634f;

constexpr size_t OFF_Y = 0;
constexpr size_t OFF_STP = (size_t)M * D;
constexpr size_t OFF_CVP = OFF_STP + 2ull * 4 * 8 * 128 * 128;
constexpr size_t OFF_KP = OFF_CVP + 2ull * 4 * 3 * 3072;
constexpr size_t OFF_VP = OFF_KP + 2ull * MP * 1024;
constexpr size_t OFF_STS = OFF_VP + 2ull * MP * 1024;
constexpr size_t OFF_CVS = OFF_STS + 2ull * 16 * 8 * 128 * 128;
constexpr size_t OFF_KSO = OFF_CVS + 2ull * 16 * 3 * 3072;
constexpr size_t OFF_VSO = OFF_KSO + 2ull * MS * 1024;

constexpr size_t WS_WING = 0;
constexpr size_t WS_WOUTG = WS_WING + 2ull * 4096 * 1024 * 2;
constexpr size_t WS_WIND = WS_WOUTG + 2ull * 1024 * 1024 * 2;
constexpr size_t WS_WOUTD = WS_WIND + 2ull * 4096 * 1024 * 2;
constexpr size_t WS_ADA = WS_WOUTD + 2ull * 1024 * 1024 * 2;
constexpr size_t WS_ROPE = WS_ADA + 4ull * NB * 3072 * 4;
constexpr size_t WS_AB = WS_ROPE + 8208ull * 64 * 4;
constexpr size_t WS_GL = WS_AB + (size_t)M * 16 * 4;
constexpr size_t WS_BAR = WS_GL + 17408;
constexpr size_t WS_HBUF = WS_GL + 32768;
constexpr size_t WS_ORAW = WS_HBUF + (size_t)M * 1024 * 2;
constexpr size_t WS_PROJ = WS_ORAW + 256;
constexpr size_t WS_R1 = WS_PROJ + (size_t)M * 4096 * 2;
constexpr size_t WS_KH = WS_R1;
constexpr size_t WS_VH = WS_KH + (size_t)MP * 1024 * 2;
constexpr size_t WS_ORAWB = WS_R1 + (size_t)NITEM * ITEM_BYTES;
constexpr size_t WS_KS = WS_ORAWB + (size_t)M * 1024 * 2;
constexpr size_t WS_VS = WS_KS + 16ull * KSROWS * 1024 * 2;
constexpr size_t WS_END = WS_VS + 16ull * KSROWS * 1024 * 2;

constexpr int LDS_BYTES = 131072 + 16;

struct Params { const float* in[25]; float* out; unsigned char* ws; };

DI float bf2f(bf16_t v) { return __uint_as_float(((unsigned)v) << 16); }
DI unsigned pk2(float a, float b) { f32x2 v = {a, b}; bf16x2_t r = __builtin_convertvector(v, bf16x2_t); return __builtin_bit_cast(unsigned, r); }
DI bf16_t f2bf(float a) { return (bf16_t)(pk2(a, 0.f) & 0xffffu); }
template <int CTRL> DI float dppf(float v) { return __builtin_bit_cast(float, __builtin_amdgcn_update_dpp(0, __builtin_bit_cast(int, v), CTRL, 0xf, 0xf, true)); }
DI float row_sum16(float v) { v += dppf<0x128>(v); v += dppf<0x124>(v); v += dppf<0x122>(v); v += dppf<0x121>(v); return v; }
DI float wave_sum(float v) { v = row_sum16(v); v += __shfl_xor(v, 16); v += __shfl_xor(v, 32); return v; }
DI float readlane_f(float v, int l) { return __builtin_bit_cast(float, __builtin_amdgcn_readlane(__builtin_bit_cast(int, v), l)); }
DI float siluf(float x) { return x * __builtin_amdgcn_rcpf(1.f + __expf(-x)); }
DI int ppos(int idx) { const int d5 = idx & 31; return (idx & ~31) | (((d5 >> 2) & 3) << 3) | ((d5 >> 4) << 2) | (d5 & 3); }
DI int perm64(int ls) { return (ls & 15) | (((ls >> 4) & 1) << 5) | (((ls >> 5) & 1) << 4); }
DI void unpack8(const u32x4 v, float (&o)[8]) {
#pragma unroll
    for (int i = 0; i < 4; ++i) { o[2 * i] = __uint_as_float(v[i] << 16); o[2 * i + 1] = __uint_as_float(v[i] & 0xffff0000u); }
}
DI void g2l16(const void* gptr, unsigned lds_addr) {
    asm volatile("s_mov_b32 m0, %1\n\ts_nop 0\n\tglobal_load_lds_dwordx4 %0, off" :: "v"(gptr), "s"(lds_addr) : "memory", "m0");
}
DI unsigned lds_u32(LAS unsigned char* p) { return (unsigned)(size_t)p; }
#define MFMA16(a, b, c) __builtin_amdgcn_mfma_f32_16x16x32_bf16((a), (b), (c), 0, 0, 0)
#define MFMA32(a, b, c) __builtin_amdgcn_mfma_f32_32x32x16_bf16((a), (b), (c), 0, 0, 0)

namespace pg8 {
constexpr int BM = 256, BK = 64, HALF = 128, HTB = HALF * BK * 2, STAGE_BYTES = 8 * HTB, NXCD = 8, WGM = 8;
DI int lds_byte(int r, int c) { const int st = (r >> 4) * 2 + (c >> 5), rr = r & 15, cc = c & 31, ob = rr * 64 + cc * 2; return st * 1024 + (ob ^ (((ob >> 9) & 1) << 5)); }
DI void stage_rc(int b, int& R, int& C) { const int st = b / 1024, sb = b % 1024, swz = sb ^ (((sb >> 9) & 1) << 5); R = (st >> 1) * 16 + swz / 64; C = (st & 1) * 32 + (swz % 64) / 2; }
struct Unit { int pm, pn; };
struct Gemm { const bf16_t* A; const bf16_t* Bt; int M, N, K; };
struct StaticOrder {
    int nM, nN, nwg, G, c;
    DI void init(int M_, int N_, int G_, int c_) { nM = M_ / BM; nN = N_ / BM; nwg = nM * nN; G = G_; c = c_; }
    DI bool next(int i, Unit& u) const {
        const long L = (long)i * G + c; if (L >= nwg) return false;
        int wgid = (int)L; { const int q = nwg / NXCD, r = nwg % NXCD, xcd = wgid % NXCD, off = wgid / NXCD; wgid = (xcd < r ? xcd * (q + 1) : r * (q + 1) + (xcd - r) * q) + off; }
        const int nig = WGM * nN, gid = wgid / nig, fm = gid * WGM, gsz = (nM - fm) < WGM ? (nM - fm) : WGM;
        u.pm = fm + ((wgid % nig) % gsz); u.pn = (wgid % nig) / gsz; return true;
    }
};

template <class Epi>
DI void gemm_phase(LAS unsigned char* lds, const Gemm g, const StaticOrder& S, const Epi& E) {
    int tid_ = threadIdx.x; asm volatile("" : "+v"(tid_)); const int tid = tid_, wid = __builtin_amdgcn_readfirstlane(tid >> 6), lane = tid & 63, wr = wid >> 2, wc = wid & 3, fr = lane & 15, fq = lane >> 4;
    const int K = g.K, nt = K / BK;
    unsigned voffA[2];
#pragma unroll
    for (int i = 0; i < 2; ++i) { int R, C; stage_rc(tid * 16 + i * 8192, R, C); voffA[i] = (unsigned)(R * K + C) * 2u; }
    const size_t kstep = (size_t)(BK * 2);
    const size_t hstep = (size_t)HALF * K * 2;
    const size_t tstep = 2 * hstep;
    const unsigned ldsw = (unsigned)wid * 1024u;
    const int aoff = lds_byte(wr * 64 + fr, fq * 8), boff = lds_byte(wc * 32 + fr, fq * 8);
#define PG8_SA(b, h) (((b) * 2 + (h)) * HTB)
#define PG8_SB(b, h) ((4 + (b) * 2 + (h)) * HTB)
#define PG8_STAGE(bufoff, gbase) do { _Pragma("unroll") for (int _i = 0; _i < 2; ++_i) \
        __builtin_amdgcn_global_load_lds((const unsigned*)((const char*)(gbase) + voffA[_i]), (LAS unsigned*)(lds + (bufoff) + ldsw + _i * 8192), 16, 0, 0); } while (0)
#define PG8_LDA(dst, b, h) do { _Pragma("unroll") for (int m = 0; m < 4; ++m) _Pragma("unroll") for (int k = 0; k < 2; ++k) dst[m][k] = *(const LAS bf16x8*)(lds + PG8_SA(b, h) + aoff + m * 2048 + k * 1024); } while (0)
#define PG8_LDB(dst, b, h) do { _Pragma("unroll") for (int n = 0; n < 2; ++n) _Pragma("unroll") for (int k = 0; k < 2; ++k) dst[n][k] = *(const LAS bf16x8*)(lds + PG8_SB(b, h) + boff + n * 2048 + k * 1024); } while (0)
#define PG8_MMA(ai, bj, At, Bt) do { __builtin_amdgcn_s_setprio(1); _Pragma("unroll") for (int m = 0; m < 4; ++m) _Pragma("unroll") for (int n = 0; n < 2; ++n) _Pragma("unroll") for (int k = 0; k < 2; ++k) \
        acc[ai][bj][m][n] = __builtin_amdgcn_mfma_f32_16x16x32_bf16(Bt[n][k], At[m][k], acc[ai][bj][m][n], 0, 0, 0); __builtin_amdgcn_s_setprio(0); } while (0)
#define PG8_WAIT_V(n) asm volatile("s_waitcnt vmcnt(" #n ")" ::: "memory")
#define PG8_WAIT_L(n) asm volatile("s_waitcnt lgkmcnt(" #n ")" ::: "memory")
#define PG8_BAR __builtin_amdgcn_s_barrier()
#define PG8_SCHED __builtin_amdgcn_sched_barrier(0)
    Unit cur, nxt; int ui = 0;
    if (!S.next(0, cur)) return;
    f32x4 acc[2][2][4][2];
#pragma unroll
    for (int a = 0; a < 2; ++a)
#pragma unroll
        for (int b = 0; b < 2; ++b)
#pragma unroll
            for (int m = 0; m < 4; ++m)
#pragma unroll
                for (int n = 0; n < 2; ++n) acc[a][b][m][n] = (f32x4){0.f, 0.f, 0.f, 0.f};
    bf16x8 At[4][2], B0[2][2], B1[2][2];
    const char* cA = (const char*)g.A + (size_t)cur.pm * tstep; const char* cB = (const char*)g.Bt + (size_t)cur.pn * tstep;
    PG8_STAGE(PG8_SB(0, 0), cB); PG8_STAGE(PG8_SA(0, 0), cA); PG8_STAGE(PG8_SB(0, 1), cB + hstep); PG8_STAGE(PG8_SA(0, 1), cA + hstep);
    if (wr == 1) PG8_BAR;
    PG8_WAIT_V(4); PG8_BAR;
    PG8_STAGE(PG8_SB(1, 0), cB + kstep); PG8_STAGE(PG8_SA(1, 0), cA + kstep); PG8_STAGE(PG8_SB(1, 1), cB + hstep + kstep);
    PG8_WAIT_V(6); PG8_BAR;
    for (;;) {
        const bool has_next = S.next(ui + 1, nxt);
        const char* nA = has_next ? (const char*)g.A + (size_t)nxt.pm * tstep : cA; const char* nB = has_next ? (const char*)g.Bt + (size_t)nxt.pn * tstep : cB;
        for (int t = 0; t < nt; t += 2) {
            const bool last = (t == nt - 2);
            const char* a1 = cA + (size_t)(t + 1) * kstep;
            const char* a2 = last ? nA : cA + (size_t)(t + 2) * kstep; const char* b2 = last ? nB : cB + (size_t)(t + 2) * kstep;
            const char* a3 = a2 + kstep; const char* b3 = b2 + kstep;
            PG8_LDB(B0, 0, 0); PG8_SCHED; PG8_LDA(At, 0, 0); PG8_STAGE(PG8_SA(1, 1), a1 + hstep);
            PG8_WAIT_L(8); PG8_BAR; PG8_WAIT_L(0); PG8_MMA(0, 0, At, B0); PG8_BAR; PG8_SCHED;
            PG8_LDB(B1, 0, 1); PG8_STAGE(PG8_SB(0, 0), b2);
            PG8_BAR; PG8_WAIT_L(0); PG8_MMA(0, 1, At, B1); PG8_BAR;
            PG8_LDA(At, 0, 1); PG8_STAGE(PG8_SA(0, 0), a2);
            PG8_BAR; PG8_WAIT_L(0); PG8_MMA(1, 0, At, B0); PG8_BAR; PG8_SCHED;
            PG8_STAGE(PG8_SB(0, 1), b2 + hstep);
            PG8_WAIT_V(6); PG8_BAR; PG8_MMA(1, 1, At, B1); PG8_BAR;
            PG8_LDB(B0, 1, 0); PG8_SCHED; PG8_LDA(At, 1, 0); PG8_STAGE(PG8_SA(0, 1), a2 + hstep);
            PG8_WAIT_L(8); PG8_BAR; PG8_WAIT_L(0); PG8_MMA(0, 0, At, B0); PG8_BAR; PG8_SCHED;
            PG8_LDB(B1, 1, 1); PG8_STAGE(PG8_SB(1, 0), b3);
            PG8_BAR; PG8_WAIT_L(0); PG8_MMA(0, 1, At, B1); PG8_BAR;
            PG8_LDA(At, 1, 1); PG8_STAGE(PG8_SA(1, 0), a3);
            PG8_BAR; PG8_WAIT_L(0); PG8_MMA(1, 0, At, B0); PG8_BAR; PG8_SCHED;
            PG8_STAGE(PG8_SB(1, 1), b3 + hstep);
            PG8_WAIT_V(6); PG8_BAR; PG8_MMA(1, 1, At, B1); PG8_BAR;
        }
        E(acc, cur, wr, wc, fr, fq);
        if (!has_next) break;
#pragma unroll
        for (int a = 0; a < 2; ++a)
#pragma unroll
            for (int b = 0; b < 2; ++b)
#pragma unroll
                for (int m = 0; m < 4; ++m)
#pragma unroll
                    for (int n = 0; n < 2; ++n) acc[a][b][m][n] = (f32x4){0.f, 0.f, 0.f, 0.f};
        cur = nxt; cA = nA; cB = nB; ++ui;
    }
    PG8_WAIT_V(0);
    if (wr == 0) PG8_BAR;
    PG8_BAR;
#undef PG8_SA
#undef PG8_SB
#undef PG8_STAGE
#undef PG8_LDA
#undef PG8_LDB
#undef PG8_MMA
#undef PG8_WAIT_V
#undef PG8_WAIT_L
#undef PG8_BAR
#undef PG8_SCHED
}
}

struct EpiGdnIn {
    bf16_t* proj; float* conv_p; float* conv_s;
    DI void operator()(const f32x4 (&acc)[2][2][4][2], const pg8::Unit& u, int wr, int wc, int fr, int fq) const {
        const int row0 = u.pm * 256 + wr * 64 + fr, col0 = u.pn * 256 + wc * 32 + 4 * fq;
#pragma unroll
        for (int ai = 0; ai < 2; ++ai)
#pragma unroll
            for (int m = 0; m < 4; ++m) {
                const int r = row0 + ai * 128 + m * 16;
                bf16_t* rowp = proj + (size_t)r * NPROJ + col0;
                bool tail; float* cp;
                if (r < MP) { const int t = r & (TP - 1), b = r >> 13; tail = t >= TP - 3; cp = conv_p + (size_t)(b * 3 + (t - (TP - 3))) * 3072; }
                else { const int rs = r - MP, t = rs & 15, b = rs >> 4; tail = t >= TS - 3; cp = conv_s + (size_t)(b * 3 + (t - (TS - 3))) * 3072; }
#pragma unroll
                for (int bj = 0; bj < 2; ++bj)
#pragma unroll
                    for (int n = 0; n < 2; ++n) {
                        const f32x4 v = acc[ai][bj][m][n];
                        u32x2 w; w.x = pk2(v[0], v[1]); w.y = pk2(v[2], v[3]);
                        *(u32x2*)(rowp + bj * 128 + n * 16) = w;
                        const int c = col0 + bj * 128 + n * 16;
                        if (tail && c < 3072) *(f32x4*)(cp + c) = v;
                    }
            }
    }
};

struct EpiDiffIn {
    bf16_t* proj; float* k_p; float* v_p; float* k_s; float* v_s; bf16_t* ks; bf16_t* vs; bf16_t* kh; bf16_t* vh; const float* rope;
    DI void operator()(const f32x4 (&acc)[2][2][4][2], const pg8::Unit& u, int wr, int wc, int fr, int fq) const {
        const int part = u.pn >> 2;
        const int row0 = u.pm * 256 + wr * 64 + fr;
        const int d0 = 16 * (wc & 1) + 4 * fq;
        const int cbase = u.pn * 256 + 64 * (wc >> 1) + d0;
#pragma unroll
        for (int ai = 0; ai < 2; ++ai)
#pragma unroll
            for (int m = 0; m < 4; ++m) {
                const int r = row0 + ai * 128 + m * 16;
                const int rs = r - MP;
                const int pidx = (r < MP) ? (r & (TP - 1)) : (TP + (rs & 15));
                f32x4 cs = {1.f, 1.f, 1.f, 1.f}, sn = {0.f, 0.f, 0.f, 0.f};
                if (part < 2) { cs = *(const f32x4*)(rope + (size_t)pidx * 64 + d0); sn = *(const f32x4*)(rope + (size_t)pidx * 64 + 32 + d0); }
#pragma unroll
                for (int bj = 0; bj < 2; ++bj) {
                    const f32x4 x1 = acc[ai][bj][m][0], x2 = acc[ai][bj][m][1];
                    f32x4 y1 = x1 * cs - x2 * sn, y2 = x2 * cs + x1 * sn;
                    const int col = cbase + bj * 128;
                    bf16_t* pp = proj + (size_t)r * NPROJ + col;
                    if (part == 0) { y1 *= QSCALE; y2 *= QSCALE; }
                    u32x2 w1, w2; w1.x = pk2(y1[0], y1[1]); w1.y = pk2(y1[2], y1[3]); w2.x = pk2(y2[0], y2[1]); w2.y = pk2(y2[2], y2[3]);
                    if (part == 0 || part == 3) { *(u32x2*)pp = w1; *(u32x2*)(pp + 32) = w2; }
                    if (part == 1 || part == 2) {
                        const int cc = col - part * 1024;
                        const int hh = cc >> 7, dd = cc & 127;
                        float* op; bf16_t* sp;
                        if (r < MP) { op = (part == 1 ? k_p : v_p) + (size_t)r * 1024 + cc;
                               sp = (part == 1 ? kh : vh) + ((size_t)((r >> 13) * 8 + hh) * TP + (r & (TP - 1))) * 128 + dd; }
                        else { op = (part == 1 ? k_s : v_s) + (size_t)rs * 1024 + cc;
                               sp = (part == 1 ? ks : vs) + ((size_t)((rs >> 4) * 8 + hh) * KSROWS + PAST + (rs & 15)) * 128 + dd; }
                        *(f32x4*)op = y1; *(f32x4*)(op + 32) = y2;
                        *(u32x2*)sp = w1; *(u32x2*)(sp + 32) = w2;
                    }
                }
            }
    }
};

struct EpiOut {
    bf16_t* C;
    DI void operator()(const f32x4 (&acc)[2][2][4][2], const pg8::Unit& u, int wr, int wc, int fr, int fq) const {
        const int row0 = u.pm * 256 + wr * 64 + fr, col0 = u.pn * 256 + wc * 32 + 4 * fq;
#pragma unroll
        for (int ai = 0; ai < 2; ++ai)
#pragma unroll
            for (int m = 0; m < 4; ++m) {
                bf16_t* rowp = C + (size_t)(row0 + ai * 128 + m * 16) * 1024 + col0;
#pragma unroll
                for (int bj = 0; bj < 2; ++bj)
#pragma unroll
                    for (int n = 0; n < 2; ++n) { const f32x4 v = acc[ai][bj][m][n]; u32x2 w; w.x = pk2(v[0], v[1]); w.y = pk2(v[2], v[3]); *(u32x2*)(rowp + bj * 128 + n * 16) = w; }
            }
    }
};

DI void transpose_tile(const float* W, int ldw, int n0, int k0, bf16_t* WT, bool perm, LAS float* tile) {
    int tid_ = threadIdx.x; asm volatile("" : "+v"(tid_)); const int tid = tid_;
    {
        const int kk = tid >> 4, c4 = (tid & 15) * 4;
#pragma unroll
        for (int p = 0; p < 2; ++p) {
            const f32x4 v = *(const f32x4*)(W + (size_t)(k0 + kk + 32 * p) * ldw + n0 + c4);
            LAS float* t = tile + (kk + 32 * p) * 65 + c4;
            t[0] = v[0]; t[1] = v[1]; t[2] = v[2]; t[3] = v[3];
        }
    }
    __syncthreads();
    {
        const int n = tid >> 3, ks = (tid & 7) * 8;
        const int src = perm ? perm64(n) : n;
        float v[8];
#pragma unroll
        for (int e = 0; e < 8; ++e) v[e] = tile[(ks + e) * 65 + src];
        u32x4 w; w.x = pk2(v[0], v[1]); w.y = pk2(v[2], v[3]); w.z = pk2(v[4], v[5]); w.w = pk2(v[6], v[7]);
        *(u32x4*)(WT + (size_t)(n0 + n) * 1024 + k0 + ks) = w;
    }
    __syncthreads();
}

DI void phase_prep(const Params& P, LAS unsigned char* lds) {
    int tid_ = threadIdx.x; asm volatile("" : "+v"(tid_)); const int tid = tid_, G = gridDim.x;
    unsigned char* ws = P.ws;
    for (int id = blockIdx.x; id < 5120; id += G) {
        const int j = id / 2560; int rem = id % 2560;
        const float* W; int ldw; bf16_t* WT; bool perm = false; int t;
        if (rem < 1024) { W = P.in[12] + (size_t)j * 1024 * 4112; ldw = 4112; WT = (bf16_t*)(ws + WS_WING) + (size_t)j * 4096 * 1024; t = rem; }
        else if (rem < 1280) { W = P.in[17] + (size_t)j * 1024 * 1024; ldw = 1024; WT = (bf16_t*)(ws + WS_WOUTG) + (size_t)j * 1024 * 1024; t = rem - 1024; }
        else if (rem < 2304) { W = P.in[18] + (size_t)j * 1024 * 4096; ldw = 4096; WT = (bf16_t*)(ws + WS_WIND) + (size_t)j * 4096 * 1024; t = rem - 1280; perm = true; }
        else { W = P.in[24] + (size_t)j * 1024 * 1024; ldw = 1024; WT = (bf16_t*)(ws + WS_WOUTD) + (size_t)j * 1024 * 1024; t = rem - 2304; }
        transpose_tile(W, ldw, (t >> 4) * 64, (t & 15) * 64, WT, perm, (LAS float*)lds);
    }
    for (int idx = blockIdx.x * 512 + tid; idx < 8208 * 32; idx += G * 512) {
        const int pi = idx >> 5, d = idx & 31;
        const int pos = pi < TP ? pi : PAST + (pi - TP);
        const float inv = 1.0f / powf(10000.0f, (float)d / 32.0f);
        const float ang = (float)pos * inv;
        const double rev = (double)ang * 0.15915494309189535;
        const double fr = rev - floor(rev);
        float* rp = (float*)(ws + WS_ROPE) + (size_t)pi * 64;
        rp[d] = __builtin_amdgcn_cosf((float)fr);
        rp[32 + d] = __builtin_amdgcn_sinf((float)fr);
    }
    {
        LAS float* cact = (LAS float*)lds;
        LAS float* red = (LAS float*)(lds + 81920);
        bool loaded = false;
        for (int id = (G - 1 - blockIdx.x); id < 192; id += G) {
            if (!loaded) {
                for (int e = tid; e < NB * 1024; e += 512) {
                    const int b = e >> 10, k = e & 1023;
                    const float c = b < BP ? P.in[2][b * 1024 + k] : P.in[3][(b - BP) * 1024 + k];
                    cact[e] = siluf(c);
                }
                loaded = true;
            }
            __syncthreads();
            const int i = id / 48, cb = id % 48;
            const int col = tid & 63, kg = tid >> 6;
            const float* Wp = P.in[10] + (size_t)i * 1024 * 3072 + cb * 64 + col;
            float acc[NB];
#pragma unroll
            for (int b = 0; b < NB; ++b) acc[b] = 0.f;
            for (int k = kg * 128; k < kg * 128 + 128; k += 4) {
                const float w0 = Wp[(size_t)k * 3072], w1 = Wp[(size_t)(k + 1) * 3072], w2 = Wp[(size_t)(k + 2) * 3072], w3 = Wp[(size_t)(k + 3) * 3072];
#pragma unroll
                for (int b = 0; b < NB; ++b) {
                    const f32x4 c4 = *(const LAS f32x4*)(cact + b * 1024 + k);
                    acc[b] += c4[0] * w0 + c4[1] * w1 + c4[2] * w2 + c4[3] * w3;
                }
            }
#pragma unroll
            for (int b = 0; b < NB; ++b) red[(kg * NB + b) * 64 + col] = acc[b];
            __syncthreads();
            for (int o = tid; o < NB * 64; o += 512) {
                const int b = o >> 6, c = o & 63;
                float s = P.in[11][i * 3072 + cb * 64 + c];
#pragma unroll
                for (int g = 0; g < 8; ++g) s += red[(g * NB + b) * 64 + c];
                ((float*)(ws + WS_ADA))[((size_t)i * NB + b) * 3072 + cb * 64 + c] = s;
            }
        }
        __syncthreads();
    }
}

DI void phase_elem(const Params& P, LAS unsigned char* lds, int layer) {
    int tid_ = threadIdx.x; asm volatile("" : "+v"(tid_)); const int tid = tid_, wid = __builtin_amdgcn_readfirstlane(tid >> 6), lane = tid & 63, G = gridDim.x;
    unsigned char* ws = P.ws;
    const int j = layer >> 1;
    const bool gdn = (layer < 4) && !(layer & 1);
    LAS float* wab = (LAS float*)lds;
    if (gdn) {
        const float* Wp = P.in[12] + (size_t)j * 1024 * 4112 + 4096;
        for (int e = tid; e < 16384; e += 512) { const int k = e >> 4, c = e & 15; wab[c * 1024 + k] = Wp[(size_t)k * 4112 + c]; }
        __syncthreads();
    }
    const float* ada = (const float*)(ws + WS_ADA);
    float* X = P.out;
    const bf16_t* OUTB = (const bf16_t*)(ws + WS_PROJ);
    bf16_t* HB = (bf16_t*)(ws + WS_HBUF);
    float* AB = (float*)(ws + WS_AB);
    for (int r = blockIdx.x * 8 + wid; r < M; r += G * 8) {
        const int b = r < MP ? (r >> 13) : BP + ((r - MP) >> 4);
        const float* xs = (layer <= 1) ? (r < MP ? P.in[0] + (size_t)r * 1024 : P.in[1] + (size_t)(r - MP) * 1024) : X + (size_t)r * 1024;
        f32x4 x[4];
#pragma unroll
        for (int q = 0; q < 4; ++q) x[q] = *(const f32x4*)(xs + 4 * (lane + 64 * q));
        if (layer >= 1) {
            f32x4 o[4]; float ss = 0.f;
#pragma unroll
            for (int q = 0; q < 4; ++q) { const u32x2 ow = *(const u32x2*)(OUTB + (size_t)r * 1024 + 4 * (lane + 64 * q));
                o[q] = (f32x4){__uint_as_float(ow.x << 16), __uint_as_float(ow.x & 0xffff0000u), __uint_as_float(ow.y << 16), __uint_as_float(ow.y & 0xffff0000u)};
                ss += o[q][0] * o[q][0] + o[q][1] * o[q][1] + o[q][2] * o[q][2] + o[q][3] * o[q][3]; }
            ss = wave_sum(ss);
            const float rstd = __builtin_amdgcn_rsqf(ss * (1.f / 1024.f) + RMS_EPS);
            const float* gp = ada + ((size_t)(layer - 1) * NB + b) * 3072 + 2048;
            const float* np = P.in[9] + (layer - 1) * 1024;
#pragma unroll
            for (int q = 0; q < 4; ++q) {
                const int d = 4 * (lane + 64 * q);
                const f32x4 gt = *(const f32x4*)(gp + d), nw = *(const f32x4*)(np + d);
                x[q] = x[q] + gt * (o[q] * rstd * nw);
                *(f32x4*)(X + (size_t)r * 1024 + d) = x[q];
            }
        }
        if (layer < 4) {
            float ss = 0.f;
#pragma unroll
            for (int q = 0; q < 4; ++q) ss += x[q][0] * x[q][0] + x[q][1] * x[q][1] + x[q][2] * x[q][2] + x[q][3] * x[q][3];
            ss = wave_sum(ss);
            const float rstd = __builtin_amdgcn_rsqf(ss * (1.f / 1024.f) + RMS_EPS);
            const float* ap = ada + ((size_t)layer * NB + b) * 3072;
            const float* np = P.in[8] + layer * 1024;
            f32x4 hv[4];
#pragma unroll
            for (int q = 0; q < 4; ++q) {
                const int d = 4 * (lane + 64 * q);
                const f32x4 sh = *(const f32x4*)(ap + d), sc = *(const f32x4*)(ap + 1024 + d), nw = *(const f32x4*)(np + d);
                hv[q] = (x[q] * rstd * nw) * (1.f + sc) + sh;
                u32x2 w; w.x = pk2(hv[q][0], hv[q][1]); w.y = pk2(hv[q][2], hv[q][3]);
                *(u32x2*)(HB + (size_t)r * 1024 + d) = w;
            }
            if (gdn) {
                float mine = 0.f;
#pragma unroll
                for (int c = 0; c < 16; ++c) {
                    float a = 0.f;
#pragma unroll
                    for (int q = 0; q < 4; ++q) { const f32x4 w4 = *(const LAS f32x4*)(wab + c * 1024 + 4 * (lane + 64 * q)); a += hv[q][0] * w4[0] + hv[q][1] * w4[1] + hv[q][2] * w4[2] + hv[q][3] * w4[3]; }
                    a = row_sum16(a);
                    if ((lane & 15) == c) mine = a;
                }
                mine += __shfl_xor(mine, 16); mine += __shfl_xor(mine, 32);
                if (lane < 16) AB[(size_t)r * 16 + lane] = mine;
            }
        }
    }
}

DI void convert_cache(const Params& P, int j, int b0, int nb) {
    int tid_ = threadIdx.x; asm volatile("" : "+v"(tid_)); const int tid = tid_;
    unsigned char* ws = P.ws;
    const int bx = blockIdx.x - b0; const int G = nb;
    {
        const float* ck = P.in[6] + (size_t)j * 16 * PAST * 1024;
        const float* cv = P.in[7] + (size_t)j * 16 * PAST * 1024;
        bf16_t* KS = (bf16_t*)(ws + WS_KS); bf16_t* VS = (bf16_t*)(ws + WS_VS);
        const size_t nun = (size_t)16 * PAST * 128;
        for (size_t u = (size_t)bx * 512 + tid; u < 2 * nun; u += (size_t)G * 512) {
            const bool isv = u >= nun; const size_t uu = isv ? u - nun : u;
            const size_t b = uu / ((size_t)PAST * 128), rem = uu % ((size_t)PAST * 128);
            const size_t row = rem >> 7, c8 = rem & 127, hh = c8 >> 4, d8 = c8 & 15;
            const float* sp = (isv ? cv : ck) + uu * 8;
            const f32x4 a = *(const f32x4*)sp, c = *(const f32x4*)(sp + 4);
            u32x4 w; w.x = pk2(a[0], a[1]); w.y = pk2(a[2], a[3]); w.z = pk2(c[0], c[1]); w.w = pk2(c[2], c[3]);
            *(u32x4*)((isv ? VS : KS) + ((b * 8 + hh) * KSROWS + row) * 128 + d8 * 8) = w;
        }
        const size_t npad = (size_t)128 * 48 * 16;
        for (size_t u = (size_t)bx * 512 + tid; u < 2 * npad; u += (size_t)G * 512) {
            const bool isv = u >= npad; const size_t uu = isv ? u - npad : u;
            const size_t sq = uu / (48 * 16), rem = uu % (48 * 16);
            *(u32x4*)((isv ? VS : KS) + (sq * KSROWS + PAST + TS) * 128 + rem * 8) = (u32x4){0u, 0u, 0u, 0u};
        }
    }
}

DI void phase_g1(const Params& P, LAS unsigned char* lds, int layer) {
    int tid_ = threadIdx.x; asm volatile("" : "+v"(tid_)); const int tid = tid_, wid = __builtin_amdgcn_readfirstlane(tid >> 6), lane = tid & 63, G = gridDim.x;
    const int fr = lane & 15, fq = lane >> 4;
    unsigned char* ws = P.ws;
    const int j = layer >> 1;
    const bf16_t* proj = (const bf16_t*)(ws + WS_PROJ);
    const float* AB = (const float*)(ws + WS_AB);
    float* GL = (float*)(ws + WS_GL);
    const float* convw = P.in[13] + (size_t)j * 4 * 3072;
    const float* cconv = P.in[5] + (size_t)j * 16 * 3 * 3072;
    LAS unsigned char* Qs = lds;
    LAS unsigned char* Ks = lds + 17408;
    LAS unsigned char* VBt = lds + 34816;
    LAS unsigned char* KBt = lds + 53248;
    LAS float* A32 = (LAS float*)(lds + 71680);
    LAS unsigned char* Ts = lds + 88320;
    LAS unsigned char* QKs = lds + 97536;
    LAS float* Gs = (LAS float*)(lds + 105728);

    u32x4 rows[11];
#define G1_ROWLOAD(IT) do { const int _it = (IT); if (tid < 384 && _it < NITEM) { int _h, _c, _row0, _nv; bool _smp; \
            if (_it < NITEM_P) { const int _seq = _it >> 7; _h = _seq & 7; _c = _it & 127; _row0 = (_seq >> 3) * TP + 64 * _c; _nv = 64; _smp = false; } \
            else { const int _s = _it - NITEM_P; _h = _s & 7; _c = 0; _row0 = MP + (_s >> 3) * TS; _nv = TS; _smp = true; } \
            int _t = tid; asm volatile("" : "+v"(_t)); const int _l16 = _t & 15, _grp = _t >> 4, _part = _grp >> 3, _rb = _grp & 7; \
            const int _ch = _part * 1024 + _h * 128 + 8 * _l16; \
            _Pragma("unroll") for (int _k = 0; _k < 11; ++_k) { const int _lr = 8 * _rb - 3 + _k; \
                const bool _up = (_lr >= 0 && _lr < _nv) || (_lr < 0 && !_smp && _c > 0); const int _lrc = _up ? _lr : 0; \
                rows[_k] = *(const u32x4*)(proj + (size_t)(_row0 + _lrc) * NPROJ + _ch); } } } while (0)
    G1_ROWLOAD((int)blockIdx.x);
    for (int item = blockIdx.x; item < NITEM; item += G) {
        int b, h, c, row0, nvalid; bool sample;
        if (item < NITEM_P) { const int seq = item >> 7; b = seq >> 3; h = seq & 7; c = item & 127; row0 = b * TP + 64 * c; nvalid = 64; sample = false; }
        else { const int s = item - NITEM_P; b = s >> 3; h = s & 7; c = 0; row0 = MP + b * TS; nvalid = TS; sample = true; }
        unsigned char* ib = ws + WS_R1 + (size_t)item * ITEM_BYTES;
        float val[8][8];
        float rn[8];
        int tido = tid; asm volatile("" : "+v"(tido));
        const int l16 = tido & 15, grp = tido >> 4, part = grp >> 3, rb = grp & 7;
        const int lane = tido & 63, fr = lane & 15, fq = lane >> 4;
        if (tid < 384) {
            const int ch = part * 1024 + h * 128 + 8 * l16;
            float wv[4][8];
#pragma unroll
            for (int t = 0; t < 4; ++t) {
                const f32x4 a = *(const f32x4*)(convw + t * 3072 + ch), bb = *(const f32x4*)(convw + t * 3072 + ch + 4);
                wv[t][0] = a[0]; wv[t][1] = a[1]; wv[t][2] = a[2]; wv[t][3] = a[3]; wv[t][4] = bb[0]; wv[t][5] = bb[1]; wv[t][6] = bb[2]; wv[t][7] = bb[3];
            }
            float win[4][8];
#pragma unroll
            for (int t = 0; t < 4; ++t)
#pragma unroll
                for (int e = 0; e < 8; ++e) win[t][e] = 0.f;
#pragma unroll
            for (int k = 0; k < 11; ++k) {
                const int lr = 8 * rb - 3 + k;
                float in8[8];
                {
                    const bool use_proj = (lr >= 0 && lr < nvalid) || (lr < 0 && !sample && c > 0);
                    unpack8(rows[k], in8);
                    if (!use_proj) {
#pragma unroll
                        for (int e = 0; e < 8; ++e) in8[e] = 0.f;
                    }
                }
                if (k < 3) {
                    if (sample && lr < 0) {
                        const float* sp = cconv + (size_t)(b * 3 + (3 + lr)) * 3072 + ch;
                        const f32x4 a = *(const f32x4*)sp, bb = *(const f32x4*)(sp + 4);
                        in8[0] = a[0]; in8[1] = a[1]; in8[2] = a[2]; in8[3] = a[3]; in8[4] = bb[0]; in8[5] = bb[1]; in8[6] = bb[2]; in8[7] = bb[3];
                    }
                }
#pragma unroll
                for (int e = 0; e < 8; ++e) { win[0][e] = win[1][e]; win[1][e] = win[2][e]; win[2][e] = win[3][e]; win[3][e] = in8[e]; }
                if (k >= 3) {
                    const bool rv = (lr < nvalid);
                    float ss = 0.f;
#pragma unroll
                    for (int e = 0; e < 8; ++e) {
                        const float y = win[0][e] * wv[0][e] + win[1][e] * wv[1][e] + win[2][e] * wv[2][e] + win[3][e] * wv[3][e];
                        const float s = rv ? siluf(y) : 0.f;
                        val[k - 3][e] = s; ss += s * s;
                    }
                    ss = row_sum16(ss);
                    rn[k - 3] = __builtin_amdgcn_rsqf(ss + 1e-6f);
                }
            }
        } else if (wid == 7) {
            const int r = row0 + (lane < nvalid ? lane : 0);
            const bool valid = lane < nvalid;
            const float a = AB[(size_t)r * 16 + h], bb = AB[(size_t)r * 16 + 8 + h];
            const float xa = a + P.in[15][j * 8 + h];
            const float ey = __expf(-fabsf(xa));
            const float lp = (ey < 0.01f) ? ey * (1.f - ey * (0.5f - ey * 0.33333334f)) : __logf(1.f + ey);
            const float sp = fmaxf(xa, 0.f) + lp;
            float g = valid ? -__expf(P.in[14][j * 8 + h]) * sp : 0.f;
            const float beta = valid ? __builtin_amdgcn_rcpf(1.f + __expf(-bb)) : 0.f;
#pragma unroll
            for (int o = 1; o < 64; o <<= 1) { const float t = __shfl_up(g, o); if (lane >= o) g += t; }
            const float glast = readlane_f(g, 63);
            Gs[lane] = g; Gs[64 + lane] = beta; Gs[128 + lane] = __expf(g); Gs[192 + lane] = __expf(glast - g);
            if (lane == 0) GL[item] = __expf(glast);
        }
        __syncthreads();
        G1_ROWLOAD(item + G);
        if (tid < 384) {
#pragma unroll
            for (int rr = 0; rr < 8; ++rr) {
                const int row = 8 * rb + rr;
                const float beta = Gs[64 + row], eG = Gs[128 + row];
                if (part == 0) {
                    const float sc = rn[rr] * 0.08838834764831845f;
                    float q[8];
#pragma unroll
                    for (int e = 0; e < 8; ++e) q[e] = val[rr][e] * sc;
                    u32x4 w; w.x = pk2(q[0], q[1]); w.y = pk2(q[2], q[3]); w.z = pk2(q[4], q[5]); w.w = pk2(q[6], q[7]);
                    *(LAS u32x4*)(Qs + row * 272 + l16 * 16) = w;
                    bf16_t* qg = (bf16_t*)(ib + 49152) + row * 128;
                    u32x2 g0, g1; g0.x = pk2(q[0] * eG, q[1] * eG); g0.y = pk2(q[2] * eG, q[3] * eG); g1.x = pk2(q[4] * eG, q[5] * eG); g1.y = pk2(q[6] * eG, q[7] * eG);
                    *(u32x2*)(qg + ppos(8 * l16)) = g0; *(u32x2*)(qg + ppos(8 * l16 + 4)) = g1;
                    val[rr][0] = 0.f;
                } else if (part == 1) {
#pragma unroll
                    for (int e = 0; e < 8; ++e) val[rr][e] *= rn[rr];
                    u32x4 w; w.x = pk2(val[rr][0], val[rr][1]); w.y = pk2(val[rr][2], val[rr][3]); w.z = pk2(val[rr][4], val[rr][5]); w.w = pk2(val[rr][6], val[rr][7]);
                    *(LAS u32x4*)(Ks + row * 272 + l16 * 16) = w;
                }
            }
            if (part >= 1) {
                float bsc[8], ksc[8];
#pragma unroll
                for (int rr = 0; rr < 8; ++rr) { const int row = 8 * rb + rr; const float beta = Gs[64 + row]; bsc[rr] = (part == 1) ? beta * Gs[128 + row] : beta; ksc[rr] = Gs[192 + row]; }
                LAS unsigned char* Tt = (part == 1) ? KBt : VBt;
#pragma unroll
                for (int e = 0; e < 8; ++e) {
                    const int dch = 8 * l16 + e;
                    u32x4 w; w.x = pk2(val[0][e] * bsc[0], val[1][e] * bsc[1]); w.y = pk2(val[2][e] * bsc[2], val[3][e] * bsc[3]);
                    w.z = pk2(val[4][e] * bsc[4], val[5][e] * bsc[5]); w.w = pk2(val[6][e] * bsc[6], val[7][e] * bsc[7]);
                    *(LAS u32x4*)(Tt + dch * 144 + rb * 16) = w;
                    if (part == 1) {
                        bf16_t* kd = (bf16_t*)(ib + 65536) + dch * 64;
                        u32x2 k0, k1; k0.x = pk2(val[0][e] * ksc[0], val[1][e] * ksc[1]); k0.y = pk2(val[2][e] * ksc[2], val[3][e] * ksc[3]);
                        k1.x = pk2(val[4][e] * ksc[4], val[5][e] * ksc[5]); k1.y = pk2(val[6][e] * ksc[6], val[7][e] * ksc[7]);
                        *(u32x2*)(kd + ppos(8 * rb)) = k0; *(u32x2*)(kd + ppos(8 * rb + 4)) = k1;
                    }
                }
            }
        }
        __syncthreads();
        {
            const int mt = wid & 3; const bool isqk = wid >= 4;
            LAS unsigned char* As = isqk ? Qs : Ks;
            f32x4 acc[4];
#pragma unroll
            for (int nt = 0; nt < 4; ++nt) acc[nt] = (f32x4){0.f, 0.f, 0.f, 0.f};
#pragma unroll
            for (int ks = 0; ks < 4; ++ks) {
                const bf16x8 a = *(const LAS bf16x8*)(As + (16 * mt + fr) * 272 + (32 * ks + 8 * fq) * 2);
#pragma unroll
                for (int nt = 0; nt < 4; ++nt) {
                    const bf16x8 bfr = *(const LAS bf16x8*)(Ks + (16 * nt + fr) * 272 + (32 * ks + 8 * fq) * 2);
                    acc[nt] = MFMA16(a, bfr, acc[nt]);
                }
            }
#pragma unroll
            for (int nt = 0; nt < 4; ++nt) {
                const int cp = 16 * nt + fr; const float Gc2 = Gs[cp];
#pragma unroll
                for (int i = 0; i < 4; ++i) {
                    const int cr = 16 * mt + 4 * fq + i;
                    const float dec = __expf(Gs[cr] - Gc2);
                    if (!isqk) A32[cr * 65 + cp] = (cr > cp) ? Gs[64 + cr] * acc[nt][i] * dec : 0.f;
                    else *(LAS bf16_t*)(QKs + (cr * 64 + ppos(cp)) * 2) = f2bf((cr >= cp) ? acc[nt][i] * dec : 0.f);
                }
            }
        }
        __syncthreads();
        {
            float a[64];
#pragma unroll
            for (int jj = 0; jj < 64; ++jj) a[jj] = A32[lane * 65 + jj];
            float x[8];
#pragma unroll
            for (int cc = 0; cc < 8; ++cc) x[cc] = (lane == 8 * wid + cc) ? 1.f : 0.f;
#pragma unroll
            for (int jj = 0; jj < 64; ++jj) {
                if (jj >= 8 * wid) {
#pragma unroll
                    for (int cc = 0; cc < 8; ++cc) { const float xj = readlane_f(x[cc], jj); x[cc] -= a[jj] * xj; }
                }
            }
            u32x4 w; w.x = pk2(x[0], x[1]); w.y = pk2(x[2], x[3]); w.z = pk2(x[4], x[5]); w.w = pk2(x[6], x[7]);
            *(LAS u32x4*)(Ts + lane * 144 + wid * 16) = w;
            *(u32x4*)(ib + 81920 + tid * 16) = *(const LAS u32x4*)(QKs + tid * 16);
        }
        __syncthreads();
        {
            const bool isw = wid >= 4; const int n0 = 32 * (wid & 3);
            LAS unsigned char* Bs = isw ? KBt : VBt;
            f32x4 acc[4][2];
#pragma unroll
            for (int mt = 0; mt < 4; ++mt) { acc[mt][0] = (f32x4){0.f, 0.f, 0.f, 0.f}; acc[mt][1] = (f32x4){0.f, 0.f, 0.f, 0.f}; }
#pragma unroll
            for (int ks = 0; ks < 2; ++ks) {
                bf16x8 bfr[2];
#pragma unroll
                for (int nn = 0; nn < 2; ++nn) bfr[nn] = *(const LAS bf16x8*)(Bs + (n0 + 16 * nn + fr) * 144 + (32 * ks + 8 * fq) * 2);
#pragma unroll
                for (int mt = 0; mt < 4; ++mt) {
                    const bf16x8 a = *(const LAS bf16x8*)(Ts + (16 * mt + fr) * 144 + (32 * ks + 8 * fq) * 2);
                    acc[mt][0] = MFMA16(a, bfr[0], acc[mt][0]); acc[mt][1] = MFMA16(a, bfr[1], acc[mt][1]);
                }
            }
            if (!isw) {
                float* U = (float*)ib;
#pragma unroll
                for (int mt = 0; mt < 4; ++mt)
#pragma unroll
                    for (int nn = 0; nn < 2; ++nn) *(f32x4*)(U + (n0 + 16 * nn + fr) * 64 + 16 * mt + 4 * fq) = acc[mt][nn];
            } else {
#pragma unroll
                for (int mt = 0; mt < 4; ++mt)
#pragma unroll
                    for (int nn = 0; nn < 2; ++nn)
#pragma unroll
                        for (int i = 0; i < 4; ++i) *(LAS bf16_t*)(Qs + ((16 * mt + 4 * fq + i) * 128 + ppos(n0 + 16 * nn + fr)) * 2) = f2bf(acc[mt][nn][i]);
            }
        }
        __syncthreads();
        {
            *(u32x4*)(ib + 32768 + tid * 16) = *(const LAS u32x4*)(Qs + tid * 16);
            *(u32x4*)(ib + 32768 + 8192 + tid * 16) = *(const LAS u32x4*)(Qs + 8192 + tid * 16);
        }
        __syncthreads();
    }
}

DI void phase_scan(const Params& P, LAS unsigned char* lds, int layer) {
    int tid_ = threadIdx.x; asm volatile("" : "+v"(tid_)); const int tid = tid_, wid = __builtin_amdgcn_readfirstlane(tid >> 6), lane = tid & 63, G = gridDim.x;
    const int fr = lane & 15, fq = lane >> 4;
    unsigned char* ws = P.ws;
    const int j = layer >> 1;
    const bf16_t* proj = (const bf16_t*)(ws + WS_PROJ);
    const float* GL = (const float*)(ws + WS_GL);
    bf16_t* ORAW = (bf16_t*)(ws + WS_ORAWB);
    constexpr int BUFB = 57344;
    LAS float* red = (LAS float*)(lds + 2 * BUFB);

    if (G >= 192 && (int)blockIdx.x >= 160) { convert_cache(P, j, 160, G - 160); return; }
    for (int seq = blockIdx.x; seq < 160; seq += G) {
        int b, h, nch, item0, row0, nvalid; float* stout;
        f32x4 st[8];
        const int dvc = 16 * wid + fr;
        if (seq < 32) {
            b = seq >> 3; h = seq & 7; nch = 128; item0 = seq * 128; row0 = b * TP; nvalid = 64;
            stout = P.out + OFF_STP + ((size_t)(j * 4 + b) * 8 + h) * 16384;
#pragma unroll
            for (int mt = 0; mt < 8; ++mt) st[mt] = (f32x4){0.f, 0.f, 0.f, 0.f};
        } else {
            const int s = seq - 32; b = s >> 3; h = s & 7; nch = 1; item0 = NITEM_P + s; row0 = MP + b * TS; nvalid = TS;
            stout = P.out + OFF_STS + ((size_t)(j * 16 + b) * 8 + h) * 16384;
            const float* s0 = P.in[4] + ((size_t)(j * 16 + b) * 8 + h) * 16384;
            const unsigned s0o = (unsigned)(4 * fq * 128 + dvc);
#pragma unroll
            for (int mt = 0; mt < 8; ++mt)
#pragma unroll
                for (int i = 0; i < 4; ++i) st[mt][i] = s0[(unsigned)((16 * mt + i) * 128) + s0o];
        }
        const float onw = P.in[16][j * 128 + dvc];
        f32x4 un[4];
#define SCAN_G2L(itm, bufi, LN) do { const unsigned char* _ib = ws + WS_R1 + (size_t)(itm) * ITEM_BYTES + 32768; \
            _Pragma("unroll") for (int _p = 0; _p < 7; ++_p) { const int _L = (wid + 8 * _p) * 1024 + (LN) * 16; unsigned _src; \
                if (_p < 4) { const int _row = _L >> 8, _ch = (_L >> 4) & 15; _src = (_L & ~255) + ((_ch ^ (_row & 15)) << 4); } \
                else { const int _a = _L - 32768, _row = _a >> 7, _ch = (_a >> 4) & 7; _src = 32768 + (_a & ~127) + ((_ch ^ ((_row >> 1) & 7)) << 4); } \
                g2l16(_ib + _src, lds_u32(lds + (bufi) * BUFB + (wid + 8 * _p) * 1024)); } } while (0)
#define SCAN_LOADU(itm) do { const float* _u = (const float*)(ws + WS_R1 + (size_t)(itm) * ITEM_BYTES); const unsigned _uo = (unsigned)((16 * wid + fr) * 64 + 4 * fq); \
            _Pragma("unroll") for (int _m = 0; _m < 4; ++_m) un[_m] = *(const f32x4*)(_u + (unsigned)(16 * _m) + _uo); } while (0)
        __syncthreads();
        SCAN_G2L(item0, 0, lane);
        SCAN_LOADU(item0);
        float gln = GL[item0];
        asm volatile("s_waitcnt vmcnt(0)" ::: "memory");
        __syncthreads();
        for (int c = 0; c < nch; ++c) {
            int frq = lane; asm volatile("" : "+v"(frq));
            const int fr = frq & 15, fq = frq >> 4;
            LAS unsigned char* bb = lds + (c & 1) * BUFB;
            const float gl = gln;
            f32x4 u[4];
#pragma unroll
            for (int mt = 0; mt < 4; ++mt) u[mt] = un[mt];
            if (c + 1 < nch) { gln = GL[item0 + c + 1]; SCAN_G2L(item0 + c + 1, (c + 1) & 1, frq); SCAN_LOADU(item0 + c + 1); }
            const int x16 = fr << 4, x8 = ((fr >> 1) & 7) << 4;
            bf16x8 sf[4];
#pragma unroll
            for (int ks = 0; ks < 4; ++ks) {
                u32x4 w; w.x = pk2(-st[2 * ks][0], -st[2 * ks][1]); w.y = pk2(-st[2 * ks][2], -st[2 * ks][3]); w.z = pk2(-st[2 * ks + 1][0], -st[2 * ks + 1][1]); w.w = pk2(-st[2 * ks + 1][2], -st[2 * ks + 1][3]);
                sf[ks] = __builtin_bit_cast(bf16x8, w);
            }
            bf16x8 fa[4], fb[4];
#define SC_LD256(dst, base, mt) do { _Pragma("unroll") for (int _k = 0; _k < 4; ++_k) \
                dst[_k] = *(const LAS bf16x8*)(bb + (base) + (16 * (mt) + fr) * 256 + ((((4 * _k + fq) << 4)) ^ x16)); } while (0)
#define SC_LD128(dst, base, mtlo) do { _Pragma("unroll") for (int _m = 0; _m < 2; ++_m) _Pragma("unroll") for (int _k = 0; _k < 2; ++_k) \
                dst[_m * 2 + _k] = *(const LAS bf16x8*)(bb + (base) + (16 * ((mtlo) + _m) + fr) * 128 + ((((4 * _k + fq) << 4)) ^ x8)); } while (0)
#define SC_SB __builtin_amdgcn_sched_barrier(0)
#define SC_MU(f, mt) do { _Pragma("unroll") for (int _k = 0; _k < 4; ++_k) u[mt] = MFMA16(f[_k], sf[_k], u[mt]); } while (0)
#define SC_MO(f, mt) do { _Pragma("unroll") for (int _k = 0; _k < 4; ++_k) o[mt] = MFMA16(f[_k], sf[_k], o[mt]); } while (0)
#define SC_MQK(f, mtlo) do { _Pragma("unroll") for (int _m = 0; _m < 2; ++_m) _Pragma("unroll") for (int _k = 0; _k < 2; ++_k) o[(mtlo) + _m] = MFMA16(f[_m * 2 + _k], uf[_k], o[(mtlo) + _m]); } while (0)
#define SC_MKD(f, mtlo) do { _Pragma("unroll") for (int _m = 0; _m < 2; ++_m) { st[(mtlo) + _m] = st[(mtlo) + _m] * gl; _Pragma("unroll") for (int _k = 0; _k < 2; ++_k) st[(mtlo) + _m] = MFMA16(f[_m * 2 + _k], uf[_k], st[(mtlo) + _m]); } } while (0)
            f32x4 o[4];
#pragma unroll
            for (int mt = 0; mt < 4; ++mt) o[mt] = (f32x4){0.f, 0.f, 0.f, 0.f};
            SC_LD256(fa, 0, 0); SC_LD256(fb, 0, 1); SC_SB;
            SC_MU(fa, 0); SC_LD256(fa, 0, 2); SC_SB;
            SC_MU(fb, 1); SC_LD256(fb, 0, 3); SC_SB;
            SC_MU(fa, 2); SC_LD256(fa, 16384, 0); SC_SB;
            SC_MU(fb, 3); SC_LD256(fb, 16384, 1); SC_SB;
#pragma unroll
            for (int ks = 0; ks < 4; ++ks) sf[ks] = sf[ks] ^ (short)0x8000;
            SC_MO(fa, 0); SC_LD256(fa, 16384, 2); SC_SB;
            SC_MO(fb, 1); SC_LD256(fb, 16384, 3); SC_SB;
            SC_MO(fa, 2); SC_LD128(fa, 49152, 0); SC_SB;
            SC_MO(fb, 3); SC_LD128(fb, 49152, 2); SC_SB;
            bf16x8 uf[2];
#pragma unroll
            for (int k2 = 0; k2 < 2; ++k2) {
                u32x4 w; w.x = pk2(u[2 * k2][0], u[2 * k2][1]); w.y = pk2(u[2 * k2][2], u[2 * k2][3]); w.z = pk2(u[2 * k2 + 1][0], u[2 * k2 + 1][1]); w.w = pk2(u[2 * k2 + 1][2], u[2 * k2 + 1][3]);
                uf[k2] = __builtin_bit_cast(bf16x8, w);
            }
            SC_MQK(fa, 0); SC_LD128(fa, 32768, 0); SC_SB;
            SC_MQK(fb, 2); SC_LD128(fb, 32768, 2); SC_SB;
            SC_MKD(fa, 0); SC_LD128(fa, 32768, 4); SC_SB;
            SC_MKD(fb, 2); SC_LD128(fb, 32768, 6); SC_SB;
            SC_MKD(fa, 4); SC_SB;
            SC_MKD(fb, 6);
#undef SC_MU
#undef SC_MO
#undef SC_MQK
#undef SC_MKD
#undef SC_LD256
#undef SC_LD128
#undef SC_SB
            {
                bf16_t* obb = ORAW + (size_t)(row0 + 64 * c) * 1024 + h * 128;
                const unsigned oo = (unsigned)(4 * fq * 1024 + 16 * wid + fr);
#pragma unroll
                for (int mt = 0; mt < 4; ++mt)
#pragma unroll
                    for (int i = 0; i < 4; ++i) {
                        const int lr = 16 * mt + 4 * fq + i;
                        const bf16_t ob = f2bf(o[mt][i]);
                        if (lr < nvalid) obb[(unsigned)((16 * mt + i) * 1024) + oo] = ob;
                    }
            }
            asm volatile("s_waitcnt vmcnt(0)" ::: "memory");
            __syncthreads();
        }
        {
            int lz = lane; asm volatile("" : "+v"(lz));
            const unsigned so = (unsigned)(4 * (lz >> 4) * 128 + 16 * wid + (lz & 15));
#pragma unroll
            for (int mt = 0; mt < 8; ++mt)
#pragma unroll
                for (int i = 0; i < 4; ++i) stout[(unsigned)((16 * mt + i) * 128) + so] = st[mt][i];
        }
#undef SCAN_G2L
#undef SCAN_LOADU
    }
    if (G < 192) convert_cache(P, j, 0, G);
}

DI void phase_gnorm(const Params& P, int layer) {
    int tid_ = threadIdx.x; asm volatile("" : "+v"(tid_)); const int tid = tid_, wid = __builtin_amdgcn_readfirstlane(tid >> 6), lane = tid & 63, G = gridDim.x;
    unsigned char* ws = P.ws;
    const int j = layer >> 1;
    const bf16_t* ORAW = (const bf16_t*)(ws + WS_ORAWB);
    const bf16_t* proj = (const bf16_t*)(ws + WS_PROJ);
    bf16_t* OB = (bf16_t*)(ws + WS_HBUF);
    float onw[16];
#pragma unroll
    for (int e = 0; e < 16; ++e) onw[e] = P.in[16][j * 128 + ((16 * lane + e) & 127)];
    for (int r = blockIdx.x * 8 + wid; r < M; r += G * 8) {
        const u32x4 o0 = *(const u32x4*)(ORAW + (size_t)r * 1024 + 16 * lane), o1 = *(const u32x4*)(ORAW + (size_t)r * 1024 + 16 * lane + 8);
        const u32x4 z0 = *(const u32x4*)(proj + (size_t)r * NPROJ + 3072 + 16 * lane), z1 = *(const u32x4*)(proj + (size_t)r * NPROJ + 3072 + 16 * lane + 8);
        float ov[16], zv[16];
        { float t8[8]; unpack8(o0, t8);
#pragma unroll
          for (int e = 0; e < 8; ++e) ov[e] = t8[e];
          unpack8(o1, t8);
#pragma unroll
          for (int e = 0; e < 8; ++e) ov[8 + e] = t8[e];
          unpack8(z0, t8);
#pragma unroll
          for (int e = 0; e < 8; ++e) zv[e] = t8[e];
          unpack8(z1, t8);
#pragma unroll
          for (int e = 0; e < 8; ++e) zv[8 + e] = t8[e]; }
        float ss = 0.f;
#pragma unroll
        for (int e = 0; e < 16; ++e) ss += ov[e] * ov[e];
        ss += __shfl_xor(ss, 1); ss += __shfl_xor(ss, 2); ss += __shfl_xor(ss, 4);
        const float rstd = __builtin_amdgcn_rsqf(ss * (1.f / 128.f) + RMS_EPS);
        float y[16];
#pragma unroll
        for (int e = 0; e < 16; ++e) y[e] = ov[e] * rstd * onw[e] * siluf(zv[e]);
        u32x4 w0, w1;
        w0.x = pk2(y[0], y[1]); w0.y = pk2(y[2], y[3]); w0.z = pk2(y[4], y[5]); w0.w = pk2(y[6], y[7]);
        w1.x = pk2(y[8], y[9]); w1.y = pk2(y[10], y[11]); w1.z = pk2(y[12], y[13]); w1.w = pk2(y[14], y[15]);
        *(u32x4*)(OB + (size_t)r * 1024 + 16 * lane) = w0; *(u32x4*)(OB + (size_t)r * 1024 + 16 * lane + 8) = w1;
    }
}

DI void att_s(LAS unsigned char* Ka, int t, const bf16x8 (&qf)[4], f32x16& s0, f32x16& s1) {
#pragma unroll
    for (int i = 0; i < 16; ++i) { s0[i] = 0.f; s1[i] = 0.f; }
    bf16x8 kf[8];
#pragma unroll
    for (int s = 0; s < 4; ++s) { kf[2 * s] = *(const LAS bf16x8*)(Ka + (t ^ (s << 5))); kf[2 * s + 1] = *(const LAS bf16x8*)(Ka + 8192 + (t ^ (s << 5))); }
#pragma unroll
    for (int s = 0; s < 4; ++s) { s0 = MFMA32(kf[2 * s], qf[s], s0); s1 = MFMA32(kf[2 * s + 1], qf[s], s1); }
}
template <bool MASK>
DI float att_softmax(f32x16& s0, f32x16& s1, float& m, float& l, bf16x8 (&pf)[2][2], int h2, int nvk) {
    if (MASK) {
#pragma unroll
        for (int i = 0; i < 16; ++i) {
            const int key = (i & 3) + 8 * (i >> 2) + 4 * h2;
            s0[i] = (key < nvk) ? s0[i] : -INFINITY;
            s1[i] = (32 + key < nvk) ? s1[i] : -INFINITY;
        }
    }
    float mx = s0[0];
#pragma unroll
    for (int i = 1; i < 16; ++i) mx = fmaxf(mx, s0[i]);
#pragma unroll
    for (int i = 0; i < 16; ++i) mx = fmaxf(mx, s1[i]);
    mx = fmaxf(mx, __shfl_xor(mx, 32));
    const float mn = fmaxf(m, mx);
    const float alpha = __builtin_amdgcn_exp2f(m - mn);
    m = mn;
    float ps = 0.f;
#pragma unroll
    for (int i = 0; i < 16; ++i) { s0[i] = __builtin_amdgcn_exp2f(s0[i] - mn); s1[i] = __builtin_amdgcn_exp2f(s1[i] - mn); ps += s0[i] + s1[i]; }
    l = l * alpha + ps;
    u32x4 w;
    w.x = pk2(s0[0], s0[1]); w.y = pk2(s0[2], s0[3]); w.z = pk2(s0[4], s0[5]); w.w = pk2(s0[6], s0[7]); pf[0][0] = __builtin_bit_cast(bf16x8, w);
    w.x = pk2(s0[8], s0[9]); w.y = pk2(s0[10], s0[11]); w.z = pk2(s0[12], s0[13]); w.w = pk2(s0[14], s0[15]); pf[0][1] = __builtin_bit_cast(bf16x8, w);
    w.x = pk2(s1[0], s1[1]); w.y = pk2(s1[2], s1[3]); w.z = pk2(s1[4], s1[5]); w.w = pk2(s1[6], s1[7]); pf[1][0] = __builtin_bit_cast(bf16x8, w);
    w.x = pk2(s1[8], s1[9]); w.y = pk2(s1[10], s1[11]); w.z = pk2(s1[12], s1[13]); w.w = pk2(s1[14], s1[15]); pf[1][1] = __builtin_bit_cast(bf16x8, w);
    return alpha;
}
DI void att_pv(LAS unsigned char* Va, int q4, f32x16 (&O)[4], const bf16x8 (&pf)[2][2]) {
    s16x4 lo[16], hi[16];
#define PV_LD(i) do { LAS unsigned char* _vp = Va + ((((i) >> 2) ^ q4) << 6) + (32 * (((i) >> 1) & 1) + 16 * ((i) & 1)) * 256; \
        lo[i] = __builtin_amdgcn_ds_read_tr16_b64_v4i16((LAS s16x4*)_vp); hi[i] = __builtin_amdgcn_ds_read_tr16_b64_v4i16((LAS s16x4*)(_vp + 8 * 256)); } while (0)
    PV_LD(0); PV_LD(1); PV_LD(2);
#pragma unroll
    for (int i = 0; i < 16; ++i) {
        if (i + 3 < 16) PV_LD(i + 3);
        const bf16x8 vf = __builtin_shufflevector(lo[i], hi[i], 0, 1, 2, 3, 4, 5, 6, 7);
        O[i >> 2] = MFMA32(vf, pf[(i >> 1) & 1][i & 1], O[i >> 2]);
    }
#undef PV_LD
}

DI void phase_attn(const Params& P, LAS unsigned char* lds, int layer) {
    int tid_ = threadIdx.x; asm volatile("" : "+v"(tid_)); const int tid = tid_, wid = __builtin_amdgcn_readfirstlane(tid >> 6), lane = tid & 63, G = gridDim.x;
    unsigned char* ws = P.ws;
    const int j = layer >> 1;
    const int comp = wid >> 2, rg = wid & 3, r32 = lane & 31, h2 = lane >> 5;
    const bf16_t* proj = (const bf16_t*)(ws + WS_PROJ);
    bf16_t* OB = (bf16_t*)(ws + WS_HBUF);
    const float lam_init = 0.8f - 0.6f * expf(-0.3f * (float)layer);
    float lam;
    {
        float d1 = 0.f, d2 = 0.f;
        for (int i = 0; i < 64; ++i) { d1 += P.in[19][j * 64 + i] * P.in[20][j * 64 + i]; d2 += P.in[21][j * 64 + i] * P.in[22][j * 64 + i]; }
        lam = expf(d1) - expf(d2) + lam_init;
    }
    const float* subln = P.in[23] + j * 128;
    constexpr int TB = 32768;
    const int vb = (G % 8 == 0) ? (blockIdx.x % 8) * (G / 8) + blockIdx.x / 8 : blockIdx.x;
    const int nrounds = (G == 256) ? 9 : (2176 + G - 1) / G;
#define ATT_WAITV(n) asm volatile("s_waitcnt vmcnt(" #n ")" ::: "memory")
#define ATT_BAR() do { asm volatile("" ::: "memory"); __builtin_amdgcn_s_barrier(); asm volatile("" ::: "memory"); } while (0)
    for (int k = 0; k < nrounds; ++k) {
        int id;
        if (G == 256) {
            if (k < 8) { const int xcd = vb >> 5, idx = vb & 31; const int seq = xcd * 4 + (k >> 1); const int qt = (k & 1) ? idx : (63 - idx); id = seq * 64 + qt; }
            else { if (vb >= 128) break; id = 2048 + vb; }
        } else { id = vb + k * G; if (id >= 2176) break; }
        int h, qrow0, nt_all, nt_mine, last_valid; const int kvstride = 128; const bf16_t* Kp; const bf16_t* Vp; bool sample;
        if (id < 2048) {
            const int seq = id >> 6, qt = id & 63, b = seq >> 3; h = seq & 7; sample = false;
            qrow0 = b * TP + 128 * qt + 32 * rg; nt_all = 2 * qt + 2; nt_mine = (rg < 2) ? 2 * qt + 1 : 2 * qt + 2; last_valid = 64 * nt_mine;
            Kp = (const bf16_t*)(ws + WS_KH) + (size_t)seq * TP * 128; Vp = (const bf16_t*)(ws + WS_VH) + (size_t)seq * TP * 128;
        } else {
            const int s = id - 2048, b = s >> 3; h = s & 7; sample = true;
            qrow0 = MP + b * TS; nt_all = 34; nt_mine = (rg == 0) ? 34 : 0; last_valid = PAST + TS;
            Kp = (const bf16_t*)(ws + WS_KS) + (size_t)s * KSROWS * 128; Vp = (const bf16_t*)(ws + WS_VS) + (size_t)s * KSROWS * 128;
        }
        bf16x8 qf[4];
        {
            const int qr = qrow0 + (sample ? (r32 & 15) : r32);
            const bf16_t* qp = proj + (size_t)qr * NPROJ + h * 128 + comp * 64 + 8 * h2;
#pragma unroll
            for (int s = 0; s < 4; ++s) qf[s] = *(const bf16x8*)(qp + 16 * s);
        }
        f32x16 O[4];
#pragma unroll
        for (int et = 0; et < 4; ++et)
#pragma unroll
            for (int i = 0; i < 16; ++i) O[et][i] = 0.f;
        float m = -INFINITY, l = 0.f;
        bf16x8 pf[2][2];
#pragma unroll
        for (int a = 0; a < 2; ++a)
#pragma unroll
            for (int c2 = 0; c2 < 2; ++c2) pf[a][c2] = (bf16x8){0, 0, 0, 0, 0, 0, 0, 0};
        f32x16 sA0, sA1, sB0, sB1;
        const bf16_t* gsrc;
        {
            const int rowl = lane >> 4, c = lane & 15;
            const int row0 = 16 * (wid & 3) + rowl;
            const int lc = (wid < 4) ? (c ^ (row0 & 15)) : (c ^ ((row0 & 3) << 2));
            gsrc = ((wid < 4) ? Kp : Vp) + (size_t)row0 * kvstride + lc * 8;
        }
#define ATT_G2L(kt, bufi) do { _Pragma("unroll") for (int _i = 0; _i < 4; ++_i) { \
            const bf16_t* _s = gsrc + (size_t)(64 * (kt) + 4 * _i) * kvstride; \
            if (wid < 4) _s += (((lane & 15) ^ ((16 * (wid & 3) + 4 * _i + (lane >> 4)) & 15)) - ((lane & 15) ^ ((16 * (wid & 3) + (lane >> 4)) & 15))) * 8; \
            g2l16(_s, lds_u32(lds + (bufi) * TB + (4 * wid + _i) * 1024)); } } while (0)
        asm volatile("" :: "v"(qf[0]), "v"(qf[1]), "v"(qf[2]), "v"(qf[3]));
        __syncthreads();
        ATT_G2L(0, 0);
        if (nt_all > 1) { ATT_G2L(1, 1); ATT_WAITV(4); } else { ATT_WAITV(0); }
        ATT_BAR();
        {
            const int koff = r32 * 256, t = ((comp * 8 + h2) ^ (r32 & 15)) << 4;
            att_s(lds + koff, t, qf, sA0, sA1);
        }
#define ATT_ITER(KT, sC0, sC1, sN0, sN1, EDGE) do { \
            const int kt = (KT); \
            int lo_ = lane; asm volatile("" : "+v"(lo_)); \
            const int r32_ = lo_ & 31, h2_ = lo_ >> 5, q4_ = (lo_ & 15) >> 2, p4_ = lo_ & 3, blk_ = (lo_ >> 4) & 1; \
            const int koff_ = r32_ * 256, t_ = ((comp * 8 + h2_) ^ (r32_ & 15)) << 4; \
            const int voff_ = (4 * h2_ + q4_) * 256 + (2 * blk_ + (p4_ >> 1)) * 16 + (p4_ & 1) * 8; \
            ATT_WAITV(0); ATT_BAR(); \
            if (kt + 2 < nt_all) ATT_G2L(kt + 2, (kt + 2) & 3); \
            att_s(lds + ((kt + 1) & 3) * TB + koff_, t_, qf, sN0, sN1); \
            if (!(EDGE) || kt >= 1) att_pv(lds + ((kt - 1) & 3) * TB + 16384 + voff_, q4_, O, pf); \
            const float alpha = att_softmax<EDGE>(sC0, sC1, m, l, pf, h2_, last_valid - 64 * kt); \
            asm volatile("" :: "v"(l), "v"(pf[0][0]), "v"(pf[0][1]), "v"(pf[1][0]), "v"(pf[1][1]));     \
            _Pragma("unroll") for (int _g = 0; _g < 24; ++_g) { __builtin_amdgcn_sched_group_barrier(0x008, 1, 0); __builtin_amdgcn_sched_group_barrier(0x002, 7, 0); } \
            if (__any(alpha != 1.f)) { \
                _Pragma("unroll") for (int et = 0; et < 4; ++et) _Pragma("unroll") for (int i = 0; i < 16; ++i) O[et][i] *= alpha; } \
            } while (0)
        {
            const int npairs = nt_all >> 1;
            ATT_ITER(0, sA0, sA1, sB0, sB1, true);
            ATT_ITER(1, sB0, sB1, sA0, sA1, true);
            for (int pp = 1; pp < npairs - 1; ++pp) {
                ATT_ITER(2 * pp, sA0, sA1, sB0, sB1, false);
                ATT_ITER(2 * pp + 1, sB0, sB1, sA0, sA1, false);
            }
            if (npairs > 1) {
                ATT_ITER(nt_all - 2, sA0, sA1, sB0, sB1, true);
                ATT_ITER(nt_all - 1, sB0, sB1, sA0, sA1, true);
            }
        }
        {
            const int lt = nt_all - 1;
            const int h2b = lane >> 5, q4 = (lane & 15) >> 2, p4 = lane & 3, blk = (lane >> 4) & 1;
            const int voff = (4 * h2b + q4) * 256 + (2 * blk + (p4 >> 1)) * 16 + (p4 & 1) * 8;
            att_pv(lds + (lt & 3) * TB + 16384 + voff, q4, O, pf);
        }
        __syncthreads();
#undef ATT_ITER
#undef ATT_G2L
        const float lt = l + __shfl_xor(l, 32);
        const float inv = (nt_mine > 0) ? 1.f / lt : 0.f;
        LAS float* XO = (LAS float*)lds;
        if (comp == 1) {
            const float sc = inv * lam;
#pragma unroll
            for (int et = 0; et < 4; ++et)
#pragma unroll
                for (int i = 0; i < 16; ++i) XO[(rg * 128 + 32 * et + (i & 3) + 8 * (i >> 2) + 4 * h2) * 32 + r32] = O[et][i] * sc;
        }
        __syncthreads();
        if (comp == 0 && nt_mine > 0) {
            float ss = 0.f;
#pragma unroll
            for (int et = 0; et < 4; ++et)
#pragma unroll
                for (int i = 0; i < 16; ++i) { const float v = O[et][i] * inv - XO[(rg * 128 + 32 * et + (i & 3) + 8 * (i >> 2) + 4 * h2) * 32 + r32]; O[et][i] = v; ss += v * v; }
            ss += __shfl_xor(ss, 32);
            const float rstd = __builtin_amdgcn_rsqf(ss * (1.f / 128.f) + RMS_EPS) * (1.f - lam_init);
            const bool rvalid = sample ? (r32 < TS) : true;
            const int row = qrow0 + r32;
            if (rvalid) {
#pragma unroll
                for (int et = 0; et < 4; ++et)
#pragma unroll
                    for (int g4 = 0; g4 < 4; ++g4) {
                        const int e0 = 32 * et + 8 * g4 + 4 * h2;
                        const u32x2 zz = *(const u32x2*)(proj + (size_t)row * NPROJ + 3072 + h * 128 + e0);
                        const f32x4 sl = *(const f32x4*)(subln + e0);
                        const float z0 = __uint_as_float(zz.x << 16), z1 = __uint_as_float(zz.x & 0xffff0000u), z2 = __uint_as_float(zz.y << 16), z3 = __uint_as_float(zz.y & 0xffff0000u);
                        u32x2 w;
                        w.x = pk2(O[et][4 * g4] * rstd * sl[0] * siluf(z0), O[et][4 * g4 + 1] * rstd * sl[1] * siluf(z1));
                        w.y = pk2(O[et][4 * g4 + 2] * rstd * sl[2] * siluf(z2), O[et][4 * g4 + 3] * rstd * sl[3] * siluf(z3));
                        *(u32x2*)(OB + (size_t)row * 1024 + h * 128 + e0) = w;
                    }
            }
        }
        __syncthreads();
    }
}


#define XB_TMO      128
#define XB_XCNT(j)  (256  + 64 * (j))
#define XB_XSUB(j)  (1280 + 64 * (j))
#define XB_XGEN(j)  (2304 + 64 * (j))
#define XB_TOP      3328
#define XB_TOPGEN   3392
#define XCD_BAR_WORDS 3456
#define XB_SPIN_CAP (1u << 18)
DI unsigned xb_ld(unsigned* p)              { return __hip_atomic_load(p, __ATOMIC_RELAXED, __HIP_MEMORY_SCOPE_AGENT); }
DI unsigned xb_add(unsigned* p, unsigned v) { return __hip_atomic_fetch_add(p, v, __ATOMIC_RELAXED, __HIP_MEMORY_SCOPE_AGENT); }
DI unsigned xb_xcc_id() { return (unsigned)__builtin_amdgcn_s_getreg((3 << 11) | 20) & 0xFu; }
#define XB_SPIN(cond, bar) do { unsigned _sp = 0; while (cond) { __builtin_amdgcn_s_sleep(1); \
    if ((++_sp & 255u) == 0u) { if (xb_ld(&(bar)[XB_TMO])) break; if (_sp > XB_SPIN_CAP) { atomicAdd(&(bar)[XB_TMO], 1u); break; } } } } while (0)
DI void xcd_barrier_complete(unsigned* bar, unsigned x, unsigned& nloc, unsigned& nx) {
    const unsigned G = gridDim.x * gridDim.y * gridDim.z;
    unsigned sum, cnt, mine, sp = 0u;
    for (;;) {
        sum = 0u; cnt = 0u; mine = 0u;
#pragma unroll
        for (unsigned j = 0; j < 16; ++j) { const unsigned c = xb_ld(&bar[XB_XCNT(j)]); sum += c; cnt += (c > 0u) ? 1u : 0u; mine = (j == x) ? c : mine; }
        if (sum == G) break;
        __builtin_amdgcn_s_sleep(1);
        if ((++sp & 255u) == 0u) { if (xb_ld(&bar[XB_TMO])) break; if (sp > XB_SPIN_CAP) { atomicAdd(&bar[XB_TMO], 1u); break; } }
    }
    nloc = mine > 0u ? mine : 1u; nx = cnt > 0u ? cnt : 1u;
}
DI void xcd_barrier(unsigned* bar, volatile LAS unsigned* st) {
    asm volatile("s_waitcnt vmcnt(0)" ::: "memory");
    __syncthreads();
    if (threadIdx.x == 0) {
        const unsigned x = xb_xcc_id();
        __builtin_amdgcn_s_waitcnt(0);
        unsigned nloc = st[0], nx = st[1];
        if (nloc == 0u) { xcd_barrier_complete(bar, x, nloc, nx); st[0] = nloc; st[1] = nx; }
        const unsigned old = xb_add(&bar[XB_XSUB(x)], 1u);
        const unsigned gen = old / nloc;
        if (old + 1u == (gen + 1u) * nloc) {
            __builtin_amdgcn_fence(__ATOMIC_RELEASE, "agent");
            asm volatile("s_waitcnt vmcnt(0)" ::: "memory");
            const unsigned og = xb_add(&bar[XB_TOP], 1u);
            const unsigned tg = og / nx;
            if (og + 1u == (tg + 1u) * nx) xb_add(&bar[XB_TOPGEN], 1u);
            else XB_SPIN(xb_ld(&bar[XB_TOPGEN]) == tg, bar);
            __builtin_amdgcn_fence(__ATOMIC_ACQUIRE, "agent");
            xb_add(&bar[XB_XGEN(x)], 1u);
            asm volatile("s_waitcnt vmcnt(0)" ::: "memory");
        } else {
            XB_SPIN(xb_ld(&bar[XB_XGEN(x)]) == gen, bar);
            __builtin_amdgcn_fence(__ATOMIC_ACQUIRE, "agent");
            asm volatile("s_waitcnt vmcnt(0)" ::: "memory");
        }
    }
    __syncthreads();
}

typedef const __attribute__((address_space(4))) Params* CParP;
#define LOADP() Params P; { CParP kp_ = KP; asm volatile("" : "+s"(kp_)); P = *kp_; } unsigned char* ws = P.ws; (void)ws
__global__ void __launch_bounds__(512, 2) fwd_megakernel(Params Pin) {
#if defined(__HIP_DEVICE_COMPILE__)
    extern __shared__ __attribute__((aligned(16))) unsigned char lds_raw[];
    LAS unsigned char* lds = (LAS unsigned char*)lds_raw;
    cg::grid_group grid = cg::this_grid();
    const CParP KP = (CParP)__builtin_amdgcn_kernarg_segment_ptr();
    volatile LAS unsigned* xst = (volatile LAS unsigned*)(lds + 131072);
    if (threadIdx.x == 0) { xst[0] = 0u; xst[1] = 0u; }
    __syncthreads();
    { LOADP(); if (threadIdx.x == 0) (void)xb_add(&((unsigned*)(ws + WS_BAR))[XB_XCNT(xb_xcc_id())], 1u); }
#define GRID_BAR() do { LOADP(); xcd_barrier((unsigned*)(ws + WS_BAR), xst); } while (0)
    { LOADP(); phase_prep(P, lds); }
    grid.sync();
    for (int layer = 0; layer < 4; ++layer) {
        const int j = layer >> 1;
        { LOADP(); phase_elem(P, lds, layer); }
        GRID_BAR();
        {
            LOADP();
            pg8::StaticOrder S; S.init(M, NPROJ, gridDim.x, blockIdx.x);
            pg8::Gemm g;
            g.A = (const bf16_t*)(ws + WS_HBUF); g.M = M; g.N = NPROJ; g.K = 1024;
            if (!(layer & 1)) {
                g.Bt = (const bf16_t*)(ws + WS_WING) + (size_t)j * 4096 * 1024;
                EpiGdnIn E; E.proj = (bf16_t*)(ws + WS_PROJ); E.conv_p = P.out + OFF_CVP + (size_t)j * 4 * 3 * 3072; E.conv_s = P.out + OFF_CVS + (size_t)j * 16 * 3 * 3072;
                pg8::gemm_phase(lds, g, S, E);
            } else {
                g.Bt = (const bf16_t*)(ws + WS_WIND) + (size_t)j * 4096 * 1024;
                EpiDiffIn E; E.proj = (bf16_t*)(ws + WS_PROJ);
                E.k_p = P.out + OFF_KP + (size_t)j * MP * 1024; E.v_p = P.out + OFF_VP + (size_t)j * MP * 1024;
                E.k_s = P.out + OFF_KSO + (size_t)j * MS * 1024; E.v_s = P.out + OFF_VSO + (size_t)j * MS * 1024;
                E.ks = (bf16_t*)(ws + WS_KS); E.vs = (bf16_t*)(ws + WS_VS); E.kh = (bf16_t*)(ws + WS_KH); E.vh = (bf16_t*)(ws + WS_VH); E.rope = (const float*)(ws + WS_ROPE);
                pg8::gemm_phase(lds, g, S, E);
            }
        }
        GRID_BAR();
        if (!(layer & 1)) {
            { LOADP(); phase_g1(P, lds, layer); }
            GRID_BAR();
            { LOADP(); phase_scan(P, lds, layer); }
            GRID_BAR();
            { LOADP(); phase_gnorm(P, layer); }
        } else {
            { LOADP(); phase_attn(P, lds, layer); }
        }
        GRID_BAR();
        {
            LOADP();
            pg8::StaticOrder S; S.init(M, 1024, gridDim.x, blockIdx.x);
            pg8::Gemm g;
            g.A = (const bf16_t*)(ws + WS_HBUF); g.M = M; g.N = 1024; g.K = 1024;
            g.Bt = (const bf16_t*)(ws + ((layer & 1) ? WS_WOUTD : WS_WOUTG)) + (size_t)j * 1024 * 1024;
            EpiOut E; E.C = (bf16_t*)(ws + WS_PROJ);
            pg8::gemm_phase(lds, g, S, E);
        }
        GRID_BAR();
    }
    { LOADP(); phase_elem(P, lds, 4); }
#endif
}

extern "C" void kernel_launch(void* const* d_in, const int* in_sizes, int n_in, void* d_out, int out_size, void* d_ws, size_t ws_size, hipStream_t stream) {
    static int grid_blocks = 0;
    if (!grid_blocks) {
        int dev = 0, cus = 0, per_cu = 0;
        hipGetDevice(&dev);
        hipDeviceGetAttribute(&cus, hipDeviceAttributeMultiprocessorCount, dev);
        hipFuncSetAttribute((const void*)fwd_megakernel, hipFuncAttributeMaxDynamicSharedMemorySize, LDS_BYTES);
        hipOccupancyMaxActiveBlocksPerMultiprocessor(&per_cu, (const void*)fwd_megakernel, 512, LDS_BYTES);
        if (per_cu < 1) per_cu = 1;
        grid_blocks = cus * per_cu;
        if (ws_size < WS_END) fprintf(stderr, "kernel_launch: workspace too small: %zu < %zu\n", ws_size, (size_t)WS_END);
    }
    hipMemsetAsync((unsigned char*)d_ws + WS_BAR, 0, XCD_BAR_WORDS * sizeof(unsigned), stream);
    Params p{};
    for (int i = 0; i < 25; ++i) p.in[i] = (const float*)d_in[i];
    p.out = (float*)d_out; p.ws = (unsigned char*)d_ws;
    void* args[] = {&p};
    hipError_t e = hipLaunchCooperativeKernel((const void*)fwd_megakernel, dim3(grid_blocks), dim3(512), args, LDS_BYTES, stream);
    if (e != hipSuccess) fprintf(stderr, "cooperative launch failed: %s (grid %d)\n", hipGetErrorString(e), grid_blocks);
}
```

```cpp
#include <hip/hip_runtime.h>
#include <hip/hip_cooperative_groups.h>
#include <cstdio>
namespace cg = cooperative_groups;

#define DI __device__ __forceinline__
#define LAS __attribute__((address_space(3)))
typedef unsigned short bf16_t;
typedef short bf16x8 __attribute__((ext_vector_type(8)));
typedef short s16x4 __attribute__((ext_vector_type(4)));
typedef float f32x2 __attribute__((ext_vector_type(2)));
typedef float f32x4 __attribute__((ext_vector_type(4)));
typedef float f32x16 __attribute__((ext_vector_type(16)));
typedef unsigned u32x2 __attribute__((ext_vector_type(2)));
typedef unsigned u32x4 __attribute__((ext_vector_type(4)));
typedef __bf16 bf16x2_t __attribute__((ext_vector_type(2)));

#define REP_G1 1
#define REP_SCAN 1
#define REP_ATTN 1
#define REP_GIN 1
#define REP_GOUT 1
#define REP_PREP 1
DI int opaque_i(int v) { asm volatile("" : "+s"(v)); return v; }
constexpr int D = 1024, TP = 8192, BP = 4, BS = 16, TS = 16, PAST = 2048;
constexpr int MP = BP * TP, MS = BS * TS, M = MP + MS, NB = BP + BS;
constexpr int NPROJ = 4096;
constexpr int KSROWS = 2112;
constexpr int NITEM_P = 4096, NITEM = 4224;
constexpr size_t ITEM_BYTES = 90112;
constexpr float RMS_EPS = 1e-6f;
constexpr float QSCALE = 0.125f * 1.4426950408889634f;

constexpr size_t OFF_Y = 0;
constexpr size_t OFF_STP = (size_t)M * D;
constexpr size_t OFF_CVP = OFF_STP + 2ull * 4 * 8 * 128 * 128;
constexpr size_t OFF_KP = OFF_CVP + 2ull * 4 * 3 * 3072;
constexpr size_t OFF_VP = OFF_KP + 2ull * MP * 1024;
constexpr size_t OFF_STS = OFF_VP + 2ull * MP * 1024;
constexpr size_t OFF_CVS = OFF_STS + 2ull * 16 * 8 * 128 * 128;
constexpr size_t OFF_KSO = OFF_CVS + 2ull * 16 * 3 * 3072;
constexpr size_t OFF_VSO = OFF_KSO + 2ull * MS * 1024;

constexpr size_t WS_WING = 0;
constexpr size_t WS_WOUTG = WS_WING + 2ull * 4096 * 1024 * 2;
constexpr size_t WS_WIND = WS_WOUTG + 2ull * 1024 * 1024 * 2;
constexpr size_t WS_WOUTD = WS_WIND + 2ull * 4096 * 1024 * 2;
constexpr size_t WS_ADA = WS_WOUTD + 2ull * 1024 * 1024 * 2;
constexpr size_t WS_ROPE = WS_ADA + 4ull * NB * 3072 * 4;
constexpr size_t WS_AB = WS_ROPE + 8208ull * 64 * 4;
constexpr size_t WS_GL = WS_AB + (size_t)M * 16 * 4;
constexpr size_t WS_BAR = WS_GL + 17408;
constexpr size_t WS_HBUF = WS_GL + 32768;
constexpr size_t WS_ORAW = WS_HBUF + (size_t)M * 1024 * 2;
constexpr size_t WS_PROJ = WS_ORAW + 256;
constexpr size_t WS_R1 = WS_PROJ + (size_t)M * 4096 * 2;
constexpr size_t WS_KH = WS_R1;
constexpr size_t WS_VH = WS_KH + (size_t)MP * 1024 * 2;
constexpr size_t WS_ORAWB = WS_R1 + (size_t)NITEM * ITEM_BYTES;
constexpr size_t WS_KS = WS_ORAWB + (size_t)M * 1024 * 2;
constexpr size_t WS_VS = WS_KS + 16ull * KSROWS * 1024 * 2;
constexpr size_t WS_END = WS_VS + 16ull * KSROWS * 1024 * 2;

constexpr int LDS_BYTES = 131072 + 16;

struct Params { const float* in[25]; float* out; unsigned char* ws; };

DI float bf2f(bf16_t v) { return __uint_as_float(((unsigned)v) << 16); }
DI unsigned pk2(float a, float b) { f32x2 v = {a, b}; bf16x2_t r = __builtin_convertvector(v, bf16x2_t); return __builtin_bit_cast(unsigned, r); }
DI bf16_t f2bf(float a) { return (bf16_t)(pk2(a, 0.f) & 0xffffu); }
template <int CTRL> DI float dppf(float v) { return __builtin_bit_cast(float, __builtin_amdgcn_update_dpp(0, __builtin_bit_cast(int, v), CTRL, 0xf, 0xf, true)); }
DI float row_sum16(float v) { v += dppf<0x128>(v); v += dppf<0x124>(v); v += dppf<0x122>(v); v += dppf<0x121>(v); return v; }
DI float wave_sum(float v) { v = row_sum16(v); v += __shfl_xor(v, 16); v += __shfl_xor(v, 32); return v; }
DI float readlane_f(float v, int l) { return __builtin_bit_cast(float, __builtin_amdgcn_readlane(__builtin_bit_cast(int, v), l)); }
DI float siluf(float x) { return x * __builtin_amdgcn_rcpf(1.f + __expf(-x)); }
DI int ppos(int idx) { const int d5 = idx & 31; return (idx & ~31) | (((d5 >> 2) & 3) << 3) | ((d5 >> 4) << 2) | (d5 & 3); }
DI int perm64(int ls) { return (ls & 15) | (((ls >> 4) & 1) << 5) | (((ls >> 5) & 1) << 4); }
DI void unpack8(const u32x4 v, float (&o)[8]) {
#pragma unroll
    for (int i = 0; i < 4; ++i) { o[2 * i] = __uint_as_float(v[i] << 16); o[2 * i + 1] = __uint_as_float(v[i] & 0xffff0000u); }
}
DI void g2l16(const void* gptr, unsigned lds_addr) {
    asm volatile("s_mov_b32 m0, %1\n\ts_nop 0\n\tglobal_load_lds_dwordx4 %0, off" :: "v"(gptr), "s"(lds_addr) : "memory", "m0");
}
DI unsigned lds_u32(LAS unsigned char* p) { return (unsigned)(size_t)p; }
#define MFMA16(a, b, c) __builtin_amdgcn_mfma_f32_16x16x32_bf16((a), (b), (c), 0, 0, 0)
#define MFMA32(a, b, c) __builtin_amdgcn_mfma_f32_32x32x16_bf16((a), (b), (c), 0, 0, 0)

namespace pg8 {
constexpr int BM = 256, BK = 64, HALF = 128, HTB = HALF * BK * 2, STAGE_BYTES = 8 * HTB, NXCD = 8, WGM = 8;
DI int lds_byte(int r, int c) { const int st = (r >> 4) * 2 + (c >> 5), rr = r & 15, cc = c & 31, ob = rr * 64 + cc * 2; return st * 1024 + (ob ^ (((ob >> 9) & 1) << 5)); }
DI void stage_rc(int b, int& R, int& C) { const int st = b / 1024, sb = b % 1024, swz = sb ^ (((sb >> 9) & 1) << 5); R = (st >> 1) * 16 + swz / 64; C = (st & 1) * 32 + (swz % 64) / 2; }
struct Unit { int pm, pn; };
struct Gemm { const bf16_t* A; const bf16_t* Bt; int M, N, K; };
struct StaticOrder {
    int nM, nN, nwg, G, c;
    DI void init(int M_, int N_, int G_, int c_) { nM = M_ / BM; nN = N_ / BM; nwg = nM * nN; G = G_; c = c_; }
    DI bool next(int i, Unit& u) const {
        const long L = (long)i * G + c; if (L >= nwg) return false;
        int wgid = (int)L; { const int q = nwg / NXCD, r = nwg % NXCD, xcd = wgid % NXCD, off = wgid / NXCD; wgid = (xcd < r ? xcd * (q + 1) : r * (q + 1) + (xcd - r) * q) + off; }
        const int nig = WGM * nN, gid = wgid / nig, fm = gid * WGM, gsz = (nM - fm) < WGM ? (nM - fm) : WGM;
        u.pm = fm + ((wgid % nig) % gsz); u.pn = (wgid % nig) / gsz; return true;
    }
};

template <class Epi>
DI void gemm_phase(LAS unsigned char* lds, const Gemm g, const StaticOrder& S, const Epi& E) {
    int tid_ = threadIdx.x; asm volatile("" : "+v"(tid_)); const int tid = tid_, wid = __builtin_amdgcn_readfirstlane(tid >> 6), lane = tid & 63, wr = wid >> 2, wc = wid & 3, fr = lane & 15, fq = lane >> 4;
    const int K = g.K, nt = K / BK;
    unsigned voffA[2];
#pragma unroll
    for (int i = 0; i < 2; ++i) { int R, C; stage_rc(tid * 16 + i * 8192, R, C); voffA[i] = (unsigned)(R * K + C) * 2u; }
    const size_t kstep = (size_t)(BK * 2);
    const size_t hstep = (size_t)HALF * K * 2;
    const size_t tstep = 2 * hstep;
    const unsigned ldsw = (unsigned)wid * 1024u;
    const int aoff = lds_byte(wr * 64 + fr, fq * 8), boff = lds_byte(wc * 32 + fr, fq * 8);
#define PG8_SA(b, h) (((b) * 2 + (h)) * HTB)
#define PG8_SB(b, h) ((4 + (b) * 2 + (h)) * HTB)
#define PG8_STAGE(bufoff, gbase) do { _Pragma("unroll") for (int _i = 0; _i < 2; ++_i) \
        __builtin_amdgcn_global_load_lds((const unsigned*)((const char*)(gbase) + voffA[_i]), (LAS unsigned*)(lds + (bufoff) + ldsw + _i * 8192), 16, 0, 0); } while (0)
#define PG8_LDA(dst, b, h) do { _Pragma("unroll") for (int m = 0; m < 4; ++m) _Pragma("unroll") for (int k = 0; k < 2; ++k) dst[m][k] = *(const LAS bf16x8*)(lds + PG8_SA(b, h) + aoff + m * 2048 + k * 1024); } while (0)
#define PG8_LDB(dst, b, h) do { _Pragma("unroll") for (int n = 0; n < 2; ++n) _Pragma("unroll") for (int k = 0; k < 2; ++k) dst[n][k] = *(const LAS bf16x8*)(lds + PG8_SB(b, h) + boff + n * 2048 + k * 1024); } while (0)
#define PG8_MMA(ai, bj, At, Bt) do { __builtin_amdgcn_s_setprio(1); _Pragma("unroll") for (int m = 0; m < 4; ++m) _Pragma("unroll") for (int n = 0; n < 2; ++n) _Pragma("unroll") for (int k = 0; k < 2; ++k) \
        acc[ai][bj][m][n] = __builtin_amdgcn_mfma_f32_16x16x32_bf16(Bt[n][k], At[m][k], acc[ai][bj][m][n], 0, 0, 0); __builtin_amdgcn_s_setprio(0); } while (0)
#define PG8_WAIT_V(n) asm volatile("s_waitcnt vmcnt(" #n ")" ::: "memory")
#define PG8_WAIT_L(n) asm volatile("s_waitcnt lgkmcnt(" #n ")" ::: "memory")
#define PG8_BAR __builtin_amdgcn_s_barrier()
#define PG8_SCHED __builtin_amdgcn_sched_barrier(0)
    Unit cur, nxt; int ui = 0;
    if (!S.next(0, cur)) return;
    f32x4 acc[2][2][4][2];
#pragma unroll
    for (int a = 0; a < 2; ++a)
#pragma unroll
        for (int b = 0; b < 2; ++b)
#pragma unroll
            for (int m = 0; m < 4; ++m)
#pragma unroll
                for (int n = 0; n < 2; ++n) acc[a][b][m][n] = (f32x4){0.f, 0.f, 0.f, 0.f};
    bf16x8 At[4][2], B0[2][2], B1[2][2];
    const char* cA = (const char*)g.A + (size_t)cur.pm * tstep; const char* cB = (const char*)g.Bt + (size_t)cur.pn * tstep;
    PG8_STAGE(PG8_SB(0, 0), cB); PG8_STAGE(PG8_SA(0, 0), cA); PG8_STAGE(PG8_SB(0, 1), cB + hstep); PG8_STAGE(PG8_SA(0, 1), cA + hstep);
    if (wr == 1) PG8_BAR;
    PG8_WAIT_V(4); PG8_BAR;
    PG8_STAGE(PG8_SB(1, 0), cB + kstep); PG8_STAGE(PG8_SA(1, 0), cA + kstep); PG8_STAGE(PG8_SB(1, 1), cB + hstep + kstep);
    PG8_WAIT_V(6); PG8_BAR;
    for (;;) {
        const bool has_next = S.next(ui + 1, nxt);
        const char* nA = has_next ? (const char*)g.A + (size_t)nxt.pm * tstep : cA; const char* nB = has_next ? (const char*)g.Bt + (size_t)nxt.pn * tstep : cB;
        for (int t = 0; t < nt; t += 2) {
            const bool last = (t == nt - 2);
            const char* a1 = cA + (size_t)(t + 1) * kstep;
            const char* a2 = last ? nA : cA + (size_t)(t + 2) * kstep; const char* b2 = last ? nB : cB + (size_t)(t + 2) * kstep;
            const char* a3 = a2 + kstep; const char* b3 = b2 + kstep;
            PG8_LDB(B0, 0, 0); PG8_SCHED; PG8_LDA(At, 0, 0); PG8_STAGE(PG8_SA(1, 1), a1 + hstep);
            PG8_WAIT_L(8); PG8_BAR; PG8_WAIT_L(0); PG8_MMA(0, 0, At, B0); PG8_BAR; PG8_SCHED;
            PG8_LDB(B1, 0, 1); PG8_STAGE(PG8_SB(0, 0), b2);
            PG8_BAR; PG8_WAIT_L(0); PG8_MMA(0, 1, At, B1); PG8_BAR;
            PG8_LDA(At, 0, 1); PG8_STAGE(PG8_SA(0, 0), a2);
            PG8_BAR; PG8_WAIT_L(0); PG8_MMA(1, 0, At, B0); PG8_BAR; PG8_SCHED;
            PG8_STAGE(PG8_SB(0, 1), b2 + hstep);
            PG8_WAIT_V(6); PG8_BAR; PG8_MMA(1, 1, At, B1); PG8_BAR;
            PG8_LDB(B0, 1, 0); PG8_SCHED; PG8_LDA(At, 1, 0); PG8_STAGE(PG8_SA(0, 1), a2 + hstep);
            PG8_WAIT_L(8); PG8_BAR; PG8_WAIT_L(0); PG8_MMA(0, 0, At, B0); PG8_BAR; PG8_SCHED;
            PG8_LDB(B1, 1, 1); PG8_STAGE(PG8_SB(1, 0), b3);
            PG8_BAR; PG8_WAIT_L(0); PG8_MMA(0, 1, At, B1); PG8_BAR;
            PG8_LDA(At, 1, 1); PG8_STAGE(PG8_SA(1, 0), a3);
            PG8_BAR; PG8_WAIT_L(0); PG8_MMA(1, 0, At, B0); PG8_BAR; PG8_SCHED;
            PG8_STAGE(PG8_SB(1, 1), b3 + hstep);
            PG8_WAIT_V(6); PG8_BAR; PG8_MMA(1, 1, At, B1); PG8_BAR;
        }
        E(acc, cur, wr, wc, fr, fq);
        if (!has_next) break;
#pragma unroll
        for (int a = 0; a < 2; ++a)
#pragma unroll
            for (int b = 0; b < 2; ++b)
#pragma unroll
                for (int m = 0; m < 4; ++m)
#pragma unroll
                    for (int n = 0; n < 2; ++n) acc[a][b][m][n] = (f32x4){0.f, 0.f, 0.f, 0.f};
        cur = nxt; cA = nA; cB = nB; ++ui;
    }
    PG8_WAIT_V(0);
    if (wr == 0) PG8_BAR;
    PG8_BAR;
#undef PG8_SA
#undef PG8_SB
#undef PG8_STAGE
#undef PG8_LDA
#undef PG8_LDB
#undef PG8_MMA
#undef PG8_WAIT_V
#undef PG8_WAIT_L
#undef PG8_BAR
#undef PG8_SCHED
}
}

struct EpiGdnIn {
    bf16_t* proj; float* conv_p; float* conv_s;
    DI void operator()(const f32x4 (&acc)[2][2][4][2], const pg8::Unit& u, int wr, int wc, int fr, int fq) const {
        const int row0 = u.pm * 256 + wr * 64 + fr, col0 = u.pn * 256 + wc * 32 + 4 * fq;
#pragma unroll
        for (int ai = 0; ai < 2; ++ai)
#pragma unroll
            for (int m = 0; m < 4; ++m) {
                const int r = row0 + ai * 128 + m * 16;
                bf16_t* rowp = proj + (size_t)r * NPROJ + col0;
                bool tail; float* cp;
                if (r < MP) { const int t = r & (TP - 1), b = r >> 13; tail = t >= TP - 3; cp = conv_p + (size_t)(b * 3 + (t - (TP - 3))) * 3072; }
                else { const int rs = r - MP, t = rs & 15, b = rs >> 4; tail = t >= TS - 3; cp = conv_s + (size_t)(b * 3 + (t - (TS - 3))) * 3072; }
#pragma unroll
                for (int bj = 0; bj < 2; ++bj)
#pragma unroll
                    for (int n = 0; n < 2; ++n) {
                        const f32x4 v = acc[ai][bj][m][n];
                        u32x2 w; w.x = pk2(v[0], v[1]); w.y = pk2(v[2], v[3]);
                        *(u32x2*)(rowp + bj * 128 + n * 16) = w;
                        const int c = col0 + bj * 128 + n * 16;
                        if (tail && c < 3072) *(f32x4*)(cp + c) = v;
                    }
            }
    }
};

struct EpiDiffIn {
    bf16_t* proj; float* k_p; float* v_p; float* k_s; float* v_s; bf16_t* ks; bf16_t* vs; bf16_t* kh; bf16_t* vh; const float* rope;
    DI void operator()(const f32x4 (&acc)[2][2][4][2], const pg8::Unit& u, int wr, int wc, int fr, int fq) const {
        const int part = u.pn >> 2;
        const int row0 = u.pm * 256 + wr * 64 + fr;
        const int d0 = 16 * (wc & 1) + 4 * fq;
        const int cbase = u.pn * 256 + 64 * (wc >> 1) + d0;
#pragma unroll
        for (int ai = 0; ai < 2; ++ai)
#pragma unroll
            for (int m = 0; m < 4; ++m) {
                const int r = row0 + ai * 128 + m * 16;
                const int rs = r - MP;
                const int pidx = (r < MP) ? (r & (TP - 1)) : (TP + (rs & 15));
                f32x4 cs = {1.f, 1.f, 1.f, 1.f}, sn = {0.f, 0.f, 0.f, 0.f};
                if (part < 2) { cs = *(const f32x4*)(rope + (size_t)pidx * 64 + d0); sn = *(const f32x4*)(rope + (size_t)pidx * 64 + 32 + d0); }
#pragma unroll
                for (int bj = 0; bj < 2; ++bj) {
                    const f32x4 x1 = acc[ai][bj][m][0], x2 = acc[ai][bj][m][1];
                    f32x4 y1 = x1 * cs - x2 * sn, y2 = x2 * cs + x1 * sn;
                    const int col = cbase + bj * 128;
                    bf16_t* pp = proj + (size_t)r * NPROJ + col;
                    if (part == 0) { y1 *= QSCALE; y2 *= QSCALE; }
                    u32x2 w1, w2; w1.x = pk2(y1[0], y1[1]); w1.y = pk2(y1[2], y1[3]); w2.x = pk2(y2[0], y2[1]); w2.y = pk2(y2[2], y2[3]);
                    if (part == 0 || part == 3) { *(u32x2*)pp = w1; *(u32x2*)(pp + 32) = w2; }
                    if (part == 1 || part == 2) {
                        const int cc = col - part * 1024;
                        const int hh = cc >> 7, dd = cc & 127;
                        float* op; bf16_t* sp;
                        if (r < MP) { op = (part == 1 ? k_p : v_p) + (size_t)r * 1024 + cc;
                               sp = (part == 1 ? kh : vh) + ((size_t)((r >> 13) * 8 + hh) * TP + (r & (TP - 1))) * 128 + dd; }
                        else { op = (part == 1 ? k_s : v_s) + (size_t)rs * 1024 + cc;
                               sp = (part == 1 ? ks : vs) + ((size_t)((rs >> 4) * 8 + hh) * KSROWS + PAST + (rs & 15)) * 128 + dd; }
                        *(f32x4*)op = y1; *(f32x4*)(op + 32) = y2;
                        *(u32x2*)sp = w1; *(u32x2*)(sp + 32) = w2;
                    }
                }
            }
    }
};

struct EpiOut {
    bf16_t* C;
    DI void operator()(const f32x4 (&acc)[2][2][4][2], const pg8::Unit& u, int wr, int wc, int fr, int fq) const {
        const int row0 = u.pm * 256 + wr * 64 + fr, col0 = u.pn * 256 + wc * 32 + 4 * fq;
#pragma unroll
        for (int ai = 0; ai < 2; ++ai)
#pragma unroll
            for (int m = 0; m < 4; ++m) {
                bf16_t* rowp = C + (size_t)(row0 + ai * 128 + m * 16) * 1024 + col0;
#pragma unroll
                for (int bj = 0; bj < 2; ++bj)
#pragma unroll
                    for (int n = 0; n < 2; ++n) { const f32x4 v = acc[ai][bj][m][n]; u32x2 w; w.x = pk2(v[0], v[1]); w.y = pk2(v[2], v[3]); *(u32x2*)(rowp + bj * 128 + n * 16) = w; }
            }
    }
};

DI void transpose_tile(const float* W, int ldw, int n0, int k0, bf16_t* WT, bool perm, LAS float* tile) {
    int tid_ = threadIdx.x; asm volatile("" : "+v"(tid_)); const int tid = tid_;
    {
        const int kk = tid >> 4, c4 = (tid & 15) * 4;
#pragma unroll
        for (int p = 0; p < 2; ++p) {
            const f32x4 v = *(const f32x4*)(W + (size_t)(k0 + kk + 32 * p) * ldw + n0 + c4);
            LAS float* t = tile + (kk + 32 * p) * 65 + c4;
            t[0] = v[0]; t[1] = v[1]; t[2] = v[2]; t[3] = v[3];
        }
    }
    __syncthreads();
    {
        const int n = tid >> 3, ks = (tid & 7) * 8;
        const int src = perm ? perm64(n) : n;
        float v[8];
#pragma unroll
        for (int e = 0; e < 8; ++e) v[e] = tile[(ks + e) * 65 + src];
        u32x4 w; w.x = pk2(v[0], v[1]); w.y = pk2(v[2], v[3]); w.z = pk2(v[4], v[5]); w.w = pk2(v[6], v[7]);
        *(u32x4*)(WT + (size_t)(n0 + n) * 1024 + k0 + ks) = w;
    }
    __syncthreads();
}

DI void phase_prep(const Params& P, LAS unsigned char* lds) {
    int tid_ = threadIdx.x; asm volatile("" : "+v"(tid_)); const int tid = tid_, G = gridDim.x;
    unsigned char* ws = P.ws;
    for (int id = blockIdx.x; id < 5120; id += G) {
        const int j = id / 2560; int rem = id % 2560;
        const float* W; int ldw; bf16_t* WT; bool perm = false; int t;
        if (rem < 1024) { W = P.in[12] + (size_t)j * 1024 * 4112; ldw = 4112; WT = (bf16_t*)(ws + WS_WING) + (size_t)j * 4096 * 1024; t = rem; }
        else if (rem < 1280) { W = P.in[17] + (size_t)j * 1024 * 1024; ldw = 1024; WT = (bf16_t*)(ws + WS_WOUTG) + (size_t)j * 1024 * 1024; t = rem - 1024; }
        else if (rem < 2304) { W = P.in[18] + (size_t)j * 1024 * 4096; ldw = 4096; WT = (bf16_t*)(ws + WS_WIND) + (size_t)j * 4096 * 1024; t = rem - 1280; perm = true; }
        else { W = P.in[24] + (size_t)j * 1024 * 1024; ldw = 1024; WT = (bf16_t*)(ws + WS_WOUTD) + (size_t)j * 1024 * 1024; t = rem - 2304; }
        transpose_tile(W, ldw, (t >> 4) * 64, (t & 15) * 64, WT, perm, (LAS float*)lds);
    }
    for (int idx = blockIdx.x * 512 + tid; idx < 8208 * 32; idx += G * 512) {
        const int pi = idx >> 5, d = idx & 31;
        const int pos = pi < TP ? pi : PAST + (pi - TP);
        const float inv = 1.0f / powf(10000.0f, (float)d / 32.0f);
        const float ang = (float)pos * inv;
        const double rev = (double)ang * 0.15915494309189535;
        const double fr = rev - floor(rev);
        float* rp = (float*)(ws + WS_ROPE) + (size_t)pi * 64;
        rp[d] = __builtin_amdgcn_cosf((float)fr);
        rp[32 + d] = __builtin_amdgcn_sinf((float)fr);
    }
    {
        LAS float* cact = (LAS float*)lds;
        LAS float* red = (LAS float*)(lds + 81920);
        bool loaded = false;
        for (int id = (G - 1 - blockIdx.x); id < 192; id += G) {
            if (!loaded) {
                for (int e = tid; e < NB * 1024; e += 512) {
                    const int b = e >> 10, k = e & 1023;
                    const float c = b < BP ? P.in[2][b * 1024 + k] : P.in[3][(b - BP) * 1024 + k];
                    cact[e] = siluf(c);
                }
                loaded = true;
            }
            __syncthreads();
            const int i = id / 48, cb = id % 48;
            const int col = tid & 63, kg = tid >> 6;
            const float* Wp = P.in[10] + (size_t)i * 1024 * 3072 + cb * 64 + col;
            float acc[NB];
#pragma unroll
            for (int b = 0; b < NB; ++b) acc[b] = 0.f;
            for (int k = kg * 128; k < kg * 128 + 128; k += 4) {
                const float w0 = Wp[(size_t)k * 3072], w1 = Wp[(size_t)(k + 1) * 3072], w2 = Wp[(size_t)(k + 2) * 3072], w3 = Wp[(size_t)(k + 3) * 3072];
#pragma unroll
                for (int b = 0; b < NB; ++b) {
                    const f32x4 c4 = *(const LAS f32x4*)(cact + b * 1024 + k);
                    acc[b] += c4[0] * w0 + c4[1] * w1 + c4[2] * w2 + c4[3] * w3;
                }
            }
#pragma unroll
            for (int b = 0; b < NB; ++b) red[(kg * NB + b) * 64 + col] = acc[b];
            __syncthreads();
            for (int o = tid; o < NB * 64; o += 512) {
                const int b = o >> 6, c = o & 63;
                float s = P.in[11][i * 3072 + cb * 64 + c];
#pragma unroll
                for (int g = 0; g < 8; ++g) s += red[(g * NB + b) * 64 + c];
                ((float*)(ws + WS_ADA))[((size_t)i * NB + b) * 3072 + cb * 64 + c] = s;
            }
        }
        __syncthreads();
    }
}

DI void phase_elem(const Params& P, LAS unsigned char* lds, int layer) {
    int tid_ = threadIdx.x; asm volatile("" : "+v"(tid_)); const int tid = tid_, wid = __builtin_amdgcn_readfirstlane(tid >> 6), lane = tid & 63, G = gridDim.x;
    unsigned char* ws = P.ws;
    const int j = layer >> 1;
    const bool gdn = (layer < 4) && !(layer & 1);
    LAS float* wab = (LAS float*)lds;
    if (gdn) {
        const float* Wp = P.in[12] + (size_t)j * 1024 * 4112 + 4096;
        for (int e = tid; e < 16384; e += 512) { const int k = e >> 4, c = e & 15; wab[c * 1024 + k] = Wp[(size_t)k * 4112 + c]; }
        __syncthreads();
    }
    const float* ada = (const float*)(ws + WS_ADA);
    float* X = P.out;
    const bf16_t* OUTB = (const bf16_t*)(ws + WS_PROJ);
    bf16_t* HB = (bf16_t*)(ws + WS_HBUF);
    float* AB = (float*)(ws + WS_AB);
    f32x4 xn[4]; u32x2 own[4];
#define EL_LOAD(R) do { const int _r = (R); if (_r < M) { \
        const float* _xs = (layer <= 1) ? (_r < MP ? P.in[0] + (size_t)_r * 1024 : P.in[1] + (size_t)(_r - MP) * 1024) : X + (size_t)_r * 1024; \
        _Pragma("unroll") for (int _q = 0; _q < 4; ++_q) xn[_q] = *(const f32x4*)(_xs + 4 * (lane + 64 * _q)); \
        if (layer >= 1) { _Pragma("unroll") for (int _q = 0; _q < 4; ++_q) own[_q] = *(const u32x2*)(OUTB + (size_t)_r * 1024 + 4 * (lane + 64 * _q)); } } } while (0)
    EL_LOAD(blockIdx.x * 8 + wid);
    for (int r = blockIdx.x * 8 + wid; r < M; r += G * 8) {
        const int b = r < MP ? (r >> 13) : BP + ((r - MP) >> 4);
        f32x4 x[4]; u32x2 owc[4];
#pragma unroll
        for (int q = 0; q < 4; ++q) { x[q] = xn[q]; owc[q] = own[q]; }
        EL_LOAD(r + G * 8);
        if (layer >= 1) {
            f32x4 o[4]; float ss = 0.f;
#pragma unroll
            for (int q = 0; q < 4; ++q) { const u32x2 ow = owc[q];
                o[q] = (f32x4){__uint_as_float(ow.x << 16), __uint_as_float(ow.x & 0xffff0000u), __uint_as_float(ow.y << 16), __uint_as_float(ow.y & 0xffff0000u)};
                ss += o[q][0] * o[q][0] + o[q][1] * o[q][1] + o[q][2] * o[q][2] + o[q][3] * o[q][3]; }
            ss = wave_sum(ss);
            const float rstd = __builtin_amdgcn_rsqf(ss * (1.f / 1024.f) + RMS_EPS);
            const float* gp = ada + ((size_t)(layer - 1) * NB + b) * 3072 + 2048;
            const float* np = P.in[9] + (layer - 1) * 1024;
#pragma unroll
            for (int q = 0; q < 4; ++q) {
                const int d = 4 * (lane + 64 * q);
                const f32x4 gt = *(const f32x4*)(gp + d), nw = *(const f32x4*)(np + d);
                x[q] = x[q] + gt * (o[q] * rstd * nw);
                *(f32x4*)(X + (size_t)r * 1024 + d) = x[q];
            }
        }
        if (layer < 4) {
            float ss = 0.f;
#pragma unroll
            for (int q = 0; q < 4; ++q) ss += x[q][0] * x[q][0] + x[q][1] * x[q][1] + x[q][2] * x[q][2] + x[q][3] * x[q][3];
            ss = wave_sum(ss);
            const float rstd = __builtin_amdgcn_rsqf(ss * (1.f / 1024.f) + RMS_EPS);
            const float* ap = ada + ((size_t)layer * NB + b) * 3072;
            const float* np = P.in[8] + layer * 1024;
            f32x4 hv[4];
#pragma unroll
            for (int q = 0; q < 4; ++q) {
                const int d = 4 * (lane + 64 * q);
                const f32x4 sh = *(const f32x4*)(ap + d), sc = *(const f32x4*)(ap + 1024 + d), nw = *(const f32x4*)(np + d);
                hv[q] = (x[q] * rstd * nw) * (1.f + sc) + sh;
                u32x2 w; w.x = pk2(hv[q][0], hv[q][1]); w.y = pk2(hv[q][2], hv[q][3]);
                *(u32x2*)(HB + (size_t)r * 1024 + d) = w;
            }
            if (gdn) {
                float mine = 0.f;
#pragma unroll
                for (int c = 0; c < 16; ++c) {
                    float a = 0.f;
#pragma unroll
                    for (int q = 0; q < 4; ++q) { const f32x4 w4 = *(const LAS f32x4*)(wab + c * 1024 + 4 * (lane + 64 * q)); a += hv[q][0] * w4[0] + hv[q][1] * w4[1] + hv[q][2] * w4[2] + hv[q][3] * w4[3]; }
                    a = row_sum16(a);
                    if ((lane & 15) == c) mine = a;
                }
                mine += __shfl_xor(mine, 16); mine += __shfl_xor(mine, 32);
                if (lane < 16) AB[(size_t)r * 16 + lane] = mine;
            }
        }
    }
}

DI void convert_cache(const Params& P, int j, int b0, int nb) {
    int tid_ = threadIdx.x; asm volatile("" : "+v"(tid_)); const int tid = tid_;
    unsigned char* ws = P.ws;
    const int bx = blockIdx.x - b0; const int G = nb;
    {
        const float* ck = P.in[6] + (size_t)j * 16 * PAST * 1024;
        const float* cv = P.in[7] + (size_t)j * 16 * PAST * 1024;
        bf16_t* KS = (bf16_t*)(ws + WS_KS); bf16_t* VS = (bf16_t*)(ws + WS_VS);
        const size_t nun = (size_t)16 * PAST * 128;
        for (size_t u = (size_t)bx * 512 + tid; u < 2 * nun; u += (size_t)G * 512) {
            const bool isv = u >= nun; const size_t uu = isv ? u - nun : u;
            const size_t b = uu / ((size_t)PAST * 128), rem = uu % ((size_t)PAST * 128);
            const size_t row = rem >> 7, c8 = rem & 127, hh = c8 >> 4, d8 = c8 & 15;
            const float* sp = (isv ? cv : ck) + uu * 8;
            const f32x4 a = *(const f32x4*)sp, c = *(const f32x4*)(sp + 4);
            u32x4 w; w.x = pk2(a[0], a[1]); w.y = pk2(a[2], a[3]); w.z = pk2(c[0], c[1]); w.w = pk2(c[2], c[3]);
            *(u32x4*)((isv ? VS : KS) + ((b * 8 + hh) * KSROWS + row) * 128 + d8 * 8) = w;
        }
        const size_t npad = (size_t)128 * 48 * 16;
        for (size_t u = (size_t)bx * 512 + tid; u < 2 * npad; u += (size_t)G * 512) {
            const bool isv = u >= npad; const size_t uu = isv ? u - npad : u;
            const size_t sq = uu / (48 * 16), rem = uu % (48 * 16);
            *(u32x4*)((isv ? VS : KS) + (sq * KSROWS + PAST + TS) * 128 + rem * 8) = (u32x4){0u, 0u, 0u, 0u};
        }
    }
}

DI void phase_g1(const Params& P, LAS unsigned char* lds, int layer) {
    int tid_ = threadIdx.x; asm volatile("" : "+v"(tid_)); const int tid = tid_, wid = __builtin_amdgcn_readfirstlane(tid >> 6), lane = tid & 63, G = gridDim.x;
    const int fr = lane & 15, fq = lane >> 4;
    unsigned char* ws = P.ws;
    const int j = layer >> 1;
    const bf16_t* proj = (const bf16_t*)(ws + WS_PROJ);
    const float* AB = (const float*)(ws + WS_AB);
    float* GL = (float*)(ws + WS_GL);
    const float* convw = P.in[13] + (size_t)j * 4 * 3072;
    const float* cconv = P.in[5] + (size_t)j * 16 * 3 * 3072;
    LAS unsigned char* Qs = lds;
    LAS unsigned char* Ks = lds + 17408;
    LAS unsigned char* VBt = lds + 34816;
    LAS unsigned char* KBt = lds + 53248;
    LAS float* A32 = (LAS float*)(lds + 71680);
    LAS unsigned char* Ts = lds + 88320;
    LAS unsigned char* QKs = lds + 97536;
    LAS float* Gs = (LAS float*)(lds + 105728);

    u32x4 rows[11];
#define G1_ROWLOAD(IT) do { const int _it = (IT); if (tid < 384 && _it < NITEM) { int _h, _c, _row0, _nv; bool _smp; \
            if (_it < NITEM_P) { const int _seq = _it >> 7; _h = _seq & 7; _c = _it & 127; _row0 = (_seq >> 3) * TP + 64 * _c; _nv = 64; _smp = false; } \
            else { const int _s = _it - NITEM_P; _h = _s & 7; _c = 0; _row0 = MP + (_s >> 3) * TS; _nv = TS; _smp = true; } \
            int _t = tid; asm volatile("" : "+v"(_t)); const int _l16 = _t & 15, _grp = _t >> 4, _part = _grp >> 3, _rb = _grp & 7; \
            const int _ch = _part * 1024 + _h * 128 + 8 * _l16; \
            _Pragma("unroll") for (int _k = 0; _k < 11; ++_k) { const int _lr = 8 * _rb - 3 + _k; \
                const bool _up = (_lr >= 0 && _lr < _nv) || (_lr < 0 && !_smp && _c > 0); const int _lrc = _up ? _lr : 0; \
                rows[_k] = *(const u32x4*)(proj + (size_t)(_row0 + _lrc) * NPROJ + _ch); } } } while (0)
    G1_ROWLOAD((int)blockIdx.x);
    for (int item = blockIdx.x; item < NITEM; item += G) {
        int b, h, c, row0, nvalid; bool sample;
        if (item < NITEM_P) { const int seq = item >> 7; b = seq >> 3; h = seq & 7; c = item & 127; row0 = b * TP + 64 * c; nvalid = 64; sample = false; }
        else { const int s = item - NITEM_P; b = s >> 3; h = s & 7; c = 0; row0 = MP + b * TS; nvalid = TS; sample = true; }
        unsigned char* ib = ws + WS_R1 + (size_t)item * ITEM_BYTES;
        float val[8][8];
        float rn[8];
        int tido = tid; asm volatile("" : "+v"(tido));
        const int l16 = tido & 15, grp = tido >> 4, part = grp >> 3, rb = grp & 7;
        const int lane = tido & 63, fr = lane & 15, fq = lane >> 4;
        if (tid < 384) {
            const int ch = part * 1024 + h * 128 + 8 * l16;
            float wv[4][8];
#pragma unroll
            for (int t = 0; t < 4; ++t) {
                const f32x4 a = *(const f32x4*)(convw + t * 3072 + ch), bb = *(const f32x4*)(convw + t * 3072 + ch + 4);
                wv[t][0] = a[0]; wv[t][1] = a[1]; wv[t][2] = a[2]; wv[t][3] = a[3]; wv[t][4] = bb[0]; wv[t][5] = bb[1]; wv[t][6] = bb[2]; wv[t][7] = bb[3];
            }
            float win[4][8];
#pragma unroll
            for (int t = 0; t < 4; ++t)
#pragma unroll
                for (int e = 0; e < 8; ++e) win[t][e] = 0.f;
#pragma unroll
            for (int k = 0; k < 11; ++k) {
                const int lr = 8 * rb - 3 + k;
                float in8[8];
                {
                    const bool use_proj = (lr >= 0 && lr < nvalid) || (lr < 0 && !sample && c > 0);
                    unpack8(rows[k], in8);
                    if (!use_proj) {
#pragma unroll
                        for (int e = 0; e < 8; ++e) in8[e] = 0.f;
                    }
                }
                if (k < 3) {
                    if (sample && lr < 0) {
                        const float* sp = cconv + (size_t)(b * 3 + (3 + lr)) * 3072 + ch;
                        const f32x4 a = *(const f32x4*)sp, bb = *(const f32x4*)(sp + 4);
                        in8[0] = a[0]; in8[1] = a[1]; in8[2] = a[2]; in8[3] = a[3]; in8[4] = bb[0]; in8[5] = bb[1]; in8[6] = bb[2]; in8[7] = bb[3];
                    }
                }
#pragma unroll
                for (int e = 0; e < 8; ++e) { win[0][e] = win[1][e]; win[1][e] = win[2][e]; win[2][e] = win[3][e]; win[3][e] = in8[e]; }
                if (k >= 3) {
                    const bool rv = (lr < nvalid);
                    float ss = 0.f;
#pragma unroll
                    for (int e = 0; e < 8; ++e) {
                        const float y = win[0][e] * wv[0][e] + win[1][e] * wv[1][e] + win[2][e] * wv[2][e] + win[3][e] * wv[3][e];
                        const float s = rv ? siluf(y) : 0.f;
                        val[k - 3][e] = s; ss += s * s;
                    }
                    ss = row_sum16(ss);
                    rn[k - 3] = __builtin_amdgcn_rsqf(ss + 1e-6f);
                }
            }
        } else if (wid == 7) {
            const int r = row0 + (lane < nvalid ? lane : 0);
            const bool valid = lane < nvalid;
            const float a = AB[(size_t)r * 16 + h], bb = AB[(size_t)r * 16 + 8 + h];
            const float xa = a + P.in[15][j * 8 + h];
            const float ey = __expf(-fabsf(xa));
            const float lp = (ey < 0.01f) ? ey * (1.f - ey * (0.5f - ey * 0.33333334f)) : __logf(1.f + ey);
            const float sp = fmaxf(xa, 0.f) + lp;
            float g = valid ? -__expf(P.in[14][j * 8 + h]) * sp : 0.f;
            const float beta = valid ? __builtin_amdgcn_rcpf(1.f + __expf(-bb)) : 0.f;
#pragma unroll
            for (int o = 1; o < 64; o <<= 1) { const float t = __shfl_up(g, o); if (lane >= o) g += t; }
            const float glast = readlane_f(g, 63);
            Gs[lane] = g; Gs[64 + lane] = beta; Gs[128 + lane] = __expf(g); Gs[192 + lane] = __expf(glast - g);
            if (lane == 0) GL[item] = __expf(glast);
        }
        __syncthreads();
        G1_ROWLOAD(item + G);
        if (tid < 384) {
#pragma unroll
            for (int rr = 0; rr < 8; ++rr) {
                const int row = 8 * rb + rr;
                const float beta = Gs[64 + row], eG = Gs[128 + row];
                if (part == 0) {
                    const float sc = rn[rr] * 0.08838834764831845f;
                    float q[8];
#pragma unroll
                    for (int e = 0; e < 8; ++e) q[e] = val[rr][e] * sc;
                    u32x4 w; w.x = pk2(q[0], q[1]); w.y = pk2(q[2], q[3]); w.z = pk2(q[4], q[5]); w.w = pk2(q[6], q[7]);
                    *(LAS u32x4*)(Qs + row * 272 + l16 * 16) = w;
                    bf16_t* qg = (bf16_t*)(ib + 49152) + row * 128;
                    u32x2 g0, g1; g0.x = pk2(q[0] * eG, q[1] * eG); g0.y = pk2(q[2] * eG, q[3] * eG); g1.x = pk2(q[4] * eG, q[5] * eG); g1.y = pk2(q[6] * eG, q[7] * eG);
                    *(u32x2*)(qg + ppos(8 * l16)) = g0; *(u32x2*)(qg + ppos(8 * l16 + 4)) = g1;
                    val[rr][0] = 0.f;
                } else if (part == 1) {
#pragma unroll
                    for (int e = 0; e < 8; ++e) val[rr][e] *= rn[rr];
                    u32x4 w; w.x = pk2(val[rr][0], val[rr][1]); w.y = pk2(val[rr][2], val[rr][3]); w.z = pk2(val[rr][4], val[rr][5]); w.w = pk2(val[rr][6], val[rr][7]);
                    *(LAS u32x4*)(Ks + row * 272 + l16 * 16) = w;
                }
            }
            if (part >= 1) {
                float bsc[8], ksc[8];
#pragma unroll
                for (int rr = 0; rr < 8; ++rr) { const int row = 8 * rb + rr; const float beta = Gs[64 + row]; bsc[rr] = (part == 1) ? beta * Gs[128 + row] : beta; ksc[rr] = Gs[192 + row]; }
                LAS unsigned char* Tt = (part == 1) ? KBt : VBt;
#pragma unroll
                for (int e = 0; e < 8; ++e) {
                    const int dch = 8 * l16 + e;
                    u32x4 w; w.x = pk2(val[0][e] * bsc[0], val[1][e] * bsc[1]); w.y = pk2(val[2][e] * bsc[2], val[3][e] * bsc[3]);
                    w.z = pk2(val[4][e] * bsc[4], val[5][e] * bsc[5]); w.w = pk2(val[6][e] * bsc[6], val[7][e] * bsc[7]);
                    *(LAS u32x4*)(Tt + dch * 144 + rb * 16) = w;
                    if (part == 1) {
                        bf16_t* kd = (bf16_t*)(ib + 65536) + dch * 64;
                        u32x2 k0, k1; k0.x = pk2(val[0][e] * ksc[0], val[1][e] * ksc[1]); k0.y = pk2(val[2][e] * ksc[2], val[3][e] * ksc[3]);
                        k1.x = pk2(val[4][e] * ksc[4], val[5][e] * ksc[5]); k1.y = pk2(val[6][e] * ksc[6], val[7][e] * ksc[7]);
                        *(u32x2*)(kd + ppos(8 * rb)) = k0; *(u32x2*)(kd + ppos(8 * rb + 4)) = k1;
                    }
                }
            }
        }
        __syncthreads();
        {
            const int mt = wid & 3; const bool isqk = wid >= 4;
            LAS unsigned char* As = isqk ? Qs : Ks;
            f32x4 acc[4];
#pragma unroll
            for (int nt = 0; nt < 4; ++nt) acc[nt] = (f32x4){0.f, 0.f, 0.f, 0.f};
#pragma unroll
            for (int ks = 0; ks < 4; ++ks) {
                const bf16x8 a = *(const LAS bf16x8*)(As + (16 * mt + fr) * 272 + (32 * ks + 8 * fq) * 2);
#pragma unroll
                for (int nt = 0; nt < 4; ++nt) {
                    const bf16x8 bfr = *(const LAS bf16x8*)(Ks + (16 * nt + fr) * 272 + (32 * ks + 8 * fq) * 2);
                    acc[nt] = MFMA16(a, bfr, acc[nt]);
                }
            }
#pragma unroll
            for (int nt = 0; nt < 4; ++nt) {
                const int cp = 16 * nt + fr; const float Gc2 = Gs[cp];
#pragma unroll
                for (int i = 0; i < 4; ++i) {
                    const int cr = 16 * mt + 4 * fq + i;
                    const float dec = __expf(Gs[cr] - Gc2);
                    if (!isqk) A32[cr * 65 + cp] = (cr > cp) ? Gs[64 + cr] * acc[nt][i] * dec : 0.f;
                    else *(LAS bf16_t*)(QKs + (cr * 64 + ppos(cp)) * 2) = f2bf((cr >= cp) ? acc[nt][i] * dec : 0.f);
                }
            }
        }
        __syncthreads();
        {
            float a[64];
#pragma unroll
            for (int jj = 0; jj < 64; ++jj) a[jj] = A32[lane * 65 + jj];
            float x[8];
#pragma unroll
            for (int cc = 0; cc < 8; ++cc) x[cc] = (lane == 8 * wid + cc) ? 1.f : 0.f;
#pragma unroll
            for (int jj = 0; jj < 64; ++jj) {
                if (jj >= 8 * wid) {
#pragma unroll
                    for (int cc = 0; cc < 8; ++cc) { const float xj = readlane_f(x[cc], jj); x[cc] -= a[jj] * xj; }
                }
            }
            u32x4 w; w.x = pk2(x[0], x[1]); w.y = pk2(x[2], x[3]); w.z = pk2(x[4], x[5]); w.w = pk2(x[6], x[7]);
            *(LAS u32x4*)(Ts + lane * 144 + wid * 16) = w;
            *(u32x4*)(ib + 81920 + tid * 16) = *(const LAS u32x4*)(QKs + tid * 16);
        }
        __syncthreads();
        {
            const bool isw = wid >= 4; const int n0 = 32 * (wid & 3);
            LAS unsigned char* Bs = isw ? KBt : VBt;
            f32x4 acc[4][2];
#pragma unroll
            for (int mt = 0; mt < 4; ++mt) { acc[mt][0] = (f32x4){0.f, 0.f, 0.f, 0.f}; acc[mt][1] = (f32x4){0.f, 0.f, 0.f, 0.f}; }
#pragma unroll
            for (int ks = 0; ks < 2; ++ks) {
                bf16x8 bfr[2];
#pragma unroll
                for (int nn = 0; nn < 2; ++nn) bfr[nn] = *(const LAS bf16x8*)(Bs + (n0 + 16 * nn + fr) * 144 + (32 * ks + 8 * fq) * 2);
#pragma unroll
                for (int mt = 0; mt < 4; ++mt) {
                    const bf16x8 a = *(const LAS bf16x8*)(Ts + (16 * mt + fr) * 144 + (32 * ks + 8 * fq) * 2);
                    acc[mt][0] = MFMA16(a, bfr[0], acc[mt][0]); acc[mt][1] = MFMA16(a, bfr[1], acc[mt][1]);
                }
            }
            if (!isw) {
                float* U = (float*)ib;
#pragma unroll
                for (int mt = 0; mt < 4; ++mt)
#pragma unroll
                    for (int nn = 0; nn < 2; ++nn) *(f32x4*)(U + (n0 + 16 * nn + fr) * 64 + 16 * mt + 4 * fq) = acc[mt][nn];
            } else {
#pragma unroll
                for (int mt = 0; mt < 4; ++mt)
#pragma unroll
                    for (int nn = 0; nn < 2; ++nn)
#pragma unroll
                        for (int i = 0; i < 4; ++i) *(LAS bf16_t*)(Qs + ((16 * mt + 4 * fq + i) * 128 + ppos(n0 + 16 * nn + fr)) * 2) = f2bf(acc[mt][nn][i]);
            }
        }
        __syncthreads();
        {
            *(u32x4*)(ib + 32768 + tid * 16) = *(const LAS u32x4*)(Qs + tid * 16);
            *(u32x4*)(ib + 32768 + 8192 + tid * 16) = *(const LAS u32x4*)(Qs + 8192 + tid * 16);
        }
        __syncthreads();
    }
}

DI void phase_scan(const Params& P, LAS unsigned char* lds, int layer) {
    int tid_ = threadIdx.x; asm volatile("" : "+v"(tid_)); const int tid = tid_, wid = __builtin_amdgcn_readfirstlane(tid >> 6), lane = tid & 63, G = gridDim.x;
    const int fr = lane & 15, fq = lane >> 4;
    unsigned char* ws = P.ws;
    const int j = layer >> 1;
    const bf16_t* proj = (const bf16_t*)(ws + WS_PROJ);
    const float* GL = (const float*)(ws + WS_GL);
    bf16_t* ORAW = (bf16_t*)(ws + WS_ORAWB);
    constexpr int BUFB = 57344;
    LAS float* red = (LAS float*)(lds + 2 * BUFB);

    if (G >= 192 && (int)blockIdx.x >= 160) { convert_cache(P, j, 160, G - 160); return; }
    for (int seq = blockIdx.x; seq < 160; seq += G) {
        int b, h, nch, item0, row0, nvalid; float* stout;
        f32x4 st[8];
        const int dvc = 16 * wid + fr;
        if (seq < 32) {
            b = seq >> 3; h = seq & 7; nch = 128; item0 = seq * 128; row0 = b * TP; nvalid = 64;
            stout = P.out + OFF_STP + ((size_t)(j * 4 + b) * 8 + h) * 16384;
#pragma unroll
            for (int mt = 0; mt < 8; ++mt) st[mt] = (f32x4){0.f, 0.f, 0.f, 0.f};
        } else {
            const int s = seq - 32; b = s >> 3; h = s & 7; nch = 1; item0 = NITEM_P + s; row0 = MP + b * TS; nvalid = TS;
            stout = P.out + OFF_STS + ((size_t)(j * 16 + b) * 8 + h) * 16384;
            const float* s0 = P.in[4] + ((size_t)(j * 16 + b) * 8 + h) * 16384;
            const unsigned s0o = (unsigned)(4 * fq * 128 + dvc);
#pragma unroll
            for (int mt = 0; mt < 8; ++mt)
#pragma unroll
                for (int i = 0; i < 4; ++i) st[mt][i] = s0[(unsigned)((16 * mt + i) * 128) + s0o];
        }
        const float onw = P.in[16][j * 128 + dvc];
        f32x4 un[4];
#define SCAN_G2L(itm, bufi, LN) do { const unsigned char* _ib = ws + WS_R1 + (size_t)(itm) * ITEM_BYTES + 32768; \
            _Pragma("unroll") for (int _p = 0; _p < 7; ++_p) { const int _L = (wid + 8 * _p) * 1024 + (LN) * 16; unsigned _src; \
                if (_p < 4) { const int _row = _L >> 8, _ch = (_L >> 4) & 15; _src = (_L & ~255) + ((_ch ^ (_row & 15)) << 4); } \
                else { const int _a = _L - 32768, _row = _a >> 7, _ch = (_a >> 4) & 7; _src = 32768 + (_a & ~127) + ((_ch ^ ((_row >> 1) & 7)) << 4); } \
                g2l16(_ib + _src, lds_u32(lds + (bufi) * BUFB + (wid + 8 * _p) * 1024)); } } while (0)
#define SCAN_LOADU(itm) do { const float* _u = (const float*)(ws + WS_R1 + (size_t)(itm) * ITEM_BYTES); const unsigned _uo = (unsigned)((16 * wid + fr) * 64 + 4 * fq); \
            _Pragma("unroll") for (int _m = 0; _m < 4; ++_m) un[_m] = *(const f32x4*)(_u + (unsigned)(16 * _m) + _uo); } while (0)
        __syncthreads();
        SCAN_G2L(item0, 0, lane);
        SCAN_LOADU(item0);
        float gln = GL[item0];
        asm volatile("s_waitcnt vmcnt(0)" ::: "memory");
        __syncthreads();
        for (int c = 0; c < nch; ++c) {
            int frq = lane; asm volatile("" : "+v"(frq));
            const int fr = frq & 15, fq = frq >> 4;
            LAS unsigned char* bb = lds + (c & 1) * BUFB;
            const float gl = gln;
            f32x4 u[4];
#pragma unroll
            for (int mt = 0; mt < 4; ++mt) u[mt] = un[mt];
            if (c + 1 < nch) { gln = GL[item0 + c + 1]; SCAN_G2L(item0 + c + 1, (c + 1) & 1, frq); SCAN_LOADU(item0 + c + 1); }
            const int x16 = fr << 4, x8 = ((fr >> 1) & 7) << 4;
            bf16x8 sf[4];
#pragma unroll
            for (int ks = 0; ks < 4; ++ks) {
                u32x4 w; w.x = pk2(-st[2 * ks][0], -st[2 * ks][1]); w.y = pk2(-st[2 * ks][2], -st[2 * ks][3]); w.z = pk2(-st[2 * ks + 1][0], -st[2 * ks + 1][1]); w.w = pk2(-st[2 * ks + 1][2], -st[2 * ks + 1][3]);
                sf[ks] = __builtin_bit_cast(bf16x8, w);
            }
            bf16x8 fa[4], fb[4];
#define SC_LD256(dst, base, mt) do { _Pragma("unroll") for (int _k = 0; _k < 4; ++_k) \
                dst[_k] = *(const LAS bf16x8*)(bb + (base) + (16 * (mt) + fr) * 256 + ((((4 * _k + fq) << 4)) ^ x16)); } while (0)
#define SC_LD128(dst, base, mtlo) do { _Pragma("unroll") for (int _m = 0; _m < 2; ++_m) _Pragma("unroll") for (int _k = 0; _k < 2; ++_k) \
                dst[_m * 2 + _k] = *(const LAS bf16x8*)(bb + (base) + (16 * ((mtlo) + _m) + fr) * 128 + ((((4 * _k + fq) << 4)) ^ x8)); } while (0)
#define SC_SB __builtin_amdgcn_sched_barrier(0)
#define SC_MU(f, mt) do { _Pragma("unroll") for (int _k = 0; _k < 4; ++_k) u[mt] = MFMA16(f[_k], sf[_k], u[mt]); } while (0)
#define SC_MO(f, mt) do { _Pragma("unroll") for (int _k = 0; _k < 4; ++_k) o[mt] = MFMA16(f[_k], sf[_k], o[mt]); } while (0)
#define SC_MQK(f, mtlo) do { _Pragma("unroll") for (int _m = 0; _m < 2; ++_m) _Pragma("unroll") for (int _k = 0; _k < 2; ++_k) o[(mtlo) + _m] = MFMA16(f[_m * 2 + _k], uf[_k], o[(mtlo) + _m]); } while (0)
#define SC_MKD(f, mtlo) do { _Pragma("unroll") for (int _m = 0; _m < 2; ++_m) { st[(mtlo) + _m] = st[(mtlo) + _m] * gl; _Pragma("unroll") for (int _k = 0; _k < 2; ++_k) st[(mtlo) + _m] = MFMA16(f[_m * 2 + _k], uf[_k], st[(mtlo) + _m]); } } while (0)
            f32x4 o[4];
#pragma unroll
            for (int mt = 0; mt < 4; ++mt) o[mt] = (f32x4){0.f, 0.f, 0.f, 0.f};
            SC_LD256(fa, 0, 0); SC_LD256(fb, 0, 1); SC_SB;
            SC_MU(fa, 0); SC_LD256(fa, 0, 2); SC_SB;
            SC_MU(fb, 1); SC_LD256(fb, 0, 3); SC_SB;
            SC_MU(fa, 2); SC_LD256(fa, 16384, 0); SC_SB;
            SC_MU(fb, 3); SC_LD256(fb, 16384, 1); SC_SB;
#pragma unroll
            for (int ks = 0; ks < 4; ++ks) sf[ks] = sf[ks] ^ (short)0x8000;
            SC_MO(fa, 0); SC_LD256(fa, 16384, 2); SC_SB;
            SC_MO(fb, 1); SC_LD256(fb, 16384, 3); SC_SB;
            SC_MO(fa, 2); SC_LD128(fa, 49152, 0); SC_SB;
            SC_MO(fb, 3); SC_LD128(fb, 49152, 2); SC_SB;
            bf16x8 uf[2];
#pragma unroll
            for (int k2 = 0; k2 < 2; ++k2) {
                u32x4 w; w.x = pk2(u[2 * k2][0], u[2 * k2][1]); w.y = pk2(u[2 * k2][2], u[2 * k2][3]); w.z = pk2(u[2 * k2 + 1][0], u[2 * k2 + 1][1]); w.w = pk2(u[2 * k2 + 1][2], u[2 * k2 + 1][3]);
                uf[k2] = __builtin_bit_cast(bf16x8, w);
            }
            SC_MQK(fa, 0); SC_LD128(fa, 32768, 0); SC_SB;
            SC_MQK(fb, 2); SC_LD128(fb, 32768, 2); SC_SB;
            SC_MKD(fa, 0); SC_LD128(fa, 32768, 4); SC_SB;
            SC_MKD(fb, 2); SC_LD128(fb, 32768, 6); SC_SB;
            SC_MKD(fa, 4); SC_SB;
            SC_MKD(fb, 6);
#undef SC_MU
#undef SC_MO
#undef SC_MQK
#undef SC_MKD
#undef SC_LD256
#undef SC_LD128
#undef SC_SB
            {
                bf16_t* obb = ORAW + (size_t)(row0 + 64 * c) * 1024 + h * 128;
                const unsigned oo = (unsigned)(4 * fq * 1024 + 16 * wid + fr);
#pragma unroll
                for (int mt = 0; mt < 4; ++mt)
#pragma unroll
                    for (int i = 0; i < 4; ++i) {
                        const int lr = 16 * mt + 4 * fq + i;
                        const bf16_t ob = f2bf(o[mt][i]);
                        if (lr < nvalid) obb[(unsigned)((16 * mt + i) * 1024) + oo] = ob;
                    }
            }
            asm volatile("s_waitcnt vmcnt(0)" ::: "memory");
            __syncthreads();
        }
        {
            int lz = lane; asm volatile("" : "+v"(lz));
            const unsigned so = (unsigned)(4 * (lz >> 4) * 128 + 16 * wid + (lz & 15));
#pragma unroll
            for (int mt = 0; mt < 8; ++mt)
#pragma unroll
                for (int i = 0; i < 4; ++i) stout[(unsigned)((16 * mt + i) * 128) + so] = st[mt][i];
        }
#undef SCAN_G2L
#undef SCAN_LOADU
    }
    if (G < 192) convert_cache(P, j, 0, G);
}

DI void phase_gnorm(const Params& P, int layer) {
    int tid_ = threadIdx.x; asm volatile("" : "+v"(tid_)); const int tid = tid_, wid = __builtin_amdgcn_readfirstlane(tid >> 6), lane = tid & 63, G = gridDim.x;
    unsigned char* ws = P.ws;
    const int j = layer >> 1;
    const bf16_t* ORAW = (const bf16_t*)(ws + WS_ORAWB);
    const bf16_t* proj = (const bf16_t*)(ws + WS_PROJ);
    bf16_t* OB = (bf16_t*)(ws + WS_HBUF);
    float onw[16];
#pragma unroll
    for (int e = 0; e < 16; ++e) onw[e] = P.in[16][j * 128 + ((16 * lane + e) & 127)];
    for (int r = blockIdx.x * 8 + wid; r < M; r += G * 8) {
        const u32x4 o0 = *(const u32x4*)(ORAW + (size_t)r * 1024 + 16 * lane), o1 = *(const u32x4*)(ORAW + (size_t)r * 1024 + 16 * lane + 8);
        const u32x4 z0 = *(const u32x4*)(proj + (size_t)r * NPROJ + 3072 + 16 * lane), z1 = *(const u32x4*)(proj + (size_t)r * NPROJ + 3072 + 16 * lane + 8);
        float ov[16], zv[16];
        { float t8[8]; unpack8(o0, t8);
#pragma unroll
          for (int e = 0; e < 8; ++e) ov[e] = t8[e];
          unpack8(o1, t8);
#pragma unroll
          for (int e = 0; e < 8; ++e) ov[8 + e] = t8[e];
          unpack8(z0, t8);
#pragma unroll
          for (int e = 0; e < 8; ++e) zv[e] = t8[e];
          unpack8(z1, t8);
#pragma unroll
          for (int e = 0; e < 8; ++e) zv[8 + e] = t8[e]; }
        float ss = 0.f;
#pragma unroll
        for (int e = 0; e < 16; ++e) ss += ov[e] * ov[e];
        ss += __shfl_xor(ss, 1); ss += __shfl_xor(ss, 2); ss += __shfl_xor(ss, 4);
        const float rstd = __builtin_amdgcn_rsqf(ss * (1.f / 128.f) + RMS_EPS);
        float y[16];
#pragma unroll
        for (int e = 0; e < 16; ++e) y[e] = ov[e] * rstd * onw[e] * siluf(zv[e]);
        u32x4 w0, w1;
        w0.x = pk2(y[0], y[1]); w0.y = pk2(y[2], y[3]); w0.z = pk2(y[4], y[5]); w0.w = pk2(y[6], y[7]);
        w1.x = pk2(y[8], y[9]); w1.y = pk2(y[10], y[11]); w1.z = pk2(y[12], y[13]); w1.w = pk2(y[14], y[15]);
        *(u32x4*)(OB + (size_t)r * 1024 + 16 * lane) = w0; *(u32x4*)(OB + (size_t)r * 1024 + 16 * lane + 8) = w1;
    }
}

DI void att_s(LAS unsigned char* Ka, int t, const bf16x8 (&qf)[4], f32x16& s0, f32x16& s1) {
#pragma unroll
    for (int i = 0; i < 16; ++i) { s0[i] = 0.f; s1[i] = 0.f; }
    bf16x8 kf[8];
#pragma unroll
    for (int s = 0; s < 4; ++s) { kf[2 * s] = *(const LAS bf16x8*)(Ka + (t ^ (s << 5))); kf[2 * s + 1] = *(const LAS bf16x8*)(Ka + 8192 + (t ^ (s << 5))); }
#pragma unroll
    for (int s = 0; s < 4; ++s) { s0 = MFMA32(kf[2 * s], qf[s], s0); s1 = MFMA32(kf[2 * s + 1], qf[s], s1); }
}
template <bool MASK>
DI float att_softmax(f32x16& s0, f32x16& s1, float& m, float& l, bf16x8 (&pf)[2][2], int h2, int nvk) {
    if (MASK) {
#pragma unroll
        for (int i = 0; i < 16; ++i) {
            const int key = (i & 3) + 8 * (i >> 2) + 4 * h2;
            s0[i] = (key < nvk) ? s0[i] : -INFINITY;
            s1[i] = (32 + key < nvk) ? s1[i] : -INFINITY;
        }
    }
    float mx = s0[0];
#pragma unroll
    for (int i = 1; i < 16; ++i) mx = fmaxf(mx, s0[i]);
#pragma unroll
    for (int i = 0; i < 16; ++i) mx = fmaxf(mx, s1[i]);
    mx = fmaxf(mx, __shfl_xor(mx, 32));
    const float mn = fmaxf(m, mx);
    const float alpha = __builtin_amdgcn_exp2f(m - mn);
    m = mn;
    float ps = 0.f;
#pragma unroll
    for (int i = 0; i < 16; ++i) { s0[i] = __builtin_amdgcn_exp2f(s0[i] - mn); s1[i] = __builtin_amdgcn_exp2f(s1[i] - mn); ps += s0[i] + s1[i]; }
    l = l * alpha + ps;
    u32x4 w;
    w.x = pk2(s0[0], s0[1]); w.y = pk2(s0[2], s0[3]); w.z = pk2(s0[4], s0[5]); w.w = pk2(s0[6], s0[7]); pf[0][0] = __builtin_bit_cast(bf16x8, w);
    w.x = pk2(s0[8], s0[9]); w.y = pk2(s0[10], s0[11]); w.z = pk2(s0[12], s0[13]); w.w = pk2(s0[14], s0[15]); pf[0][1] = __builtin_bit_cast(bf16x8, w);
    w.x = pk2(s1[0], s1[1]); w.y = pk2(s1[2], s1[3]); w.z = pk2(s1[4], s1[5]); w.w = pk2(s1[6], s1[7]); pf[1][0] = __builtin_bit_cast(bf16x8, w);
    w.x = pk2(s1[8], s1[9]); w.y = pk2(s1[10], s1[11]); w.z = pk2(s1[12], s1[13]); w.w = pk2(s1[14], s1[15]); pf[1][1] = __builtin_bit_cast(bf16x8, w);
    return alpha;
}
DI void att_pv(LAS unsigned char* Va, int q4, f32x16 (&O)[4], const bf16x8 (&pf)[2][2]) {
    s16x4 lo[16], hi[16];
#define PV_LD(i) do { LAS unsigned char* _vp = Va + ((((i) >> 2) ^ q4) << 6) + (32 * (((i) >> 1) & 1) + 16 * ((i) & 1)) * 256; \
        lo[i] = __builtin_amdgcn_ds_read_tr16_b64_v4i16((LAS s16x4*)_vp); hi[i] = __builtin_amdgcn_ds_read_tr16_b64_v4i16((LAS s16x4*)(_vp + 8 * 256)); } while (0)
    PV_LD(0); PV_LD(1); PV_LD(2);
#pragma unroll
    for (int i = 0; i < 16; ++i) {
        if (i + 3 < 16) PV_LD(i + 3);
        const bf16x8 vf = __builtin_shufflevector(lo[i], hi[i], 0, 1, 2, 3, 4, 5, 6, 7);
        O[i >> 2] = MFMA32(vf, pf[(i >> 1) & 1][i & 1], O[i >> 2]);
    }
#undef PV_LD
}

DI void phase_attn(const Params& P, LAS unsigned char* lds, int layer) {
    int tid_ = threadIdx.x; asm volatile("" : "+v"(tid_)); const int tid = tid_, wid = __builtin_amdgcn_readfirstlane(tid >> 6), lane = tid & 63, G = gridDim.x;
    unsigned char* ws = P.ws;
    const int j = layer >> 1;
    const int comp = wid >> 2, rg = wid & 3, r32 = lane & 31, h2 = lane >> 5;
    const bf16_t* proj = (const bf16_t*)(ws + WS_PROJ);
    bf16_t* OB = (bf16_t*)(ws + WS_HBUF);
    const float lam_init = 0.8f - 0.6f * expf(-0.3f * (float)layer);
    float lam;
    {
        float d1 = 0.f, d2 = 0.f;
        for (int i = 0; i < 64; ++i) { d1 += P.in[19][j * 64 + i] * P.in[20][j * 64 + i]; d2 += P.in[21][j * 64 + i] * P.in[22][j * 64 + i]; }
        lam = expf(d1) - expf(d2) + lam_init;
    }
    const float* subln = P.in[23] + j * 128;
    constexpr int TB = 32768;
    const int vb = (G % 8 == 0) ? (blockIdx.x % 8) * (G / 8) + blockIdx.x / 8 : blockIdx.x;
    const int nrounds = (G == 256) ? 9 : (2176 + G - 1) / G;
#define ATT_WAITV(n) asm volatile("s_waitcnt vmcnt(" #n ")" ::: "memory")
#define ATT_BAR() do { asm volatile("" ::: "memory"); __builtin_amdgcn_s_barrier(); asm volatile("" ::: "memory"); } while (0)
    for (int k = 0; k < nrounds; ++k) {
        int id;
        if (G == 256) {
            if (k < 8) { const int xcd = vb >> 5, idx = vb & 31; const int seq = xcd * 4 + (k >> 1); const int qt = (k & 1) ? idx : (63 - idx); id = seq * 64 + qt; }
            else { if (vb >= 128) break; id = 2048 + vb; }
        } else { id = vb + k * G; if (id >= 2176) break; }
        int h, qrow0, nt_all, nt_mine, last_valid; const int kvstride = 128; const bf16_t* Kp; const bf16_t* Vp; bool sample;
        if (id < 2048) {
            const int seq = id >> 6, qt = id & 63, b = seq >> 3; h = seq & 7; sample = false;
            qrow0 = b * TP + 128 * qt + 32 * rg; nt_all = 2 * qt + 2; nt_mine = (rg < 2) ? 2 * qt + 1 : 2 * qt + 2; last_valid = 64 * nt_mine;
            Kp = (const bf16_t*)(ws + WS_KH) + (size_t)seq * TP * 128; Vp = (const bf16_t*)(ws + WS_VH) + (size_t)seq * TP * 128;
        } else {
            const int s = id - 2048, b = s >> 3; h = s & 7; sample = true;
            qrow0 = MP + b * TS; nt_all = 34; nt_mine = (rg == 0) ? 34 : 0; last_valid = PAST + TS;
            Kp = (const bf16_t*)(ws + WS_KS) + (size_t)s * KSROWS * 128; Vp = (const bf16_t*)(ws + WS_VS) + (size_t)s * KSROWS * 128;
        }
        bf16x8 qf[4];
        {
            const int qr = qrow0 + (sample ? (r32 & 15) : r32);
            const bf16_t* qp = proj + (size_t)qr * NPROJ + h * 128 + comp * 64 + 8 * h2;
#pragma unroll
            for (int s = 0; s < 4; ++s) qf[s] = *(const bf16x8*)(qp + 16 * s);
        }
        f32x16 O[4];
#pragma unroll
        for (int et = 0; et < 4; ++et)
#pragma unroll
            for (int i = 0; i < 16; ++i) O[et][i] = 0.f;
        float m = -INFINITY, l = 0.f;
        bf16x8 pf[2][2];
#pragma unroll
        for (int a = 0; a < 2; ++a)
#pragma unroll
            for (int c2 = 0; c2 < 2; ++c2) pf[a][c2] = (bf16x8){0, 0, 0, 0, 0, 0, 0, 0};
        f32x16 sA0, sA1, sB0, sB1;
        const bf16_t* gsrc;
        {
            const int rowl = lane >> 4, c = lane & 15;
            const int row0 = 16 * (wid & 3) + rowl;
            const int lc = (wid < 4) ? (c ^ (row0 & 15)) : (c ^ ((row0 & 3) << 2));
            gsrc = ((wid < 4) ? Kp : Vp) + (size_t)row0 * kvstride + lc * 8;
        }
#define ATT_G2L(kt, bufi) do { _Pragma("unroll") for (int _i = 0; _i < 4; ++_i) { \
            const bf16_t* _s = gsrc + (size_t)(64 * (kt) + 4 * _i) * kvstride; \
            if (wid < 4) _s += (((lane & 15) ^ ((16 * (wid & 3) + 4 * _i + (lane >> 4)) & 15)) - ((lane & 15) ^ ((16 * (wid & 3) + (lane >> 4)) & 15))) * 8; \
            g2l16(_s, lds_u32(lds + (bufi) * TB + (4 * wid + _i) * 1024)); } } while (0)
        ATT_G2L(0, 0);
        if (nt_all > 1) ATT_G2L(1, 1);
        asm volatile("" :: "v"(qf[0]), "v"(qf[1]), "v"(qf[2]), "v"(qf[3]));
        if (nt_all > 1) { ATT_WAITV(4); } else { ATT_WAITV(0); }
        ATT_BAR();
        {
            const int koff = r32 * 256, t = ((comp * 8 + h2) ^ (r32 & 15)) << 4;
            att_s(lds + koff, t, qf, sA0, sA1);
        }
#define ATT_ITER(KT, sC0, sC1, sN0, sN1, EDGE) do { \
            const int kt = (KT); \
            int lo_ = lane; asm volatile("" : "+v"(lo_)); \
            const int r32_ = lo_ & 31, h2_ = lo_ >> 5, q4_ = (lo_ & 15) >> 2, p4_ = lo_ & 3, blk_ = (lo_ >> 4) & 1; \
            const int koff_ = r32_ * 256, t_ = ((comp * 8 + h2_) ^ (r32_ & 15)) << 4; \
            const int voff_ = (4 * h2_ + q4_) * 256 + (2 * blk_ + (p4_ >> 1)) * 16 + (p4_ & 1) * 8; \
            ATT_WAITV(0); ATT_BAR(); \
            if (kt + 2 < nt_all) ATT_G2L(kt + 2, (kt + 2) & 3); \
            att_s(lds + ((kt + 1) & 3) * TB + koff_, t_, qf, sN0, sN1); \
            if (!(EDGE) || kt >= 1) att_pv(lds + ((kt - 1) & 3) * TB + 16384 + voff_, q4_, O, pf); \
            const float alpha = att_softmax<EDGE>(sC0, sC1, m, l, pf, h2_, last_valid - 64 * kt); \
            asm volatile("" :: "v"(l), "v"(pf[0][0]), "v"(pf[0][1]), "v"(pf[1][0]), "v"(pf[1][1]));     \
            _Pragma("unroll") for (int _g = 0; _g < 24; ++_g) { __builtin_amdgcn_sched_group_barrier(0x008, 1, 0); __builtin_amdgcn_sched_group_barrier(0x002, 7, 0); } \
            if (__any(alpha != 1.f)) { \
                _Pragma("unroll") for (int et = 0; et < 4; ++et) _Pragma("unroll") for (int i = 0; i < 16; ++i) O[et][i] *= alpha; } \
            } while (0)
        {
            const int npairs = nt_all >> 1;
            ATT_ITER(0, sA0, sA1, sB0, sB1, true);
            ATT_ITER(1, sB0, sB1, sA0, sA1, true);
            for (int pp = 1; pp < npairs - 1; ++pp) {
                ATT_ITER(2 * pp, sA0, sA1, sB0, sB1, false);
                ATT_ITER(2 * pp + 1, sB0, sB1, sA0, sA1, false);
            }
            if (npairs > 1) {
                ATT_ITER(nt_all - 2, sA0, sA1, sB0, sB1, true);
                ATT_ITER(nt_all - 1, sB0, sB1, sA0, sA1, true);
            }
        }
        {
            const int lt = nt_all - 1;
            const int h2b = lane >> 5, q4 = (lane & 15) >> 2, p4 = lane & 3, blk = (lane >> 4) & 1;
            const int voff = (4 * h2b + q4) * 256 + (2 * blk + (p4 >> 1)) * 16 + (p4 & 1) * 8;
            att_pv(lds + (lt & 3) * TB + 16384 + voff, q4, O, pf);
        }
        __syncthreads();
#undef ATT_ITER
#undef ATT_G2L
        const float lt = l + __shfl_xor(l, 32);
        const float inv = (nt_mine > 0) ? 1.f / lt : 0.f;
        LAS float* XO = (LAS float*)lds;
        if (comp == 1) {
            const float sc = inv * lam;
#pragma unroll
            for (int et = 0; et < 4; ++et)
#pragma unroll
                for (int i = 0; i < 16; ++i) XO[(rg * 128 + 32 * et + (i & 3) + 8 * (i >> 2) + 4 * h2) * 32 + r32] = O[et][i] * sc;
        }
        __syncthreads();
        if (comp == 0 && nt_mine > 0) {
            float ss = 0.f;
#pragma unroll
            for (int et = 0; et < 4; ++et)
#pragma unroll
                for (int i = 0; i < 16; ++i) { const float v = O[et][i] * inv - XO[(rg * 128 + 32 * et + (i & 3) + 8 * (i >> 2) + 4 * h2) * 32 + r32]; O[et][i] = v; ss += v * v; }
            ss += __shfl_xor(ss, 32);
            const float rstd = __builtin_amdgcn_rsqf(ss * (1.f / 128.f) + RMS_EPS) * (1.f - lam_init);
            const bool rvalid = sample ? (r32 < TS) : true;
            const int row = qrow0 + r32;
            if (rvalid) {
#pragma unroll
                for (int et = 0; et < 4; ++et)
#pragma unroll
                    for (int g4 = 0; g4 < 4; ++g4) {
                        const int e0 = 32 * et + 8 * g4 + 4 * h2;
                        const u32x2 zz = *(const u32x2*)(proj + (size_t)row * NPROJ + 3072 + h * 128 + e0);
                        const f32x4 sl = *(const f32x4*)(subln + e0);
                        const float z0 = __uint_as_float(zz.x << 16), z1 = __uint_as_float(zz.x & 0xffff0000u), z2 = __uint_as_float(zz.y << 16), z3 = __uint_as_float(zz.y & 0xffff0000u);
                        u32x2 w;
                        w.x = pk2(O[et][4 * g4] * rstd * sl[0] * siluf(z0), O[et][4 * g4 + 1] * rstd * sl[1] * siluf(z1));
                        w.y = pk2(O[et][4 * g4 + 2] * rstd * sl[2] * siluf(z2), O[et][4 * g4 + 3] * rstd * sl[3] * siluf(z3));
                        *(u32x2*)(OB + (size_t)row * 1024 + h * 128 + e0) = w;
                    }
            }
        }
        __syncthreads();
    }
}


#define XB_TMO      128
#define XB_XCNT(j)  (256  + 64 * (j))
#define XB_XSUB(j)  (1280 + 64 * (j))
#define XB_XGEN(j)  (2304 + 64 * (j))
#define XB_TOP      3328
#define XB_TOPGEN   3392
#define XCD_BAR_WORDS 3456
#define XB_SPIN_CAP (1u << 18)
DI unsigned xb_ld(unsigned* p)              { return __hip_atomic_load(p, __ATOMIC_RELAXED, __HIP_MEMORY_SCOPE_AGENT); }
DI unsigned xb_add(unsigned* p, unsigned v) { return __hip_atomic_fetch_add(p, v, __ATOMIC_RELAXED, __HIP_MEMORY_SCOPE_AGENT); }
DI unsigned xb_xcc_id() { return (unsigned)__builtin_amdgcn_s_getreg((3 << 11) | 20) & 0xFu; }
#define XB_SPIN(cond, bar) do { unsigned _sp = 0; while (cond) { __builtin_amdgcn_s_sleep(1); \
    if ((++_sp & 255u) == 0u) { if (xb_ld(&(bar)[XB_TMO])) break; if (_sp > XB_SPIN_CAP) { atomicAdd(&(bar)[XB_TMO], 1u); break; } } } } while (0)
DI void xcd_barrier_complete(unsigned* bar, unsigned x, unsigned& nloc, unsigned& nx) {
    const unsigned G = gridDim.x * gridDim.y * gridDim.z;
    unsigned sum, cnt, mine, sp = 0u;
    for (;;) {
        sum = 0u; cnt = 0u; mine = 0u;
#pragma unroll
        for (unsigned j = 0; j < 16; ++j) { const unsigned c = xb_ld(&bar[XB_XCNT(j)]); sum += c; cnt += (c > 0u) ? 1u : 0u; mine = (j == x) ? c : mine; }
        if (sum == G) break;
        __builtin_amdgcn_s_sleep(1);
        if ((++sp & 255u) == 0u) { if (xb_ld(&bar[XB_TMO])) break; if (sp > XB_SPIN_CAP) { atomicAdd(&bar[XB_TMO], 1u); break; } }
    }
    nloc = mine > 0u ? mine : 1u; nx = cnt > 0u ? cnt : 1u;
}
DI void xcd_barrier(unsigned* bar, volatile LAS unsigned* st) {
    asm volatile("s_waitcnt vmcnt(0)" ::: "memory");
    __syncthreads();
    if (threadIdx.x == 0) {
        const unsigned x = xb_xcc_id();
        __builtin_amdgcn_s_waitcnt(0);
        unsigned nloc = st[0], nx = st[1];
        if (nloc == 0u) { xcd_barrier_complete(bar, x, nloc, nx); st[0] = nloc; st[1] = nx; }
        const unsigned old = xb_add(&bar[XB_XSUB(x)], 1u);
        const unsigned gen = old / nloc;
        if (old + 1u == (gen + 1u) * nloc) {
            __builtin_amdgcn_fence(__ATOMIC_RELEASE, "agent");
            asm volatile("s_waitcnt vmcnt(0)" ::: "memory");
            const unsigned og = xb_add(&bar[XB_TOP], 1u);
            const unsigned tg = og / nx;
            if (og + 1u == (tg + 1u) * nx) xb_add(&bar[XB_TOPGEN], 1u);
            else XB_SPIN(xb_ld(&bar[XB_TOPGEN]) == tg, bar);
            __builtin_amdgcn_fence(__ATOMIC_ACQUIRE, "agent");
            xb_add(&bar[XB_XGEN(x)], 1u);
            asm volatile("s_waitcnt vmcnt(0)" ::: "memory");
        } else {
            XB_SPIN(xb_ld(&bar[XB_XGEN(x)]) == gen, bar);
            __builtin_amdgcn_fence(__ATOMIC_ACQUIRE, "agent");
            asm volatile("s_waitcnt vmcnt(0)" ::: "memory");
        }
    }
    __syncthreads();
}

typedef const __attribute__((address_space(4))) Params* CParP;
#define LOADP() Params P; { CParP kp_ = KP; asm volatile("" : "+s"(kp_)); P = *kp_; } unsigned char* ws = P.ws; (void)ws
__global__ void __launch_bounds__(512, 2) fwd_megakernel(Params Pin) {
#if defined(__HIP_DEVICE_COMPILE__)
    extern __shared__ __attribute__((aligned(16))) unsigned char lds_raw[];
    LAS unsigned char* lds = (LAS unsigned char*)lds_raw;
    cg::grid_group grid = cg::this_grid();
    const CParP KP = (CParP)__builtin_amdgcn_kernarg_segment_ptr();
    volatile LAS unsigned* xst = (volatile LAS unsigned*)(lds + 131072);
    if (threadIdx.x == 0) { xst[0] = 0u; xst[1] = 0u; }
    __syncthreads();
    { LOADP(); if (threadIdx.x == 0) (void)xb_add(&((unsigned*)(ws + WS_BAR))[XB_XCNT(xb_xcc_id())], 1u); }
#define GRID_BAR() do { LOADP(); xcd_barrier((unsigned*)(ws + WS_BAR), xst); } while (0)
    { LOADP(); phase_prep(P, lds); }
    grid.sync();
    for (int layer = 0; layer < 4; ++layer) {
        const int j = layer >> 1;
        { LOADP(); phase_elem(P, lds, layer); }
        GRID_BAR();
        {
            LOADP();
            pg8::StaticOrder S; S.init(M, NPROJ, gridDim.x, blockIdx.x);
            pg8::Gemm g;
            g.A = (const bf16_t*)(ws + WS_HBUF); g.M = M; g.N = NPROJ; g.K = 1024;
            if (!(layer & 1)) {
                g.Bt = (const bf16_t*)(ws + WS_WING) + (size_t)j * 4096 * 1024;
                EpiGdnIn E; E.proj = (bf16_t*)(ws + WS_PROJ); E.conv_p = P.out + OFF_CVP + (size_t)j * 4 * 3 * 3072; E.conv_s = P.out + OFF_CVS + (size_t)j * 16 * 3 * 3072;
                pg8::gemm_phase(lds, g, S, E);
            } else {
                g.Bt = (const bf16_t*)(ws + WS_WIND) + (size_t)j * 4096 * 1024;
                EpiDiffIn E; E.proj = (bf16_t*)(ws + WS_PROJ);
                E.k_p = P.out + OFF_KP + (size_t)j * MP * 1024; E.v_p = P.out + OFF_VP + (size_t)j * MP * 1024;
                E.k_s = P.out + OFF_KSO + (size_t)j * MS * 1024; E.v_s = P.out + OFF_VSO + (size_t)j * MS * 1024;
                E.ks = (bf16_t*)(ws + WS_KS); E.vs = (bf16_t*)(ws + WS_VS); E.kh = (bf16_t*)(ws + WS_KH); E.vh = (bf16_t*)(ws + WS_VH); E.rope = (const float*)(ws + WS_ROPE);
                pg8::gemm_phase(lds, g, S, E);
            }
        }
        GRID_BAR();
        if (!(layer & 1)) {
            { LOADP(); phase_g1(P, lds, layer); }
            GRID_BAR();
            { LOADP(); phase_scan(P, lds, layer); }
            GRID_BAR();
            { LOADP(); phase_gnorm(P, layer); }
        } else {
            { LOADP(); phase_attn(P, lds, layer); }
        }
        GRID_BAR();
        {
            LOADP();
            pg8::StaticOrder S; S.init(M, 1024, gridDim.x, blockIdx.x);
            pg8::Gemm g;
            g.A = (const bf16_t*)(ws + WS_HBUF); g.M = M; g.N = 1024; g.K = 1024;
            g.Bt = (const bf16_t*)(ws + ((layer & 1) ? WS_WOUTD : WS_WOUTG)) + (size_t)j * 1024 * 1024;
            EpiOut E; E.C = (bf16_t*)(ws + WS_PROJ);
            pg8::gemm_phase(lds, g, S, E);
        }
        GRID_BAR();
    }
    { LOADP(); phase_elem(P, lds, 4); }
#endif
}

extern "C" void kernel_launch(void* const* d_in, const int* in_sizes, int n_in, void* d_out, int out_size, void* d_ws, size_t ws_size, hipStream_t stream) {
    static int grid_blocks = 0;
    if (!grid_blocks) {
        int dev = 0, cus = 0, per_cu = 0;
        hipGetDevice(&dev);
        hipDeviceGetAttribute(&cus, hipDeviceAttributeMultiprocessorCount, dev);
        hipFuncSetAttribute((const void*)fwd_megakernel, hipFuncAttributeMaxDynamicSharedMemorySize, LDS_BYTES);
        hipOccupancyMaxActiveBlocksPerMultiprocessor(&per_cu, (const void*)fwd_megakernel, 512, LDS_BYTES);
        if (per_cu < 1) per_cu = 1;
        grid_blocks = cus * per_cu;
        if (ws_size < WS_END) fprintf(stderr, "kernel_launch: workspace too small: %zu < %zu\n", ws_size, (size_t)WS_END);
    }
    hipMemsetAsync((unsigned char*)d_ws + WS_BAR, 0, XCD_BAR_WORDS * sizeof(unsigned), stream);
    Params p{};
    for (int i = 0; i < 25; ++i) p.in[i] = (const float*)d_in[i];
    p.out = (float*)d_out; p.ws = (unsigned char*)d_ws;
    void* args[] = {&p};
    hipError_t e = hipLaunchCooperativeKernel((const void*)fwd_megakernel, dim3(grid_blocks), dim3(512), args, LDS_BYTES, stream);
    if (e != hipSuccess) fprintf(stderr, "cooperative launch failed: %s (grid %d)\n", hipGetErrorString(e), grid_blocks);
}
```

```cpp
#include <hip/hip_runtime.h>
#include <hip/hip_cooperative_groups.h>
#include <cstdio>
namespace cg = cooperative_groups;

#define DI __device__ __forceinline__
#define LAS __attribute__((address_space(3)))
typedef unsigned short bf16_t;
typedef short bf16x8 __attribute__((ext_vector_type(8)));
typedef short s16x4 __attribute__((ext_vector_type(4)));
typedef float f32x2 __attribute__((ext_vector_type(2)));
typedef float f32x4 __attribute__((ext_vector_type(4)));
typedef float f32x16 __attribute__((ext_vector_type(16)));
typedef unsigned u32x2 __attribute__((ext_vector_type(2)));
typedef unsigned u32x4 __attribute__((ext_vector_type(4)));
typedef __bf16 bf16x2_t __attribute__((ext_vector_type(2)));

#define REP_G1 1
#define REP_SCAN 1
#define REP_ATTN 1
#define REP_GIN 1
#define REP_GOUT 1
#define REP_PREP 1
DI int opaque_i(int v) { asm volatile("" : "+s"(v)); return v; }
constexpr int D = 1024, TP = 8192, BP = 4, BS = 16, TS = 16, PAST = 2048;
constexpr int MP = BP * TP, MS = BS * TS, M = MP + MS, NB = BP + BS;
constexpr int NPROJ = 4096;
constexpr int KSROWS = 2112;
constexpr int NITEM_P = 4096, NITEM = 4224;
constexpr size_t ITEM_BYTES = 90112;
constexpr float RMS_EPS = 1e-6f;
constexpr float QSCALE = 0.125f * 1.4426950408889634f;

constexpr size_t OFF_Y = 0;
constexpr size_t OFF_STP = (size_t)M * D;
constexpr size_t OFF_CVP = OFF_STP + 2ull * 4 * 8 * 128 * 128;
constexpr size_t OFF_KP = OFF_CVP + 2ull * 4 * 3 * 3072;
constexpr size_t OFF_VP = OFF_KP + 2ull * MP * 1024;
constexpr size_t OFF_STS = OFF_VP + 2ull * MP * 1024;
constexpr size_t OFF_CVS = OFF_STS + 2ull * 16 * 8 * 128 * 128;
constexpr size_t OFF_KSO = OFF_CVS + 2ull * 16 * 3 * 3072;
constexpr size_t OFF_VSO = OFF_KSO + 2ull * MS * 1024;

constexpr size_t WS_WING = 0;
constexpr size_t WS_WOUTG = WS_WING + 2ull * 4096 * 1024 * 2;
constexpr size_t WS_WIND = WS_WOUTG + 2ull * 1024 * 1024 * 2;
constexpr size_t WS_WOUTD = WS_WIND + 2ull * 4096 * 1024 * 2;
constexpr size_t WS_ADA = WS_WOUTD + 2ull * 1024 * 1024 * 2;
constexpr size_t WS_ROPE = WS_ADA + 4ull * NB * 3072 * 4;
constexpr size_t WS_AB = WS_ROPE + 8208ull * 64 * 4;
constexpr size_t WS_GL = WS_AB + (size_t)M * 16 * 4;
constexpr size_t WS_BAR = WS_GL + 17408;
constexpr size_t WS_HBUF = WS_GL + 32768;
constexpr size_t WS_ORAW = WS_HBUF + (size_t)M * 1024 * 2;
constexpr size_t WS_PROJ = WS_ORAW + 256;
constexpr size_t WS_R1 = WS_PROJ + (size_t)M * 4096 * 2;
constexpr size_t WS_KH = WS_R1;
constexpr size_t WS_VH = WS_KH + (size_t)MP * 1024 * 2;
constexpr size_t WS_ORAWB = WS_R1 + (size_t)NITEM * ITEM_BYTES;
constexpr size_t WS_KS = WS_ORAWB + (size_t)M * 1024 * 2;
constexpr size_t WS_VS = WS_KS + 16ull * KSROWS * 1024 * 2;
constexpr size_t WS_END = WS_VS + 16ull * KSROWS * 1024 * 2;

constexpr int LDS_BYTES = 131072 + 16;

struct Params { const float* in[25]; float* out; unsigned char* ws; };

DI float bf2f(bf16_t v) { return __uint_as_float(((unsigned)v) << 16); }
DI unsigned pk2(float a, float b) { f32x2 v = {a, b}; bf16x2_t r = __builtin_convertvector(v, bf16x2_t); return __builtin_bit_cast(unsigned, r); }
DI bf16_t f2bf(float a) { return (bf16_t)(pk2(a, 0.f) & 0xffffu); }
template <int CTRL> DI float dppf(float v) { return __builtin_bit_cast(float, __builtin_amdgcn_update_dpp(0, __builtin_bit_cast(int, v), CTRL, 0xf, 0xf, true)); }
DI float row_sum16(float v) { v += dppf<0x128>(v); v += dppf<0x124>(v); v += dppf<0x122>(v); v += dppf<0x121>(v); return v; }
DI float wave_sum(float v) { v = row_sum16(v); v += __shfl_xor(v, 16); v += __shfl_xor(v, 32); return v; }
DI float readlane_f(float v, int l) { return __builtin_bit_cast(float, __builtin_amdgcn_readlane(__builtin_bit_cast(int, v), l)); }
DI float siluf(float x) { return x * __builtin_amdgcn_rcpf(1.f + __expf(-x)); }
DI int ppos(int idx) { const int d5 = idx & 31; return (idx & ~31) | (((d5 >> 2) & 3) << 3) | ((d5 >> 4) << 2) | (d5 & 3); }
DI int perm64(int ls) { return (ls & 15) | (((ls >> 4) & 1) << 5) | (((ls >> 5) & 1) << 4); }
DI void unpack8(const u32x4 v, float (&o)[8]) {
#pragma unroll
    for (int i = 0; i < 4; ++i) { o[2 * i] = __uint_as_float(v[i] << 16); o[2 * i + 1] = __uint_as_float(v[i] & 0xffff0000u); }
}
DI void g2l16(const void* gptr, unsigned lds_addr) {
    asm volatile("s_mov_b32 m0, %1\n\ts_nop 0\n\tglobal_load_lds_dwordx4 %0, off" :: "v"(gptr), "s"(lds_addr) : "memory", "m0");
}
DI unsigned lds_u32(LAS unsigned char* p) { return (unsigned)(size_t)p; }
#define MFMA16(a, b, c) __builtin_amdgcn_mfma_f32_16x16x32_bf16((a), (b), (c), 0, 0, 0)
#define MFMA32(a, b, c) __builtin_amdgcn_mfma_f32_32x32x16_bf16((a), (b), (c), 0, 0, 0)

namespace pg8 {
constexpr int BM = 256, BK = 64, HALF = 128, HTB = HALF * BK * 2, STAGE_BYTES = 8 * HTB, NXCD = 8, WGM = 8;
DI int lds_byte(int r, int c) { const int st = (r >> 4) * 2 + (c >> 5), rr = r & 15, cc = c & 31, ob = rr * 64 + cc * 2; return st * 1024 + (ob ^ (((ob >> 9) & 1) << 5)); }
DI void stage_rc(int b, int& R, int& C) { const int st = b / 1024, sb = b % 1024, swz = sb ^ (((sb >> 9) & 1) << 5); R = (st >> 1) * 16 + swz / 64; C = (st & 1) * 32 + (swz % 64) / 2; }
struct Unit { int pm, pn; };
struct Gemm { const bf16_t* A; const bf16_t* Bt; int M, N, K; };
struct StaticOrder {
    int nM, nN, nwg, G, c;
    DI void init(int M_, int N_, int G_, int c_) { nM = M_ / BM; nN = N_ / BM; nwg = nM * nN; G = G_; c = c_; }
    DI bool next(int i, Unit& u) const {
        const long L = (long)i * G + c; if (L >= nwg) return false;
        int wgid = (int)L; { const int q = nwg / NXCD, r = nwg % NXCD, xcd = wgid % NXCD, off = wgid / NXCD; wgid = (xcd < r ? xcd * (q + 1) : r * (q + 1) + (xcd - r) * q) + off; }
        const int nig = WGM * nN, gid = wgid / nig, fm = gid * WGM, gsz = (nM - fm) < WGM ? (nM - fm) : WGM;
        u.pm = fm + ((wgid % nig) % gsz); u.pn = (wgid % nig) / gsz; return true;
    }
};

template <class Epi>
DI void gemm_phase(LAS unsigned char* lds, const Gemm g, const StaticOrder& S, const Epi& E) {
    int tid_ = threadIdx.x; asm volatile("" : "+v"(tid_)); const int tid = tid_, wid = __builtin_amdgcn_readfirstlane(tid >> 6), lane = tid & 63, wr = wid >> 2, wc = wid & 3, fr = lane & 15, fq = lane >> 4;
    const int K = g.K, nt = K / BK;
    unsigned voffA[2];
#pragma unroll
    for (int i = 0; i < 2; ++i) { int R, C; stage_rc(tid * 16 + i * 8192, R, C); voffA[i] = (unsigned)(R * K + C) * 2u; }
    const size_t kstep = (size_t)(BK * 2);
    const size_t hstep = (size_t)HALF * K * 2;
    const size_t tstep = 2 * hstep;
    const unsigned ldsw = (unsigned)wid * 1024u;
    const int aoff = lds_byte(wr * 64 + fr, fq * 8), boff = lds_byte(wc * 32 + fr, fq * 8);
#define PG8_SA(b, h) (((b) * 2 + (h)) * HTB)
#define PG8_SB(b, h) ((4 + (b) * 2 + (h)) * HTB)
#define PG8_STAGE(bufoff, gbase) do { _Pragma("unroll") for (int _i = 0; _i < 2; ++_i) \
        __builtin_amdgcn_global_load_lds((const unsigned*)((const char*)(gbase) + voffA[_i]), (LAS unsigned*)(lds + (bufoff) + ldsw + _i * 8192), 16, 0, 0); } while (0)
#define PG8_LDA(dst, b, h) do { _Pragma("unroll") for (int m = 0; m < 4; ++m) _Pragma("unroll") for (int k = 0; k < 2; ++k) dst[m][k] = *(const LAS bf16x8*)(lds + PG8_SA(b, h) + aoff + m * 2048 + k * 1024); } while (0)
#define PG8_LDB(dst, b, h) do { _Pragma("unroll") for (int n = 0; n < 2; ++n) _Pragma("unroll") for (int k = 0; k < 2; ++k) dst[n][k] = *(const LAS bf16x8*)(lds + PG8_SB(b, h) + boff + n * 2048 + k * 1024); } while (0)
#define PG8_MMA(ai, bj, At, Bt) do { __builtin_amdgcn_s_setprio(1); _Pragma("unroll") for (int m = 0; m < 4; ++m) _Pragma("unroll") for (int n = 0; n < 2; ++n) _Pragma("unroll") for (int k = 0; k < 2; ++k) \
        acc[ai][bj][m][n] = __builtin_amdgcn_mfma_f32_16x16x32_bf16(Bt[n][k], At[m][k], acc[ai][bj][m][n], 0, 0, 0); __builtin_amdgcn_s_setprio(0); } while (0)
#define PG8_WAIT_V(n) asm volatile("s_waitcnt vmcnt(" #n ")" ::: "memory")
#define PG8_WAIT_L(n) asm volatile("s_waitcnt lgkmcnt(" #n ")" ::: "memory")
#define PG8_BAR __builtin_amdgcn_s_barrier()
#define PG8_SCHED __builtin_amdgcn_sched_barrier(0)
    Unit cur, nxt; int ui = 0;
    if (!S.next(0, cur)) return;
    f32x4 acc[2][2][4][2];
#pragma unroll
    for (int a = 0; a < 2; ++a)
#pragma unroll
        for (int b = 0; b < 2; ++b)
#pragma unroll
            for (int m = 0; m < 4; ++m)
#pragma unroll
                for (int n = 0; n < 2; ++n) acc[a][b][m][n] = (f32x4){0.f, 0.f, 0.f, 0.f};
    bf16x8 At[4][2], B0[2][2], B1[2][2];
    const char* cA = (const char*)g.A + (size_t)cur.pm * tstep; const char* cB = (const char*)g.Bt + (size_t)cur.pn * tstep;
    PG8_STAGE(PG8_SB(0, 0), cB); PG8_STAGE(PG8_SA(0, 0), cA); PG8_STAGE(PG8_SB(0, 1), cB + hstep); PG8_STAGE(PG8_SA(0, 1), cA + hstep);
    if (wr == 1) PG8_BAR;
    PG8_WAIT_V(4); PG8_BAR;
    PG8_STAGE(PG8_SB(1, 0), cB + kstep); PG8_STAGE(PG8_SA(1, 0), cA + kstep); PG8_STAGE(PG8_SB(1, 1), cB + hstep + kstep);
    PG8_WAIT_V(6); PG8_BAR;
    for (;;) {
        const bool has_next = S.next(ui + 1, nxt);
        const char* nA = has_next ? (const char*)g.A + (size_t)nxt.pm * tstep : cA; const char* nB = has_next ? (const char*)g.Bt + (size_t)nxt.pn * tstep : cB;
        for (int t = 0; t < nt; t += 2) {
            const bool last = (t == nt - 2);
            const char* a1 = cA + (size_t)(t + 1) * kstep;
            const char* a2 = last ? nA : cA + (size_t)(t + 2) * kstep; const char* b2 = last ? nB : cB + (size_t)(t + 2) * kstep;
            const char* a3 = a2 + kstep; const char* b3 = b2 + kstep;
            PG8_LDB(B0, 0, 0); PG8_SCHED; PG8_LDA(At, 0, 0); PG8_STAGE(PG8_SA(1, 1), a1 + hstep);
            PG8_WAIT_L(8); PG8_BAR; PG8_WAIT_L(0); PG8_MMA(0, 0, At, B0); PG8_BAR; PG8_SCHED;
            PG8_LDB(B1, 0, 1); PG8_STAGE(PG8_SB(0, 0), b2);
            PG8_BAR; PG8_WAIT_L(0); PG8_MMA(0, 1, At, B1); PG8_BAR;
            PG8_LDA(At, 0, 1); PG8_STAGE(PG8_SA(0, 0), a2);
            PG8_BAR; PG8_WAIT_L(0); PG8_MMA(1, 0, At, B0); PG8_BAR; PG8_SCHED;
            PG8_STAGE(PG8_SB(0, 1), b2 + hstep);
            PG8_WAIT_V(6); PG8_BAR; PG8_MMA(1, 1, At, B1); PG8_BAR;
            PG8_LDB(B0, 1, 0); PG8_SCHED; PG8_LDA(At, 1, 0); PG8_STAGE(PG8_SA(0, 1), a2 + hstep);
            PG8_WAIT_L(8); PG8_BAR; PG8_WAIT_L(0); PG8_MMA(0, 0, At, B0); PG8_BAR; PG8_SCHED;
            PG8_LDB(B1, 1, 1); PG8_STAGE(PG8_SB(1, 0), b3);
            PG8_BAR; PG8_WAIT_L(0); PG8_MMA(0, 1, At, B1); PG8_BAR;
            PG8_LDA(At, 1, 1); PG8_STAGE(PG8_SA(1, 0), a3);
            PG8_BAR; PG8_WAIT_L(0); PG8_MMA(1, 0, At, B0); PG8_BAR; PG8_SCHED;
            PG8_STAGE(PG8_SB(1, 1), b3 + hstep);
            PG8_WAIT_V(6); PG8_BAR; PG8_MMA(1, 1, At, B1); PG8_BAR;
        }
        E(acc, cur, wr, wc, fr, fq);
        if (!has_next) break;
#pragma unroll
        for (int a = 0; a < 2; ++a)
#pragma unroll
            for (int b = 0; b < 2; ++b)
#pragma unroll
                for (int m = 0; m < 4; ++m)
#pragma unroll
                    for (int n = 0; n < 2; ++n) acc[a][b][m][n] = (f32x4){0.f, 0.f, 0.f, 0.f};
        cur = nxt; cA = nA; cB = nB; ++ui;
    }
    PG8_WAIT_V(0);
    if (wr == 0) PG8_BAR;
    PG8_BAR;
#undef PG8_SA
#undef PG8_SB
#undef PG8_STAGE
#undef PG8_LDA
#undef PG8_LDB
#undef PG8_MMA
#undef PG8_WAIT_V
#undef PG8_WAIT_L
#undef PG8_BAR
#undef PG8_SCHED
}
}

struct EpiGdnIn {
    bf16_t* proj; float* conv_p; float* conv_s;
    DI void operator()(const f32x4 (&acc)[2][2][4][2], const pg8::Unit& u, int wr, int wc, int fr, int fq) const {
        const int row0 = u.pm * 256 + wr * 64 + fr, col0 = u.pn * 256 + wc * 32 + 4 * fq;
#pragma unroll
        for (int ai = 0; ai < 2; ++ai)
#pragma unroll
            for (int m = 0; m < 4; ++m) {
                const int r = row0 + ai * 128 + m * 16;
                bf16_t* rowp = proj + (size_t)r * NPROJ + col0;
                bool tail; float* cp;
                if (r < MP) { const int t = r & (TP - 1), b = r >> 13; tail = t >= TP - 3; cp = conv_p + (size_t)(b * 3 + (t - (TP - 3))) * 3072; }
                else { const int rs = r - MP, t = rs & 15, b = rs >> 4; tail = t >= TS - 3; cp = conv_s + (size_t)(b * 3 + (t - (TS - 3))) * 3072; }
#pragma unroll
                for (int bj = 0; bj < 2; ++bj)
#pragma unroll
                    for (int n = 0; n < 2; ++n) {
                        const f32x4 v = acc[ai][bj][m][n];
                        u32x2 w; w.x = pk2(v[0], v[1]); w.y = pk2(v[2], v[3]);
                        *(u32x2*)(rowp + bj * 128 + n * 16) = w;
                        const int c = col0 + bj * 128 + n * 16;
                        if (tail && c < 3072) *(f32x4*)(cp + c) = v;
                    }
            }
    }
};

struct EpiDiffIn {
    bf16_t* proj; float* k_p; float* v_p; float* k_s; float* v_s; bf16_t* ks; bf16_t* vs; bf16_t* kh; bf16_t* vh; const float* rope;
    DI void operator()(const f32x4 (&acc)[2][2][4][2], const pg8::Unit& u, int wr, int wc, int fr, int fq) const {
        const int part = u.pn >> 2;
        const int row0 = u.pm * 256 + wr * 64 + fr;
        const int d0 = 16 * (wc & 1) + 4 * fq;
        const int cbase = u.pn * 256 + 64 * (wc >> 1) + d0;
#pragma unroll
        for (int ai = 0; ai < 2; ++ai)
#pragma unroll
            for (int m = 0; m < 4; ++m) {
                const int r = row0 + ai * 128 + m * 16;
                const int rs = r - MP;
                const int pidx = (r < MP) ? (r & (TP - 1)) : (TP + (rs & 15));
                f32x4 cs = {1.f, 1.f, 1.f, 1.f}, sn = {0.f, 0.f, 0.f, 0.f};
                if (part < 2) { cs = *(const f32x4*)(rope + (size_t)pidx * 64 + d0); sn = *(const f32x4*)(rope + (size_t)pidx * 64 + 32 + d0); }
#pragma unroll
                for (int bj = 0; bj < 2; ++bj) {
                    const f32x4 x1 = acc[ai][bj][m][0], x2 = acc[ai][bj][m][1];
                    f32x4 y1 = x1 * cs - x2 * sn, y2 = x2 * cs + x1 * sn;
                    const int col = cbase + bj * 128;
                    bf16_t* pp = proj + (size_t)r * NPROJ + col;
                    if (part == 0) { y1 *= QSCALE; y2 *= QSCALE; }
                    u32x2 w1, w2; w1.x = pk2(y1[0], y1[1]); w1.y = pk2(y1[2], y1[3]); w2.x = pk2(y2[0], y2[1]); w2.y = pk2(y2[2], y2[3]);
                    if (part == 0 || part == 3) { *(u32x2*)pp = w1; *(u32x2*)(pp + 32) = w2; }
                    if (part == 1 || part == 2) {
                        const int cc = col - part * 1024;
                        const int hh = cc >> 7, dd = cc & 127;
                        float* op; bf16_t* sp;
                        if (r < MP) { op = (part == 1 ? k_p : v_p) + (size_t)r * 1024 + cc;
                               sp = (part == 1 ? kh : vh) + ((size_t)((r >> 13) * 8 + hh) * TP + (r & (TP - 1))) * 128 + dd; }
                        else { op = (part == 1 ? k_s : v_s) + (size_t)rs * 1024 + cc;
                               sp = (part == 1 ? ks : vs) + ((size_t)((rs >> 4) * 8 + hh) * KSROWS + PAST + (rs & 15)) * 128 + dd; }
                        *(f32x4*)op = y1; *(f32x4*)(op + 32) = y2;
                        *(u32x2*)sp = w1; *(u32x2*)(sp + 32) = w2;
                    }
                }
            }
    }
};

struct EpiOut {
    bf16_t* C;
    DI void operator()(const f32x4 (&acc)[2][2][4][2], const pg8::Unit& u, int wr, int wc, int fr, int fq) const {
        const int row0 = u.pm * 256 + wr * 64 + fr, col0 = u.pn * 256 + wc * 32 + 4 * fq;
#pragma unroll
        for (int ai = 0; ai < 2; ++ai)
#pragma unroll
            for (int m = 0; m < 4; ++m) {
                bf16_t* rowp = C + (size_t)(row0 + ai * 128 + m * 16) * 1024 + col0;
#pragma unroll
                for (int bj = 0; bj < 2; ++bj)
#pragma unroll
                    for (int n = 0; n < 2; ++n) { const f32x4 v = acc[ai][bj][m][n]; u32x2 w; w.x = pk2(v[0], v[1]); w.y = pk2(v[2], v[3]); *(u32x2*)(rowp + bj * 128 + n * 16) = w; }
            }
    }
};

DI void transpose_tile(const float* W, int ldw, int n0, int k0, bf16_t* WT, bool perm, LAS float* tile) {
    int tid_ = threadIdx.x; asm volatile("" : "+v"(tid_)); const int tid = tid_;
    {
        const int kk = tid >> 4, c4 = (tid & 15) * 4;
#pragma unroll
        for (int p = 0; p < 2; ++p) {
            const f32x4 v = *(const f32x4*)(W + (size_t)(k0 + kk + 32 * p) * ldw + n0 + c4);
            LAS float* t = tile + (kk + 32 * p) * 65 + c4;
            t[0] = v[0]; t[1] = v[1]; t[2] = v[2]; t[3] = v[3];
        }
    }
    __syncthreads();
    {
        const int n = tid >> 3, ks = (tid & 7) * 8;
        const int src = perm ? perm64(n) : n;
        float v[8];
#pragma unroll
        for (int e = 0; e < 8; ++e) v[e] = tile[(ks + e) * 65 + src];
        u32x4 w; w.x = pk2(v[0], v[1]); w.y = pk2(v[2], v[3]); w.z = pk2(v[4], v[5]); w.w = pk2(v[6], v[7]);
        *(u32x4*)(WT + (size_t)(n0 + n) * 1024 + k0 + ks) = w;
    }
    __syncthreads();
}

DI void phase_prep(const Params& P, LAS unsigned char* lds) {
    int tid_ = threadIdx.x; asm volatile("" : "+v"(tid_)); const int tid = tid_, G = gridDim.x;
    unsigned char* ws = P.ws;
    for (int id = blockIdx.x; id < 5120; id += G) {
        const int j = id / 2560; int rem = id % 2560;
        const float* W; int ldw; bf16_t* WT; bool perm = false; int t;
        if (rem < 1024) { W = P.in[12] + (size_t)j * 1024 * 4112; ldw = 4112; WT = (bf16_t*)(ws + WS_WING) + (size_t)j * 4096 * 1024; t = rem; }
        else if (rem < 1280) { W = P.in[17] + (size_t)j * 1024 * 1024; ldw = 1024; WT = (bf16_t*)(ws + WS_WOUTG) + (size_t)j * 1024 * 1024; t = rem - 1024; }
        else if (rem < 2304) { W = P.in[18] + (size_t)j * 1024 * 4096; ldw = 4096; WT = (bf16_t*)(ws + WS_WIND) + (size_t)j * 4096 * 1024; t = rem - 1280; perm = true; }
        else { W = P.in[24] + (size_t)j * 1024 * 1024; ldw = 1024; WT = (bf16_t*)(ws + WS_WOUTD) + (size_t)j * 1024 * 1024; t = rem - 2304; }
        transpose_tile(W, ldw, (t >> 4) * 64, (t & 15) * 64, WT, perm, (LAS float*)lds);
    }
    for (int idx = blockIdx.x * 512 + tid; idx < 8208 * 32; idx += G * 512) {
        const int pi = idx >> 5, d = idx & 31;
        const int pos = pi < TP ? pi : PAST + (pi - TP);
        const float inv = 1.0f / powf(10000.0f, (float)d / 32.0f);
        const float ang = (float)pos * inv;
        const double rev = (double)ang * 0.15915494309189535;
        const double fr = rev - floor(rev);
        float* rp = (float*)(ws + WS_ROPE) + (size_t)pi * 64;
        rp[d] = __builtin_amdgcn_cosf((float)fr);
        rp[32 + d] = __builtin_amdgcn_sinf((float)fr);
    }
    {
        LAS float* cact = (LAS float*)lds;
        LAS float* red = (LAS float*)(lds + 81920);
        bool loaded = false;
        for (int id = (G - 1 - blockIdx.x); id < 192; id += G) {
            if (!loaded) {
                for (int e = tid; e < NB * 1024; e += 512) {
                    const int b = e >> 10, k = e & 1023;
                    const float c = b < BP ? P.in[2][b * 1024 + k] : P.in[3][(b - BP) * 1024 + k];
                    cact[e] = siluf(c);
                }
                loaded = true;
            }
            __syncthreads();
            const int i = id / 48, cb = id % 48;
            const int col = tid & 63, kg = tid >> 6;
            const float* Wp = P.in[10] + (size_t)i * 1024 * 3072 + cb * 64 + col;
            float acc[NB];
#pragma unroll
            for (int b = 0; b < NB; ++b) acc[b] = 0.f;
            for (int k = kg * 128; k < kg * 128 + 128; k += 4) {
                const float w0 = Wp[(size_t)k * 3072], w1 = Wp[(size_t)(k + 1) * 3072], w2 = Wp[(size_t)(k + 2) * 3072], w3 = Wp[(size_t)(k + 3) * 3072];
#pragma unroll
                for (int b = 0; b < NB; ++b) {
                    const f32x4 c4 = *(const LAS f32x4*)(cact + b * 1024 + k);
                    acc[b] += c4[0] * w0 + c4[1] * w1 + c4[2] * w2 + c4[3] * w3;
                }
            }
#pragma unroll
            for (int b = 0; b < NB; ++b) red[(kg * NB + b) * 64 + col] = acc[b];
            __syncthreads();
            for (int o = tid; o < NB * 64; o += 512) {
                const int b = o >> 6, c = o & 63;
                float s = P.in[11][i * 3072 + cb * 64 + c];
#pragma unroll
                for (int g = 0; g < 8; ++g) s += red[(g * NB + b) * 64 + c];
                ((float*)(ws + WS_ADA))[((size_t)i * NB + b) * 3072 + cb * 64 + c] = s;
            }
        }
        __syncthreads();
    }
}

DI void phase_elem(const Params& P, LAS unsigned char* lds, int layer) {
    int tid_ = threadIdx.x; asm volatile("" : "+v"(tid_)); const int tid = tid_, wid = __builtin_amdgcn_readfirstlane(tid >> 6), lane = tid & 63, G = gridDim.x;
    unsigned char* ws = P.ws;
    const int j = layer >> 1;
    const bool gdn = (layer < 4) && !(layer & 1);
    LAS float* wab = (LAS float*)lds;
    if (gdn) {
        const float* Wp = P.in[12] + (size_t)j * 1024 * 4112 + 4096;
        for (int e = tid; e < 16384; e += 512) { const int k = e >> 4, c = e & 15; wab[c * 1024 + k] = Wp[(size_t)k * 4112 + c]; }
        __syncthreads();
    }
    const float* ada = (const float*)(ws + WS_ADA);
    float* X = P.out;
    const bf16_t* OUTB = (const bf16_t*)(ws + WS_PROJ);
    bf16_t* HB = (bf16_t*)(ws + WS_HBUF);
    float* AB = (float*)(ws + WS_AB);
    f32x4 xn[4]; u32x2 own[4];
#define EL_LOAD(R) do { const int _r = (R); if (_r < M) { \
        const float* _xs = (layer <= 1) ? (_r < MP ? P.in[0] + (size_t)_r * 1024 : P.in[1] + (size_t)(_r - MP) * 1024) : X + (size_t)_r * 1024; \
        _Pragma("unroll") for (int _q = 0; _q < 4; ++_q) xn[_q] = *(const f32x4*)(_xs + 4 * (lane + 64 * _q)); \
        if (layer >= 1) { _Pragma("unroll") for (int _q = 0; _q < 4; ++_q) own[_q] = *(const u32x2*)(OUTB + (size_t)_r * 1024 + 4 * (lane + 64 * _q)); } } } while (0)
    EL_LOAD(blockIdx.x * 8 + wid);
    for (int r = blockIdx.x * 8 + wid; r < M; r += G * 8) {
        const int b = r < MP ? (r >> 13) : BP + ((r - MP) >> 4);
        f32x4 x[4]; u32x2 owc[4];
#pragma unroll
        for (int q = 0; q < 4; ++q) { x[q] = xn[q]; owc[q] = own[q]; }
        EL_LOAD(r + G * 8);
        if (layer >= 1) {
            f32x4 o[4]; float ss = 0.f;
#pragma unroll
            for (int q = 0; q < 4; ++q) { const u32x2 ow = owc[q];
                o[q] = (f32x4){__uint_as_float(ow.x << 16), __uint_as_float(ow.x & 0xffff0000u), __uint_as_float(ow.y << 16), __uint_as_float(ow.y & 0xffff0000u)};
                ss += o[q][0] * o[q][0] + o[q][1] * o[q][1] + o[q][2] * o[q][2] + o[q][3] * o[q][3]; }
            ss = wave_sum(ss);
            const float rstd = __builtin_amdgcn_rsqf(ss * (1.f / 1024.f) + RMS_EPS);
            const float* gp = ada + ((size_t)(layer - 1) * NB + b) * 3072 + 2048;
            const float* np = P.in[9] + (layer - 1) * 1024;
#pragma unroll
            for (int q = 0; q < 4; ++q) {
                const int d = 4 * (lane + 64 * q);
                const f32x4 gt = *(const f32x4*)(gp + d), nw = *(const f32x4*)(np + d);
                x[q] = x[q] + gt * (o[q] * rstd * nw);
                *(f32x4*)(X + (size_t)r * 1024 + d) = x[q];
            }
        }
        if (layer < 4) {
            float ss = 0.f;
#pragma unroll
            for (int q = 0; q < 4; ++q) ss += x[q][0] * x[q][0] + x[q][1] * x[q][1] + x[q][2] * x[q][2] + x[q][3] * x[q][3];
            ss = wave_sum(ss);
            const float rstd = __builtin_amdgcn_rsqf(ss * (1.f / 1024.f) + RMS_EPS);
            const float* ap = ada + ((size_t)layer * NB + b) * 3072;
            const float* np = P.in[8] + layer * 1024;
            f32x4 hv[4];
#pragma unroll
            for (int q = 0; q < 4; ++q) {
                const int d = 4 * (lane + 64 * q);
                const f32x4 sh = *(const f32x4*)(ap + d), sc = *(const f32x4*)(ap + 1024 + d), nw = *(const f32x4*)(np + d);
                hv[q] = (x[q] * rstd * nw) * (1.f + sc) + sh;
                u32x2 w; w.x = pk2(hv[q][0], hv[q][1]); w.y = pk2(hv[q][2], hv[q][3]);
                *(u32x2*)(HB + (size_t)r * 1024 + d) = w;
            }
            if (gdn) {
                float mine = 0.f;
#pragma unroll
                for (int c = 0; c < 16; ++c) {
                    float a = 0.f;
#pragma unroll
                    for (int q = 0; q < 4; ++q) { const f32x4 w4 = *(const LAS f32x4*)(wab + c * 1024 + 4 * (lane + 64 * q)); a += hv[q][0] * w4[0] + hv[q][1] * w4[1] + hv[q][2] * w4[2] + hv[q][3] * w4[3]; }
                    a = row_sum16(a);
                    if ((lane & 15) == c) mine = a;
                }
                mine += __shfl_xor(mine, 16); mine += __shfl_xor(mine, 32);
                if (lane < 16) AB[(size_t)r * 16 + lane] = mine;
            }
        }
    }
}

DI void convert_cache(const Params& P, int j, int b0, int nb) {
    int tid_ = threadIdx.x; asm volatile("" : "+v"(tid_)); const int tid = tid_;
    unsigned char* ws = P.ws;
    const int bx = blockIdx.x - b0; const int G = nb;
    {
        const float* ck = P.in[6] + (size_t)j * 16 * PAST * 1024;
        const float* cv = P.in[7] + (size_t)j * 16 * PAST * 1024;
        bf16_t* KS = (bf16_t*)(ws + WS_KS); bf16_t* VS = (bf16_t*)(ws + WS_VS);
        const size_t nun = (size_t)16 * PAST * 128;
        for (size_t u = (size_t)bx * 512 + tid; u < 2 * nun; u += (size_t)G * 512) {
            const bool isv = u >= nun; const size_t uu = isv ? u - nun : u;
            const size_t b = uu / ((size_t)PAST * 128), rem = uu % ((size_t)PAST * 128);
            const size_t row = rem >> 7, c8 = rem & 127, hh = c8 >> 4, d8 = c8 & 15;
            const float* sp = (isv ? cv : ck) + uu * 8;
            const f32x4 a = *(const f32x4*)sp, c = *(const f32x4*)(sp + 4);
            u32x4 w; w.x = pk2(a[0], a[1]); w.y = pk2(a[2], a[3]); w.z = pk2(c[0], c[1]); w.w = pk2(c[2], c[3]);
            *(u32x4*)((isv ? VS : KS) + ((b * 8 + hh) * KSROWS + row) * 128 + d8 * 8) = w;
        }
        const size_t npad = (size_t)128 * 48 * 16;
        for (size_t u = (size_t)bx * 512 + tid; u < 2 * npad; u += (size_t)G * 512) {
            const bool isv = u >= npad; const size_t uu = isv ? u - npad : u;
            const size_t sq = uu / (48 * 16), rem = uu % (48 * 16);
            *(u32x4*)((isv ? VS : KS) + (sq * KSROWS + PAST + TS) * 128 + rem * 8) = (u32x4){0u, 0u, 0u, 0u};
        }
    }
}

DI void phase_g1(const Params& P, LAS unsigned char* lds, int layer) {
    int tid_ = threadIdx.x; asm volatile("" : "+v"(tid_)); const int tid = tid_, wid = __builtin_amdgcn_readfirstlane(tid >> 6), lane = tid & 63, G = gridDim.x;
    const int fr = lane & 15, fq = lane >> 4;
    unsigned char* ws = P.ws;
    const int j = layer >> 1;
    const bf16_t* proj = (const bf16_t*)(ws + WS_PROJ);
    const float* AB = (const float*)(ws + WS_AB);
    float* GL = (float*)(ws + WS_GL);
    const float* convw = P.in[13] + (size_t)j * 4 * 3072;
    const float* cconv = P.in[5] + (size_t)j * 16 * 3 * 3072;
    LAS unsigned char* Qs = lds;
    LAS unsigned char* Ks = lds + 17408;
    LAS unsigned char* VBt = lds + 34816;
    LAS unsigned char* KBt = lds + 53248;
    LAS float* A32 = (LAS float*)(lds + 71680);
    LAS unsigned char* Ts = lds + 88320;
    LAS unsigned char* QKs = lds + 97536;
    LAS float* Gs = (LAS float*)(lds + 105728);

    u32x4 rows[11];
#define G1_ROWLOAD(IT) do { const int _it = (IT); if (tid < 384 && _it < NITEM) { int _h, _c, _row0, _nv; bool _smp; \
            if (_it < NITEM_P) { const int _seq = _it >> 7; _h = _seq & 7; _c = _it & 127; _row0 = (_seq >> 3) * TP + 64 * _c; _nv = 64; _smp = false; } \
            else { const int _s = _it - NITEM_P; _h = _s & 7; _c = 0; _row0 = MP + (_s >> 3) * TS; _nv = TS; _smp = true; } \
            int _t = tid; asm volatile("" : "+v"(_t)); const int _l16 = _t & 15, _grp = _t >> 4, _part = _grp >> 3, _rb = _grp & 7; \
            const int _ch = _part * 1024 + _h * 128 + 8 * _l16; \
            _Pragma("unroll") for (int _k = 0; _k < 11; ++_k) { const int _lr = 8 * _rb - 3 + _k; \
                const bool _up = (_lr >= 0 && _lr < _nv) || (_lr < 0 && !_smp && _c > 0); const int _lrc = _up ? _lr : 0; \
                rows[_k] = *(const u32x4*)(proj + (size_t)(_row0 + _lrc) * NPROJ + _ch); } } } while (0)
    G1_ROWLOAD((int)blockIdx.x);
    for (int item = blockIdx.x; item < NITEM; item += G) {
        int b, h, c, row0, nvalid; bool sample;
        if (item < NITEM_P) { const int seq = item >> 7; b = seq >> 3; h = seq & 7; c = item & 127; row0 = b * TP + 64 * c; nvalid = 64; sample = false; }
        else { const int s = item - NITEM_P; b = s >> 3; h = s & 7; c = 0; row0 = MP + b * TS; nvalid = TS; sample = true; }
        unsigned char* ib = ws + WS_R1 + (size_t)item * ITEM_BYTES;
        float val[8][8];
        float rn[8];
        int tido = tid; asm volatile("" : "+v"(tido));
        const int l16 = tido & 15, grp = tido >> 4, part = grp >> 3, rb = grp & 7;
        const int lane = tido & 63, fr = lane & 15, fq = lane >> 4;
        if (tid < 384) {
            const int ch = part * 1024 + h * 128 + 8 * l16;
            float wv[4][8];
#pragma unroll
            for (int t = 0; t < 4; ++t) {
                const f32x4 a = *(const f32x4*)(convw + t * 3072 + ch), bb = *(const f32x4*)(convw + t * 3072 + ch + 4);
                wv[t][0] = a[0]; wv[t][1] = a[1]; wv[t][2] = a[2]; wv[t][3] = a[3]; wv[t][4] = bb[0]; wv[t][5] = bb[1]; wv[t][6] = bb[2]; wv[t][7] = bb[3];
            }
            float win[4][8];
#pragma unroll
            for (int t = 0; t < 4; ++t)
#pragma unroll
                for (int e = 0; e < 8; ++e) win[t][e] = 0.f;
#pragma unroll
            for (int k = 0; k < 11; ++k) {
                const int lr = 8 * rb - 3 + k;
                float in8[8];
                {
                    const bool use_proj = (lr >= 0 && lr < nvalid) || (lr < 0 && !sample && c > 0);
                    unpack8(rows[k], in8);
                    if (!use_proj) {
#pragma unroll
                        for (int e = 0; e < 8; ++e) in8[e] = 0.f;
                    }
                }
                if (k < 3) {
                    if (sample && lr < 0) {
                        const float* sp = cconv + (size_t)(b * 3 + (3 + lr)) * 3072 + ch;
                        const f32x4 a = *(const f32x4*)sp, bb = *(const f32x4*)(sp + 4);
                        in8[0] = a[0]; in8[1] = a[1]; in8[2] = a[2]; in8[3] = a[3]; in8[4] = bb[0]; in8[5] = bb[1]; in8[6] = bb[2]; in8[7] = bb[3];
                    }
                }
#pragma unroll
                for (int e = 0; e < 8; ++e) { win[0][e] = win[1][e]; win[1][e] = win[2][e]; win[2][e] = win[3][e]; win[3][e] = in8[e]; }
                if (k >= 3) {
                    const bool rv = (lr < nvalid);
                    float ss = 0.f;
#pragma unroll
                    for (int e = 0; e < 8; ++e) {
                        const float y = win[0][e] * wv[0][e] + win[1][e] * wv[1][e] + win[2][e] * wv[2][e] + win[3][e] * wv[3][e];
                        const float s = rv ? siluf(y) : 0.f;
                        val[k - 3][e] = s; ss += s * s;
                    }
                    ss = row_sum16(ss);
                    rn[k - 3] = __builtin_amdgcn_rsqf(ss + 1e-6f);
                }
            }
        } else if (wid == 7) {
            const int r = row0 + (lane < nvalid ? lane : 0);
            const bool valid = lane < nvalid;
            const float a = AB[(size_t)r * 16 + h], bb = AB[(size_t)r * 16 + 8 + h];
            const float xa = a + P.in[15][j * 8 + h];
            const float ey = __expf(-fabsf(xa));
            const float lp = (ey < 0.01f) ? ey * (1.f - ey * (0.5f - ey * 0.33333334f)) : __logf(1.f + ey);
            const float sp = fmaxf(xa, 0.f) + lp;
            float g = valid ? -__expf(P.in[14][j * 8 + h]) * sp : 0.f;
            const float beta = valid ? __builtin_amdgcn_rcpf(1.f + __expf(-bb)) : 0.f;
#pragma unroll
            for (int o = 1; o < 64; o <<= 1) { const float t = __shfl_up(g, o); if (lane >= o) g += t; }
            const float glast = readlane_f(g, 63);
            Gs[lane] = g; Gs[64 + lane] = beta; Gs[128 + lane] = __expf(g); Gs[192 + lane] = __expf(glast - g);
            if (lane == 0) GL[item] = __expf(glast);
        }
        __syncthreads();
        G1_ROWLOAD(item + G);
        if (tid < 384) {
#pragma unroll
            for (int rr = 0; rr < 8; ++rr) {
                const int row = 8 * rb + rr;
                const float beta = Gs[64 + row], eG = Gs[128 + row];
                if (part == 0) {
                    const float sc = rn[rr] * 0.08838834764831845f;
                    float q[8];
#pragma unroll
                    for (int e = 0; e < 8; ++e) q[e] = val[rr][e] * sc;
                    u32x4 w; w.x = pk2(q[0], q[1]); w.y = pk2(q[2], q[3]); w.z = pk2(q[4], q[5]); w.w = pk2(q[6], q[7]);
                    *(LAS u32x4*)(Qs + row * 272 + l16 * 16) = w;
                    bf16_t* qg = (bf16_t*)(ib + 49152) + row * 128;
                    u32x2 g0, g1; g0.x = pk2(q[0] * eG, q[1] * eG); g0.y = pk2(q[2] * eG, q[3] * eG); g1.x = pk2(q[4] * eG, q[5] * eG); g1.y = pk2(q[6] * eG, q[7] * eG);
                    *(u32x2*)(qg + ppos(8 * l16)) = g0; *(u32x2*)(qg + ppos(8 * l16 + 4)) = g1;
                    val[rr][0] = 0.f;
                } else if (part == 1) {
#pragma unroll
                    for (int e = 0; e < 8; ++e) val[rr][e] *= rn[rr];
                    u32x4 w; w.x = pk2(val[rr][0], val[rr][1]); w.y = pk2(val[rr][2], val[rr][3]); w.z = pk2(val[rr][4], val[rr][5]); w.w = pk2(val[rr][6], val[rr][7]);
                    *(LAS u32x4*)(Ks + row * 272 + l16 * 16) = w;
                }
            }
            if (part >= 1) {
                float bsc[8], ksc[8];
#pragma unroll
                for (int rr = 0; rr < 8; ++rr) { const int row = 8 * rb + rr; const float beta = Gs[64 + row]; bsc[rr] = (part == 1) ? beta * Gs[128 + row] : beta; ksc[rr] = Gs[192 + row]; }
                LAS unsigned char* Tt = (part == 1) ? KBt : VBt;
#pragma unroll
                for (int e = 0; e < 8; ++e) {
                    const int dch = 8 * l16 + e;
                    u32x4 w; w.x = pk2(val[0][e] * bsc[0], val[1][e] * bsc[1]); w.y = pk2(val[2][e] * bsc[2], val[3][e] * bsc[3]);
                    w.z = pk2(val[4][e] * bsc[4], val[5][e] * bsc[5]); w.w = pk2(val[6][e] * bsc[6], val[7][e] * bsc[7]);
                    *(LAS u32x4*)(Tt + dch * 144 + rb * 16) = w;
                    if (part == 1) {
                        bf16_t* kd = (bf16_t*)(ib + 65536) + dch * 64;
                        u32x2 k0, k1; k0.x = pk2(val[0][e] * ksc[0], val[1][e] * ksc[1]); k0.y = pk2(val[2][e] * ksc[2], val[3][e] * ksc[3]);
                        k1.x = pk2(val[4][e] * ksc[4], val[5][e] * ksc[5]); k1.y = pk2(val[6][e] * ksc[6], val[7][e] * ksc[7]);
                        *(u32x2*)(kd + ppos(8 * rb)) = k0; *(u32x2*)(kd + ppos(8 * rb + 4)) = k1;
                    }
                }
            }
        }
        __syncthreads();
        {
            const int mt = wid & 3; const bool isqk = wid >= 4;
            LAS unsigned char* As = isqk ? Qs : Ks;
            f32x4 acc[4];
#pragma unroll
            for (int nt = 0; nt < 4; ++nt) acc[nt] = (f32x4){0.f, 0.f, 0.f, 0.f};
#pragma unroll
            for (int ks = 0; ks < 4; ++ks) {
                const bf16x8 a = *(const LAS bf16x8*)(As + (16 * mt + fr) * 272 + (32 * ks + 8 * fq) * 2);
#pragma unroll
                for (int nt = 0; nt < 4; ++nt) {
                    const bf16x8 bfr = *(const LAS bf16x8*)(Ks + (16 * nt + fr) * 272 + (32 * ks + 8 * fq) * 2);
                    acc[nt] = MFMA16(a, bfr, acc[nt]);
                }
            }
#pragma unroll
            for (int nt = 0; nt < 4; ++nt) {
                const int cp = 16 * nt + fr; const float Gc2 = Gs[cp];
#pragma unroll
                for (int i = 0; i < 4; ++i) {
                    const int cr = 16 * mt + 4 * fq + i;
                    const float dec = __expf(Gs[cr] - Gc2);
                    if (!isqk) A32[cr * 65 + cp] = (cr > cp) ? Gs[64 + cr] * acc[nt][i] * dec : 0.f;
                    else *(LAS bf16_t*)(QKs + (cr * 64 + ppos(cp)) * 2) = f2bf((cr >= cp) ? acc[nt][i] * dec : 0.f);
                }
            }
        }
        __syncthreads();
        {
            float a[64];
#pragma unroll
            for (int jj = 0; jj < 64; ++jj) a[jj] = A32[lane * 65 + jj];
            float x[8];
#pragma unroll
            for (int cc = 0; cc < 8; ++cc) x[cc] = (lane == 8 * wid + cc) ? 1.f : 0.f;
#pragma unroll
            for (int jj = 0; jj < 64; ++jj) {
                if (jj >= 8 * wid) {
#pragma unroll
                    for (int cc = 0; cc < 8; ++cc) { const float xj = readlane_f(x[cc], jj); x[cc] -= a[jj] * xj; }
                }
            }
            u32x4 w; w.x = pk2(x[0], x[1]); w.y = pk2(x[2], x[3]); w.z = pk2(x[4], x[5]); w.w = pk2(x[6], x[7]);
            *(LAS u32x4*)(Ts + lane * 144 + wid * 16) = w;
            *(u32x4*)(ib + 81920 + tid * 16) = *(const LAS u32x4*)(QKs + tid * 16);
        }
        __syncthreads();
        {
            const bool isw = wid >= 4; const int n0 = 32 * (wid & 3);
            LAS unsigned char* Bs = isw ? KBt : VBt;
            f32x4 acc[4][2];
#pragma unroll
            for (int mt = 0; mt < 4; ++mt) { acc[mt][0] = (f32x4){0.f, 0.f, 0.f, 0.f}; acc[mt][1] = (f32x4){0.f, 0.f, 0.f, 0.f}; }
#pragma unroll
            for (int ks = 0; ks < 2; ++ks) {
                bf16x8 bfr[2];
#pragma unroll
                for (int nn = 0; nn < 2; ++nn) bfr[nn] = *(const LAS bf16x8*)(Bs + (n0 + 16 * nn + fr) * 144 + (32 * ks + 8 * fq) * 2);
#pragma unroll
                for (int mt = 0; mt < 4; ++mt) {
                    const bf16x8 a = *(const LAS bf16x8*)(Ts + (16 * mt + fr) * 144 + (32 * ks + 8 * fq) * 2);
                    acc[mt][0] = MFMA16(a, bfr[0], acc[mt][0]); acc[mt][1] = MFMA16(a, bfr[1], acc[mt][1]);
                }
            }
            if (!isw) {
                float* U = (float*)ib;
#pragma unroll
                for (int mt = 0; mt < 4; ++mt)
#pragma unroll
                    for (int nn = 0; nn < 2; ++nn) *(f32x4*)(U + (n0 + 16 * nn + fr) * 64 + 16 * mt + 4 * fq) = acc[mt][nn];
            } else {
#pragma unroll
                for (int mt = 0; mt < 4; ++mt)
#pragma unroll
                    for (int nn = 0; nn < 2; ++nn)
#pragma unroll
                        for (int i = 0; i < 4; ++i) *(LAS bf16_t*)(Qs + ((16 * mt + 4 * fq + i) * 128 + ppos(n0 + 16 * nn + fr)) * 2) = f2bf(acc[mt][nn][i]);
            }
        }
        __syncthreads();
        {
            *(u32x4*)(ib + 32768 + tid * 16) = *(const LAS u32x4*)(Qs + tid * 16);
            *(u32x4*)(ib + 32768 + 8192 + tid * 16) = *(const LAS u32x4*)(Qs + 8192 + tid * 16);
        }
        __syncthreads();
    }
}

DI void phase_scan(const Params& P, LAS unsigned char* lds, int layer) {
    int tid_ = threadIdx.x; asm volatile("" : "+v"(tid_)); const int tid = tid_, wid = __builtin_amdgcn_readfirstlane(tid >> 6), lane = tid & 63, G = gridDim.x;
    const int fr = lane & 15, fq = lane >> 4;
    unsigned char* ws = P.ws;
    const int j = layer >> 1;
    const bf16_t* proj = (const bf16_t*)(ws + WS_PROJ);
    const float* GL = (const float*)(ws + WS_GL);
    bf16_t* ORAW = (bf16_t*)(ws + WS_ORAWB);
    constexpr int BUFB = 57344;
    LAS float* red = (LAS float*)(lds + 2 * BUFB);

    if (G >= 192 && (int)blockIdx.x >= 160) { convert_cache(P, j, 160, G - 160); return; }
    for (int seq = blockIdx.x; seq < 160; seq += G) {
        int b, h, nch, item0, row0, nvalid; float* stout;
        f32x4 st[8];
        const int dvc = 16 * wid + fr;
        if (seq < 32) {
            b = seq >> 3; h = seq & 7; nch = 128; item0 = seq * 128; row0 = b * TP; nvalid = 64;
            stout = P.out + OFF_STP + ((size_t)(j * 4 + b) * 8 + h) * 16384;
#pragma unroll
            for (int mt = 0; mt < 8; ++mt) st[mt] = (f32x4){0.f, 0.f, 0.f, 0.f};
        } else {
            const int s = seq - 32; b = s >> 3; h = s & 7; nch = 1; item0 = NITEM_P + s; row0 = MP + b * TS; nvalid = TS;
            stout = P.out + OFF_STS + ((size_t)(j * 16 + b) * 8 + h) * 16384;
            const float* s0 = P.in[4] + ((size_t)(j * 16 + b) * 8 + h) * 16384;
            const unsigned s0o = (unsigned)(4 * fq * 128 + dvc);
#pragma unroll
            for (int mt = 0; mt < 8; ++mt)
#pragma unroll
                for (int i = 0; i < 4; ++i) st[mt][i] = s0[(unsigned)((16 * mt + i) * 128) + s0o];
        }
        const float onw = P.in[16][j * 128 + dvc];
        f32x4 un[4];
#define SCAN_G2L(itm, bufi, LN) do { const unsigned char* _ib = ws + WS_R1 + (size_t)(itm) * ITEM_BYTES + 32768; \
            _Pragma("unroll") for (int _p = 0; _p < 7; ++_p) { const int _L = (wid + 8 * _p) * 1024 + (LN) * 16; unsigned _src; \
                if (_p < 4) { const int _row = _L >> 8, _ch = (_L >> 4) & 15; _src = (_L & ~255) + ((_ch ^ (_row & 15)) << 4); } \
                else { const int _a = _L - 32768, _row = _a >> 7, _ch = (_a >> 4) & 7; _src = 32768 + (_a & ~127) + ((_ch ^ ((_row >> 1) & 7)) << 4); } \
                g2l16(_ib + _src, lds_u32(lds + (bufi) * BUFB + (wid + 8 * _p) * 1024)); } } while (0)
#define SCAN_LOADU(itm) do { const float* _u = (const float*)(ws + WS_R1 + (size_t)(itm) * ITEM_BYTES); const unsigned _uo = (unsigned)((16 * wid + fr) * 64 + 4 * fq); \
            _Pragma("unroll") for (int _m = 0; _m < 4; ++_m) un[_m] = *(const f32x4*)(_u + (unsigned)(16 * _m) + _uo); } while (0)
        __syncthreads();
        SCAN_G2L(item0, 0, lane);
        SCAN_LOADU(item0);
        float gln = GL[item0];
        asm volatile("s_waitcnt vmcnt(0)" ::: "memory");
        __syncthreads();
        for (int c = 0; c < nch; ++c) {
            int frq = lane; asm volatile("" : "+v"(frq));
            const int fr = frq & 15, fq = frq >> 4;
            LAS unsigned char* bb = lds + (c & 1) * BUFB;
            const float gl = gln;
            f32x4 u[4];
#pragma unroll
            for (int mt = 0; mt < 4; ++mt) u[mt] = un[mt];
            if (c + 1 < nch) { gln = GL[item0 + c + 1]; SCAN_G2L(item0 + c + 1, (c + 1) & 1, frq); SCAN_LOADU(item0 + c + 1); }
            const int x16 = fr << 4, x8 = ((fr >> 1) & 7) << 4;
            bf16x8 sf[4];
#pragma unroll
            for (int ks = 0; ks < 4; ++ks) {
                u32x4 w; w.x = pk2(-st[2 * ks][0], -st[2 * ks][1]); w.y = pk2(-st[2 * ks][2], -st[2 * ks][3]); w.z = pk2(-st[2 * ks + 1][0], -st[2 * ks + 1][1]); w.w = pk2(-st[2 * ks + 1][2], -st[2 * ks + 1][3]);
                sf[ks] = __builtin_bit_cast(bf16x8, w);
            }
            bf16x8 fa[4], fb[4];
#define SC_LD256(dst, base, mt) do { _Pragma("unroll") for (int _k = 0; _k < 4; ++_k) \
                dst[_k] = *(const LAS bf16x8*)(bb + (base) + (16 * (mt) + fr) * 256 + ((((4 * _k + fq) << 4)) ^ x16)); } while (0)
#define SC_LD128(dst, base, mtlo) do { _Pragma("unroll") for (int _m = 0; _m < 2; ++_m) _Pragma("unroll") for (int _k = 0; _k < 2; ++_k) \
                dst[_m * 2 + _k] = *(const LAS bf16x8*)(bb + (base) + (16 * ((mtlo) + _m) + fr) * 128 + ((((4 * _k + fq) << 4)) ^ x8)); } while (0)
#define SC_SB __builtin_amdgcn_sched_barrier(0)
#define SC_MU(f, mt) do { _Pragma("unroll") for (int _k = 0; _k < 4; ++_k) u[mt] = MFMA16(f[_k], sf[_k], u[mt]); } while (0)
#define SC_MO(f, mt) do { _Pragma("unroll") for (int _k = 0; _k < 4; ++_k) o[mt] = MFMA16(f[_k], sf[_k], o[mt]); } while (0)
#define SC_MQK(f, mtlo) do { _Pragma("unroll") for (int _m = 0; _m < 2; ++_m) _Pragma("unroll") for (int _k = 0; _k < 2; ++_k) o[(mtlo) + _m] = MFMA16(f[_m * 2 + _k], uf[_k], o[(mtlo) + _m]); } while (0)
#define SC_MKD(f, mtlo) do { _Pragma("unroll") for (int _m = 0; _m < 2; ++_m) { st[(mtlo) + _m] = st[(mtlo) + _m] * gl; _Pragma("unroll") for (int _k = 0; _k < 2; ++_k) st[(mtlo) + _m] = MFMA16(f[_m * 2 + _k], uf[_k], st[(mtlo) + _m]); } } while (0)
            f32x4 o[4];
#pragma unroll
            for (int mt = 0; mt < 4; ++mt) o[mt] = (f32x4){0.f, 0.f, 0.f, 0.f};
            SC_LD256(fa, 0, 0); SC_LD256(fb, 0, 1); SC_SB;
            SC_MU(fa, 0); SC_LD256(fa, 0, 2); SC_SB;
            SC_MU(fb, 1); SC_LD256(fb, 0, 3); SC_SB;
            SC_MU(fa, 2); SC_LD256(fa, 16384, 0); SC_SB;
            SC_MU(fb, 3); SC_LD256(fb, 16384, 1); SC_SB;
#pragma unroll
            for (int ks = 0; ks < 4; ++ks) sf[ks] = sf[ks] ^ (short)0x8000;
            SC_MO(fa, 0); SC_LD256(fa, 16384, 2); SC_SB;
            SC_MO(fb, 1); SC_LD256(fb, 16384, 3); SC_SB;
            SC_MO(fa, 2); SC_LD128(fa, 49152, 0); SC_SB;
            SC_MO(fb, 3); SC_LD128(fb, 49152, 2); SC_SB;
            bf16x8 uf[2];
#pragma unroll
            for (int k2 = 0; k2 < 2; ++k2) {
                u32x4 w; w.x = pk2(u[2 * k2][0], u[2 * k2][1]); w.y = pk2(u[2 * k2][2], u[2 * k2][3]); w.z = pk2(u[2 * k2 + 1][0], u[2 * k2 + 1][1]); w.w = pk2(u[2 * k2 + 1][2], u[2 * k2 + 1][3]);
                uf[k2] = __builtin_bit_cast(bf16x8, w);
            }
            SC_MQK(fa, 0); SC_LD128(fa, 32768, 0); SC_SB;
            SC_MQK(fb, 2); SC_LD128(fb, 32768, 2); SC_SB;
            SC_MKD(fa, 0); SC_LD128(fa, 32768, 4); SC_SB;
            SC_MKD(fb, 2); SC_LD128(fb, 32768, 6); SC_SB;
            SC_MKD(fa, 4); SC_SB;
            SC_MKD(fb, 6);
#undef SC_MU
#undef SC_MO
#undef SC_MQK
#undef SC_MKD
#undef SC_LD256
#undef SC_LD128
#undef SC_SB
            {
                bf16_t* obb = ORAW + (size_t)(row0 + 64 * c) * 1024 + h * 128;
                const unsigned oo = (unsigned)(4 * fq * 1024 + 16 * wid + fr);
#pragma unroll
                for (int mt = 0; mt < 4; ++mt)
#pragma unroll
                    for (int i = 0; i < 4; ++i) {
                        const int lr = 16 * mt + 4 * fq + i;
                        const bf16_t ob = f2bf(o[mt][i]);
                        if (lr < nvalid) obb[(unsigned)((16 * mt + i) * 1024) + oo] = ob;
                    }
            }
            asm volatile("s_waitcnt vmcnt(0)" ::: "memory");
            __syncthreads();
        }
        {
            int lz = lane; asm volatile("" : "+v"(lz));
            const unsigned so = (unsigned)(4 * (lz >> 4) * 128 + 16 * wid + (lz & 15));
#pragma unroll
            for (int mt = 0; mt < 8; ++mt)
#pragma unroll
                for (int i = 0; i < 4; ++i) stout[(unsigned)((16 * mt + i) * 128) + so] = st[mt][i];
        }
#undef SCAN_G2L
#undef SCAN_LOADU
    }
    if (G < 192) convert_cache(P, j, 0, G);
}

DI void phase_gnorm(const Params& P, int layer) {
    int tid_ = threadIdx.x; asm volatile("" : "+v"(tid_)); const int tid = tid_, wid = __builtin_amdgcn_readfirstlane(tid >> 6), lane = tid & 63, G = gridDim.x;
    unsigned char* ws = P.ws;
    const int j = layer >> 1;
    const bf16_t* ORAW = (const bf16_t*)(ws + WS_ORAWB);
    const bf16_t* proj = (const bf16_t*)(ws + WS_PROJ);
    bf16_t* OB = (bf16_t*)(ws + WS_HBUF);
    float onw[16];
#pragma unroll
    for (int e = 0; e < 16; ++e) onw[e] = P.in[16][j * 128 + ((16 * lane + e) & 127)];
    for (int r = blockIdx.x * 8 + wid; r < M; r += G * 8) {
        const u32x4 o0 = *(const u32x4*)(ORAW + (size_t)r * 1024 + 16 * lane), o1 = *(const u32x4*)(ORAW + (size_t)r * 1024 + 16 * lane + 8);
        const u32x4 z0 = *(const u32x4*)(proj + (size_t)r * NPROJ + 3072 + 16 * lane), z1 = *(const u32x4*)(proj + (size_t)r * NPROJ + 3072 + 16 * lane + 8);
        float ov[16], zv[16];
        { float t8[8]; unpack8(o0, t8);
#pragma unroll
          for (int e = 0; e < 8; ++e) ov[e] = t8[e];
          unpack8(o1, t8);
#pragma unroll
          for (int e = 0; e < 8; ++e) ov[8 + e] = t8[e];
          unpack8(z0, t8);
#pragma unroll
          for (int e = 0; e < 8; ++e) zv[e] = t8[e];
          unpack8(z1, t8);
#pragma unroll
          for (int e = 0; e < 8; ++e) zv[8 + e] = t8[e]; }
        float ss = 0.f;
#pragma unroll
        for (int e = 0; e < 16; ++e) ss += ov[e] * ov[e];
        ss += __shfl_xor(ss, 1); ss += __shfl_xor(ss, 2); ss += __shfl_xor(ss, 4);
        const float rstd = __builtin_amdgcn_rsqf(ss * (1.f / 128.f) + RMS_EPS);
        float y[16];
#pragma unroll
        for (int e = 0; e < 16; ++e) y[e] = ov[e] * rstd * onw[e] * siluf(zv[e]);
        u32x4 w0, w1;
        w0.x = pk2(y[0], y[1]); w0.y = pk2(y[2], y[3]); w0.z = pk2(y[4], y[5]); w0.w = pk2(y[6], y[7]);
        w1.x = pk2(y[8], y[9]); w1.y = pk2(y[10], y[11]); w1.z = pk2(y[12], y[13]); w1.w = pk2(y[14], y[15]);
        *(u32x4*)(OB + (size_t)r * 1024 + 16 * lane) = w0; *(u32x4*)(OB + (size_t)r * 1024 + 16 * lane + 8) = w1;
    }
}

DI void att_s(LAS unsigned char* Ka, int t, const bf16x8 (&qf)[4], f32x16& s0, f32x16& s1) {
#pragma unroll
    for (int i = 0; i < 16; ++i) { s0[i] = 0.f; s1[i] = 0.f; }
    bf16x8 kf[8];
#pragma unroll
    for (int s = 0; s < 4; ++s) { kf[2 * s] = *(const LAS bf16x8*)(Ka + (t ^ (s << 5))); kf[2 * s + 1] = *(const LAS bf16x8*)(Ka + 8192 + (t ^ (s << 5))); }
#pragma unroll
    for (int s = 0; s < 4; ++s) { s0 = MFMA32(kf[2 * s], qf[s], s0); s1 = MFMA32(kf[2 * s + 1], qf[s], s1); }
}
template <bool MASK>
DI float att_softmax(f32x16& s0, f32x16& s1, float& m, float& l, bf16x8 (&pf)[2][2], int h2, int nvk) {
    if (MASK) {
#pragma unroll
        for (int i = 0; i < 16; ++i) {
            const int key = (i & 3) + 8 * (i >> 2) + 4 * h2;
            s0[i] = (key < nvk) ? s0[i] : -INFINITY;
            s1[i] = (32 + key < nvk) ? s1[i] : -INFINITY;
        }
    }
    float mx = s0[0];
#pragma unroll
    for (int i = 1; i < 16; ++i) mx = fmaxf(mx, s0[i]);
#pragma unroll
    for (int i = 0; i < 16; ++i) mx = fmaxf(mx, s1[i]);
    mx = fmaxf(mx, __shfl_xor(mx, 32));
    const float mn = fmaxf(m, mx);
    const float alpha = __builtin_amdgcn_exp2f(m - mn);
    m = mn;
    float ps = 0.f;
#pragma unroll
    for (int i = 0; i < 16; ++i) { s0[i] = __builtin_amdgcn_exp2f(s0[i] - mn); s1[i] = __builtin_amdgcn_exp2f(s1[i] - mn); ps += s0[i] + s1[i]; }
    l = l * alpha + ps;
    u32x4 w;
    w.x = pk2(s0[0], s0[1]); w.y = pk2(s0[2], s0[3]); w.z = pk2(s0[4], s0[5]); w.w = pk2(s0[6], s0[7]); pf[0][0] = __builtin_bit_cast(bf16x8, w);
    w.x = pk2(s0[8], s0[9]); w.y = pk2(s0[10], s0[11]); w.z = pk2(s0[12], s0[13]); w.w = pk2(s0[14], s0[15]); pf[0][1] = __builtin_bit_cast(bf16x8, w);
    w.x = pk2(s1[0], s1[1]); w.y = pk2(s1[2], s1[3]); w.z = pk2(s1[4], s1[5]); w.w = pk2(s1[6], s1[7]); pf[1][0] = __builtin_bit_cast(bf16x8, w);
    w.x = pk2(s1[8], s1[9]); w.y = pk2(s1[10], s1[11]); w.z = pk2(s1[12], s1[13]); w.w = pk2(s1[14], s1[15]); pf[1][1] = __builtin_bit_cast(bf16x8, w);
    return alpha;
}
DI void att_pv(LAS unsigned char* Va, int q4, f32x16 (&O)[4], const bf16x8 (&pf)[2][2]) {
    s16x4 lo[16], hi[16];
#define PV_LD(i) do { LAS unsigned char* _vp = Va + ((((i) >> 2) ^ q4) << 6) + (32 * (((i) >> 1) & 1) + 16 * ((i) & 1)) * 256; \
        lo[i] = __builtin_amdgcn_ds_read_tr16_b64_v4i16((LAS s16x4*)_vp); hi[i] = __builtin_amdgcn_ds_read_tr16_b64_v4i16((LAS s16x4*)(_vp + 8 * 256)); } while (0)
    PV_LD(0); PV_LD(1); PV_LD(2);
#pragma unroll
    for (int i = 0; i < 16; ++i) {
        if (i + 3 < 16) PV_LD(i + 3);
        const bf16x8 vf = __builtin_shufflevector(lo[i], hi[i], 0, 1, 2, 3, 4, 5, 6, 7);
        O[i >> 2] = MFMA32(vf, pf[(i >> 1) & 1][i & 1], O[i >> 2]);
    }
#undef PV_LD
}

DI void phase_attn(const Params& P, LAS unsigned char* lds, int layer) {
    int tid_ = threadIdx.x; asm volatile("" : "+v"(tid_)); const int tid = tid_, wid = __builtin_amdgcn_readfirstlane(tid >> 6), lane = tid & 63, G = gridDim.x;
    unsigned char* ws = P.ws;
    const int j = layer >> 1;
    const int comp = wid >> 2, rg = wid & 3, r32 = lane & 31, h2 = lane >> 5;
    const bf16_t* proj = (const bf16_t*)(ws + WS_PROJ);
    bf16_t* OB = (bf16_t*)(ws + WS_HBUF);
    const float lam_init = 0.8f - 0.6f * expf(-0.3f * (float)layer);
    float lam;
    {
        float d1 = 0.f, d2 = 0.f;
        for (int i = 0; i < 64; ++i) { d1 += P.in[19][j * 64 + i] * P.in[20][j * 64 + i]; d2 += P.in[21][j * 64 + i] * P.in[22][j * 64 + i]; }
        lam = expf(d1) - expf(d2) + lam_init;
    }
    const float* subln = P.in[23] + j * 128;
    constexpr int TB = 32768;
    const int vb = (G % 8 == 0) ? (blockIdx.x % 8) * (G / 8) + blockIdx.x / 8 : blockIdx.x;
    const int nrounds = (G == 256) ? 9 : (2176 + G - 1) / G;
#define ATT_WAITV(n) asm volatile("s_waitcnt vmcnt(" #n ")" ::: "memory")
#define ATT_BAR() do { asm volatile("" ::: "memory"); __builtin_amdgcn_s_barrier(); asm volatile("" ::: "memory"); } while (0)
    for (int k = 0; k < nrounds; ++k) {
        int id;
        if (G == 256) {
            if (k < 8) { const int xcd = vb >> 5, idx = vb & 31; const int seq = xcd * 4 + (k >> 1); const int qt = (k & 1) ? idx : (63 - idx); id = seq * 64 + qt; }
            else { if (vb >= 128) break; id = 2048 + vb; }
        } else { id = vb + k * G; if (id >= 2176) break; }
        int h, qrow0, nt_all, nt_mine, last_valid; const int kvstride = 128; const bf16_t* Kp; const bf16_t* Vp; bool sample;
        if (id < 2048) {
            const int seq = id >> 6, qt = id & 63, b = seq >> 3; h = seq & 7; sample = false;
            qrow0 = b * TP + 128 * qt + 32 * rg; nt_all = 2 * qt + 2; nt_mine = (rg < 2) ? 2 * qt + 1 : 2 * qt + 2; last_valid = 64 * nt_mine;
            Kp = (const bf16_t*)(ws + WS_KH) + (size_t)seq * TP * 128; Vp = (const bf16_t*)(ws + WS_VH) + (size_t)seq * TP * 128;
        } else {
            const int s = id - 2048, b = s >> 3; h = s & 7; sample = true;
            qrow0 = MP + b * TS; nt_all = 34; nt_mine = (rg == 0) ? 34 : 0; last_valid = PAST + TS;
            Kp = (const bf16_t*)(ws + WS_KS) + (size_t)s * KSROWS * 128; Vp = (const bf16_t*)(ws + WS_VS) + (size_t)s * KSROWS * 128;
        }
        bf16x8 qf[4];
        {
            const int qr = qrow0 + (sample ? (r32 & 15) : r32);
            const bf16_t* qp = proj + (size_t)qr * NPROJ + h * 128 + comp * 64 + 8 * h2;
#pragma unroll
            for (int s = 0; s < 4; ++s) qf[s] = *(const bf16x8*)(qp + 16 * s);
        }
        f32x16 O[4];
#pragma unroll
        for (int et = 0; et < 4; ++et)
#pragma unroll
            for (int i = 0; i < 16; ++i) O[et][i] = 0.f;
        float m = -INFINITY, l = 0.f;
        bf16x8 pf[2][2];
#pragma unroll
        for (int a = 0; a < 2; ++a)
#pragma unroll
            for (int c2 = 0; c2 < 2; ++c2) pf[a][c2] = (bf16x8){0, 0, 0, 0, 0, 0, 0, 0};
        f32x16 sA0, sA1, sB0, sB1;
        const bf16_t* gsrc;
        {
            const int rowl = lane >> 4, c = lane & 15;
            const int row0 = 16 * (wid & 3) + rowl;
            const int lc = (wid < 4) ? (c ^ (row0 & 15)) : (c ^ ((row0 & 3) << 2));
            gsrc = ((wid < 4) ? Kp : Vp) + (size_t)row0 * kvstride + lc * 8;
        }
#define ATT_G2L(kt, bufi) do { _Pragma("unroll") for (int _i = 0; _i < 4; ++_i) { \
            const bf16_t* _s = gsrc + (size_t)(64 * (kt) + 4 * _i) * kvstride; \
            if (wid < 4) _s += (((lane & 15) ^ ((16 * (wid & 3) + 4 * _i + (lane >> 4)) & 15)) - ((lane & 15) ^ ((16 * (wid & 3) + (lane >> 4)) & 15))) * 8; \
            g2l16(_s, lds_u32(lds + (bufi) * TB + (4 * wid + _i) * 1024)); } } while (0)
        ATT_G2L(0, 0);
        if (nt_all > 1) ATT_G2L(1, 1);
        asm volatile("" :: "v"(qf[0]), "v"(qf[1]), "v"(qf[2]), "v"(qf[3]));
        if (nt_all > 1) { ATT_WAITV(4); } else { ATT_WAITV(0); }
        ATT_BAR();
        {
            const int koff = r32 * 256, t = ((comp * 8 + h2) ^ (r32 & 15)) << 4;
            att_s(lds + koff, t, qf, sA0, sA1);
        }
#define ATT_ITER(KT, sC0, sC1, sN0, sN1, EDGE) do { \
            const int kt = (KT); \
            int lo_ = lane; asm volatile("" : "+v"(lo_)); \
            const int r32_ = lo_ & 31, h2_ = lo_ >> 5, q4_ = (lo_ & 15) >> 2, p4_ = lo_ & 3, blk_ = (lo_ >> 4) & 1; \
            const int koff_ = r32_ * 256, t_ = ((comp * 8 + h2_) ^ (r32_ & 15)) << 4; \
            const int voff_ = (4 * h2_ + q4_) * 256 + (2 * blk_ + (p4_ >> 1)) * 16 + (p4_ & 1) * 8; \
            ATT_WAITV(0); ATT_BAR(); \
            if (kt + 2 < nt_all) ATT_G2L(kt + 2, (kt + 2) & 3); \
            att_s(lds + ((kt + 1) & 3) * TB + koff_, t_, qf, sN0, sN1); \
            if (!(EDGE) || kt >= 1) att_pv(lds + ((kt - 1) & 3) * TB + 16384 + voff_, q4_, O, pf); \
            const float alpha = att_softmax<EDGE>(sC0, sC1, m, l, pf, h2_, last_valid - 64 * kt); \
            asm volatile("" :: "v"(l), "v"(pf[0][0]), "v"(pf[0][1]), "v"(pf[1][0]), "v"(pf[1][1]));     \
            _Pragma("unroll") for (int _g = 0; _g < 24; ++_g) { __builtin_amdgcn_sched_group_barrier(0x008, 1, 0); __builtin_amdgcn_sched_group_barrier(0x002, 5, 0); } \
            if (__any(alpha != 1.f)) { \
                _Pragma("unroll") for (int et = 0; et < 4; ++et) _Pragma("unroll") for (int i = 0; i < 16; ++i) O[et][i] *= alpha; } \
            } while (0)
        {
            const int npairs = nt_all >> 1;
            ATT_ITER(0, sA0, sA1, sB0, sB1, true);
            ATT_ITER(1, sB0, sB1, sA0, sA1, true);
            for (int pp = 1; pp < npairs - 1; ++pp) {
                ATT_ITER(2 * pp, sA0, sA1, sB0, sB1, false);
                ATT_ITER(2 * pp + 1, sB0, sB1, sA0, sA1, false);
            }
            if (npairs > 1) {
                ATT_ITER(nt_all - 2, sA0, sA1, sB0, sB1, true);
                ATT_ITER(nt_all - 1, sB0, sB1, sA0, sA1, true);
            }
        }
        {
            const int lt = nt_all - 1;
            const int h2b = lane >> 5, q4 = (lane & 15) >> 2, p4 = lane & 3, blk = (lane >> 4) & 1;
            const int voff = (4 * h2b + q4) * 256 + (2 * blk + (p4 >> 1)) * 16 + (p4 & 1) * 8;
            att_pv(lds + (lt & 3) * TB + 16384 + voff, q4, O, pf);
        }
        __syncthreads();
#undef ATT_ITER
#undef ATT_G2L
        const float lt = l + __shfl_xor(l, 32);
        const float inv = (nt_mine > 0) ? 1.f / lt : 0.f;
        LAS float* XO = (LAS float*)lds;
        if (comp == 1) {
            const float sc = inv * lam;
#pragma unroll
            for (int et = 0; et < 4; ++et)
#pragma unroll
                for (int i = 0; i < 16; ++i) XO[(rg * 128 + 32 * et + (i & 3) + 8 * (i >> 2) + 4 * h2) * 32 + r32] = O[et][i] * sc;
        }
        __syncthreads();
        if (comp == 0 && nt_mine > 0) {
            float ss = 0.f;
#pragma unroll
            for (int et = 0; et < 4; ++et)
#pragma unroll
                for (int i = 0; i < 16; ++i) { const float v = O[et][i] * inv - XO[(rg * 128 + 32 * et + (i & 3) + 8 * (i >> 2) + 4 * h2) * 32 + r32]; O[et][i] = v; ss += v * v; }
            ss += __shfl_xor(ss, 32);
            const float rstd = __builtin_amdgcn_rsqf(ss * (1.f / 128.f) + RMS_EPS) * (1.f - lam_init);
            const bool rvalid = sample ? (r32 < TS) : true;
            const int row = qrow0 + r32;
            if (rvalid) {
#pragma unroll
                for (int et = 0; et < 4; ++et)
#pragma unroll
                    for (int g4 = 0; g4 < 4; ++g4) {
                        const int e0 = 32 * et + 8 * g4 + 4 * h2;
                        const u32x2 zz = *(const u32x2*)(proj + (size_t)row * NPROJ + 3072 + h * 128 + e0);
                        const f32x4 sl = *(const f32x4*)(subln + e0);
                        const float z0 = __uint_as_float(zz.x << 16), z1 = __uint_as_float(zz.x & 0xffff0000u), z2 = __uint_as_float(zz.y << 16), z3 = __uint_as_float(zz.y & 0xffff0000u);
                        u32x2 w;
                        w.x = pk2(O[et][4 * g4] * rstd * sl[0] * siluf(z0), O[et][4 * g4 + 1] * rstd * sl[1] * siluf(z1));
                        w.y = pk2(O[et][4 * g4 + 2] * rstd * sl[2] * siluf(z2), O[et][4 * g4 + 3] * rstd * sl[3] * siluf(z3));
                        *(u32x2*)(OB + (size_t)row * 1024 + h * 128 + e0) = w;
                    }
            }
        }
        __syncthreads();
    }
}


#define XB_TMO      128
#define XB_XCNT(j)  (256  + 64 * (j))
#define XB_XSUB(j)  (1280 + 64 * (j))
#define XB_XGEN(j)  (2304 + 64 * (j))
#define XB_TOP      3328
#define XB_TOPGEN   3392
#define XCD_BAR_WORDS 3456
#define XB_SPIN_CAP (1u << 18)
DI unsigned xb_ld(unsigned* p)              { return __hip_atomic_load(p, __ATOMIC_RELAXED, __HIP_MEMORY_SCOPE_AGENT); }
DI unsigned xb_add(unsigned* p, unsigned v) { return __hip_atomic_fetch_add(p, v, __ATOMIC_RELAXED, __HIP_MEMORY_SCOPE_AGENT); }
DI unsigned xb_xcc_id() { return (unsigned)__builtin_amdgcn_s_getreg((3 << 11) | 20) & 0xFu; }
#define XB_SPIN(cond, bar) do { unsigned _sp = 0; while (cond) { __builtin_amdgcn_s_sleep(1); \
    if ((++_sp & 255u) == 0u) { if (xb_ld(&(bar)[XB_TMO])) break; if (_sp > XB_SPIN_CAP) { atomicAdd(&(bar)[XB_TMO], 1u); break; } } } } while (0)
DI void xcd_barrier_complete(unsigned* bar, unsigned x, unsigned& nloc, unsigned& nx) {
    const unsigned G = gridDim.x * gridDim.y * gridDim.z;
    unsigned sum, cnt, mine, sp = 0u;
    for (;;) {
        sum = 0u; cnt = 0u; mine = 0u;
#pragma unroll
        for (unsigned j = 0; j < 16; ++j) { const unsigned c = xb_ld(&bar[XB_XCNT(j)]); sum += c; cnt += (c > 0u) ? 1u : 0u; mine = (j == x) ? c : mine; }
        if (sum == G) break;
        __builtin_amdgcn_s_sleep(1);
        if ((++sp & 255u) == 0u) { if (xb_ld(&bar[XB_TMO])) break; if (sp > XB_SPIN_CAP) { atomicAdd(&bar[XB_TMO], 1u); break; } }
    }
    nloc = mine > 0u ? mine : 1u; nx = cnt > 0u ? cnt : 1u;
}
DI void xcd_barrier(unsigned* bar, volatile LAS unsigned* st) {
    asm volatile("s_waitcnt vmcnt(0)" ::: "memory");
    __syncthreads();
    if (threadIdx.x == 0) {
        const unsigned x = xb_xcc_id();
        __builtin_amdgcn_s_waitcnt(0);
        unsigned nloc = st[0], nx = st[1];
        if (nloc == 0u) { xcd_barrier_complete(bar, x, nloc, nx); st[0] = nloc; st[1] = nx; }
        const unsigned old = xb_add(&bar[XB_XSUB(x)], 1u);
        const unsigned gen = old / nloc;
        if (old + 1u == (gen + 1u) * nloc) {
            __builtin_amdgcn_fence(__ATOMIC_RELEASE, "agent");
            asm volatile("s_waitcnt vmcnt(0)" ::: "memory");
            const unsigned og = xb_add(&bar[XB_TOP], 1u);
            const unsigned tg = og / nx;
            if (og + 1u == (tg + 1u) * nx) xb_add(&bar[XB_TOPGEN], 1u);
            else XB_SPIN(xb_ld(&bar[XB_TOPGEN]) == tg, bar);
            __builtin_amdgcn_fence(__ATOMIC_ACQUIRE, "agent");
            xb_add(&bar[XB_XGEN(x)], 1u);
            asm volatile("s_waitcnt vmcnt(0)" ::: "memory");
        } else {
            XB_SPIN(xb_ld(&bar[XB_XGEN(x)]) == gen, bar);
            __builtin_amdgcn_fence(__ATOMIC_ACQUIRE, "agent");
            asm volatile("s_waitcnt vmcnt(0)" ::: "memory");
        }
    }
    __syncthreads();
}

typedef const __attribute__((address_space(4))) Params* CParP;
#define LOADP() Params P; { CParP kp_ = KP; asm volatile("" : "+s"(kp_)); P = *kp_; } unsigned char* ws = P.ws; (void)ws
__global__ void __launch_bounds__(512, 2) fwd_megakernel(Params Pin) {
#if defined(__HIP_DEVICE_COMPILE__)
    extern __shared__ __attribute__((aligned(16))) unsigned char lds_raw[];
    LAS unsigned char* lds = (LAS unsigned char*)lds_raw;
    cg::grid_group grid = cg::this_grid();
    const CParP KP = (CParP)__builtin_amdgcn_kernarg_segment_ptr();
    volatile LAS unsigned* xst = (volatile LAS unsigned*)(lds + 131072);
    if (threadIdx.x == 0) { xst[0] = 0u; xst[1] = 0u; }
    __syncthreads();
    { LOADP(); if (threadIdx.x == 0) (void)xb_add(&((unsigned*)(ws + WS_BAR))[XB_XCNT(xb_xcc_id())], 1u); }
#define GRID_BAR() do { LOADP(); xcd_barrier((unsigned*)(ws + WS_BAR), xst); } while (0)
    { LOADP(); phase_prep(P, lds); }
    grid.sync();
    for (int layer = 0; layer < 4; ++layer) {
        const int j = layer >> 1;
        { LOADP(); phase_elem(P, lds, layer); }
        GRID_BAR();
        {
            LOADP();
            pg8::StaticOrder S; S.init(M, NPROJ, gridDim.x, blockIdx.x);
            pg8::Gemm g;
            g.A = (const bf16_t*)(ws + WS_HBUF); g.M = M; g.N = NPROJ; g.K = 1024;
            if (!(layer & 1)) {
                g.Bt = (const bf16_t*)(ws + WS_WING) + (size_t)j * 4096 * 1024;
                EpiGdnIn E; E.proj = (bf16_t*)(ws + WS_PROJ); E.conv_p = P.out + OFF_CVP + (size_t)j * 4 * 3 * 3072; E.conv_s = P.out + OFF_CVS + (size_t)j * 16 * 3 * 3072;
                pg8::gemm_phase(lds, g, S, E);
            } else {
                g.Bt = (const bf16_t*)(ws + WS_WIND) + (size_t)j * 4096 * 1024;
                EpiDiffIn E; E.proj = (bf16_t*)(ws + WS_PROJ);
                E.k_p = P.out + OFF_KP + (size_t)j * MP * 1024; E.v_p = P.out + OFF_VP + (size_t)j * MP * 1024;
                E.k_s = P.out + OFF_KSO + (size_t)j * MS * 1024; E.v_s = P.out + OFF_VSO + (size_t)j * MS * 1024;
                E.ks = (bf16_t*)(ws + WS_KS); E.vs = (bf16_t*)(ws + WS_VS); E.kh = (bf16_t*)(ws + WS_KH); E.vh = (bf16_t*)(ws + WS_VH); E.rope = (const float*)(ws + WS_ROPE);
                pg8::gemm_phase(lds, g, S, E);
            }
        }
        GRID_BAR();
        if (!(layer & 1)) {
            { LOADP(); phase_g1(P, lds, layer); }
            GRID_BAR();
            { LOADP(); phase_scan(P, lds, layer); }
            GRID_BAR();
            { LOADP(); phase_gnorm(P, layer); }
        } else {
            { LOADP(); phase_attn(P, lds, layer); }
        }
        GRID_BAR();
        {
            LOADP();
            pg8::StaticOrder S; S.init(M, 1024, gridDim.x, blockIdx.x);
            pg8::Gemm g;
            g.A = (const bf16_t*)(ws + WS_HBUF); g.M = M; g.N = 1024; g.K = 1024;
            g.Bt = (const bf16_t*)(ws + ((layer & 1) ? WS_WOUTD : WS_WOUTG)) + (size_t)j * 1024 * 1024;
            EpiOut E; E.C = (bf16_t*)(ws + WS_PROJ);
            pg8::gemm_phase(lds, g, S, E);
        }
        GRID_BAR();
    }
    { LOADP(); phase_elem(P, lds, 4); }
#endif
}

extern "C" void kernel_launch(void* const* d_in, const int* in_sizes, int n_in, void* d_out, int out_size, void* d_ws, size_t ws_size, hipStream_t stream) {
    static int grid_blocks = 0;
    if (!grid_blocks) {
        int dev = 0, cus = 0, per_cu = 0;
        hipGetDevice(&dev);
        hipDeviceGetAttribute(&cus, hipDeviceAttributeMultiprocessorCount, dev);
        hipFuncSetAttribute((const void*)fwd_megakernel, hipFuncAttributeMaxDynamicSharedMemorySize, LDS_BYTES);
        hipOccupancyMaxActiveBlocksPerMultiprocessor(&per_cu, (const void*)fwd_megakernel, 512, LDS_BYTES);
        if (per_cu < 1) per_cu = 1;
        grid_blocks = cus * per_cu;
        if (ws_size < WS_END) fprintf(stderr, "kernel_launch: workspace too small: %zu < %zu\n", ws_size, (size_t)WS_END);
    }
    hipMemsetAsync((unsigned char*)d_ws + WS_BAR, 0, XCD_BAR_WORDS * sizeof(unsigned), stream);
    Params p{};
    for (int i = 0; i < 25; ++i) p.in[i] = (const float*)d_in[i];
    p.out = (float*)d_out; p.ws = (unsigned char*)d_ws;
    void* args[] = {&p};
    hipError_t e = hipLaunchCooperativeKernel((const void*)fwd_megakernel, dim3(grid_blocks), dim3(512), args, LDS_BYTES, stream);
    if (e != hipSuccess) fprintf(stderr, "cooperative launch failed: %s (grid %d)\n", hipGetErrorString(e), grid_blocks);
}
```

```cpp
#include <hip/hip_runtime.h>
#include <hip/hip_cooperative_groups.h>
#include <cstdio>
namespace cg = cooperative_groups;

#define DI __device__ __forceinline__
#define LAS __attribute__((address_space(3)))
typedef unsigned short bf16_t;
typedef short bf16x8 __attribute__((ext_vector_type(8)));
typedef short s16x4 __attribute__((ext_vector_type(4)));
typedef float f32x2 __attribute__((ext_vector_type(2)));
typedef float f32x4 __attribute__((ext_vector_type(4)));
typedef float f32x16 __attribute__((ext_vector_type(16)));
typedef unsigned u32x2 __attribute__((ext_vector_type(2)));
typedef unsigned u32x4 __attribute__((ext_vector_type(4)));
typedef __bf16 bf16x2_t __attribute__((ext_vector_type(2)));

#define REP_G1 1
#define REP_SCAN 1
#define REP_ATTN 1
#define REP_GIN 1
#define REP_GOUT 1
#define REP_PREP 1
DI int opaque_i(int v) { asm volatile("" : "+s"(v)); return v; }
constexpr int D = 1024, TP = 8192, BP = 4, BS = 16, TS = 16, PAST = 2048;
constexpr int MP = BP * TP, MS = BS * TS, M = MP + MS, NB = BP + BS;
constexpr int NPROJ = 4096;
constexpr int KSROWS = 2112;
constexpr int NITEM_P = 4096, NITEM = 4224;
constexpr size_t ITEM_BYTES = 90112;
constexpr float RMS_EPS = 1e-6f;
constexpr float QSCALE = 0.125f * 1.4426950408889634f;

constexpr size_t OFF_Y = 0;
constexpr size_t OFF_STP = (size_t)M * D;
constexpr size_t OFF_CVP = OFF_STP + 2ull * 4 * 8 * 128 * 128;
constexpr size_t OFF_KP = OFF_CVP + 2ull * 4 * 3 * 3072;
constexpr size_t OFF_VP = OFF_KP + 2ull * MP * 1024;
constexpr size_t OFF_STS = OFF_VP + 2ull * MP * 1024;
constexpr size_t OFF_CVS = OFF_STS + 2ull * 16 * 8 * 128 * 128;
constexpr size_t OFF_KSO = OFF_CVS + 2ull * 16 * 3 * 3072;
constexpr size_t OFF_VSO = OFF_KSO + 2ull * MS * 1024;

constexpr size_t WS_WING = 0;
constexpr size_t WS_WOUTG = WS_WING + 2ull * 4096 * 1024 * 2;
constexpr size_t WS_WIND = WS_WOUTG + 2ull * 1024 * 1024 * 2;
constexpr size_t WS_WOUTD = WS_WIND + 2ull * 4096 * 1024 * 2;
constexpr size_t WS_ADA = WS_WOUTD + 2ull * 1024 * 1024 * 2;
constexpr size_t WS_ROPE = WS_ADA + 4ull * NB * 3072 * 4;
constexpr size_t WS_AB = WS_ROPE + 8208ull * 64 * 4;
constexpr size_t WS_GL = WS_AB + (size_t)M * 16 * 4;
constexpr size_t WS_BAR = WS_GL + 17408;
constexpr size_t WS_HBUF = WS_GL + 32768;
constexpr size_t WS_ORAW = WS_HBUF + (size_t)M * 1024 * 2;
constexpr size_t WS_PROJ = WS_ORAW + 256;
constexpr size_t WS_R1 = WS_PROJ + (size_t)M * 4096 * 2;
constexpr size_t WS_KH = WS_R1;
constexpr size_t WS_VH = WS_KH + (size_t)MP * 1024 * 2;
constexpr size_t WS_ORAWB = WS_R1 + (size_t)NITEM * ITEM_BYTES;
constexpr size_t WS_KS = WS_ORAWB + (size_t)M * 1024 * 2;
constexpr size_t WS_VS = WS_KS + 16ull * KSROWS * 1024 * 2;
constexpr size_t WS_END = WS_VS + 16ull * KSROWS * 1024 * 2;

constexpr int LDS_BYTES = 131072 + 16;

struct Params { const float* in[25]; float* out; unsigned char* ws; };

DI float bf2f(bf16_t v) { return __uint_as_float(((unsigned)v) << 16); }
DI unsigned pk2(float a, float b) { f32x2 v = {a, b}; bf16x2_t r = __builtin_convertvector(v, bf16x2_t); return __builtin_bit_cast(unsigned, r); }
DI bf16_t f2bf(float a) { return (bf16_t)(pk2(a, 0.f) & 0xffffu); }
template <int CTRL> DI float dppf(float v) { return __builtin_bit_cast(float, __builtin_amdgcn_update_dpp(0, __builtin_bit_cast(int, v), CTRL, 0xf, 0xf, true)); }
DI float row_sum16(float v) { v += dppf<0x128>(v); v += dppf<0x124>(v); v += dppf<0x122>(v); v += dppf<0x121>(v); return v; }
DI float wave_sum(float v) { v = row_sum16(v); v += __shfl_xor(v, 16); v += __shfl_xor(v, 32); return v; }
DI float readlane_f(float v, int l) { return __builtin_bit_cast(float, __builtin_amdgcn_readlane(__builtin_bit_cast(int, v), l)); }
DI float siluf(float x) { return x * __builtin_amdgcn_rcpf(1.f + __expf(-x)); }
DI int ppos(int idx) { const int d5 = idx & 31; return (idx & ~31) | (((d5 >> 2) & 3) << 3) | ((d5 >> 4) << 2) | (d5 & 3); }
DI int perm64(int ls) { return (ls & 15) | (((ls >> 4) & 1) << 5) | (((ls >> 5) & 1) << 4); }
DI void unpack8(const u32x4 v, float (&o)[8]) {
#pragma unroll
    for (int i = 0; i < 4; ++i) { o[2 * i] = __uint_as_float(v[i] << 16); o[2 * i + 1] = __uint_as_float(v[i] & 0xffff0000u); }
}
DI void g2l16(const void* gptr, unsigned lds_addr) {
    asm volatile("s_mov_b32 m0, %1\n\ts_nop 0\n\tglobal_load_lds_dwordx4 %0, off" :: "v"(gptr), "s"(lds_addr) : "memory", "m0");
}
DI unsigned lds_u32(LAS unsigned char* p) { return (unsigned)(size_t)p; }
#define MFMA16(a, b, c) __builtin_amdgcn_mfma_f32_16x16x32_bf16((a), (b), (c), 0, 0, 0)
#define MFMA32(a, b, c) __builtin_amdgcn_mfma_f32_32x32x16_bf16((a), (b), (c), 0, 0, 0)

namespace pg8 {
constexpr int BM = 256, BK = 64, HALF = 128, HTB = HALF * BK * 2, STAGE_BYTES = 8 * HTB, NXCD = 8, WGM = 8;
DI int lds_byte(int r, int c) { const int st = (r >> 4) * 2 + (c >> 5), rr = r & 15, cc = c & 31, ob = rr * 64 + cc * 2; return st * 1024 + (ob ^ (((ob >> 9) & 1) << 5)); }
DI void stage_rc(int b, int& R, int& C) { const int st = b / 1024, sb = b % 1024, swz = sb ^ (((sb >> 9) & 1) << 5); R = (st >> 1) * 16 + swz / 64; C = (st & 1) * 32 + (swz % 64) / 2; }
struct Unit { int pm, pn; };
struct Gemm { const bf16_t* A; const bf16_t* Bt; int M, N, K; };
struct StaticOrder {
    int nM, nN, nwg, G, c;
    DI void init(int M_, int N_, int G_, int c_) { nM = M_ / BM; nN = N_ / BM; nwg = nM * nN; G = G_; c = c_; }
    DI bool next(int i, Unit& u) const {
        const long L = (long)i * G + c; if (L >= nwg) return false;
        int wgid = (int)L; { const int q = nwg / NXCD, r = nwg % NXCD, xcd = wgid % NXCD, off = wgid / NXCD; wgid = (xcd < r ? xcd * (q + 1) : r * (q + 1) + (xcd - r) * q) + off; }
        const int nig = WGM * nN, gid = wgid / nig, fm = gid * WGM, gsz = (nM - fm) < WGM ? (nM - fm) : WGM;
        u.pm = fm + ((wgid % nig) % gsz); u.pn = (wgid % nig) / gsz; return true;
    }
};

template <class Epi>
DI void gemm_phase(LAS unsigned char* lds, const Gemm g, const StaticOrder& S, const Epi& E) {
    int tid_ = threadIdx.x; asm volatile("" : "+v"(tid_)); const int tid = tid_, wid = __builtin_amdgcn_readfirstlane(tid >> 6), lane = tid & 63, wr = wid >> 2, wc = wid & 3, fr = lane & 15, fq = lane >> 4;
    const int K = g.K, nt = K / BK;
    unsigned voffA[2];
#pragma unroll
    for (int i = 0; i < 2; ++i) { int R, C; stage_rc(tid * 16 + i * 8192, R, C); voffA[i] = (unsigned)(R * K + C) * 2u; }
    const size_t kstep = (size_t)(BK * 2);
    const size_t hstep = (size_t)HALF * K * 2;
    const size_t tstep = 2 * hstep;
    const unsigned ldsw = (unsigned)wid * 1024u;
    const int aoff = lds_byte(wr * 64 + fr, fq * 8), boff = lds_byte(wc * 32 + fr, fq * 8);
#define PG8_SA(b, h) (((b) * 2 + (h)) * HTB)
#define PG8_SB(b, h) ((4 + (b) * 2 + (h)) * HTB)
#define PG8_STAGE(bufoff, gbase) do { _Pragma("unroll") for (int _i = 0; _i < 2; ++_i) \
        __builtin_amdgcn_global_load_lds((const unsigned*)((const char*)(gbase) + voffA[_i]), (LAS unsigned*)(lds + (bufoff) + ldsw + _i * 8192), 16, 0, 0); } while (0)
#define PG8_LDA(dst, b, h) do { _Pragma("unroll") for (int m = 0; m < 4; ++m) _Pragma("unroll") for (int k = 0; k < 2; ++k) dst[m][k] = *(const LAS bf16x8*)(lds + PG8_SA(b, h) + aoff + m * 2048 + k * 1024); } while (0)
#define PG8_LDB(dst, b, h) do { _Pragma("unroll") for (int n = 0; n < 2; ++n) _Pragma("unroll") for (int k = 0; k < 2; ++k) dst[n][k] = *(const LAS bf16x8*)(lds + PG8_SB(b, h) + boff + n * 2048 + k * 1024); } while (0)
#define PG8_MMA(ai, bj, At, Bt) do { __builtin_amdgcn_s_setprio(1); _Pragma("unroll") for (int m = 0; m < 4; ++m) _Pragma("unroll") for (int n = 0; n < 2; ++n) _Pragma("unroll") for (int k = 0; k < 2; ++k) \
        acc[ai][bj][m][n] = __builtin_amdgcn_mfma_f32_16x16x32_bf16(Bt[n][k], At[m][k], acc[ai][bj][m][n], 0, 0, 0); __builtin_amdgcn_s_setprio(0); } while (0)
#define PG8_WAIT_V(n) asm volatile("s_waitcnt vmcnt(" #n ")" ::: "memory")
#define PG8_WAIT_L(n) asm volatile("s_waitcnt lgkmcnt(" #n ")" ::: "memory")
#define PG8_BAR __builtin_amdgcn_s_barrier()
#define PG8_SCHED __builtin_amdgcn_sched_barrier(0)
    Unit cur, nxt; int ui = 0;
    if (!S.next(0, cur)) return;
    f32x4 acc[2][2][4][2];
#pragma unroll
    for (int a = 0; a < 2; ++a)
#pragma unroll
        for (int b = 0; b < 2; ++b)
#pragma unroll
            for (int m = 0; m < 4; ++m)
#pragma unroll
                for (int n = 0; n < 2; ++n) acc[a][b][m][n] = (f32x4){0.f, 0.f, 0.f, 0.f};
    bf16x8 At[4][2], B0[2][2], B1[2][2];
    const char* cA = (const char*)g.A + (size_t)cur.pm * tstep; const char* cB = (const char*)g.Bt + (size_t)cur.pn * tstep;
    PG8_STAGE(PG8_SB(0, 0), cB); PG8_STAGE(PG8_SA(0, 0), cA); PG8_STAGE(PG8_SB(0, 1), cB + hstep); PG8_STAGE(PG8_SA(0, 1), cA + hstep);
    if (wr == 1) PG8_BAR;
    PG8_WAIT_V(4); PG8_BAR;
    PG8_STAGE(PG8_SB(1, 0), cB + kstep); PG8_STAGE(PG8_SA(1, 0), cA + kstep); PG8_STAGE(PG8_SB(1, 1), cB + hstep + kstep);
    PG8_WAIT_V(6); PG8_BAR;
    for (;;) {
        const bool has_next = S.next(ui + 1, nxt);
        const char* nA = has_next ? (const char*)g.A + (size_t)nxt.pm * tstep : cA; const char* nB = has_next ? (const char*)g.Bt + (size_t)nxt.pn * tstep : cB;
        for (int t = 0; t < nt; t += 2) {
            const bool last = (t == nt - 2);
            const char* a1 = cA + (size_t)(t + 1) * kstep;
            const char* a2 = last ? nA : cA + (size_t)(t + 2) * kstep; const char* b2 = last ? nB : cB + (size_t)(t + 2) * kstep;
            const char* a3 = a2 + kstep; const char* b3 = b2 + kstep;
            PG8_LDB(B0, 0, 0); PG8_SCHED; PG8_LDA(At, 0, 0); PG8_STAGE(PG8_SA(1, 1), a1 + hstep);
            PG8_WAIT_L(8); PG8_BAR; PG8_WAIT_L(0); PG8_MMA(0, 0, At, B0); PG8_BAR; PG8_SCHED;
            PG8_LDB(B1, 0, 1); PG8_STAGE(PG8_SB(0, 0), b2);
            PG8_BAR; PG8_WAIT_L(0); PG8_MMA(0, 1, At, B1); PG8_BAR;
            PG8_LDA(At, 0, 1); PG8_STAGE(PG8_SA(0, 0), a2);
            PG8_BAR; PG8_WAIT_L(0); PG8_MMA(1, 0, At, B0); PG8_BAR; PG8_SCHED;
            PG8_STAGE(PG8_SB(0, 1), b2 + hstep);
            PG8_WAIT_V(6); PG8_BAR; PG8_MMA(1, 1, At, B1); PG8_BAR;
            PG8_LDB(B0, 1, 0); PG8_SCHED; PG8_LDA(At, 1, 0); PG8_STAGE(PG8_SA(0, 1), a2 + hstep);
            PG8_WAIT_L(8); PG8_BAR; PG8_WAIT_L(0); PG8_MMA(0, 0, At, B0); PG8_BAR; PG8_SCHED;
            PG8_LDB(B1, 1, 1); PG8_STAGE(PG8_SB(1, 0), b3);
            PG8_BAR; PG8_WAIT_L(0); PG8_MMA(0, 1, At, B1); PG8_BAR;
            PG8_LDA(At, 1, 1); PG8_STAGE(PG8_SA(1, 0), a3);
            PG8_BAR; PG8_WAIT_L(0); PG8_MMA(1, 0, At, B0); PG8_BAR; PG8_SCHED;
            PG8_STAGE(PG8_SB(1, 1), b3 + hstep);
            PG8_WAIT_V(6); PG8_BAR; PG8_MMA(1, 1, At, B1); PG8_BAR;
        }
        E(acc, cur, wr, wc, fr, fq);
        if (!has_next) break;
#pragma unroll
        for (int a = 0; a < 2; ++a)
#pragma unroll
            for (int b = 0; b < 2; ++b)
#pragma unroll
                for (int m = 0; m < 4; ++m)
#pragma unroll
                    for (int n = 0; n < 2; ++n) acc[a][b][m][n] = (f32x4){0.f, 0.f, 0.f, 0.f};
        cur = nxt; cA = nA; cB = nB; ++ui;
    }
    PG8_WAIT_V(0);
    if (wr == 0) PG8_BAR;
    PG8_BAR;
#undef PG8_SA
#undef PG8_SB
#undef PG8_STAGE
#undef PG8_LDA
#undef PG8_LDB
#undef PG8_MMA
#undef PG8_WAIT_V
#undef PG8_WAIT_L
#undef PG8_BAR
#undef PG8_SCHED
}
}

struct EpiGdnIn {
    bf16_t* proj; float* conv_p; float* conv_s;
    DI void operator()(const f32x4 (&acc)[2][2][4][2], const pg8::Unit& u, int wr, int wc, int fr, int fq) const {
        const int row0 = u.pm * 256 + wr * 64 + fr, col0 = u.pn * 256 + wc * 32 + 4 * fq;
#pragma unroll
        for (int ai = 0; ai < 2; ++ai)
#pragma unroll
            for (int m = 0; m < 4; ++m) {
                const int r = row0 + ai * 128 + m * 16;
                bf16_t* rowp = proj + (size_t)r * NPROJ + col0;
                bool tail; float* cp;
                if (r < MP) { const int t = r & (TP - 1), b = r >> 13; tail = t >= TP - 3; cp = conv_p + (size_t)(b * 3 + (t - (TP - 3))) * 3072; }
                else { const int rs = r - MP, t = rs & 15, b = rs >> 4; tail = t >= TS - 3; cp = conv_s + (size_t)(b * 3 + (t - (TS - 3))) * 3072; }
#pragma unroll
                for (int bj = 0; bj < 2; ++bj)
#pragma unroll
                    for (int n = 0; n < 2; ++n) {
                        const f32x4 v = acc[ai][bj][m][n];
                        u32x2 w; w.x = pk2(v[0], v[1]); w.y = pk2(v[2], v[3]);
                        *(u32x2*)(rowp + bj * 128 + n * 16) = w;
                        const int c = col0 + bj * 128 + n * 16;
                        if (tail && c < 3072) *(f32x4*)(cp + c) = v;
                    }
            }
    }
};

struct EpiDiffIn {
    bf16_t* proj; float* k_p; float* v_p; float* k_s; float* v_s; bf16_t* ks; bf16_t* vs; bf16_t* kh; bf16_t* vh; const float* rope;
    DI void operator()(const f32x4 (&acc)[2][2][4][2], const pg8::Unit& u, int wr, int wc, int fr, int fq) const {
        const int part = u.pn >> 2;
        const int row0 = u.pm * 256 + wr * 64 + fr;
        const int d0 = 16 * (wc & 1) + 4 * fq;
        const int cbase = u.pn * 256 + 64 * (wc >> 1) + d0;
#pragma unroll
        for (int ai = 0; ai < 2; ++ai)
#pragma unroll
            for (int m = 0; m < 4; ++m) {
                const int r = row0 + ai * 128 + m * 16;
                const int rs = r - MP;
                const int pidx = (r < MP) ? (r & (TP - 1)) : (TP + (rs & 15));
                f32x4 cs = {1.f, 1.f, 1.f, 1.f}, sn = {0.f, 0.f, 0.f, 0.f};
                if (part < 2) { cs = *(const f32x4*)(rope + (size_t)pidx * 64 + d0); sn = *(const f32x4*)(rope + (size_t)pidx * 64 + 32 + d0); }
#pragma unroll
                for (int bj = 0; bj < 2; ++bj) {
                    const f32x4 x1 = acc[ai][bj][m][0], x2 = acc[ai][bj][m][1];
                    f32x4 y1 = x1 * cs - x2 * sn, y2 = x2 * cs + x1 * sn;
                    const int col = cbase + bj * 128;
                    bf16_t* pp = proj + (size_t)r * NPROJ + col;
                    if (part == 0) { y1 *= QSCALE; y2 *= QSCALE; }
                    u32x2 w1, w2; w1.x = pk2(y1[0], y1[1]); w1.y = pk2(y1[2], y1[3]); w2.x = pk2(y2[0], y2[1]); w2.y = pk2(y2[2], y2[3]);
                    if (part == 0 || part == 3) { *(u32x2*)pp = w1; *(u32x2*)(pp + 32) = w2; }
                    if (part == 1 || part == 2) {
                        const int cc = col - part * 1024;
                        const int hh = cc >> 7, dd = cc & 127;
                        float* op; bf16_t* sp;
                        if (r < MP) { op = (part == 1 ? k_p : v_p) + (size_t)r * 1024 + cc;
                               sp = (part == 1 ? kh : vh) + ((size_t)((r >> 13) * 8 + hh) * TP + (r & (TP - 1))) * 128 + dd; }
                        else { op = (part == 1 ? k_s : v_s) + (size_t)rs * 1024 + cc;
                               sp = (part == 1 ? ks : vs) + ((size_t)((rs >> 4) * 8 + hh) * KSROWS + PAST + (rs & 15)) * 128 + dd; }
                        *(f32x4*)op = y1; *(f32x4*)(op + 32) = y2;
                        *(u32x2*)sp = w1; *(u32x2*)(sp + 32) = w2;
                    }
                }
            }
    }
};

struct EpiOut {
    bf16_t* C;
    DI void operator()(const f32x4 (&acc)[2][2][4][2], const pg8::Unit& u, int wr, int wc, int fr, int fq) const {
        const int row0 = u.pm * 256 + wr * 64 + fr, col0 = u.pn * 256 + wc * 32 + 4 * fq;
#pragma unroll
        for (int ai = 0; ai < 2; ++ai)
#pragma unroll
            for (int m = 0; m < 4; ++m) {
                bf16_t* rowp = C + (size_t)(row0 + ai * 128 + m * 16) * 1024 + col0;
#pragma unroll
                for (int bj = 0; bj < 2; ++bj)
#pragma unroll
                    for (int n = 0; n < 2; ++n) { const f32x4 v = acc[ai][bj][m][n]; u32x2 w; w.x = pk2(v[0], v[1]); w.y = pk2(v[2], v[3]); *(u32x2*)(rowp + bj * 128 + n * 16) = w; }
            }
    }
};

DI void transpose_tile(const float* W, int ldw, int n0, int k0, bf16_t* WT, bool perm, LAS float* tile) {
    int tid_ = threadIdx.x; asm volatile("" : "+v"(tid_)); const int tid = tid_;
    {
        const int kk = tid >> 4, c4 = (tid & 15) * 4;
#pragma unroll
        for (int p = 0; p < 2; ++p) {
            const f32x4 v = *(const f32x4*)(W + (size_t)(k0 + kk + 32 * p) * ldw + n0 + c4);
            LAS float* t = tile + (kk + 32 * p) * 65 + c4;
            t[0] = v[0]; t[1] = v[1]; t[2] = v[2]; t[3] = v[3];
        }
    }
    __syncthreads();
    {
        const int n = tid >> 3, ks = (tid & 7) * 8;
        const int src = perm ? perm64(n) : n;
        float v[8];
#pragma unroll
        for (int e = 0; e < 8; ++e) v[e] = tile[(ks + e) * 65 + src];
        u32x4 w; w.x = pk2(v[0], v[1]); w.y = pk2(v[2], v[3]); w.z = pk2(v[4], v[5]); w.w = pk2(v[6], v[7]);
        *(u32x4*)(WT + (size_t)(n0 + n) * 1024 + k0 + ks) = w;
    }
    __syncthreads();
}

DI void phase_prep(const Params& P, LAS unsigned char* lds) {
    int tid_ = threadIdx.x; asm volatile("" : "+v"(tid_)); const int tid = tid_, G = gridDim.x;
    unsigned char* ws = P.ws;
    for (int id = blockIdx.x; id < 5120; id += G) {
        const int j = id / 2560; int rem = id % 2560;
        const float* W; int ldw; bf16_t* WT; bool perm = false; int t;
        if (rem < 1024) { W = P.in[12] + (size_t)j * 1024 * 4112; ldw = 4112; WT = (bf16_t*)(ws + WS_WING) + (size_t)j * 4096 * 1024; t = rem; }
        else if (rem < 1280) { W = P.in[17] + (size_t)j * 1024 * 1024; ldw = 1024; WT = (bf16_t*)(ws + WS_WOUTG) + (size_t)j * 1024 * 1024; t = rem - 1024; }
        else if (rem < 2304) { W = P.in[18] + (size_t)j * 1024 * 4096; ldw = 4096; WT = (bf16_t*)(ws + WS_WIND) + (size_t)j * 4096 * 1024; t = rem - 1280; perm = true; }
        else { W = P.in[24] + (size_t)j * 1024 * 1024; ldw = 1024; WT = (bf16_t*)(ws + WS_WOUTD) + (size_t)j * 1024 * 1024; t = rem - 2304; }
        transpose_tile(W, ldw, (t >> 4) * 64, (t & 15) * 64, WT, perm, (LAS float*)lds);
    }
    for (int idx = blockIdx.x * 512 + tid; idx < 8208 * 32; idx += G * 512) {
        const int pi = idx >> 5, d = idx & 31;
        const int pos = pi < TP ? pi : PAST + (pi - TP);
        const float inv = 1.0f / powf(10000.0f, (float)d / 32.0f);
        const float ang = (float)pos * inv;
        const double rev = (double)ang * 0.15915494309189535;
        const double fr = rev - floor(rev);
        float* rp = (float*)(ws + WS_ROPE) + (size_t)pi * 64;
        rp[d] = __builtin_amdgcn_cosf((float)fr);
        rp[32 + d] = __builtin_amdgcn_sinf((float)fr);
    }
    {
        LAS float* cact = (LAS float*)lds;
        LAS float* red = (LAS float*)(lds + 81920);
        bool loaded = false;
        for (int id = (G - 1 - blockIdx.x); id < 192; id += G) {
            if (!loaded) {
                for (int e = tid; e < NB * 1024; e += 512) {
                    const int b = e >> 10, k = e & 1023;
                    const float c = b < BP ? P.in[2][b * 1024 + k] : P.in[3][(b - BP) * 1024 + k];
                    cact[e] = siluf(c);
                }
                loaded = true;
            }
            __syncthreads();
            const int i = id / 48, cb = id % 48;
            const int col = tid & 63, kg = tid >> 6;
            const float* Wp = P.in[10] + (size_t)i * 1024 * 3072 + cb * 64 + col;
            float acc[NB];
#pragma unroll
            for (int b = 0; b < NB; ++b) acc[b] = 0.f;
            for (int k = kg * 128; k < kg * 128 + 128; k += 4) {
                const float w0 = Wp[(size_t)k * 3072], w1 = Wp[(size_t)(k + 1) * 3072], w2 = Wp[(size_t)(k + 2) * 3072], w3 = Wp[(size_t)(k + 3) * 3072];
#pragma unroll
                for (int b = 0; b < NB; ++b) {
                    const f32x4 c4 = *(const LAS f32x4*)(cact + b * 1024 + k);
                    acc[b] += c4[0] * w0 + c4[1] * w1 + c4[2] * w2 + c4[3] * w3;
                }
            }
#pragma unroll
            for (int b = 0; b < NB; ++b) red[(kg * NB + b) * 64 + col] = acc[b];
            __syncthreads();
            for (int o = tid; o < NB * 64; o += 512) {
                const int b = o >> 6, c = o & 63;
                float s = P.in[11][i * 3072 + cb * 64 + c];
#pragma unroll
                for (int g = 0; g < 8; ++g) s += red[(g * NB + b) * 64 + c];
                ((float*)(ws + WS_ADA))[((size_t)i * NB + b) * 3072 + cb * 64 + c] = s;
            }
        }
        __syncthreads();
    }
}

DI void phase_elem(const Params& P, LAS unsigned char* lds, int layer) {
    int tid_ = threadIdx.x; asm volatile("" : "+v"(tid_)); const int tid = tid_, wid = __builtin_amdgcn_readfirstlane(tid >> 6), lane = tid & 63, G = gridDim.x;
    unsigned char* ws = P.ws;
    const int j = layer >> 1;
    const bool gdn = (layer < 4) && !(layer & 1);
    LAS float* wab = (LAS float*)lds;
    if (gdn) {
        const float* Wp = P.in[12] + (size_t)j * 1024 * 4112 + 4096;
        for (int e = tid; e < 16384; e += 512) { const int k = e >> 4, c = e & 15; wab[c * 1024 + k] = Wp[(size_t)k * 4112 + c]; }
        __syncthreads();
    }
    const float* ada = (const float*)(ws + WS_ADA);
    float* X = P.out;
    const bf16_t* OUTB = (const bf16_t*)(ws + WS_PROJ);
    bf16_t* HB = (bf16_t*)(ws + WS_HBUF);
    float* AB = (float*)(ws + WS_AB);
    f32x4 xn[4]; u32x2 own[4];
#define EL_LOAD(R) do { const int _r = (R); if (_r < M) { \
        const float* _xs = (layer <= 1) ? (_r < MP ? P.in[0] + (size_t)_r * 1024 : P.in[1] + (size_t)(_r - MP) * 1024) : X + (size_t)_r * 1024; \
        _Pragma("unroll") for (int _q = 0; _q < 4; ++_q) xn[_q] = *(const f32x4*)(_xs + 4 * (lane + 64 * _q)); \
        if (layer >= 1) { _Pragma("unroll") for (int _q = 0; _q < 4; ++_q) own[_q] = *(const u32x2*)(OUTB + (size_t)_r * 1024 + 4 * (lane + 64 * _q)); } } } while (0)
    EL_LOAD(blockIdx.x * 8 + wid);
    for (int r = blockIdx.x * 8 + wid; r < M; r += G * 8) {
        const int b = r < MP ? (r >> 13) : BP + ((r - MP) >> 4);
        f32x4 x[4]; u32x2 owc[4];
#pragma unroll
        for (int q = 0; q < 4; ++q) { x[q] = xn[q]; owc[q] = own[q]; }
        EL_LOAD(r + G * 8);
        if (layer >= 1) {
            f32x4 o[4]; float ss = 0.f;
#pragma unroll
            for (int q = 0; q < 4; ++q) { const u32x2 ow = owc[q];
                o[q] = (f32x4){__uint_as_float(ow.x << 16), __uint_as_float(ow.x & 0xffff0000u), __uint_as_float(ow.y << 16), __uint_as_float(ow.y & 0xffff0000u)};
                ss += o[q][0] * o[q][0] + o[q][1] * o[q][1] + o[q][2] * o[q][2] + o[q][3] * o[q][3]; }
            ss = wave_sum(ss);
            const float rstd = __builtin_amdgcn_rsqf(ss * (1.f / 1024.f) + RMS_EPS);
            const float* gp = ada + ((size_t)(layer - 1) * NB + b) * 3072 + 2048;
            const float* np = P.in[9] + (layer - 1) * 1024;
#pragma unroll
            for (int q = 0; q < 4; ++q) {
                const int d = 4 * (lane + 64 * q);
                const f32x4 gt = *(const f32x4*)(gp + d), nw = *(const f32x4*)(np + d);
                x[q] = x[q] + gt * (o[q] * rstd * nw);
                *(f32x4*)(X + (size_t)r * 1024 + d) = x[q];
            }
        }
        if (layer < 4) {
            float ss = 0.f;
#pragma unroll
            for (int q = 0; q < 4; ++q) ss += x[q][0] * x[q][0] + x[q][1] * x[q][1] + x[q][2] * x[q][2] + x[q][3] * x[q][3];
            ss = wave_sum(ss);
            const float rstd = __builtin_amdgcn_rsqf(ss * (1.f / 1024.f) + RMS_EPS);
            const float* ap = ada + ((size_t)layer * NB + b) * 3072;
            const float* np = P.in[8] + layer * 1024;
            f32x4 hv[4];
#pragma unroll
            for (int q = 0; q < 4; ++q) {
                const int d = 4 * (lane + 64 * q);
                const f32x4 sh = *(const f32x4*)(ap + d), sc = *(const f32x4*)(ap + 1024 + d), nw = *(const f32x4*)(np + d);
                hv[q] = (x[q] * rstd * nw) * (1.f + sc) + sh;
                u32x2 w; w.x = pk2(hv[q][0], hv[q][1]); w.y = pk2(hv[q][2], hv[q][3]);
                *(u32x2*)(HB + (size_t)r * 1024 + d) = w;
            }
            if (gdn) {
                float mine = 0.f;
#pragma unroll
                for (int c = 0; c < 16; ++c) {
                    float a = 0.f;
#pragma unroll
                    for (int q = 0; q < 4; ++q) { const f32x4 w4 = *(const LAS f32x4*)(wab + c * 1024 + 4 * (lane + 64 * q)); a += hv[q][0] * w4[0] + hv[q][1] * w4[1] + hv[q][2] * w4[2] + hv[q][3] * w4[3]; }
                    a = row_sum16(a);
                    if ((lane & 15) == c) mine = a;
                }
                mine += __shfl_xor(mine, 16); mine += __shfl_xor(mine, 32);
                if (lane < 16) AB[(size_t)r * 16 + lane] = mine;
            }
        }
    }
}

DI void convert_cache(const Params& P, int j, int b0, int nb) {
    int tid_ = threadIdx.x; asm volatile("" : "+v"(tid_)); const int tid = tid_;
    unsigned char* ws = P.ws;
    const int bx = blockIdx.x - b0; const int G = nb;
    {
        const float* ck = P.in[6] + (size_t)j * 16 * PAST * 1024;
        const float* cv = P.in[7] + (size_t)j * 16 * PAST * 1024;
        bf16_t* KS = (bf16_t*)(ws + WS_KS); bf16_t* VS = (bf16_t*)(ws + WS_VS);
        const size_t nun = (size_t)16 * PAST * 128;
        for (size_t u = (size_t)bx * 512 + tid; u < 2 * nun; u += (size_t)G * 512) {
            const bool isv = u >= nun; const size_t uu = isv ? u - nun : u;
            const size_t b = uu / ((size_t)PAST * 128), rem = uu % ((size_t)PAST * 128);
            const size_t row = rem >> 7, c8 = rem & 127, hh = c8 >> 4, d8 = c8 & 15;
            const float* sp = (isv ? cv : ck) + uu * 8;
            const f32x4 a = *(const f32x4*)sp, c = *(const f32x4*)(sp + 4);
            u32x4 w; w.x = pk2(a[0], a[1]); w.y = pk2(a[2], a[3]); w.z = pk2(c[0], c[1]); w.w = pk2(c[2], c[3]);
            *(u32x4*)((isv ? VS : KS) + ((b * 8 + hh) * KSROWS + row) * 128 + d8 * 8) = w;
        }
        const size_t npad = (size_t)128 * 48 * 16;
        for (size_t u = (size_t)bx * 512 + tid; u < 2 * npad; u += (size_t)G * 512) {
            const bool isv = u >= npad; const size_t uu = isv ? u - npad : u;
            const size_t sq = uu / (48 * 16), rem = uu % (48 * 16);
            *(u32x4*)((isv ? VS : KS) + (sq * KSROWS + PAST + TS) * 128 + rem * 8) = (u32x4){0u, 0u, 0u, 0u};
        }
    }
}

DI void phase_g1(const Params& P, LAS unsigned char* lds, int layer) {
    int tid_ = threadIdx.x; asm volatile("" : "+v"(tid_)); const int tid = tid_, wid = __builtin_amdgcn_readfirstlane(tid >> 6), lane = tid & 63, G = gridDim.x;
    const int fr = lane & 15, fq = lane >> 4;
    unsigned char* ws = P.ws;
    const int j = layer >> 1;
    const bf16_t* proj = (const bf16_t*)(ws + WS_PROJ);
    const float* AB = (const float*)(ws + WS_AB);
    float* GL = (float*)(ws + WS_GL);
    const float* convw = P.in[13] + (size_t)j * 4 * 3072;
    const float* cconv = P.in[5] + (size_t)j * 16 * 3 * 3072;
    LAS unsigned char* Qs = lds;
    LAS unsigned char* Ks = lds + 17408;
    LAS unsigned char* VBt = lds + 34816;
    LAS unsigned char* KBt = lds + 53248;
    LAS float* A32 = (LAS float*)(lds + 71680);
    LAS unsigned char* Ts = lds + 88320;
    LAS unsigned char* QKs = lds + 97536;
    LAS float* Gs = (LAS float*)(lds + 105728);

    u32x4 rows[11];
#define G1_ROWLOAD(IT) do { const int _it = (IT); if (tid < 384 && _it < NITEM) { int _h, _c, _row0, _nv; bool _smp; \
            if (_it < NITEM_P) { const int _seq = _it >> 7; _h = _seq & 7; _c = _it & 127; _row0 = (_seq >> 3) * TP + 64 * _c; _nv = 64; _smp = false; } \
            else { const int _s = _it - NITEM_P; _h = _s & 7; _c = 0; _row0 = MP + (_s >> 3) * TS; _nv = TS; _smp = true; } \
            int _t = tid; asm volatile("" : "+v"(_t)); const int _l16 = _t & 15, _grp = _t >> 4, _part = _grp >> 3, _rb = _grp & 7; \
            const int _ch = _part * 1024 + _h * 128 + 8 * _l16; \
            _Pragma("unroll") for (int _k = 0; _k < 11; ++_k) { const int _lr = 8 * _rb - 3 + _k; \
                const bool _up = (_lr >= 0 && _lr < _nv) || (_lr < 0 && !_smp && _c > 0); const int _lrc = _up ? _lr : 0; \
                rows[_k] = *(const u32x4*)(proj + (size_t)(_row0 + _lrc) * NPROJ + _ch); } } } while (0)
    G1_ROWLOAD((int)blockIdx.x);
    for (int item = blockIdx.x; item < NITEM; item += G) {
        int b, h, c, row0, nvalid; bool sample;
        if (item < NITEM_P) { const int seq = item >> 7; b = seq >> 3; h = seq & 7; c = item & 127; row0 = b * TP + 64 * c; nvalid = 64; sample = false; }
        else { const int s = item - NITEM_P; b = s >> 3; h = s & 7; c = 0; row0 = MP + b * TS; nvalid = TS; sample = true; }
        unsigned char* ib = ws + WS_R1 + (size_t)item * ITEM_BYTES;
        float val[8][8];
        float rn[8];
        int tido = tid; asm volatile("" : "+v"(tido));
        const int l16 = tido & 15, grp = tido >> 4, part = grp >> 3, rb = grp & 7;
        const int lane = tido & 63, fr = lane & 15, fq = lane >> 4;
        if (tid < 384) {
            const int ch = part * 1024 + h * 128 + 8 * l16;
            float wv[4][8];
#pragma unroll
            for (int t = 0; t < 4; ++t) {
                const f32x4 a = *(const f32x4*)(convw + t * 3072 + ch), bb = *(const f32x4*)(convw + t * 3072 + ch + 4);
                wv[t][0] = a[0]; wv[t][1] = a[1]; wv[t][2] = a[2]; wv[t][3] = a[3]; wv[t][4] = bb[0]; wv[t][5] = bb[1]; wv[t][6] = bb[2]; wv[t][7] = bb[3];
            }
            float win[4][8];
#pragma unroll
            for (int t = 0; t < 4; ++t)
#pragma unroll
                for (int e = 0; e < 8; ++e) win[t][e] = 0.f;
#pragma unroll
            for (int k = 0; k < 11; ++k) {
                const int lr = 8 * rb - 3 + k;
                float in8[8];
                {
                    const bool use_proj = (lr >= 0 && lr < nvalid) || (lr < 0 && !sample && c > 0);
                    unpack8(rows[k], in8);
                    if (!use_proj) {
#pragma unroll
                        for (int e = 0; e < 8; ++e) in8[e] = 0.f;
                    }
                }
                if (k < 3) {
                    if (sample && lr < 0) {
                        const float* sp = cconv + (size_t)(b * 3 + (3 + lr)) * 3072 + ch;
                        const f32x4 a = *(const f32x4*)sp, bb = *(const f32x4*)(sp + 4);
                        in8[0] = a[0]; in8[1] = a[1]; in8[2] = a[2]; in8[3] = a[3]; in8[4] = bb[0]; in8[5] = bb[1]; in8[6] = bb[2]; in8[7] = bb[3];
                    }
                }
#pragma unroll
                for (int e = 0; e < 8; ++e) { win[0][e] = win[1][e]; win[1][e] = win[2][e]; win[2][e] = win[3][e]; win[3][e] = in8[e]; }
                if (k >= 3) {
                    const bool rv = (lr < nvalid);
                    float ss = 0.f;
#pragma unroll
                    for (int e = 0; e < 8; ++e) {
                        const float y = win[0][e] * wv[0][e] + win[1][e] * wv[1][e] + win[2][e] * wv[2][e] + win[3][e] * wv[3][e];
                        const float s = rv ? siluf(y) : 0.f;
                        val[k - 3][e] = s; ss += s * s;
                    }
                    ss = row_sum16(ss);
                    rn[k - 3] = __builtin_amdgcn_rsqf(ss + 1e-6f);
                }
            }
        } else if (wid == 7) {
            const int r = row0 + (lane < nvalid ? lane : 0);
            const bool valid = lane < nvalid;
            const float a = AB[(size_t)r * 16 + h], bb = AB[(size_t)r * 16 + 8 + h];
            const float xa = a + P.in[15][j * 8 + h];
            const float ey = __expf(-fabsf(xa));
            const float lp = (ey < 0.01f) ? ey * (1.f - ey * (0.5f - ey * 0.33333334f)) : __logf(1.f + ey);
            const float sp = fmaxf(xa, 0.f) + lp;
            float g = valid ? -__expf(P.in[14][j * 8 + h]) * sp : 0.f;
            const float beta = valid ? __builtin_amdgcn_rcpf(1.f + __expf(-bb)) : 0.f;
#pragma unroll
            for (int o = 1; o < 64; o <<= 1) { const float t = __shfl_up(g, o); if (lane >= o) g += t; }
            const float glast = readlane_f(g, 63);
            Gs[lane] = g; Gs[64 + lane] = beta; Gs[128 + lane] = __expf(g); Gs[192 + lane] = __expf(glast - g);
            if (lane == 0) GL[item] = __expf(glast);
        }
        __syncthreads();
        G1_ROWLOAD(item + G);
        if (tid < 384) {
#pragma unroll
            for (int rr = 0; rr < 8; ++rr) {
                const int row = 8 * rb + rr;
                const float beta = Gs[64 + row], eG = Gs[128 + row];
                if (part == 0) {
                    const float sc = rn[rr] * 0.08838834764831845f;
                    float q[8];
#pragma unroll
                    for (int e = 0; e < 8; ++e) q[e] = val[rr][e] * sc;
                    u32x4 w; w.x = pk2(q[0], q[1]); w.y = pk2(q[2], q[3]); w.z = pk2(q[4], q[5]); w.w = pk2(q[6], q[7]);
                    *(LAS u32x4*)(Qs + row * 272 + l16 * 16) = w;
                    bf16_t* qg = (bf16_t*)(ib + 49152) + row * 128;
                    u32x2 g0, g1; g0.x = pk2(q[0] * eG, q[1] * eG); g0.y = pk2(q[2] * eG, q[3] * eG); g1.x = pk2(q[4] * eG, q[5] * eG); g1.y = pk2(q[6] * eG, q[7] * eG);
                    *(u32x2*)(qg + ppos(8 * l16)) = g0; *(u32x2*)(qg + ppos(8 * l16 + 4)) = g1;
                    val[rr][0] = 0.f;
                } else if (part == 1) {
#pragma unroll
                    for (int e = 0; e < 8; ++e) val[rr][e] *= rn[rr];
                    u32x4 w; w.x = pk2(val[rr][0], val[rr][1]); w.y = pk2(val[rr][2], val[rr][3]); w.z = pk2(val[rr][4], val[rr][5]); w.w = pk2(val[rr][6], val[rr][7]);
                    *(LAS u32x4*)(Ks + row * 272 + l16 * 16) = w;
                }
            }
            if (part >= 1) {
                float bsc[8], ksc[8];
#pragma unroll
                for (int rr = 0; rr < 8; ++rr) { const int row = 8 * rb + rr; const float beta = Gs[64 + row]; bsc[rr] = (part == 1) ? beta * Gs[128 + row] : beta; ksc[rr] = Gs[192 + row]; }
                LAS unsigned char* Tt = (part == 1) ? KBt : VBt;
#pragma unroll
                for (int e = 0; e < 8; ++e) {
                    const int dch = 8 * l16 + e;
                    u32x4 w; w.x = pk2(val[0][e] * bsc[0], val[1][e] * bsc[1]); w.y = pk2(val[2][e] * bsc[2], val[3][e] * bsc[3]);
                    w.z = pk2(val[4][e] * bsc[4], val[5][e] * bsc[5]); w.w = pk2(val[6][e] * bsc[6], val[7][e] * bsc[7]);
                    *(LAS u32x4*)(Tt + dch * 144 + rb * 16) = w;
                    if (part == 1) {
                        bf16_t* kd = (bf16_t*)(ib + 65536) + dch * 64;
                        u32x2 k0, k1; k0.x = pk2(val[0][e] * ksc[0], val[1][e] * ksc[1]); k0.y = pk2(val[2][e] * ksc[2], val[3][e] * ksc[3]);
                        k1.x = pk2(val[4][e] * ksc[4], val[5][e] * ksc[5]); k1.y = pk2(val[6][e] * ksc[6], val[7][e] * ksc[7]);
                        *(u32x2*)(kd + ppos(8 * rb)) = k0; *(u32x2*)(kd + ppos(8 * rb + 4)) = k1;
                    }
                }
            }
        }
        __syncthreads();
        {
            const int mt = wid & 3; const bool isqk = wid >= 4;
            LAS unsigned char* As = isqk ? Qs : Ks;
            f32x4 acc[4];
#pragma unroll
            for (int nt = 0; nt < 4; ++nt) acc[nt] = (f32x4){0.f, 0.f, 0.f, 0.f};
#pragma unroll
            for (int ks = 0; ks < 4; ++ks) {
                const bf16x8 a = *(const LAS bf16x8*)(As + (16 * mt + fr) * 272 + (32 * ks + 8 * fq) * 2);
#pragma unroll
                for (int nt = 0; nt < 4; ++nt) {
                    const bf16x8 bfr = *(const LAS bf16x8*)(Ks + (16 * nt + fr) * 272 + (32 * ks + 8 * fq) * 2);
                    acc[nt] = MFMA16(a, bfr, acc[nt]);
                }
            }
#pragma unroll
            for (int nt = 0; nt < 4; ++nt) {
                const int cp = 16 * nt + fr; const float Gc2 = Gs[cp];
#pragma unroll
                for (int i = 0; i < 4; ++i) {
                    const int cr = 16 * mt + 4 * fq + i;
                    const float dec = __expf(Gs[cr] - Gc2);
                    if (!isqk) A32[cr * 65 + cp] = (cr > cp) ? Gs[64 + cr] * acc[nt][i] * dec : 0.f;
                    else *(LAS bf16_t*)(QKs + (cr * 64 + ppos(cp)) * 2) = f2bf((cr >= cp) ? acc[nt][i] * dec : 0.f);
                }
            }
        }
        __syncthreads();
        {
            float a[64];
#pragma unroll
            for (int jj = 0; jj < 64; ++jj) a[jj] = A32[lane * 65 + jj];
            float x[8];
#pragma unroll
            for (int cc = 0; cc < 8; ++cc) x[cc] = (lane == 8 * wid + cc) ? 1.f : 0.f;
#pragma unroll
            for (int jj = 0; jj < 64; ++jj) {
                if (jj >= 8 * wid) {
#pragma unroll
                    for (int cc = 0; cc < 8; ++cc) { const float xj = readlane_f(x[cc], jj); x[cc] -= a[jj] * xj; }
                }
            }
            u32x4 w; w.x = pk2(x[0], x[1]); w.y = pk2(x[2], x[3]); w.z = pk2(x[4], x[5]); w.w = pk2(x[6], x[7]);
            *(LAS u32x4*)(Ts + lane * 144 + wid * 16) = w;
            *(u32x4*)(ib + 81920 + tid * 16) = *(const LAS u32x4*)(QKs + tid * 16);
        }
        __syncthreads();
        {
            const bool isw = wid >= 4; const int n0 = 32 * (wid & 3);
            LAS unsigned char* Bs = isw ? KBt : VBt;
            f32x4 acc[4][2];
#pragma unroll
            for (int mt = 0; mt < 4; ++mt) { acc[mt][0] = (f32x4){0.f, 0.f, 0.f, 0.f}; acc[mt][1] = (f32x4){0.f, 0.f, 0.f, 0.f}; }
#pragma unroll
            for (int ks = 0; ks < 2; ++ks) {
                bf16x8 bfr[2];
#pragma unroll
                for (int nn = 0; nn < 2; ++nn) bfr[nn] = *(const LAS bf16x8*)(Bs + (n0 + 16 * nn + fr) * 144 + (32 * ks + 8 * fq) * 2);
#pragma unroll
                for (int mt = 0; mt < 4; ++mt) {
                    const bf16x8 a = *(const LAS bf16x8*)(Ts + (16 * mt + fr) * 144 + (32 * ks + 8 * fq) * 2);
                    acc[mt][0] = MFMA16(a, bfr[0], acc[mt][0]); acc[mt][1] = MFMA16(a, bfr[1], acc[mt][1]);
                }
            }
            if (!isw) {
                float* U = (float*)ib;
#pragma unroll
                for (int mt = 0; mt < 4; ++mt)
#pragma unroll
                    for (int nn = 0; nn < 2; ++nn) *(f32x4*)(U + (n0 + 16 * nn + fr) * 64 + 16 * mt + 4 * fq) = acc[mt][nn];
            } else {
#pragma unroll
                for (int mt = 0; mt < 4; ++mt)
#pragma unroll
                    for (int nn = 0; nn < 2; ++nn)
#pragma unroll
                        for (int i = 0; i < 4; ++i) *(LAS bf16_t*)(Qs + ((16 * mt + 4 * fq + i) * 128 + ppos(n0 + 16 * nn + fr)) * 2) = f2bf(acc[mt][nn][i]);
            }
        }
        __syncthreads();
        {
            *(u32x4*)(ib + 32768 + tid * 16) = *(const LAS u32x4*)(Qs + tid * 16);
            *(u32x4*)(ib + 32768 + 8192 + tid * 16) = *(const LAS u32x4*)(Qs + 8192 + tid * 16);
        }
        __syncthreads();
    }
}

DI void phase_scan(const Params& P, LAS unsigned char* lds, int layer) {
    int tid_ = threadIdx.x; asm volatile("" : "+v"(tid_)); const int tid = tid_, wid = __builtin_amdgcn_readfirstlane(tid >> 6), lane = tid & 63, G = gridDim.x;
    const int fr = lane & 15, fq = lane >> 4;
    unsigned char* ws = P.ws;
    const int j = layer >> 1;
    const bf16_t* proj = (const bf16_t*)(ws + WS_PROJ);
    const float* GL = (const float*)(ws + WS_GL);
    bf16_t* ORAW = (bf16_t*)(ws + WS_ORAWB);
    constexpr int BUFB = 57344;
    LAS float* red = (LAS float*)(lds + 2 * BUFB);

    if (G >= 192 && (int)blockIdx.x >= 160) { convert_cache(P, j, 160, G - 160); return; }
    for (int seq = blockIdx.x; seq < 160; seq += G) {
        int b, h, nch, item0, row0, nvalid; float* stout;
        f32x4 st[8];
        const int dvc = 16 * wid + fr;
        if (seq < 32) {
            b = seq >> 3; h = seq & 7; nch = 128; item0 = seq * 128; row0 = b * TP; nvalid = 64;
            stout = P.out + OFF_STP + ((size_t)(j * 4 + b) * 8 + h) * 16384;
#pragma unroll
            for (int mt = 0; mt < 8; ++mt) st[mt] = (f32x4){0.f, 0.f, 0.f, 0.f};
        } else {
            const int s = seq - 32; b = s >> 3; h = s & 7; nch = 1; item0 = NITEM_P + s; row0 = MP + b * TS; nvalid = TS;
            stout = P.out + OFF_STS + ((size_t)(j * 16 + b) * 8 + h) * 16384;
            const float* s0 = P.in[4] + ((size_t)(j * 16 + b) * 8 + h) * 16384;
            const unsigned s0o = (unsigned)(4 * fq * 128 + dvc);
#pragma unroll
            for (int mt = 0; mt < 8; ++mt)
#pragma unroll
                for (int i = 0; i < 4; ++i) st[mt][i] = s0[(unsigned)((16 * mt + i) * 128) + s0o];
        }
        const float onw = P.in[16][j * 128 + dvc];
        f32x4 un[4];
#define SCAN_G2L(itm, bufi, LN) do { const unsigned char* _ib = ws + WS_R1 + (size_t)(itm) * ITEM_BYTES + 32768; \
            _Pragma("unroll") for (int _p = 0; _p < 7; ++_p) { const int _L = (wid + 8 * _p) * 1024 + (LN) * 16; unsigned _src; \
                if (_p < 4) { const int _row = _L >> 8, _ch = (_L >> 4) & 15; _src = (_L & ~255) + ((_ch ^ (_row & 15)) << 4); } \
                else { const int _a = _L - 32768, _row = _a >> 7, _ch = (_a >> 4) & 7; _src = 32768 + (_a & ~127) + ((_ch ^ ((_row >> 1) & 7)) << 4); } \
                g2l16(_ib + _src, lds_u32(lds + (bufi) * BUFB + (wid + 8 * _p) * 1024)); } } while (0)
#define SCAN_LOADU(itm) do { const float* _u = (const float*)(ws + WS_R1 + (size_t)(itm) * ITEM_BYTES); const unsigned _uo = (unsigned)((16 * wid + fr) * 64 + 4 * fq); \
            _Pragma("unroll") for (int _m = 0; _m < 4; ++_m) un[_m] = *(const f32x4*)(_u + (unsigned)(16 * _m) + _uo); } while (0)
        __syncthreads();
        SCAN_G2L(item0, 0, lane);
        SCAN_LOADU(item0);
        float gln = GL[item0];
        asm volatile("s_waitcnt vmcnt(0)" ::: "memory");
        __syncthreads();
        for (int c = 0; c < nch; ++c) {
            int frq = lane; asm volatile("" : "+v"(frq));
            const int fr = frq & 15, fq = frq >> 4;
            LAS unsigned char* bb = lds + (c & 1) * BUFB;
            const float gl = gln;
            f32x4 u[4];
#pragma unroll
            for (int mt = 0; mt < 4; ++mt) u[mt] = un[mt];
            if (c + 1 < nch) { gln = GL[item0 + c + 1]; SCAN_G2L(item0 + c + 1, (c + 1) & 1, frq); SCAN_LOADU(item0 + c + 1); }
            const int x16 = fr << 4, x8 = ((fr >> 1) & 7) << 4;
            bf16x8 sf[4];
#pragma unroll
            for (int ks = 0; ks < 4; ++ks) {
                u32x4 w; w.x = pk2(-st[2 * ks][0], -st[2 * ks][1]); w.y = pk2(-st[2 * ks][2], -st[2 * ks][3]); w.z = pk2(-st[2 * ks + 1][0], -st[2 * ks + 1][1]); w.w = pk2(-st[2 * ks + 1][2], -st[2 * ks + 1][3]);
                sf[ks] = __builtin_bit_cast(bf16x8, w);
            }
            bf16x8 fa[4], fb[4];
#define SC_LD256(dst, base, mt) do { _Pragma("unroll") for (int _k = 0; _k < 4; ++_k) \
                dst[_k] = *(const LAS bf16x8*)(bb + (base) + (16 * (mt) + fr) * 256 + ((((4 * _k + fq) << 4)) ^ x16)); } while (0)
#define SC_LD128(dst, base, mtlo) do { _Pragma("unroll") for (int _m = 0; _m < 2; ++_m) _Pragma("unroll") for (int _k = 0; _k < 2; ++_k) \
                dst[_m * 2 + _k] = *(const LAS bf16x8*)(bb + (base) + (16 * ((mtlo) + _m) + fr) * 128 + ((((4 * _k + fq) << 4)) ^ x8)); } while (0)
#define SC_SB __builtin_amdgcn_sched_barrier(0)
#define SC_MU(f, mt) do { _Pragma("unroll") for (int _k = 0; _k < 4; ++_k) u[mt] = MFMA16(f[_k], sf[_k], u[mt]); } while (0)
#define SC_MO(f, mt) do { _Pragma("unroll") for (int _k = 0; _k < 4; ++_k) o[mt] = MFMA16(f[_k], sf[_k], o[mt]); } while (0)
#define SC_MQK(f, mtlo) do { _Pragma("unroll") for (int _m = 0; _m < 2; ++_m) _Pragma("unroll") for (int _k = 0; _k < 2; ++_k) o[(mtlo) + _m] = MFMA16(f[_m * 2 + _k], uf[_k], o[(mtlo) + _m]); } while (0)
#define SC_MKD(f, mtlo) do { _Pragma("unroll") for (int _m = 0; _m < 2; ++_m) { st[(mtlo) + _m] = st[(mtlo) + _m] * gl; _Pragma("unroll") for (int _k = 0; _k < 2; ++_k) st[(mtlo) + _m] = MFMA16(f[_m * 2 + _k], uf[_k], st[(mtlo) + _m]); } } while (0)
            f32x4 o[4];
#pragma unroll
            for (int mt = 0; mt < 4; ++mt) o[mt] = (f32x4){0.f, 0.f, 0.f, 0.f};
            SC_LD256(fa, 0, 0); SC_LD256(fb, 0, 1); SC_SB;
            SC_MU(fa, 0); SC_LD256(fa, 0, 2); SC_SB;
            SC_MU(fb, 1); SC_LD256(fb, 0, 3); SC_SB;
            SC_MU(fa, 2); SC_LD256(fa, 16384, 0); SC_SB;
            SC_MU(fb, 3); SC_LD256(fb, 16384, 1); SC_SB;
#pragma unroll
            for (int ks = 0; ks < 4; ++ks) sf[ks] = sf[ks] ^ (short)0x8000;
            SC_MO(fa, 0); SC_LD256(fa, 16384, 2); SC_SB;
            SC_MO(fb, 1); SC_LD256(fb, 16384, 3); SC_SB;
            SC_MO(fa, 2); SC_LD128(fa, 49152, 0); SC_SB;
            SC_MO(fb, 3); SC_LD128(fb, 49152, 2); SC_SB;
            bf16x8 uf[2];
#pragma unroll
            for (int k2 = 0; k2 < 2; ++k2) {
                u32x4 w; w.x = pk2(u[2 * k2][0], u[2 * k2][1]); w.y = pk2(u[2 * k2][2], u[2 * k2][3]); w.z = pk2(u[2 * k2 + 1][0], u[2 * k2 + 1][1]); w.w = pk2(u[2 * k2 + 1][2], u[2 * k2 + 1][3]);
                uf[k2] = __builtin_bit_cast(bf16x8, w);
            }
            SC_MQK(fa, 0); SC_LD128(fa, 32768, 0); SC_SB;
            SC_MQK(fb, 2); SC_LD128(fb, 32768, 2); SC_SB;
            SC_MKD(fa, 0); SC_LD128(fa, 32768, 4); SC_SB;
            SC_MKD(fb, 2); SC_LD128(fb, 32768, 6); SC_SB;
            SC_MKD(fa, 4); SC_SB;
            SC_MKD(fb, 6);
#undef SC_MU
#undef SC_MO
#undef SC_MQK
#undef SC_MKD
#undef SC_LD256
#undef SC_LD128
#undef SC_SB
            {
                bf16_t* obb = ORAW + (size_t)(row0 + 64 * c) * 1024 + h * 128;
                const unsigned oo = (unsigned)(4 * fq * 1024 + 16 * wid + fr);
                if (nvalid == 64) {
#pragma unroll
                    for (int mt = 0; mt < 4; ++mt)
#pragma unroll
                        for (int i = 0; i < 4; ++i) obb[(unsigned)((16 * mt + i) * 1024) + oo] = f2bf(o[mt][i]);
                } else {
#pragma unroll
                    for (int i = 0; i < 4; ++i) obb[(unsigned)(i * 1024) + oo] = f2bf(o[0][i]);
                }
            }
            asm volatile("s_waitcnt vmcnt(0)" ::: "memory");
            __syncthreads();
        }
        {
            int lz = lane; asm volatile("" : "+v"(lz));
            const unsigned so = (unsigned)(4 * (lz >> 4) * 128 + 16 * wid + (lz & 15));
#pragma unroll
            for (int mt = 0; mt < 8; ++mt)
#pragma unroll
                for (int i = 0; i < 4; ++i) stout[(unsigned)((16 * mt + i) * 128) + so] = st[mt][i];
        }
#undef SCAN_G2L
#undef SCAN_LOADU
    }
    if (G < 192) convert_cache(P, j, 0, G);
}

DI void phase_gnorm(const Params& P, int layer) {
    int tid_ = threadIdx.x; asm volatile("" : "+v"(tid_)); const int tid = tid_, wid = __builtin_amdgcn_readfirstlane(tid >> 6), lane = tid & 63, G = gridDim.x;
    unsigned char* ws = P.ws;
    const int j = layer >> 1;
    const bf16_t* ORAW = (const bf16_t*)(ws + WS_ORAWB);
    const bf16_t* proj = (const bf16_t*)(ws + WS_PROJ);
    bf16_t* OB = (bf16_t*)(ws + WS_HBUF);
    float onw[16];
#pragma unroll
    for (int e = 0; e < 16; ++e) onw[e] = P.in[16][j * 128 + ((16 * lane + e) & 127)];
    for (int r = blockIdx.x * 8 + wid; r < M; r += G * 8) {
        const u32x4 o0 = *(const u32x4*)(ORAW + (size_t)r * 1024 + 16 * lane), o1 = *(const u32x4*)(ORAW + (size_t)r * 1024 + 16 * lane + 8);
        const u32x4 z0 = *(const u32x4*)(proj + (size_t)r * NPROJ + 3072 + 16 * lane), z1 = *(const u32x4*)(proj + (size_t)r * NPROJ + 3072 + 16 * lane + 8);
        float ov[16], zv[16];
        { float t8[8]; unpack8(o0, t8);
#pragma unroll
          for (int e = 0; e < 8; ++e) ov[e] = t8[e];
          unpack8(o1, t8);
#pragma unroll
          for (int e = 0; e < 8; ++e) ov[8 + e] = t8[e];
          unpack8(z0, t8);
#pragma unroll
          for (int e = 0; e < 8; ++e) zv[e] = t8[e];
          unpack8(z1, t8);
#pragma unroll
          for (int e = 0; e < 8; ++e) zv[8 + e] = t8[e]; }
        float ss = 0.f;
#pragma unroll
        for (int e = 0; e < 16; ++e) ss += ov[e] * ov[e];
        ss += __shfl_xor(ss, 1); ss += __shfl_xor(ss, 2); ss += __shfl_xor(ss, 4);
        const float rstd = __builtin_amdgcn_rsqf(ss * (1.f / 128.f) + RMS_EPS);
        float y[16];
#pragma unroll
        for (int e = 0; e < 16; ++e) y[e] = ov[e] * rstd * onw[e] * siluf(zv[e]);
        u32x4 w0, w1;
        w0.x = pk2(y[0], y[1]); w0.y = pk2(y[2], y[3]); w0.z = pk2(y[4], y[5]); w0.w = pk2(y[6], y[7]);
        w1.x = pk2(y[8], y[9]); w1.y = pk2(y[10], y[11]); w1.z = pk2(y[12], y[13]); w1.w = pk2(y[14], y[15]);
        *(u32x4*)(OB + (size_t)r * 1024 + 16 * lane) = w0; *(u32x4*)(OB + (size_t)r * 1024 + 16 * lane + 8) = w1;
    }
}

DI void att_s(LAS unsigned char* Ka, int t, const bf16x8 (&qf)[4], f32x16& s0, f32x16& s1) {
#pragma unroll
    for (int i = 0; i < 16; ++i) { s0[i] = 0.f; s1[i] = 0.f; }
    bf16x8 kf[8];
#pragma unroll
    for (int s = 0; s < 4; ++s) { kf[2 * s] = *(const LAS bf16x8*)(Ka + (t ^ (s << 5))); kf[2 * s + 1] = *(const LAS bf16x8*)(Ka + 8192 + (t ^ (s << 5))); }
#pragma unroll
    for (int s = 0; s < 4; ++s) { s0 = MFMA32(kf[2 * s], qf[s], s0); s1 = MFMA32(kf[2 * s + 1], qf[s], s1); }
}
template <bool MASK>
DI float att_softmax(f32x16& s0, f32x16& s1, float& m, float& l, bf16x8 (&pf)[2][2], int h2, int nvk) {
    if (MASK) {
#pragma unroll
        for (int i = 0; i < 16; ++i) {
            const int key = (i & 3) + 8 * (i >> 2) + 4 * h2;
            s0[i] = (key < nvk) ? s0[i] : -INFINITY;
            s1[i] = (32 + key < nvk) ? s1[i] : -INFINITY;
        }
    }
    float mx = s0[0];
#pragma unroll
    for (int i = 1; i < 16; ++i) mx = fmaxf(mx, s0[i]);
#pragma unroll
    for (int i = 0; i < 16; ++i) mx = fmaxf(mx, s1[i]);
    mx = fmaxf(mx, __shfl_xor(mx, 32));
    const float mn = fmaxf(m, mx);
    const float alpha = __builtin_amdgcn_exp2f(m - mn);
    m = mn;
    float ps = 0.f;
#pragma unroll
    for (int i = 0; i < 16; ++i) { s0[i] = __builtin_amdgcn_exp2f(s0[i] - mn); s1[i] = __builtin_amdgcn_exp2f(s1[i] - mn); ps += s0[i] + s1[i]; }
    l = l * alpha + ps;
    u32x4 w;
    w.x = pk2(s0[0], s0[1]); w.y = pk2(s0[2], s0[3]); w.z = pk2(s0[4], s0[5]); w.w = pk2(s0[6], s0[7]); pf[0][0] = __builtin_bit_cast(bf16x8, w);
    w.x = pk2(s0[8], s0[9]); w.y = pk2(s0[10], s0[11]); w.z = pk2(s0[12], s0[13]); w.w = pk2(s0[14], s0[15]); pf[0][1] = __builtin_bit_cast(bf16x8, w);
    w.x = pk2(s1[0], s1[1]); w.y = pk2(s1[2], s1[3]); w.z = pk2(s1[4], s1[5]); w.w = pk2(s1[6], s1[7]); pf[1][0] = __builtin_bit_cast(bf16x8, w);
    w.x = pk2(s1[8], s1[9]); w.y = pk2(s1[10], s1[11]); w.z = pk2(s1[12], s1[13]); w.w = pk2(s1[14], s1[15]); pf[1][1] = __builtin_bit_cast(bf16x8, w);
    return alpha;
}
DI void att_pv(LAS unsigned char* Va, int q4, f32x16 (&O)[4], const bf16x8 (&pf)[2][2]) {
    s16x4 lo[16], hi[16];
#define PV_LD(i) do { LAS unsigned char* _vp = Va + ((((i) >> 2) ^ q4) << 6) + (32 * (((i) >> 1) & 1) + 16 * ((i) & 1)) * 256; \
        lo[i] = __builtin_amdgcn_ds_read_tr16_b64_v4i16((LAS s16x4*)_vp); hi[i] = __builtin_amdgcn_ds_read_tr16_b64_v4i16((LAS s16x4*)(_vp + 8 * 256)); } while (0)
    PV_LD(0); PV_LD(1); PV_LD(2);
#pragma unroll
    for (int i = 0; i < 16; ++i) {
        if (i + 3 < 16) PV_LD(i + 3);
        const bf16x8 vf = __builtin_shufflevector(lo[i], hi[i], 0, 1, 2, 3, 4, 5, 6, 7);
        O[i >> 2] = MFMA32(vf, pf[(i >> 1) & 1][i & 1], O[i >> 2]);
    }
#undef PV_LD
}

DI void phase_attn(const Params& P, LAS unsigned char* lds, int layer) {
    int tid_ = threadIdx.x; asm volatile("" : "+v"(tid_)); const int tid = tid_, wid = __builtin_amdgcn_readfirstlane(tid >> 6), lane = tid & 63, G = gridDim.x;
    unsigned char* ws = P.ws;
    const int j = layer >> 1;
    const int comp = wid >> 2, rg = wid & 3, r32 = lane & 31, h2 = lane >> 5;
    const bf16_t* proj = (const bf16_t*)(ws + WS_PROJ);
    bf16_t* OB = (bf16_t*)(ws + WS_HBUF);
    const float lam_init = 0.8f - 0.6f * expf(-0.3f * (float)layer);
    float lam;
    {
        float d1 = 0.f, d2 = 0.f;
        for (int i = 0; i < 64; ++i) { d1 += P.in[19][j * 64 + i] * P.in[20][j * 64 + i]; d2 += P.in[21][j * 64 + i] * P.in[22][j * 64 + i]; }
        lam = expf(d1) - expf(d2) + lam_init;
    }
    const float* subln = P.in[23] + j * 128;
    constexpr int TB = 32768;
    const int vb = (G % 8 == 0) ? (blockIdx.x % 8) * (G / 8) + blockIdx.x / 8 : blockIdx.x;
    const int nrounds = (G == 256) ? 9 : (2176 + G - 1) / G;
#define ATT_WAITV(n) asm volatile("s_waitcnt vmcnt(" #n ")" ::: "memory")
#define ATT_BAR() do { asm volatile("" ::: "memory"); __builtin_amdgcn_s_barrier(); asm volatile("" ::: "memory"); } while (0)
    for (int k = 0; k < nrounds; ++k) {
        int id;
        if (G == 256) {
            if (k < 8) { const int xcd = vb >> 5, idx = vb & 31; const int seq = xcd * 4 + (k >> 1); const int qt = (k & 1) ? idx : (63 - idx); id = seq * 64 + qt; }
            else { if (vb >= 128) break; id = 2048 + vb; }
        } else { id = vb + k * G; if (id >= 2176) break; }
        int h, qrow0, nt_all, nt_mine, last_valid; const int kvstride = 128; const bf16_t* Kp; const bf16_t* Vp; bool sample;
        if (id < 2048) {
            const int seq = id >> 6, qt = id & 63, b = seq >> 3; h = seq & 7; sample = false;
            qrow0 = b * TP + 128 * qt + 32 * rg; nt_all = 2 * qt + 2; nt_mine = (rg < 2) ? 2 * qt + 1 : 2 * qt + 2; last_valid = 64 * nt_mine;
            Kp = (const bf16_t*)(ws + WS_KH) + (size_t)seq * TP * 128; Vp = (const bf16_t*)(ws + WS_VH) + (size_t)seq * TP * 128;
        } else {
            const int s = id - 2048, b = s >> 3; h = s & 7; sample = true;
            qrow0 = MP + b * TS; nt_all = 34; nt_mine = (rg == 0) ? 34 : 0; last_valid = PAST + TS;
            Kp = (const bf16_t*)(ws + WS_KS) + (size_t)s * KSROWS * 128; Vp = (const bf16_t*)(ws + WS_VS) + (size_t)s * KSROWS * 128;
        }
        bf16x8 qf[4];
        {
            const int qr = qrow0 + (sample ? (r32 & 15) : r32);
            const bf16_t* qp = proj + (size_t)qr * NPROJ + h * 128 + comp * 64 + 8 * h2;
#pragma unroll
            for (int s = 0; s < 4; ++s) qf[s] = *(const bf16x8*)(qp + 16 * s);
        }
        f32x16 O[4];
#pragma unroll
        for (int et = 0; et < 4; ++et)
#pragma unroll
            for (int i = 0; i < 16; ++i) O[et][i] = 0.f;
        float m = -INFINITY, l = 0.f;
        bf16x8 pf[2][2];
#pragma unroll
        for (int a = 0; a < 2; ++a)
#pragma unroll
            for (int c2 = 0; c2 < 2; ++c2) pf[a][c2] = (bf16x8){0, 0, 0, 0, 0, 0, 0, 0};
        f32x16 sA0, sA1, sB0, sB1;
        const bf16_t* gsrc;
        {
            const int rowl = lane >> 4, c = lane & 15;
            const int row0 = 16 * (wid & 3) + rowl;
            const int lc = (wid < 4) ? (c ^ (row0 & 15)) : (c ^ ((row0 & 3) << 2));
            gsrc = ((wid < 4) ? Kp : Vp) + (size_t)row0 * kvstride + lc * 8;
        }
#define ATT_G2L(kt, bufi) do { _Pragma("unroll") for (int _i = 0; _i < 4; ++_i) { \
            const bf16_t* _s = gsrc + (size_t)(64 * (kt) + 4 * _i) * kvstride; \
            if (wid < 4) _s += (((lane & 15) ^ ((16 * (wid & 3) + 4 * _i + (lane >> 4)) & 15)) - ((lane & 15) ^ ((16 * (wid & 3) + (lane >> 4)) & 15))) * 8; \
            g2l16(_s, lds_u32(lds + (bufi) * TB + (4 * wid + _i) * 1024)); } } while (0)
        ATT_G2L(0, 0);
        if (nt_all > 1) ATT_G2L(1, 1);
        asm volatile("" :: "v"(qf[0]), "v"(qf[1]), "v"(qf[2]), "v"(qf[3]));
        if (nt_all > 1) { ATT_WAITV(4); } else { ATT_WAITV(0); }
        ATT_BAR();
        {
            const int koff = r32 * 256, t = ((comp * 8 + h2) ^ (r32 & 15)) << 4;
            att_s(lds + koff, t, qf, sA0, sA1);
        }
#define ATT_ITER(KT, sC0, sC1, sN0, sN1, EDGE) do { \
            const int kt = (KT); \
            int lo_ = lane; asm volatile("" : "+v"(lo_)); \
            const int r32_ = lo_ & 31, h2_ = lo_ >> 5, q4_ = (lo_ & 15) >> 2, p4_ = lo_ & 3, blk_ = (lo_ >> 4) & 1; \
            const int koff_ = r32_ * 256, t_ = ((comp * 8 + h2_) ^ (r32_ & 15)) << 4; \
            const int voff_ = (4 * h2_ + q4_) * 256 + (2 * blk_ + (p4_ >> 1)) * 16 + (p4_ & 1) * 8; \
            ATT_WAITV(0); ATT_BAR(); \
            if (kt + 2 < nt_all) ATT_G2L(kt + 2, (kt + 2) & 3); \
            att_s(lds + ((kt + 1) & 3) * TB + koff_, t_, qf, sN0, sN1); \
            if (!(EDGE) || kt >= 1) att_pv(lds + ((kt - 1) & 3) * TB + 16384 + voff_, q4_, O, pf); \
            const float alpha = att_softmax<EDGE>(sC0, sC1, m, l, pf, h2_, last_valid - 64 * kt); \
            asm volatile("" :: "v"(l), "v"(pf[0][0]), "v"(pf[0][1]), "v"(pf[1][0]), "v"(pf[1][1]));     \
            _Pragma("unroll") for (int _g = 0; _g < 24; ++_g) { __builtin_amdgcn_sched_group_barrier(0x008, 1, 0); __builtin_amdgcn_sched_group_barrier(0x002, 5, 0); } \
            if (__any(alpha != 1.f)) { \
                _Pragma("unroll") for (int et = 0; et < 4; ++et) _Pragma("unroll") for (int i = 0; i < 16; ++i) O[et][i] *= alpha; } \
            } while (0)
        {
            const int npairs = nt_all >> 1;
            ATT_ITER(0, sA0, sA1, sB0, sB1, true);
            ATT_ITER(1, sB0, sB1, sA0, sA1, true);
            for (int pp = 1; pp < npairs - 1; ++pp) {
                ATT_ITER(2 * pp, sA0, sA1, sB0, sB1, false);
                ATT_ITER(2 * pp + 1, sB0, sB1, sA0, sA1, false);
            }
            if (npairs > 1) {
                ATT_ITER(nt_all - 2, sA0, sA1, sB0, sB1, true);
                ATT_ITER(nt_all - 1, sB0, sB1, sA0, sA1, true);
            }
        }
        {
            const int lt = nt_all - 1;
            const int h2b = lane >> 5, q4 = (lane & 15) >> 2, p4 = lane & 3, blk = (lane >> 4) & 1;
            const int voff = (4 * h2b + q4) * 256 + (2 * blk + (p4 >> 1)) * 16 + (p4 & 1) * 8;
            att_pv(lds + (lt & 3) * TB + 16384 + voff, q4, O, pf);
        }
        __syncthreads();
#undef ATT_ITER
#undef ATT_G2L
        const float lt = l + __shfl_xor(l, 32);
        const float inv = (nt_mine > 0) ? 1.f / lt : 0.f;
        LAS float* XO = (LAS float*)lds;
        if (comp == 1) {
            const float sc = inv * lam;
#pragma unroll
            for (int et = 0; et < 4; ++et)
#pragma unroll
                for (int i = 0; i < 16; ++i) XO[(rg * 128 + 32 * et + (i & 3) + 8 * (i >> 2) + 4 * h2) * 32 + r32] = O[et][i] * sc;
        }
        __syncthreads();
        if (comp == 0 && nt_mine > 0) {
            float ss = 0.f;
#pragma unroll
            for (int et = 0; et < 4; ++et)
#pragma unroll
                for (int i = 0; i < 16; ++i) { const float v = O[et][i] * inv - XO[(rg * 128 + 32 * et + (i & 3) + 8 * (i >> 2) + 4 * h2) * 32 + r32]; O[et][i] = v; ss += v * v; }
            ss += __shfl_xor(ss, 32);
            const float rstd = __builtin_amdgcn_rsqf(ss * (1.f / 128.f) + RMS_EPS) * (1.f - lam_init);
            const bool rvalid = sample ? (r32 < TS) : true;
            const int row = qrow0 + r32;
            if (rvalid) {
#pragma unroll
                for (int et = 0; et < 4; ++et)
#pragma unroll
                    for (int g4 = 0; g4 < 4; ++g4) {
                        const int e0 = 32 * et + 8 * g4 + 4 * h2;
                        const u32x2 zz = *(const u32x2*)(proj + (size_t)row * NPROJ + 3072 + h * 128 + e0);
                        const f32x4 sl = *(const f32x4*)(subln + e0);
                        const float z0 = __uint_as_float(zz.x << 16), z1 = __uint_as_float(zz.x & 0xffff0000u), z2 = __uint_as_float(zz.y << 16), z3 = __uint_as_float(zz.y & 0xffff0000u);
                        u32x2 w;
                        w.x = pk2(O[et][4 * g4] * rstd * sl[0] * siluf(z0), O[et][4 * g4 + 1] * rstd * sl[1] * siluf(z1));
                        w.y = pk2(O[et][4 * g4 + 2] * rstd * sl[2] * siluf(z2), O[et][4 * g4 + 3] * rstd * sl[3] * siluf(z3));
                        *(u32x2*)(OB + (size_t)row * 1024 + h * 128 + e0) = w;
                    }
            }
        }
        __syncthreads();
    }
}


#define XB_TMO      128
#define XB_XCNT(j)  (256  + 64 * (j))
#define XB_XSUB(j)  (1280 + 64 * (j))
#define XB_XGEN(j)  (2304 + 64 * (j))
#define XB_TOP      3328
#define XB_TOPGEN   3392
#define XCD_BAR_WORDS 3456
#define XB_SPIN_CAP (1u << 18)
DI unsigned xb_ld(unsigned* p)              { return __hip_atomic_load(p, __ATOMIC_RELAXED, __HIP_MEMORY_SCOPE_AGENT); }
DI unsigned xb_add(unsigned* p, unsigned v) { return __hip_atomic_fetch_add(p, v, __ATOMIC_RELAXED, __HIP_MEMORY_SCOPE_AGENT); }
DI unsigned xb_xcc_id() { return (unsigned)__builtin_amdgcn_s_getreg((3 << 11) | 20) & 0xFu; }
#define XB_SPIN(cond, bar) do { unsigned _sp = 0; while (cond) { __builtin_amdgcn_s_sleep(1); \
    if ((++_sp & 255u) == 0u) { if (xb_ld(&(bar)[XB_TMO])) break; if (_sp > XB_SPIN_CAP) { atomicAdd(&(bar)[XB_TMO], 1u); break; } } } } while (0)
DI void xcd_barrier_complete(unsigned* bar, unsigned x, unsigned& nloc, unsigned& nx) {
    const unsigned G = gridDim.x * gridDim.y * gridDim.z;
    unsigned sum, cnt, mine, sp = 0u;
    for (;;) {
        sum = 0u; cnt = 0u; mine = 0u;
#pragma unroll
        for (unsigned j = 0; j < 16; ++j) { const unsigned c = xb_ld(&bar[XB_XCNT(j)]); sum += c; cnt += (c > 0u) ? 1u : 0u; mine = (j == x) ? c : mine; }
        if (sum == G) break;
        __builtin_amdgcn_s_sleep(1);
        if ((++sp & 255u) == 0u) { if (xb_ld(&bar[XB_TMO])) break; if (sp > XB_SPIN_CAP) { atomicAdd(&bar[XB_TMO], 1u); break; } }
    }
    nloc = mine > 0u ? mine : 1u; nx = cnt > 0u ? cnt : 1u;
}
DI void xcd_barrier(unsigned* bar, volatile LAS unsigned* st) {
    asm volatile("s_waitcnt vmcnt(0)" ::: "memory");
    __syncthreads();
    if (threadIdx.x == 0) {
        const unsigned x = xb_xcc_id();
        __builtin_amdgcn_s_waitcnt(0);
        unsigned nloc = st[0], nx = st[1];
        if (nloc == 0u) { xcd_barrier_complete(bar, x, nloc, nx); st[0] = nloc; st[1] = nx; }
        const unsigned old = xb_add(&bar[XB_XSUB(x)], 1u);
        const unsigned gen = old / nloc;
        if (old + 1u == (gen + 1u) * nloc) {
            __builtin_amdgcn_fence(__ATOMIC_RELEASE, "agent");
            asm volatile("s_waitcnt vmcnt(0)" ::: "memory");
            const unsigned og = xb_add(&bar[XB_TOP], 1u);
            const unsigned tg = og / nx;
            if (og + 1u == (tg + 1u) * nx) xb_add(&bar[XB_TOPGEN], 1u);
            else XB_SPIN(xb_ld(&bar[XB_TOPGEN]) == tg, bar);
            __builtin_amdgcn_fence(__ATOMIC_ACQUIRE, "agent");
            xb_add(&bar[XB_XGEN(x)], 1u);
            asm volatile("s_waitcnt vmcnt(0)" ::: "memory");
        } else {
            XB_SPIN(xb_ld(&bar[XB_XGEN(x)]) == gen, bar);
            __builtin_amdgcn_fence(__ATOMIC_ACQUIRE, "agent");
            asm volatile("s_waitcnt vmcnt(0)" ::: "memory");
        }
    }
    __syncthreads();
}

typedef const __attribute__((address_space(4))) Params* CParP;
#define LOADP() Params P; { CParP kp_ = KP; asm volatile("" : "+s"(kp_)); P = *kp_; } unsigned char* ws = P.ws; (void)ws
__global__ void __launch_bounds__(512, 2) fwd_megakernel(Params Pin) {
#if defined(__HIP_DEVICE_COMPILE__)
    extern __shared__ __attribute__((aligned(16))) unsigned char lds_raw[];
    LAS unsigned char* lds = (LAS unsigned char*)lds_raw;
    cg::grid_group grid = cg::this_grid();
    const CParP KP = (CParP)__builtin_amdgcn_kernarg_segment_ptr();
    volatile LAS unsigned* xst = (volatile LAS unsigned*)(lds + 131072);
    if (threadIdx.x == 0) { xst[0] = 0u; xst[1] = 0u; }
    __syncthreads();
    { LOADP(); if (threadIdx.x == 0) (void)xb_add(&((unsigned*)(ws + WS_BAR))[XB_XCNT(xb_xcc_id())], 1u); }
#define GRID_BAR() do { LOADP(); xcd_barrier((unsigned*)(ws + WS_BAR), xst); } while (0)
    { LOADP(); phase_prep(P, lds); }
    grid.sync();
    for (int layer = 0; layer < 4; ++layer) {
        const int j = layer >> 1;
        { LOADP(); phase_elem(P, lds, layer); }
        GRID_BAR();
        {
            LOADP();
            pg8::StaticOrder S; S.init(M, NPROJ, gridDim.x, blockIdx.x);
            pg8::Gemm g;
            g.A = (const bf16_t*)(ws + WS_HBUF); g.M = M; g.N = NPROJ; g.K = 1024;
            if (!(layer & 1)) {
                g.Bt = (const bf16_t*)(ws + WS_WING) + (size_t)j * 4096 * 1024;
                EpiGdnIn E; E.proj = (bf16_t*)(ws + WS_PROJ); E.conv_p = P.out + OFF_CVP + (size_t)j * 4 * 3 * 3072; E.conv_s = P.out + OFF_CVS + (size_t)j * 16 * 3 * 3072;
                pg8::gemm_phase(lds, g, S, E);
            } else {
                g.Bt = (const bf16_t*)(ws + WS_WIND) + (size_t)j * 4096 * 1024;
                EpiDiffIn E; E.proj = (bf16_t*)(ws + WS_PROJ);
                E.k_p = P.out + OFF_KP + (size_t)j * MP * 1024; E.v_p = P.out + OFF_VP + (size_t)j * MP * 1024;
                E.k_s = P.out + OFF_KSO + (size_t)j * MS * 1024; E.v_s = P.out + OFF_VSO + (size_t)j * MS * 1024;
                E.ks = (bf16_t*)(ws + WS_KS); E.vs = (bf16_t*)(ws + WS_VS); E.kh = (bf16_t*)(ws + WS_KH); E.vh = (bf16_t*)(ws + WS_VH); E.rope = (const float*)(ws + WS_ROPE);
                pg8::gemm_phase(lds, g, S, E);
            }
        }
        GRID_BAR();
        if (!(layer & 1)) {
            { LOADP(); phase_g1(P, lds, layer); }
            GRID_BAR();
            { LOADP(); phase_scan(P, lds, layer); }
            GRID_BAR();
            { LOADP(); phase_gnorm(P, layer); }
        } else {
            { LOADP(); phase_attn(P, lds, layer); }
        }
        GRID_BAR();
        {
            LOADP();
            pg8::StaticOrder S; S.init(M, 1024, gridDim.x, blockIdx.x);
            pg8::Gemm g;
            g.A = (const bf16_t*)(ws + WS_HBUF); g.M = M; g.N = 1024; g.K = 1024;
            g.Bt = (const bf16_t*)(ws + ((layer & 1) ? WS_WOUTD : WS_WOUTG)) + (size_t)j * 1024 * 1024;
            EpiOut E; E.C = (bf16_t*)(ws + WS_PROJ);
            pg8::gemm_phase(lds, g, S, E);
        }
        GRID_BAR();
    }
    { LOADP(); phase_elem(P, lds, 4); }
#endif
}

extern "C" void kernel_launch(void* const* d_in, const int* in_sizes, int n_in, void* d_out, int out_size, void* d_ws, size_t ws_size, hipStream_t stream) {
    static int grid_blocks = 0;
    if (!grid_blocks) {
        int dev = 0, cus = 0, per_cu = 0;
        hipGetDevice(&dev);
        hipDeviceGetAttribute(&cus, hipDeviceAttributeMultiprocessorCount, dev);
        hipFuncSetAttribute((const void*)fwd_megakernel, hipFuncAttributeMaxDynamicSharedMemorySize, LDS_BYTES);
        hipOccupancyMaxActiveBlocksPerMultiprocessor(&per_cu, (const void*)fwd_megakernel, 512, LDS_BYTES);
        if (per_cu < 1) per_cu = 1;
        grid_blocks = cus * per_cu;
        if (ws_size < WS_END) fprintf(stderr, "kernel_launch: workspace too small: %zu < %zu\n", ws_size, (size_t)WS_END);
    }
    hipMemsetAsync((unsigned char*)d_ws + WS_BAR, 0, XCD_BAR_WORDS * sizeof(unsigned), stream);
    Params p{};
    for (int i = 0; i < 25; ++i) p.in[i] = (const float*)d_in[i];
    p.out = (float*)d_out; p.ws = (unsigned char*)d_ws;
    void* args[] = {&p};
    hipError_t e = hipLaunchCooperativeKernel((const void*)fwd_megakernel, dim3(grid_blocks), dim3(512), args, LDS_BYTES, stream);
    if (e != hipSuccess) fprintf(stderr, "cooperative launch failed: %s (grid %d)\n", hipGetErrorString(e), grid_blocks);
}
```

```cpp
#include <hip/hip_runtime.h>
#include <hip/hip_cooperative_groups.h>
#include <cstdio>
namespace cg = cooperative_groups;

#define DI __device__ __forceinline__
#define LAS __attribute__((address_space(3)))
typedef unsigned short bf16_t;
typedef short bf16x8 __attribute__((ext_vector_type(8)));
typedef short s16x4 __attribute__((ext_vector_type(4)));
typedef float f32x2 __attribute__((ext_vector_type(2)));
typedef float f32x4 __attribute__((ext_vector_type(4)));
typedef float f32x16 __attribute__((ext_vector_type(16)));
typedef unsigned u32x2 __attribute__((ext_vector_type(2)));
typedef unsigned u32x4 __attribute__((ext_vector_type(4)));
typedef __bf16 bf16x2_t __attribute__((ext_vector_type(2)));

#define REP_G1 1
#define REP_SCAN 1
#define REP_ATTN 1
#define REP_GIN 1
#define REP_GOUT 1
#define REP_PREP 1
DI int opaque_i(int v) { asm volatile("" : "+s"(v)); return v; }
constexpr int D = 1024, TP = 8192, BP = 4, BS = 16, TS = 16, PAST = 2048;
constexpr int MP = BP * TP, MS = BS * TS, M = MP + MS, NB = BP + BS;
constexpr int NPROJ = 4096;
constexpr int KSROWS = 2112;
constexpr int NITEM_P = 4096, NITEM = 4224;
constexpr size_t ITEM_BYTES = 90112;
constexpr float RMS_EPS = 1e-6f;
constexpr float QSCALE = 0.125f * 1.4426950408889634f;

constexpr size_t OFF_Y = 0;
constexpr size_t OFF_STP = (size_t)M * D;
constexpr size_t OFF_CVP = OFF_STP + 2ull * 4 * 8 * 128 * 128;
constexpr size_t OFF_KP = OFF_CVP + 2ull * 4 * 3 * 3072;
constexpr size_t OFF_VP = OFF_KP + 2ull * MP * 1024;
constexpr size_t OFF_STS = OFF_VP + 2ull * MP * 1024;
constexpr size_t OFF_CVS = OFF_STS + 2ull * 16 * 8 * 128 * 128;
constexpr size_t OFF_KSO = OFF_CVS + 2ull * 16 * 3 * 3072;
constexpr size_t OFF_VSO = OFF_KSO + 2ull * MS * 1024;

constexpr size_t WS_WING = 0;
constexpr size_t WS_WOUTG = WS_WING + 2ull * 4096 * 1024 * 2;
constexpr size_t WS_WIND = WS_WOUTG + 2ull * 1024 * 1024 * 2;
constexpr size_t WS_WOUTD = WS_WIND + 2ull * 4096 * 1024 * 2;
constexpr size_t WS_ADA = WS_WOUTD + 2ull * 1024 * 1024 * 2;
constexpr size_t WS_ROPE = WS_ADA + 4ull * NB * 3072 * 4;
constexpr size_t WS_AB = WS_ROPE + 8208ull * 64 * 4;
constexpr size_t WS_GL = WS_AB + (size_t)M * 16 * 4;
constexpr size_t WS_BAR = WS_GL + 17408;
constexpr size_t WS_HBUF = WS_GL + 32768;
constexpr size_t WS_ORAW = WS_HBUF + (size_t)M * 1024 * 2;
constexpr size_t WS_PROJ = WS_ORAW + 256;
constexpr size_t WS_R1 = WS_PROJ + (size_t)M * 4096 * 2;
constexpr size_t WS_KH = WS_R1;
constexpr size_t WS_VH = WS_KH + (size_t)MP * 1024 * 2;
constexpr size_t WS_ORAWB = WS_R1 + (size_t)NITEM * ITEM_BYTES;
constexpr size_t WS_KS = WS_ORAWB + (size_t)M * 1024 * 2;
constexpr size_t WS_VS = WS_KS + 16ull * KSROWS * 1024 * 2;
constexpr size_t WS_END = WS_VS + 16ull * KSROWS * 1024 * 2;

constexpr int LDS_BYTES = 131072 + 16;

struct Params { const float* in[25]; float* out; unsigned char* ws; };

DI float bf2f(bf16_t v) { return __uint_as_float(((unsigned)v) << 16); }
DI unsigned pk2(float a, float b) { f32x2 v = {a, b}; bf16x2_t r = __builtin_convertvector(v, bf16x2_t); return __builtin_bit_cast(unsigned, r); }
DI bf16_t f2bf(float a) { return (bf16_t)(pk2(a, 0.f) & 0xffffu); }
template <int CTRL> DI float dppf(float v) { return __builtin_bit_cast(float, __builtin_amdgcn_update_dpp(0, __builtin_bit_cast(int, v), CTRL, 0xf, 0xf, true)); }
DI float row_sum16(float v) { v += dppf<0x128>(v); v += dppf<0x124>(v); v += dppf<0x122>(v); v += dppf<0x121>(v); return v; }
DI float wave_sum(float v) { v = row_sum16(v); v += __shfl_xor(v, 16); v += __shfl_xor(v, 32); return v; }
DI float readlane_f(float v, int l) { return __builtin_bit_cast(float, __builtin_amdgcn_readlane(__builtin_bit_cast(int, v), l)); }
DI float siluf(float x) { return x * __builtin_amdgcn_rcpf(1.f + __expf(-x)); }
DI int ppos(int idx) { const int d5 = idx & 31; return (idx & ~31) | (((d5 >> 2) & 3) << 3) | ((d5 >> 4) << 2) | (d5 & 3); }
DI int perm64(int ls) { return (ls & 15) | (((ls >> 4) & 1) << 5) | (((ls >> 5) & 1) << 4); }
DI void unpack8(const u32x4 v, float (&o)[8]) {
#pragma unroll
    for (int i = 0; i < 4; ++i) { o[2 * i] = __uint_as_float(v[i] << 16); o[2 * i + 1] = __uint_as_float(v[i] & 0xffff0000u); }
}
DI void g2l16(const void* gptr, unsigned lds_addr) {
    asm volatile("s_mov_b32 m0, %1\n\ts_nop 0\n\tglobal_load_lds_dwordx4 %0, off" :: "v"(gptr), "s"(lds_addr) : "memory", "m0");
}
DI unsigned lds_u32(LAS unsigned char* p) { return (unsigned)(size_t)p; }
#define MFMA16(a, b, c) __builtin_amdgcn_mfma_f32_16x16x32_bf16((a), (b), (c), 0, 0, 0)
#define MFMA32(a, b, c) __builtin_amdgcn_mfma_f32_32x32x16_bf16((a), (b), (c), 0, 0, 0)

namespace pg8 {
constexpr int BM = 256, BK = 64, HALF = 128, HTB = HALF * BK * 2, STAGE_BYTES = 8 * HTB, NXCD = 8, WGM = 8;
DI int lds_byte(int r, int c) { const int st = (r >> 4) * 2 + (c >> 5), rr = r & 15, cc = c & 31, ob = rr * 64 + cc * 2; return st * 1024 + (ob ^ (((ob >> 9) & 1) << 5)); }
DI void stage_rc(int b, int& R, int& C) { const int st = b / 1024, sb = b % 1024, swz = sb ^ (((sb >> 9) & 1) << 5); R = (st >> 1) * 16 + swz / 64; C = (st & 1) * 32 + (swz % 64) / 2; }
struct Unit { int pm, pn; };
struct Gemm { const bf16_t* A; const bf16_t* Bt; int M, N, K; };
struct StaticOrder {
    int nM, nN, nwg, G, c;
    DI void init(int M_, int N_, int G_, int c_) { nM = M_ / BM; nN = N_ / BM; nwg = nM * nN; G = G_; c = c_; }
    DI bool next(int i, Unit& u) const {
        const long L = (long)i * G + c; if (L >= nwg) return false;
        int wgid = (int)L; { const int q = nwg / NXCD, r = nwg % NXCD, xcd = wgid % NXCD, off = wgid / NXCD; wgid = (xcd < r ? xcd * (q + 1) : r * (q + 1) + (xcd - r) * q) + off; }
        const int nig = WGM * nN, gid = wgid / nig, fm = gid * WGM, gsz = (nM - fm) < WGM ? (nM - fm) : WGM;
        u.pm = fm + ((wgid % nig) % gsz); u.pn = (wgid % nig) / gsz; return true;
    }
};

template <class Epi>
DI void gemm_phase(LAS unsigned char* lds, const Gemm g, const StaticOrder& S, const Epi& E) {
    int tid_ = threadIdx.x; asm volatile("" : "+v"(tid_)); const int tid = tid_, wid = __builtin_amdgcn_readfirstlane(tid >> 6), lane = tid & 63, wr = wid >> 2, wc = wid & 3, fr = lane & 15, fq = lane >> 4;
    const int K = g.K, nt = K / BK;
    unsigned voffA[2];
#pragma unroll
    for (int i = 0; i < 2; ++i) { int R, C; stage_rc(tid * 16 + i * 8192, R, C); voffA[i] = (unsigned)(R * K + C) * 2u; }
    const size_t kstep = (size_t)(BK * 2);
    const size_t hstep = (size_t)HALF * K * 2;
    const size_t tstep = 2 * hstep;
    const unsigned ldsw = (unsigned)wid * 1024u;
    const int aoff = lds_byte(wr * 64 + fr, fq * 8), boff = lds_byte(wc * 32 + fr, fq * 8);
#define PG8_SA(b, h) (((b) * 2 + (h)) * HTB)
#define PG8_SB(b, h) ((4 + (b) * 2 + (h)) * HTB)
#define PG8_STAGE(bufoff, gbase) do { _Pragma("unroll") for (int _i = 0; _i < 2; ++_i) \
        __builtin_amdgcn_global_load_lds((const unsigned*)((const char*)(gbase) + voffA[_i]), (LAS unsigned*)(lds + (bufoff) + ldsw + _i * 8192), 16, 0, 0); } while (0)
#define PG8_LDA(dst, b, h) do { _Pragma("unroll") for (int m = 0; m < 4; ++m) _Pragma("unroll") for (int k = 0; k < 2; ++k) dst[m][k] = *(const LAS bf16x8*)(lds + PG8_SA(b, h) + aoff + m * 2048 + k * 1024); } while (0)
#define PG8_LDB(dst, b, h) do { _Pragma("unroll") for (int n = 0; n < 2; ++n) _Pragma("unroll") for (int k = 0; k < 2; ++k) dst[n][k] = *(const LAS bf16x8*)(lds + PG8_SB(b, h) + boff + n * 2048 + k * 1024); } while (0)
#define PG8_MMA(ai, bj, At, Bt) do { __builtin_amdgcn_s_setprio(1); _Pragma("unroll") for (int m = 0; m < 4; ++m) _Pragma("unroll") for (int n = 0; n < 2; ++n) _Pragma("unroll") for (int k = 0; k < 2; ++k) \
        acc[ai][bj][m][n] = __builtin_amdgcn_mfma_f32_16x16x32_bf16(Bt[n][k], At[m][k], acc[ai][bj][m][n], 0, 0, 0); __builtin_amdgcn_s_setprio(0); } while (0)
#define PG8_WAIT_V(n) asm volatile("s_waitcnt vmcnt(" #n ")" ::: "memory")
#define PG8_WAIT_L(n) asm volatile("s_waitcnt lgkmcnt(" #n ")" ::: "memory")
#define PG8_BAR __builtin_amdgcn_s_barrier()
#define PG8_SCHED __builtin_amdgcn_sched_barrier(0)
    Unit cur, nxt; int ui = 0;
    if (!S.next(0, cur)) return;
    f32x4 acc[2][2][4][2];
#pragma unroll
    for (int a = 0; a < 2; ++a)
#pragma unroll
        for (int b = 0; b < 2; ++b)
#pragma unroll
            for (int m = 0; m < 4; ++m)
#pragma unroll
                for (int n = 0; n < 2; ++n) acc[a][b][m][n] = (f32x4){0.f, 0.f, 0.f, 0.f};
    bf16x8 At[4][2], B0[2][2], B1[2][2];
    const char* cA = (const char*)g.A + (size_t)cur.pm * tstep; const char* cB = (const char*)g.Bt + (size_t)cur.pn * tstep;
    PG8_STAGE(PG8_SB(0, 0), cB); PG8_STAGE(PG8_SA(0, 0), cA); PG8_STAGE(PG8_SB(0, 1), cB + hstep); PG8_STAGE(PG8_SA(0, 1), cA + hstep);
    if (wr == 1) PG8_BAR;
    PG8_WAIT_V(4); PG8_BAR;
    PG8_STAGE(PG8_SB(1, 0), cB + kstep); PG8_STAGE(PG8_SA(1, 0), cA + kstep); PG8_STAGE(PG8_SB(1, 1), cB + hstep + kstep);
    PG8_WAIT_V(6); PG8_BAR;
    for (;;) {
        const bool has_next = S.next(ui + 1, nxt);
        const char* nA = has_next ? (const char*)g.A + (size_t)nxt.pm * tstep : cA; const char* nB = has_next ? (const char*)g.Bt + (size_t)nxt.pn * tstep : cB;
        for (int t = 0; t < nt; t += 2) {
            const bool last = (t == nt - 2);
            const char* a1 = cA + (size_t)(t + 1) * kstep;
            const char* a2 = last ? nA : cA + (size_t)(t + 2) * kstep; const char* b2 = last ? nB : cB + (size_t)(t + 2) * kstep;
            const char* a3 = a2 + kstep; const char* b3 = b2 + kstep;
            PG8_LDB(B0, 0, 0); PG8_SCHED; PG8_LDA(At, 0, 0); PG8_STAGE(PG8_SA(1, 1), a1 + hstep);
            PG8_WAIT_L(8); PG8_BAR; PG8_WAIT_L(0); PG8_MMA(0, 0, At, B0); PG8_BAR; PG8_SCHED;
            PG8_LDB(B1, 0, 1); PG8_STAGE(PG8_SB(0, 0), b2);
            PG8_BAR; PG8_WAIT_L(0); PG8_MMA(0, 1, At, B1); PG8_BAR;
            PG8_LDA(At, 0, 1); PG8_STAGE(PG8_SA(0, 0), a2);
            PG8_BAR; PG8_WAIT_L(0); PG8_MMA(1, 0, At, B0); PG8_BAR; PG8_SCHED;
            PG8_STAGE(PG8_SB(0, 1), b2 + hstep);
            PG8_WAIT_V(6); PG8_BAR; PG8_MMA(1, 1, At, B1); PG8_BAR;
            PG8_LDB(B0, 1, 0); PG8_SCHED; PG8_LDA(At, 1, 0); PG8_STAGE(PG8_SA(0, 1), a2 + hstep);
            PG8_WAIT_L(8); PG8_BAR; PG8_WAIT_L(0); PG8_MMA(0, 0, At, B0); PG8_BAR; PG8_SCHED;
            PG8_LDB(B1, 1, 1); PG8_STAGE(PG8_SB(1, 0), b3);
            PG8_BAR; PG8_WAIT_L(0); PG8_MMA(0, 1, At, B1); PG8_BAR;
            PG8_LDA(At, 1, 1); PG8_STAGE(PG8_SA(1, 0), a3);
            PG8_BAR; PG8_WAIT_L(0); PG8_MMA(1, 0, At, B0); PG8_BAR; PG8_SCHED;
            PG8_STAGE(PG8_SB(1, 1), b3 + hstep);
            PG8_WAIT_V(6); PG8_BAR; PG8_MMA(1, 1, At, B1); PG8_BAR;
        }
        E(acc, cur, wr, wc, fr, fq);
        if (!has_next) break;
#pragma unroll
        for (int a = 0; a < 2; ++a)
#pragma unroll
            for (int b = 0; b < 2; ++b)
#pragma unroll
                for (int m = 0; m < 4; ++m)
#pragma unroll
                    for (int n = 0; n < 2; ++n) acc[a][b][m][n] = (f32x4){0.f, 0.f, 0.f, 0.f};
        cur = nxt; cA = nA; cB = nB; ++ui;
    }
    PG8_WAIT_V(0);
    if (wr == 0) PG8_BAR;
    PG8_BAR;
#undef PG8_SA
#undef PG8_SB
#undef PG8_STAGE
#undef PG8_LDA
#undef PG8_LDB
#undef PG8_MMA
#undef PG8_WAIT_V
#undef PG8_WAIT_L
#undef PG8_BAR
#undef PG8_SCHED
}
}

struct EpiGdnIn {
    bf16_t* proj; float* conv_p; float* conv_s;
    DI void operator()(const f32x4 (&acc)[2][2][4][2], const pg8::Unit& u, int wr, int wc, int fr, int fq) const {
        const int row0 = u.pm * 256 + wr * 64 + fr, col0 = u.pn * 256 + wc * 32 + 4 * fq;
#pragma unroll
        for (int ai = 0; ai < 2; ++ai)
#pragma unroll
            for (int m = 0; m < 4; ++m) {
                const int r = row0 + ai * 128 + m * 16;
                bf16_t* rowp = proj + (size_t)r * NPROJ + col0;
                bool tail; float* cp;
                if (r < MP) { const int t = r & (TP - 1), b = r >> 13; tail = t >= TP - 3; cp = conv_p + (size_t)(b * 3 + (t - (TP - 3))) * 3072; }
                else { const int rs = r - MP, t = rs & 15, b = rs >> 4; tail = t >= TS - 3; cp = conv_s + (size_t)(b * 3 + (t - (TS - 3))) * 3072; }
#pragma unroll
                for (int bj = 0; bj < 2; ++bj)
#pragma unroll
                    for (int n = 0; n < 2; ++n) {
                        const f32x4 v = acc[ai][bj][m][n];
                        u32x2 w; w.x = pk2(v[0], v[1]); w.y = pk2(v[2], v[3]);
                        *(u32x2*)(rowp + bj * 128 + n * 16) = w;
                        const int c = col0 + bj * 128 + n * 16;
                        if (tail && c < 3072) *(f32x4*)(cp + c) = v;
                    }
            }
    }
};

struct EpiDiffIn {
    bf16_t* proj; float* k_p; float* v_p; float* k_s; float* v_s; bf16_t* ks; bf16_t* vs; bf16_t* kh; bf16_t* vh; const float* rope;
    DI void operator()(const f32x4 (&acc)[2][2][4][2], const pg8::Unit& u, int wr, int wc, int fr, int fq) const {
        const int part = u.pn >> 2;
        const int row0 = u.pm * 256 + wr * 64 + fr;
        const int d0 = 16 * (wc & 1) + 4 * fq;
        const int cbase = u.pn * 256 + 64 * (wc >> 1) + d0;
#pragma unroll
        for (int ai = 0; ai < 2; ++ai)
#pragma unroll
            for (int m = 0; m < 4; ++m) {
                const int r = row0 + ai * 128 + m * 16;
                const int rs = r - MP;
                const int pidx = (r < MP) ? (r & (TP - 1)) : (TP + (rs & 15));
                f32x4 cs = {1.f, 1.f, 1.f, 1.f}, sn = {0.f, 0.f, 0.f, 0.f};
                if (part < 2) { cs = *(const f32x4*)(rope + (size_t)pidx * 64 + d0); sn = *(const f32x4*)(rope + (size_t)pidx * 64 + 32 + d0); }
#pragma unroll
                for (int bj = 0; bj < 2; ++bj) {
                    const f32x4 x1 = acc[ai][bj][m][0], x2 = acc[ai][bj][m][1];
                    f32x4 y1 = x1 * cs - x2 * sn, y2 = x2 * cs + x1 * sn;
                    const int col = cbase + bj * 128;
                    bf16_t* pp = proj + (size_t)r * NPROJ + col;
                    if (part == 0) { y1 *= QSCALE; y2 *= QSCALE; }
                    u32x2 w1, w2; w1.x = pk2(y1[0], y1[1]); w1.y = pk2(y1[2], y1[3]); w2.x = pk2(y2[0], y2[1]); w2.y = pk2(y2[2], y2[3]);
                    if (part == 0 || part == 3) { *(u32x2*)pp = w1; *(u32x2*)(pp + 32) = w2; }
                    if (part == 1 || part == 2) {
                        const int cc = col - part * 1024;
                        const int hh = cc >> 7, dd = cc & 127;
                        float* op; bf16_t* sp;
                        if (r < MP) { op = (part == 1 ? k_p : v_p) + (size_t)r * 1024 + cc;
                               sp = (part == 1 ? kh : vh) + ((size_t)((r >> 13) * 8 + hh) * TP + (r & (TP - 1))) * 128 + dd; }
                        else { op = (part == 1 ? k_s : v_s) + (size_t)rs * 1024 + cc;
                               sp = (part == 1 ? ks : vs) + ((size_t)((rs >> 4) * 8 + hh) * KSROWS + PAST + (rs & 15)) * 128 + dd; }
                        *(f32x4*)op = y1; *(f32x4*)(op + 32) = y2;
                        *(u32x2*)sp = w1; *(u32x2*)(sp + 32) = w2;
                    }
                }
            }
    }
};

struct EpiOut {
    bf16_t* C;
    DI void operator()(const f32x4 (&acc)[2][2][4][2], const pg8::Unit& u, int wr, int wc, int fr, int fq) const {
        const int row0 = u.pm * 256 + wr * 64 + fr, col0 = u.pn * 256 + wc * 32 + 4 * fq;
#pragma unroll
        for (int ai = 0; ai < 2; ++ai)
#pragma unroll
            for (int m = 0; m < 4; ++m) {
                bf16_t* rowp = C + (size_t)(row0 + ai * 128 + m * 16) * 1024 + col0;
#pragma unroll
                for (int bj = 0; bj < 2; ++bj)
#pragma unroll
                    for (int n = 0; n < 2; ++n) { const f32x4 v = acc[ai][bj][m][n]; u32x2 w; w.x = pk2(v[0], v[1]); w.y = pk2(v[2], v[3]); *(u32x2*)(rowp + bj * 128 + n * 16) = w; }
            }
    }
};

DI void transpose_tile(const float* W, int ldw, int n0, int k0, bf16_t* WT, bool perm, LAS float* tile) {
    int tid_ = threadIdx.x; asm volatile("" : "+v"(tid_)); const int tid = tid_;
    {
        const int kk = tid >> 4, c4 = (tid & 15) * 4;
#pragma unroll
        for (int p = 0; p < 2; ++p) {
            const f32x4 v = *(const f32x4*)(W + (size_t)(k0 + kk + 32 * p) * ldw + n0 + c4);
            LAS float* t = tile + (kk + 32 * p) * 65 + c4;
            t[0] = v[0]; t[1] = v[1]; t[2] = v[2]; t[3] = v[3];
        }
    }
    __syncthreads();
    {
        const int n = tid >> 3, ks = (tid & 7) * 8;
        const int src = perm ? perm64(n) : n;
        float v[8];
#pragma unroll
        for (int e = 0; e < 8; ++e) v[e] = tile[(ks + e) * 65 + src];
        u32x4 w; w.x = pk2(v[0], v[1]); w.y = pk2(v[2], v[3]); w.z = pk2(v[4], v[5]); w.w = pk2(v[6], v[7]);
        *(u32x4*)(WT + (size_t)(n0 + n) * 1024 + k0 + ks) = w;
    }
    __syncthreads();
}

DI void phase_prep(const Params& P, LAS unsigned char* lds) {
    int tid_ = threadIdx.x; asm volatile("" : "+v"(tid_)); const int tid = tid_, G = gridDim.x;
    unsigned char* ws = P.ws;
    for (int id = blockIdx.x; id < 5120; id += G) {
        const int j = id / 2560; int rem = id % 2560;
        const float* W; int ldw; bf16_t* WT; bool perm = false; int t;
        if (rem < 1024) { W = P.in[12] + (size_t)j * 1024 * 4112; ldw = 4112; WT = (bf16_t*)(ws + WS_WING) + (size_t)j * 4096 * 1024; t = rem; }
        else if (rem < 1280) { W = P.in[17] + (size_t)j * 1024 * 1024; ldw = 1024; WT = (bf16_t*)(ws + WS_WOUTG) + (size_t)j * 1024 * 1024; t = rem - 1024; }
        else if (rem < 2304) { W = P.in[18] + (size_t)j * 1024 * 4096; ldw = 4096; WT = (bf16_t*)(ws + WS_WIND) + (size_t)j * 4096 * 1024; t = rem - 1280; perm = true; }
        else { W = P.in[24] + (size_t)j * 1024 * 1024; ldw = 1024; WT = (bf16_t*)(ws + WS_WOUTD) + (size_t)j * 1024 * 1024; t = rem - 2304; }
        transpose_tile(W, ldw, (t >> 4) * 64, (t & 15) * 64, WT, perm, (LAS float*)lds);
    }
    for (int idx = blockIdx.x * 512 + tid; idx < 8208 * 32; idx += G * 512) {
        const int pi = idx >> 5, d = idx & 31;
        const int pos = pi < TP ? pi : PAST + (pi - TP);
        const float inv = 1.0f / powf(10000.0f, (float)d / 32.0f);
        const float ang = (float)pos * inv;
        const double rev = (double)ang * 0.15915494309189535;
        const double fr = rev - floor(rev);
        float* rp = (float*)(ws + WS_ROPE) + (size_t)pi * 64;
        rp[d] = __builtin_amdgcn_cosf((float)fr);
        rp[32 + d] = __builtin_amdgcn_sinf((float)fr);
    }
    {
        LAS float* cact = (LAS float*)lds;
        LAS float* red = (LAS float*)(lds + 81920);
        bool loaded = false;
        for (int id = (G - 1 - blockIdx.x); id < 192; id += G) {
            if (!loaded) {
                for (int e = tid; e < NB * 1024; e += 512) {
                    const int b = e >> 10, k = e & 1023;
                    const float c = b < BP ? P.in[2][b * 1024 + k] : P.in[3][(b - BP) * 1024 + k];
                    cact[e] = siluf(c);
                }
                loaded = true;
            }
            __syncthreads();
            const int i = id / 48, cb = id % 48;
            const int col = tid & 63, kg = tid >> 6;
            const float* Wp = P.in[10] + (size_t)i * 1024 * 3072 + cb * 64 + col;
            float acc[NB];
#pragma unroll
            for (int b = 0; b < NB; ++b) acc[b] = 0.f;
            for (int k = kg * 128; k < kg * 128 + 128; k += 4) {
                const float w0 = Wp[(size_t)k * 3072], w1 = Wp[(size_t)(k + 1) * 3072], w2 = Wp[(size_t)(k + 2) * 3072], w3 = Wp[(size_t)(k + 3) * 3072];
#pragma unroll
                for (int b = 0; b < NB; ++b) {
                    const f32x4 c4 = *(const LAS f32x4*)(cact + b * 1024 + k);
                    acc[b] += c4[0] * w0 + c4[1] * w1 + c4[2] * w2 + c4[3] * w3;
                }
            }
#pragma unroll
            for (int b = 0; b < NB; ++b) red[(kg * NB + b) * 64 + col] = acc[b];
            __syncthreads();
            for (int o = tid; o < NB * 64; o += 512) {
                const int b = o >> 6, c = o & 63;
                float s = P.in[11][i * 3072 + cb * 64 + c];
#pragma unroll
                for (int g = 0; g < 8; ++g) s += red[(g * NB + b) * 64 + c];
                ((float*)(ws + WS_ADA))[((size_t)i * NB + b) * 3072 + cb * 64 + c] = s;
            }
        }
        __syncthreads();
    }
}

DI void phase_elem(const Params& P, LAS unsigned char* lds, int layer) {
    int tid_ = threadIdx.x; asm volatile("" : "+v"(tid_)); const int tid = tid_, wid = __builtin_amdgcn_readfirstlane(tid >> 6), lane = tid & 63, G = gridDim.x;
    unsigned char* ws = P.ws;
    const int j = layer >> 1;
    const bool gdn = (layer < 4) && !(layer & 1);
    LAS float* wab = (LAS float*)lds;
    if (gdn) {
        const float* Wp = P.in[12] + (size_t)j * 1024 * 4112 + 4096;
        for (int e = tid; e < 16384; e += 512) { const int k = e >> 4, c = e & 15; wab[c * 1024 + k] = Wp[(size_t)k * 4112 + c]; }
        __syncthreads();
    }
    const float* ada = (const float*)(ws + WS_ADA);
    float* X = P.out;
    const bf16_t* OUTB = (const bf16_t*)(ws + WS_PROJ);
    bf16_t* HB = (bf16_t*)(ws + WS_HBUF);
    float* AB = (float*)(ws + WS_AB);
    f32x4 xn[4]; u32x2 own[4];
#define EL_LOAD(R) do { const int _r = (R); if (_r < M) { \
        const float* _xs = (layer <= 1) ? (_r < MP ? P.in[0] + (size_t)_r * 1024 : P.in[1] + (size_t)(_r - MP) * 1024) : X + (size_t)_r * 1024; \
        _Pragma("unroll") for (int _q = 0; _q < 4; ++_q) xn[_q] = *(const f32x4*)(_xs + 4 * (lane + 64 * _q)); \
        if (layer >= 1) { _Pragma("unroll") for (int _q = 0; _q < 4; ++_q) own[_q] = *(const u32x2*)(OUTB + (size_t)_r * 1024 + 4 * (lane + 64 * _q)); } } } while (0)
    EL_LOAD(blockIdx.x * 8 + wid);
    for (int r = blockIdx.x * 8 + wid; r < M; r += G * 8) {
        const int b = r < MP ? (r >> 13) : BP + ((r - MP) >> 4);
        f32x4 x[4]; u32x2 owc[4];
#pragma unroll
        for (int q = 0; q < 4; ++q) { x[q] = xn[q]; owc[q] = own[q]; }
        EL_LOAD(r + G * 8);
        if (layer >= 1) {
            f32x4 o[4]; float ss = 0.f;
#pragma unroll
            for (int q = 0; q < 4; ++q) { const u32x2 ow = owc[q];
                o[q] = (f32x4){__uint_as_float(ow.x << 16), __uint_as_float(ow.x & 0xffff0000u), __uint_as_float(ow.y << 16), __uint_as_float(ow.y & 0xffff0000u)};
                ss += o[q][0] * o[q][0] + o[q][1] * o[q][1] + o[q][2] * o[q][2] + o[q][3] * o[q][3]; }
            ss = wave_sum(ss);
            const float rstd = __builtin_amdgcn_rsqf(ss * (1.f / 1024.f) + RMS_EPS);
            const float* gp = ada + ((size_t)(layer - 1) * NB + b) * 3072 + 2048;
            const float* np = P.in[9] + (layer - 1) * 1024;
#pragma unroll
            for (int q = 0; q < 4; ++q) {
                const int d = 4 * (lane + 64 * q);
                const f32x4 gt = *(const f32x4*)(gp + d), nw = *(const f32x4*)(np + d);
                x[q] = x[q] + gt * (o[q] * rstd * nw);
                *(f32x4*)(X + (size_t)r * 1024 + d) = x[q];
            }
        }
        if (layer < 4) {
            float ss = 0.f;
#pragma unroll
            for (int q = 0; q < 4; ++q) ss += x[q][0] * x[q][0] + x[q][1] * x[q][1] + x[q][2] * x[q][2] + x[q][3] * x[q][3];
            ss = wave_sum(ss);
            const float rstd = __builtin_amdgcn_rsqf(ss * (1.f / 1024.f) + RMS_EPS);
            const float* ap = ada + ((size_t)layer * NB + b) * 3072;
            const float* np = P.in[8] + layer * 1024;
            f32x4 hv[4];
#pragma unroll
            for (int q = 0; q < 4; ++q) {
                const int d = 4 * (lane + 64 * q);
                const f32x4 sh = *(const f32x4*)(ap + d), sc = *(const f32x4*)(ap + 1024 + d), nw = *(const f32x4*)(np + d);
                hv[q] = (x[q] * rstd * nw) * (1.f + sc) + sh;
                u32x2 w; w.x = pk2(hv[q][0], hv[q][1]); w.y = pk2(hv[q][2], hv[q][3]);
                *(u32x2*)(HB + (size_t)r * 1024 + d) = w;
            }
            if (gdn) {
                float mine = 0.f;
#pragma unroll
                for (int c = 0; c < 16; ++c) {
                    float a = 0.f;
#pragma unroll
                    for (int q = 0; q < 4; ++q) { const f32x4 w4 = *(const LAS f32x4*)(wab + c * 1024 + 4 * (lane + 64 * q)); a += hv[q][0] * w4[0] + hv[q][1] * w4[1] + hv[q][2] * w4[2] + hv[q][3] * w4[3]; }
                    a = row_sum16(a);
                    if ((lane & 15) == c) mine = a;
                }
                mine += __shfl_xor(mine, 16); mine += __shfl_xor(mine, 32);
                if (lane < 16) AB[(size_t)r * 16 + lane] = mine;
            }
        }
    }
}

DI void convert_cache(const Params& P, int j, int b0, int nb) {
    int tid_ = threadIdx.x; asm volatile("" : "+v"(tid_)); const int tid = tid_;
    unsigned char* ws = P.ws;
    const int bx = blockIdx.x - b0; const int G = nb;
    {
        const float* ck = P.in[6] + (size_t)j * 16 * PAST * 1024;
        const float* cv = P.in[7] + (size_t)j * 16 * PAST * 1024;
        bf16_t* KS = (bf16_t*)(ws + WS_KS); bf16_t* VS = (bf16_t*)(ws + WS_VS);
        const size_t nun = (size_t)16 * PAST * 128;
        for (size_t u = (size_t)bx * 512 + tid; u < 2 * nun; u += (size_t)G * 512) {
            const bool isv = u >= nun; const size_t uu = isv ? u - nun : u;
            const size_t b = uu / ((size_t)PAST * 128), rem = uu % ((size_t)PAST * 128);
            const size_t row = rem >> 7, c8 = rem & 127, hh = c8 >> 4, d8 = c8 & 15;
            const float* sp = (isv ? cv : ck) + uu * 8;
            const f32x4 a = *(const f32x4*)sp, c = *(const f32x4*)(sp + 4);
            u32x4 w; w.x = pk2(a[0], a[1]); w.y = pk2(a[2], a[3]); w.z = pk2(c[0], c[1]); w.w = pk2(c[2], c[3]);
            *(u32x4*)((isv ? VS : KS) + ((b * 8 + hh) * KSROWS + row) * 128 + d8 * 8) = w;
        }
        const size_t npad = (size_t)128 * 48 * 16;
        for (size_t u = (size_t)bx * 512 + tid; u < 2 * npad; u += (size_t)G * 512) {
            const bool isv = u >= npad; const size_t uu = isv ? u - npad : u;
            const size_t sq = uu / (48 * 16), rem = uu % (48 * 16);
            *(u32x4*)((isv ? VS : KS) + (sq * KSROWS + PAST + TS) * 128 + rem * 8) = (u32x4){0u, 0u, 0u, 0u};
        }
    }
}

DI void phase_g1(const Params& P, LAS unsigned char* lds, int layer) {
    int tid_ = threadIdx.x; asm volatile("" : "+v"(tid_)); const int tid = tid_, wid = __builtin_amdgcn_readfirstlane(tid >> 6), lane = tid & 63, G = gridDim.x;
    const int fr = lane & 15, fq = lane >> 4;
    unsigned char* ws = P.ws;
    const int j = layer >> 1;
    const bf16_t* proj = (const bf16_t*)(ws + WS_PROJ);
    const float* AB = (const float*)(ws + WS_AB);
    float* GL = (float*)(ws + WS_GL);
    const float* convw = P.in[13] + (size_t)j * 4 * 3072;
    const float* cconv = P.in[5] + (size_t)j * 16 * 3 * 3072;
    LAS unsigned char* Qs = lds;
    LAS unsigned char* Ks = lds + 17408;
    LAS unsigned char* VBt = lds + 34816;
    LAS unsigned char* KBt = lds + 53248;
    LAS float* A32 = (LAS float*)(lds + 71680);
    LAS unsigned char* Ts = lds + 88320;
    LAS unsigned char* QKs = lds + 97536;
    LAS float* Gs = (LAS float*)(lds + 105728);

    u32x4 rows[11];
#define G1_ROWLOAD(IT) do { const int _it = (IT); if (tid < 384 && _it < NITEM) { int _h, _c, _row0, _nv; bool _smp; \
            if (_it < NITEM_P) { const int _seq = _it >> 7; _h = _seq & 7; _c = _it & 127; _row0 = (_seq >> 3) * TP + 64 * _c; _nv = 64; _smp = false; } \
            else { const int _s = _it - NITEM_P; _h = _s & 7; _c = 0; _row0 = MP + (_s >> 3) * TS; _nv = TS; _smp = true; } \
            int _t = tid; asm volatile("" : "+v"(_t)); const int _l16 = _t & 15, _grp = _t >> 4, _part = _grp >> 3, _rb = _grp & 7; \
            const int _ch = _part * 1024 + _h * 128 + 8 * _l16; \
            _Pragma("unroll") for (int _k = 0; _k < 11; ++_k) { const int _lr = 8 * _rb - 3 + _k; \
                const bool _up = (_lr >= 0 && _lr < _nv) || (_lr < 0 && !_smp && _c > 0); const int _lrc = _up ? _lr : 0; \
                rows[_k] = *(const u32x4*)(proj + (size_t)(_row0 + _lrc) * NPROJ + _ch); } } } while (0)
    G1_ROWLOAD((int)blockIdx.x);
    for (int item = blockIdx.x; item < NITEM; item += G) {
        int b, h, c, row0, nvalid; bool sample;
        if (item < NITEM_P) { const int seq = item >> 7; b = seq >> 3; h = seq & 7; c = item & 127; row0 = b * TP + 64 * c; nvalid = 64; sample = false; }
        else { const int s = item - NITEM_P; b = s >> 3; h = s & 7; c = 0; row0 = MP + b * TS; nvalid = TS; sample = true; }
        unsigned char* ib = ws + WS_R1 + (size_t)item * ITEM_BYTES;
        float val[8][8];
        float rn[8];
        int tido = tid; asm volatile("" : "+v"(tido));
        const int l16 = tido & 15, grp = tido >> 4, part = grp >> 3, rb = grp & 7;
        const int lane = tido & 63, fr = lane & 15, fq = lane >> 4;
        if (tid < 384) {
            const int ch = part * 1024 + h * 128 + 8 * l16;
            float wv[4][8];
#pragma unroll
            for (int t = 0; t < 4; ++t) {
                const f32x4 a = *(const f32x4*)(convw + t * 3072 + ch), bb = *(const f32x4*)(convw + t * 3072 + ch + 4);
                wv[t][0] = a[0]; wv[t][1] = a[1]; wv[t][2] = a[2]; wv[t][3] = a[3]; wv[t][4] = bb[0]; wv[t][5] = bb[1]; wv[t][6] = bb[2]; wv[t][7] = bb[3];
            }
            float win[4][8];
#pragma unroll
            for (int t = 0; t < 4; ++t)
#pragma unroll
                for (int e = 0; e < 8; ++e) win[t][e] = 0.f;
#pragma unroll
            for (int k = 0; k < 11; ++k) {
                const int lr = 8 * rb - 3 + k;
                float in8[8];
                {
                    const bool use_proj = (lr >= 0 && lr < nvalid) || (lr < 0 && !sample && c > 0);
                    unpack8(rows[k], in8);
                    if (!use_proj) {
#pragma unroll
                        for (int e = 0; e < 8; ++e) in8[e] = 0.f;
                    }
                }
                if (k < 3) {
                    if (sample && lr < 0) {
                        const float* sp = cconv + (size_t)(b * 3 + (3 + lr)) * 3072 + ch;
                        const f32x4 a = *(const f32x4*)sp, bb = *(const f32x4*)(sp + 4);
                        in8[0] = a[0]; in8[1] = a[1]; in8[2] = a[2]; in8[3] = a[3]; in8[4] = bb[0]; in8[5] = bb[1]; in8[6] = bb[2]; in8[7] = bb[3];
                    }
                }
#pragma unroll
                for (int e = 0; e < 8; ++e) { win[0][e] = win[1][e]; win[1][e] = win[2][e]; win[2][e] = win[3][e]; win[3][e] = in8[e]; }
                if (k >= 3) {
                    const bool rv = (lr < nvalid);
                    float ss = 0.f;
#pragma unroll
                    for (int e = 0; e < 8; ++e) {
                        const float y = win[0][e] * wv[0][e] + win[1][e] * wv[1][e] + win[2][e] * wv[2][e] + win[3][e] * wv[3][e];
                        const float s = rv ? siluf(y) : 0.f;
                        val[k - 3][e] = s; ss += s * s;
                    }
                    ss = row_sum16(ss);
                    rn[k - 3] = __builtin_amdgcn_rsqf(ss + 1e-6f);
                }
            }
        } else if (wid == 7) {
            const int r = row0 + (lane < nvalid ? lane : 0);
            const bool valid = lane < nvalid;
            const float a = AB[(size_t)r * 16 + h], bb = AB[(size_t)r * 16 + 8 + h];
            const float xa = a + P.in[15][j * 8 + h];
            const float ey = __expf(-fabsf(xa));
            const float lp = (ey < 0.01f) ? ey * (1.f - ey * (0.5f - ey * 0.33333334f)) : __logf(1.f + ey);
            const float sp = fmaxf(xa, 0.f) + lp;
            float g = valid ? -__expf(P.in[14][j * 8 + h]) * sp : 0.f;
            const float beta = valid ? __builtin_amdgcn_rcpf(1.f + __expf(-bb)) : 0.f;
#pragma unroll
            for (int o = 1; o < 64; o <<= 1) { const float t = __shfl_up(g, o); if (lane >= o) g += t; }
            const float glast = readlane_f(g, 63);
            Gs[lane] = g; Gs[64 + lane] = beta; Gs[128 + lane] = __expf(g); Gs[192 + lane] = __expf(glast - g);
            if (lane == 0) GL[item] = __expf(glast);
        }
        __syncthreads();
        G1_ROWLOAD(item + G);
        if (tid < 384) {
#pragma unroll
            for (int rr = 0; rr < 8; ++rr) {
                const int row = 8 * rb + rr;
                const float beta = Gs[64 + row], eG = Gs[128 + row];
                if (part == 0) {
                    const float sc = rn[rr] * 0.08838834764831845f;
                    float q[8];
#pragma unroll
                    for (int e = 0; e < 8; ++e) q[e] = val[rr][e] * sc;
                    u32x4 w; w.x = pk2(q[0], q[1]); w.y = pk2(q[2], q[3]); w.z = pk2(q[4], q[5]); w.w = pk2(q[6], q[7]);
                    *(LAS u32x4*)(Qs + row * 272 + l16 * 16) = w;
                    bf16_t* qg = (bf16_t*)(ib + 49152) + row * 128;
                    u32x2 g0, g1; g0.x = pk2(q[0] * eG, q[1] * eG); g0.y = pk2(q[2] * eG, q[3] * eG); g1.x = pk2(q[4] * eG, q[5] * eG); g1.y = pk2(q[6] * eG, q[7] * eG);
                    *(u32x2*)(qg + ppos(8 * l16)) = g0; *(u32x2*)(qg + ppos(8 * l16 + 4)) = g1;
                    val[rr][0] = 0.f;
                } else if (part == 1) {
#pragma unroll
                    for (int e = 0; e < 8; ++e) val[rr][e] *= rn[rr];
                    u32x4 w; w.x = pk2(val[rr][0], val[rr][1]); w.y = pk2(val[rr][2], val[rr][3]); w.z = pk2(val[rr][4], val[rr][5]); w.w = pk2(val[rr][6], val[rr][7]);
                    *(LAS u32x4*)(Ks + row * 272 + l16 * 16) = w;
                }
            }
            if (part >= 1) {
                float bsc[8], ksc[8];
#pragma unroll
                for (int rr = 0; rr < 8; ++rr) { const int row = 8 * rb + rr; const float beta = Gs[64 + row]; bsc[rr] = (part == 1) ? beta * Gs[128 + row] : beta; ksc[rr] = Gs[192 + row]; }
                LAS unsigned char* Tt = (part == 1) ? KBt : VBt;
#pragma unroll
                for (int e = 0; e < 8; ++e) {
                    const int dch = 8 * l16 + e;
                    u32x4 w; w.x = pk2(val[0][e] * bsc[0], val[1][e] * bsc[1]); w.y = pk2(val[2][e] * bsc[2], val[3][e] * bsc[3]);
                    w.z = pk2(val[4][e] * bsc[4], val[5][e] * bsc[5]); w.w = pk2(val[6][e] * bsc[6], val[7][e] * bsc[7]);
                    *(LAS u32x4*)(Tt + dch * 144 + rb * 16) = w;
                    if (part == 1) {
                        bf16_t* kd = (bf16_t*)(ib + 65536) + dch * 64;
                        u32x2 k0, k1; k0.x = pk2(val[0][e] * ksc[0], val[1][e] * ksc[1]); k0.y = pk2(val[2][e] * ksc[2], val[3][e] * ksc[3]);
                        k1.x = pk2(val[4][e] * ksc[4], val[5][e] * ksc[5]); k1.y = pk2(val[6][e] * ksc[6], val[7][e] * ksc[7]);
                        *(u32x2*)(kd + ppos(8 * rb)) = k0; *(u32x2*)(kd + ppos(8 * rb + 4)) = k1;
                    }
                }
            }
        }
        __syncthreads();
        {
            const int mt = wid & 3; const bool isqk = wid >= 4;
            LAS unsigned char* As = isqk ? Qs : Ks;
            f32x4 acc[4];
#pragma unroll
            for (int nt = 0; nt < 4; ++nt) acc[nt] = (f32x4){0.f, 0.f, 0.f, 0.f};
#pragma unroll
            for (int ks = 0; ks < 4; ++ks) {
                const bf16x8 a = *(const LAS bf16x8*)(As + (16 * mt + fr) * 272 + (32 * ks + 8 * fq) * 2);
#pragma unroll
                for (int nt = 0; nt < 4; ++nt) {
                    const bf16x8 bfr = *(const LAS bf16x8*)(Ks + (16 * nt + fr) * 272 + (32 * ks + 8 * fq) * 2);
                    acc[nt] = MFMA16(a, bfr, acc[nt]);
                }
            }
#pragma unroll
            for (int nt = 0; nt < 4; ++nt) {
                const int cp = 16 * nt + fr; const float Gc2 = Gs[cp];
#pragma unroll
                for (int i = 0; i < 4; ++i) {
                    const int cr = 16 * mt + 4 * fq + i;
                    const float dec = __expf(Gs[cr] - Gc2);
                    if (!isqk) A32[cr * 65 + cp] = (cr > cp) ? Gs[64 + cr] * acc[nt][i] * dec : 0.f;
                    else *(LAS bf16_t*)(QKs + (cr * 64 + ppos(cp)) * 2) = f2bf((cr >= cp) ? acc[nt][i] * dec : 0.f);
                }
            }
        }
        __syncthreads();
        {
            float a[64];
#pragma unroll
            for (int jj = 0; jj < 64; ++jj) a[jj] = A32[lane * 65 + jj];
            float x[8];
#pragma unroll
            for (int cc = 0; cc < 8; ++cc) x[cc] = (lane == 8 * wid + cc) ? 1.f : 0.f;
#pragma unroll
            for (int jj = 0; jj < 64; ++jj) {
                if (jj >= 8 * wid) {
#pragma unroll
                    for (int cc = 0; cc < 8; ++cc) { const float xj = readlane_f(x[cc], jj); x[cc] -= a[jj] * xj; }
                }
            }
            u32x4 w; w.x = pk2(x[0], x[1]); w.y = pk2(x[2], x[3]); w.z = pk2(x[4], x[5]); w.w = pk2(x[6], x[7]);
            *(LAS u32x4*)(Ts + lane * 144 + wid * 16) = w;
            *(u32x4*)(ib + 81920 + tid * 16) = *(const LAS u32x4*)(QKs + tid * 16);
        }
        __syncthreads();
        {
            const bool isw = wid >= 4; const int n0 = 32 * (wid & 3);
            LAS unsigned char* Bs = isw ? KBt : VBt;
            f32x4 acc[4][2];
#pragma unroll
            for (int mt = 0; mt < 4; ++mt) { acc[mt][0] = (f32x4){0.f, 0.f, 0.f, 0.f}; acc[mt][1] = (f32x4){0.f, 0.f, 0.f, 0.f}; }
#pragma unroll
            for (int ks = 0; ks < 2; ++ks) {
                bf16x8 bfr[2];
#pragma unroll
                for (int nn = 0; nn < 2; ++nn) bfr[nn] = *(const LAS bf16x8*)(Bs + (n0 + 16 * nn + fr) * 144 + (32 * ks + 8 * fq) * 2);
#pragma unroll
                for (int mt = 0; mt < 4; ++mt) {
                    const bf16x8 a = *(const LAS bf16x8*)(Ts + (16 * mt + fr) * 144 + (32 * ks + 8 * fq) * 2);
                    acc[mt][0] = MFMA16(a, bfr[0], acc[mt][0]); acc[mt][1] = MFMA16(a, bfr[1], acc[mt][1]);
                }
            }
            if (!isw) {
                bf16_t* U = (bf16_t*)ib;
#pragma unroll
                for (int mt = 0; mt < 4; ++mt)
#pragma unroll
                    for (int nn = 0; nn < 2; ++nn) { u32x2 w; w.x = pk2(acc[mt][nn][0], acc[mt][nn][1]); w.y = pk2(acc[mt][nn][2], acc[mt][nn][3]);
                        *(u32x2*)(U + (n0 + 16 * nn + fr) * 64 + 16 * mt + 4 * fq) = w; }
            } else {
#pragma unroll
                for (int mt = 0; mt < 4; ++mt)
#pragma unroll
                    for (int nn = 0; nn < 2; ++nn)
#pragma unroll
                        for (int i = 0; i < 4; ++i) *(LAS bf16_t*)(Qs + ((16 * mt + 4 * fq + i) * 128 + ppos(n0 + 16 * nn + fr)) * 2) = f2bf(acc[mt][nn][i]);
            }
        }
        __syncthreads();
        {
            *(u32x4*)(ib + 32768 + tid * 16) = *(const LAS u32x4*)(Qs + tid * 16);
            *(u32x4*)(ib + 32768 + 8192 + tid * 16) = *(const LAS u32x4*)(Qs + 8192 + tid * 16);
        }
        __syncthreads();
    }
}

DI void phase_scan(const Params& P, LAS unsigned char* lds, int layer) {
    int tid_ = threadIdx.x; asm volatile("" : "+v"(tid_)); const int tid = tid_, wid = __builtin_amdgcn_readfirstlane(tid >> 6), lane = tid & 63, G = gridDim.x;
    const int fr = lane & 15, fq = lane >> 4;
    unsigned char* ws = P.ws;
    const int j = layer >> 1;
    const bf16_t* proj = (const bf16_t*)(ws + WS_PROJ);
    const float* GL = (const float*)(ws + WS_GL);
    bf16_t* ORAW = (bf16_t*)(ws + WS_ORAWB);
    constexpr int BUFB = 57344;
    LAS float* red = (LAS float*)(lds + 2 * BUFB);

    if (G >= 192 && (int)blockIdx.x >= 160) { convert_cache(P, j, 160, G - 160); return; }
    for (int seq = blockIdx.x; seq < 160; seq += G) {
        int b, h, nch, item0, row0, nvalid; float* stout;
        f32x4 st[8];
        const int dvc = 16 * wid + fr;
        if (seq < 32) {
            b = seq >> 3; h = seq & 7; nch = 128; item0 = seq * 128; row0 = b * TP; nvalid = 64;
            stout = P.out + OFF_STP + ((size_t)(j * 4 + b) * 8 + h) * 16384;
#pragma unroll
            for (int mt = 0; mt < 8; ++mt) st[mt] = (f32x4){0.f, 0.f, 0.f, 0.f};
        } else {
            const int s = seq - 32; b = s >> 3; h = s & 7; nch = 1; item0 = NITEM_P + s; row0 = MP + b * TS; nvalid = TS;
            stout = P.out + OFF_STS + ((size_t)(j * 16 + b) * 8 + h) * 16384;
            const float* s0 = P.in[4] + ((size_t)(j * 16 + b) * 8 + h) * 16384;
            const unsigned s0o = (unsigned)(4 * fq * 128 + dvc);
#pragma unroll
            for (int mt = 0; mt < 8; ++mt)
#pragma unroll
                for (int i = 0; i < 4; ++i) st[mt][i] = s0[(unsigned)((16 * mt + i) * 128) + s0o];
        }
        const float onw = P.in[16][j * 128 + dvc];
        u32x2 un[4];
#define SCAN_G2L(itm, bufi, LN) do { const unsigned char* _ib = ws + WS_R1 + (size_t)(itm) * ITEM_BYTES + 32768; \
            _Pragma("unroll") for (int _p = 0; _p < 7; ++_p) { const int _L = (wid + 8 * _p) * 1024 + (LN) * 16; unsigned _src; \
                if (_p < 4) { const int _row = _L >> 8, _ch = (_L >> 4) & 15; _src = (_L & ~255) + ((_ch ^ (_row & 15)) << 4); } \
                else { const int _a = _L - 32768, _row = _a >> 7, _ch = (_a >> 4) & 7; _src = 32768 + (_a & ~127) + ((_ch ^ ((_row >> 1) & 7)) << 4); } \
                g2l16(_ib + _src, lds_u32(lds + (bufi) * BUFB + (wid + 8 * _p) * 1024)); } } while (0)
#define SCAN_LOADU(itm) do { const bf16_t* _u = (const bf16_t*)(ws + WS_R1 + (size_t)(itm) * ITEM_BYTES); const unsigned _uo = (unsigned)((16 * wid + fr) * 64 + 4 * fq); \
            _Pragma("unroll") for (int _m = 0; _m < 4; ++_m) un[_m] = *(const u32x2*)(_u + (unsigned)(16 * _m) + _uo); } while (0)
        __syncthreads();
        SCAN_G2L(item0, 0, lane);
        SCAN_LOADU(item0);
        float gln = GL[item0];
        asm volatile("s_waitcnt vmcnt(0)" ::: "memory");
        __syncthreads();
        for (int c = 0; c < nch; ++c) {
            int frq = lane; asm volatile("" : "+v"(frq));
            const int fr = frq & 15, fq = frq >> 4;
            LAS unsigned char* bb = lds + (c & 1) * BUFB;
            const float gl = gln;
            f32x4 u[4];
#pragma unroll
            for (int mt = 0; mt < 4; ++mt) u[mt] = (f32x4){__uint_as_float(un[mt].x << 16), __uint_as_float(un[mt].x & 0xffff0000u), __uint_as_float(un[mt].y << 16), __uint_as_float(un[mt].y & 0xffff0000u)};
            if (c + 1 < nch) { gln = GL[item0 + c + 1]; SCAN_G2L(item0 + c + 1, (c + 1) & 1, frq); SCAN_LOADU(item0 + c + 1); }
            const int x16 = fr << 4, x8 = ((fr >> 1) & 7) << 4;
            bf16x8 sf[4];
#pragma unroll
            for (int ks = 0; ks < 4; ++ks) {
                u32x4 w; w.x = pk2(-st[2 * ks][0], -st[2 * ks][1]); w.y = pk2(-st[2 * ks][2], -st[2 * ks][3]); w.z = pk2(-st[2 * ks + 1][0], -st[2 * ks + 1][1]); w.w = pk2(-st[2 * ks + 1][2], -st[2 * ks + 1][3]);
                sf[ks] = __builtin_bit_cast(bf16x8, w);
            }
            bf16x8 fa[4], fb[4];
#define SC_LD256(dst, base, mt) do { _Pragma("unroll") for (int _k = 0; _k < 4; ++_k) \
                dst[_k] = *(const LAS bf16x8*)(bb + (base) + (16 * (mt) + fr) * 256 + ((((4 * _k + fq) << 4)) ^ x16)); } while (0)
#define SC_LD128(dst, base, mtlo) do { _Pragma("unroll") for (int _m = 0; _m < 2; ++_m) _Pragma("unroll") for (int _k = 0; _k < 2; ++_k) \
                dst[_m * 2 + _k] = *(const LAS bf16x8*)(bb + (base) + (16 * ((mtlo) + _m) + fr) * 128 + ((((4 * _k + fq) << 4)) ^ x8)); } while (0)
#define SC_SB __builtin_amdgcn_sched_barrier(0)
#define SC_MU(f, mt) do { _Pragma("unroll") for (int _k = 0; _k < 4; ++_k) u[mt] = MFMA16(f[_k], sf[_k], u[mt]); } while (0)
#define SC_MO(f, mt) do { _Pragma("unroll") for (int _k = 0; _k < 4; ++_k) o[mt] = MFMA16(f[_k], sf[_k], o[mt]); } while (0)
#define SC_MQK(f, mtlo) do { _Pragma("unroll") for (int _m = 0; _m < 2; ++_m) _Pragma("unroll") for (int _k = 0; _k < 2; ++_k) o[(mtlo) + _m] = MFMA16(f[_m * 2 + _k], uf[_k], o[(mtlo) + _m]); } while (0)
#define SC_MKD(f, mtlo) do { _Pragma("unroll") for (int _m = 0; _m < 2; ++_m) { st[(mtlo) + _m] = st[(mtlo) + _m] * gl; _Pragma("unroll") for (int _k = 0; _k < 2; ++_k) st[(mtlo) + _m] = MFMA16(f[_m * 2 + _k], uf[_k], st[(mtlo) + _m]); } } while (0)
            f32x4 o[4];
#pragma unroll
            for (int mt = 0; mt < 4; ++mt) o[mt] = (f32x4){0.f, 0.f, 0.f, 0.f};
            SC_LD256(fa, 0, 0); SC_LD256(fb, 0, 1); SC_SB;
            SC_MU(fa, 0); SC_LD256(fa, 0, 2); SC_SB;
            SC_MU(fb, 1); SC_LD256(fb, 0, 3); SC_SB;
            SC_MU(fa, 2); SC_LD256(fa, 16384, 0); SC_SB;
            SC_MU(fb, 3); SC_LD256(fb, 16384, 1); SC_SB;
#pragma unroll
            for (int ks = 0; ks < 4; ++ks) sf[ks] = sf[ks] ^ (short)0x8000;
            SC_MO(fa, 0); SC_LD256(fa, 16384, 2); SC_SB;
            SC_MO(fb, 1); SC_LD256(fb, 16384, 3); SC_SB;
            SC_MO(fa, 2); SC_LD128(fa, 49152, 0); SC_SB;
            SC_MO(fb, 3); SC_LD128(fb, 49152, 2); SC_SB;
            bf16x8 uf[2];
#pragma unroll
            for (int k2 = 0; k2 < 2; ++k2) {
                u32x4 w; w.x = pk2(u[2 * k2][0], u[2 * k2][1]); w.y = pk2(u[2 * k2][2], u[2 * k2][3]); w.z = pk2(u[2 * k2 + 1][0], u[2 * k2 + 1][1]); w.w = pk2(u[2 * k2 + 1][2], u[2 * k2 + 1][3]);
                uf[k2] = __builtin_bit_cast(bf16x8, w);
            }
            SC_MQK(fa, 0); SC_LD128(fa, 32768, 0); SC_SB;
            SC_MQK(fb, 2); SC_LD128(fb, 32768, 2); SC_SB;
            SC_MKD(fa, 0); SC_LD128(fa, 32768, 4); SC_SB;
            SC_MKD(fb, 2); SC_LD128(fb, 32768, 6); SC_SB;
            SC_MKD(fa, 4); SC_SB;
            SC_MKD(fb, 6);
#undef SC_MU
#undef SC_MO
#undef SC_MQK
#undef SC_MKD
#undef SC_LD256
#undef SC_LD128
#undef SC_SB
            {
                bf16_t* obb = ORAW + (size_t)(row0 + 64 * c) * 1024 + h * 128;
                const unsigned oo = (unsigned)(4 * fq * 1024 + 16 * wid + fr);
                if (nvalid == 64) {
#pragma unroll
                    for (int mt = 0; mt < 4; ++mt)
#pragma unroll
                        for (int i = 0; i < 4; ++i) obb[(unsigned)((16 * mt + i) * 1024) + oo] = f2bf(o[mt][i]);
                } else {
#pragma unroll
                    for (int i = 0; i < 4; ++i) obb[(unsigned)(i * 1024) + oo] = f2bf(o[0][i]);
                }
            }
            asm volatile("s_waitcnt vmcnt(0)" ::: "memory");
            __syncthreads();
        }
        {
            int lz = lane; asm volatile("" : "+v"(lz));
            const unsigned so = (unsigned)(4 * (lz >> 4) * 128 + 16 * wid + (lz & 15));
#pragma unroll
            for (int mt = 0; mt < 8; ++mt)
#pragma unroll
                for (int i = 0; i < 4; ++i) stout[(unsigned)((16 * mt + i) * 128) + so] = st[mt][i];
        }
#undef SCAN_G2L
#undef SCAN_LOADU
    }
    if (G < 192) convert_cache(P, j, 0, G);
}

DI void phase_gnorm(const Params& P, int layer) {
    int tid_ = threadIdx.x; asm volatile("" : "+v"(tid_)); const int tid = tid_, wid = __builtin_amdgcn_readfirstlane(tid >> 6), lane = tid & 63, G = gridDim.x;
    unsigned char* ws = P.ws;
    const int j = layer >> 1;
    const bf16_t* ORAW = (const bf16_t*)(ws + WS_ORAWB);
    const bf16_t* proj = (const bf16_t*)(ws + WS_PROJ);
    bf16_t* OB = (bf16_t*)(ws + WS_HBUF);
    float onw[16];
#pragma unroll
    for (int e = 0; e < 16; ++e) onw[e] = P.in[16][j * 128 + ((16 * lane + e) & 127)];
    for (int r = blockIdx.x * 8 + wid; r < M; r += G * 8) {
        const u32x4 o0 = *(const u32x4*)(ORAW + (size_t)r * 1024 + 16 * lane), o1 = *(const u32x4*)(ORAW + (size_t)r * 1024 + 16 * lane + 8);
        const u32x4 z0 = *(const u32x4*)(proj + (size_t)r * NPROJ + 3072 + 16 * lane), z1 = *(const u32x4*)(proj + (size_t)r * NPROJ + 3072 + 16 * lane + 8);
        float ov[16], zv[16];
        { float t8[8]; unpack8(o0, t8);
#pragma unroll
          for (int e = 0; e < 8; ++e) ov[e] = t8[e];
          unpack8(o1, t8);
#pragma unroll
          for (int e = 0; e < 8; ++e) ov[8 + e] = t8[e];
          unpack8(z0, t8);
#pragma unroll
          for (int e = 0; e < 8; ++e) zv[e] = t8[e];
          unpack8(z1, t8);
#pragma unroll
          for (int e = 0; e < 8; ++e) zv[8 + e] = t8[e]; }
        float ss = 0.f;
#pragma unroll
        for (int e = 0; e < 16; ++e) ss += ov[e] * ov[e];
        ss += __shfl_xor(ss, 1); ss += __shfl_xor(ss, 2); ss += __shfl_xor(ss, 4);
        const float rstd = __builtin_amdgcn_rsqf(ss * (1.f / 128.f) + RMS_EPS);
        float y[16];
#pragma unroll
        for (int e = 0; e < 16; ++e) y[e] = ov[e] * rstd * onw[e] * siluf(zv[e]);
        u32x4 w0, w1;
        w0.x = pk2(y[0], y[1]); w0.y = pk2(y[2], y[3]); w0.z = pk2(y[4], y[5]); w0.w = pk2(y[6], y[7]);
        w1.x = pk2(y[8], y[9]); w1.y = pk2(y[10], y[11]); w1.z = pk2(y[12], y[13]); w1.w = pk2(y[14], y[15]);
        *(u32x4*)(OB + (size_t)r * 1024 + 16 * lane) = w0; *(u32x4*)(OB + (size_t)r * 1024 + 16 * lane + 8) = w1;
    }
}

DI void att_s(LAS unsigned char* Ka, int t, const bf16x8 (&qf)[4], f32x16& s0, f32x16& s1) {
#pragma unroll
    for (int i = 0; i < 16; ++i) { s0[i] = 0.f; s1[i] = 0.f; }
    bf16x8 kf[8];
#pragma unroll
    for (int s = 0; s < 4; ++s) { kf[2 * s] = *(const LAS bf16x8*)(Ka + (t ^ (s << 5))); kf[2 * s + 1] = *(const LAS bf16x8*)(Ka + 8192 + (t ^ (s << 5))); }
#pragma unroll
    for (int s = 0; s < 4; ++s) { s0 = MFMA32(kf[2 * s], qf[s], s0); s1 = MFMA32(kf[2 * s + 1], qf[s], s1); }
}
template <bool MASK>
DI float att_softmax(f32x16& s0, f32x16& s1, float& m, float& l, bf16x8 (&pf)[2][2], int h2, int nvk) {
    if (MASK) {
#pragma unroll
        for (int i = 0; i < 16; ++i) {
            const int key = (i & 3) + 8 * (i >> 2) + 4 * h2;
            s0[i] = (key < nvk) ? s0[i] : -INFINITY;
            s1[i] = (32 + key < nvk) ? s1[i] : -INFINITY;
        }
    }
    float mx = s0[0];
#pragma unroll
    for (int i = 1; i < 16; ++i) mx = fmaxf(mx, s0[i]);
#pragma unroll
    for (int i = 0; i < 16; ++i) mx = fmaxf(mx, s1[i]);
    mx = fmaxf(mx, __shfl_xor(mx, 32));
    const float mn = fmaxf(m, mx);
    const float alpha = __builtin_amdgcn_exp2f(m - mn);
    m = mn;
    float ps = 0.f;
#pragma unroll
    for (int i = 0; i < 16; ++i) { s0[i] = __builtin_amdgcn_exp2f(s0[i] - mn); s1[i] = __builtin_amdgcn_exp2f(s1[i] - mn); ps += s0[i] + s1[i]; }
    l = l * alpha + ps;
    u32x4 w;
    w.x = pk2(s0[0], s0[1]); w.y = pk2(s0[2], s0[3]); w.z = pk2(s0[4], s0[5]); w.w = pk2(s0[6], s0[7]); pf[0][0] = __builtin_bit_cast(bf16x8, w);
    w.x = pk2(s0[8], s0[9]); w.y = pk2(s0[10], s0[11]); w.z = pk2(s0[12], s0[13]); w.w = pk2(s0[14], s0[15]); pf[0][1] = __builtin_bit_cast(bf16x8, w);
    w.x = pk2(s1[0], s1[1]); w.y = pk2(s1[2], s1[3]); w.z = pk2(s1[4], s1[5]); w.w = pk2(s1[6], s1[7]); pf[1][0] = __builtin_bit_cast(bf16x8, w);
    w.x = pk2(s1[8], s1[9]); w.y = pk2(s1[10], s1[11]); w.z = pk2(s1[12], s1[13]); w.w = pk2(s1[14], s1[15]); pf[1][1] = __builtin_bit_cast(bf16x8, w);
    return alpha;
}
DI void att_pv(LAS unsigned char* Va, int q4, f32x16 (&O)[4], const bf16x8 (&pf)[2][2]) {
    s16x4 lo[16], hi[16];
#define PV_LD(i) do { LAS unsigned char* _vp = Va + ((((i) >> 2) ^ q4) << 6) + (32 * (((i) >> 1) & 1) + 16 * ((i) & 1)) * 256; \
        lo[i] = __builtin_amdgcn_ds_read_tr16_b64_v4i16((LAS s16x4*)_vp); hi[i] = __builtin_amdgcn_ds_read_tr16_b64_v4i16((LAS s16x4*)(_vp + 8 * 256)); } while (0)
    PV_LD(0); PV_LD(1); PV_LD(2);
#pragma unroll
    for (int i = 0; i < 16; ++i) {
        if (i + 3 < 16) PV_LD(i + 3);
        const bf16x8 vf = __builtin_shufflevector(lo[i], hi[i], 0, 1, 2, 3, 4, 5, 6, 7);
        O[i >> 2] = MFMA32(vf, pf[(i >> 1) & 1][i & 1], O[i >> 2]);
    }
#undef PV_LD
}

DI void phase_attn(const Params& P, LAS unsigned char* lds, int layer) {
    int tid_ = threadIdx.x; asm volatile("" : "+v"(tid_)); const int tid = tid_, wid = __builtin_amdgcn_readfirstlane(tid >> 6), lane = tid & 63, G = gridDim.x;
    unsigned char* ws = P.ws;
    const int j = layer >> 1;
    const int comp = wid >> 2, rg = wid & 3, r32 = lane & 31, h2 = lane >> 5;
    const bf16_t* proj = (const bf16_t*)(ws + WS_PROJ);
    bf16_t* OB = (bf16_t*)(ws + WS_HBUF);
    const float lam_init = 0.8f - 0.6f * expf(-0.3f * (float)layer);
    float lam;
    {
        float d1 = 0.f, d2 = 0.f;
        for (int i = 0; i < 64; ++i) { d1 += P.in[19][j * 64 + i] * P.in[20][j * 64 + i]; d2 += P.in[21][j * 64 + i] * P.in[22][j * 64 + i]; }
        lam = expf(d1) - expf(d2) + lam_init;
    }
    const float* subln = P.in[23] + j * 128;
    constexpr int TB = 32768;
    const int vb = (G % 8 == 0) ? (blockIdx.x % 8) * (G / 8) + blockIdx.x / 8 : blockIdx.x;
    const int nrounds = (G == 256) ? 9 : (2176 + G - 1) / G;
#define ATT_WAITV(n) asm volatile("s_waitcnt vmcnt(" #n ")" ::: "memory")
#define ATT_BAR() do { asm volatile("" ::: "memory"); __builtin_amdgcn_s_barrier(); asm volatile("" ::: "memory"); } while (0)
    for (int k = 0; k < nrounds; ++k) {
        int id;
        if (G == 256) {
            if (k < 8) { const int xcd = vb >> 5, idx = vb & 31; const int seq = xcd * 4 + (k >> 1); const int qt = (k & 1) ? idx : (63 - idx); id = seq * 64 + qt; }
            else { if (vb >= 128) break; id = 2048 + vb; }
        } else { id = vb + k * G; if (id >= 2176) break; }
        int h, qrow0, nt_all, nt_mine, last_valid; const int kvstride = 128; const bf16_t* Kp; const bf16_t* Vp; bool sample;
        if (id < 2048) {
            const int seq = id >> 6, qt = id & 63, b = seq >> 3; h = seq & 7; sample = false;
            qrow0 = b * TP + 128 * qt + 32 * rg; nt_all = 2 * qt + 2; nt_mine = (rg < 2) ? 2 * qt + 1 : 2 * qt + 2; last_valid = 64 * nt_mine;
            Kp = (const bf16_t*)(ws + WS_KH) + (size_t)seq * TP * 128; Vp = (const bf16_t*)(ws + WS_VH) + (size_t)seq * TP * 128;
        } else {
            const int s = id - 2048, b = s >> 3; h = s & 7; sample = true;
            qrow0 = MP + b * TS; nt_all = 34; nt_mine = (rg == 0) ? 34 : 0; last_valid = PAST + TS;
            Kp = (const bf16_t*)(ws + WS_KS) + (size_t)s * KSROWS * 128; Vp = (const bf16_t*)(ws + WS_VS) + (size_t)s * KSROWS * 128;
        }
        bf16x8 qf[4];
        {
            const int qr = qrow0 + (sample ? (r32 & 15) : r32);
            const bf16_t* qp = proj + (size_t)qr * NPROJ + h * 128 + comp * 64 + 8 * h2;
#pragma unroll
            for (int s = 0; s < 4; ++s) qf[s] = *(const bf16x8*)(qp + 16 * s);
        }
        f32x16 O[4];
#pragma unroll
        for (int et = 0; et < 4; ++et)
#pragma unroll
            for (int i = 0; i < 16; ++i) O[et][i] = 0.f;
        float m = -INFINITY, l = 0.f;
        bf16x8 pf[2][2];
#pragma unroll
        for (int a = 0; a < 2; ++a)
#pragma unroll
            for (int c2 = 0; c2 < 2; ++c2) pf[a][c2] = (bf16x8){0, 0, 0, 0, 0, 0, 0, 0};
        f32x16 sA0, sA1, sB0, sB1;
        const bf16_t* gsrc;
        {
            const int rowl = lane >> 4, c = lane & 15;
            const int row0 = 16 * (wid & 3) + rowl;
            const int lc = (wid < 4) ? (c ^ (row0 & 15)) : (c ^ ((row0 & 3) << 2));
            gsrc = ((wid < 4) ? Kp : Vp) + (size_t)row0 * kvstride + lc * 8;
        }
#define ATT_G2L(kt, bufi) do { _Pragma("unroll") for (int _i = 0; _i < 4; ++_i) { \
            const bf16_t* _s = gsrc + (size_t)(64 * (kt) + 4 * _i) * kvstride; \
            if (wid < 4) _s += (((lane & 15) ^ ((16 * (wid & 3) + 4 * _i + (lane >> 4)) & 15)) - ((lane & 15) ^ ((16 * (wid & 3) + (lane >> 4)) & 15))) * 8; \
            g2l16(_s, lds_u32(lds + (bufi) * TB + (4 * wid + _i) * 1024)); } } while (0)
        ATT_G2L(0, 0);
        if (nt_all > 1) ATT_G2L(1, 1);
        asm volatile("" :: "v"(qf[0]), "v"(qf[1]), "v"(qf[2]), "v"(qf[3]));
        if (nt_all > 1) { ATT_WAITV(4); } else { ATT_WAITV(0); }
        ATT_BAR();
        {
            const int koff = r32 * 256, t = ((comp * 8 + h2) ^ (r32 & 15)) << 4;
            att_s(lds + koff, t, qf, sA0, sA1);
        }
#define ATT_ITER(KT, sC0, sC1, sN0, sN1, EDGE) do { \
            const int kt = (KT); \
            int lo_ = lane; asm volatile("" : "+v"(lo_)); \
            const int r32_ = lo_ & 31, h2_ = lo_ >> 5, q4_ = (lo_ & 15) >> 2, p4_ = lo_ & 3, blk_ = (lo_ >> 4) & 1; \
            const int koff_ = r32_ * 256, t_ = ((comp * 8 + h2_) ^ (r32_ & 15)) << 4; \
            const int voff_ = (4 * h2_ + q4_) * 256 + (2 * blk_ + (p4_ >> 1)) * 16 + (p4_ & 1) * 8; \
            ATT_WAITV(0); ATT_BAR(); \
            if (kt + 2 < nt_all) ATT_G2L(kt + 2, (kt + 2) & 3); \
            att_s(lds + ((kt + 1) & 3) * TB + koff_, t_, qf, sN0, sN1); \
            if (!(EDGE) || kt >= 1) att_pv(lds + ((kt - 1) & 3) * TB + 16384 + voff_, q4_, O, pf); \
            const float alpha = att_softmax<EDGE>(sC0, sC1, m, l, pf, h2_, last_valid - 64 * kt); \
            asm volatile("" :: "v"(l), "v"(pf[0][0]), "v"(pf[0][1]), "v"(pf[1][0]), "v"(pf[1][1]));     \
            _Pragma("unroll") for (int _g = 0; _g < 24; ++_g) { __builtin_amdgcn_sched_group_barrier(0x008, 1, 0); __builtin_amdgcn_sched_group_barrier(0x002, 5, 0); } \
            if (__any(alpha != 1.f)) { \
                _Pragma("unroll") for (int et = 0; et < 4; ++et) _Pragma("unroll") for (int i = 0; i < 16; ++i) O[et][i] *= alpha; } \
            } while (0)
        {
            const int npairs = nt_all >> 1;
            ATT_ITER(0, sA0, sA1, sB0, sB1, true);
            ATT_ITER(1, sB0, sB1, sA0, sA1, true);
            for (int pp = 1; pp < npairs - 1; ++pp) {
                ATT_ITER(2 * pp, sA0, sA1, sB0, sB1, false);
                ATT_ITER(2 * pp + 1, sB0, sB1, sA0, sA1, false);
            }
            if (npairs > 1) {
                ATT_ITER(nt_all - 2, sA0, sA1, sB0, sB1, true);
                ATT_ITER(nt_all - 1, sB0, sB1, sA0, sA1, true);
            }
        }
        {
            const int lt = nt_all - 1;
            const int h2b = lane >> 5, q4 = (lane & 15) >> 2, p4 = lane & 3, blk = (lane >> 4) & 1;
            const int voff = (4 * h2b + q4) * 256 + (2 * blk + (p4 >> 1)) * 16 + (p4 & 1) * 8;
            att_pv(lds + (lt & 3) * TB + 16384 + voff, q4, O, pf);
        }
        __syncthreads();
#undef ATT_ITER
#undef ATT_G2L
        const float lt = l + __shfl_xor(l, 32);
        const float inv = (nt_mine > 0) ? 1.f / lt : 0.f;
        LAS float* XO = (LAS float*)lds;
        if (comp == 1) {
            const float sc = inv * lam;
#pragma unroll
            for (int et = 0; et < 4; ++et)
#pragma unroll
                for (int i = 0; i < 16; ++i) XO[(rg * 128 + 32 * et + (i & 3) + 8 * (i >> 2) + 4 * h2) * 32 + r32] = O[et][i] * sc;
        }
        __syncthreads();
        if (comp == 0 && nt_mine > 0) {
            float ss = 0.f;
#pragma unroll
            for (int et = 0; et < 4; ++et)
#pragma unroll
                for (int i = 0; i < 16; ++i) { const float v = O[et][i] * inv - XO[(rg * 128 + 32 * et + (i & 3) + 8 * (i >> 2) + 4 * h2) * 32 + r32]; O[et][i] = v; ss += v * v; }
            ss += __shfl_xor(ss, 32);
            const float rstd = __builtin_amdgcn_rsqf(ss * (1.f / 128.f) + RMS_EPS) * (1.f - lam_init);
            const bool rvalid = sample ? (r32 < TS) : true;
            const int row = qrow0 + r32;
            if (rvalid) {
#pragma unroll
                for (int et = 0; et < 4; ++et)
#pragma unroll
                    for (int g4 = 0; g4 < 4; ++g4) {
                        const int e0 = 32 * et + 8 * g4 + 4 * h2;
                        const u32x2 zz = *(const u32x2*)(proj + (size_t)row * NPROJ + 3072 + h * 128 + e0);
                        const f32x4 sl = *(const f32x4*)(subln + e0);
                        const float z0 = __uint_as_float(zz.x << 16), z1 = __uint_as_float(zz.x & 0xffff0000u), z2 = __uint_as_float(zz.y << 16), z3 = __uint_as_float(zz.y & 0xffff0000u);
                        u32x2 w;
                        w.x = pk2(O[et][4 * g4] * rstd * sl[0] * siluf(z0), O[et][4 * g4 + 1] * rstd * sl[1] * siluf(z1));
                        w.y = pk2(O[et][4 * g4 + 2] * rstd * sl[2] * siluf(z2), O[et][4 * g4 + 3] * rstd * sl[3] * siluf(z3));
                        *(u32x2*)(OB + (size_t)row * 1024 + h * 128 + e0) = w;
                    }
            }
        }
        __syncthreads();
    }
}


#define XB_TMO      128
#define XB_XCNT(j)  (256  + 64 * (j))
#define XB_XSUB(j)  (1280 + 64 * (j))
#define XB_XGEN(j)  (2304 + 64 * (j))
#define XB_TOP      3328
#define XB_TOPGEN   3392
#define XCD_BAR_WORDS 3456
#define XB_SPIN_CAP (1u << 18)
DI unsigned xb_ld(unsigned* p)              { return __hip_atomic_load(p, __ATOMIC_RELAXED, __HIP_MEMORY_SCOPE_AGENT); }
DI unsigned xb_add(unsigned* p, unsigned v) { return __hip_atomic_fetch_add(p, v, __ATOMIC_RELAXED, __HIP_MEMORY_SCOPE_AGENT); }
DI unsigned xb_xcc_id() { return (unsigned)__builtin_amdgcn_s_getreg((3 << 11) | 20) & 0xFu; }
#define XB_SPIN(cond, bar) do { unsigned _sp = 0; while (cond) { __builtin_amdgcn_s_sleep(1); \
    if ((++_sp & 255u) == 0u) { if (xb_ld(&(bar)[XB_TMO])) break; if (_sp > XB_SPIN_CAP) { atomicAdd(&(bar)[XB_TMO], 1u); break; } } } } while (0)
DI void xcd_barrier_complete(unsigned* bar, unsigned x, unsigned& nloc, unsigned& nx) {
    const unsigned G = gridDim.x * gridDim.y * gridDim.z;
    unsigned sum, cnt, mine, sp = 0u;
    for (;;) {
        sum = 0u; cnt = 0u; mine = 0u;
#pragma unroll
        for (unsigned j = 0; j < 16; ++j) { const unsigned c = xb_ld(&bar[XB_XCNT(j)]); sum += c; cnt += (c > 0u) ? 1u : 0u; mine = (j == x) ? c : mine; }
        if (sum == G) break;
        __builtin_amdgcn_s_sleep(1);
        if ((++sp & 255u) == 0u) { if (xb_ld(&bar[XB_TMO])) break; if (sp > XB_SPIN_CAP) { atomicAdd(&bar[XB_TMO], 1u); break; } }
    }
    nloc = mine > 0u ? mine : 1u; nx = cnt > 0u ? cnt : 1u;
}
DI void xcd_barrier(unsigned* bar, volatile LAS unsigned* st) {
    asm volatile("s_waitcnt vmcnt(0)" ::: "memory");
    __syncthreads();
    if (threadIdx.x == 0) {
        const unsigned x = xb_xcc_id();
        __builtin_amdgcn_s_waitcnt(0);
        unsigned nloc = st[0], nx = st[1];
        if (nloc == 0u) { xcd_barrier_complete(bar, x, nloc, nx); st[0] = nloc; st[1] = nx; }
        const unsigned old = xb_add(&bar[XB_XSUB(x)], 1u);
        const unsigned gen = old / nloc;
        if (old + 1u == (gen + 1u) * nloc) {
            __builtin_amdgcn_fence(__ATOMIC_RELEASE, "agent");
            asm volatile("s_waitcnt vmcnt(0)" ::: "memory");
            const unsigned og = xb_add(&bar[XB_TOP], 1u);
            const unsigned tg = og / nx;
            if (og + 1u == (tg + 1u) * nx) xb_add(&bar[XB_TOPGEN], 1u);
            else XB_SPIN(xb_ld(&bar[XB_TOPGEN]) == tg, bar);
            __builtin_amdgcn_fence(__ATOMIC_ACQUIRE, "agent");
            xb_add(&bar[XB_XGEN(x)], 1u);
            asm volatile("s_waitcnt vmcnt(0)" ::: "memory");
        } else {
            XB_SPIN(xb_ld(&bar[XB_XGEN(x)]) == gen, bar);
            __builtin_amdgcn_fence(__ATOMIC_ACQUIRE, "agent");
            asm volatile("s_waitcnt vmcnt(0)" ::: "memory");
        }
    }
    __syncthreads();
}

typedef const __attribute__((address_space(4))) Params* CParP;
#define LOADP() Params P; { CParP kp_ = KP; asm volatile("" : "+s"(kp_)); P = *kp_; } unsigned char* ws = P.ws; (void)ws
__global__ void __launch_bounds__(512, 2) fwd_megakernel(Params Pin) {
#if defined(__HIP_DEVICE_COMPILE__)
    extern __shared__ __attribute__((aligned(16))) unsigned char lds_raw[];
    LAS unsigned char* lds = (LAS unsigned char*)lds_raw;
    cg::grid_group grid = cg::this_grid();
    const CParP KP = (CParP)__builtin_amdgcn_kernarg_segment_ptr();
    volatile LAS unsigned* xst = (volatile LAS unsigned*)(lds + 131072);
    if (threadIdx.x == 0) { xst[0] = 0u; xst[1] = 0u; }
    __syncthreads();
    { LOADP(); if (threadIdx.x == 0) (void)xb_add(&((unsigned*)(ws + WS_BAR))[XB_XCNT(xb_xcc_id())], 1u); }
#define GRID_BAR() do { LOADP(); xcd_barrier((unsigned*)(ws + WS_BAR), xst); } while (0)
    { LOADP(); phase_prep(P, lds); }
    grid.sync();
    for (int layer = 0; layer < 4; ++layer) {
        const int j = layer >> 1;
        { LOADP(); phase_elem(P, lds, layer); }
        GRID_BAR();
        {
            LOADP();
            pg8::StaticOrder S; S.init(M, NPROJ, gridDim.x, blockIdx.x);
            pg8::Gemm g;
            g.A = (const bf16_t*)(ws + WS_HBUF); g.M = M; g.N = NPROJ; g.K = 1024;
            if (!(layer & 1)) {
                g.Bt = (const bf16_t*)(ws + WS_WING) + (size_t)j * 4096 * 1024;
                EpiGdnIn E; E.proj = (bf16_t*)(ws + WS_PROJ); E.conv_p = P.out + OFF_CVP + (size_t)j * 4 * 3 * 3072; E.conv_s = P.out + OFF_CVS + (size_t)j * 16 * 3 * 3072;
                pg8::gemm_phase(lds, g, S, E);
            } else {
                g.Bt = (const bf16_t*)(ws + WS_WIND) + (size_t)j * 4096 * 1024;
                EpiDiffIn E; E.proj = (bf16_t*)(ws + WS_PROJ);
                E.k_p = P.out + OFF_KP + (size_t)j * MP * 1024; E.v_p = P.out + OFF_VP + (size_t)j * MP * 1024;
                E.k_s = P.out + OFF_KSO + (size_t)j * MS * 1024; E.v_s = P.out + OFF_VSO + (size_t)j * MS * 1024;
                E.ks = (bf16_t*)(ws + WS_KS); E.vs = (bf16_t*)(ws + WS_VS); E.kh = (bf16_t*)(ws + WS_KH); E.vh = (bf16_t*)(ws + WS_VH); E.rope = (const float*)(ws + WS_ROPE);
                pg8::gemm_phase(lds, g, S, E);
            }
        }
        GRID_BAR();
        if (!(layer & 1)) {
            { LOADP(); phase_g1(P, lds, layer); }
            GRID_BAR();
            { LOADP(); phase_scan(P, lds, layer); }
            GRID_BAR();
            { LOADP(); phase_gnorm(P, layer); }
        } else {
            { LOADP(); phase_attn(P, lds, layer); }
        }
        GRID_BAR();
        {
            LOADP();
            pg8::StaticOrder S; S.init(M, 1024, gridDim.x, blockIdx.x);
            pg8::Gemm g;
            g.A = (const bf16_t*)(ws + WS_HBUF); g.M = M; g.N = 1024; g.K = 1024;
            g.Bt = (const bf16_t*)(ws + ((layer & 1) ? WS_WOUTD : WS_WOUTG)) + (size_t)j * 1024 * 1024;
            EpiOut E; E.C = (bf16_t*)(ws + WS_PROJ);
            pg8::gemm_phase(lds, g, S, E);
        }
        GRID_BAR();
    }
    { LOADP(); phase_elem(P, lds, 4); }
#endif
}

extern "C" void kernel_launch(void* const* d_in, const int* in_sizes, int n_in, void* d_out, int out_size, void* d_ws, size_t ws_size, hipStream_t stream) {
    static int grid_blocks = 0;
    if (!grid_blocks) {
        int dev = 0, cus = 0, per_cu = 0;
        hipGetDevice(&dev);
        hipDeviceGetAttribute(&cus, hipDeviceAttributeMultiprocessorCount, dev);
        hipFuncSetAttribute((const void*)fwd_megakernel, hipFuncAttributeMaxDynamicSharedMemorySize, LDS_BYTES);
        hipOccupancyMaxActiveBlocksPerMultiprocessor(&per_cu, (const void*)fwd_megakernel, 512, LDS_BYTES);
        if (per_cu < 1) per_cu = 1;
        grid_blocks = cus * per_cu;
        if (ws_size < WS_END) fprintf(stderr, "kernel_launch: workspace too small: %zu < %zu\n", ws_size, (size_t)WS_END);
    }
    hipMemsetAsync((unsigned char*)d_ws + WS_BAR, 0, XCD_BAR_WORDS * sizeof(unsigned), stream);
    Params p{};
    for (int i = 0; i < 25; ++i) p.in[i] = (const float*)d_in[i];
    p.out = (float*)d_out; p.ws = (unsigned char*)d_ws;
    void* args[] = {&p};
    hipError_t e = hipLaunchCooperativeKernel((const void*)fwd_megakernel, dim3(grid_blocks), dim3(512), args, LDS_BYTES, stream);
    if (e != hipSuccess) fprintf(stderr, "cooperative launch failed: %s (grid %d)\n", hipGetErrorString(e), grid_blocks);
}
```
